# Optimizing an MI355X kernel written in HIP

```python
import jax, jax.numpy as jnp
from jax import lax
import numpy as np

D_MODEL = 1024
BATCH = 16
SEQ = 2048
DEPTH = 1

CHUNK = 64
Q_BLOCK = 128
EPS = 1e-6
MLA_HEADS = 8
QK_NOPE = 64
QK_ROPE = 32
QK_HEAD = QK_NOPE + QK_ROPE
V_HEAD = 64
Q_LORA = 256
KV_LORA = 128
ROPE_THETA = 10000.0
LRU_WIDTH = 1024
LRU_BLOCKS = 8
LRU_BW = LRU_WIDTH // LRU_BLOCKS
CONV_WIDTH = 4
LRU_C = 8.0
PEER_HEADS = 8
N_KEYS = 128
N_EXPERTS = N_KEYS * N_KEYS
PEER_DKEY = 256
PEER_HALF = PEER_DKEY // 2
PEER_TOPK = 16
TOKEN_BLOCK = 128
IN_COLS = Q_LORA + KV_LORA + QK_ROPE + 2 * LRU_WIDTH + 2 * D_MODEL
IN_SPLITS = [Q_LORA, Q_LORA + KV_LORA, Q_LORA + KV_LORA + QK_ROPE,
             Q_LORA + KV_LORA + QK_ROPE + LRU_WIDTH,
             Q_LORA + KV_LORA + QK_ROPE + 2 * LRU_WIDTH]

kernel_name = "hybrid_mla_rglru_peer_chunk_causal"


def rms_norm(x, g):
    xf = x.astype(jnp.float32)
    y = xf * lax.rsqrt(jnp.mean(xf * xf, axis=-1, keepdims=True) + EPS)
    return (y * g.astype(jnp.float32)).astype(x.dtype)


def apply_rope(t, cos, sin):
    t1, t2 = jnp.split(t, 2, axis=-1)
    return jnp.concatenate([t1 * cos - t2 * sin, t1 * sin + t2 * cos], axis=-1)


def mla_attention(c_q, c_kv, k_rope, positions, q_a_norm_g, w_uq, kv_a_norm_g, w_ukv,
                  q_norm_g, k_norm_g):
    B, S, _ = c_q.shape
    H = MLA_HEADS
    q = (rms_norm(c_q, q_a_norm_g) @ w_uq).reshape(B, S, H, QK_HEAD)
    kv = (rms_norm(c_kv, kv_a_norm_g) @ w_ukv).reshape(B, S, H, QK_NOPE + V_HEAD)
    k_nope, v = kv[..., :QK_NOPE], kv[..., QK_NOPE:]
    k = jnp.concatenate([k_nope, jnp.broadcast_to(k_rope[:, :, None, :], (B, S, H, QK_ROPE))], axis=-1)
    q = rms_norm(q, q_norm_g)
    k = rms_norm(k, k_norm_g)
    inv_freq = 1.0 / (ROPE_THETA ** (jnp.arange(0, QK_ROPE, 2, dtype=jnp.float32) / QK_ROPE))
    ang = positions.astype(jnp.float32)[..., None] * inv_freq
    cos = jnp.cos(ang)[:, :, None, :].astype(q.dtype)
    sin = jnp.sin(ang)[:, :, None, :].astype(q.dtype)
    q = jnp.concatenate([q[..., :QK_NOPE], apply_rope(q[..., QK_NOPE:], cos, sin)], axis=-1)
    k = jnp.concatenate([k[..., :QK_NOPE], apply_rope(k[..., QK_NOPE:], cos, sin)], axis=-1)
    nb = S // Q_BLOCK
    qb = q.reshape(B, nb, Q_BLOCK, H, QK_HEAD).transpose(1, 0, 2, 3, 4)
    key_chunk = jnp.arange(S) // CHUNK
    scale = QK_HEAD ** -0.5
    neg = jnp.finfo(jnp.float32).min

    def block(args):
        qi, bi = args
        s = jnp.einsum('bqhd,bkhd->bhqk', qi, k, preferred_element_type=jnp.float32) * scale
        q_chunk = (bi * Q_BLOCK + jnp.arange(Q_BLOCK)) // CHUNK
        mask = key_chunk[None, :] <= q_chunk[:, None]
        p = jax.nn.softmax(jnp.where(mask, s, neg), axis=-1).astype(v.dtype)
        return jnp.einsum('bhqk,bkhd->bqhd', p, v)

    o = lax.map(block, (qb, jnp.arange(nb)))
    return o.transpose(1, 0, 2, 3, 4).reshape(B, S, H * V_HEAD)


def rg_lru_branch(xb, gb, conv_w, conv_b, w_rg, b_rg, w_ig, b_ig, lru_lambda):
    B, S, C = xb.shape
    xc = lax.conv_general_dilated(xb, conv_w[:, None, :], window_strides=(1,),
                                  padding=[(CONV_WIDTH - 1, 0)],
                                  dimension_numbers=('NWC', 'WIO', 'NWC'),
                                  feature_group_count=C) + conv_b
    xblk = xc.reshape(B, S, LRU_BLOCKS, LRU_BW)
    r = jax.nn.sigmoid(jnp.einsum('bsni,nio->bsno', xblk, w_rg).reshape(B, S, C) + b_rg)
    i = jax.nn.sigmoid(jnp.einsum('bsni,nio->bsno', xblk, w_ig).reshape(B, S, C) + b_ig)
    log_a = (-LRU_C * r.astype(jnp.float32)) * jax.nn.softplus(-lru_lambda.astype(jnp.float32))
    a = jnp.exp(log_a)
    b = jnp.sqrt(-jnp.expm1(2.0 * log_a)) * (i * xc).astype(jnp.float32)

    def combine(e1, e2):
        a1, b1 = e1
        a2, b2 = e2
        return a1 * a2, a2 * b1 + b2

    _, h = lax.associative_scan(combine, (a, b), axis=1)
    return h.astype(xb.dtype) * jax.nn.gelu(gb)


def peer_ffn(h, w_query, sub_keys, expert_u, expert_v):
    B, S, D = h.shape
    hb = h.reshape((B * S) // TOKEN_BLOCK, TOKEN_BLOCK, D)
    K = PEER_TOPK

    def block(xt):
        q = (xt @ w_query).reshape(TOKEN_BLOCK, PEER_HEADS, 2, PEER_HALF)
        s = jnp.einsum('thpd,hpnd->thpn', q, sub_keys, preferred_element_type=jnp.float32)
        s_top, i_top = lax.top_k(s, K)
        cand = (s_top[:, :, 0, :, None] + s_top[:, :, 1, None, :]).reshape(TOKEN_BLOCK, PEER_HEADS, K * K)
        cand_idx = (i_top[:, :, 0, :, None] * N_KEYS + i_top[:, :, 1, None, :]).reshape(TOKEN_BLOCK, PEER_HEADS, K * K)
        best, pos = lax.top_k(cand, K)
        idx = jnp.take_along_axis(cand_idx, pos, axis=-1)
        g = jax.nn.softmax(best, axis=-1)
        u = expert_u[idx]
        v = expert_v[idx]
        act = jax.nn.gelu(jnp.einsum('td,thkd->thk', xt, u))
        return jnp.einsum('thk,thkd->td', (g * act).astype(xt.dtype), v)

    return lax.map(block, hb).reshape(B, S, D)


def _normal(key, shape, scale):
    return jax.random.normal(key, shape, jnp.float32) * scale


def setup_inputs(seed: int = 0) -> dict:
    key = jax.random.key(seed)
    ks = jax.random.split(key, 32)
    L, D, H = DEPTH, D_MODEL, MLA_HEADS
    x = _normal(ks[0], (BATCH, SEQ, D), 1.0)
    c = _normal(ks[1], (BATCH, D), 1.0)
    positions = (jax.random.randint(ks[2], (BATCH, 1), 0, 4096, dtype=jnp.int32)
                 + jnp.arange(SEQ, dtype=jnp.int32)[None, :]).astype(jnp.int32)
    u = jax.random.uniform(ks[21], (L, LRU_WIDTH), jnp.float32, 0.9, 0.999)
    a_base = u ** (1.0 / LRU_C)
    lru_lambda = jnp.log(a_base) - jnp.log1p(-a_base)
    return {
        'x': x,
        'c': c,
        'positions': positions,
        'w_ada': _normal(ks[3], (L, D, 6 * D), 0.5 * D ** -0.5),
        'b_ada': _normal(ks[4], (L, 6 * D), 0.02),
        'norm1_g': 1.0 + _normal(ks[5], (L, D), 0.02),
        'w_in': _normal(ks[6], (L, D, IN_COLS), D ** -0.5),
        'q_a_norm_g': 1.0 + _normal(ks[7], (L, Q_LORA), 0.02),
        'w_uq': _normal(ks[8], (L, Q_LORA, H * QK_HEAD), Q_LORA ** -0.5),
        'kv_a_norm_g': 1.0 + _normal(ks[9], (L, KV_LORA), 0.02),
        'w_ukv': _normal(ks[10], (L, KV_LORA, H * (QK_NOPE + V_HEAD)), KV_LORA ** -0.5),
        'q_norm_g': 1.0 + _normal(ks[11], (L, QK_HEAD), 0.02),
        'k_norm_g': 1.0 + _normal(ks[12], (L, QK_HEAD), 0.02),
        'w_o_attn': _normal(ks[13], (L, H * V_HEAD, D), (H * V_HEAD) ** -0.5),
        'conv_w': _normal(ks[14], (L, CONV_WIDTH, LRU_WIDTH), CONV_WIDTH ** -0.5),
        'conv_b': _normal(ks[15], (L, LRU_WIDTH), 0.02),
        'w_rg': _normal(ks[16], (L, LRU_BLOCKS, LRU_BW, LRU_BW), LRU_BW ** -0.5),
        'b_rg': _normal(ks[17], (L, LRU_WIDTH), 0.02),
        'w_ig': _normal(ks[18], (L, LRU_BLOCKS, LRU_BW, LRU_BW), LRU_BW ** -0.5),
        'b_ig': _normal(ks[19], (L, LRU_WIDTH), 0.02),
        'lru_lambda': lru_lambda,
        'w_o_lru': _normal(ks[22], (L, LRU_WIDTH, D), LRU_WIDTH ** -0.5),
        'w_out': _normal(ks[23], (L, D, D), D ** -0.5),
        'norm2_g': 1.0 + _normal(ks[24], (L, D), 0.02),
        'w_query': _normal(ks[25], (L, D, PEER_HEADS * PEER_DKEY), D ** -0.5),
        'sub_keys': _normal(ks[26], (L, PEER_HEADS, 2, N_KEYS, PEER_HALF), PEER_HALF ** -0.5),
        'expert_u': _normal(ks[27], (L, N_EXPERTS, D), D ** -0.5),
        'expert_v': _normal(ks[28], (L, N_EXPERTS, D), PEER_HEADS ** -0.5),
    }


def reference(x, c, positions, w_ada, b_ada, norm1_g, w_in, q_a_norm_g, w_uq, kv_a_norm_g,
              w_ukv, q_norm_g, k_norm_g, w_o_attn, conv_w, conv_b, w_rg, b_rg, w_ig, b_ig,
              lru_lambda, w_o_lru, w_out, norm2_g, w_query, sub_keys, expert_u, expert_v):
    cs = jax.nn.silu(c)
    for l in range(DEPTH):
        mod = cs @ w_ada[l] + b_ada[l]
        shift1, scale1, gate1, shift2, scale2, gate2 = [m[:, None, :] for m in jnp.split(mod, 6, axis=-1)]
        h = rms_norm(x, norm1_g[l]) * (1 + scale1) + shift1
        proj = h @ w_in[l]
        c_q, c_kv, k_rope, lru_x, lru_gate, merge_logits = jnp.split(proj, IN_SPLITS, axis=-1)
        attn = mla_attention(c_q, c_kv, k_rope, positions, q_a_norm_g[l], w_uq[l],
                             kv_a_norm_g[l], w_ukv[l], q_norm_g[l], k_norm_g[l])
        rec = rg_lru_branch(lru_x, lru_gate, conv_w[l], conv_b[l], w_rg[l], b_rg[l],
                            w_ig[l], b_ig[l], lru_lambda[l])
        g_attn, g_rec = jnp.split(jax.nn.sigmoid(merge_logits), 2, axis=-1)
        y = g_attn * (attn @ w_o_attn[l]) + g_rec * (rec @ w_o_lru[l])
        x = x + gate1 * (y @ w_out[l])
        h2 = rms_norm(x, norm2_g[l]) * (1 + scale2) + shift2
        x = x + gate2 * peer_ffn(h2, w_query[l], sub_keys[l], expert_u[l], expert_v[l])
    return x
```

```cpp
#include <hip/hip_runtime.h>
#include <cstdio>
#include <cstdint>

#define LAS __attribute__((address_space(3)))
#define GAS __attribute__((address_space(1)))
typedef unsigned short bf16_t;
typedef short bf16x8 __attribute__((ext_vector_type(8)));
typedef float f32x4 __attribute__((ext_vector_type(4)));
typedef unsigned u32x4 __attribute__((ext_vector_type(4)));
typedef unsigned u32x2 __attribute__((ext_vector_type(2)));
typedef float f32x2 __attribute__((ext_vector_type(2)));

#ifndef MK_N_LAUNCHES
#define MK_N_LAUNCHES 1
#endif

constexpr int T = 32768, D = 1024, NB_ = 16, S = 2048, H = 8;
constexpr int QKH = 96, VH = 64;
constexpr int NE = 16384;
constexpr float EPS = 1e-6f;

constexpr size_t MiB = 1u << 20;
constexpr size_t WS_CTL = 0, CTL_ZERO_BYTES = 65536;
constexpr size_t WS_MOD = 1 * MiB;
constexpr size_t WS_RSTD = 1 * MiB + 512 * 1024;
constexpr size_t WS_C8SP = 1 * MiB + 448 * 1024;
constexpr size_t WS_WIN = 2 * MiB;
constexpr size_t WS_WUQ = 11 * MiB;
constexpr size_t WS_WUKV = 11 * MiB + 512 * 1024;
constexpr size_t WS_WOA = 12 * MiB;
constexpr size_t WS_WOL = 13 * MiB;
constexpr size_t WS_WOUT = 15 * MiB;
constexpr size_t WS_WQ = 17 * MiB;
constexpr size_t WS_WG = 21 * MiB;
constexpr size_t WS_SK = 22 * MiB;
constexpr size_t WS_EU = 24 * MiB;
constexpr size_t WS_EV = 40 * MiB;
constexpr size_t WS_SU = 1 * MiB + 768 * 1024;
constexpr size_t WS_SV = 1 * MiB + 832 * 1024;
constexpr size_t WS_WGT = 440 * MiB;
constexpr size_t WS_H2Q = 456 * MiB;
constexpr size_t WS_SH = 1 * MiB + 896 * 1024;
constexpr size_t WS_PD = 280 * MiB;
constexpr size_t WS_R0 = 88 * MiB;
constexpr size_t WS_R1 = 152 * MiB;
constexpr size_t WS_R2 = 184 * MiB;
constexpr size_t WS_R3 = 248 * MiB;
constexpr size_t WS_R4 = 312 * MiB;
constexpr size_t WS_R5 = 376 * MiB;
constexpr size_t WS_R6 = 424 * MiB;
constexpr size_t WS_QP = 152 * MiB;
constexpr size_t WS_SC = 280 * MiB;
constexpr size_t WS_IDX = 408 * MiB;
constexpr size_t WS_GW = 424 * MiB;
constexpr size_t WS_END = 488 * MiB;

constexpr int LDS_BYTES = 147456;
constexpr int MISC_OFF = 131072 + 320;

__device__ __forceinline__ unsigned f2bf(float f) { unsigned u = __builtin_bit_cast(unsigned, f); return (u + 0x7fffu + ((u >> 16) & 1u)) >> 16; }
__device__ __forceinline__ unsigned pk2(float lo, float hi) { return f2bf(lo) | (f2bf(hi) << 16); }
__device__ __forceinline__ float bf2f(unsigned h) { return __builtin_bit_cast(float, h << 16); }
__device__ __forceinline__ float bflo(unsigned w) { return __builtin_bit_cast(float, w << 16); }
__device__ __forceinline__ float bfhi(unsigned w) { return __builtin_bit_cast(float, w & 0xffff0000u); }
__device__ __forceinline__ float sigmoidf_(float x) { return 1.f / (1.f + __expf(-x)); }
__device__ __forceinline__ float gelu_tanh(float x) {
    const float u = 0.7978845608028654f * (x + 0.044715f * x * x * x);
    const float e = __expf(2.f * u);
    const float th = 1.f - 2.f / (e + 1.f);
    return 0.5f * x * (1.f + th);
}
__device__ __forceinline__ float wave_sum(float v) {
#pragma unroll
    for (int o = 1; o < 64; o <<= 1) v += __shfl_xor(v, o);
    return v;
}
__device__ __forceinline__ void unpack8(const u32x4 w, float (&v)[8]) {
    v[0] = bflo(w.x); v[1] = bfhi(w.x); v[2] = bflo(w.y); v[3] = bfhi(w.y); v[4] = bflo(w.z); v[5] = bfhi(w.z); v[6] = bflo(w.w); v[7] = bfhi(w.w);
}
__device__ __forceinline__ u32x4 pack8(const float (&v)[8]) {
    u32x4 w; w.x = pk2(v[0], v[1]); w.y = pk2(v[2], v[3]); w.z = pk2(v[4], v[5]); w.w = pk2(v[6], v[7]); return w;
}

namespace pg8 {
#define PG8_LAS __attribute__((address_space(3)))
constexpr int BM = 256, BK = 64, HALF = 128, HTB = HALF * BK * 2, STAGE_BYTES = 8 * HTB, NXCD = 8, WGM = 8;
__host__ __device__ __forceinline__ int lds_byte(int r, int c) { const int st = (r >> 4) * 2 + (c >> 5), rr = r & 15, cc = c & 31, ob = rr * 64 + cc * 2; return st * 1024 + (ob ^ (((ob >> 9) & 1) << 5)); }
__host__ __device__ __forceinline__ void stage_rc(int b, int& R, int& C) { const int st = b / 1024, sb = b % 1024, swz = sb ^ (((sb >> 9) & 1) << 5); R = (st >> 1) * 16 + swz / 64; C = (st & 1) * 32 + (swz % 64) / 2; }
__host__ __device__ __forceinline__ int perm32(int rho) { const int n = rho >> 4, i = rho & 15; return 8 * (i >> 2) + 4 * n + (i & 3); }

struct Unit { int pm, pn; };
struct Gemm { const bf16_t* A; const bf16_t* Bt; };

template <int M_, int N_> struct StaticOrder {
    static constexpr int nM = M_ / BM, nN = N_ / BM, nwg = nM * nN;
    int G, c;
    __host__ __device__ void init(int G_, int c_) { G = G_; c = c_; }
    __host__ __device__ bool next(int i, Unit& u) const {
        const long L = (long)i * G + c; if (L >= nwg) return false;
        int wgid = (int)L; { const int q = nwg / NXCD, r = nwg % NXCD, xcd = wgid % NXCD, off = wgid / NXCD; wgid = (xcd < r ? xcd * (q + 1) : r * (q + 1) + (xcd - r) * q) + off; }
        const int nig = WGM * nN, gid = wgid / nig, fm = gid * WGM, gsz = (nM - fm) < WGM ? (nM - fm) : WGM;
        u.pm = fm + ((wgid % nig) % gsz); u.pn = (wgid % nig) / gsz; return true;
    }
};

template <class F> struct EpiF {
    static constexpr bool PERM = true;
    F f;
    __device__ __forceinline__ void operator()(const f32x4 (&acc)[2][2][4][2], const Unit& u, int wr, int wc, int fr, int fq) const {
        const int c = wc * 32 + 8 * fq;
#pragma unroll
        for (int ai = 0; ai < 2; ++ai)
#pragma unroll
            for (int m = 0; m < 4; ++m) {
                const int row = u.pm * BM + ai * HALF + wr * 64 + m * 16 + fr;
                float v0[8], v1[8];
#pragma unroll
                for (int j = 0; j < 4; ++j) { v0[j] = acc[ai][0][m][0][j]; v0[4 + j] = acc[ai][0][m][1][j]; v1[j] = acc[ai][1][m][0][j]; v1[4 + j] = acc[ai][1][m][1][j]; }
                f(row, u.pn, c, v0, v1);
            }
    }
};

template <int K, int LDA, int ACS, class Epi, class Sched>
__device__ __forceinline__ void gemm_phase(PG8_LAS unsigned char* lds, const Gemm g, const Sched& S, const Epi& E) {
    const int tid = threadIdx.x, wid = __builtin_amdgcn_readfirstlane(tid >> 6), lane = tid & 63, wr = wid >> 2, wc = wid & 3, fr = lane & 15, fq = lane >> 4;
    constexpr int nt = K / BK;
    unsigned voffA[2], voffB[2];
#pragma unroll
    for (int i = 0; i < 2; ++i) { int R, C; stage_rc(tid * 16 + i * 8192, R, C); const int Rb = Epi::PERM ? ((R & ~31) + perm32(R & 31)) : R;
        voffA[i] = (unsigned)(R * LDA + C) * 2u; voffB[i] = (unsigned)(Rb * K + C) * 2u; }
    constexpr size_t kstep = (size_t)(BK * 2);
    constexpr size_t hstepA = (size_t)HALF * LDA * 2, hstepB = (size_t)HALF * K * 2;
    constexpr size_t tstepA = 2 * hstepA, tstepB = 2 * hstepB;
    constexpr size_t acsb = (size_t)ACS * 2;
    const unsigned ldsw = (unsigned)wid * 1024u;
    const int aoff = lds_byte(wr * 64 + fr, fq * 8), boff = lds_byte(wc * 32 + fr, fq * 8);
#define PG8_SA(b, h) (((b) * 2 + (h)) * HTB)
#define PG8_SB(b, h) ((4 + (b) * 2 + (h)) * HTB)
#define PG8_STAGE(bufoff, gbase, voff) do { _Pragma("unroll") for (int _i = 0; _i < 2; ++_i) \
        __builtin_amdgcn_global_load_lds((const unsigned*)((const char*)(gbase) + (voff)[_i]), (PG8_LAS unsigned*)(lds + (bufoff) + ldsw + _i * 8192), 16, 0, 0); } while (0)
#define PG8_LDA(dst, b, h) do { _Pragma("unroll") for (int m = 0; m < 4; ++m) _Pragma("unroll") for (int k = 0; k < 2; ++k) dst[m][k] = *(const PG8_LAS bf16x8*)(lds + PG8_SA(b, h) + aoff + m * 2048 + k * 1024); } while (0)
#define PG8_LDB(dst, b, h) do { _Pragma("unroll") for (int n = 0; n < 2; ++n) _Pragma("unroll") for (int k = 0; k < 2; ++k) dst[n][k] = *(const PG8_LAS bf16x8*)(lds + PG8_SB(b, h) + boff + n * 2048 + k * 1024); } while (0)
#define PG8_MMA(ai, bj, At, Bt) do { __builtin_amdgcn_s_setprio(1); _Pragma("unroll") for (int m = 0; m < 4; ++m) _Pragma("unroll") for (int n = 0; n < 2; ++n) _Pragma("unroll") for (int k = 0; k < 2; ++k) \
        acc[ai][bj][m][n] = __builtin_amdgcn_mfma_f32_16x16x32_bf16(Bt[n][k], At[m][k], acc[ai][bj][m][n], 0, 0, 0); __builtin_amdgcn_s_setprio(0); } while (0)
#define PG8_WAIT_V(n) asm volatile("s_waitcnt vmcnt(" #n ")" ::: "memory")
#define PG8_WAIT_L(n) asm volatile("s_waitcnt lgkmcnt(" #n ")" ::: "memory")
#define PG8_BAR __builtin_amdgcn_s_barrier()
#define PG8_SCHED __builtin_amdgcn_sched_barrier(0)
    Unit cur, nxt; int ui = 0;
    if (!S.next(0, cur)) return;
    f32x4 acc[2][2][4][2];
#pragma unroll
    for (int a = 0; a < 2; ++a)
#pragma unroll
        for (int b = 0; b < 2; ++b)
#pragma unroll
            for (int m = 0; m < 4; ++m)
#pragma unroll
                for (int n = 0; n < 2; ++n) acc[a][b][m][n] = (f32x4){0.f, 0.f, 0.f, 0.f};
    bf16x8 At[4][2], B0[2][2], B1[2][2];
    const char* cA = (const char*)g.A + (size_t)cur.pm * tstepA + (size_t)cur.pn * acsb; const char* cB = (const char*)g.Bt + (size_t)cur.pn * tstepB;
    PG8_STAGE(PG8_SB(0, 0), cB, voffB); PG8_STAGE(PG8_SB(0, 1), cB + hstepB, voffB); PG8_STAGE(PG8_SA(0, 0), cA, voffA); PG8_STAGE(PG8_SA(0, 1), cA + hstepA, voffA);
    if (wr == 1) PG8_BAR;
    PG8_WAIT_V(2); PG8_BAR;
    PG8_STAGE(PG8_SB(1, 0), cB + kstep, voffB); PG8_STAGE(PG8_SA(1, 0), cA + kstep, voffA); PG8_STAGE(PG8_SB(1, 1), cB + hstepB + kstep, voffB);
    PG8_WAIT_V(6); PG8_BAR;
    for (;;) {
        const bool has_next = S.next(ui + 1, nxt);
        const char* nA = has_next ? (const char*)g.A + (size_t)nxt.pm * tstepA + (size_t)nxt.pn * acsb : cA; const char* nB = has_next ? (const char*)g.Bt + (size_t)nxt.pn * tstepB : cB;
#pragma unroll 1
        for (int t = 0; t < nt; t += 2) {
            const bool last = (t == nt - 2);
            const char* a1 = cA + (size_t)(t + 1) * kstep;
            const char* a2 = last ? nA : cA + (size_t)(t + 2) * kstep; const char* b2 = last ? nB : cB + (size_t)(t + 2) * kstep;
            const char* a3 = a2 + kstep; const char* b3 = b2 + kstep;
            PG8_LDB(B0, 0, 0); PG8_LDB(B1, 0, 1); PG8_SCHED; PG8_LDA(At, 0, 0); PG8_STAGE(PG8_SA(1, 1), a1 + hstepA, voffA);
            PG8_WAIT_V(8); PG8_WAIT_L(0); PG8_BAR; PG8_MMA(0, 0, At, B0); PG8_MMA(0, 1, At, B1); PG8_BAR; PG8_SCHED;
            PG8_LDA(At, 0, 1); PG8_STAGE(PG8_SB(0, 0), b2, voffB); PG8_STAGE(PG8_SB(0, 1), b2 + hstepB, voffB); PG8_STAGE(PG8_SA(0, 0), a2, voffA);
            PG8_WAIT_V(8); PG8_WAIT_L(0); PG8_BAR; PG8_MMA(1, 0, At, B0); PG8_MMA(1, 1, At, B1); PG8_BAR; PG8_SCHED;
            PG8_LDB(B0, 1, 0); PG8_LDB(B1, 1, 1); PG8_SCHED; PG8_LDA(At, 1, 0); PG8_STAGE(PG8_SA(0, 1), a2 + hstepA, voffA);
            PG8_WAIT_V(8); PG8_WAIT_L(0); PG8_BAR; PG8_MMA(0, 0, At, B0); PG8_MMA(0, 1, At, B1); PG8_BAR; PG8_SCHED;
            PG8_LDA(At, 1, 1); PG8_STAGE(PG8_SB(1, 0), b3, voffB); PG8_STAGE(PG8_SB(1, 1), b3 + hstepB, voffB); PG8_STAGE(PG8_SA(1, 0), a3, voffA);
            PG8_WAIT_V(8); PG8_WAIT_L(0); PG8_BAR; PG8_MMA(1, 0, At, B0); PG8_MMA(1, 1, At, B1); PG8_BAR; PG8_SCHED;
        }
        if (wr == 0) PG8_BAR;
        E(acc, cur, wr, wc, fr, fq);
        if (!has_next) break;
#pragma unroll
        for (int a = 0; a < 2; ++a)
#pragma unroll
            for (int b = 0; b < 2; ++b)
#pragma unroll
                for (int m = 0; m < 4; ++m)
#pragma unroll
                    for (int n = 0; n < 2; ++n) acc[a][b][m][n] = (f32x4){0.f, 0.f, 0.f, 0.f};
        cur = nxt; cA = nA; cB = nB; ++ui;
        if (wr == 1) PG8_BAR;
    }
    PG8_WAIT_V(0);
    PG8_BAR;
#undef PG8_SA
#undef PG8_SB
#undef PG8_STAGE
#undef PG8_LDA
#undef PG8_LDB
#undef PG8_MMA
#undef PG8_WAIT_V
#undef PG8_WAIT_L
#undef PG8_BAR
#undef PG8_SCHED
}
}

#define XB_TMO      128
#define XB_XCNT(j)  (256  + 64 * (j))
#define XB_XSUB(j)  (1280 + 64 * (j))
#define XB_XGEN(j)  (2304 + 64 * (j))
#define XB_TOP      3328
#define XB_TOPGEN   3392
#define XCD_BAR_WORDS 3456
#define XB_SPIN_CAP (1u << 18)
__device__ __forceinline__ unsigned xb_ld(unsigned* p)              { return __hip_atomic_load(p, __ATOMIC_RELAXED, __HIP_MEMORY_SCOPE_AGENT); }
__device__ __forceinline__ unsigned xb_add(unsigned* p, unsigned v) { return __hip_atomic_fetch_add(p, v, __ATOMIC_RELAXED, __HIP_MEMORY_SCOPE_AGENT); }
__device__ __forceinline__ unsigned xb_xcc_id() { return (unsigned)__builtin_amdgcn_s_getreg((3 << 11) | 20) & 0xFu; }
#define XB_SPIN(cond, bar) do { unsigned _sp = 0; while (cond) { __builtin_amdgcn_s_sleep(1); \
    if ((++_sp & 255u) == 0u) { if (xb_ld(&(bar)[XB_TMO])) break; if (_sp > XB_SPIN_CAP) { atomicAdd(&(bar)[XB_TMO], 1u); break; } } } } while (0)
struct XcdBarrier { unsigned* bar; unsigned x; volatile LAS unsigned* st; };
__device__ __forceinline__ XcdBarrier xcd_barrier_post(unsigned* bar, volatile LAS unsigned* st) {
    XcdBarrier b; b.bar = bar; b.x = xb_xcc_id(); b.st = st;
    if (threadIdx.x == 0) (void)xb_add(&bar[XB_XCNT(b.x)], 1u);
    return b;
}
__device__ __forceinline__ void xcd_barrier_complete(unsigned* bar, unsigned x, unsigned& nloc, unsigned& nx) {
    const unsigned G = gridDim.x * gridDim.y * gridDim.z;
    unsigned sum, cnt, mine, sp = 0u;
    for (;;) {
        sum = 0u; cnt = 0u; mine = 0u;
#pragma unroll
        for (unsigned j = 0; j < 16; ++j) { const unsigned c = xb_ld(&bar[XB_XCNT(j)]); sum += c; cnt += (c > 0u) ? 1u : 0u; mine = (j == x) ? c : mine; }
        if (sum == G) break;
        __builtin_amdgcn_s_sleep(1);
        if ((++sp & 255u) == 0u) { if (xb_ld(&bar[XB_TMO])) break; if (sp > XB_SPIN_CAP) { atomicAdd(&bar[XB_TMO], 1u); break; } }
    }
    nloc = mine > 0u ? mine : 1u; nx = cnt > 0u ? cnt : 1u;
}
__device__ __forceinline__ void xcd_barrier(const XcdBarrier& b) {
    asm volatile("s_waitcnt vmcnt(0)" ::: "memory");
    __syncthreads();
    if (threadIdx.x == 0) {
        unsigned* bar = b.bar;
        __builtin_amdgcn_s_waitcnt(0);
        unsigned nloc = b.st[0], nx = b.st[1];
        if (nloc == 0u) { xcd_barrier_complete(bar, b.x, nloc, nx); b.st[0] = nloc; b.st[1] = nx; }
        const unsigned old = xb_add(&bar[XB_XSUB(b.x)], 1u);
        const unsigned gen = old / nloc;
        if (old + 1u == (gen + 1u) * nloc) {
            __builtin_amdgcn_fence(__ATOMIC_RELEASE, "agent");
            asm volatile("s_waitcnt vmcnt(0)" ::: "memory");
            const unsigned og = xb_add(&bar[XB_TOP], 1u);
            const unsigned tg = og / nx;
            if (og + 1u == (tg + 1u) * nx) xb_add(&bar[XB_TOPGEN], 1u);
            else XB_SPIN(xb_ld(&bar[XB_TOPGEN]) == tg, bar);
            __builtin_amdgcn_fence(__ATOMIC_ACQUIRE, "agent");
            xb_add(&bar[XB_XGEN(b.x)], 1u);
            asm volatile("s_waitcnt vmcnt(0)" ::: "memory");
        } else {
            XB_SPIN(xb_ld(&bar[XB_XGEN(b.x)]) == gen, bar);
            __builtin_amdgcn_fence(__ATOMIC_ACQUIRE, "agent");
            asm volatile("s_waitcnt vmcnt(0)" ::: "memory");
        }
    }
    __syncthreads();
}

struct Args { const float* in[28]; float* out; unsigned char* ws; int ph_lo, ph_hi; };
enum { I_X = 0, I_C, I_POS, I_WADA, I_BADA, I_N1G, I_WIN, I_QAG, I_WUQ, I_KVAG, I_WUKV, I_QNG, I_KNG, I_WOA, I_CONVW, I_CONVB, I_WRG, I_BRG, I_WIG, I_BIG, I_LAM, I_WOL, I_WOUT, I_N2G, I_WQ, I_SUBK, I_EU, I_EV };
constexpr int N_PHASES = 17;

struct Ctx {
    LAS unsigned char* lds;
    int tid, lane, wave, vcu, G;
    const float* const* in; float* out; unsigned char* ws;
};
#define WSP(type, off) ((type*)(c.ws + (off)))

template <class F>
__device__ __forceinline__ void tr_tile(const Ctx& c, bf16_t* dst, int K, int n0, int k0, F f) {
    LAS float* scr = (LAS float*)c.lds;
#pragma unroll
    for (int i = 0; i < 8; ++i) { const int kk = i * 8 + (c.tid >> 6), nn = c.tid & 63; scr[kk * 65 + nn] = f(k0 + kk, n0 + nn); }
    __syncthreads();
#pragma unroll
    for (int i = 0; i < 8; ++i) { const int nn = i * 8 + (c.tid >> 6), kk = c.tid & 63; dst[(size_t)(n0 + nn) * K + k0 + kk] = (bf16_t)f2bf(scr[kk * 65 + nn]); }
    __syncthreads();
}

__device__ __forceinline__ void phase_prep(const Ctx& c) {
    const float* w_in = c.in[I_WIN]; const float* w_uq = c.in[I_WUQ]; const float* qag = c.in[I_QAG]; const float* w_ukv = c.in[I_WUKV]; const float* kvag = c.in[I_KVAG];
    const float* w_oa = c.in[I_WOA]; const float* w_ol = c.in[I_WOL]; const float* w_out = c.in[I_WOUT]; const float* w_q = c.in[I_WQ];
    const float* w_rg = c.in[I_WRG]; const float* w_ig = c.in[I_WIG];
    constexpr int T_WIN = 72 * 16, T_WUQ = 12 * 4, T_WUKV = 16 * 2, T_WOA = 16 * 8, T_WOL = 16 * 16, T_WOUT = 16 * 16, T_WQ = 32 * 16, T_WG = 8 * 4 * 2;
    constexpr int T_ALL = T_WIN + T_WUQ + T_WUKV + T_WOA + T_WOL + T_WOUT + T_WQ + T_WG;
    for (int it = c.vcu; it < T_ALL; it += c.G) {
        int r = it;
        if (r < T_WIN) { const int nb = r / 16, kb = r % 16;
            tr_tile(c, WSP(bf16_t, WS_WIN), 1024, nb * 64, kb * 64, [=](int k, int n) -> float { return n < 416 ? w_in[(size_t)k * 4512 + n] : (n < 512 ? 0.f : w_in[(size_t)k * 4512 + n - 96]); }); continue; }
        r -= T_WIN;
        if (r < T_WUQ) { const int nb = r / 4, kb = r % 4;
            tr_tile(c, WSP(bf16_t, WS_WUQ), 256, nb * 64, kb * 64, [=](int k, int n) -> float { return w_uq[(size_t)k * 768 + n] * qag[k]; }); continue; }
        r -= T_WUQ;
        if (r < T_WUKV) { const int nb = r / 2, kb = r % 2;
            tr_tile(c, WSP(bf16_t, WS_WUKV), 128, nb * 64, kb * 64, [=](int k, int n) -> float { return w_ukv[(size_t)k * 1024 + n] * kvag[k]; }); continue; }
        r -= T_WUKV;
        if (r < T_WOA) { const int nb = r / 8, kb = r % 8;
            tr_tile(c, WSP(bf16_t, WS_WOA), 512, nb * 64, kb * 64, [=](int k, int n) -> float { return w_oa[(size_t)k * 1024 + n]; }); continue; }
        r -= T_WOA;
        if (r < T_WOL) { const int nb = r / 16, kb = r % 16;
            tr_tile(c, WSP(bf16_t, WS_WOL), 1024, nb * 64, kb * 64, [=](int k, int n) -> float { return w_ol[(size_t)k * 1024 + n]; }); continue; }
        r -= T_WOL;
        if (r < T_WOUT) { const int nb = r / 16, kb = r % 16;
            tr_tile(c, WSP(bf16_t, WS_WOUT), 1024, nb * 64, kb * 64, [=](int k, int n) -> float { return w_out[(size_t)k * 1024 + n]; }); continue; }
        r -= T_WOUT;
        if (r < T_WQ) { const int nb = r / 16, kb = r % 16;
            tr_tile(c, WSP(bf16_t, WS_WQ), 1024, nb * 64, kb * 64, [=](int k, int n) -> float { return w_q[(size_t)k * 2048 + n]; }); continue; }
        r -= T_WQ;
        { const int blk = r / 8, q = r % 8, nb = q / 2, kb = q % 2;
            tr_tile(c, WSP(bf16_t, WS_WG) + (size_t)blk * 256 * 128, 128, nb * 64, kb * 64,
                    [=](int k, int n) -> float { return n < 128 ? w_rg[((size_t)blk * 128 + k) * 128 + n] : w_ig[((size_t)blk * 128 + k) * 128 + n - 128]; }); }
    }
    { const float* lam = c.in[I_LAM]; float* t8 = WSP(float, WS_C8SP);
      if (c.vcu == 0) for (int e = c.tid; e < 1024; e += 512) t8[e] = -8.f * log1pf(__expf(-lam[e])); }
    { const float* sk = c.in[I_SUBK]; bf16_t* dst = WSP(bf16_t, WS_SK);
      for (int e = c.vcu * 512 + c.tid; e < 8 * 256 * 256; e += c.G * 512) {
          const int h = e >> 16, r = (e >> 8) & 255, cc = e & 255;
          float v = 0.f; if ((r >> 7) == (cc >> 7)) v = sk[(((size_t)h * 2 + (r >> 7)) * 128 + (r & 127)) * 128 + (cc & 127)];
          dst[e] = (bf16_t)f2bf(v); } }
    { const int gw = c.vcu * 8 + c.wave, NGW = c.G * 8, L = c.lane;
      for (int r = gw; r < 2 * NE; r += NGW) {
          const int isv = r >= NE, e = isv ? r - NE : r;
          const f32x4* src4 = (const f32x4*)((isv ? c.in[I_EV] : c.in[I_EU]) + (size_t)e * 1024 + 16 * L);
          f32x4 v[4]; float am = 0.f;
#pragma unroll
          for (int j = 0; j < 4; ++j) { v[j] = src4[j]; am = fmaxf(am, fmaxf(fmaxf(fabsf(v[j].x), fabsf(v[j].y)), fmaxf(fabsf(v[j].z), fabsf(v[j].w)))); }
#pragma unroll
          for (int o = 1; o < 64; o <<= 1) am = fmaxf(am, __shfl_xor(am, o));
          const float s = am > 0.f ? am * (1.f / 256.f) : 1.f, inv = 1.f / s;
          u32x4 q;
          { int w;
            w = __builtin_amdgcn_cvt_pk_fp8_f32(v[0].x * inv, v[0].y * inv, 0, false); w = __builtin_amdgcn_cvt_pk_fp8_f32(v[0].z * inv, v[0].w * inv, w, true); q.x = (unsigned)w;
            w = __builtin_amdgcn_cvt_pk_fp8_f32(v[1].x * inv, v[1].y * inv, 0, false); w = __builtin_amdgcn_cvt_pk_fp8_f32(v[1].z * inv, v[1].w * inv, w, true); q.y = (unsigned)w;
            w = __builtin_amdgcn_cvt_pk_fp8_f32(v[2].x * inv, v[2].y * inv, 0, false); w = __builtin_amdgcn_cvt_pk_fp8_f32(v[2].z * inv, v[2].w * inv, w, true); q.z = (unsigned)w;
            w = __builtin_amdgcn_cvt_pk_fp8_f32(v[3].x * inv, v[3].y * inv, 0, false); w = __builtin_amdgcn_cvt_pk_fp8_f32(v[3].z * inv, v[3].w * inv, w, true); q.w = (unsigned)w; }
          if (!isv) { *(u32x4*)(c.ws + WS_EU + ((size_t)(L >> 3) * NE + e) * 128 + (L & 7) * 16) = q; if (L == 0) WSP(float, WS_SU)[e] = s; }
          else { *(u32x4*)(c.ws + WS_EV + ((size_t)(L >> 3) * NE + e) * 128 + (L & 7) * 16) = q; if (L == 0) WSP(float, WS_SV)[e] = s; }
      } }
    { const float* cin = c.in[I_C]; const float* w_ada = c.in[I_WADA]; const float* b_ada = c.in[I_BADA]; float* mod = WSP(float, WS_MOD);
      LAS float* cs = (LAS float*)c.lds;
      LAS float* red = (LAS float*)(c.lds + 65536);
      bool have = false;
      for (int it = c.vcu; it < 192; it += c.G) {
          if (!have) { for (int e = c.tid; e < 16 * 1024; e += 512) { const float v = cin[e]; cs[e] = v / (1.f + __expf(-v)); } have = true; }
          __syncthreads();
          const int cl = c.tid & 31, ks = c.tid >> 5, j = it * 32 + cl;
          float acc[16];
#pragma unroll
          for (int b = 0; b < 16; ++b) acc[b] = 0.f;
          for (int kk = 0; kk < 64; ++kk) { const int k = ks * 64 + kk; const float w = w_ada[(size_t)k * 6144 + j];
#pragma unroll
              for (int b = 0; b < 16; ++b) acc[b] += cs[b * 1024 + k] * w; }
#pragma unroll
          for (int b = 0; b < 16; ++b) red[(ks * 16 + b) * 32 + cl] = acc[b];
          __syncthreads();
          { const int b = c.tid >> 5; float s = b_ada[j];
#pragma unroll
            for (int k2 = 0; k2 < 16; ++k2) s += red[(k2 * 16 + b) * 32 + cl];
            mod[b * 6144 + j] = s; }
          __syncthreads();
      } }
}

template <bool Q8>
__device__ __forceinline__ void phase_modnorm(const Ctx& c, const float* x, const float* g, int shift_off, int scale_off, bf16_t* dst) {
    const float* mod = WSP(float, WS_MOD);
    const int gw = c.vcu * 8 + c.wave, NGW = c.G * 8;
    for (int m = gw; m < T; m += NGW) {
        const int b = m >> 11;
        const f32x4* xr = (const f32x4*)(x + (size_t)m * D) + c.lane;
        f32x4 v[4]; float s = 0.f;
#pragma unroll
        for (int j = 0; j < 4; ++j) { v[j] = xr[64 * j]; s += (v[j].x * v[j].x + v[j].y * v[j].y) + (v[j].z * v[j].z + v[j].w * v[j].w); }
        const float rstd = rsqrtf(wave_sum(s) * (1.f / D) + EPS);
        u32x2* o8 = (u32x2*)(dst + (size_t)m * D) + c.lane;
        float am = 0.f;
#pragma unroll
        for (int j = 0; j < 4; ++j) {
            const int col = 4 * c.lane + 256 * j;
            const f32x4 gg = *(const f32x4*)(g + col), sc = *(const f32x4*)(mod + b * 6144 + scale_off + col), sh = *(const f32x4*)(mod + b * 6144 + shift_off + col);
            const float r0 = v[j].x * rstd * gg.x * (1.f + sc.x) + sh.x, r1 = v[j].y * rstd * gg.y * (1.f + sc.y) + sh.y;
            const float r2 = v[j].z * rstd * gg.z * (1.f + sc.z) + sh.z, r3 = v[j].w * rstd * gg.w * (1.f + sc.w) + sh.w;
            u32x2 w; w.x = pk2(r0, r1); w.y = pk2(r2, r3); o8[64 * j] = w;
            if (Q8) { v[j].x = r0; v[j].y = r1; v[j].z = r2; v[j].w = r3; am = fmaxf(am, fmaxf(fmaxf(fabsf(r0), fabsf(r1)), fmaxf(fabsf(r2), fabsf(r3)))); }
        }
        if (Q8) {
#pragma unroll
            for (int o = 1; o < 64; o <<= 1) am = fmaxf(am, __shfl_xor(am, o));
            const float sq = am > 0.f ? am * (1.f / 256.f) : 1.f, inv = 1.f / sq;
            unsigned* q8 = (unsigned*)(c.ws + WS_H2Q + (size_t)m * D) + c.lane;
#pragma unroll
            for (int j = 0; j < 4; ++j) { int w = __builtin_amdgcn_cvt_pk_fp8_f32(v[j].x * inv, v[j].y * inv, 0, false); w = __builtin_amdgcn_cvt_pk_fp8_f32(v[j].z * inv, v[j].w * inv, w, true); q8[64 * j] = (unsigned)w; }
            if (c.lane == 0) WSP(float, WS_SH)[m] = sq;
        }
    }
}

__device__ __forceinline__ void phase_conv(const Ctx& c) {
    const bf16_t* pa = WSP(bf16_t, WS_R1); const bf16_t* lx = WSP(bf16_t, WS_R2); bf16_t* xc = WSP(bf16_t, WS_R4); float* rstd = WSP(float, WS_RSTD);
    const float* cw = c.in[I_CONVW]; const float* cb = c.in[I_CONVB];
    const int gt = c.vcu * 512 + c.tid, NT = c.G * 512;
    for (int t = gt; t < T; t += NT) {
        const u32x4* p = (const u32x4*)(pa + (size_t)t * 512);
        float sq = 0.f, skv = 0.f;
        for (int i = 0; i < 32; ++i) { float v[8]; unpack8(p[i], v);
#pragma unroll
            for (int j = 0; j < 8; ++j) sq += v[j] * v[j]; }
        for (int i = 32; i < 48; ++i) { float v[8]; unpack8(p[i], v);
#pragma unroll
            for (int j = 0; j < 8; ++j) skv += v[j] * v[j]; }
        rstd[2 * t] = rsqrtf(sq * (1.f / 256.f) + EPS); rstd[2 * t + 1] = rsqrtf(skv * (1.f / 128.f) + EPS);
    }
    for (int e = gt; e < T * 128; e += NT) {
        const int t = e >> 7, ch = (e & 127) * 8, s = t & 2047;
        float acc[8];
        { const f32x4 b0 = *(const f32x4*)(cb + ch), b1 = *(const f32x4*)(cb + ch + 4); acc[0] = b0.x; acc[1] = b0.y; acc[2] = b0.z; acc[3] = b0.w; acc[4] = b1.x; acc[5] = b1.y; acc[6] = b1.z; acc[7] = b1.w; }
#pragma unroll
        for (int j = 0; j < 4; ++j) {
            if (s - 3 + j >= 0) {
                float v[8]; unpack8(*(const u32x4*)(lx + (size_t)(t - 3 + j) * 1024 + ch), v);
                const f32x4 w0 = *(const f32x4*)(cw + j * 1024 + ch), w1 = *(const f32x4*)(cw + j * 1024 + ch + 4);
                acc[0] += w0.x * v[0]; acc[1] += w0.y * v[1]; acc[2] += w0.z * v[2]; acc[3] += w0.w * v[3];
                acc[4] += w1.x * v[4]; acc[5] += w1.y * v[5]; acc[6] += w1.z * v[6]; acc[7] += w1.w * v[7];
            }
        }
        *(u32x4*)(xc + (size_t)t * 1024 + ch) = pack8(acc);
    }
}

__device__ __forceinline__ void phase_scan(const Ctx& c) {
    const bf16_t* LA = WSP(bf16_t, WS_R0); bf16_t* Bv = WSP(bf16_t, WS_R6); const bf16_t* gate = WSP(bf16_t, WS_R3);
    LAS float* Ps = (LAS float*)c.lds; LAS float* Hs = Ps + 512;
    for (int it = c.vcu; it < 256; it += c.G) {
        const int b = it >> 4, cg = it & 15, seg = c.tid >> 6, ch = cg * 64 + (c.tid & 63);
        const size_t base = ((size_t)b * 2048 + seg * 256) * 1024 + ch;
        float P = 1.f, Hl = 0.f;
#pragma unroll 8
        for (int i = 0; i < 256; ++i) { const float a = exp2f(bf2f(LA[base + (size_t)i * 1024])); const float bb = bf2f(Bv[base + (size_t)i * 1024]); Hl = a * Hl + bb; P *= a; }
        Ps[c.tid] = P; Hs[c.tid] = Hl;
        __syncthreads();
        float h = 0.f;
        for (int s2 = 0; s2 < seg; ++s2) h = Ps[s2 * 64 + (c.tid & 63)] * h + Hs[s2 * 64 + (c.tid & 63)];
#pragma unroll 8
        for (int i = 0; i < 256; ++i) { const float a = exp2f(bf2f(LA[base + (size_t)i * 1024])); const float bb = bf2f(Bv[base + (size_t)i * 1024]); h = a * h + bb;
            const float gv = bf2f(gate[base + (size_t)i * 1024]); Bv[base + (size_t)i * 1024] = (bf16_t)f2bf(h * gelu_tanh(gv)); }
        __syncthreads();
    }
}

__device__ __forceinline__ void phase_qkv_layout(const Ctx& c) {
    const bf16_t* qraw = WSP(bf16_t, WS_R5); const bf16_t* kvraw = WSP(bf16_t, WS_R2); const bf16_t* pa = WSP(bf16_t, WS_R1);
    bf16_t* Qh = WSP(bf16_t, WS_R4); bf16_t* Kh = WSP(bf16_t, WS_R3); bf16_t* Vh = WSP(bf16_t, WS_R0);
    const float* qng = c.in[I_QNG]; const float* kng = c.in[I_KNG]; const int* pos = (const int*)c.in[I_POS];
    const float qscale = 0.10206207261596577f * 1.4426950408889634f;
    const int gt = c.vcu * 512 + c.tid, NT = c.G * 512;
    for (int e = gt; e < T * H; e += NT) {
        const int t = e >> 3, h = e & 7, b = t >> 11, s = t & 2047;
        const float pf = (float)pos[t];
        const size_t orow = ((size_t)(b * H + h) * S + s);
        {
            const u32x4* p = (const u32x4*)(qraw + (size_t)t * 768 + h * 96);
            float ss = 0.f;
            for (int i = 0; i < 12; ++i) { float v[8]; unpack8(p[i], v);
#pragma unroll
                for (int j = 0; j < 8; ++j) ss += v[j] * v[j]; }
            const float r = rsqrtf(ss * (1.f / 96.f) + EPS) * qscale;
            u32x4* o = (u32x4*)(Qh + orow * 96);
            for (int i = 0; i < 8; ++i) { float v[8]; unpack8(p[i], v);
#pragma unroll
                for (int j = 0; j < 8; ++j) v[j] = v[j] * r * qng[i * 8 + j];
                o[i] = pack8(v); }
            for (int i = 0; i < 2; ++i) { float v1[8], v2[8], o1[8], o2[8]; unpack8(p[8 + i], v1); unpack8(p[10 + i], v2);
#pragma unroll
                for (int j = 0; j < 8; ++j) { const int jj = i * 8 + j;
                    const float invf = exp2f(-(float)jj * (13.287712379549449f / 16.f));
                    const float ang = pf * invf; const float n = rintf(ang * 0.15915494309189535f);
                    const float red = (float)((double)ang - (double)n * 6.283185307179586);
                    const float cs = __cosf(red), sn = __sinf(red);
                    const float t1 = v1[j] * r * qng[64 + jj], t2 = v2[j] * r * qng[80 + jj];
                    o1[j] = t1 * cs - t2 * sn; o2[j] = t1 * sn + t2 * cs; }
                o[8 + i] = pack8(o1); o[10 + i] = pack8(o2); }
        }
        {
            const u32x4* pn = (const u32x4*)(kvraw + (size_t)t * 1024 + h * 128);
            const u32x4* pr = (const u32x4*)(pa + (size_t)t * 512 + 384);
            float ss = 0.f;
            for (int i = 0; i < 8; ++i) { float v[8]; unpack8(pn[i], v);
#pragma unroll
                for (int j = 0; j < 8; ++j) ss += v[j] * v[j]; }
            for (int i = 0; i < 4; ++i) { float v[8]; unpack8(pr[i], v);
#pragma unroll
                for (int j = 0; j < 8; ++j) ss += v[j] * v[j]; }
            const float r = rsqrtf(ss * (1.f / 96.f) + EPS);
            u32x4* o = (u32x4*)(Kh + orow * 96);
            for (int i = 0; i < 8; ++i) { float v[8]; unpack8(pn[i], v);
#pragma unroll
                for (int j = 0; j < 8; ++j) v[j] = v[j] * r * kng[i * 8 + j];
                o[i] = pack8(v); }
            for (int i = 0; i < 2; ++i) { float v1[8], v2[8], o1[8], o2[8]; unpack8(pr[i], v1); unpack8(pr[2 + i], v2);
#pragma unroll
                for (int j = 0; j < 8; ++j) { const int jj = i * 8 + j;
                    const float invf = exp2f(-(float)jj * (13.287712379549449f / 16.f));
                    const float ang = pf * invf; const float n = rintf(ang * 0.15915494309189535f);
                    const float red = (float)((double)ang - (double)n * 6.283185307179586);
                    const float cs = __cosf(red), sn = __sinf(red);
                    const float t1 = v1[j] * r * kng[64 + jj], t2 = v2[j] * r * kng[80 + jj];
                    o1[j] = t1 * cs - t2 * sn; o2[j] = t1 * sn + t2 * cs; }
                o[8 + i] = pack8(o1); o[10 + i] = pack8(o2); }
            u32x4* ov = (u32x4*)(Vh + orow * 64);
            for (int i = 0; i < 8; ++i) ov[i] = pn[8 + i];
        }
    }
}

constexpr int KROW = 208, VTROW = 144;
constexpr int KBUF = 64 * KROW, VBUF = 64 * VTROW;
__device__ __forceinline__ void attn_unit(const Ctx& c, int b, int h, int qb) {
    const bf16_t* Qh = WSP(bf16_t, WS_R4); const bf16_t* Kh = WSP(bf16_t, WS_R3); const bf16_t* Vh = WSP(bf16_t, WS_R0); bf16_t* AO = WSP(bf16_t, WS_R0 + 32 * MiB);
    const int fr = c.lane & 15, g = c.lane >> 4, wid = c.wave;
    const size_t hb = (size_t)(b * H + h) * S;
    const int q0 = qb * 128 + wid * 16;
    const int nblk = 2 * qb + 2, nmine = 2 * qb + 1 + (wid >> 2);
    bf16x8 qf[3];
#pragma unroll
    for (int ks = 0; ks < 3; ++ks) qf[ks] = *(const bf16x8*)(Qh + (hb + q0 + fr) * 96 + ks * 32 + g * 8);
    f32x4 o[4];
#pragma unroll
    for (int dt = 0; dt < 4; ++dt) o[dt] = (f32x4){0.f, 0.f, 0.f, 0.f};
    float mrun = -1e30f, lrun = 0.f;
    u32x4 kr0, kr1, vr;
    const int kc0 = c.tid, kc1 = c.tid + 512;
    const u32x4* Ksrc = (const u32x4*)(Kh + hb * 96); const u32x4* Vsrc = (const u32x4*)(Vh + hb * 64);
    kr0 = Ksrc[kc0]; kr1 = (kc1 < 768) ? Ksrc[kc1] : (u32x4){0, 0, 0, 0}; vr = Vsrc[c.tid];
    for (int j = 0; j < nblk; ++j) {
        LAS unsigned char* kb = c.lds + (j & 1) * (KBUF + VBUF); LAS unsigned char* vb = kb + KBUF;
        *(LAS u32x4*)(kb + (kc0 / 12) * KROW + (kc0 % 12) * 16) = kr0;
        if (kc1 < 768) *(LAS u32x4*)(kb + (kc1 / 12) * KROW + (kc1 % 12) * 16) = kr1;
        { const int key = c.tid >> 3, d0 = (c.tid & 7) * 8;
          const int kk = key & 31, slot = (key & 32) + 8 * ((kk >> 2) & 3) + 4 * (kk >> 4) + (kk & 3);
          const unsigned w[4] = {vr.x, vr.y, vr.z, vr.w};
#pragma unroll
          for (int i = 0; i < 4; ++i) { *(LAS bf16_t*)(vb + (d0 + 2 * i) * VTROW + slot * 2) = (bf16_t)(w[i] & 0xffffu); *(LAS bf16_t*)(vb + (d0 + 2 * i + 1) * VTROW + slot * 2) = (bf16_t)(w[i] >> 16); } }
        __syncthreads();
        if (j + 1 < nblk) { kr0 = Ksrc[(j + 1) * 768 + kc0]; if (kc1 < 768) kr1 = Ksrc[(j + 1) * 768 + kc1]; vr = Vsrc[(j + 1) * 512 + c.tid]; }
        if (j < nmine) {
            f32x4 sacc[4];
#pragma unroll
            for (int kt = 0; kt < 4; ++kt) { sacc[kt] = (f32x4){0.f, 0.f, 0.f, 0.f};
#pragma unroll
                for (int ks = 0; ks < 3; ++ks) { const bf16x8 kf = *(const LAS bf16x8*)(kb + (16 * kt + fr) * KROW + (ks * 32 + g * 8) * 2);
                    sacc[kt] = __builtin_amdgcn_mfma_f32_16x16x32_bf16(kf, qf[ks], sacc[kt], 0, 0, 0); } }
            float mx = sacc[0][0];
#pragma unroll
            for (int kt = 0; kt < 4; ++kt)
#pragma unroll
                for (int r = 0; r < 4; ++r) mx = fmaxf(mx, sacc[kt][r]);
            mx = fmaxf(mx, __shfl_xor(mx, 16)); mx = fmaxf(mx, __shfl_xor(mx, 32));
            const float mnew = fmaxf(mrun, mx), alpha = exp2f(mrun - mnew); mrun = mnew;
            float ps = 0.f;
#pragma unroll
            for (int kt = 0; kt < 4; ++kt)
#pragma unroll
                for (int r = 0; r < 4; ++r) { const float p = exp2f(sacc[kt][r] - mnew); sacc[kt][r] = p; ps += p; }
            lrun = lrun * alpha + ps;
#pragma unroll
            for (int dt = 0; dt < 4; ++dt) o[dt] = o[dt] * alpha;
#pragma unroll
            for (int s2 = 0; s2 < 2; ++s2) {
                u32x4 pw; pw.x = pk2(sacc[2 * s2][0], sacc[2 * s2][1]); pw.y = pk2(sacc[2 * s2][2], sacc[2 * s2][3]); pw.z = pk2(sacc[2 * s2 + 1][0], sacc[2 * s2 + 1][1]); pw.w = pk2(sacc[2 * s2 + 1][2], sacc[2 * s2 + 1][3]);
                const bf16x8 pb = __builtin_bit_cast(bf16x8, pw);
#pragma unroll
                for (int dt = 0; dt < 4; ++dt) { const bf16x8 vf = *(const LAS bf16x8*)(vb + (16 * dt + fr) * VTROW + (32 * s2 + 8 * g) * 2);
                    o[dt] = __builtin_amdgcn_mfma_f32_16x16x32_bf16(vf, pb, o[dt], 0, 0, 0); }
            }
        }
    }
    float lt = lrun + __shfl_xor(lrun, 16); lt += __shfl_xor(lt, 32);
    const float inv = 1.f / lt;
    bf16_t* orow = AO + ((size_t)b * S + q0 + fr) * 512 + h * 64;
#pragma unroll
    for (int dt = 0; dt < 4; ++dt) { u32x2 w; w.x = pk2(o[dt][0] * inv, o[dt][1] * inv); w.y = pk2(o[dt][2] * inv, o[dt][3] * inv); *(u32x2*)(orow + 16 * dt + 4 * g) = w; }
    __syncthreads();
}
__device__ __forceinline__ void phase_attn(const Ctx& c) {
    for (int v = c.vcu; v < 256; v += c.G) {
        const int bh = v >> 1, odd = v & 1;
        for (int i = 0; i < 8; ++i) {
            const int setA[8] = {15, 12, 10, 9, 6, 5, 3, 0}, setB[8] = {14, 13, 11, 8, 7, 4, 2, 1};
            int qb = 0;
#pragma unroll
            for (int k = 0; k < 8; ++k) if (k == i) qb = odd ? setB[k] : setA[k];
            attn_unit(c, bh >> 3, bh & 7, qb);
        }
    }
}

__device__ __forceinline__ float wave_max(float v) {
#pragma unroll
    for (int o = 1; o < 64; o <<= 1) v = fmaxf(v, __shfl_xor(v, o));
    return v;
}
__device__ __forceinline__ int wave_min_i(int v) {
#pragma unroll
    for (int o = 1; o < 64; o <<= 1) v = min(v, __shfl_xor(v, o));
    return v;
}
__device__ __forceinline__ int prefix_cnt(unsigned long long m) { return (int)__builtin_amdgcn_mbcnt_hi((unsigned)(m >> 32), __builtin_amdgcn_mbcnt_lo((unsigned)m, 0u)); }
template <int NV, int NBITS> __device__ __forceinline__ void select16(const unsigned (&key)[NV], int (&slot)[NV]) {
    unsigned tau = 0u;
    for (int bit = NBITS - 1; bit >= 0; --bit) {
        const unsigned trial = tau | (1u << bit); int cnt = 0;
#pragma unroll
        for (int j = 0; j < NV; ++j) cnt += __popcll(__ballot(key[j] >= trial));
        if (cnt >= 16) { tau = trial; if (cnt == 16) break; }
    }
    int base = 0;
#pragma unroll
    for (int j = 0; j < NV; ++j) { const unsigned long long m = __ballot(key[j] > tau); slot[j] = (key[j] > tau) ? base + prefix_cnt(m) : -1; base += __popcll(m); }
#pragma unroll
    for (int j = 0; j < NV; ++j) { const unsigned long long m = __ballot(key[j] == tau); if (key[j] == tau) { const int s = base + prefix_cnt(m); slot[j] = s < 16 ? s : -1; } base += __popcll(m); }
}
template <int N> __device__ __forceinline__ void bitonic_stage_desc(unsigned (&x)[N], int k, int j) {
#pragma unroll
    for (int i = 0; i < N; ++i) { const int l = i ^ j; if (l > i) { const bool asc = ((i & k) != 0);
        const unsigned a = x[i], b = x[l]; const unsigned hi = a > b ? a : b, lo = a > b ? b : a; x[i] = asc ? lo : hi; x[l] = asc ? hi : lo; } }
}
__device__ __forceinline__ void sort16_desc(unsigned (&x)[16]) {
#pragma unroll
    for (int k = 2; k <= 16; k <<= 1)
#pragma unroll
        for (int j = k >> 1; j > 0; j >>= 1) bitonic_stage_desc<16>(x, k, j);
}
__device__ __forceinline__ void merge16_desc(unsigned (&run)[16], const unsigned (&ch)[16]) {
#pragma unroll
    for (int i = 0; i < 16; ++i) run[i] = run[i] > ch[15 - i] ? run[i] : ch[15 - i];
#pragma unroll
    for (int j = 8; j > 0; j >>= 1) bitonic_stage_desc<16>(run, 16, j);
}
__device__ __forceinline__ unsigned mono_hi(unsigned w) { return w ^ ((unsigned)((int)w >> 31) | 0x80000000u); }
__device__ __forceinline__ float demono_hi(unsigned k) { const unsigned kk = k & 0xffff0000u; return __builtin_bit_cast(float, (kk ^ ((unsigned)(~(int)kk >> 31) | 0x80000000u)) & 0xffff0000u); }
__device__ __forceinline__ void top16_list(const bf16_t* s, unsigned (&run)[16]) {
#pragma unroll
    for (int ck = 0; ck < 8; ++ck) {
        const u32x4 w0 = *(const u32x4*)(s + ck * 16), w1 = *(const u32x4*)(s + ck * 16 + 8);
        const unsigned w[8] = {w0.x, w0.y, w0.z, w0.w, w1.x, w1.y, w1.z, w1.w};
        unsigned ch[16];
#pragma unroll
        for (int i = 0; i < 8; ++i) { ch[2 * i] = (mono_hi(w[i] << 16) & 0xffff0000u) | (unsigned)(ck * 16 + 2 * i); ch[2 * i + 1] = (mono_hi(w[i]) & 0xffff0000u) | (unsigned)(ck * 16 + 2 * i + 1); }
        sort16_desc(ch);
        if (ck == 0) {
#pragma unroll
            for (int i = 0; i < 16; ++i) run[i] = ch[i];
        } else merge16_desc(run, ch);
    }
}
__device__ __forceinline__ void phase_topk(const Ctx& c) {
    const bf16_t* sc = WSP(bf16_t, WS_SC); int* IDX = WSP(int, WS_IDX); float* GW = WSP(float, WS_GW);
    const int gl = (c.vcu * 8 + c.wave) * 64 + c.lane, NL = c.G * 512;
    for (int e = gl; e < T * H; e += NL) {
        unsigned ka[16], kb[16];
        top16_list(sc + (size_t)e * 256, ka);
        top16_list(sc + (size_t)e * 256 + 128, kb);
        float sa[16], sb[16]; unsigned ia[16], ib[16];
#pragma unroll
        for (int i = 0; i < 16; ++i) { sa[i] = demono_hi(ka[i]); sb[i] = demono_hi(kb[i]); ia[i] = (ka[i] & 0x7fu) << 7; ib[i] = kb[i] & 0x7fu; }
        const float mx = sa[0] + sb[0];
        unsigned run[16], ch[16]; int n = 0, nc = 0;
#pragma unroll
        for (int a = 0; a < 16; ++a)
#pragma unroll
            for (int b = 0; b < 16; ++b) if ((a + 1) * (b + 1) <= 16) {
                const int k = 65535 + (int)((sa[a] + sb[b] - mx) * 1024.f);
                ch[n] = ((unsigned)(k < 0 ? 0 : k) << 16) | ia[a] | ib[b];
                if (++n == 16) { sort16_desc(ch); if (nc == 0) {
#pragma unroll
                        for (int i = 0; i < 16; ++i) run[i] = ch[i]; } else merge16_desc(run, ch);
                    n = 0; ++nc; }
            }
#pragma unroll
        for (int i = 2; i < 16; ++i) ch[i] = 0u;
        sort16_desc(ch); merge16_desc(run, ch);
        float ex[16]; float sum = 0.f;
#pragma unroll
        for (int i = 0; i < 16; ++i) { ex[i] = __expf((float)((int)(run[i] >> 16) - 65535) * (1.f / 1024.f)); sum += ex[i]; }
        const float inv = 1.f / sum;
        u32x4* oi = (u32x4*)(IDX + (size_t)e * 16); f32x4* og = (f32x4*)(GW + (size_t)e * 16);
#pragma unroll
        for (int q = 0; q < 4; ++q) { u32x4 vi; vi.x = run[4 * q] & 0x3fffu; vi.y = run[4 * q + 1] & 0x3fffu; vi.z = run[4 * q + 2] & 0x3fffu; vi.w = run[4 * q + 3] & 0x3fffu; oi[q] = vi;
            f32x4 vg; vg.x = ex[4 * q] * inv; vg.y = ex[4 * q + 1] * inv; vg.z = ex[4 * q + 2] * inv; vg.w = ex[4 * q + 3] * inv; og[q] = vg; }
    }
}

__device__ __forceinline__ void dec16_fp8(const u32x4 r, float (&f)[16]) {
    const unsigned w[4] = {r.x, r.y, r.z, r.w};
#pragma unroll
    for (int i = 0; i < 4; ++i) { const f32x2 lo = __builtin_amdgcn_cvt_pk_f32_fp8((int)w[i], false), hi = __builtin_amdgcn_cvt_pk_f32_fp8((int)w[i], true);
        f[4 * i] = lo.x; f[4 * i + 1] = lo.y; f[4 * i + 2] = hi.x; f[4 * i + 3] = hi.y; }
}
__device__ __forceinline__ void phase_peer_u(const Ctx& c) {
    const int* IDX = WSP(int, WS_IDX);
    const int L = c.lane, p = blockIdx.x & 7, rank = blockIdx.x >> 3, nrank = (c.G + 7 - p) >> 3;
    const int np = c.G < 8 ? c.G : 8;
    LAS int* mb = (LAS int*)(c.lds + c.wave * 1024);
    const int r16 = L & 15, g4 = L >> 4;
    for (int pp = p; pp < 8; pp += np) {
        const unsigned char* EU8 = c.ws + WS_EU + (size_t)pp * NE * 128 + g4 * 32;
        const unsigned char* H8 = c.ws + WS_H2Q + pp * 128 + g4 * 32;
        float* PD = WSP(float, WS_PD) + (size_t)pp * T * 128;
        const int t0 = rank * 8 + c.wave, ts = nrank * 8;
        if (t0 >= T) continue;
        { const int g0 = IDX[(size_t)t0 * 128 + L], g1 = IDX[(size_t)t0 * 128 + 64 + L]; mb[L] = g0; mb[64 + L] = g1; }
        u32x4 rA[8], rB[8];
#pragma unroll
        for (int G = 0; G < 4; ++G) { const u32x4* rp = (const u32x4*)(EU8 + (size_t)mb[16 * G + r16] * 128); rA[2 * G] = rp[0]; rA[2 * G + 1] = rp[1]; }
        int cur = 0;
        for (int t = t0; t < T; t += ts) {
            const int tn = (t + ts < T) ? t + ts : t;
            const int gn0 = IDX[(size_t)tn * 128 + L], gn1 = IDX[(size_t)tn * 128 + 64 + L];
            const u32x4 hq0 = *(const u32x4*)(H8 + (size_t)t * 1024), hq1 = *(const u32x4*)(H8 + (size_t)t * 1024 + 16);
            const long hb[4] = { (long)(((unsigned long long)hq0.y << 32) | hq0.x), (long)(((unsigned long long)hq0.w << 32) | hq0.z), (long)(((unsigned long long)hq1.y << 32) | hq1.x), (long)(((unsigned long long)hq1.w << 32) | hq1.z) };
#pragma unroll
            for (int G = 0; G < 4; ++G) { const u32x4* rp = (const u32x4*)(EU8 + (size_t)mb[cur * 128 + 64 + 16 * G + r16] * 128); rB[2 * G] = rp[0]; rB[2 * G + 1] = rp[1]; }
            f32x4 acc[8];
#pragma unroll
            for (int G = 0; G < 4; ++G) { const u32x4 lo = rA[2 * G], hi = rA[2 * G + 1]; f32x4 a = (f32x4){0.f, 0.f, 0.f, 0.f};
                a = __builtin_amdgcn_mfma_f32_16x16x32_fp8_fp8((long)(((unsigned long long)lo.y << 32) | lo.x), hb[0], a, 0, 0, 0);
                a = __builtin_amdgcn_mfma_f32_16x16x32_fp8_fp8((long)(((unsigned long long)lo.w << 32) | lo.z), hb[1], a, 0, 0, 0);
                a = __builtin_amdgcn_mfma_f32_16x16x32_fp8_fp8((long)(((unsigned long long)hi.y << 32) | hi.x), hb[2], a, 0, 0, 0);
                a = __builtin_amdgcn_mfma_f32_16x16x32_fp8_fp8((long)(((unsigned long long)hi.w << 32) | hi.z), hb[3], a, 0, 0, 0);
                acc[G] = a; }
            mb[(cur ^ 1) * 128 + L] = gn0; mb[(cur ^ 1) * 128 + 64 + L] = gn1;
#pragma unroll
            for (int G = 0; G < 4; ++G) { const u32x4* rp = (const u32x4*)(EU8 + (size_t)mb[(cur ^ 1) * 128 + 16 * G + r16] * 128); rA[2 * G] = rp[0]; rA[2 * G + 1] = rp[1]; }
#pragma unroll
            for (int G = 0; G < 4; ++G) { const u32x4 lo = rB[2 * G], hi = rB[2 * G + 1]; f32x4 a = (f32x4){0.f, 0.f, 0.f, 0.f};
                a = __builtin_amdgcn_mfma_f32_16x16x32_fp8_fp8((long)(((unsigned long long)lo.y << 32) | lo.x), hb[0], a, 0, 0, 0);
                a = __builtin_amdgcn_mfma_f32_16x16x32_fp8_fp8((long)(((unsigned long long)lo.w << 32) | lo.z), hb[1], a, 0, 0, 0);
                a = __builtin_amdgcn_mfma_f32_16x16x32_fp8_fp8((long)(((unsigned long long)hi.y << 32) | hi.x), hb[2], a, 0, 0, 0);
                a = __builtin_amdgcn_mfma_f32_16x16x32_fp8_fp8((long)(((unsigned long long)hi.w << 32) | hi.z), hb[3], a, 0, 0, 0);
                acc[4 + G] = a; }
            f32x4 o = acc[0];
#pragma unroll
            for (int G = 1; G < 8; ++G) if (r16 == G) o = acc[G];
            if (r16 < 8) *(f32x4*)(PD + (size_t)t * 128 + 16 * r16 + 4 * g4) = o;
            cur ^= 1;
        }
    }
}
__device__ __forceinline__ void phase_peer_fin(const Ctx& c) {
    const int* IDX = WSP(int, WS_IDX); const float* GW = WSP(float, WS_GW); const float* PD = WSP(float, WS_PD); unsigned* WGT = WSP(unsigned, WS_WGT);
    const float* SU = WSP(float, WS_SU); const float* SV = WSP(float, WS_SV); const float* SH = WSP(float, WS_SH);
    for (int i = c.vcu * 512 + c.tid; i < T * 128; i += c.G * 512) {
        float d = 0.f;
#pragma unroll
        for (int p = 0; p < 8; ++p) d += PD[(size_t)p * T * 128 + i];
        const int e = IDX[i];
        WGT[i] = (f2bf(GW[i] * gelu_tanh(d * SU[e] * SH[i >> 7]) * SV[e]) << 16) | (unsigned)e;
    }
}
template <bool DRY> __device__ __forceinline__ void phase_peer_v(const Ctx& c) {
    const unsigned* WI = WSP(unsigned, WS_WGT); const float* mod = WSP(float, WS_MOD);
    const int L = c.lane, p = blockIdx.x & 7, rank = blockIdx.x >> 3, nrank = (c.G + 7 - p) >> 3;
    const int np = c.G < 8 ? c.G : 8;
    const bool b5 = L & 32, b4 = L & 16, b3 = L & 8;
    LAS unsigned* mb = (LAS unsigned*)(c.lds + c.wave * 1024);
    const int kl = L >> 3;
    for (int pp = p; pp < 8; pp += np) {
        const unsigned char* EV8 = c.ws + WS_EV + (size_t)pp * NE * 128 + (L & 7) * 16;
        const int col = pp * 128 + (L & 7) * 16 + (b5 ? 8 : 0) + (b4 ? 4 : 0) + (b3 ? 2 : 0);
        const int t0 = rank * 8 + c.wave, ts = nrank * 8;
        if (t0 >= T) continue;
        { const unsigned g0 = WI[(size_t)t0 * 128 + L], g1 = WI[(size_t)t0 * 128 + 64 + L]; mb[L] = g0; mb[64 + L] = g1; }
        u32x4 rA[8], rB[8];
#pragma unroll
        for (int i = 0; i < 8; ++i) rA[i] = *(const u32x4*)(EV8 + (size_t)(mb[8 * i + kl] & 0xffffu) * 128);
        int cur = 0;
        for (int t = t0; t < T; t += ts) {
            const int tn = (t + ts < T) ? t + ts : t;
            const unsigned gn0 = WI[(size_t)tn * 128 + L], gn1 = WI[(size_t)tn * 128 + 64 + L];
            float* o = c.out + (size_t)t * 1024 + col; const float* g2 = mod + (t >> 11) * 6144 + 5120 + col;
            f32x2 xo = *(const f32x2*)o; const f32x2 gt = *(const f32x2*)g2;
#pragma unroll
            for (int i = 0; i < 8; ++i) rB[i] = *(const u32x4*)(EV8 + (size_t)(mb[cur * 128 + 64 + 8 * i + kl] & 0xffffu) * 128);
            f32x2 ac2[8];
#pragma unroll
            for (int j = 0; j < 8; ++j) ac2[j] = (f32x2){0.f, 0.f};
#pragma unroll
            for (int i = 0; i < 8; ++i) { const float w = bfhi(mb[cur * 128 + 8 * i + kl]); const f32x2 w2 = {w, w}; const unsigned ww[4] = {rA[i].x, rA[i].y, rA[i].z, rA[i].w};
#pragma unroll
                for (int d = 0; d < 4; ++d) { ac2[2 * d] = ac2[2 * d] + __builtin_amdgcn_cvt_pk_f32_fp8((int)ww[d], false) * w2; ac2[2 * d + 1] = ac2[2 * d + 1] + __builtin_amdgcn_cvt_pk_f32_fp8((int)ww[d], true) * w2; }
                }
            mb[(cur ^ 1) * 128 + L] = gn0; mb[(cur ^ 1) * 128 + 64 + L] = gn1;
#pragma unroll
            for (int i = 0; i < 8; ++i) rA[i] = *(const u32x4*)(EV8 + (size_t)(mb[(cur ^ 1) * 128 + 8 * i + kl] & 0xffffu) * 128);
#pragma unroll
            for (int i = 0; i < 8; ++i) { const float w = bfhi(mb[cur * 128 + 64 + 8 * i + kl]); const f32x2 w2 = {w, w}; const unsigned ww[4] = {rB[i].x, rB[i].y, rB[i].z, rB[i].w};
#pragma unroll
                for (int d = 0; d < 4; ++d) { ac2[2 * d] = ac2[2 * d] + __builtin_amdgcn_cvt_pk_f32_fp8((int)ww[d], false) * w2; ac2[2 * d + 1] = ac2[2 * d + 1] + __builtin_amdgcn_cvt_pk_f32_fp8((int)ww[d], true) * w2; }
                }
            float acc[16];
#pragma unroll
            for (int j = 0; j < 8; ++j) { acc[2 * j] = ac2[j].x; acc[2 * j + 1] = ac2[j].y; }
            float n8[8], n4[4], n2[2];
#pragma unroll
            for (int i = 0; i < 8; ++i) { const float send = b5 ? acc[i] : acc[i + 8], keep = b5 ? acc[i + 8] : acc[i]; n8[i] = keep + __shfl_xor(send, 32); }
#pragma unroll
            for (int i = 0; i < 4; ++i) { const float send = b4 ? n8[i] : n8[i + 4], keep = b4 ? n8[i + 4] : n8[i]; n4[i] = keep + __shfl_xor(send, 16); }
#pragma unroll
            for (int i = 0; i < 2; ++i) { const float send = b3 ? n4[i] : n4[i + 2], keep = b3 ? n4[i + 2] : n4[i]; n2[i] = keep + __shfl_xor(send, 8); }
            xo.x += gt.x * n2[0]; xo.y += gt.y * n2[1];
            if (DRY) asm volatile("" :: "v"(xo.x), "v"(xo.y)); else *(f32x2*)o = xo;
            cur ^= 1;
        }
    }
}

struct FInProj { bf16_t *pa, *lx, *lg, *mg;
    __device__ __forceinline__ void operator()(int row, int pn, int cc, const float (&v0)[8], const float (&v1)[8]) const {
        bf16_t* d;
        if (pn < 2) d = pa + (size_t)row * 512 + pn * 256 + cc; else if (pn < 6) d = lx + (size_t)row * 1024 + (pn - 2) * 256 + cc;
        else if (pn < 10) d = lg + (size_t)row * 1024 + (pn - 6) * 256 + cc; else d = mg + (size_t)row * 2048 + (pn - 10) * 256 + cc;
        *(u32x4*)d = pack8(v0); *(u32x4*)(d + 128) = pack8(v1); } };
struct FRowScale { bf16_t* dst; int ldc; const float* rstd; int which;
    __device__ __forceinline__ void operator()(int row, int pn, int cc, const float (&v0)[8], const float (&v1)[8]) const {
        const float r = rstd[2 * row + which]; float a[8], b[8];
#pragma unroll
        for (int j = 0; j < 8; ++j) { a[j] = v0[j] * r; b[j] = v1[j] * r; }
        *(u32x4*)(dst + (size_t)row * ldc + pn * 256 + cc) = pack8(a); *(u32x4*)(dst + (size_t)row * ldc + pn * 256 + 128 + cc) = pack8(b); } };
struct FGates { const bf16_t* xc; bf16_t *LA, *Bv; const float *brg, *big, *c8sp;
    __device__ __forceinline__ void operator()(int row, int pn, int cc, const float (&v0)[8], const float (&v1)[8]) const {
        const int ch = pn * 128 + cc; float x[8], la[8], bv[8]; unpack8(*(const u32x4*)(xc + (size_t)row * 1024 + ch), x);
#pragma unroll
        for (int j = 0; j < 8; ++j) {
            const float r = __builtin_amdgcn_rcpf(1.f + __expf(-(v0[j] + brg[ch + j]))), ig = __builtin_amdgcn_rcpf(1.f + __expf(-(v1[j] + big[ch + j])));
            const float loga = r * c8sp[ch + j];
            const float z = 2.f * loga;
            const float ser = -z * (1.f + z * (0.5f + z * (0.16666667f + z * (0.041666668f + z * (0.008333334f + z * 0.0013888889f)))));
            const float om = (z > -0.25f) ? ser : (1.f - __expf(z));
            la[j] = loga * 1.4426950408889634f;
            bv[j] = sqrtf(om) * (ig * x[j]);
        }
        *(u32x4*)(LA + (size_t)row * 1024 + ch) = pack8(la); *(u32x4*)(Bv + (size_t)row * 1024 + ch) = pack8(bv); } };
struct FY1 { const bf16_t* mg; bf16_t* y; int goff; bool accum;
    __device__ __forceinline__ void one(int row, int col, const float (&v)[8]) const {
        float gt[8], o[8]; unpack8(*(const u32x4*)(mg + (size_t)row * 2048 + goff + col), gt);
        if (accum) unpack8(*(const u32x4*)(y + (size_t)row * 1024 + col), o);
#pragma unroll
        for (int j = 0; j < 8; ++j) o[j] = (accum ? o[j] : 0.f) + sigmoidf_(gt[j]) * v[j];
        *(u32x4*)(y + (size_t)row * 1024 + col) = pack8(o); }
    __device__ __forceinline__ void operator()(int row, int pn, int cc, const float (&v0)[8], const float (&v1)[8]) const { one(row, pn * 256 + cc, v0); one(row, pn * 256 + 128 + cc, v1); } };
struct FX1 { const float* x; float* out; const float* mod;
    __device__ __forceinline__ void one(int row, int col, const float (&v)[8]) const {
        const float* g1 = mod + (row >> 11) * 6144 + 2048 + col; const float* xr = x + (size_t)row * 1024 + col; float* o = out + (size_t)row * 1024 + col;
        const f32x4 x0 = *(const f32x4*)xr, x1 = *(const f32x4*)(xr + 4), a0 = *(const f32x4*)g1, a1 = *(const f32x4*)(g1 + 4);
        f32x4 r0, r1; r0.x = x0.x + a0.x * v[0]; r0.y = x0.y + a0.y * v[1]; r0.z = x0.z + a0.z * v[2]; r0.w = x0.w + a0.w * v[3];
        r1.x = x1.x + a1.x * v[4]; r1.y = x1.y + a1.y * v[5]; r1.z = x1.z + a1.z * v[6]; r1.w = x1.w + a1.w * v[7];
        *(f32x4*)o = r0; *(f32x4*)(o + 4) = r1; }
    __device__ __forceinline__ void operator()(int row, int pn, int cc, const float (&v0)[8], const float (&v1)[8]) const { one(row, pn * 256 + cc, v0); one(row, pn * 256 + 128 + cc, v1); } };
struct FStore { bf16_t* dst; int ldc;
    __device__ __forceinline__ void operator()(int row, int pn, int cc, const float (&v0)[8], const float (&v1)[8]) const {
        *(u32x4*)(dst + (size_t)row * ldc + pn * 256 + cc) = pack8(v0); *(u32x4*)(dst + (size_t)row * ldc + pn * 256 + 128 + cc) = pack8(v1); } };

template <int M, int N, int K, int LDA, int ACS, class F> __device__ __forceinline__ void run_gemm(const Ctx& c, const bf16_t* A, const bf16_t* Bt, const F& f) {
    pg8::Gemm g{A, Bt}; pg8::StaticOrder<M, N> So; So.init(c.G, (int)blockIdx.x);
    pg8::EpiF<F> E{f};
    pg8::gemm_phase<K, LDA, ACS, pg8::EpiF<F>, pg8::StaticOrder<M, N>>((PG8_LAS unsigned char*)c.lds, g, So, E);
}

__global__ void __launch_bounds__(512, 2) mk_fwd(Args args) {
    extern __shared__ __attribute__((aligned(16))) unsigned char lds_raw[];
    Ctx c;
    c.lds = (LAS unsigned char*)lds_raw;
    c.tid = threadIdx.x; c.lane = c.tid & 63; c.wave = __builtin_amdgcn_readfirstlane(c.tid >> 6);
    c.G = gridDim.x; { const int bx = blockIdx.x; c.vcu = (c.G % 8 == 0) ? (bx % 8) * (c.G / 8) + bx / 8 : bx; }
    c.in = args.in; c.out = args.out; c.ws = args.ws;
    volatile LAS unsigned* MISC = (volatile LAS unsigned*)(c.lds + MISC_OFF);
    if (c.tid < 32) MISC[c.tid] = 0u;
    __syncthreads();
    XcdBarrier bar; bar.bar = (unsigned*)(c.ws + WS_CTL) + 4096; bar.x = 0; bar.st = nullptr;
    if (args.ph_hi - args.ph_lo > 1) bar = xcd_barrier_post((unsigned*)(c.ws + WS_CTL) + 4096, MISC + 8);

    const int lo = args.ph_lo, hi = args.ph_hi;
#ifndef ONLYP
#define ONLYP -1
#endif
#define IN(k) (lo <= (k) && (k) < hi && (ONLYP < 0 || ONLYP == (k)))
#define SEAM(k) do { if ((k) + 1 < hi) xcd_barrier(bar); } while (0)
#ifndef REPEAT_MASK
#define REPEAT_MASK 0
#endif
#define PHASE(k, ...) if (IN(k)) { { __VA_ARGS__ } if ((REPEAT_MASK >> (k)) & 1) { xcd_barrier(bar); { __VA_ARGS__ } } SEAM(k); }
    PHASE(0, phase_prep(c);)
    PHASE(1, phase_modnorm<false>(c, c.in[I_X], c.in[I_N1G], 0, 1024, WSP(bf16_t, WS_R0));)
    PHASE(2, FInProj f{WSP(bf16_t, WS_R1), WSP(bf16_t, WS_R2), WSP(bf16_t, WS_R3), (bf16_t*)c.out};
             run_gemm<T, 4608, 1024, 1024, 0>(c, WSP(bf16_t, WS_R0), WSP(bf16_t, WS_WIN), f);)
    PHASE(3, phase_conv(c);)
    PHASE(4, { FRowScale fq{WSP(bf16_t, WS_R5), 768, WSP(float, WS_RSTD), 0};
               run_gemm<T, 768, 256, 512, 0>(c, WSP(bf16_t, WS_R1), WSP(bf16_t, WS_WUQ), fq); }
             { FGates fg{WSP(bf16_t, WS_R4), WSP(bf16_t, WS_R0), WSP(bf16_t, WS_R6), c.in[I_BRG], c.in[I_BIG], WSP(float, WS_C8SP)};
               run_gemm<T, 2048, 128, 1024, 128>(c, WSP(bf16_t, WS_R4), WSP(bf16_t, WS_WG), fg); })
    PHASE(5, { FRowScale fkv{WSP(bf16_t, WS_R2), 1024, WSP(float, WS_RSTD), 1};
               run_gemm<T, 1024, 128, 512, 0>(c, WSP(bf16_t, WS_R1) + 256, WSP(bf16_t, WS_WUKV), fkv); }
             phase_scan(c);)
    PHASE(6, phase_qkv_layout(c);)
    PHASE(7, phase_attn(c);)
    PHASE(8, { FY1 f1{(const bf16_t*)c.out, WSP(bf16_t, WS_R2), 0, false};
               run_gemm<T, 1024, 512, 512, 0>(c, WSP(bf16_t, WS_R0 + 32 * MiB), WSP(bf16_t, WS_WOA), f1); }
             { FY1 f2{(const bf16_t*)c.out, WSP(bf16_t, WS_R2), 1024, true};
               run_gemm<T, 1024, 1024, 1024, 0>(c, WSP(bf16_t, WS_R6), WSP(bf16_t, WS_WOL), f2); })
    PHASE(9, FX1 f{c.in[I_X], c.out, WSP(float, WS_MOD)};
             run_gemm<T, 1024, 1024, 1024, 0>(c, WSP(bf16_t, WS_R2), WSP(bf16_t, WS_WOUT), f);)
    PHASE(10, phase_modnorm<true>(c, c.out, c.in[I_N2G], 3072, 4096, WSP(bf16_t, WS_R0));)
    PHASE(11, FStore f{WSP(bf16_t, WS_QP), 2048};
              run_gemm<T, 2048, 1024, 1024, 0>(c, WSP(bf16_t, WS_R0), WSP(bf16_t, WS_WQ), f);)
    PHASE(12, FStore f{WSP(bf16_t, WS_SC), 2048};
              run_gemm<T, 2048, 256, 2048, 256>(c, WSP(bf16_t, WS_QP), WSP(bf16_t, WS_SK), f);)
    PHASE(13, phase_topk(c);)
    PHASE(14, phase_peer_u(c);)
    PHASE(15, phase_peer_fin(c);)
#ifdef PROBE_VDRY
    if (IN(16)) { phase_peer_v<true>(c); xcd_barrier(bar); }
#endif
    PHASE(16, phase_peer_v<false>(c);)
#undef PHASE
#undef IN
#undef SEAM
}

extern "C" void kernel_launch(void* const* d_in, const int* in_sizes, int n_in, void* d_out, int out_size, void* d_ws, size_t ws_size, hipStream_t stream) {
    static int grid = 0;
    if (grid == 0) {
        if (n_in != 28 || out_size != T * D || ws_size < WS_END) { fprintf(stderr, "kernel_launch: unexpected shapes (n_in %d out %d ws %zu)\n", n_in, out_size, ws_size); grid = -1; return; }
        int dev = 0, cus = 0, per_cu = 0;
        if (hipGetDevice(&dev) != hipSuccess || hipDeviceGetAttribute(&cus, hipDeviceAttributeMultiprocessorCount, dev) != hipSuccess) { grid = -1; return; }
        if (hipFuncSetAttribute((const void*)mk_fwd, hipFuncAttributeMaxDynamicSharedMemorySize, LDS_BYTES) != hipSuccess) { fprintf(stderr, "kernel_launch: hipFuncSetAttribute failed\n"); grid = -1; return; }
        if (hipOccupancyMaxActiveBlocksPerMultiprocessor(&per_cu, (const void*)mk_fwd, 512, LDS_BYTES) != hipSuccess || per_cu < 1) { fprintf(stderr, "kernel_launch: occupancy query says %d blocks per CU\n", per_cu); grid = -1; (void)hipGetLastError(); return; }
        grid = cus;
    }
    if (grid < 0) return;
    (void)hipMemsetAsync((char*)d_ws + WS_CTL, 0, CTL_ZERO_BYTES, stream);
    Args a{};
    for (int i = 0; i < 28; ++i) a.in[i] = (const float*)d_in[i];
    a.out = (float*)d_out; a.ws = (unsigned char*)d_ws;
#if MK_N_LAUNCHES == 1
    a.ph_lo = 0; a.ph_hi = N_PHASES;
    hipLaunchKernelGGL(mk_fwd, dim3(grid), dim3(512), LDS_BYTES, stream, a);
#else
    for (int ph = 0; ph < N_PHASES; ++ph) { a.ph_lo = ph; a.ph_hi = ph + 1; hipLaunchKernelGGL(mk_fwd, dim3(grid), dim3(512), LDS_BYTES, stream, a); }
#endif
}
```

```cpp
#include <hip/hip_runtime.h>
#include <cstdio>
#include <cstdint>

#define LAS __attribute__((address_space(3)))
#define GAS __attribute__((address_space(1)))
typedef unsigned short bf16_t;
typedef short bf16x8 __attribute__((ext_vector_type(8)));
typedef float f32x4 __attribute__((ext_vector_type(4)));
typedef float f32x2 __attribute__((ext_vector_type(2)));
typedef unsigned u32x4 __attribute__((ext_vector_type(4)));
typedef unsigned u32x2 __attribute__((ext_vector_type(2)));

#ifndef MK_N_LAUNCHES
#define MK_N_LAUNCHES 1
#endif

constexpr int T = 32768, D = 1024, NB_ = 16, S = 2048, H = 8;
constexpr int QKH = 96, VH = 64;
constexpr int NE = 16384;
constexpr float EPS = 1e-6f;

constexpr size_t MiB = 1u << 20;
constexpr size_t WS_CTL = 0, CTL_ZERO_BYTES = 65536;
constexpr size_t WS_MOD = 1 * MiB;
constexpr size_t WS_RSTD = 1 * MiB + 512 * 1024;
constexpr size_t WS_C8SP = 1 * MiB + 448 * 1024;
constexpr size_t WS_WIN = 2 * MiB;
constexpr size_t WS_WUQ = 11 * MiB;
constexpr size_t WS_WUKV = 11 * MiB + 512 * 1024;
constexpr size_t WS_WOA = 12 * MiB;
constexpr size_t WS_WOL = 13 * MiB;
constexpr size_t WS_WOUT = 15 * MiB;
constexpr size_t WS_WQ = 17 * MiB;
constexpr size_t WS_WG = 21 * MiB;
constexpr size_t WS_SK = 22 * MiB;
constexpr size_t WS_EU = 24 * MiB;
constexpr size_t WS_EV = 40 * MiB;
constexpr size_t WS_SU = 1 * MiB + 768 * 1024;
constexpr size_t WS_SV = 1 * MiB + 832 * 1024;
constexpr size_t WS_WGT = 440 * MiB;
constexpr size_t WS_H2Q = 456 * MiB;
constexpr size_t WS_SH = 1 * MiB + 896 * 1024;
constexpr size_t WS_PD = 280 * MiB;
constexpr size_t WS_R0 = 88 * MiB;
constexpr size_t WS_R1 = 152 * MiB;
constexpr size_t WS_R2 = 184 * MiB;
constexpr size_t WS_R3 = 248 * MiB;
constexpr size_t WS_R4 = 312 * MiB;
constexpr size_t WS_R5 = 376 * MiB;
constexpr size_t WS_R6 = 424 * MiB;
constexpr size_t WS_QP = 152 * MiB;
constexpr size_t WS_SC = 280 * MiB;
constexpr size_t WS_IDX = 408 * MiB;
constexpr size_t WS_GW = 424 * MiB;
constexpr size_t WS_END = 488 * MiB;

constexpr int LDS_BYTES = 147456;
constexpr int MISC_OFF = 131072 + 320;

__device__ __forceinline__ unsigned f2bf(float f) { unsigned u = __builtin_bit_cast(unsigned, f); return (u + 0x7fffu + ((u >> 16) & 1u)) >> 16; }
typedef __bf16 bf16x2_t __attribute__((ext_vector_type(2)));
__device__ __forceinline__ unsigned pk2(float lo, float hi) { f32x2 v = {lo, hi}; return __builtin_bit_cast(unsigned, __builtin_convertvector(v, bf16x2_t)); }
__device__ __forceinline__ float bf2f(unsigned h) { return __builtin_bit_cast(float, h << 16); }
__device__ __forceinline__ float bflo(unsigned w) { return __builtin_bit_cast(float, w << 16); }
__device__ __forceinline__ float bfhi(unsigned w) { return __builtin_bit_cast(float, w & 0xffff0000u); }
__device__ __forceinline__ float sigmoidf_(float x) { return 1.f / (1.f + __expf(-x)); }
__device__ __forceinline__ float gelu_tanh(float x) {
    const float u = 0.7978845608028654f * (x + 0.044715f * x * x * x);
    const float e = __expf(2.f * u);
    const float th = 1.f - 2.f / (e + 1.f);
    return 0.5f * x * (1.f + th);
}
__device__ __forceinline__ int lane_id_v() { int l; asm volatile("v_mbcnt_lo_u32_b32 %0, -1, 0\n\tv_mbcnt_hi_u32_b32 %0, -1, %0" : "=v"(l)); return l; }
__device__ __forceinline__ float wave_sum(float v) {
#pragma unroll
    for (int o = 1; o < 64; o <<= 1) v += __shfl_xor(v, o);
    return v;
}
__device__ __forceinline__ void unpack8(const u32x4 w, float (&v)[8]) {
    v[0] = bflo(w.x); v[1] = bfhi(w.x); v[2] = bflo(w.y); v[3] = bfhi(w.y); v[4] = bflo(w.z); v[5] = bfhi(w.z); v[6] = bflo(w.w); v[7] = bfhi(w.w);
}
__device__ __forceinline__ u32x4 pack8(const float (&v)[8]) {
    u32x4 w; w.x = pk2(v[0], v[1]); w.y = pk2(v[2], v[3]); w.z = pk2(v[4], v[5]); w.w = pk2(v[6], v[7]); return w;
}

namespace pg8 {
#define PG8_LAS __attribute__((address_space(3)))
constexpr int BM = 256, BK = 64, HALF = 128, HTB = HALF * BK * 2, STAGE_BYTES = 8 * HTB, NXCD = 8, WGM = 8;
__host__ __device__ __forceinline__ int lds_byte(int r, int c) { const int st = (r >> 4) * 2 + (c >> 5), rr = r & 15, cc = c & 31, ob = rr * 64 + cc * 2; return st * 1024 + (ob ^ (((ob >> 9) & 1) << 5)); }
__host__ __device__ __forceinline__ void stage_rc(int b, int& R, int& C) { const int st = b / 1024, sb = b % 1024, swz = sb ^ (((sb >> 9) & 1) << 5); R = (st >> 1) * 16 + swz / 64; C = (st & 1) * 32 + (swz % 64) / 2; }
__host__ __device__ __forceinline__ int perm32(int rho) { const int n = rho >> 4, i = rho & 15; return 8 * (i >> 2) + 4 * n + (i & 3); }

struct Unit { int pm, pn; };
struct Gemm { const bf16_t* A; const bf16_t* Bt; };

template <int M_, int N_> struct StaticOrder {
    static constexpr int nM = M_ / BM, nN = N_ / BM, nwg = nM * nN;
    int G, c;
    __host__ __device__ void init(int G_, int c_) { G = G_; c = c_; }
    __host__ __device__ bool next(int i, Unit& u) const {
        const long L = (long)i * G + c; if (L >= nwg) return false;
        int wgid = (int)L; { const int q = nwg / NXCD, r = nwg % NXCD, xcd = wgid % NXCD, off = wgid / NXCD; wgid = (xcd < r ? xcd * (q + 1) : r * (q + 1) + (xcd - r) * q) + off; }
        const int nig = WGM * nN, gid = wgid / nig, fm = gid * WGM, gsz = (nM - fm) < WGM ? (nM - fm) : WGM;
        u.pm = fm + ((wgid % nig) % gsz); u.pn = (wgid % nig) / gsz; return true;
    }
};

template <class F> struct EpiF {
    static constexpr bool PERM = true;
    F f;
    __device__ __forceinline__ void operator()(const f32x4 (&acc)[2][2][4][2], const Unit& u, int wr, int wc, int fr, int fq) const {
        const int c = wc * 32 + 8 * fq;
#pragma unroll
        for (int ai = 0; ai < 2; ++ai)
#pragma unroll
            for (int m = 0; m < 4; ++m) {
                const int row = u.pm * BM + ai * HALF + wr * 64 + m * 16 + fr;
                float v0[8], v1[8];
#pragma unroll
                for (int j = 0; j < 4; ++j) { v0[j] = acc[ai][0][m][0][j]; v0[4 + j] = acc[ai][0][m][1][j]; v1[j] = acc[ai][1][m][0][j]; v1[4 + j] = acc[ai][1][m][1][j]; }
                f(row, u.pn, c, v0, v1);
            }
    }
};

template <int K, int LDA, int ACS, class Epi, class Sched>
__device__ __forceinline__ void gemm_phase(PG8_LAS unsigned char* lds, const Gemm g, const Sched& S, const Epi& E, const int tid) {
    const int wid = __builtin_amdgcn_readfirstlane(tid >> 6), lane = tid & 63, wr = wid >> 2, wc = wid & 3, fr = lane & 15, fq = lane >> 4;
    constexpr int nt = K / BK;
    unsigned voffA[2], voffB[2];
#pragma unroll
    for (int i = 0; i < 2; ++i) { int R, C; stage_rc(tid * 16 + i * 8192, R, C); const int Rb = Epi::PERM ? ((R & ~31) + perm32(R & 31)) : R;
        voffA[i] = (unsigned)(R * LDA + C) * 2u; voffB[i] = (unsigned)(Rb * K + C) * 2u; }
    constexpr size_t kstep = (size_t)(BK * 2);
    constexpr size_t hstepA = (size_t)HALF * LDA * 2, hstepB = (size_t)HALF * K * 2;
    constexpr size_t tstepA = 2 * hstepA, tstepB = 2 * hstepB;
    constexpr size_t acsb = (size_t)ACS * 2;
    const unsigned ldsw = (unsigned)wid * 1024u;
    const int aoff = lds_byte(wr * 64 + fr, fq * 8), boff = lds_byte(wc * 32 + fr, fq * 8);
#define PG8_SA(b, h) (((b) * 2 + (h)) * HTB)
#define PG8_SB(b, h) ((4 + (b) * 2 + (h)) * HTB)
#define PG8_STAGE(bufoff, gbase, voff) do { _Pragma("unroll") for (int _i = 0; _i < 2; ++_i) \
        __builtin_amdgcn_global_load_lds((const unsigned*)((const char*)(gbase) + (voff)[_i]), (PG8_LAS unsigned*)(lds + (bufoff) + ldsw + _i * 8192), 16, 0, 0); } while (0)
#define PG8_LDA(dst, b, h) do { _Pragma("unroll") for (int m = 0; m < 4; ++m) _Pragma("unroll") for (int k = 0; k < 2; ++k) dst[m][k] = *(const PG8_LAS bf16x8*)(lds + PG8_SA(b, h) + aoff + m * 2048 + k * 1024); } while (0)
#define PG8_LDB(dst, b, h) do { _Pragma("unroll") for (int n = 0; n < 2; ++n) _Pragma("unroll") for (int k = 0; k < 2; ++k) dst[n][k] = *(const PG8_LAS bf16x8*)(lds + PG8_SB(b, h) + boff + n * 2048 + k * 1024); } while (0)
#define PG8_MMA(ai, bj, At, Bt) do { __builtin_amdgcn_s_setprio(1); _Pragma("unroll") for (int m = 0; m < 4; ++m) _Pragma("unroll") for (int n = 0; n < 2; ++n) _Pragma("unroll") for (int k = 0; k < 2; ++k) \
        acc[ai][bj][m][n] = __builtin_amdgcn_mfma_f32_16x16x32_bf16(Bt[n][k], At[m][k], acc[ai][bj][m][n], 0, 0, 0); __builtin_amdgcn_s_setprio(0); } while (0)
#define PG8_WAIT_V(n) asm volatile("s_waitcnt vmcnt(" #n ")" ::: "memory")
#define PG8_WAIT_L(n) asm volatile("s_waitcnt lgkmcnt(" #n ")" ::: "memory")
#define PG8_BAR __builtin_amdgcn_s_barrier()
#define PG8_SCHED __builtin_amdgcn_sched_barrier(0)
    Unit cur, nxt; int ui = 0;
    if (!S.next(0, cur)) return;
    f32x4 acc[2][2][4][2];
#pragma unroll
    for (int a = 0; a < 2; ++a)
#pragma unroll
        for (int b = 0; b < 2; ++b)
#pragma unroll
            for (int m = 0; m < 4; ++m)
#pragma unroll
                for (int n = 0; n < 2; ++n) acc[a][b][m][n] = (f32x4){0.f, 0.f, 0.f, 0.f};
    bf16x8 At[4][2], B0[2][2], B1[2][2];
    const char* cA = (const char*)g.A + (size_t)cur.pm * tstepA + (size_t)cur.pn * acsb; const char* cB = (const char*)g.Bt + (size_t)cur.pn * tstepB;
    PG8_STAGE(PG8_SB(0, 0), cB, voffB); PG8_STAGE(PG8_SB(0, 1), cB + hstepB, voffB); PG8_STAGE(PG8_SA(0, 0), cA, voffA); PG8_STAGE(PG8_SA(0, 1), cA + hstepA, voffA);
    if (wr == 1) PG8_BAR;
    PG8_WAIT_V(2); PG8_BAR;
    PG8_STAGE(PG8_SB(1, 0), cB + kstep, voffB); PG8_STAGE(PG8_SA(1, 0), cA + kstep, voffA); PG8_STAGE(PG8_SB(1, 1), cB + hstepB + kstep, voffB);
    PG8_WAIT_V(6); PG8_BAR;
    for (;;) {
        const bool has_next = S.next(ui + 1, nxt);
        const char* nA = has_next ? (const char*)g.A + (size_t)nxt.pm * tstepA + (size_t)nxt.pn * acsb : cA; const char* nB = has_next ? (const char*)g.Bt + (size_t)nxt.pn * tstepB : cB;
#pragma unroll 1
        for (int t = 0; t < nt; t += 2) {
            const bool last = (t == nt - 2);
            const char* a1 = cA + (size_t)(t + 1) * kstep;
            const char* a2 = last ? nA : cA + (size_t)(t + 2) * kstep; const char* b2 = last ? nB : cB + (size_t)(t + 2) * kstep;
            const char* a3 = a2 + kstep; const char* b3 = b2 + kstep;
            PG8_LDB(B0, 0, 0); PG8_LDB(B1, 0, 1); PG8_SCHED; PG8_LDA(At, 0, 0); PG8_STAGE(PG8_SA(1, 1), a1 + hstepA, voffA);
            PG8_WAIT_V(8); PG8_WAIT_L(0); PG8_BAR; PG8_MMA(0, 0, At, B0); PG8_MMA(0, 1, At, B1); PG8_BAR; PG8_SCHED;
            PG8_LDA(At, 0, 1); PG8_STAGE(PG8_SB(0, 0), b2, voffB); PG8_STAGE(PG8_SB(0, 1), b2 + hstepB, voffB); PG8_STAGE(PG8_SA(0, 0), a2, voffA);
            PG8_WAIT_V(8); PG8_WAIT_L(0); PG8_BAR; PG8_MMA(1, 0, At, B0); PG8_MMA(1, 1, At, B1); PG8_BAR; PG8_SCHED;
            PG8_LDB(B0, 1, 0); PG8_LDB(B1, 1, 1); PG8_SCHED; PG8_LDA(At, 1, 0); PG8_STAGE(PG8_SA(0, 1), a2 + hstepA, voffA);
            PG8_WAIT_V(8); PG8_WAIT_L(0); PG8_BAR; PG8_MMA(0, 0, At, B0); PG8_MMA(0, 1, At, B1); PG8_BAR; PG8_SCHED;
            PG8_LDA(At, 1, 1); PG8_STAGE(PG8_SB(1, 0), b3, voffB); PG8_STAGE(PG8_SB(1, 1), b3 + hstepB, voffB); PG8_STAGE(PG8_SA(1, 0), a3, voffA);
            PG8_WAIT_V(8); PG8_WAIT_L(0); PG8_BAR; PG8_MMA(1, 0, At, B0); PG8_MMA(1, 1, At, B1); PG8_BAR; PG8_SCHED;
        }
        if (wr == 0) PG8_BAR;
        E(acc, cur, wr, wc, fr, fq);
        if (!has_next) break;
#pragma unroll
        for (int a = 0; a < 2; ++a)
#pragma unroll
            for (int b = 0; b < 2; ++b)
#pragma unroll
                for (int m = 0; m < 4; ++m)
#pragma unroll
                    for (int n = 0; n < 2; ++n) acc[a][b][m][n] = (f32x4){0.f, 0.f, 0.f, 0.f};
        cur = nxt; cA = nA; cB = nB; ++ui;
        if (wr == 1) PG8_BAR;
    }
    PG8_WAIT_V(0);
    PG8_BAR;
#undef PG8_SA
#undef PG8_SB
#undef PG8_STAGE
#undef PG8_LDA
#undef PG8_LDB
#undef PG8_MMA
#undef PG8_WAIT_V
#undef PG8_WAIT_L
#undef PG8_BAR
#undef PG8_SCHED
}
}

#define XB_TMO      128
#define XB_XCNT(j)  (256  + 64 * (j))
#define XB_XSUB(j)  (1280 + 64 * (j))
#define XB_XGEN(j)  (2304 + 64 * (j))
#define XB_TOP      3328
#define XB_TOPGEN   3392
#define XCD_BAR_WORDS 3456
#define XB_SPIN_CAP (1u << 18)
__device__ __forceinline__ unsigned xb_ld(unsigned* p)              { return __hip_atomic_load(p, __ATOMIC_RELAXED, __HIP_MEMORY_SCOPE_AGENT); }
__device__ __forceinline__ unsigned xb_add(unsigned* p, unsigned v) { return __hip_atomic_fetch_add(p, v, __ATOMIC_RELAXED, __HIP_MEMORY_SCOPE_AGENT); }
__device__ __forceinline__ unsigned xb_xcc_id() { return (unsigned)__builtin_amdgcn_s_getreg((3 << 11) | 20) & 0xFu; }
#define XB_SPIN(cond, bar) do { unsigned _sp = 0; while (cond) { __builtin_amdgcn_s_sleep(1); \
    if ((++_sp & 255u) == 0u) { if (xb_ld(&(bar)[XB_TMO])) break; if (_sp > XB_SPIN_CAP) { atomicAdd(&(bar)[XB_TMO], 1u); break; } } } } while (0)
struct XcdBarrier { unsigned* bar; unsigned x; volatile LAS unsigned* st; };
__device__ __forceinline__ XcdBarrier xcd_barrier_post(unsigned* bar, volatile LAS unsigned* st) {
    XcdBarrier b; b.bar = bar; b.x = xb_xcc_id(); b.st = st;
    if (threadIdx.x == 0) (void)xb_add(&bar[XB_XCNT(b.x)], 1u);
    return b;
}
__device__ __forceinline__ void xcd_barrier_complete(unsigned* bar, unsigned x, unsigned& nloc, unsigned& nx) {
    const unsigned G = gridDim.x * gridDim.y * gridDim.z;
    unsigned sum, cnt, mine, sp = 0u;
    for (;;) {
        sum = 0u; cnt = 0u; mine = 0u;
#pragma unroll
        for (unsigned j = 0; j < 16; ++j) { const unsigned c = xb_ld(&bar[XB_XCNT(j)]); sum += c; cnt += (c > 0u) ? 1u : 0u; mine = (j == x) ? c : mine; }
        if (sum == G) break;
        __builtin_amdgcn_s_sleep(1);
        if ((++sp & 255u) == 0u) { if (xb_ld(&bar[XB_TMO])) break; if (sp > XB_SPIN_CAP) { atomicAdd(&bar[XB_TMO], 1u); break; } }
    }
    nloc = mine > 0u ? mine : 1u; nx = cnt > 0u ? cnt : 1u;
}
__device__ __forceinline__ void xcd_barrier(const XcdBarrier& b, int wave) {
    asm volatile("s_waitcnt vmcnt(0)" ::: "memory");
    __syncthreads();
    if (wave == 0 && lane_id_v() == 0) {
        unsigned* bar = b.bar;
        __builtin_amdgcn_s_waitcnt(0);
        unsigned nloc = b.st[0], nx = b.st[1];
        if (nloc == 0u) { xcd_barrier_complete(bar, b.x, nloc, nx); b.st[0] = nloc; b.st[1] = nx; }
        const unsigned old = xb_add(&bar[XB_XSUB(b.x)], 1u);
        const unsigned gen = old / nloc;
        if (old + 1u == (gen + 1u) * nloc) {
            __builtin_amdgcn_fence(__ATOMIC_RELEASE, "agent");
            asm volatile("s_waitcnt vmcnt(0)" ::: "memory");
            const unsigned og = xb_add(&bar[XB_TOP], 1u);
            const unsigned tg = og / nx;
            if (og + 1u == (tg + 1u) * nx) xb_add(&bar[XB_TOPGEN], 1u);
            else XB_SPIN(xb_ld(&bar[XB_TOPGEN]) == tg, bar);
            __builtin_amdgcn_fence(__ATOMIC_ACQUIRE, "agent");
            xb_add(&bar[XB_XGEN(b.x)], 1u);
            asm volatile("s_waitcnt vmcnt(0)" ::: "memory");
        } else {
            XB_SPIN(xb_ld(&bar[XB_XGEN(b.x)]) == gen, bar);
            __builtin_amdgcn_fence(__ATOMIC_ACQUIRE, "agent");
            asm volatile("s_waitcnt vmcnt(0)" ::: "memory");
        }
    }
    __syncthreads();
}

struct Args { const float* in[28]; float* out; unsigned char* ws; int ph_lo, ph_hi; };
enum { I_X = 0, I_C, I_POS, I_WADA, I_BADA, I_N1G, I_WIN, I_QAG, I_WUQ, I_KVAG, I_WUKV, I_QNG, I_KNG, I_WOA, I_CONVW, I_CONVB, I_WRG, I_BRG, I_WIG, I_BIG, I_LAM, I_WOL, I_WOUT, I_N2G, I_WQ, I_SUBK, I_EU, I_EV };
constexpr int N_PHASES = 17;

struct Ctx {
    LAS unsigned char* lds;
    int tid, lane, wave, vcu, G;
    const float* const* in; float* out; unsigned char* ws;
};
#define WSP(type, off) ((type*)(c.ws + (off)))

template <class F>
__device__ __forceinline__ void tr_tile(const Ctx& c, bf16_t* dst, int K, int n0, int k0, F f) {
    LAS float* scr = (LAS float*)c.lds;
#pragma unroll
    for (int i = 0; i < 8; ++i) { const int kk = i * 8 + (c.tid >> 6), nn = c.tid & 63; scr[kk * 65 + nn] = f(k0 + kk, n0 + nn); }
    __syncthreads();
#pragma unroll
    for (int i = 0; i < 8; ++i) { const int nn = i * 8 + (c.tid >> 6), kk = c.tid & 63; dst[(size_t)(n0 + nn) * K + k0 + kk] = (bf16_t)f2bf(scr[kk * 65 + nn]); }
    __syncthreads();
}

__device__ __forceinline__ void phase_prep(const Ctx& c0) {
    Ctx c = c0; c.lane = lane_id_v(); c.tid = c.wave * 64 + c.lane;
    const float* w_in = c.in[I_WIN]; const float* w_uq = c.in[I_WUQ]; const float* qag = c.in[I_QAG]; const float* w_ukv = c.in[I_WUKV]; const float* kvag = c.in[I_KVAG];
    const float* w_oa = c.in[I_WOA]; const float* w_ol = c.in[I_WOL]; const float* w_out = c.in[I_WOUT]; const float* w_q = c.in[I_WQ];
    const float* w_rg = c.in[I_WRG]; const float* w_ig = c.in[I_WIG];
    constexpr int T_WIN = 72 * 16, T_WUQ = 12 * 4, T_WUKV = 16 * 2, T_WOA = 16 * 8, T_WOL = 16 * 16, T_WOUT = 16 * 16, T_WQ = 32 * 16, T_WG = 8 * 4 * 2;
    constexpr int T_ALL = T_WIN + T_WUQ + T_WUKV + T_WOA + T_WOL + T_WOUT + T_WQ + T_WG;
    for (int it = c.vcu; it < T_ALL; it += c.G) {
        int r = it;
        if (r < T_WIN) { const int nb = r / 16, kb = r % 16;
            tr_tile(c, WSP(bf16_t, WS_WIN), 1024, nb * 64, kb * 64, [=](int k, int n) -> float { return n < 416 ? w_in[(size_t)k * 4512 + n] : (n < 512 ? 0.f : w_in[(size_t)k * 4512 + n - 96]); }); continue; }
        r -= T_WIN;
        if (r < T_WUQ) { const int nb = r / 4, kb = r % 4;
            tr_tile(c, WSP(bf16_t, WS_WUQ), 256, nb * 64, kb * 64, [=](int k, int n) -> float { return w_uq[(size_t)k * 768 + n] * qag[k]; }); continue; }
        r -= T_WUQ;
        if (r < T_WUKV) { const int nb = r / 2, kb = r % 2;
            tr_tile(c, WSP(bf16_t, WS_WUKV), 128, nb * 64, kb * 64, [=](int k, int n) -> float { return w_ukv[(size_t)k * 1024 + n] * kvag[k]; }); continue; }
        r -= T_WUKV;
        if (r < T_WOA) { const int nb = r / 8, kb = r % 8;
            tr_tile(c, WSP(bf16_t, WS_WOA), 512, nb * 64, kb * 64, [=](int k, int n) -> float { return w_oa[(size_t)k * 1024 + n]; }); continue; }
        r -= T_WOA;
        if (r < T_WOL) { const int nb = r / 16, kb = r % 16;
            tr_tile(c, WSP(bf16_t, WS_WOL), 1024, nb * 64, kb * 64, [=](int k, int n) -> float { return w_ol[(size_t)k * 1024 + n]; }); continue; }
        r -= T_WOL;
        if (r < T_WOUT) { const int nb = r / 16, kb = r % 16;
            tr_tile(c, WSP(bf16_t, WS_WOUT), 1024, nb * 64, kb * 64, [=](int k, int n) -> float { return w_out[(size_t)k * 1024 + n]; }); continue; }
        r -= T_WOUT;
        if (r < T_WQ) { const int nb = r / 16, kb = r % 16;
            tr_tile(c, WSP(bf16_t, WS_WQ), 1024, nb * 64, kb * 64, [=](int k, int n) -> float { return w_q[(size_t)k * 2048 + n]; }); continue; }
        r -= T_WQ;
        { const int blk = r / 8, q = r % 8, nb = q / 2, kb = q % 2;
            tr_tile(c, WSP(bf16_t, WS_WG) + (size_t)blk * 256 * 128, 128, nb * 64, kb * 64,
                    [=](int k, int n) -> float { return n < 128 ? w_rg[((size_t)blk * 128 + k) * 128 + n] : w_ig[((size_t)blk * 128 + k) * 128 + n - 128]; }); }
    }
    { const float* lam = c.in[I_LAM]; float* t8 = WSP(float, WS_C8SP);
      if (c.vcu == 0) for (int e = c.tid; e < 1024; e += 512) t8[e] = -8.f * log1pf(__expf(-lam[e])); }
    { const float* sk = c.in[I_SUBK]; bf16_t* dst = WSP(bf16_t, WS_SK);
      for (int e = c.vcu * 512 + c.tid; e < 8 * 256 * 256; e += c.G * 512) {
          const int h = e >> 16, r = (e >> 8) & 255, cc = e & 255;
          float v = 0.f; if ((r >> 7) == (cc >> 7)) v = sk[(((size_t)h * 2 + (r >> 7)) * 128 + (r & 127)) * 128 + (cc & 127)];
          dst[e] = (bf16_t)f2bf(v); } }
    { const int gw = c.vcu * 8 + c.wave, NGW = c.G * 8, L = c.lane;
      for (int r = gw; r < 2 * NE; r += NGW) {
          const int isv = r >= NE, e = isv ? r - NE : r;
          const f32x4* src4 = (const f32x4*)((isv ? c.in[I_EV] : c.in[I_EU]) + (size_t)e * 1024 + 16 * L);
          f32x4 v[4]; float am = 0.f;
#pragma unroll
          for (int j = 0; j < 4; ++j) { v[j] = src4[j]; am = fmaxf(am, fmaxf(fmaxf(fabsf(v[j].x), fabsf(v[j].y)), fmaxf(fabsf(v[j].z), fabsf(v[j].w)))); }
#pragma unroll
          for (int o = 1; o < 64; o <<= 1) am = fmaxf(am, __shfl_xor(am, o));
          const float s = am > 0.f ? am * (1.f / 256.f) : 1.f, inv = 1.f / s;
          u32x4 q;
          { int w;
            w = __builtin_amdgcn_cvt_pk_fp8_f32(v[0].x * inv, v[0].y * inv, 0, false); w = __builtin_amdgcn_cvt_pk_fp8_f32(v[0].z * inv, v[0].w * inv, w, true); q.x = (unsigned)w;
            w = __builtin_amdgcn_cvt_pk_fp8_f32(v[1].x * inv, v[1].y * inv, 0, false); w = __builtin_amdgcn_cvt_pk_fp8_f32(v[1].z * inv, v[1].w * inv, w, true); q.y = (unsigned)w;
            w = __builtin_amdgcn_cvt_pk_fp8_f32(v[2].x * inv, v[2].y * inv, 0, false); w = __builtin_amdgcn_cvt_pk_fp8_f32(v[2].z * inv, v[2].w * inv, w, true); q.z = (unsigned)w;
            w = __builtin_amdgcn_cvt_pk_fp8_f32(v[3].x * inv, v[3].y * inv, 0, false); w = __builtin_amdgcn_cvt_pk_fp8_f32(v[3].z * inv, v[3].w * inv, w, true); q.w = (unsigned)w; }
          if (!isv) { *(u32x4*)(c.ws + WS_EU + ((size_t)(L >> 3) * NE + e) * 128 + (L & 7) * 16) = q; if (L == 0) WSP(float, WS_SU)[e] = s; }
          else { *(u32x4*)(c.ws + WS_EV + ((size_t)(L >> 3) * NE + e) * 128 + (L & 7) * 16) = q; if (L == 0) WSP(float, WS_SV)[e] = s; }
      } }
    { const float* cin = c.in[I_C]; const float* w_ada = c.in[I_WADA]; const float* b_ada = c.in[I_BADA]; float* mod = WSP(float, WS_MOD);
      LAS float* cs = (LAS float*)c.lds;
      LAS float* red = (LAS float*)(c.lds + 65536);
      bool have = false;
      for (int it = c.vcu; it < 192; it += c.G) {
          if (!have) { for (int e = c.tid; e < 16 * 1024; e += 512) { const float v = cin[e]; cs[e] = v / (1.f + __expf(-v)); } have = true; }
          __syncthreads();
          const int cl = c.tid & 31, ks = c.tid >> 5, j = it * 32 + cl;
          float acc[16];
#pragma unroll
          for (int b = 0; b < 16; ++b) acc[b] = 0.f;
          for (int kk = 0; kk < 64; ++kk) { const int k = ks * 64 + kk; const float w = w_ada[(size_t)k * 6144 + j];
#pragma unroll
              for (int b = 0; b < 16; ++b) acc[b] += cs[b * 1024 + k] * w; }
#pragma unroll
          for (int b = 0; b < 16; ++b) red[(ks * 16 + b) * 32 + cl] = acc[b];
          __syncthreads();
          { const int b = c.tid >> 5; float s = b_ada[j];
#pragma unroll
            for (int k2 = 0; k2 < 16; ++k2) s += red[(k2 * 16 + b) * 32 + cl];
            mod[b * 6144 + j] = s; }
          __syncthreads();
      } }
}

template <bool Q8>
__device__ __forceinline__ void phase_modnorm(const Ctx& c0, const float* x, const float* g, int shift_off, int scale_off, bf16_t* dst) {
    Ctx c = c0; c.lane = lane_id_v(); c.tid = c.wave * 64 + c.lane;
    const float* mod = WSP(float, WS_MOD);
    const int gw = c.vcu * 8 + c.wave, NGW = c.G * 8;
    for (int m = gw; m < T; m += NGW) {
        const int b = m >> 11;
        const f32x4* xr = (const f32x4*)(x + (size_t)m * D) + c.lane;
        f32x4 v[4]; float s = 0.f;
#pragma unroll
        for (int j = 0; j < 4; ++j) { v[j] = xr[64 * j]; s += (v[j].x * v[j].x + v[j].y * v[j].y) + (v[j].z * v[j].z + v[j].w * v[j].w); }
        const float rstd = rsqrtf(wave_sum(s) * (1.f / D) + EPS);
        u32x2* o8 = (u32x2*)(dst + (size_t)m * D) + c.lane;
        float am = 0.f;
#pragma unroll
        for (int j = 0; j < 4; ++j) {
            const int col = 4 * c.lane + 256 * j;
            const f32x4 gg = *(const f32x4*)(g + col), sc = *(const f32x4*)(mod + b * 6144 + scale_off + col), sh = *(const f32x4*)(mod + b * 6144 + shift_off + col);
            const float r0 = v[j].x * rstd * gg.x * (1.f + sc.x) + sh.x, r1 = v[j].y * rstd * gg.y * (1.f + sc.y) + sh.y;
            const float r2 = v[j].z * rstd * gg.z * (1.f + sc.z) + sh.z, r3 = v[j].w * rstd * gg.w * (1.f + sc.w) + sh.w;
            u32x2 w; w.x = pk2(r0, r1); w.y = pk2(r2, r3); o8[64 * j] = w;
            if (Q8) { v[j].x = r0; v[j].y = r1; v[j].z = r2; v[j].w = r3; am = fmaxf(am, fmaxf(fmaxf(fabsf(r0), fabsf(r1)), fmaxf(fabsf(r2), fabsf(r3)))); }
        }
        if (Q8) {
#pragma unroll
            for (int o = 1; o < 64; o <<= 1) am = fmaxf(am, __shfl_xor(am, o));
            const float sq = am > 0.f ? am * (1.f / 256.f) : 1.f, inv = 1.f / sq;
            unsigned* q8 = (unsigned*)(c.ws + WS_H2Q + (size_t)m * D) + c.lane;
#pragma unroll
            for (int j = 0; j < 4; ++j) { int w = __builtin_amdgcn_cvt_pk_fp8_f32(v[j].x * inv, v[j].y * inv, 0, false); w = __builtin_amdgcn_cvt_pk_fp8_f32(v[j].z * inv, v[j].w * inv, w, true); q8[64 * j] = (unsigned)w; }
            if (c.lane == 0) WSP(float, WS_SH)[m] = sq;
        }
    }
}

__device__ __forceinline__ void phase_conv(const Ctx& c0) {
    Ctx c = c0; c.lane = lane_id_v(); c.tid = c.wave * 64 + c.lane;
    const bf16_t* pa = WSP(bf16_t, WS_R1); const bf16_t* lx = WSP(bf16_t, WS_R2); bf16_t* xc = WSP(bf16_t, WS_R4); float* rstd = WSP(float, WS_RSTD);
    const float* cw = c.in[I_CONVW]; const float* cb = c.in[I_CONVB];
    const int gt = c.vcu * 512 + c.tid, NT = c.G * 512;
    for (int t = gt; t < T; t += NT) {
        const u32x4* p = (const u32x4*)(pa + (size_t)t * 512);
        float sq = 0.f, skv = 0.f;
        for (int i = 0; i < 32; ++i) { float v[8]; unpack8(p[i], v);
#pragma unroll
            for (int j = 0; j < 8; ++j) sq += v[j] * v[j]; }
        for (int i = 32; i < 48; ++i) { float v[8]; unpack8(p[i], v);
#pragma unroll
            for (int j = 0; j < 8; ++j) skv += v[j] * v[j]; }
        rstd[2 * t] = rsqrtf(sq * (1.f / 256.f) + EPS); rstd[2 * t + 1] = rsqrtf(skv * (1.f / 128.f) + EPS);
    }
    for (int e = gt; e < T * 128; e += NT) {
        const int t = e >> 7, ch = (e & 127) * 8, s = t & 2047;
        float acc[8];
        { const f32x4 b0 = *(const f32x4*)(cb + ch), b1 = *(const f32x4*)(cb + ch + 4); acc[0] = b0.x; acc[1] = b0.y; acc[2] = b0.z; acc[3] = b0.w; acc[4] = b1.x; acc[5] = b1.y; acc[6] = b1.z; acc[7] = b1.w; }
#pragma unroll
        for (int j = 0; j < 4; ++j) {
            if (s - 3 + j >= 0) {
                float v[8]; unpack8(*(const u32x4*)(lx + (size_t)(t - 3 + j) * 1024 + ch), v);
                const f32x4 w0 = *(const f32x4*)(cw + j * 1024 + ch), w1 = *(const f32x4*)(cw + j * 1024 + ch + 4);
                acc[0] += w0.x * v[0]; acc[1] += w0.y * v[1]; acc[2] += w0.z * v[2]; acc[3] += w0.w * v[3];
                acc[4] += w1.x * v[4]; acc[5] += w1.y * v[5]; acc[6] += w1.z * v[6]; acc[7] += w1.w * v[7];
            }
        }
        *(u32x4*)(xc + (size_t)t * 1024 + ch) = pack8(acc);
    }
}

__device__ __forceinline__ void phase_scan(const Ctx& c0) {
    Ctx c = c0; c.lane = lane_id_v(); c.tid = c.wave * 64 + c.lane;
    const bf16_t* LA = WSP(bf16_t, WS_R0); bf16_t* Bv = WSP(bf16_t, WS_R6); const bf16_t* gate = WSP(bf16_t, WS_R3);
    LAS float* Ps = (LAS float*)c.lds; LAS float* Hs = Ps + 512;
    for (int it = c.vcu; it < 256; it += c.G) {
        const int b = it >> 4, cg = it & 15, seg = c.tid >> 6, ch = cg * 64 + (c.tid & 63);
        const size_t base = ((size_t)b * 2048 + seg * 256) * 1024 + ch;
        float P = 1.f, Hl = 0.f;
#pragma unroll 8
        for (int i = 0; i < 256; ++i) { const float a = __builtin_amdgcn_exp2f(bf2f(LA[base + (size_t)i * 1024])); const float bb = bf2f(Bv[base + (size_t)i * 1024]); Hl = a * Hl + bb; P *= a; }
        Ps[c.tid] = P; Hs[c.tid] = Hl;
        __syncthreads();
        float h = 0.f;
        for (int s2 = 0; s2 < seg; ++s2) h = Ps[s2 * 64 + (c.tid & 63)] * h + Hs[s2 * 64 + (c.tid & 63)];
#pragma unroll 8
        for (int i = 0; i < 256; ++i) { const float a = __builtin_amdgcn_exp2f(bf2f(LA[base + (size_t)i * 1024])); const float bb = bf2f(Bv[base + (size_t)i * 1024]); h = a * h + bb;
            const float gv = bf2f(gate[base + (size_t)i * 1024]); Bv[base + (size_t)i * 1024] = (bf16_t)f2bf(h * gelu_tanh(gv)); }
        __syncthreads();
    }
}

__device__ __forceinline__ void phase_qkv_layout(const Ctx& c0) {
    Ctx c = c0; c.lane = lane_id_v(); c.tid = c.wave * 64 + c.lane;
    const bf16_t* qraw = WSP(bf16_t, WS_R5); const bf16_t* kvraw = WSP(bf16_t, WS_R2); const bf16_t* pa = WSP(bf16_t, WS_R1);
    bf16_t* Qh = WSP(bf16_t, WS_R4); bf16_t* Kh = WSP(bf16_t, WS_R3); bf16_t* Vh = WSP(bf16_t, WS_R0);
    const float* qng = c.in[I_QNG]; const float* kng = c.in[I_KNG]; const int* pos = (const int*)c.in[I_POS];
    const float qscale = 0.10206207261596577f * 1.4426950408889634f;
    const int gt = c.vcu * 512 + c.tid, NT = c.G * 512;
    for (int e = gt; e < T * H; e += NT) {
        const int t = e >> 3, h = e & 7, b = t >> 11, s = t & 2047;
        const float pf = (float)pos[t];
        const size_t orow = ((size_t)(b * H + h) * S + s);
        {
            const u32x4* p = (const u32x4*)(qraw + (size_t)t * 768 + h * 96);
            float ss = 0.f;
            for (int i = 0; i < 12; ++i) { float v[8]; unpack8(p[i], v);
#pragma unroll
                for (int j = 0; j < 8; ++j) ss += v[j] * v[j]; }
            const float r = rsqrtf(ss * (1.f / 96.f) + EPS) * qscale;
            u32x4* o = (u32x4*)(Qh + orow * 96);
            for (int i = 0; i < 8; ++i) { float v[8]; unpack8(p[i], v);
#pragma unroll
                for (int j = 0; j < 8; ++j) v[j] = v[j] * r * qng[i * 8 + j];
                o[i] = pack8(v); }
            for (int i = 0; i < 2; ++i) { float v1[8], v2[8], o1[8], o2[8]; unpack8(p[8 + i], v1); unpack8(p[10 + i], v2);
#pragma unroll
                for (int j = 0; j < 8; ++j) { const int jj = i * 8 + j;
                    const float invf = exp2f(-(float)jj * (13.287712379549449f / 16.f));
                    const float ang = pf * invf; const float n = rintf(ang * 0.15915494309189535f);
                    const float red = (float)((double)ang - (double)n * 6.283185307179586);
                    const float cs = __cosf(red), sn = __sinf(red);
                    const float t1 = v1[j] * r * qng[64 + jj], t2 = v2[j] * r * qng[80 + jj];
                    o1[j] = t1 * cs - t2 * sn; o2[j] = t1 * sn + t2 * cs; }
                o[8 + i] = pack8(o1); o[10 + i] = pack8(o2); }
        }
        {
            const u32x4* pn = (const u32x4*)(kvraw + (size_t)t * 1024 + h * 128);
            const u32x4* pr = (const u32x4*)(pa + (size_t)t * 512 + 384);
            float ss = 0.f;
            for (int i = 0; i < 8; ++i) { float v[8]; unpack8(pn[i], v);
#pragma unroll
                for (int j = 0; j < 8; ++j) ss += v[j] * v[j]; }
            for (int i = 0; i < 4; ++i) { float v[8]; unpack8(pr[i], v);
#pragma unroll
                for (int j = 0; j < 8; ++j) ss += v[j] * v[j]; }
            const float r = rsqrtf(ss * (1.f / 96.f) + EPS);
            u32x4* o = (u32x4*)(Kh + orow * 96);
            for (int i = 0; i < 8; ++i) { float v[8]; unpack8(pn[i], v);
#pragma unroll
                for (int j = 0; j < 8; ++j) v[j] = v[j] * r * kng[i * 8 + j];
                o[i] = pack8(v); }
            for (int i = 0; i < 2; ++i) { float v1[8], v2[8], o1[8], o2[8]; unpack8(pr[i], v1); unpack8(pr[2 + i], v2);
#pragma unroll
                for (int j = 0; j < 8; ++j) { const int jj = i * 8 + j;
                    const float invf = exp2f(-(float)jj * (13.287712379549449f / 16.f));
                    const float ang = pf * invf; const float n = rintf(ang * 0.15915494309189535f);
                    const float red = (float)((double)ang - (double)n * 6.283185307179586);
                    const float cs = __cosf(red), sn = __sinf(red);
                    const float t1 = v1[j] * r * kng[64 + jj], t2 = v2[j] * r * kng[80 + jj];
                    o1[j] = t1 * cs - t2 * sn; o2[j] = t1 * sn + t2 * cs; }
                o[8 + i] = pack8(o1); o[10 + i] = pack8(o2); }
            u32x4* ov = (u32x4*)(Vh + orow * 64);
            for (int i = 0; i < 8; ++i) ov[i] = pn[8 + i];
        }
    }
}

constexpr int KROW = 208, VROW = 160;
constexpr int KBUF = 128 * KROW, VBUF = 128 * VROW;
typedef short v4i16_t __attribute__((ext_vector_type(4)));
__device__ __forceinline__ void attn_chunk(LAS unsigned char* kb, LAS unsigned char* vb, const bf16x8 (&qf)[3], f32x4 (&o)[4], float& mrun, float& lrun, int fr, int g) {
    f32x4 sacc[4];
#pragma unroll
    for (int kt = 0; kt < 4; ++kt) { sacc[kt] = (f32x4){0.f, 0.f, 0.f, 0.f};
#pragma unroll
        for (int ks = 0; ks < 3; ++ks) { const bf16x8 kf = *(const LAS bf16x8*)(kb + (16 * kt + fr) * KROW + (ks * 32 + g * 8) * 2);
            sacc[kt] = __builtin_amdgcn_mfma_f32_16x16x32_bf16(kf, qf[ks], sacc[kt], 0, 0, 0); } }
    float mx = sacc[0][0];
#pragma unroll
    for (int kt = 0; kt < 4; ++kt)
#pragma unroll
        for (int r = 0; r < 4; ++r) mx = fmaxf(mx, sacc[kt][r]);
    mx = fmaxf(mx, __shfl_xor(mx, 16)); mx = fmaxf(mx, __shfl_xor(mx, 32));
    const float mnew = fmaxf(mrun, mx), alpha = __builtin_amdgcn_exp2f(mrun - mnew); mrun = mnew;
    float ps = 0.f;
#pragma unroll
    for (int kt = 0; kt < 4; ++kt)
#pragma unroll
        for (int r = 0; r < 4; ++r) { const float p = __builtin_amdgcn_exp2f(sacc[kt][r] - mnew); sacc[kt][r] = p; ps += p; }
    lrun = lrun * alpha + ps;
#pragma unroll
    for (int dt = 0; dt < 4; ++dt) o[dt] = o[dt] * alpha;
#pragma unroll
    for (int s2 = 0; s2 < 2; ++s2) {
        u32x4 pw; pw.x = pk2(sacc[2 * s2][0], sacc[2 * s2][1]); pw.y = pk2(sacc[2 * s2][2], sacc[2 * s2][3]); pw.z = pk2(sacc[2 * s2 + 1][0], sacc[2 * s2 + 1][1]); pw.w = pk2(sacc[2 * s2 + 1][2], sacc[2 * s2 + 1][3]);
        const bf16x8 pb = __builtin_bit_cast(bf16x8, pw);
#pragma unroll
        for (int dt = 0; dt < 4; ++dt) {
            LAS unsigned char* va = vb + (32 * s2 + 4 * g + (fr >> 2)) * VROW + (16 * dt + 4 * (fr & 3)) * 2;
            const v4i16_t t0 = __builtin_amdgcn_ds_read_tr16_b64_v4i16((LAS v4i16_t*)va), t1 = __builtin_amdgcn_ds_read_tr16_b64_v4i16((LAS v4i16_t*)(va + 16 * VROW));
            const bf16x8 vf = (bf16x8){t0[0], t0[1], t0[2], t0[3], t1[0], t1[1], t1[2], t1[3]};
            o[dt] = __builtin_amdgcn_mfma_f32_16x16x32_bf16(vf, pb, o[dt], 0, 0, 0); }
    }
}
__device__ __forceinline__ void attn_unit(const Ctx& c, int b, int h, int qb) {
    const bf16_t* Qh = WSP(bf16_t, WS_R4); const bf16_t* Kh = WSP(bf16_t, WS_R3); const bf16_t* Vh = WSP(bf16_t, WS_R0); bf16_t* AO = WSP(bf16_t, WS_R0 + 32 * MiB);
    const int fr = c.lane & 15, g = c.lane >> 4, wid = c.wave;
    const size_t hb = (size_t)(b * H + h) * S;
    const int q0 = qb * 128 + wid * 16;
    const int nsup = qb + 1;
    bf16x8 qf[3];
#pragma unroll
    for (int ks = 0; ks < 3; ++ks) qf[ks] = *(const bf16x8*)(Qh + (hb + q0 + fr) * 96 + ks * 32 + g * 8);
    f32x4 o[4];
#pragma unroll
    for (int dt = 0; dt < 4; ++dt) o[dt] = (f32x4){0.f, 0.f, 0.f, 0.f};
    float mrun = -1e30f, lrun = 0.f;
    u32x4 kr[3], vr[2];
    const u32x4* Ksrc = (const u32x4*)(Kh + hb * 96); const u32x4* Vsrc = (const u32x4*)(Vh + hb * 64);
#pragma unroll
    for (int i = 0; i < 3; ++i) kr[i] = Ksrc[c.tid + 512 * i];
#pragma unroll
    for (int i = 0; i < 2; ++i) vr[i] = Vsrc[c.tid + 512 * i];
    for (int j = 0; j < nsup; ++j) {
        LAS unsigned char* kb = c.lds + (j & 1) * (KBUF + VBUF); LAS unsigned char* vb = kb + KBUF;
#pragma unroll
        for (int i = 0; i < 3; ++i) { const int kc = c.tid + 512 * i; *(LAS u32x4*)(kb + (kc / 12) * KROW + (kc % 12) * 16) = kr[i]; }
#pragma unroll
        for (int i = 0; i < 2; ++i) { const int vc = c.tid + 512 * i; *(LAS u32x4*)(vb + (vc >> 3) * VROW + (vc & 7) * 16) = vr[i]; }
        __syncthreads();
        if (j + 1 < nsup) {
#pragma unroll
            for (int i = 0; i < 3; ++i) kr[i] = Ksrc[(j + 1) * 1536 + c.tid + 512 * i];
#pragma unroll
            for (int i = 0; i < 2; ++i) vr[i] = Vsrc[(j + 1) * 1024 + c.tid + 512 * i];
        }
        attn_chunk(kb, vb, qf, o, mrun, lrun, fr, g);
        if (j + 1 < nsup || wid >= 4) attn_chunk(kb + 64 * KROW, vb + 64 * VROW, qf, o, mrun, lrun, fr, g);
    }
    float lt = lrun + __shfl_xor(lrun, 16); lt += __shfl_xor(lt, 32);
    const float inv = 1.f / lt;
    bf16_t* orow = AO + ((size_t)b * S + q0 + fr) * 512 + h * 64;
#pragma unroll
    for (int dt = 0; dt < 4; ++dt) { u32x2 w; w.x = pk2(o[dt][0] * inv, o[dt][1] * inv); w.y = pk2(o[dt][2] * inv, o[dt][3] * inv); *(u32x2*)(orow + 16 * dt + 4 * g) = w; }
    __syncthreads();
}
__device__ __forceinline__ void phase_attn(const Ctx& c0) {
    Ctx c = c0; c.lane = lane_id_v(); c.tid = c.wave * 64 + c.lane;
    for (int v = c.vcu; v < 256; v += c.G) {
        const int bh = v >> 1, odd = v & 1;
        for (int i = 0; i < 8; ++i) {
            const int setA[8] = {15, 12, 10, 9, 6, 5, 3, 0}, setB[8] = {14, 13, 11, 8, 7, 4, 2, 1};
            int qb = 0;
#pragma unroll
            for (int k = 0; k < 8; ++k) if (k == i) qb = odd ? setB[k] : setA[k];
            attn_unit(c, bh >> 3, bh & 7, qb);
        }
    }
}

__device__ __forceinline__ float wave_max(float v) {
#pragma unroll
    for (int o = 1; o < 64; o <<= 1) v = fmaxf(v, __shfl_xor(v, o));
    return v;
}
__device__ __forceinline__ int wave_min_i(int v) {
#pragma unroll
    for (int o = 1; o < 64; o <<= 1) v = min(v, __shfl_xor(v, o));
    return v;
}
__device__ __forceinline__ int prefix_cnt(unsigned long long m) { return (int)__builtin_amdgcn_mbcnt_hi((unsigned)(m >> 32), __builtin_amdgcn_mbcnt_lo((unsigned)m, 0u)); }
template <int NV, int NBITS> __device__ __forceinline__ void select16(const unsigned (&key)[NV], int (&slot)[NV]) {
    unsigned tau = 0u;
    for (int bit = NBITS - 1; bit >= 0; --bit) {
        const unsigned trial = tau | (1u << bit); int cnt = 0;
#pragma unroll
        for (int j = 0; j < NV; ++j) cnt += __popcll(__ballot(key[j] >= trial));
        if (cnt >= 16) { tau = trial; if (cnt == 16) break; }
    }
    int base = 0;
#pragma unroll
    for (int j = 0; j < NV; ++j) { const unsigned long long m = __ballot(key[j] > tau); slot[j] = (key[j] > tau) ? base + prefix_cnt(m) : -1; base += __popcll(m); }
#pragma unroll
    for (int j = 0; j < NV; ++j) { const unsigned long long m = __ballot(key[j] == tau); if (key[j] == tau) { const int s = base + prefix_cnt(m); slot[j] = s < 16 ? s : -1; } base += __popcll(m); }
}
template <int N> __device__ __forceinline__ void bitonic_stage_desc(unsigned (&x)[N], int k, int j) {
#pragma unroll
    for (int i = 0; i < N; ++i) { const int l = i ^ j; if (l > i) { const bool asc = ((i & k) != 0);
        const unsigned a = x[i], b = x[l]; const unsigned hi = a > b ? a : b, lo = a > b ? b : a; x[i] = asc ? lo : hi; x[l] = asc ? hi : lo; } }
}
__device__ __forceinline__ void sort16_desc(unsigned (&x)[16]) {
#pragma unroll
    for (int k = 2; k <= 16; k <<= 1)
#pragma unroll
        for (int j = k >> 1; j > 0; j >>= 1) bitonic_stage_desc<16>(x, k, j);
}
__device__ __forceinline__ void merge16_desc(unsigned (&run)[16], const unsigned (&ch)[16]) {
#pragma unroll
    for (int i = 0; i < 16; ++i) run[i] = run[i] > ch[15 - i] ? run[i] : ch[15 - i];
#pragma unroll
    for (int j = 8; j > 0; j >>= 1) bitonic_stage_desc<16>(run, 16, j);
}
__device__ __forceinline__ unsigned mono_hi(unsigned w) { return w ^ ((unsigned)((int)w >> 31) | 0x80000000u); }
__device__ __forceinline__ float demono_hi(unsigned k) { const unsigned kk = k & 0xffff0000u; return __builtin_bit_cast(float, (kk ^ ((unsigned)(~(int)kk >> 31) | 0x80000000u)) & 0xffff0000u); }
__device__ __forceinline__ void top16_list(const bf16_t* s, unsigned (&run)[16]) {
#pragma unroll
    for (int ck = 0; ck < 8; ++ck) {
        const u32x4 w0 = *(const u32x4*)(s + ck * 16), w1 = *(const u32x4*)(s + ck * 16 + 8);
        const unsigned w[8] = {w0.x, w0.y, w0.z, w0.w, w1.x, w1.y, w1.z, w1.w};
        unsigned ch[16];
#pragma unroll
        for (int i = 0; i < 8; ++i) { ch[2 * i] = (mono_hi(w[i] << 16) & 0xffff0000u) | (unsigned)(ck * 16 + 2 * i); ch[2 * i + 1] = (mono_hi(w[i]) & 0xffff0000u) | (unsigned)(ck * 16 + 2 * i + 1); }
        sort16_desc(ch);
        if (ck == 0) {
#pragma unroll
            for (int i = 0; i < 16; ++i) run[i] = ch[i];
        } else merge16_desc(run, ch);
    }
}
__device__ __forceinline__ void phase_topk(const Ctx& c0) {
    Ctx c = c0; c.lane = lane_id_v(); c.tid = c.wave * 64 + c.lane;
    const bf16_t* sc = WSP(bf16_t, WS_SC); int* IDX = WSP(int, WS_IDX); float* GW = WSP(float, WS_GW);
    const int gl = (c.vcu * 8 + c.wave) * 64 + c.lane, NL = c.G * 512;
    for (int e = gl; e < T * H; e += NL) {
        unsigned ka[16], kb[16];
        top16_list(sc + (size_t)e * 256, ka);
        top16_list(sc + (size_t)e * 256 + 128, kb);
        float sa[16], sb[16]; unsigned ia[16], ib[16];
#pragma unroll
        for (int i = 0; i < 16; ++i) { sa[i] = demono_hi(ka[i]); sb[i] = demono_hi(kb[i]); ia[i] = (ka[i] & 0x7fu) << 7; ib[i] = kb[i] & 0x7fu; }
        const float mx = sa[0] + sb[0];
        unsigned run[16], ch[16]; int n = 0, nc = 0;
#pragma unroll
        for (int a = 0; a < 16; ++a)
#pragma unroll
            for (int b = 0; b < 16; ++b) if ((a + 1) * (b + 1) <= 16) {
                const int k = 65535 + (int)((sa[a] + sb[b] - mx) * 1024.f);
                ch[n] = ((unsigned)(k < 0 ? 0 : k) << 16) | ia[a] | ib[b];
                if (++n == 16) { sort16_desc(ch); if (nc == 0) {
#pragma unroll
                        for (int i = 0; i < 16; ++i) run[i] = ch[i]; } else merge16_desc(run, ch);
                    n = 0; ++nc; }
            }
#pragma unroll
        for (int i = 2; i < 16; ++i) ch[i] = 0u;
        sort16_desc(ch); merge16_desc(run, ch);
        float ex[16]; float sum = 0.f;
#pragma unroll
        for (int i = 0; i < 16; ++i) { ex[i] = __expf((float)((int)(run[i] >> 16) - 65535) * (1.f / 1024.f)); sum += ex[i]; }
        const float inv = 1.f / sum;
        u32x4* oi = (u32x4*)(IDX + (size_t)e * 16); f32x4* og = (f32x4*)(GW + (size_t)e * 16);
#pragma unroll
        for (int q = 0; q < 4; ++q) { u32x4 vi; vi.x = run[4 * q] & 0x3fffu; vi.y = run[4 * q + 1] & 0x3fffu; vi.z = run[4 * q + 2] & 0x3fffu; vi.w = run[4 * q + 3] & 0x3fffu; oi[q] = vi;
            f32x4 vg; vg.x = ex[4 * q] * inv; vg.y = ex[4 * q + 1] * inv; vg.z = ex[4 * q + 2] * inv; vg.w = ex[4 * q + 3] * inv; og[q] = vg; }
    }
}

__device__ __forceinline__ void dec16_fp8(const u32x4 r, float (&f)[16]) {
    const unsigned w[4] = {r.x, r.y, r.z, r.w};
#pragma unroll
    for (int i = 0; i < 4; ++i) { const f32x2 lo = __builtin_amdgcn_cvt_pk_f32_fp8((int)w[i], false), hi = __builtin_amdgcn_cvt_pk_f32_fp8((int)w[i], true);
        f[4 * i] = lo.x; f[4 * i + 1] = lo.y; f[4 * i + 2] = hi.x; f[4 * i + 3] = hi.y; }
}
__device__ __forceinline__ void phase_peer_u(const Ctx& c0) {
    Ctx c = c0; c.lane = lane_id_v(); c.tid = c.wave * 64 + c.lane;
    const bf16_t* h2 = WSP(bf16_t, WS_R0); const int* IDX = WSP(int, WS_IDX);
    const int L = c.lane, p = blockIdx.x & 7, rank = blockIdx.x >> 3, nrank = (c.G + 7 - p) >> 3;
    const int np = c.G < 8 ? c.G : 8;
    const bool b2 = L & 4, b1 = L & 2, b0 = L & 1;
    LAS int* mb = (LAS int*)(c.lds + c.wave * 1024);
    const int kl = L >> 3;
    for (int pp = p; pp < 8; pp += np) {
        const unsigned char* EU8b = c.ws + WS_EU + (size_t)pp * NE * 128;
        float* PD = WSP(float, WS_PD) + (size_t)pp * T * 128;
        const int t0 = rank * 8 + c.wave, ts = nrank * 8;
        if (t0 >= T) continue;
        { const int g0 = IDX[(size_t)t0 * 128 + L], g1 = IDX[(size_t)t0 * 128 + 64 + L]; mb[L] = g0; mb[64 + L] = g1; }
        u32x4 rA[8], rB[8];
        { const unsigned char* EU8 = EU8b + (L & 7) * 16;
#pragma unroll
        for (int i = 0; i < 8; ++i) rA[i] = *(const u32x4*)(EU8 + (size_t)mb[8 * i + kl] * 128); }
        int cur = 0;
#pragma unroll 1
        for (int t = t0; t < T; t += ts) {
            int lo16 = (L & 7) * 16; asm volatile("" : "+v"(lo16)); const unsigned char* EU8 = EU8b + lo16;
            const int tn = (t + ts < T) ? t + ts : t;
            const int gn0 = IDX[(size_t)tn * 128 + L], gn1 = IDX[(size_t)tn * 128 + 64 + L];
            float hv[16];
            { const u32x4* ph = (const u32x4*)(h2 + (size_t)t * 1024 + pp * 128 + (L & 7) * 16); float a[8], b[8]; unpack8(ph[0], a); unpack8(ph[1], b);
#pragma unroll
              for (int j = 0; j < 8; ++j) { hv[j] = a[j]; hv[8 + j] = b[j]; } }
#pragma unroll
            for (int i = 0; i < 8; ++i) rB[i] = *(const u32x4*)(EU8 + (size_t)mb[cur * 128 + 64 + 8 * i + kl] * 128);
            float d[16];
#pragma unroll
            for (int i = 0; i < 8; ++i) { float f[16]; dec16_fp8(rA[i], f); float s = 0.f;
#pragma unroll
                for (int j = 0; j < 16; ++j) s += hv[j] * f[j];
                d[i] = s; }
            mb[(cur ^ 1) * 128 + L] = gn0; mb[(cur ^ 1) * 128 + 64 + L] = gn1;
#pragma unroll
            for (int i = 0; i < 8; ++i) rA[i] = *(const u32x4*)(EU8 + (size_t)mb[(cur ^ 1) * 128 + 8 * i + kl] * 128);
#pragma unroll
            for (int i = 0; i < 8; ++i) { float f[16]; dec16_fp8(rB[i], f); float s = 0.f;
#pragma unroll
                for (int j = 0; j < 16; ++j) s += hv[j] * f[j];
                d[8 + i] = s; }
            float n8[8], n4[4], n2[2];
#pragma unroll
            for (int i = 0; i < 8; ++i) { const float send = b2 ? d[i] : d[i + 8], keep = b2 ? d[i + 8] : d[i]; n8[i] = keep + __shfl_xor(send, 4); }
#pragma unroll
            for (int i = 0; i < 4; ++i) { const float send = b1 ? n8[i] : n8[i + 4], keep = b1 ? n8[i + 4] : n8[i]; n4[i] = keep + __shfl_xor(send, 2); }
#pragma unroll
            for (int i = 0; i < 2; ++i) { const float send = b0 ? n4[i] : n4[i + 2], keep = b0 ? n4[i + 2] : n4[i]; n2[i] = keep + __shfl_xor(send, 1); }
            const int i0 = (b2 ? 8 : 0) + (b1 ? 4 : 0) + (b0 ? 2 : 0);
            PD[(size_t)t * 128 + 8 * i0 + kl] = n2[0]; PD[(size_t)t * 128 + 8 * (i0 + 1) + kl] = n2[1];
            cur ^= 1;
        }
    }
}
__device__ __forceinline__ void phase_peer_fin(const Ctx& c0) {
    Ctx c = c0; c.lane = lane_id_v(); c.tid = c.wave * 64 + c.lane;
    const int* IDX = WSP(int, WS_IDX); const float* GW = WSP(float, WS_GW); const float* PD = WSP(float, WS_PD); unsigned* WGT = WSP(unsigned, WS_WGT);
    const float* SU = WSP(float, WS_SU); const float* SV = WSP(float, WS_SV); const float* SH = WSP(float, WS_SH);
    for (int i = c.vcu * 512 + c.tid; i < T * 128; i += c.G * 512) {
        float d = 0.f;
#pragma unroll
        for (int p = 0; p < 8; ++p) d += PD[(size_t)p * T * 128 + i];
        const int e = IDX[i];
        WGT[i] = (f2bf(GW[i] * gelu_tanh(d * SU[e]) * SV[e]) << 16) | (unsigned)e;
    }
}
template <bool DRY> __device__ __forceinline__ void phase_peer_v(const Ctx& c0) {
    Ctx c = c0; c.lane = lane_id_v(); c.tid = c.wave * 64 + c.lane;
    const unsigned* WI = WSP(unsigned, WS_WGT); const float* mod = WSP(float, WS_MOD);
    const int L = c.lane, p = blockIdx.x & 7, rank = blockIdx.x >> 3, nrank = (c.G + 7 - p) >> 3;
    const int np = c.G < 8 ? c.G : 8;
    const bool b5 = L & 32, b4 = L & 16, b3 = L & 8;
    LAS unsigned* mb = (LAS unsigned*)(c.lds + c.wave * 1024);
    const int kl = L >> 3;
    for (int pp = p; pp < 8; pp += np) {
        const unsigned char* EV8 = c.ws + WS_EV + (size_t)pp * NE * 128 + (L & 7) * 16;
        const int col = pp * 128 + (L & 7) * 16 + (b5 ? 8 : 0) + (b4 ? 4 : 0) + (b3 ? 2 : 0);
        const int t0 = rank * 8 + c.wave, ts = nrank * 8;
        if (t0 >= T) continue;
        { const unsigned g0 = WI[(size_t)t0 * 128 + L], g1 = WI[(size_t)t0 * 128 + 64 + L]; mb[L] = g0; mb[64 + L] = g1; }
        u32x4 rA[8], rB[8];
#pragma unroll
        for (int i = 0; i < 8; ++i) rA[i] = *(const u32x4*)(EV8 + (size_t)(mb[8 * i + kl] & 0xffffu) * 128);
        int cur = 0;
#pragma unroll 1
        for (int t = t0; t < T; t += ts) {
            const int tn = (t + ts < T) ? t + ts : t;
            const unsigned gn0 = WI[(size_t)tn * 128 + L], gn1 = WI[(size_t)tn * 128 + 64 + L];
            float* o = c.out + (size_t)t * 1024 + col; const float* g2 = mod + (t >> 11) * 6144 + 5120 + col;
            f32x2 xo = *(const f32x2*)o; const f32x2 gt = *(const f32x2*)g2;
#pragma unroll
            for (int i = 0; i < 8; ++i) rB[i] = *(const u32x4*)(EV8 + (size_t)(mb[cur * 128 + 64 + 8 * i + kl] & 0xffffu) * 128);
            f32x2 ac2[8];
#pragma unroll
            for (int j = 0; j < 8; ++j) ac2[j] = (f32x2){0.f, 0.f};
#pragma unroll
            for (int i = 0; i < 8; ++i) { const float w = bfhi(mb[cur * 128 + 8 * i + kl]); const f32x2 w2 = {w, w}; const unsigned ww[4] = {rA[i].x, rA[i].y, rA[i].z, rA[i].w};
#pragma unroll
                for (int d = 0; d < 4; ++d) { ac2[2 * d] = ac2[2 * d] + __builtin_amdgcn_cvt_pk_f32_fp8((int)ww[d], false) * w2; ac2[2 * d + 1] = ac2[2 * d + 1] + __builtin_amdgcn_cvt_pk_f32_fp8((int)ww[d], true) * w2; }
                }
            mb[(cur ^ 1) * 128 + L] = gn0; mb[(cur ^ 1) * 128 + 64 + L] = gn1;
#pragma unroll
            for (int i = 0; i < 8; ++i) rA[i] = *(const u32x4*)(EV8 + (size_t)(mb[(cur ^ 1) * 128 + 8 * i + kl] & 0xffffu) * 128);
#pragma unroll
            for (int i = 0; i < 8; ++i) { const float w = bfhi(mb[cur * 128 + 64 + 8 * i + kl]); const f32x2 w2 = {w, w}; const unsigned ww[4] = {rB[i].x, rB[i].y, rB[i].z, rB[i].w};
#pragma unroll
                for (int d = 0; d < 4; ++d) { ac2[2 * d] = ac2[2 * d] + __builtin_amdgcn_cvt_pk_f32_fp8((int)ww[d], false) * w2; ac2[2 * d + 1] = ac2[2 * d + 1] + __builtin_amdgcn_cvt_pk_f32_fp8((int)ww[d], true) * w2; }
                }
            float acc[16];
#pragma unroll
            for (int j = 0; j < 8; ++j) { acc[2 * j] = ac2[j].x; acc[2 * j + 1] = ac2[j].y; }
            float n8[8], n4[4], n2[2];
#pragma unroll
            for (int i = 0; i < 8; ++i) { const float send = b5 ? acc[i] : acc[i + 8], keep = b5 ? acc[i + 8] : acc[i]; n8[i] = keep + __shfl_xor(send, 32); }
#pragma unroll
            for (int i = 0; i < 4; ++i) { const float send = b4 ? n8[i] : n8[i + 4], keep = b4 ? n8[i + 4] : n8[i]; n4[i] = keep + __shfl_xor(send, 16); }
#pragma unroll
            for (int i = 0; i < 2; ++i) { const float send = b3 ? n4[i] : n4[i + 2], keep = b3 ? n4[i + 2] : n4[i]; n2[i] = keep + __shfl_xor(send, 8); }
            xo.x += gt.x * n2[0]; xo.y += gt.y * n2[1];
            if (DRY) asm volatile("" :: "v"(xo.x), "v"(xo.y)); else *(f32x2*)o = xo;
            cur ^= 1;
        }
    }
}

struct FInProj { bf16_t *pa, *lx, *lg, *mg;
    __device__ __forceinline__ void operator()(int row, int pn, int cc, const float (&v0)[8], const float (&v1)[8]) const {
        bf16_t* d;
        if (pn < 2) d = pa + (size_t)row * 512 + pn * 256 + cc; else if (pn < 6) d = lx + (size_t)row * 1024 + (pn - 2) * 256 + cc;
        else if (pn < 10) d = lg + (size_t)row * 1024 + (pn - 6) * 256 + cc; else d = mg + (size_t)row * 2048 + (pn - 10) * 256 + cc;
        *(u32x4*)d = pack8(v0); *(u32x4*)(d + 128) = pack8(v1); } };
struct FRowScale { bf16_t* dst; int ldc; const float* rstd; int which;
    __device__ __forceinline__ void operator()(int row, int pn, int cc, const float (&v0)[8], const float (&v1)[8]) const {
        const float r = rstd[2 * row + which]; float a[8], b[8];
#pragma unroll
        for (int j = 0; j < 8; ++j) { a[j] = v0[j] * r; b[j] = v1[j] * r; }
        *(u32x4*)(dst + (size_t)row * ldc + pn * 256 + cc) = pack8(a); *(u32x4*)(dst + (size_t)row * ldc + pn * 256 + 128 + cc) = pack8(b); } };
struct FGates { const bf16_t* xc; bf16_t *LA, *Bv; const float *brg, *big, *c8sp;
    __device__ __forceinline__ void operator()(int row, int pn, int cc, const float (&v0)[8], const float (&v1)[8]) const {
        const int ch = pn * 128 + cc; float x[8], la[8], bv[8]; unpack8(*(const u32x4*)(xc + (size_t)row * 1024 + ch), x);
#pragma unroll
        for (int j = 0; j < 8; ++j) {
            const float r = __builtin_amdgcn_rcpf(1.f + __expf(-(v0[j] + brg[ch + j]))), ig = __builtin_amdgcn_rcpf(1.f + __expf(-(v1[j] + big[ch + j])));
            const float loga = r * c8sp[ch + j];
            const float z = 2.f * loga;
            const float ser = -z * (1.f + z * (0.5f + z * (0.16666667f + z * (0.041666668f + z * (0.008333334f + z * 0.0013888889f)))));
            const float om = (z > -0.25f) ? ser : (1.f - __expf(z));
            la[j] = loga * 1.4426950408889634f;
            bv[j] = sqrtf(om) * (ig * x[j]);
        }
        *(u32x4*)(LA + (size_t)row * 1024 + ch) = pack8(la); *(u32x4*)(Bv + (size_t)row * 1024 + ch) = pack8(bv); } };
struct FY1 { const bf16_t* mg; bf16_t* y; int goff; bool accum;
    __device__ __forceinline__ void one(int row, int col, const float (&v)[8]) const {
        float gt[8], o[8]; unpack8(*(const u32x4*)(mg + (size_t)row * 2048 + goff + col), gt);
        if (accum) unpack8(*(const u32x4*)(y + (size_t)row * 1024 + col), o);
#pragma unroll
        for (int j = 0; j < 8; ++j) o[j] = (accum ? o[j] : 0.f) + sigmoidf_(gt[j]) * v[j];
        *(u32x4*)(y + (size_t)row * 1024 + col) = pack8(o); }
    __device__ __forceinline__ void operator()(int row, int pn, int cc, const float (&v0)[8], const float (&v1)[8]) const { one(row, pn * 256 + cc, v0); one(row, pn * 256 + 128 + cc, v1); } };
struct FX1 { const float* x; float* out; const float* mod;
    __device__ __forceinline__ void one(int row, int col, const float (&v)[8]) const {
        const float* g1 = mod + (row >> 11) * 6144 + 2048 + col; const float* xr = x + (size_t)row * 1024 + col; float* o = out + (size_t)row * 1024 + col;
        const f32x4 x0 = *(const f32x4*)xr, x1 = *(const f32x4*)(xr + 4), a0 = *(const f32x4*)g1, a1 = *(const f32x4*)(g1 + 4);
        f32x4 r0, r1; r0.x = x0.x + a0.x * v[0]; r0.y = x0.y + a0.y * v[1]; r0.z = x0.z + a0.z * v[2]; r0.w = x0.w + a0.w * v[3];
        r1.x = x1.x + a1.x * v[4]; r1.y = x1.y + a1.y * v[5]; r1.z = x1.z + a1.z * v[6]; r1.w = x1.w + a1.w * v[7];
        *(f32x4*)o = r0; *(f32x4*)(o + 4) = r1; }
    __device__ __forceinline__ void operator()(int row, int pn, int cc, const float (&v0)[8], const float (&v1)[8]) const { one(row, pn * 256 + cc, v0); one(row, pn * 256 + 128 + cc, v1); } };
struct FStore { bf16_t* dst; int ldc;
    __device__ __forceinline__ void operator()(int row, int pn, int cc, const float (&v0)[8], const float (&v1)[8]) const {
        *(u32x4*)(dst + (size_t)row * ldc + pn * 256 + cc) = pack8(v0); *(u32x4*)(dst + (size_t)row * ldc + pn * 256 + 128 + cc) = pack8(v1); } };

template <int M, int N, int K, int LDA, int ACS, class F> __device__ __forceinline__ void run_gemm(const Ctx& c, const bf16_t* A, const bf16_t* Bt, const F& f) {
    pg8::Gemm g{A, Bt}; pg8::StaticOrder<M, N> So; So.init(c.G, (int)blockIdx.x);
    pg8::EpiF<F> E{f};
    pg8::gemm_phase<K, LDA, ACS, pg8::EpiF<F>, pg8::StaticOrder<M, N>>((PG8_LAS unsigned char*)c.lds, g, So, E, c.wave * 64 + lane_id_v());
}

__global__ void __launch_bounds__(512, 2) mk_fwd(Args args) {
    extern __shared__ __attribute__((aligned(16))) unsigned char lds_raw[];
    Ctx c;
    c.lds = (LAS unsigned char*)lds_raw;
    c.wave = __builtin_amdgcn_readfirstlane(threadIdx.x >> 6); c.lane = lane_id_v(); c.tid = c.wave * 64 + c.lane;
    c.G = gridDim.x; { const int bx = blockIdx.x; c.vcu = (c.G % 8 == 0) ? (bx % 8) * (c.G / 8) + bx / 8 : bx; }
    c.in = args.in; c.out = args.out; c.ws = args.ws;
    volatile LAS unsigned* MISC = (volatile LAS unsigned*)(c.lds + MISC_OFF);
    if (c.tid < 32) MISC[c.tid] = 0u;
    __syncthreads();
    XcdBarrier bar; bar.bar = (unsigned*)(c.ws + WS_CTL) + 4096; bar.x = 0; bar.st = nullptr;
    if (args.ph_hi - args.ph_lo > 1) bar = xcd_barrier_post((unsigned*)(c.ws + WS_CTL) + 4096, MISC + 8);

    const int lo = args.ph_lo, hi = args.ph_hi;
#ifndef ONLYP
#define ONLYP -1
#endif
#define IN(k) (lo <= (k) && (k) < hi && (ONLYP < 0 || ONLYP == (k)))
#define SEAM(k) do { if ((k) + 1 < hi) xcd_barrier(bar, c.wave); } while (0)
#ifndef REPEAT_MASK
#define REPEAT_MASK 0
#endif
#define PHASE(k, ...) if (IN(k)) { c.lane = lane_id_v(); c.tid = c.wave * 64 + c.lane; { __VA_ARGS__ } if ((REPEAT_MASK >> (k)) & 1) { xcd_barrier(bar, c.wave); { __VA_ARGS__ } } SEAM(k); }
    PHASE(0, phase_prep(c);)
    PHASE(1, phase_modnorm<false>(c, c.in[I_X], c.in[I_N1G], 0, 1024, WSP(bf16_t, WS_R0));)
    PHASE(2, FInProj f{WSP(bf16_t, WS_R1), WSP(bf16_t, WS_R2), WSP(bf16_t, WS_R3), (bf16_t*)c.out};
             run_gemm<T, 4608, 1024, 1024, 0>(c, WSP(bf16_t, WS_R0), WSP(bf16_t, WS_WIN), f);)
    PHASE(3, phase_conv(c);)
    PHASE(4, { FRowScale fq{WSP(bf16_t, WS_R5), 768, WSP(float, WS_RSTD), 0};
               run_gemm<T, 768, 256, 512, 0>(c, WSP(bf16_t, WS_R1), WSP(bf16_t, WS_WUQ), fq); }
             { FGates fg{WSP(bf16_t, WS_R4), WSP(bf16_t, WS_R0), WSP(bf16_t, WS_R6), c.in[I_BRG], c.in[I_BIG], WSP(float, WS_C8SP)};
               run_gemm<T, 2048, 128, 1024, 128>(c, WSP(bf16_t, WS_R4), WSP(bf16_t, WS_WG), fg); })
    PHASE(5, { FRowScale fkv{WSP(bf16_t, WS_R2), 1024, WSP(float, WS_RSTD), 1};
               run_gemm<T, 1024, 128, 512, 0>(c, WSP(bf16_t, WS_R1) + 256, WSP(bf16_t, WS_WUKV), fkv); }
             phase_scan(c);)
    PHASE(6, phase_qkv_layout(c);)
    PHASE(7, phase_attn(c);)
    PHASE(8, { FY1 f1{(const bf16_t*)c.out, WSP(bf16_t, WS_R2), 0, false};
               run_gemm<T, 1024, 512, 512, 0>(c, WSP(bf16_t, WS_R0 + 32 * MiB), WSP(bf16_t, WS_WOA), f1); }
             { FY1 f2{(const bf16_t*)c.out, WSP(bf16_t, WS_R2), 1024, true};
               run_gemm<T, 1024, 1024, 1024, 0>(c, WSP(bf16_t, WS_R6), WSP(bf16_t, WS_WOL), f2); })
    PHASE(9, FX1 f{c.in[I_X], c.out, WSP(float, WS_MOD)};
             run_gemm<T, 1024, 1024, 1024, 0>(c, WSP(bf16_t, WS_R2), WSP(bf16_t, WS_WOUT), f);)
    PHASE(10, phase_modnorm<false>(c, c.out, c.in[I_N2G], 3072, 4096, WSP(bf16_t, WS_R0));)
    PHASE(11, FStore f{WSP(bf16_t, WS_QP), 2048};
              run_gemm<T, 2048, 1024, 1024, 0>(c, WSP(bf16_t, WS_R0), WSP(bf16_t, WS_WQ), f);)
    PHASE(12, FStore f{WSP(bf16_t, WS_SC), 2048};
              run_gemm<T, 2048, 256, 2048, 256>(c, WSP(bf16_t, WS_QP), WSP(bf16_t, WS_SK), f);)
    PHASE(13, phase_topk(c);)
    PHASE(14, phase_peer_u(c);)
    PHASE(15, phase_peer_fin(c);)
#ifdef PROBE_VDRY
    if (IN(16)) { c.lane = lane_id_v(); c.tid = c.wave * 64 + c.lane; phase_peer_v<true>(c); xcd_barrier(bar, c.wave); }
#endif
    PHASE(16, phase_peer_v<false>(c);)
#undef PHASE
#undef IN
#undef SEAM
}

extern "C" void kernel_launch(void* const* d_in, const int* in_sizes, int n_in, void* d_out, int out_size, void* d_ws, size_t ws_size, hipStream_t stream) {
    static int grid = 0;
    if (grid == 0) {
        if (n_in != 28 || out_size != T * D || ws_size < WS_END) { fprintf(stderr, "kernel_launch: unexpected shapes (n_in %d out %d ws %zu)\n", n_in, out_size, ws_size); grid = -1; return; }
        int dev = 0, cus = 0, per_cu = 0;
        if (hipGetDevice(&dev) != hipSuccess || hipDeviceGetAttribute(&cus, hipDeviceAttributeMultiprocessorCount, dev) != hipSuccess) { grid = -1; return; }
        if (hipFuncSetAttribute((const void*)mk_fwd, hipFuncAttributeMaxDynamicSharedMemorySize, LDS_BYTES) != hipSuccess) { fprintf(stderr, "kernel_launch: hipFuncSetAttribute failed\n"); grid = -1; return; }
        if (hipOccupancyMaxActiveBlocksPerMultiprocessor(&per_cu, (const void*)mk_fwd, 512, LDS_BYTES) != hipSuccess || per_cu < 1) { fprintf(stderr, "kernel_launch: occupancy query says %d blocks per CU\n", per_cu); grid = -1; (void)hipGetLastError(); return; }
        grid = cus;
    }
    if (grid < 0) return;
    (void)hipMemsetAsync((char*)d_ws + WS_CTL, 0, CTL_ZERO_BYTES, stream);
    Args a{};
    for (int i = 0; i < 28; ++i) a.in[i] = (const float*)d_in[i];
    a.out = (float*)d_out; a.ws = (unsigned char*)d_ws;
#if MK_N_LAUNCHES == 1
    a.ph_lo = 0; a.ph_hi = N_PHASES;
    hipLaunchKernelGGL(mk_fwd, dim3(grid), dim3(512), LDS_BYTES, stream, a);
#else
    for (int ph = 0; ph < N_PHASES; ++ph) { a.ph_lo = ph; a.ph_hi = ph + 1; hipLaunchKernelGGL(mk_fwd, dim3(grid), dim3(512), LDS_BYTES, stream, a); }
#endif
}
```

```cpp
#include <hip/hip_runtime.h>
#include <cstdio>
#include <cstdint>

#define LAS __attribute__((address_space(3)))
#define GAS __attribute__((address_space(1)))
typedef unsigned short bf16_t;
typedef short bf16x8 __attribute__((ext_vector_type(8)));
typedef float f32x4 __attribute__((ext_vector_type(4)));
typedef float f32x2 __attribute__((ext_vector_type(2)));
typedef unsigned u32x4 __attribute__((ext_vector_type(4)));
typedef unsigned u32x2 __attribute__((ext_vector_type(2)));

#ifndef MK_N_LAUNCHES
#define MK_N_LAUNCHES 1
#endif

constexpr int T = 32768, D = 1024, NB_ = 16, S = 2048, H = 8;
constexpr int QKH = 96, VH = 64;
constexpr int NE = 16384;
constexpr float EPS = 1e-6f;

constexpr size_t MiB = 1u << 20;
constexpr size_t WS_CTL = 0, CTL_ZERO_BYTES = 65536;
constexpr size_t WS_MOD = 1 * MiB;
constexpr size_t WS_RSTD = 1 * MiB + 512 * 1024;
constexpr size_t WS_C8SP = 1 * MiB + 448 * 1024;
constexpr size_t WS_WIN = 2 * MiB;
constexpr size_t WS_WUQ = 11 * MiB;
constexpr size_t WS_WUKV = 11 * MiB + 512 * 1024;
constexpr size_t WS_WOA = 12 * MiB;
constexpr size_t WS_WOL = 13 * MiB;
constexpr size_t WS_WOUT = 15 * MiB;
constexpr size_t WS_WQ = 17 * MiB;
constexpr size_t WS_WG = 21 * MiB;
constexpr size_t WS_SK = 22 * MiB;
constexpr size_t WS_EU = 24 * MiB;
constexpr size_t WS_EV = 40 * MiB;
constexpr size_t WS_SU = 1 * MiB + 768 * 1024;
constexpr size_t WS_SV = 1 * MiB + 832 * 1024;
constexpr size_t WS_WGT = 440 * MiB;
constexpr size_t WS_CS = 56 * MiB;
constexpr size_t WS_H2Q = 60 * MiB;
constexpr size_t WS_SH = 1 * MiB + 896 * 1024;
constexpr size_t WS_PD = 280 * MiB;
constexpr size_t WS_R0 = 88 * MiB;
constexpr size_t WS_R1 = 152 * MiB;
constexpr size_t WS_R2 = 184 * MiB;
constexpr size_t WS_R3 = 248 * MiB;
constexpr size_t WS_R4 = 312 * MiB;
constexpr size_t WS_R5 = 376 * MiB;
constexpr size_t WS_R6 = 424 * MiB;
constexpr size_t WS_QP = 152 * MiB;
constexpr size_t WS_SC = 280 * MiB;
constexpr size_t WS_IDX = 408 * MiB;
constexpr size_t WS_GW = 424 * MiB;
constexpr size_t WS_END = 488 * MiB;

constexpr int LDS_BYTES = 147456;
constexpr int MISC_OFF = 131072 + 320;

__device__ __forceinline__ unsigned f2bf(float f) { unsigned u = __builtin_bit_cast(unsigned, f); return (u + 0x7fffu + ((u >> 16) & 1u)) >> 16; }
typedef __bf16 bf16x2_t __attribute__((ext_vector_type(2)));
__device__ __forceinline__ unsigned pk2(float lo, float hi) { f32x2 v = {lo, hi}; return __builtin_bit_cast(unsigned, __builtin_convertvector(v, bf16x2_t)); }
__device__ __forceinline__ float bf2f(unsigned h) { return __builtin_bit_cast(float, h << 16); }
__device__ __forceinline__ float bflo(unsigned w) { return __builtin_bit_cast(float, w << 16); }
__device__ __forceinline__ float bfhi(unsigned w) { return __builtin_bit_cast(float, w & 0xffff0000u); }
__device__ __forceinline__ float sigmoidf_(float x) { return 1.f / (1.f + __expf(-x)); }
__device__ __forceinline__ float gelu_tanh(float x) {
    const float u = 0.7978845608028654f * (x + 0.044715f * x * x * x);
    const float e = __expf(2.f * u);
    const float th = 1.f - 2.f / (e + 1.f);
    return 0.5f * x * (1.f + th);
}
__device__ __forceinline__ int lane_id_v() { int l; asm volatile("v_mbcnt_lo_u32_b32 %0, -1, 0\n\tv_mbcnt_hi_u32_b32 %0, -1, %0" : "=v"(l)); return l; }
__device__ __forceinline__ float wave_sum(float v) {
#pragma unroll
    for (int o = 1; o < 64; o <<= 1) v += __shfl_xor(v, o);
    return v;
}
__device__ __forceinline__ void unpack8(const u32x4 w, float (&v)[8]) {
    v[0] = bflo(w.x); v[1] = bfhi(w.x); v[2] = bflo(w.y); v[3] = bfhi(w.y); v[4] = bflo(w.z); v[5] = bfhi(w.z); v[6] = bflo(w.w); v[7] = bfhi(w.w);
}
__device__ __forceinline__ u32x4 pack8(const float (&v)[8]) {
    u32x4 w; w.x = pk2(v[0], v[1]); w.y = pk2(v[2], v[3]); w.z = pk2(v[4], v[5]); w.w = pk2(v[6], v[7]); return w;
}

namespace pg8 {
#define PG8_LAS __attribute__((address_space(3)))
constexpr int BM = 256, BK = 64, HALF = 128, HTB = HALF * BK * 2, STAGE_BYTES = 8 * HTB, NXCD = 8, WGM = 8;
__host__ __device__ __forceinline__ int lds_byte(int r, int c) { const int st = (r >> 4) * 2 + (c >> 5), rr = r & 15, cc = c & 31, ob = rr * 64 + cc * 2; return st * 1024 + (ob ^ (((ob >> 9) & 1) << 5)); }
__host__ __device__ __forceinline__ void stage_rc(int b, int& R, int& C) { const int st = b / 1024, sb = b % 1024, swz = sb ^ (((sb >> 9) & 1) << 5); R = (st >> 1) * 16 + swz / 64; C = (st & 1) * 32 + (swz % 64) / 2; }
__host__ __device__ __forceinline__ int perm32(int rho) { const int n = rho >> 4, i = rho & 15; return 8 * (i >> 2) + 4 * n + (i & 3); }

struct Unit { int pm, pn; };
struct Gemm { const bf16_t* A; const bf16_t* Bt; };

template <int M_, int N_> struct StaticOrder {
    static constexpr int nM = M_ / BM, nN = N_ / BM, nwg = nM * nN;
    int G, c;
    __host__ __device__ void init(int G_, int c_) { G = G_; c = c_; }
    __host__ __device__ bool next(int i, Unit& u) const {
        const long L = (long)i * G + c; if (L >= nwg) return false;
        int wgid = (int)L; { const int q = nwg / NXCD, r = nwg % NXCD, xcd = wgid % NXCD, off = wgid / NXCD; wgid = (xcd < r ? xcd * (q + 1) : r * (q + 1) + (xcd - r) * q) + off; }
        const int nig = WGM * nN, gid = wgid / nig, fm = gid * WGM, gsz = (nM - fm) < WGM ? (nM - fm) : WGM;
        u.pm = fm + ((wgid % nig) % gsz); u.pn = (wgid % nig) / gsz; return true;
    }
};

template <class F> struct EpiF {
    static constexpr bool PERM = true;
    F f;
    __device__ __forceinline__ void operator()(const f32x4 (&acc)[2][2][4][2], const Unit& u, int wr, int wc, int fr, int fq) const {
        const int c = wc * 32 + 8 * fq;
#pragma unroll
        for (int ai = 0; ai < 2; ++ai)
#pragma unroll
            for (int m = 0; m < 4; ++m) {
                const int row = u.pm * BM + ai * HALF + wr * 64 + m * 16 + fr;
                float v0[8], v1[8];
#pragma unroll
                for (int j = 0; j < 4; ++j) { v0[j] = acc[ai][0][m][0][j]; v0[4 + j] = acc[ai][0][m][1][j]; v1[j] = acc[ai][1][m][0][j]; v1[4 + j] = acc[ai][1][m][1][j]; }
                f(row, u.pn, c, v0, v1);
            }
    }
};

template <int K, int LDA, int ACS, class Epi, class Sched>
__device__ __forceinline__ void gemm_phase(PG8_LAS unsigned char* lds, const Gemm g, const Sched& S, const Epi& E, const int tid) {
    const int wid = __builtin_amdgcn_readfirstlane(tid >> 6), lane = tid & 63, wr = wid >> 2, wc = wid & 3, fr = lane & 15, fq = lane >> 4;
    constexpr int nt = K / BK;
    unsigned voffA[2], voffB[2];
#pragma unroll
    for (int i = 0; i < 2; ++i) { int R, C; stage_rc(tid * 16 + i * 8192, R, C); const int Rb = Epi::PERM ? ((R & ~31) + perm32(R & 31)) : R;
        voffA[i] = (unsigned)(R * LDA + C) * 2u; voffB[i] = (unsigned)(Rb * K + C) * 2u; }
    constexpr size_t kstep = (size_t)(BK * 2);
    constexpr size_t hstepA = (size_t)HALF * LDA * 2, hstepB = (size_t)HALF * K * 2;
    constexpr size_t tstepA = 2 * hstepA, tstepB = 2 * hstepB;
    constexpr size_t acsb = (size_t)ACS * 2;
    const unsigned ldsw = (unsigned)wid * 1024u;
    const int aoff = lds_byte(wr * 64 + fr, fq * 8), boff = lds_byte(wc * 32 + fr, fq * 8);
#define PG8_SA(b, h) (((b) * 2 + (h)) * HTB)
#define PG8_SB(b, h) ((4 + (b) * 2 + (h)) * HTB)
#define PG8_STAGE(bufoff, gbase, voff) do { _Pragma("unroll") for (int _i = 0; _i < 2; ++_i) \
        __builtin_amdgcn_global_load_lds((const unsigned*)((const char*)(gbase) + (voff)[_i]), (PG8_LAS unsigned*)(lds + (bufoff) + ldsw + _i * 8192), 16, 0, 0); } while (0)
#define PG8_LDA(dst, b, h) do { _Pragma("unroll") for (int m = 0; m < 4; ++m) _Pragma("unroll") for (int k = 0; k < 2; ++k) dst[m][k] = *(const PG8_LAS bf16x8*)(lds + PG8_SA(b, h) + aoff + m * 2048 + k * 1024); } while (0)
#define PG8_LDB(dst, b, h) do { _Pragma("unroll") for (int n = 0; n < 2; ++n) _Pragma("unroll") for (int k = 0; k < 2; ++k) dst[n][k] = *(const PG8_LAS bf16x8*)(lds + PG8_SB(b, h) + boff + n * 2048 + k * 1024); } while (0)
#define PG8_MMA(ai, bj, At, Bt) do { __builtin_amdgcn_s_setprio(1); _Pragma("unroll") for (int m = 0; m < 4; ++m) _Pragma("unroll") for (int n = 0; n < 2; ++n) _Pragma("unroll") for (int k = 0; k < 2; ++k) \
        acc[ai][bj][m][n] = __builtin_amdgcn_mfma_f32_16x16x32_bf16(Bt[n][k], At[m][k], acc[ai][bj][m][n], 0, 0, 0); __builtin_amdgcn_s_setprio(0); } while (0)
#define PG8_WAIT_V(n) asm volatile("s_waitcnt vmcnt(" #n ")" ::: "memory")
#define PG8_WAIT_L(n) asm volatile("s_waitcnt lgkmcnt(" #n ")" ::: "memory")
#define PG8_BAR __builtin_amdgcn_s_barrier()
#define PG8_SCHED __builtin_amdgcn_sched_barrier(0)
    Unit cur, nxt; int ui = 0;
    if (!S.next(0, cur)) return;
    f32x4 acc[2][2][4][2];
#pragma unroll
    for (int a = 0; a < 2; ++a)
#pragma unroll
        for (int b = 0; b < 2; ++b)
#pragma unroll
            for (int m = 0; m < 4; ++m)
#pragma unroll
                for (int n = 0; n < 2; ++n) acc[a][b][m][n] = (f32x4){0.f, 0.f, 0.f, 0.f};
    bf16x8 At[4][2], B0[2][2], B1[2][2];
    const char* cA = (const char*)g.A + (size_t)cur.pm * tstepA + (size_t)cur.pn * acsb; const char* cB = (const char*)g.Bt + (size_t)cur.pn * tstepB;
    PG8_STAGE(PG8_SB(0, 0), cB, voffB); PG8_STAGE(PG8_SB(0, 1), cB + hstepB, voffB); PG8_STAGE(PG8_SA(0, 0), cA, voffA); PG8_STAGE(PG8_SA(0, 1), cA + hstepA, voffA);
    if (wr == 1) PG8_BAR;
    PG8_WAIT_V(2); PG8_BAR;
    PG8_STAGE(PG8_SB(1, 0), cB + kstep, voffB); PG8_STAGE(PG8_SA(1, 0), cA + kstep, voffA); PG8_STAGE(PG8_SB(1, 1), cB + hstepB + kstep, voffB);
    PG8_WAIT_V(6); PG8_BAR;
    for (;;) {
        const bool has_next = S.next(ui + 1, nxt);
        const char* nA = has_next ? (const char*)g.A + (size_t)nxt.pm * tstepA + (size_t)nxt.pn * acsb : cA; const char* nB = has_next ? (const char*)g.Bt + (size_t)nxt.pn * tstepB : cB;
#pragma unroll 1
        for (int t = 0; t < nt; t += 2) {
            const bool last = (t == nt - 2);
            const char* a1 = cA + (size_t)(t + 1) * kstep;
            const char* a2 = last ? nA : cA + (size_t)(t + 2) * kstep; const char* b2 = last ? nB : cB + (size_t)(t + 2) * kstep;
            const char* a3 = a2 + kstep; const char* b3 = b2 + kstep;
            PG8_LDB(B0, 0, 0); PG8_LDB(B1, 0, 1); PG8_SCHED; PG8_LDA(At, 0, 0); PG8_STAGE(PG8_SA(1, 1), a1 + hstepA, voffA);
            PG8_WAIT_V(8); PG8_WAIT_L(0); PG8_BAR; PG8_MMA(0, 0, At, B0); PG8_MMA(0, 1, At, B1); PG8_BAR; PG8_SCHED;
            PG8_LDA(At, 0, 1); PG8_STAGE(PG8_SB(0, 0), b2, voffB); PG8_STAGE(PG8_SB(0, 1), b2 + hstepB, voffB); PG8_STAGE(PG8_SA(0, 0), a2, voffA);
            PG8_WAIT_V(8); PG8_WAIT_L(0); PG8_BAR; PG8_MMA(1, 0, At, B0); PG8_MMA(1, 1, At, B1); PG8_BAR; PG8_SCHED;
            PG8_LDB(B0, 1, 0); PG8_LDB(B1, 1, 1); PG8_SCHED; PG8_LDA(At, 1, 0); PG8_STAGE(PG8_SA(0, 1), a2 + hstepA, voffA);
            PG8_WAIT_V(8); PG8_WAIT_L(0); PG8_BAR; PG8_MMA(0, 0, At, B0); PG8_MMA(0, 1, At, B1); PG8_BAR; PG8_SCHED;
            PG8_LDA(At, 1, 1); PG8_STAGE(PG8_SB(1, 0), b3, voffB); PG8_STAGE(PG8_SB(1, 1), b3 + hstepB, voffB); PG8_STAGE(PG8_SA(1, 0), a3, voffA);
            PG8_WAIT_V(8); PG8_WAIT_L(0); PG8_BAR; PG8_MMA(1, 0, At, B0); PG8_MMA(1, 1, At, B1); PG8_BAR; PG8_SCHED;
        }
        if (wr == 0) PG8_BAR;
        E(acc, cur, wr, wc, fr, fq);
        if (!has_next) break;
#pragma unroll
        for (int a = 0; a < 2; ++a)
#pragma unroll
            for (int b = 0; b < 2; ++b)
#pragma unroll
                for (int m = 0; m < 4; ++m)
#pragma unroll
                    for (int n = 0; n < 2; ++n) acc[a][b][m][n] = (f32x4){0.f, 0.f, 0.f, 0.f};
        cur = nxt; cA = nA; cB = nB; ++ui;
        if (wr == 1) PG8_BAR;
    }
    PG8_WAIT_V(0);
    PG8_BAR;
#undef PG8_SA
#undef PG8_SB
#undef PG8_STAGE
#undef PG8_LDA
#undef PG8_LDB
#undef PG8_MMA
#undef PG8_WAIT_V
#undef PG8_WAIT_L
#undef PG8_BAR
#undef PG8_SCHED
}
}

#define XB_TMO      128
#define XB_XCNT(j)  (256  + 64 * (j))
#define XB_XSUB(j)  (1280 + 64 * (j))
#define XB_XGEN(j)  (2304 + 64 * (j))
#define XB_TOP      3328
#define XB_TOPGEN   3392
#define XCD_BAR_WORDS 3456
#define XB_SPIN_CAP (1u << 18)
__device__ __forceinline__ unsigned xb_ld(unsigned* p)              { return __hip_atomic_load(p, __ATOMIC_RELAXED, __HIP_MEMORY_SCOPE_AGENT); }
__device__ __forceinline__ unsigned xb_add(unsigned* p, unsigned v) { return __hip_atomic_fetch_add(p, v, __ATOMIC_RELAXED, __HIP_MEMORY_SCOPE_AGENT); }
__device__ __forceinline__ unsigned xb_xcc_id() { return (unsigned)__builtin_amdgcn_s_getreg((3 << 11) | 20) & 0xFu; }
#define XB_SPIN(cond, bar) do { unsigned _sp = 0; while (cond) { __builtin_amdgcn_s_sleep(1); \
    if ((++_sp & 255u) == 0u) { if (xb_ld(&(bar)[XB_TMO])) break; if (_sp > XB_SPIN_CAP) { atomicAdd(&(bar)[XB_TMO], 1u); break; } } } } while (0)
struct XcdBarrier { unsigned* bar; unsigned x; volatile LAS unsigned* st; };
__device__ __forceinline__ XcdBarrier xcd_barrier_post(unsigned* bar, volatile LAS unsigned* st) {
    XcdBarrier b; b.bar = bar; b.x = xb_xcc_id(); b.st = st;
    if (threadIdx.x == 0) (void)xb_add(&bar[XB_XCNT(b.x)], 1u);
    return b;
}
__device__ __forceinline__ void xcd_barrier_complete(unsigned* bar, unsigned x, unsigned& nloc, unsigned& nx) {
    const unsigned G = gridDim.x * gridDim.y * gridDim.z;
    unsigned sum, cnt, mine, sp = 0u;
    for (;;) {
        sum = 0u; cnt = 0u; mine = 0u;
#pragma unroll
        for (unsigned j = 0; j < 16; ++j) { const unsigned c = xb_ld(&bar[XB_XCNT(j)]); sum += c; cnt += (c > 0u) ? 1u : 0u; mine = (j == x) ? c : mine; }
        if (sum == G) break;
        __builtin_amdgcn_s_sleep(1);
        if ((++sp & 255u) == 0u) { if (xb_ld(&bar[XB_TMO])) break; if (sp > XB_SPIN_CAP) { atomicAdd(&bar[XB_TMO], 1u); break; } }
    }
    nloc = mine > 0u ? mine : 1u; nx = cnt > 0u ? cnt : 1u;
}
__device__ __forceinline__ void xcd_barrier(const XcdBarrier& b, int wave) {
    asm volatile("s_waitcnt vmcnt(0)" ::: "memory");
    __syncthreads();
    if (wave == 0 && lane_id_v() == 0) {
        unsigned* bar = b.bar;
        __builtin_amdgcn_s_waitcnt(0);
        unsigned nloc = b.st[0], nx = b.st[1];
        if (nloc == 0u) { xcd_barrier_complete(bar, b.x, nloc, nx); b.st[0] = nloc; b.st[1] = nx; }
        const unsigned old = xb_add(&bar[XB_XSUB(b.x)], 1u);
        const unsigned gen = old / nloc;
        if (old + 1u == (gen + 1u) * nloc) {
            __builtin_amdgcn_fence(__ATOMIC_RELEASE, "agent");
            asm volatile("s_waitcnt vmcnt(0)" ::: "memory");
            const unsigned og = xb_add(&bar[XB_TOP], 1u);
            const unsigned tg = og / nx;
            if (og + 1u == (tg + 1u) * nx) xb_add(&bar[XB_TOPGEN], 1u);
            else XB_SPIN(xb_ld(&bar[XB_TOPGEN]) == tg, bar);
            __builtin_amdgcn_fence(__ATOMIC_ACQUIRE, "agent");
            xb_add(&bar[XB_XGEN(b.x)], 1u);
            asm volatile("s_waitcnt vmcnt(0)" ::: "memory");
        } else {
            XB_SPIN(xb_ld(&bar[XB_XGEN(b.x)]) == gen, bar);
            __builtin_amdgcn_fence(__ATOMIC_ACQUIRE, "agent");
            asm volatile("s_waitcnt vmcnt(0)" ::: "memory");
        }
    }
    __syncthreads();
}

struct Args { const float* in[28]; float* out; unsigned char* ws; int ph_lo, ph_hi; };
enum { I_X = 0, I_C, I_POS, I_WADA, I_BADA, I_N1G, I_WIN, I_QAG, I_WUQ, I_KVAG, I_WUKV, I_QNG, I_KNG, I_WOA, I_CONVW, I_CONVB, I_WRG, I_BRG, I_WIG, I_BIG, I_LAM, I_WOL, I_WOUT, I_N2G, I_WQ, I_SUBK, I_EU, I_EV };
constexpr int N_PHASES = 17;

struct Ctx {
    LAS unsigned char* lds;
    int tid, lane, wave, vcu, G;
    const float* const* in; float* out; unsigned char* ws;
};
#define WSP(type, off) ((type*)(c.ws + (off)))

template <class F>
__device__ __forceinline__ void tr_tile(const Ctx& c, bf16_t* dst, int K, int n0, int k0, F f) {
    LAS float* scr = (LAS float*)c.lds;
#pragma unroll
    for (int i = 0; i < 8; ++i) { const int kk = i * 8 + (c.tid >> 6), nn = c.tid & 63; scr[kk * 65 + nn] = f(k0 + kk, n0 + nn); }
    __syncthreads();
    { const int kc = c.tid & 7, nn = c.tid >> 3;
      LAS const float* s = scr + (8 * kc) * 65 + nn;
      u32x4 o; o.x = pk2(s[0], s[65]); o.y = pk2(s[2 * 65], s[3 * 65]); o.z = pk2(s[4 * 65], s[5 * 65]); o.w = pk2(s[6 * 65], s[7 * 65]);
      *(u32x4*)(dst + (size_t)(n0 + nn) * K + k0 + 8 * kc) = o; }
    __syncthreads();
}

__device__ __forceinline__ void phase_prep(const Ctx& c0) {
    Ctx c = c0; c.lane = lane_id_v(); c.tid = c.wave * 64 + c.lane;
    const float* w_in = c.in[I_WIN]; const float* w_uq = c.in[I_WUQ]; const float* qag = c.in[I_QAG]; const float* w_ukv = c.in[I_WUKV]; const float* kvag = c.in[I_KVAG];
    const float* w_oa = c.in[I_WOA]; const float* w_ol = c.in[I_WOL]; const float* w_out = c.in[I_WOUT]; const float* w_q = c.in[I_WQ];
    const float* w_rg = c.in[I_WRG]; const float* w_ig = c.in[I_WIG];
    constexpr int T_WIN = 72 * 16, T_WUQ = 12 * 4, T_WUKV = 16 * 2, T_WOA = 16 * 8, T_WOL = 16 * 16, T_WOUT = 16 * 16, T_WQ = 32 * 16, T_WG = 8 * 4 * 2;
    constexpr int T_ALL = T_WIN + T_WUQ + T_WUKV + T_WOA + T_WOL + T_WOUT + T_WQ + T_WG;
    for (int it = c.vcu; it < T_ALL; it += c.G) {
        int r = it;
        if (r < T_WIN) { const int nb = r / 16, kb = r % 16;
            tr_tile(c, WSP(bf16_t, WS_WIN), 1024, nb * 64, kb * 64, [=](int k, int n) -> float { return n < 416 ? w_in[(size_t)k * 4512 + n] : (n < 512 ? 0.f : w_in[(size_t)k * 4512 + n - 96]); }); continue; }
        r -= T_WIN;
        if (r < T_WUQ) { const int nb = r / 4, kb = r % 4;
            tr_tile(c, WSP(bf16_t, WS_WUQ), 256, nb * 64, kb * 64, [=](int k, int n) -> float { return w_uq[(size_t)k * 768 + n] * qag[k]; }); continue; }
        r -= T_WUQ;
        if (r < T_WUKV) { const int nb = r / 2, kb = r % 2;
            tr_tile(c, WSP(bf16_t, WS_WUKV), 128, nb * 64, kb * 64, [=](int k, int n) -> float { return w_ukv[(size_t)k * 1024 + n] * kvag[k]; }); continue; }
        r -= T_WUKV;
        if (r < T_WOA) { const int nb = r / 8, kb = r % 8;
            tr_tile(c, WSP(bf16_t, WS_WOA), 512, nb * 64, kb * 64, [=](int k, int n) -> float { return w_oa[(size_t)k * 1024 + n]; }); continue; }
        r -= T_WOA;
        if (r < T_WOL) { const int nb = r / 16, kb = r % 16;
            tr_tile(c, WSP(bf16_t, WS_WOL), 1024, nb * 64, kb * 64, [=](int k, int n) -> float { return w_ol[(size_t)k * 1024 + n]; }); continue; }
        r -= T_WOL;
        if (r < T_WOUT) { const int nb = r / 16, kb = r % 16;
            tr_tile(c, WSP(bf16_t, WS_WOUT), 1024, nb * 64, kb * 64, [=](int k, int n) -> float { return w_out[(size_t)k * 1024 + n]; }); continue; }
        r -= T_WOUT;
        if (r < T_WQ) { const int nb = r / 16, kb = r % 16;
            tr_tile(c, WSP(bf16_t, WS_WQ), 1024, nb * 64, kb * 64, [=](int k, int n) -> float { return w_q[(size_t)k * 2048 + n]; }); continue; }
        r -= T_WQ;
        { const int blk = r / 8, q = r % 8, nb = q / 2, kb = q % 2;
            tr_tile(c, WSP(bf16_t, WS_WG) + (size_t)blk * 256 * 128, 128, nb * 64, kb * 64,
                    [=](int k, int n) -> float { return n < 128 ? w_rg[((size_t)blk * 128 + k) * 128 + n] : w_ig[((size_t)blk * 128 + k) * 128 + n - 128]; }); }
    }
    { const float* lam = c.in[I_LAM]; float* t8 = WSP(float, WS_C8SP);
      if (c.vcu == 0) for (int e = c.tid; e < 1024; e += 512) t8[e] = -8.f * log1pf(__expf(-lam[e])); }
    { const float* sk = c.in[I_SUBK]; bf16_t* dst = WSP(bf16_t, WS_SK);
      for (int e = c.vcu * 512 + c.tid; e < 8 * 256 * 256; e += c.G * 512) {
          const int h = e >> 16, r = (e >> 8) & 255, cc = e & 255;
          float v = 0.f; if ((r >> 7) == (cc >> 7)) v = sk[(((size_t)h * 2 + (r >> 7)) * 128 + (r & 127)) * 128 + (cc & 127)];
          dst[e] = (bf16_t)f2bf(v); } }
    { const int gw = c.vcu * 8 + c.wave, NGW = c.G * 8, L = c.lane;
      for (int r = gw; r < 2 * NE; r += NGW) {
          const int isv = r >= NE, e = isv ? r - NE : r;
          const f32x4* src4 = (const f32x4*)((isv ? c.in[I_EV] : c.in[I_EU]) + (size_t)e * 1024 + 16 * L);
          f32x4 v[4]; float am = 0.f;
#pragma unroll
          for (int j = 0; j < 4; ++j) { v[j] = src4[j]; am = fmaxf(am, fmaxf(fmaxf(fabsf(v[j].x), fabsf(v[j].y)), fmaxf(fabsf(v[j].z), fabsf(v[j].w)))); }
#pragma unroll
          for (int o = 1; o < 64; o <<= 1) am = fmaxf(am, __shfl_xor(am, o));
          const float s = am > 0.f ? am * (1.f / 256.f) : 1.f, inv = 1.f / s;
          u32x4 q;
          { int w;
            w = __builtin_amdgcn_cvt_pk_fp8_f32(v[0].x * inv, v[0].y * inv, 0, false); w = __builtin_amdgcn_cvt_pk_fp8_f32(v[0].z * inv, v[0].w * inv, w, true); q.x = (unsigned)w;
            w = __builtin_amdgcn_cvt_pk_fp8_f32(v[1].x * inv, v[1].y * inv, 0, false); w = __builtin_amdgcn_cvt_pk_fp8_f32(v[1].z * inv, v[1].w * inv, w, true); q.y = (unsigned)w;
            w = __builtin_amdgcn_cvt_pk_fp8_f32(v[2].x * inv, v[2].y * inv, 0, false); w = __builtin_amdgcn_cvt_pk_fp8_f32(v[2].z * inv, v[2].w * inv, w, true); q.z = (unsigned)w;
            w = __builtin_amdgcn_cvt_pk_fp8_f32(v[3].x * inv, v[3].y * inv, 0, false); w = __builtin_amdgcn_cvt_pk_fp8_f32(v[3].z * inv, v[3].w * inv, w, true); q.w = (unsigned)w; }
          if (!isv) { *(u32x4*)(c.ws + WS_EU + ((size_t)(L >> 3) * NE + e) * 128 + (L & 7) * 16) = q; if (L == 0) WSP(float, WS_SU)[e] = s; }
          else { *(u32x4*)(c.ws + WS_EV + ((size_t)(L >> 3) * NE + e) * 128 + (L & 7) * 16) = q; if (L == 0) WSP(float, WS_SV)[e] = s; }
      } }
    { const float* cin = c.in[I_C]; const float* w_ada = c.in[I_WADA]; const float* b_ada = c.in[I_BADA]; float* mod = WSP(float, WS_MOD);
      LAS float* cs = (LAS float*)c.lds;
      LAS float* red = (LAS float*)(c.lds + 65536);
      bool have = false;
      for (int it = c.vcu; it < 192; it += c.G) {
          if (!have) { for (int e = c.tid; e < 16 * 1024; e += 512) { const float v = cin[e]; cs[e] = v / (1.f + __expf(-v)); } have = true; }
          __syncthreads();
          const int cl = c.tid & 31, ks = c.tid >> 5, j = it * 32 + cl;
          float acc[16];
#pragma unroll
          for (int b = 0; b < 16; ++b) acc[b] = 0.f;
          for (int kk = 0; kk < 64; ++kk) { const int k = ks * 64 + kk; const float w = w_ada[(size_t)k * 6144 + j];
#pragma unroll
              for (int b = 0; b < 16; ++b) acc[b] += cs[b * 1024 + k] * w; }
#pragma unroll
          for (int b = 0; b < 16; ++b) red[(ks * 16 + b) * 32 + cl] = acc[b];
          __syncthreads();
          { const int b = c.tid >> 5; float s = b_ada[j];
#pragma unroll
            for (int k2 = 0; k2 < 16; ++k2) s += red[(k2 * 16 + b) * 32 + cl];
            mod[b * 6144 + j] = s; }
          __syncthreads();
      } }
}

template <bool Q8>
__device__ __forceinline__ void phase_modnorm(const Ctx& c0, const float* x, const float* g, int shift_off, int scale_off, bf16_t* dst) {
    Ctx c = c0; c.lane = lane_id_v(); c.tid = c.wave * 64 + c.lane;
    const float* mod = WSP(float, WS_MOD);
    const int gw = c.vcu * 8 + c.wave, NGW = c.G * 8;
    for (int m = gw; m < T; m += NGW) {
        const int b = m >> 11;
        const f32x4* xr = (const f32x4*)(x + (size_t)m * D) + c.lane;
        f32x4 v[4]; float s = 0.f;
#pragma unroll
        for (int j = 0; j < 4; ++j) { v[j] = xr[64 * j]; s += (v[j].x * v[j].x + v[j].y * v[j].y) + (v[j].z * v[j].z + v[j].w * v[j].w); }
        const float rstd = rsqrtf(wave_sum(s) * (1.f / D) + EPS);
        u32x2* o8 = (u32x2*)(dst + (size_t)m * D) + c.lane;
        float am = 0.f;
#pragma unroll
        for (int j = 0; j < 4; ++j) {
            const int col = 4 * c.lane + 256 * j;
            const f32x4 gg = *(const f32x4*)(g + col), sc = *(const f32x4*)(mod + b * 6144 + scale_off + col), sh = *(const f32x4*)(mod + b * 6144 + shift_off + col);
            const float r0 = v[j].x * rstd * gg.x * (1.f + sc.x) + sh.x, r1 = v[j].y * rstd * gg.y * (1.f + sc.y) + sh.y;
            const float r2 = v[j].z * rstd * gg.z * (1.f + sc.z) + sh.z, r3 = v[j].w * rstd * gg.w * (1.f + sc.w) + sh.w;
            u32x2 w; w.x = pk2(r0, r1); w.y = pk2(r2, r3); o8[64 * j] = w;
            if (Q8) { v[j].x = r0; v[j].y = r1; v[j].z = r2; v[j].w = r3; am = fmaxf(am, fmaxf(fmaxf(fabsf(r0), fabsf(r1)), fmaxf(fabsf(r2), fabsf(r3)))); }
        }
        if (Q8) {
#pragma unroll
            for (int o = 1; o < 64; o <<= 1) am = fmaxf(am, __shfl_xor(am, o));
            const float sq = am > 0.f ? am * (1.f / 256.f) : 1.f, inv = 1.f / sq;
            unsigned* q8 = (unsigned*)(c.ws + WS_H2Q + (size_t)m * D) + c.lane;
#pragma unroll
            for (int j = 0; j < 4; ++j) { int w = __builtin_amdgcn_cvt_pk_fp8_f32(v[j].x * inv, v[j].y * inv, 0, false); w = __builtin_amdgcn_cvt_pk_fp8_f32(v[j].z * inv, v[j].w * inv, w, true); q8[64 * j] = (unsigned)w; }
            if (c.lane == 0) WSP(float, WS_SH)[m] = sq;
        }
    }
}

__device__ __forceinline__ void phase_conv(const Ctx& c0) {
    Ctx c = c0; c.lane = lane_id_v(); c.tid = c.wave * 64 + c.lane;
    const bf16_t* pa = WSP(bf16_t, WS_R1); const bf16_t* lx = WSP(bf16_t, WS_R2); bf16_t* xc = WSP(bf16_t, WS_R4); float* rstd = WSP(float, WS_RSTD);
    const float* cw = c.in[I_CONVW]; const float* cb = c.in[I_CONVB];
    const int gt = c.vcu * 512 + c.tid, NT = c.G * 512;
    { const int gw = c.vcu * 8 + c.wave, NGW = c.G * 8, L = c.lane;
      for (int t = gw; t < T; t += NGW) {
          float ss = 0.f;
          if (L < 48) { float v[8]; unpack8(*(const u32x4*)(pa + (size_t)t * 512 + 8 * L), v);
#pragma unroll
              for (int j = 0; j < 8; ++j) ss += v[j] * v[j]; }
          const float sq = wave_sum(L < 32 ? ss : 0.f), skv = wave_sum(L >= 32 ? ss : 0.f);
          if (L == 0) { rstd[2 * t] = rsqrtf(sq * (1.f / 256.f) + EPS); rstd[2 * t + 1] = rsqrtf(skv * (1.f / 128.f) + EPS); }
      } }
    { const int* pos = (const int*)c.in[I_POS]; float* CS = WSP(float, WS_CS);
      for (int e = gt; e < T * 16; e += NT) {
          const int t = e >> 4, jj = e & 15;
          const float invf = exp2f(-(float)jj * (13.287712379549449f / 16.f));
          const float ang = (float)pos[t] * invf; const float n = rintf(ang * 0.15915494309189535f);
          const float red = (float)((double)ang - (double)n * 6.283185307179586);
          CS[(size_t)t * 32 + jj] = __cosf(red); CS[(size_t)t * 32 + 16 + jj] = __sinf(red);
      } }
    {
        const int ch = (gt & 127) * 8;
        f32x4 wv[4][2]; f32x4 bv[2];
#pragma unroll
        for (int j = 0; j < 4; ++j) { wv[j][0] = *(const f32x4*)(cw + j * 1024 + ch); wv[j][1] = *(const f32x4*)(cw + j * 1024 + ch + 4); }
        bv[0] = *(const f32x4*)(cb + ch); bv[1] = *(const f32x4*)(cb + ch + 4);
        const int tstep = NT >> 7;
        for (int tq = gt >> 7; tq < T; tq += 4 * tstep) {
            u32x4 raw[4][4];
#pragma unroll
            for (int u = 0; u < 4; ++u) { const int t = tq + u * tstep; const int s = t & 2047;
#pragma unroll
                for (int j = 0; j < 4; ++j) { raw[u][j] = (u32x4){0u, 0u, 0u, 0u}; if (t < T && s - 3 + j >= 0) raw[u][j] = *(const u32x4*)(lx + (size_t)(t - 3 + j) * 1024 + ch); } }
#pragma unroll
            for (int u = 0; u < 4; ++u) { const int t = tq + u * tstep;
                float acc[8] = {bv[0].x, bv[0].y, bv[0].z, bv[0].w, bv[1].x, bv[1].y, bv[1].z, bv[1].w};
#pragma unroll
                for (int j = 0; j < 4; ++j) { float v[8]; unpack8(raw[u][j], v);
                    acc[0] += wv[j][0].x * v[0]; acc[1] += wv[j][0].y * v[1]; acc[2] += wv[j][0].z * v[2]; acc[3] += wv[j][0].w * v[3];
                    acc[4] += wv[j][1].x * v[4]; acc[5] += wv[j][1].y * v[5]; acc[6] += wv[j][1].z * v[6]; acc[7] += wv[j][1].w * v[7]; }
                if (t < T) *(u32x4*)(xc + (size_t)t * 1024 + ch) = pack8(acc); }
        }
    }
}

__device__ __forceinline__ void phase_scan(const Ctx& c0) {
    Ctx c = c0; c.lane = lane_id_v(); c.tid = c.wave * 64 + c.lane;
    const bf16_t* LA = WSP(bf16_t, WS_R0); bf16_t* Bv = WSP(bf16_t, WS_R6); const bf16_t* gate = WSP(bf16_t, WS_R3);
    LAS float* Ps = (LAS float*)c.lds; LAS float* Hs = Ps + 512;
    for (int it = c.vcu; it < 256; it += c.G) {
        const int b = it >> 4, cg = it & 15, seg = c.tid >> 6, ch = cg * 64 + (c.tid & 63);
        const size_t base = ((size_t)b * 2048 + seg * 256) * 1024 + ch;
        float P = 1.f, Hl = 0.f;
#pragma unroll 8
        for (int i = 0; i < 256; ++i) { const float a = __builtin_amdgcn_exp2f(bf2f(LA[base + (size_t)i * 1024])); const float bb = bf2f(Bv[base + (size_t)i * 1024]); Hl = a * Hl + bb; P *= a; }
        Ps[c.tid] = P; Hs[c.tid] = Hl;
        __syncthreads();
        float h = 0.f;
        for (int s2 = 0; s2 < seg; ++s2) h = Ps[s2 * 64 + (c.tid & 63)] * h + Hs[s2 * 64 + (c.tid & 63)];
#pragma unroll 8
        for (int i = 0; i < 256; ++i) { const float a = __builtin_amdgcn_exp2f(bf2f(LA[base + (size_t)i * 1024])); const float bb = bf2f(Bv[base + (size_t)i * 1024]); h = a * h + bb;
            const float gv = bf2f(gate[base + (size_t)i * 1024]); Bv[base + (size_t)i * 1024] = (bf16_t)f2bf(h * gelu_tanh(gv)); }
        __syncthreads();
    }
}

struct QkvRaw { u32x4 q[2], k[2], v[2]; f32x4 cs[4]; };
__device__ __forceinline__ void qkv_load(QkvRaw& r, const bf16_t* qraw, const bf16_t* kvraw, const bf16_t* pa, const float* CS, int t, int ch, int hq) {
    const bool act = ch < 12;
#pragma unroll
    for (int pass = 0; pass < 2; ++pass) { const int h = pass * 4 + hq;
        r.q[pass] = (u32x4){0u, 0u, 0u, 0u}; r.k[pass] = (u32x4){0u, 0u, 0u, 0u}; r.v[pass] = (u32x4){0u, 0u, 0u, 0u};
        if (act) r.q[pass] = *(const u32x4*)(qraw + (size_t)t * 768 + h * 96 + 8 * ch);
        if (ch < 8) { r.k[pass] = *(const u32x4*)(kvraw + (size_t)t * 1024 + h * 128 + 8 * ch); r.v[pass] = *(const u32x4*)(kvraw + (size_t)t * 1024 + h * 128 + 64 + 8 * ch); }
        else if (act) r.k[pass] = *(const u32x4*)(pa + (size_t)t * 512 + 384 + 8 * (ch - 8)); }
    const float* cp = CS + (size_t)t * 32 + 8 * (ch & 1);
    r.cs[0] = *(const f32x4*)cp; r.cs[1] = *(const f32x4*)(cp + 4); r.cs[2] = *(const f32x4*)(cp + 16); r.cs[3] = *(const f32x4*)(cp + 20);
}
__device__ __forceinline__ void phase_qkv_layout(const Ctx& c0) {
    Ctx c = c0; c.lane = lane_id_v(); c.tid = c.wave * 64 + c.lane;
    const bf16_t* qraw = WSP(bf16_t, WS_R5); const bf16_t* kvraw = WSP(bf16_t, WS_R2); const bf16_t* pa = WSP(bf16_t, WS_R1);
    bf16_t* Qh = WSP(bf16_t, WS_R4); bf16_t* Kh = WSP(bf16_t, WS_R3); bf16_t* Vh = WSP(bf16_t, WS_R0);
    const float* qng = c.in[I_QNG]; const float* kng = c.in[I_KNG]; const float* CS = WSP(float, WS_CS);
    const float qscale = 0.10206207261596577f * 1.4426950408889634f;
    const int gw = c.vcu * 8 + c.wave, NGW = c.G * 8, L = c.lane;
    const int ch = L & 15, hq = L >> 4;
    const bool act = ch < 12, isr = ch >= 8, hi2 = ch >= 10;
    float gq[8], gk[8];
#pragma unroll
    for (int j = 0; j < 8; ++j) { gq[j] = act ? qng[8 * ch + j] : 0.f; gk[j] = act ? kng[8 * ch + j] : 0.f; }
    if (gw >= T) return;
    QkvRaw cur, nxt;
    qkv_load(cur, qraw, kvraw, pa, CS, gw, ch, hq);
#pragma unroll 1
    for (int t = gw; t < T; t += NGW) {
        qkv_load(nxt, qraw, kvraw, pa, CS, (t + NGW < T) ? t + NGW : t, ch, hq);
        const int b = t >> 11, s = t & 2047;
        const float cs[8] = {cur.cs[0].x, cur.cs[0].y, cur.cs[0].z, cur.cs[0].w, cur.cs[1].x, cur.cs[1].y, cur.cs[1].z, cur.cs[1].w};
        const float sn[8] = {cur.cs[2].x, cur.cs[2].y, cur.cs[2].z, cur.cs[2].w, cur.cs[3].x, cur.cs[3].y, cur.cs[3].z, cur.cs[3].w};
#pragma unroll
        for (int pass = 0; pass < 2; ++pass) {
            const int h = pass * 4 + hq;
            const size_t orow = ((size_t)(b * H + h) * S + s);
#pragma unroll
            for (int qk = 0; qk < 2; ++qk) {
                float v[8]; unpack8(qk == 0 ? cur.q[pass] : cur.k[pass], v);
                float ss = 0.f;
#pragma unroll
                for (int j = 0; j < 8; ++j) ss += v[j] * v[j];
#pragma unroll
                for (int o = 1; o < 16; o <<= 1) ss += __shfl_xor(ss, o);
                const float r = rsqrtf(ss * (1.f / 96.f) + EPS) * (qk == 0 ? qscale : 1.f);
                float x[8], o8[8];
#pragma unroll
                for (int j = 0; j < 8; ++j) x[j] = v[j] * r * (qk == 0 ? gq[j] : gk[j]);
#pragma unroll
                for (int j = 0; j < 8; ++j) { const float px = __shfl_xor(x[j], 2);
                    o8[j] = !isr ? x[j] : (hi2 ? px * sn[j] + x[j] * cs[j] : x[j] * cs[j] - px * sn[j]); }
                if (act) *(u32x4*)((qk == 0 ? Qh : Kh) + orow * 96 + 8 * ch) = pack8(o8);
            }
            if (ch < 8) *(u32x4*)(Vh + orow * 64 + 8 * ch) = cur.v[pass];
        }
        cur = nxt;
    }
}

constexpr int KROW = 208, VROW = 160;
constexpr int KBUF = 128 * KROW, VBUF = 128 * VROW;
typedef short v4i16_t __attribute__((ext_vector_type(4)));
__device__ __forceinline__ void attn_chunk(LAS unsigned char* kb, LAS unsigned char* vb, const bf16x8 (&qf)[3], f32x4 (&o)[4], float& mrun, float& lrun, int fr, int g) {
    f32x4 sacc[4];
#pragma unroll
    for (int kt = 0; kt < 4; ++kt) { sacc[kt] = (f32x4){0.f, 0.f, 0.f, 0.f};
#pragma unroll
        for (int ks = 0; ks < 3; ++ks) { const bf16x8 kf = *(const LAS bf16x8*)(kb + (16 * kt + fr) * KROW + (ks * 32 + g * 8) * 2);
            sacc[kt] = __builtin_amdgcn_mfma_f32_16x16x32_bf16(kf, qf[ks], sacc[kt], 0, 0, 0); } }
    float mx = sacc[0][0];
#pragma unroll
    for (int kt = 0; kt < 4; ++kt)
#pragma unroll
        for (int r = 0; r < 4; ++r) mx = fmaxf(mx, sacc[kt][r]);
    mx = fmaxf(mx, __shfl_xor(mx, 16)); mx = fmaxf(mx, __shfl_xor(mx, 32));
    const float mnew = fmaxf(mrun, mx), alpha = __builtin_amdgcn_exp2f(mrun - mnew); mrun = mnew;
    float ps = 0.f;
#pragma unroll
    for (int kt = 0; kt < 4; ++kt)
#pragma unroll
        for (int r = 0; r < 4; ++r) { const float p = __builtin_amdgcn_exp2f(sacc[kt][r] - mnew); sacc[kt][r] = p; ps += p; }
    lrun = lrun * alpha + ps;
#pragma unroll
    for (int dt = 0; dt < 4; ++dt) o[dt] = o[dt] * alpha;
#pragma unroll
    for (int s2 = 0; s2 < 2; ++s2) {
        u32x4 pw; pw.x = pk2(sacc[2 * s2][0], sacc[2 * s2][1]); pw.y = pk2(sacc[2 * s2][2], sacc[2 * s2][3]); pw.z = pk2(sacc[2 * s2 + 1][0], sacc[2 * s2 + 1][1]); pw.w = pk2(sacc[2 * s2 + 1][2], sacc[2 * s2 + 1][3]);
        const bf16x8 pb = __builtin_bit_cast(bf16x8, pw);
#pragma unroll
        for (int dt = 0; dt < 4; ++dt) {
            LAS unsigned char* va = vb + (32 * s2 + 4 * g + (fr >> 2)) * VROW + (16 * dt + 4 * (fr & 3)) * 2;
            const v4i16_t t0 = __builtin_amdgcn_ds_read_tr16_b64_v4i16((LAS v4i16_t*)va), t1 = __builtin_amdgcn_ds_read_tr16_b64_v4i16((LAS v4i16_t*)(va + 16 * VROW));
            const bf16x8 vf = (bf16x8){t0[0], t0[1], t0[2], t0[3], t1[0], t1[1], t1[2], t1[3]};
            o[dt] = __builtin_amdgcn_mfma_f32_16x16x32_bf16(vf, pb, o[dt], 0, 0, 0); }
    }
}
__device__ __forceinline__ void attn_unit(const Ctx& c, int b, int h, int qb) {
    const bf16_t* Qh = WSP(bf16_t, WS_R4); const bf16_t* Kh = WSP(bf16_t, WS_R3); const bf16_t* Vh = WSP(bf16_t, WS_R0); bf16_t* AO = WSP(bf16_t, WS_R0 + 32 * MiB);
    const int fr = c.lane & 15, g = c.lane >> 4, wid = c.wave;
    const size_t hb = (size_t)(b * H + h) * S;
    const int q0 = qb * 128 + wid * 16;
    const int nsup = qb + 1;
    bf16x8 qf[3];
#pragma unroll
    for (int ks = 0; ks < 3; ++ks) qf[ks] = *(const bf16x8*)(Qh + (hb + q0 + fr) * 96 + ks * 32 + g * 8);
    f32x4 o[4];
#pragma unroll
    for (int dt = 0; dt < 4; ++dt) o[dt] = (f32x4){0.f, 0.f, 0.f, 0.f};
    float mrun = -1e30f, lrun = 0.f;
    u32x4 kr[3], vr[2];
    const u32x4* Ksrc = (const u32x4*)(Kh + hb * 96); const u32x4* Vsrc = (const u32x4*)(Vh + hb * 64);
#pragma unroll
    for (int i = 0; i < 3; ++i) kr[i] = Ksrc[c.tid + 512 * i];
#pragma unroll
    for (int i = 0; i < 2; ++i) vr[i] = Vsrc[c.tid + 512 * i];
    for (int j = 0; j < nsup; ++j) {
        LAS unsigned char* kb = c.lds + (j & 1) * (KBUF + VBUF); LAS unsigned char* vb = kb + KBUF;
#pragma unroll
        for (int i = 0; i < 3; ++i) { const int kc = c.tid + 512 * i; *(LAS u32x4*)(kb + (kc / 12) * KROW + (kc % 12) * 16) = kr[i]; }
#pragma unroll
        for (int i = 0; i < 2; ++i) { const int vc = c.tid + 512 * i; *(LAS u32x4*)(vb + (vc >> 3) * VROW + (vc & 7) * 16) = vr[i]; }
        __syncthreads();
        if (j + 1 < nsup) {
#pragma unroll
            for (int i = 0; i < 3; ++i) kr[i] = Ksrc[(j + 1) * 1536 + c.tid + 512 * i];
#pragma unroll
            for (int i = 0; i < 2; ++i) vr[i] = Vsrc[(j + 1) * 1024 + c.tid + 512 * i];
        }
        attn_chunk(kb, vb, qf, o, mrun, lrun, fr, g);
        if (j + 1 < nsup || wid >= 4) attn_chunk(kb + 64 * KROW, vb + 64 * VROW, qf, o, mrun, lrun, fr, g);
    }
    float lt = lrun + __shfl_xor(lrun, 16); lt += __shfl_xor(lt, 32);
    const float inv = 1.f / lt;
    bf16_t* orow = AO + ((size_t)b * S + q0 + fr) * 512 + h * 64;
#pragma unroll
    for (int dt = 0; dt < 4; ++dt) { u32x2 w; w.x = pk2(o[dt][0] * inv, o[dt][1] * inv); w.y = pk2(o[dt][2] * inv, o[dt][3] * inv); *(u32x2*)(orow + 16 * dt + 4 * g) = w; }
    __syncthreads();
}
__device__ __forceinline__ void phase_attn(const Ctx& c0) {
    Ctx c = c0; c.lane = lane_id_v(); c.tid = c.wave * 64 + c.lane;
    for (int v = c.vcu; v < 256; v += c.G) {
        const int bh = v >> 1, odd = v & 1;
        for (int i = 0; i < 8; ++i) {
            const int setA[8] = {15, 12, 10, 9, 6, 5, 3, 0}, setB[8] = {14, 13, 11, 8, 7, 4, 2, 1};
            int qb = 0;
#pragma unroll
            for (int k = 0; k < 8; ++k) if (k == i) qb = odd ? setB[k] : setA[k];
            attn_unit(c, bh >> 3, bh & 7, qb);
        }
    }
}

__device__ __forceinline__ float wave_max(float v) {
#pragma unroll
    for (int o = 1; o < 64; o <<= 1) v = fmaxf(v, __shfl_xor(v, o));
    return v;
}
__device__ __forceinline__ int wave_min_i(int v) {
#pragma unroll
    for (int o = 1; o < 64; o <<= 1) v = min(v, __shfl_xor(v, o));
    return v;
}
__device__ __forceinline__ int prefix_cnt(unsigned long long m) { return (int)__builtin_amdgcn_mbcnt_hi((unsigned)(m >> 32), __builtin_amdgcn_mbcnt_lo((unsigned)m, 0u)); }
template <int NV, int NBITS> __device__ __forceinline__ void select16(const unsigned (&key)[NV], int (&slot)[NV]) {
    unsigned tau = 0u;
    for (int bit = NBITS - 1; bit >= 0; --bit) {
        const unsigned trial = tau | (1u << bit); int cnt = 0;
#pragma unroll
        for (int j = 0; j < NV; ++j) cnt += __popcll(__ballot(key[j] >= trial));
        if (cnt >= 16) { tau = trial; if (cnt == 16) break; }
    }
    int base = 0;
#pragma unroll
    for (int j = 0; j < NV; ++j) { const unsigned long long m = __ballot(key[j] > tau); slot[j] = (key[j] > tau) ? base + prefix_cnt(m) : -1; base += __popcll(m); }
#pragma unroll
    for (int j = 0; j < NV; ++j) { const unsigned long long m = __ballot(key[j] == tau); if (key[j] == tau) { const int s = base + prefix_cnt(m); slot[j] = s < 16 ? s : -1; } base += __popcll(m); }
}
template <int N> __device__ __forceinline__ void bitonic_stage_desc(unsigned (&x)[N], int k, int j) {
#pragma unroll
    for (int i = 0; i < N; ++i) { const int l = i ^ j; if (l > i) { const bool asc = ((i & k) != 0);
        const unsigned a = x[i], b = x[l]; const unsigned hi = a > b ? a : b, lo = a > b ? b : a; x[i] = asc ? lo : hi; x[l] = asc ? hi : lo; } }
}
__device__ __forceinline__ void sort16_desc(unsigned (&x)[16]) {
#pragma unroll
    for (int k = 2; k <= 16; k <<= 1)
#pragma unroll
        for (int j = k >> 1; j > 0; j >>= 1) bitonic_stage_desc<16>(x, k, j);
}
__device__ __forceinline__ void merge16_desc(unsigned (&run)[16], const unsigned (&ch)[16]) {
#pragma unroll
    for (int i = 0; i < 16; ++i) run[i] = run[i] > ch[15 - i] ? run[i] : ch[15 - i];
#pragma unroll
    for (int j = 8; j > 0; j >>= 1) bitonic_stage_desc<16>(run, 16, j);
}
__device__ __forceinline__ unsigned mono_hi(unsigned w) { return w ^ ((unsigned)((int)w >> 31) | 0x80000000u); }
__device__ __forceinline__ float demono_hi(unsigned k) { const unsigned kk = k & 0xffff0000u; return __builtin_bit_cast(float, (kk ^ ((unsigned)(~(int)kk >> 31) | 0x80000000u)) & 0xffff0000u); }
__device__ __forceinline__ void top16_list(const bf16_t* s, unsigned (&run)[16]) {
#pragma unroll
    for (int ck = 0; ck < 8; ++ck) {
        const u32x4 w0 = *(const u32x4*)(s + ck * 16), w1 = *(const u32x4*)(s + ck * 16 + 8);
        const unsigned w[8] = {w0.x, w0.y, w0.z, w0.w, w1.x, w1.y, w1.z, w1.w};
        unsigned ch[16];
#pragma unroll
        for (int i = 0; i < 8; ++i) { ch[2 * i] = (mono_hi(w[i] << 16) & 0xffff0000u) | (unsigned)(ck * 16 + 2 * i); ch[2 * i + 1] = (mono_hi(w[i]) & 0xffff0000u) | (unsigned)(ck * 16 + 2 * i + 1); }
        sort16_desc(ch);
        if (ck == 0) {
#pragma unroll
            for (int i = 0; i < 16; ++i) run[i] = ch[i];
        } else merge16_desc(run, ch);
    }
}
__device__ __forceinline__ void phase_topk(const Ctx& c0) {
    Ctx c = c0; c.lane = lane_id_v(); c.tid = c.wave * 64 + c.lane;
    const bf16_t* sc = WSP(bf16_t, WS_SC); int* IDX = WSP(int, WS_IDX); float* GW = WSP(float, WS_GW);
    const int gl = (c.vcu * 8 + c.wave) * 64 + c.lane, NL = c.G * 512;
    for (int e = gl; e < T * H; e += NL) {
        unsigned ka[16], kb[16];
        top16_list(sc + (size_t)e * 256, ka);
        top16_list(sc + (size_t)e * 256 + 128, kb);
        float sa[16], sb[16]; unsigned ia[16], ib[16];
#pragma unroll
        for (int i = 0; i < 16; ++i) { sa[i] = demono_hi(ka[i]); sb[i] = demono_hi(kb[i]); ia[i] = (ka[i] & 0x7fu) << 7; ib[i] = kb[i] & 0x7fu; }
        const float mx = sa[0] + sb[0];
        unsigned run[16], ch[16]; int n = 0, nc = 0;
#pragma unroll
        for (int a = 0; a < 16; ++a)
#pragma unroll
            for (int b = 0; b < 16; ++b) if ((a + 1) * (b + 1) <= 16) {
                const int k = 65535 + (int)((sa[a] + sb[b] - mx) * 1024.f);
                ch[n] = ((unsigned)(k < 0 ? 0 : k) << 16) | ia[a] | ib[b];
                if (++n == 16) { sort16_desc(ch); if (nc == 0) {
#pragma unroll
                        for (int i = 0; i < 16; ++i) run[i] = ch[i]; } else merge16_desc(run, ch);
                    n = 0; ++nc; }
            }
#pragma unroll
        for (int i = 2; i < 16; ++i) ch[i] = 0u;
        sort16_desc(ch); merge16_desc(run, ch);
        float ex[16]; float sum = 0.f;
#pragma unroll
        for (int i = 0; i < 16; ++i) { ex[i] = __expf((float)((int)(run[i] >> 16) - 65535) * (1.f / 1024.f)); sum += ex[i]; }
        const float inv = 1.f / sum;
        u32x4* oi = (u32x4*)(IDX + (size_t)e * 16); f32x4* og = (f32x4*)(GW + (size_t)e * 16);
#pragma unroll
        for (int q = 0; q < 4; ++q) { u32x4 vi; vi.x = run[4 * q] & 0x3fffu; vi.y = run[4 * q + 1] & 0x3fffu; vi.z = run[4 * q + 2] & 0x3fffu; vi.w = run[4 * q + 3] & 0x3fffu; oi[q] = vi;
            f32x4 vg; vg.x = ex[4 * q] * inv; vg.y = ex[4 * q + 1] * inv; vg.z = ex[4 * q + 2] * inv; vg.w = ex[4 * q + 3] * inv; og[q] = vg; }
    }
}

__device__ __forceinline__ void dec16_fp8(const u32x4 r, float (&f)[16]) {
    const unsigned w[4] = {r.x, r.y, r.z, r.w};
#pragma unroll
    for (int i = 0; i < 4; ++i) { const f32x2 lo = __builtin_amdgcn_cvt_pk_f32_fp8((int)w[i], false), hi = __builtin_amdgcn_cvt_pk_f32_fp8((int)w[i], true);
        f[4 * i] = lo.x; f[4 * i + 1] = lo.y; f[4 * i + 2] = hi.x; f[4 * i + 3] = hi.y; }
}
__device__ __forceinline__ void phase_peer_u(const Ctx& c0) {
    Ctx c = c0; c.lane = lane_id_v(); c.tid = c.wave * 64 + c.lane;
    const bf16_t* h2 = WSP(bf16_t, WS_R0); const int* IDX = WSP(int, WS_IDX);
    const int L = c.lane, p = blockIdx.x & 7, rank = blockIdx.x >> 3, nrank = (c.G + 7 - p) >> 3;
    const int np = c.G < 8 ? c.G : 8;
    const bool b2 = L & 4, b1 = L & 2, b0 = L & 1;
    LAS int* mb = (LAS int*)(c.lds + c.wave * 1024);
    const int kl = L >> 3;
    for (int pp = p; pp < 8; pp += np) {
        const unsigned char* EU8b = c.ws + WS_EU + (size_t)pp * NE * 128;
        float* PD = WSP(float, WS_PD) + (size_t)pp * T * 128;
        const int t0 = rank * 8 + c.wave, ts = nrank * 8;
        if (t0 >= T) continue;
        { const int g0 = IDX[(size_t)t0 * 128 + L], g1 = IDX[(size_t)t0 * 128 + 64 + L]; mb[L] = g0; mb[64 + L] = g1; }
        u32x4 rA[8], rB[8];
        { const unsigned char* EU8 = EU8b + (L & 7) * 16;
#pragma unroll
        for (int i = 0; i < 8; ++i) rA[i] = *(const u32x4*)(EU8 + (size_t)mb[8 * i + kl] * 128); }
        int cur = 0;
#pragma unroll 1
        for (int t = t0; t < T; t += ts) {
            int lo16 = (L & 7) * 16; asm volatile("" : "+v"(lo16)); const unsigned char* EU8 = EU8b + lo16;
            const int tn = (t + ts < T) ? t + ts : t;
            const int gn0 = IDX[(size_t)tn * 128 + L], gn1 = IDX[(size_t)tn * 128 + 64 + L];
            float hv[16];
            { const u32x4* ph = (const u32x4*)(h2 + (size_t)t * 1024 + pp * 128 + (L & 7) * 16); float a[8], b[8]; unpack8(ph[0], a); unpack8(ph[1], b);
#pragma unroll
              for (int j = 0; j < 8; ++j) { hv[j] = a[j]; hv[8 + j] = b[j]; } }
#pragma unroll
            for (int i = 0; i < 8; ++i) rB[i] = *(const u32x4*)(EU8 + (size_t)mb[cur * 128 + 64 + 8 * i + kl] * 128);
            float d[16];
#pragma unroll
            for (int i = 0; i < 8; ++i) { float f[16]; dec16_fp8(rA[i], f); float s = 0.f;
#pragma unroll
                for (int j = 0; j < 16; ++j) s += hv[j] * f[j];
                d[i] = s; }
            mb[(cur ^ 1) * 128 + L] = gn0; mb[(cur ^ 1) * 128 + 64 + L] = gn1;
#pragma unroll
            for (int i = 0; i < 8; ++i) rA[i] = *(const u32x4*)(EU8 + (size_t)mb[(cur ^ 1) * 128 + 8 * i + kl] * 128);
#pragma unroll
            for (int i = 0; i < 8; ++i) { float f[16]; dec16_fp8(rB[i], f); float s = 0.f;
#pragma unroll
                for (int j = 0; j < 16; ++j) s += hv[j] * f[j];
                d[8 + i] = s; }
            float n8[8], n4[4], n2[2];
#pragma unroll
            for (int i = 0; i < 8; ++i) { const float send = b2 ? d[i] : d[i + 8], keep = b2 ? d[i + 8] : d[i]; n8[i] = keep + __shfl_xor(send, 4); }
#pragma unroll
            for (int i = 0; i < 4; ++i) { const float send = b1 ? n8[i] : n8[i + 4], keep = b1 ? n8[i + 4] : n8[i]; n4[i] = keep + __shfl_xor(send, 2); }
#pragma unroll
            for (int i = 0; i < 2; ++i) { const float send = b0 ? n4[i] : n4[i + 2], keep = b0 ? n4[i + 2] : n4[i]; n2[i] = keep + __shfl_xor(send, 1); }
            const int i0 = (b2 ? 8 : 0) + (b1 ? 4 : 0) + (b0 ? 2 : 0);
            PD[(size_t)t * 128 + 8 * i0 + kl] = n2[0]; PD[(size_t)t * 128 + 8 * (i0 + 1) + kl] = n2[1];
            cur ^= 1;
        }
    }
}
__device__ __forceinline__ void phase_peer_fin(const Ctx& c0) {
    Ctx c = c0; c.lane = lane_id_v(); c.tid = c.wave * 64 + c.lane;
    const int* IDX = WSP(int, WS_IDX); const float* GW = WSP(float, WS_GW); const float* PD = WSP(float, WS_PD); unsigned* WGT = WSP(unsigned, WS_WGT);
    const float* SU = WSP(float, WS_SU); const float* SV = WSP(float, WS_SV); const float* SH = WSP(float, WS_SH);
#pragma unroll 4
    for (int i = c.vcu * 512 + c.tid; i < T * 128; i += c.G * 512) {
        float d = 0.f;
#pragma unroll
        for (int p = 0; p < 8; ++p) d += PD[(size_t)p * T * 128 + i];
        const int e = IDX[i];
        WGT[i] = (f2bf(GW[i] * gelu_tanh(d * SU[e]) * SV[e]) << 16) | (unsigned)e;
    }
}
template <bool DRY> __device__ __forceinline__ void phase_peer_v(const Ctx& c0) {
    Ctx c = c0; c.lane = lane_id_v(); c.tid = c.wave * 64 + c.lane;
    const unsigned* WI = WSP(unsigned, WS_WGT); const float* mod = WSP(float, WS_MOD);
    const int L = c.lane, p = blockIdx.x & 7, rank = blockIdx.x >> 3, nrank = (c.G + 7 - p) >> 3;
    const int np = c.G < 8 ? c.G : 8;
    const bool b5 = L & 32, b4 = L & 16, b3 = L & 8;
    LAS unsigned* mb = (LAS unsigned*)(c.lds + c.wave * 1024);
    const int kl = L >> 3;
    for (int pp = p; pp < 8; pp += np) {
        const unsigned char* EV8 = c.ws + WS_EV + (size_t)pp * NE * 128 + (L & 7) * 16;
        const int col = pp * 128 + (L & 7) * 16 + (b5 ? 8 : 0) + (b4 ? 4 : 0) + (b3 ? 2 : 0);
        const int t0 = rank * 8 + c.wave, ts = nrank * 8;
        if (t0 >= T) continue;
        { const unsigned g0 = WI[(size_t)t0 * 128 + L], g1 = WI[(size_t)t0 * 128 + 64 + L]; mb[L] = g0; mb[64 + L] = g1; }
        u32x4 rA[8], rB[8];
#pragma unroll
        for (int i = 0; i < 8; ++i) rA[i] = *(const u32x4*)(EV8 + (size_t)(mb[8 * i + kl] & 0xffffu) * 128);
        int cur = 0;
#pragma unroll 1
        for (int t = t0; t < T; t += ts) {
            const int tn = (t + ts < T) ? t + ts : t;
            const unsigned gn0 = WI[(size_t)tn * 128 + L], gn1 = WI[(size_t)tn * 128 + 64 + L];
            float* o = c.out + (size_t)t * 1024 + col; const float* g2 = mod + (t >> 11) * 6144 + 5120 + col;
            f32x2 xo = *(const f32x2*)o; const f32x2 gt = *(const f32x2*)g2;
#pragma unroll
            for (int i = 0; i < 8; ++i) rB[i] = *(const u32x4*)(EV8 + (size_t)(mb[cur * 128 + 64 + 8 * i + kl] & 0xffffu) * 128);
            f32x2 ac2[8];
#pragma unroll
            for (int j = 0; j < 8; ++j) ac2[j] = (f32x2){0.f, 0.f};
#pragma unroll
            for (int i = 0; i < 8; ++i) { const float w = bfhi(mb[cur * 128 + 8 * i + kl]); const f32x2 w2 = {w, w}; const unsigned ww[4] = {rA[i].x, rA[i].y, rA[i].z, rA[i].w};
#pragma unroll
                for (int d = 0; d < 4; ++d) { ac2[2 * d] = ac2[2 * d] + __builtin_amdgcn_cvt_pk_f32_fp8((int)ww[d], false) * w2; ac2[2 * d + 1] = ac2[2 * d + 1] + __builtin_amdgcn_cvt_pk_f32_fp8((int)ww[d], true) * w2; }
                }
            mb[(cur ^ 1) * 128 + L] = gn0; mb[(cur ^ 1) * 128 + 64 + L] = gn1;
#pragma unroll
            for (int i = 0; i < 8; ++i) rA[i] = *(const u32x4*)(EV8 + (size_t)(mb[(cur ^ 1) * 128 + 8 * i + kl] & 0xffffu) * 128);
#pragma unroll
            for (int i = 0; i < 8; ++i) { const float w = bfhi(mb[cur * 128 + 64 + 8 * i + kl]); const f32x2 w2 = {w, w}; const unsigned ww[4] = {rB[i].x, rB[i].y, rB[i].z, rB[i].w};
#pragma unroll
                for (int d = 0; d < 4; ++d) { ac2[2 * d] = ac2[2 * d] + __builtin_amdgcn_cvt_pk_f32_fp8((int)ww[d], false) * w2; ac2[2 * d + 1] = ac2[2 * d + 1] + __builtin_amdgcn_cvt_pk_f32_fp8((int)ww[d], true) * w2; }
                }
            float acc[16];
#pragma unroll
            for (int j = 0; j < 8; ++j) { acc[2 * j] = ac2[j].x; acc[2 * j + 1] = ac2[j].y; }
            float n8[8], n4[4], n2[2];
#pragma unroll
            for (int i = 0; i < 8; ++i) { const float send = b5 ? acc[i] : acc[i + 8], keep = b5 ? acc[i + 8] : acc[i]; n8[i] = keep + __shfl_xor(send, 32); }
#pragma unroll
            for (int i = 0; i < 4; ++i) { const float send = b4 ? n8[i] : n8[i + 4], keep = b4 ? n8[i + 4] : n8[i]; n4[i] = keep + __shfl_xor(send, 16); }
#pragma unroll
            for (int i = 0; i < 2; ++i) { const float send = b3 ? n4[i] : n4[i + 2], keep = b3 ? n4[i + 2] : n4[i]; n2[i] = keep + __shfl_xor(send, 8); }
            xo.x += gt.x * n2[0]; xo.y += gt.y * n2[1];
            if (DRY) asm volatile("" :: "v"(xo.x), "v"(xo.y)); else *(f32x2*)o = xo;
            cur ^= 1;
        }
    }
}

struct FInProj { bf16_t *pa, *lx, *lg, *mg;
    __device__ __forceinline__ void operator()(int row, int pn, int cc, const float (&v0)[8], const float (&v1)[8]) const {
        bf16_t* d;
        if (pn < 2) d = pa + (size_t)row * 512 + pn * 256 + cc; else if (pn < 6) d = lx + (size_t)row * 1024 + (pn - 2) * 256 + cc;
        else if (pn < 10) d = lg + (size_t)row * 1024 + (pn - 6) * 256 + cc; else d = mg + (size_t)row * 2048 + (pn - 10) * 256 + cc;
        *(u32x4*)d = pack8(v0); *(u32x4*)(d + 128) = pack8(v1); } };
struct FRowScale { bf16_t* dst; int ldc; const float* rstd; int which;
    __device__ __forceinline__ void operator()(int row, int pn, int cc, const float (&v0)[8], const float (&v1)[8]) const {
        const float r = rstd[2 * row + which]; float a[8], b[8];
#pragma unroll
        for (int j = 0; j < 8; ++j) { a[j] = v0[j] * r; b[j] = v1[j] * r; }
        *(u32x4*)(dst + (size_t)row * ldc + pn * 256 + cc) = pack8(a); *(u32x4*)(dst + (size_t)row * ldc + pn * 256 + 128 + cc) = pack8(b); } };
struct FGates { const bf16_t* xc; bf16_t *LA, *Bv; const float *brg, *big, *c8sp;
    __device__ __forceinline__ void operator()(int row, int pn, int cc, const float (&v0)[8], const float (&v1)[8]) const {
        const int ch = pn * 128 + cc; float x[8], la[8], bv[8]; unpack8(*(const u32x4*)(xc + (size_t)row * 1024 + ch), x);
#pragma unroll
        for (int j = 0; j < 8; ++j) {
            const float r = __builtin_amdgcn_rcpf(1.f + __expf(-(v0[j] + brg[ch + j]))), ig = __builtin_amdgcn_rcpf(1.f + __expf(-(v1[j] + big[ch + j])));
            const float loga = r * c8sp[ch + j];
            const float z = 2.f * loga;
            const float ser = -z * (1.f + z * (0.5f + z * (0.16666667f + z * (0.041666668f + z * (0.008333334f + z * 0.0013888889f)))));
            const float om = (z > -0.25f) ? ser : (1.f - __expf(z));
            la[j] = loga * 1.4426950408889634f;
            bv[j] = sqrtf(om) * (ig * x[j]);
        }
        *(u32x4*)(LA + (size_t)row * 1024 + ch) = pack8(la); *(u32x4*)(Bv + (size_t)row * 1024 + ch) = pack8(bv); } };
struct FY1 { const bf16_t* mg; bf16_t* y; int goff; bool accum;
    __device__ __forceinline__ void one(int row, int col, const float (&v)[8]) const {
        float gt[8], o[8]; unpack8(*(const u32x4*)(mg + (size_t)row * 2048 + goff + col), gt);
        if (accum) unpack8(*(const u32x4*)(y + (size_t)row * 1024 + col), o);
#pragma unroll
        for (int j = 0; j < 8; ++j) o[j] = (accum ? o[j] : 0.f) + sigmoidf_(gt[j]) * v[j];
        *(u32x4*)(y + (size_t)row * 1024 + col) = pack8(o); }
    __device__ __forceinline__ void operator()(int row, int pn, int cc, const float (&v0)[8], const float (&v1)[8]) const { one(row, pn * 256 + cc, v0); one(row, pn * 256 + 128 + cc, v1); } };
struct FX1 { const float* x; float* out; const float* mod;
    __device__ __forceinline__ void one(int row, int col, const float (&v)[8]) const {
        const float* g1 = mod + (row >> 11) * 6144 + 2048 + col; const float* xr = x + (size_t)row * 1024 + col; float* o = out + (size_t)row * 1024 + col;
        const f32x4 x0 = *(const f32x4*)xr, x1 = *(const f32x4*)(xr + 4), a0 = *(const f32x4*)g1, a1 = *(const f32x4*)(g1 + 4);
        f32x4 r0, r1; r0.x = x0.x + a0.x * v[0]; r0.y = x0.y + a0.y * v[1]; r0.z = x0.z + a0.z * v[2]; r0.w = x0.w + a0.w * v[3];
        r1.x = x1.x + a1.x * v[4]; r1.y = x1.y + a1.y * v[5]; r1.z = x1.z + a1.z * v[6]; r1.w = x1.w + a1.w * v[7];
        *(f32x4*)o = r0; *(f32x4*)(o + 4) = r1; }
    __device__ __forceinline__ void operator()(int row, int pn, int cc, const float (&v0)[8], const float (&v1)[8]) const { one(row, pn * 256 + cc, v0); one(row, pn * 256 + 128 + cc, v1); } };
struct FStore { bf16_t* dst; int ldc;
    __device__ __forceinline__ void operator()(int row, int pn, int cc, const float (&v0)[8], const float (&v1)[8]) const {
        *(u32x4*)(dst + (size_t)row * ldc + pn * 256 + cc) = pack8(v0); *(u32x4*)(dst + (size_t)row * ldc + pn * 256 + 128 + cc) = pack8(v1); } };

template <int M, int N, int K, int LDA, int ACS, class F> __device__ __forceinline__ void run_gemm(const Ctx& c, const bf16_t* A, const bf16_t* Bt, const F& f) {
    pg8::Gemm g{A, Bt}; pg8::StaticOrder<M, N> So; So.init(c.G, (int)blockIdx.x);
    pg8::EpiF<F> E{f};
    pg8::gemm_phase<K, LDA, ACS, pg8::EpiF<F>, pg8::StaticOrder<M, N>>((PG8_LAS unsigned char*)c.lds, g, So, E, c.wave * 64 + lane_id_v());
}

__global__ void __launch_bounds__(512, 2) mk_fwd(Args args) {
    extern __shared__ __attribute__((aligned(16))) unsigned char lds_raw[];
    Ctx c;
    c.lds = (LAS unsigned char*)lds_raw;
    c.wave = __builtin_amdgcn_readfirstlane(threadIdx.x >> 6); c.lane = lane_id_v(); c.tid = c.wave * 64 + c.lane;
    c.G = gridDim.x; { const int bx = blockIdx.x; c.vcu = (c.G % 8 == 0) ? (bx % 8) * (c.G / 8) + bx / 8 : bx; }
    c.in = args.in; c.out = args.out; c.ws = args.ws;
    volatile LAS unsigned* MISC = (volatile LAS unsigned*)(c.lds + MISC_OFF);
    if (c.tid < 32) MISC[c.tid] = 0u;
    __syncthreads();
    XcdBarrier bar; bar.bar = (unsigned*)(c.ws + WS_CTL) + 4096; bar.x = 0; bar.st = nullptr;
    if (args.ph_hi - args.ph_lo > 1) bar = xcd_barrier_post((unsigned*)(c.ws + WS_CTL) + 4096, MISC + 8);

    const int lo = args.ph_lo, hi = args.ph_hi;
#ifndef ONLYP
#define ONLYP -1
#endif
#define IN(k) (lo <= (k) && (k) < hi && (ONLYP < 0 || ONLYP == (k)))
#define SEAM(k) do { if ((k) + 1 < hi) xcd_barrier(bar, c.wave); } while (0)
#ifndef REPEAT_MASK
#define REPEAT_MASK 0
#endif
#define PHASE(k, ...) if (IN(k)) { c.lane = lane_id_v(); c.tid = c.wave * 64 + c.lane; { __VA_ARGS__ } if ((REPEAT_MASK >> (k)) & 1) { xcd_barrier(bar, c.wave); { __VA_ARGS__ } } SEAM(k); }
    PHASE(0, phase_prep(c);)
    PHASE(1, phase_modnorm<false>(c, c.in[I_X], c.in[I_N1G], 0, 1024, WSP(bf16_t, WS_R0));)
    PHASE(2, FInProj f{WSP(bf16_t, WS_R1), WSP(bf16_t, WS_R2), WSP(bf16_t, WS_R3), (bf16_t*)c.out};
             run_gemm<T, 4608, 1024, 1024, 0>(c, WSP(bf16_t, WS_R0), WSP(bf16_t, WS_WIN), f);)
    PHASE(3, phase_conv(c);)
    PHASE(4, { FRowScale fq{WSP(bf16_t, WS_R5), 768, WSP(float, WS_RSTD), 0};
               run_gemm<T, 768, 256, 512, 0>(c, WSP(bf16_t, WS_R1), WSP(bf16_t, WS_WUQ), fq); }
             { FGates fg{WSP(bf16_t, WS_R4), WSP(bf16_t, WS_R0), WSP(bf16_t, WS_R6), c.in[I_BRG], c.in[I_BIG], WSP(float, WS_C8SP)};
               run_gemm<T, 2048, 128, 1024, 128>(c, WSP(bf16_t, WS_R4), WSP(bf16_t, WS_WG), fg); })
    PHASE(5, { FRowScale fkv{WSP(bf16_t, WS_R2), 1024, WSP(float, WS_RSTD), 1};
               run_gemm<T, 1024, 128, 512, 0>(c, WSP(bf16_t, WS_R1) + 256, WSP(bf16_t, WS_WUKV), fkv); }
             phase_scan(c);)
    PHASE(6, phase_qkv_layout(c);)
    PHASE(7, phase_attn(c);)
    PHASE(8, { FY1 f1{(const bf16_t*)c.out, WSP(bf16_t, WS_R2), 0, false};
               run_gemm<T, 1024, 512, 512, 0>(c, WSP(bf16_t, WS_R0 + 32 * MiB), WSP(bf16_t, WS_WOA), f1); }
             { FY1 f2{(const bf16_t*)c.out, WSP(bf16_t, WS_R2), 1024, true};
               run_gemm<T, 1024, 1024, 1024, 0>(c, WSP(bf16_t, WS_R6), WSP(bf16_t, WS_WOL), f2); })
    PHASE(9, FX1 f{c.in[I_X], c.out, WSP(float, WS_MOD)};
             run_gemm<T, 1024, 1024, 1024, 0>(c, WSP(bf16_t, WS_R2), WSP(bf16_t, WS_WOUT), f);)
    PHASE(10, phase_modnorm<false>(c, c.out, c.in[I_N2G], 3072, 4096, WSP(bf16_t, WS_R0));)
    PHASE(11, FStore f{WSP(bf16_t, WS_QP), 2048};
              run_gemm<T, 2048, 1024, 1024, 0>(c, WSP(bf16_t, WS_R0), WSP(bf16_t, WS_WQ), f);)
    PHASE(12, FStore f{WSP(bf16_t, WS_SC), 2048};
              run_gemm<T, 2048, 256, 2048, 256>(c, WSP(bf16_t, WS_QP), WSP(bf16_t, WS_SK), f);)
    PHASE(13, phase_topk(c);)
    PHASE(14, phase_peer_u(c);)
    PHASE(15, phase_peer_fin(c);)
#ifdef PROBE_VDRY
    if (IN(16)) { c.lane = lane_id_v(); c.tid = c.wave * 64 + c.lane; phase_peer_v<true>(c); xcd_barrier(bar, c.wave); }
#endif
    PHASE(16, phase_peer_v<false>(c);)
#undef PHASE
#undef IN
#undef SEAM
}

extern "C" void kernel_launch(void* const* d_in, const int* in_sizes, int n_in, void* d_out, int out_size, void* d_ws, size_t ws_size, hipStream_t stream) {
    static int grid = 0;
    if (grid == 0) {
        if (n_in != 28 || out_size != T * D || ws_size < WS_END) { fprintf(stderr, "kernel_launch: unexpected shapes (n_in %d out %d ws %zu)\n", n_in, out_size, ws_size); grid = -1; return; }
        int dev = 0, cus = 0, per_cu = 0;
        if (hipGetDevice(&dev) != hipSuccess || hipDeviceGetAttribute(&cus, hipDeviceAttributeMultiprocessorCount, dev) != hipSuccess) { grid = -1; return; }
        if (hipFuncSetAttribute((const void*)mk_fwd, hipFuncAttributeMaxDynamicSharedMemorySize, LDS_BYTES) != hipSuccess) { fprintf(stderr, "kernel_launch: hipFuncSetAttribute failed\n"); grid = -1; return; }
        if (hipOccupancyMaxActiveBlocksPerMultiprocessor(&per_cu, (const void*)mk_fwd, 512, LDS_BYTES) != hipSuccess || per_cu < 1) { fprintf(stderr, "kernel_launch: occupancy query says %d blocks per CU\n", per_cu); grid = -1; (void)hipGetLastError(); return; }
        grid = cus;
    }
    if (grid < 0) return;
    (void)hipMemsetAsync((char*)d_ws + WS_CTL, 0, CTL_ZERO_BYTES, stream);
    Args a{};
    for (int i = 0; i < 28; ++i) a.in[i] = (const float*)d_in[i];
    a.out = (float*)d_out; a.ws = (unsigned char*)d_ws;
#if MK_N_LAUNCHES == 1
    a.ph_lo = 0; a.ph_hi = N_PHASES;
    hipLaunchKernelGGL(mk_fwd, dim3(grid), dim3(512), LDS_BYTES, stream, a);
#else
    for (int ph = 0; ph < N_PHASES; ++ph) { a.ph_lo = ph; a.ph_hi = ph + 1; hipLaunchKernelGGL(mk_fwd, dim3(grid), dim3(512), LDS_BYTES, stream, a); }
#endif
}
```

```cpp
#include <hip/hip_runtime.h>
#include <cstdio>
#include <cstdint>

#define LAS __attribute__((address_space(3)))
#define GAS __attribute__((address_space(1)))
typedef unsigned short bf16_t;
typedef short bf16x8 __attribute__((ext_vector_type(8)));
typedef float f32x4 __attribute__((ext_vector_type(4)));
typedef float f32x2 __attribute__((ext_vector_type(2)));
typedef unsigned u32x4 __attribute__((ext_vector_type(4)));
typedef unsigned u32x2 __attribute__((ext_vector_type(2)));

#ifndef MK_N_LAUNCHES
#define MK_N_LAUNCHES 1
#endif

constexpr int T = 32768, D = 1024, NB_ = 16, S = 2048, H = 8;
constexpr int QKH = 96, VH = 64;
constexpr int NE = 16384;
constexpr float EPS = 1e-6f;

constexpr size_t MiB = 1u << 20;
constexpr size_t WS_CTL = 0, CTL_ZERO_BYTES = 65536;
constexpr size_t WS_MOD = 1 * MiB;
constexpr size_t WS_RSTD = 1 * MiB + 512 * 1024;
constexpr size_t WS_C8SP = 1 * MiB + 448 * 1024;
constexpr size_t WS_WIN = 2 * MiB;
constexpr size_t WS_WUQ = 11 * MiB;
constexpr size_t WS_WUKV = 11 * MiB + 512 * 1024;
constexpr size_t WS_WOA = 12 * MiB;
constexpr size_t WS_WOL = 13 * MiB;
constexpr size_t WS_WOUT = 15 * MiB;
constexpr size_t WS_WQ = 17 * MiB;
constexpr size_t WS_WG = 21 * MiB;
constexpr size_t WS_SK = 22 * MiB;
constexpr size_t WS_EU = 24 * MiB;
constexpr size_t WS_EV = 40 * MiB;
constexpr size_t WS_SU = 1 * MiB + 768 * 1024;
constexpr size_t WS_SV = 1 * MiB + 832 * 1024;
constexpr size_t WS_WGT = 440 * MiB;
constexpr size_t WS_CS = 56 * MiB;
constexpr size_t WS_H2Q = 60 * MiB;
constexpr size_t WS_SH = 1 * MiB + 896 * 1024;
constexpr size_t WS_PD = 280 * MiB;
constexpr size_t WS_R0 = 88 * MiB;
constexpr size_t WS_R1 = 152 * MiB;
constexpr size_t WS_R2 = 184 * MiB;
constexpr size_t WS_R3 = 248 * MiB;
constexpr size_t WS_R4 = 312 * MiB;
constexpr size_t WS_R5 = 376 * MiB;
constexpr size_t WS_R6 = 424 * MiB;
constexpr size_t WS_QP = 152 * MiB;
constexpr size_t WS_SC = 280 * MiB;
constexpr size_t WS_IDX = 408 * MiB;
constexpr size_t WS_GW = 424 * MiB;
constexpr size_t WS_END = 488 * MiB;

constexpr int LDS_BYTES = 147456;
constexpr int MISC_OFF = 131072 + 320;

__device__ __forceinline__ unsigned f2bf(float f) { unsigned u = __builtin_bit_cast(unsigned, f); return (u + 0x7fffu + ((u >> 16) & 1u)) >> 16; }
typedef __bf16 bf16x2_t __attribute__((ext_vector_type(2)));
__device__ __forceinline__ unsigned pk2(float lo, float hi) { f32x2 v = {lo, hi}; return __builtin_bit_cast(unsigned, __builtin_convertvector(v, bf16x2_t)); }
__device__ __forceinline__ float bf2f(unsigned h) { return __builtin_bit_cast(float, h << 16); }
__device__ __forceinline__ float bflo(unsigned w) { return __builtin_bit_cast(float, w << 16); }
__device__ __forceinline__ float bfhi(unsigned w) { return __builtin_bit_cast(float, w & 0xffff0000u); }
__device__ __forceinline__ float sigmoidf_(float x) { return 1.f / (1.f + __expf(-x)); }
__device__ __forceinline__ float gelu_tanh(float x) {
    const float u = 0.7978845608028654f * (x + 0.044715f * x * x * x);
    const float e = __expf(2.f * u);
    const float th = 1.f - 2.f / (e + 1.f);
    return 0.5f * x * (1.f + th);
}
__device__ __forceinline__ int lane_id_v() { int l; asm volatile("v_mbcnt_lo_u32_b32 %0, -1, 0\n\tv_mbcnt_hi_u32_b32 %0, -1, %0" : "=v"(l)); return l; }
__device__ __forceinline__ float wave_sum(float v) {
#pragma unroll
    for (int o = 1; o < 64; o <<= 1) v += __shfl_xor(v, o);
    return v;
}
__device__ __forceinline__ void unpack8(const u32x4 w, float (&v)[8]) {
    v[0] = bflo(w.x); v[1] = bfhi(w.x); v[2] = bflo(w.y); v[3] = bfhi(w.y); v[4] = bflo(w.z); v[5] = bfhi(w.z); v[6] = bflo(w.w); v[7] = bfhi(w.w);
}
__device__ __forceinline__ u32x4 pack8(const float (&v)[8]) {
    u32x4 w; w.x = pk2(v[0], v[1]); w.y = pk2(v[2], v[3]); w.z = pk2(v[4], v[5]); w.w = pk2(v[6], v[7]); return w;
}

namespace pg8 {
#define PG8_LAS __attribute__((address_space(3)))
constexpr int BM = 256, BK = 64, HALF = 128, HTB = HALF * BK * 2, STAGE_BYTES = 8 * HTB, NXCD = 8, WGM = 8;
__host__ __device__ __forceinline__ int lds_byte(int r, int c) { const int st = (r >> 4) * 2 + (c >> 5), rr = r & 15, cc = c & 31, ob = rr * 64 + cc * 2; return st * 1024 + (ob ^ (((ob >> 9) & 1) << 5)); }
__host__ __device__ __forceinline__ void stage_rc(int b, int& R, int& C) { const int st = b / 1024, sb = b % 1024, swz = sb ^ (((sb >> 9) & 1) << 5); R = (st >> 1) * 16 + swz / 64; C = (st & 1) * 32 + (swz % 64) / 2; }
__host__ __device__ __forceinline__ int perm32(int rho) { const int n = rho >> 4, i = rho & 15; return 8 * (i >> 2) + 4 * n + (i & 3); }

struct Unit { int pm, pn; };
struct Gemm { const bf16_t* A; const bf16_t* Bt; };

template <int M_, int N_> struct StaticOrder {
    static constexpr int nM = M_ / BM, nN = N_ / BM, nwg = nM * nN;
    int G, c;
    __host__ __device__ void init(int G_, int c_) { G = G_; c = c_; }
    __host__ __device__ bool next(int i, Unit& u) const {
        const long L = (long)i * G + c; if (L >= nwg) return false;
        int wgid = (int)L; { const int q = nwg / NXCD, r = nwg % NXCD, xcd = wgid % NXCD, off = wgid / NXCD; wgid = (xcd < r ? xcd * (q + 1) : r * (q + 1) + (xcd - r) * q) + off; }
        const int nig = WGM * nN, gid = wgid / nig, fm = gid * WGM, gsz = (nM - fm) < WGM ? (nM - fm) : WGM;
        u.pm = fm + ((wgid % nig) % gsz); u.pn = (wgid % nig) / gsz; return true;
    }
};

template <class F> struct EpiF {
    static constexpr bool PERM = true;
    F f;
    __device__ __forceinline__ void operator()(const f32x4 (&acc)[2][2][4][2], const Unit& u, int wr, int wc, int fr, int fq) const {
        const int c = wc * 32 + 8 * fq;
#pragma unroll
        for (int ai = 0; ai < 2; ++ai)
#pragma unroll
            for (int m = 0; m < 4; ++m) {
                const int row = u.pm * BM + ai * HALF + wr * 64 + m * 16 + fr;
                float v0[8], v1[8];
#pragma unroll
                for (int j = 0; j < 4; ++j) { v0[j] = acc[ai][0][m][0][j]; v0[4 + j] = acc[ai][0][m][1][j]; v1[j] = acc[ai][1][m][0][j]; v1[4 + j] = acc[ai][1][m][1][j]; }
                f(row, u.pn, c, v0, v1);
            }
    }
};

template <int K, int LDA, int ACS, class Epi, class Sched>
__device__ __forceinline__ void gemm_phase(PG8_LAS unsigned char* lds, const Gemm g, const Sched& S, const Epi& E, const int tid) {
    const int wid = __builtin_amdgcn_readfirstlane(tid >> 6), lane = tid & 63, wr = wid >> 2, wc = wid & 3, fr = lane & 15, fq = lane >> 4;
    constexpr int nt = K / BK;
    unsigned voffA[2], voffB[2];
#pragma unroll
    for (int i = 0; i < 2; ++i) { int R, C; stage_rc(tid * 16 + i * 8192, R, C); const int Rb = Epi::PERM ? ((R & ~31) + perm32(R & 31)) : R;
        voffA[i] = (unsigned)(R * LDA + C) * 2u; voffB[i] = (unsigned)(Rb * K + C) * 2u; }
    constexpr size_t kstep = (size_t)(BK * 2);
    constexpr size_t hstepA = (size_t)HALF * LDA * 2, hstepB = (size_t)HALF * K * 2;
    constexpr size_t tstepA = 2 * hstepA, tstepB = 2 * hstepB;
    constexpr size_t acsb = (size_t)ACS * 2;
    const unsigned ldsw = (unsigned)wid * 1024u;
    const int aoff = lds_byte(wr * 64 + fr, fq * 8), boff = lds_byte(wc * 32 + fr, fq * 8);
#define PG8_SA(b, h) (((b) * 2 + (h)) * HTB)
#define PG8_SB(b, h) ((4 + (b) * 2 + (h)) * HTB)
#define PG8_STAGE(bufoff, gbase, voff) do { _Pragma("unroll") for (int _i = 0; _i < 2; ++_i) \
        __builtin_amdgcn_global_load_lds((const unsigned*)((const char*)(gbase) + (voff)[_i]), (PG8_LAS unsigned*)(lds + (bufoff) + ldsw + _i * 8192), 16, 0, 0); } while (0)
#define PG8_LDA(dst, b, h) do { _Pragma("unroll") for (int m = 0; m < 4; ++m) _Pragma("unroll") for (int k = 0; k < 2; ++k) dst[m][k] = *(const PG8_LAS bf16x8*)(lds + PG8_SA(b, h) + aoff + m * 2048 + k * 1024); } while (0)
#define PG8_LDB(dst, b, h) do { _Pragma("unroll") for (int n = 0; n < 2; ++n) _Pragma("unroll") for (int k = 0; k < 2; ++k) dst[n][k] = *(const PG8_LAS bf16x8*)(lds + PG8_SB(b, h) + boff + n * 2048 + k * 1024); } while (0)
#define PG8_MMA(ai, bj, At, Bt) do { __builtin_amdgcn_s_setprio(1); _Pragma("unroll") for (int m = 0; m < 4; ++m) _Pragma("unroll") for (int n = 0; n < 2; ++n) _Pragma("unroll") for (int k = 0; k < 2; ++k) \
        acc[ai][bj][m][n] = __builtin_amdgcn_mfma_f32_16x16x32_bf16(Bt[n][k], At[m][k], acc[ai][bj][m][n], 0, 0, 0); __builtin_amdgcn_s_setprio(0); } while (0)
#define PG8_WAIT_V(n) asm volatile("s_waitcnt vmcnt(" #n ")" ::: "memory")
#define PG8_WAIT_L(n) asm volatile("s_waitcnt lgkmcnt(" #n ")" ::: "memory")
#define PG8_BAR __builtin_amdgcn_s_barrier()
#define PG8_SCHED __builtin_amdgcn_sched_barrier(0)
    Unit cur, nxt; int ui = 0;
    if (!S.next(0, cur)) return;
    f32x4 acc[2][2][4][2];
#pragma unroll
    for (int a = 0; a < 2; ++a)
#pragma unroll
        for (int b = 0; b < 2; ++b)
#pragma unroll
            for (int m = 0; m < 4; ++m)
#pragma unroll
                for (int n = 0; n < 2; ++n) acc[a][b][m][n] = (f32x4){0.f, 0.f, 0.f, 0.f};
    bf16x8 At[4][2], B0[2][2], B1[2][2];
    const char* cA = (const char*)g.A + (size_t)cur.pm * tstepA + (size_t)cur.pn * acsb; const char* cB = (const char*)g.Bt + (size_t)cur.pn * tstepB;
    PG8_STAGE(PG8_SB(0, 0), cB, voffB); PG8_STAGE(PG8_SB(0, 1), cB + hstepB, voffB); PG8_STAGE(PG8_SA(0, 0), cA, voffA); PG8_STAGE(PG8_SA(0, 1), cA + hstepA, voffA);
    if (wr == 1) PG8_BAR;
    PG8_WAIT_V(2); PG8_BAR;
    PG8_STAGE(PG8_SB(1, 0), cB + kstep, voffB); PG8_STAGE(PG8_SA(1, 0), cA + kstep, voffA); PG8_STAGE(PG8_SB(1, 1), cB + hstepB + kstep, voffB);
    PG8_WAIT_V(6); PG8_BAR;
    for (;;) {
        const bool has_next = S.next(ui + 1, nxt);
        const char* nA = has_next ? (const char*)g.A + (size_t)nxt.pm * tstepA + (size_t)nxt.pn * acsb : cA; const char* nB = has_next ? (const char*)g.Bt + (size_t)nxt.pn * tstepB : cB;
#pragma unroll 1
        for (int t = 0; t < nt; t += 2) {
            const bool last = (t == nt - 2);
            const char* a1 = cA + (size_t)(t + 1) * kstep;
            const char* a2 = last ? nA : cA + (size_t)(t + 2) * kstep; const char* b2 = last ? nB : cB + (size_t)(t + 2) * kstep;
            const char* a3 = a2 + kstep; const char* b3 = b2 + kstep;
            PG8_LDB(B0, 0, 0); PG8_LDB(B1, 0, 1); PG8_SCHED; PG8_LDA(At, 0, 0); PG8_STAGE(PG8_SA(1, 1), a1 + hstepA, voffA);
            PG8_WAIT_V(8); PG8_WAIT_L(0); PG8_BAR; PG8_MMA(0, 0, At, B0); PG8_MMA(0, 1, At, B1); PG8_BAR; PG8_SCHED;
            PG8_LDA(At, 0, 1); PG8_STAGE(PG8_SB(0, 0), b2, voffB); PG8_STAGE(PG8_SB(0, 1), b2 + hstepB, voffB); PG8_STAGE(PG8_SA(0, 0), a2, voffA);
            PG8_WAIT_V(8); PG8_WAIT_L(0); PG8_BAR; PG8_MMA(1, 0, At, B0); PG8_MMA(1, 1, At, B1); PG8_BAR; PG8_SCHED;
            PG8_LDB(B0, 1, 0); PG8_LDB(B1, 1, 1); PG8_SCHED; PG8_LDA(At, 1, 0); PG8_STAGE(PG8_SA(0, 1), a2 + hstepA, voffA);
            PG8_WAIT_V(8); PG8_WAIT_L(0); PG8_BAR; PG8_MMA(0, 0, At, B0); PG8_MMA(0, 1, At, B1); PG8_BAR; PG8_SCHED;
            PG8_LDA(At, 1, 1); PG8_STAGE(PG8_SB(1, 0), b3, voffB); PG8_STAGE(PG8_SB(1, 1), b3 + hstepB, voffB); PG8_STAGE(PG8_SA(1, 0), a3, voffA);
            PG8_WAIT_V(8); PG8_WAIT_L(0); PG8_BAR; PG8_MMA(1, 0, At, B0); PG8_MMA(1, 1, At, B1); PG8_BAR; PG8_SCHED;
        }
        if (wr == 0) PG8_BAR;
        E(acc, cur, wr, wc, fr, fq);
        if (!has_next) break;
#pragma unroll
        for (int a = 0; a < 2; ++a)
#pragma unroll
            for (int b = 0; b < 2; ++b)
#pragma unroll
                for (int m = 0; m < 4; ++m)
#pragma unroll
                    for (int n = 0; n < 2; ++n) acc[a][b][m][n] = (f32x4){0.f, 0.f, 0.f, 0.f};
        cur = nxt; cA = nA; cB = nB; ++ui;
        if (wr == 1) PG8_BAR;
    }
    PG8_WAIT_V(0);
    PG8_BAR;
#undef PG8_SA
#undef PG8_SB
#undef PG8_STAGE
#undef PG8_LDA
#undef PG8_LDB
#undef PG8_MMA
#undef PG8_WAIT_V
#undef PG8_WAIT_L
#undef PG8_BAR
#undef PG8_SCHED
}
}

#define XB_TMO      128
#define XB_XCNT(j)  (256  + 64 * (j))
#define XB_XSUB(j)  (1280 + 64 * (j))
#define XB_XGEN(j)  (2304 + 64 * (j))
#define XB_TOP      3328
#define XB_TOPGEN   3392
#define XCD_BAR_WORDS 3456
#define XB_SPIN_CAP (1u << 18)
__device__ __forceinline__ unsigned xb_ld(unsigned* p)              { return __hip_atomic_load(p, __ATOMIC_RELAXED, __HIP_MEMORY_SCOPE_AGENT); }
__device__ __forceinline__ unsigned xb_add(unsigned* p, unsigned v) { return __hip_atomic_fetch_add(p, v, __ATOMIC_RELAXED, __HIP_MEMORY_SCOPE_AGENT); }
__device__ __forceinline__ unsigned xb_xcc_id() { return (unsigned)__builtin_amdgcn_s_getreg((3 << 11) | 20) & 0xFu; }
#define XB_SPIN(cond, bar) do { unsigned _sp = 0; while (cond) { __builtin_amdgcn_s_sleep(1); \
    if ((++_sp & 255u) == 0u) { if (xb_ld(&(bar)[XB_TMO])) break; if (_sp > XB_SPIN_CAP) { atomicAdd(&(bar)[XB_TMO], 1u); break; } } } } while (0)
struct XcdBarrier { unsigned* bar; unsigned x; volatile LAS unsigned* st; };
__device__ __forceinline__ XcdBarrier xcd_barrier_post(unsigned* bar, volatile LAS unsigned* st) {
    XcdBarrier b; b.bar = bar; b.x = xb_xcc_id(); b.st = st;
    if (threadIdx.x == 0) (void)xb_add(&bar[XB_XCNT(b.x)], 1u);
    return b;
}
__device__ __forceinline__ void xcd_barrier_complete(unsigned* bar, unsigned x, unsigned& nloc, unsigned& nx) {
    const unsigned G = gridDim.x * gridDim.y * gridDim.z;
    unsigned sum, cnt, mine, sp = 0u;
    for (;;) {
        sum = 0u; cnt = 0u; mine = 0u;
#pragma unroll
        for (unsigned j = 0; j < 16; ++j) { const unsigned c = xb_ld(&bar[XB_XCNT(j)]); sum += c; cnt += (c > 0u) ? 1u : 0u; mine = (j == x) ? c : mine; }
        if (sum == G) break;
        __builtin_amdgcn_s_sleep(1);
        if ((++sp & 255u) == 0u) { if (xb_ld(&bar[XB_TMO])) break; if (sp > XB_SPIN_CAP) { atomicAdd(&bar[XB_TMO], 1u); break; } }
    }
    nloc = mine > 0u ? mine : 1u; nx = cnt > 0u ? cnt : 1u;
}
__device__ __forceinline__ void xcd_barrier(const XcdBarrier& b, int wave) {
    asm volatile("s_waitcnt vmcnt(0)" ::: "memory");
    __syncthreads();
    if (wave == 0 && lane_id_v() == 0) {
        unsigned* bar = b.bar;
        __builtin_amdgcn_s_waitcnt(0);
        unsigned nloc = b.st[0], nx = b.st[1];
        if (nloc == 0u) { xcd_barrier_complete(bar, b.x, nloc, nx); b.st[0] = nloc; b.st[1] = nx; }
        const unsigned old = xb_add(&bar[XB_XSUB(b.x)], 1u);
        const unsigned gen = old / nloc;
        if (old + 1u == (gen + 1u) * nloc) {
            __builtin_amdgcn_fence(__ATOMIC_RELEASE, "agent");
            asm volatile("s_waitcnt vmcnt(0)" ::: "memory");
            const unsigned og = xb_add(&bar[XB_TOP], 1u);
            const unsigned tg = og / nx;
            if (og + 1u == (tg + 1u) * nx) xb_add(&bar[XB_TOPGEN], 1u);
            else XB_SPIN(xb_ld(&bar[XB_TOPGEN]) == tg, bar);
            __builtin_amdgcn_fence(__ATOMIC_ACQUIRE, "agent");
            xb_add(&bar[XB_XGEN(b.x)], 1u);
            asm volatile("s_waitcnt vmcnt(0)" ::: "memory");
        } else {
            XB_SPIN(xb_ld(&bar[XB_XGEN(b.x)]) == gen, bar);
            __builtin_amdgcn_fence(__ATOMIC_ACQUIRE, "agent");
            asm volatile("s_waitcnt vmcnt(0)" ::: "memory");
        }
    }
    __syncthreads();
}

struct Args { const float* in[28]; float* out; unsigned char* ws; int ph_lo, ph_hi; };
enum { I_X = 0, I_C, I_POS, I_WADA, I_BADA, I_N1G, I_WIN, I_QAG, I_WUQ, I_KVAG, I_WUKV, I_QNG, I_KNG, I_WOA, I_CONVW, I_CONVB, I_WRG, I_BRG, I_WIG, I_BIG, I_LAM, I_WOL, I_WOUT, I_N2G, I_WQ, I_SUBK, I_EU, I_EV };
constexpr int N_PHASES = 17;

struct Ctx {
    LAS unsigned char* lds;
    int tid, lane, wave, vcu, G;
    const float* const* in; float* out; unsigned char* ws;
};
#define WSP(type, off) ((type*)(c.ws + (off)))

template <class F>
__device__ __forceinline__ void tr_tile(const Ctx& c, bf16_t* dst, int K, int n0, int k0, F f) {
    LAS float* scr = (LAS float*)c.lds;
#pragma unroll
    for (int i = 0; i < 8; ++i) { const int kk = i * 8 + (c.tid >> 6), nn = c.tid & 63; scr[kk * 65 + nn] = f(k0 + kk, n0 + nn); }
    __syncthreads();
    { const int kc = c.tid & 7, nn = c.tid >> 3;
      LAS const float* s = scr + (8 * kc) * 65 + nn;
      u32x4 o; o.x = pk2(s[0], s[65]); o.y = pk2(s[2 * 65], s[3 * 65]); o.z = pk2(s[4 * 65], s[5 * 65]); o.w = pk2(s[6 * 65], s[7 * 65]);
      *(u32x4*)(dst + (size_t)(n0 + nn) * K + k0 + 8 * kc) = o; }
    __syncthreads();
}

__device__ __forceinline__ void phase_prep(const Ctx& c0) {
    Ctx c = c0; c.lane = lane_id_v(); c.tid = c.wave * 64 + c.lane;
    const float* w_in = c.in[I_WIN]; const float* w_uq = c.in[I_WUQ]; const float* qag = c.in[I_QAG]; const float* w_ukv = c.in[I_WUKV]; const float* kvag = c.in[I_KVAG];
    const float* w_oa = c.in[I_WOA]; const float* w_ol = c.in[I_WOL]; const float* w_out = c.in[I_WOUT]; const float* w_q = c.in[I_WQ];
    const float* w_rg = c.in[I_WRG]; const float* w_ig = c.in[I_WIG];
    constexpr int T_WIN = 72 * 16, T_WUQ = 12 * 4, T_WUKV = 16 * 2, T_WOA = 16 * 8, T_WOL = 16 * 16, T_WOUT = 16 * 16, T_WQ = 32 * 16, T_WG = 8 * 4 * 2;
    constexpr int T_ALL = T_WIN + T_WUQ + T_WUKV + T_WOA + T_WOL + T_WOUT + T_WQ + T_WG;
    for (int it = c.vcu; it < T_ALL; it += c.G) {
        int r = it;
        if (r < T_WIN) { const int nb = r / 16, kb = r % 16;
            tr_tile(c, WSP(bf16_t, WS_WIN), 1024, nb * 64, kb * 64, [=](int k, int n) -> float { return n < 416 ? w_in[(size_t)k * 4512 + n] : (n < 512 ? 0.f : w_in[(size_t)k * 4512 + n - 96]); }); continue; }
        r -= T_WIN;
        if (r < T_WUQ) { const int nb = r / 4, kb = r % 4;
            tr_tile(c, WSP(bf16_t, WS_WUQ), 256, nb * 64, kb * 64, [=](int k, int n) -> float { return w_uq[(size_t)k * 768 + n] * qag[k]; }); continue; }
        r -= T_WUQ;
        if (r < T_WUKV) { const int nb = r / 2, kb = r % 2;
            tr_tile(c, WSP(bf16_t, WS_WUKV), 128, nb * 64, kb * 64, [=](int k, int n) -> float { return w_ukv[(size_t)k * 1024 + n] * kvag[k]; }); continue; }
        r -= T_WUKV;
        if (r < T_WOA) { const int nb = r / 8, kb = r % 8;
            tr_tile(c, WSP(bf16_t, WS_WOA), 512, nb * 64, kb * 64, [=](int k, int n) -> float { return w_oa[(size_t)k * 1024 + n]; }); continue; }
        r -= T_WOA;
        if (r < T_WOL) { const int nb = r / 16, kb = r % 16;
            tr_tile(c, WSP(bf16_t, WS_WOL), 1024, nb * 64, kb * 64, [=](int k, int n) -> float { return w_ol[(size_t)k * 1024 + n]; }); continue; }
        r -= T_WOL;
        if (r < T_WOUT) { const int nb = r / 16, kb = r % 16;
            tr_tile(c, WSP(bf16_t, WS_WOUT), 1024, nb * 64, kb * 64, [=](int k, int n) -> float { return w_out[(size_t)k * 1024 + n]; }); continue; }
        r -= T_WOUT;
        if (r < T_WQ) { const int nb = r / 16, kb = r % 16;
            tr_tile(c, WSP(bf16_t, WS_WQ), 1024, nb * 64, kb * 64, [=](int k, int n) -> float { return w_q[(size_t)k * 2048 + n]; }); continue; }
        r -= T_WQ;
        { const int blk = r / 8, q = r % 8, nb = q / 2, kb = q % 2;
            tr_tile(c, WSP(bf16_t, WS_WG) + (size_t)blk * 256 * 128, 128, nb * 64, kb * 64,
                    [=](int k, int n) -> float { return n < 128 ? w_rg[((size_t)blk * 128 + k) * 128 + n] : w_ig[((size_t)blk * 128 + k) * 128 + n - 128]; }); }
    }
    { const float* lam = c.in[I_LAM]; float* t8 = WSP(float, WS_C8SP);
      if (c.vcu == 0) for (int e = c.tid; e < 1024; e += 512) t8[e] = -8.f * log1pf(__expf(-lam[e])); }
    { const float* sk = c.in[I_SUBK]; bf16_t* dst = WSP(bf16_t, WS_SK);
      for (int e = c.vcu * 512 + c.tid; e < 8 * 256 * 256; e += c.G * 512) {
          const int h = e >> 16, r = (e >> 8) & 255, cc = e & 255;
          float v = 0.f; if ((r >> 7) == (cc >> 7)) v = sk[(((size_t)h * 2 + (r >> 7)) * 128 + (r & 127)) * 128 + (cc & 127)];
          dst[e] = (bf16_t)f2bf(v); } }
    { const int gw = c.vcu * 8 + c.wave, NGW = c.G * 8, L = c.lane;
      for (int r = gw; r < 2 * NE; r += NGW) {
          const int isv = r >= NE, e = isv ? r - NE : r;
          const f32x4* src4 = (const f32x4*)((isv ? c.in[I_EV] : c.in[I_EU]) + (size_t)e * 1024 + 16 * L);
          f32x4 v[4]; float am = 0.f;
#pragma unroll
          for (int j = 0; j < 4; ++j) { v[j] = src4[j]; am = fmaxf(am, fmaxf(fmaxf(fabsf(v[j].x), fabsf(v[j].y)), fmaxf(fabsf(v[j].z), fabsf(v[j].w)))); }
#pragma unroll
          for (int o = 1; o < 64; o <<= 1) am = fmaxf(am, __shfl_xor(am, o));
          const float s = am > 0.f ? am * (1.f / 6.f) : 1.f, inv = 1.f / s;
          unsigned w0 = 0u, w1 = 0u;
          w0 = __builtin_amdgcn_cvt_scalef32_pk_fp4_f32(w0, v[0].x * inv, v[0].y * inv, 1.0f, 0); w0 = __builtin_amdgcn_cvt_scalef32_pk_fp4_f32(w0, v[0].z * inv, v[0].w * inv, 1.0f, 1);
          w0 = __builtin_amdgcn_cvt_scalef32_pk_fp4_f32(w0, v[1].x * inv, v[1].y * inv, 1.0f, 2); w0 = __builtin_amdgcn_cvt_scalef32_pk_fp4_f32(w0, v[1].z * inv, v[1].w * inv, 1.0f, 3);
          w1 = __builtin_amdgcn_cvt_scalef32_pk_fp4_f32(w1, v[2].x * inv, v[2].y * inv, 1.0f, 0); w1 = __builtin_amdgcn_cvt_scalef32_pk_fp4_f32(w1, v[2].z * inv, v[2].w * inv, 1.0f, 1);
          w1 = __builtin_amdgcn_cvt_scalef32_pk_fp4_f32(w1, v[3].x * inv, v[3].y * inv, 1.0f, 2); w1 = __builtin_amdgcn_cvt_scalef32_pk_fp4_f32(w1, v[3].z * inv, v[3].w * inv, 1.0f, 3);
          u32x2 q; q.x = w0; q.y = w1;
          *(u32x2*)(c.ws + (isv ? WS_EV : WS_EU) + ((size_t)(L >> 4) * NE + e) * 128 + (L & 15) * 8) = q;
          if (L == 0) WSP(float, isv ? WS_SV : WS_SU)[e] = s;
      } }
    { const float* cin = c.in[I_C]; const float* w_ada = c.in[I_WADA]; const float* b_ada = c.in[I_BADA]; float* mod = WSP(float, WS_MOD);
      LAS float* cs = (LAS float*)c.lds;
      LAS float* red = (LAS float*)(c.lds + 65536);
      bool have = false;
      for (int it = c.vcu; it < 192; it += c.G) {
          if (!have) { for (int e = c.tid; e < 16 * 1024; e += 512) { const float v = cin[e]; cs[e] = v / (1.f + __expf(-v)); } have = true; }
          __syncthreads();
          const int cl = c.tid & 31, ks = c.tid >> 5, j = it * 32 + cl;
          float acc[16];
#pragma unroll
          for (int b = 0; b < 16; ++b) acc[b] = 0.f;
          for (int kk = 0; kk < 64; ++kk) { const int k = ks * 64 + kk; const float w = w_ada[(size_t)k * 6144 + j];
#pragma unroll
              for (int b = 0; b < 16; ++b) acc[b] += cs[b * 1024 + k] * w; }
#pragma unroll
          for (int b = 0; b < 16; ++b) red[(ks * 16 + b) * 32 + cl] = acc[b];
          __syncthreads();
          { const int b = c.tid >> 5; float s = b_ada[j];
#pragma unroll
            for (int k2 = 0; k2 < 16; ++k2) s += red[(k2 * 16 + b) * 32 + cl];
            mod[b * 6144 + j] = s; }
          __syncthreads();
      } }
}

template <bool Q8>
__device__ __forceinline__ void phase_modnorm(const Ctx& c0, const float* x, const float* g, int shift_off, int scale_off, bf16_t* dst) {
    Ctx c = c0; c.lane = lane_id_v(); c.tid = c.wave * 64 + c.lane;
    const float* mod = WSP(float, WS_MOD);
    const int gw = c.vcu * 8 + c.wave, NGW = c.G * 8;
    for (int m = gw; m < T; m += NGW) {
        const int b = m >> 11;
        const f32x4* xr = (const f32x4*)(x + (size_t)m * D) + c.lane;
        f32x4 v[4]; float s = 0.f;
#pragma unroll
        for (int j = 0; j < 4; ++j) { v[j] = xr[64 * j]; s += (v[j].x * v[j].x + v[j].y * v[j].y) + (v[j].z * v[j].z + v[j].w * v[j].w); }
        const float rstd = rsqrtf(wave_sum(s) * (1.f / D) + EPS);
        u32x2* o8 = (u32x2*)(dst + (size_t)m * D) + c.lane;
        float am = 0.f;
#pragma unroll
        for (int j = 0; j < 4; ++j) {
            const int col = 4 * c.lane + 256 * j;
            const f32x4 gg = *(const f32x4*)(g + col), sc = *(const f32x4*)(mod + b * 6144 + scale_off + col), sh = *(const f32x4*)(mod + b * 6144 + shift_off + col);
            const float r0 = v[j].x * rstd * gg.x * (1.f + sc.x) + sh.x, r1 = v[j].y * rstd * gg.y * (1.f + sc.y) + sh.y;
            const float r2 = v[j].z * rstd * gg.z * (1.f + sc.z) + sh.z, r3 = v[j].w * rstd * gg.w * (1.f + sc.w) + sh.w;
            u32x2 w; w.x = pk2(r0, r1); w.y = pk2(r2, r3); o8[64 * j] = w;
            if (Q8) { v[j].x = r0; v[j].y = r1; v[j].z = r2; v[j].w = r3; am = fmaxf(am, fmaxf(fmaxf(fabsf(r0), fabsf(r1)), fmaxf(fabsf(r2), fabsf(r3)))); }
        }
        if (Q8) {
#pragma unroll
            for (int o = 1; o < 64; o <<= 1) am = fmaxf(am, __shfl_xor(am, o));
            const float sq = am > 0.f ? am * (1.f / 256.f) : 1.f, inv = 1.f / sq;
            unsigned* q8 = (unsigned*)(c.ws + WS_H2Q + (size_t)m * D) + c.lane;
#pragma unroll
            for (int j = 0; j < 4; ++j) { int w = __builtin_amdgcn_cvt_pk_fp8_f32(v[j].x * inv, v[j].y * inv, 0, false); w = __builtin_amdgcn_cvt_pk_fp8_f32(v[j].z * inv, v[j].w * inv, w, true); q8[64 * j] = (unsigned)w; }
            if (c.lane == 0) WSP(float, WS_SH)[m] = sq;
        }
    }
}

__device__ __forceinline__ void phase_conv(const Ctx& c0) {
    Ctx c = c0; c.lane = lane_id_v(); c.tid = c.wave * 64 + c.lane;
    const bf16_t* pa = WSP(bf16_t, WS_R1); const bf16_t* lx = WSP(bf16_t, WS_R2); bf16_t* xc = WSP(bf16_t, WS_R4); float* rstd = WSP(float, WS_RSTD);
    const float* cw = c.in[I_CONVW]; const float* cb = c.in[I_CONVB];
    const int gt = c.vcu * 512 + c.tid, NT = c.G * 512;
    { const int gw = c.vcu * 8 + c.wave, NGW = c.G * 8, L = c.lane;
      for (int t = gw; t < T; t += NGW) {
          float ss = 0.f;
          if (L < 48) { float v[8]; unpack8(*(const u32x4*)(pa + (size_t)t * 512 + 8 * L), v);
#pragma unroll
              for (int j = 0; j < 8; ++j) ss += v[j] * v[j]; }
          const float sq = wave_sum(L < 32 ? ss : 0.f), skv = wave_sum(L >= 32 ? ss : 0.f);
          if (L == 0) { rstd[2 * t] = rsqrtf(sq * (1.f / 256.f) + EPS); rstd[2 * t + 1] = rsqrtf(skv * (1.f / 128.f) + EPS); }
      } }
    { const int* pos = (const int*)c.in[I_POS]; float* CS = WSP(float, WS_CS);
      for (int e = gt; e < T * 16; e += NT) {
          const int t = e >> 4, jj = e & 15;
          const float invf = exp2f(-(float)jj * (13.287712379549449f / 16.f));
          const float ang = (float)pos[t] * invf; const float n = rintf(ang * 0.15915494309189535f);
          const float red = (float)((double)ang - (double)n * 6.283185307179586);
          CS[(size_t)t * 32 + jj] = __cosf(red); CS[(size_t)t * 32 + 16 + jj] = __sinf(red);
      } }
    {
        const int ch = (gt & 127) * 8;
        f32x4 wv[4][2]; f32x4 bv[2];
#pragma unroll
        for (int j = 0; j < 4; ++j) { wv[j][0] = *(const f32x4*)(cw + j * 1024 + ch); wv[j][1] = *(const f32x4*)(cw + j * 1024 + ch + 4); }
        bv[0] = *(const f32x4*)(cb + ch); bv[1] = *(const f32x4*)(cb + ch + 4);
        const int tstep = NT >> 7;
        for (int tq = gt >> 7; tq < T; tq += 4 * tstep) {
            u32x4 raw[4][4];
#pragma unroll
            for (int u = 0; u < 4; ++u) { const int t = tq + u * tstep; const int s = t & 2047;
#pragma unroll
                for (int j = 0; j < 4; ++j) { raw[u][j] = (u32x4){0u, 0u, 0u, 0u}; if (t < T && s - 3 + j >= 0) raw[u][j] = *(const u32x4*)(lx + (size_t)(t - 3 + j) * 1024 + ch); } }
#pragma unroll
            for (int u = 0; u < 4; ++u) { const int t = tq + u * tstep;
                float acc[8] = {bv[0].x, bv[0].y, bv[0].z, bv[0].w, bv[1].x, bv[1].y, bv[1].z, bv[1].w};
#pragma unroll
                for (int j = 0; j < 4; ++j) { float v[8]; unpack8(raw[u][j], v);
                    acc[0] += wv[j][0].x * v[0]; acc[1] += wv[j][0].y * v[1]; acc[2] += wv[j][0].z * v[2]; acc[3] += wv[j][0].w * v[3];
                    acc[4] += wv[j][1].x * v[4]; acc[5] += wv[j][1].y * v[5]; acc[6] += wv[j][1].z * v[6]; acc[7] += wv[j][1].w * v[7]; }
                if (t < T) *(u32x4*)(xc + (size_t)t * 1024 + ch) = pack8(acc); }
        }
    }
}

__device__ __forceinline__ void phase_scan(const Ctx& c0) {
    Ctx c = c0; c.lane = lane_id_v(); c.tid = c.wave * 64 + c.lane;
    const bf16_t* LA = WSP(bf16_t, WS_R0); bf16_t* Bv = WSP(bf16_t, WS_R6); const bf16_t* gate = WSP(bf16_t, WS_R3);
    LAS float* Ps = (LAS float*)c.lds; LAS float* Hs = Ps + 512;
    for (int it = c.vcu; it < 256; it += c.G) {
        const int b = it >> 4, cg = it & 15, seg = c.tid >> 6, ch = cg * 64 + (c.tid & 63);
        const size_t base = ((size_t)b * 2048 + seg * 256) * 1024 + ch;
        float P = 1.f, Hl = 0.f;
#pragma unroll 8
        for (int i = 0; i < 256; ++i) { const float a = __builtin_amdgcn_exp2f(bf2f(LA[base + (size_t)i * 1024])); const float bb = bf2f(Bv[base + (size_t)i * 1024]); Hl = a * Hl + bb; P *= a; }
        Ps[c.tid] = P; Hs[c.tid] = Hl;
        __syncthreads();
        float h = 0.f;
        for (int s2 = 0; s2 < seg; ++s2) h = Ps[s2 * 64 + (c.tid & 63)] * h + Hs[s2 * 64 + (c.tid & 63)];
#pragma unroll 8
        for (int i = 0; i < 256; ++i) { const float a = __builtin_amdgcn_exp2f(bf2f(LA[base + (size_t)i * 1024])); const float bb = bf2f(Bv[base + (size_t)i * 1024]); h = a * h + bb;
            const float gv = bf2f(gate[base + (size_t)i * 1024]); Bv[base + (size_t)i * 1024] = (bf16_t)f2bf(h * gelu_tanh(gv)); }
        __syncthreads();
    }
}

struct QkvRaw { u32x4 q[2], k[2], v[2]; f32x4 cs[4]; };
__device__ __forceinline__ void qkv_load(QkvRaw& r, const bf16_t* qraw, const bf16_t* kvraw, const bf16_t* pa, const float* CS, int t, int ch, int hq) {
    const bool act = ch < 12;
#pragma unroll
    for (int pass = 0; pass < 2; ++pass) { const int h = pass * 4 + hq;
        r.q[pass] = (u32x4){0u, 0u, 0u, 0u}; r.k[pass] = (u32x4){0u, 0u, 0u, 0u}; r.v[pass] = (u32x4){0u, 0u, 0u, 0u};
        if (act) r.q[pass] = *(const u32x4*)(qraw + (size_t)t * 768 + h * 96 + 8 * ch);
        if (ch < 8) { r.k[pass] = *(const u32x4*)(kvraw + (size_t)t * 1024 + h * 128 + 8 * ch); r.v[pass] = *(const u32x4*)(kvraw + (size_t)t * 1024 + h * 128 + 64 + 8 * ch); }
        else if (act) r.k[pass] = *(const u32x4*)(pa + (size_t)t * 512 + 384 + 8 * (ch - 8)); }
    const float* cp = CS + (size_t)t * 32 + 8 * (ch & 1);
    r.cs[0] = *(const f32x4*)cp; r.cs[1] = *(const f32x4*)(cp + 4); r.cs[2] = *(const f32x4*)(cp + 16); r.cs[3] = *(const f32x4*)(cp + 20);
}
__device__ __forceinline__ void phase_qkv_layout(const Ctx& c0) {
    Ctx c = c0; c.lane = lane_id_v(); c.tid = c.wave * 64 + c.lane;
    const bf16_t* qraw = WSP(bf16_t, WS_R5); const bf16_t* kvraw = WSP(bf16_t, WS_R2); const bf16_t* pa = WSP(bf16_t, WS_R1);
    bf16_t* Qh = WSP(bf16_t, WS_R4); bf16_t* Kh = WSP(bf16_t, WS_R3); bf16_t* Vh = WSP(bf16_t, WS_R0);
    const float* qng = c.in[I_QNG]; const float* kng = c.in[I_KNG]; const float* CS = WSP(float, WS_CS);
    const float qscale = 0.10206207261596577f * 1.4426950408889634f;
    const int gw = c.vcu * 8 + c.wave, NGW = c.G * 8, L = c.lane;
    const int ch = L & 15, hq = L >> 4;
    const bool act = ch < 12, isr = ch >= 8, hi2 = ch >= 10;
    float gq[8], gk[8];
#pragma unroll
    for (int j = 0; j < 8; ++j) { gq[j] = act ? qng[8 * ch + j] : 0.f; gk[j] = act ? kng[8 * ch + j] : 0.f; }
    if (gw >= T) return;
    QkvRaw cur, nxt;
    qkv_load(cur, qraw, kvraw, pa, CS, gw, ch, hq);
#pragma unroll 1
    for (int t = gw; t < T; t += NGW) {
        qkv_load(nxt, qraw, kvraw, pa, CS, (t + NGW < T) ? t + NGW : t, ch, hq);
        const int b = t >> 11, s = t & 2047;
        const float cs[8] = {cur.cs[0].x, cur.cs[0].y, cur.cs[0].z, cur.cs[0].w, cur.cs[1].x, cur.cs[1].y, cur.cs[1].z, cur.cs[1].w};
        const float sn[8] = {cur.cs[2].x, cur.cs[2].y, cur.cs[2].z, cur.cs[2].w, cur.cs[3].x, cur.cs[3].y, cur.cs[3].z, cur.cs[3].w};
#pragma unroll
        for (int pass = 0; pass < 2; ++pass) {
            const int h = pass * 4 + hq;
            const size_t orow = ((size_t)(b * H + h) * S + s);
#pragma unroll
            for (int qk = 0; qk < 2; ++qk) {
                float v[8]; unpack8(qk == 0 ? cur.q[pass] : cur.k[pass], v);
                float ss = 0.f;
#pragma unroll
                for (int j = 0; j < 8; ++j) ss += v[j] * v[j];
#pragma unroll
                for (int o = 1; o < 16; o <<= 1) ss += __shfl_xor(ss, o);
                const float r = rsqrtf(ss * (1.f / 96.f) + EPS) * (qk == 0 ? qscale : 1.f);
                float x[8], o8[8];
#pragma unroll
                for (int j = 0; j < 8; ++j) x[j] = v[j] * r * (qk == 0 ? gq[j] : gk[j]);
#pragma unroll
                for (int j = 0; j < 8; ++j) { const float px = __shfl_xor(x[j], 2);
                    o8[j] = !isr ? x[j] : (hi2 ? px * sn[j] + x[j] * cs[j] : x[j] * cs[j] - px * sn[j]); }
                if (act) *(u32x4*)((qk == 0 ? Qh : Kh) + orow * 96 + 8 * ch) = pack8(o8);
            }
            if (ch < 8) *(u32x4*)(Vh + orow * 64 + 8 * ch) = cur.v[pass];
        }
        cur = nxt;
    }
}

constexpr int KROW = 208, VROW = 160;
constexpr int KBUF = 128 * KROW, VBUF = 128 * VROW;
typedef short v4i16_t __attribute__((ext_vector_type(4)));
__device__ __forceinline__ void attn_chunk(LAS unsigned char* kb, LAS unsigned char* vb, const bf16x8 (&qf)[3], f32x4 (&o)[4], float& mrun, float& lrun, int fr, int g) {
    f32x4 sacc[4];
#pragma unroll
    for (int kt = 0; kt < 4; ++kt) { sacc[kt] = (f32x4){0.f, 0.f, 0.f, 0.f};
#pragma unroll
        for (int ks = 0; ks < 3; ++ks) { const bf16x8 kf = *(const LAS bf16x8*)(kb + (16 * kt + fr) * KROW + (ks * 32 + g * 8) * 2);
            sacc[kt] = __builtin_amdgcn_mfma_f32_16x16x32_bf16(kf, qf[ks], sacc[kt], 0, 0, 0); } }
    float mx = sacc[0][0];
#pragma unroll
    for (int kt = 0; kt < 4; ++kt)
#pragma unroll
        for (int r = 0; r < 4; ++r) mx = fmaxf(mx, sacc[kt][r]);
    mx = fmaxf(mx, __shfl_xor(mx, 16)); mx = fmaxf(mx, __shfl_xor(mx, 32));
    const float mnew = fmaxf(mrun, mx), alpha = __builtin_amdgcn_exp2f(mrun - mnew); mrun = mnew;
    float ps = 0.f;
#pragma unroll
    for (int kt = 0; kt < 4; ++kt)
#pragma unroll
        for (int r = 0; r < 4; ++r) { const float p = __builtin_amdgcn_exp2f(sacc[kt][r] - mnew); sacc[kt][r] = p; ps += p; }
    lrun = lrun * alpha + ps;
#pragma unroll
    for (int dt = 0; dt < 4; ++dt) o[dt] = o[dt] * alpha;
#pragma unroll
    for (int s2 = 0; s2 < 2; ++s2) {
        u32x4 pw; pw.x = pk2(sacc[2 * s2][0], sacc[2 * s2][1]); pw.y = pk2(sacc[2 * s2][2], sacc[2 * s2][3]); pw.z = pk2(sacc[2 * s2 + 1][0], sacc[2 * s2 + 1][1]); pw.w = pk2(sacc[2 * s2 + 1][2], sacc[2 * s2 + 1][3]);
        const bf16x8 pb = __builtin_bit_cast(bf16x8, pw);
#pragma unroll
        for (int dt = 0; dt < 4; ++dt) {
            LAS unsigned char* va = vb + (32 * s2 + 4 * g + (fr >> 2)) * VROW + (16 * dt + 4 * (fr & 3)) * 2;
            const v4i16_t t0 = __builtin_amdgcn_ds_read_tr16_b64_v4i16((LAS v4i16_t*)va), t1 = __builtin_amdgcn_ds_read_tr16_b64_v4i16((LAS v4i16_t*)(va + 16 * VROW));
            const bf16x8 vf = (bf16x8){t0[0], t0[1], t0[2], t0[3], t1[0], t1[1], t1[2], t1[3]};
            o[dt] = __builtin_amdgcn_mfma_f32_16x16x32_bf16(vf, pb, o[dt], 0, 0, 0); }
    }
}
__device__ __forceinline__ void attn_unit(const Ctx& c, int b, int h, int qb) {
    const bf16_t* Qh = WSP(bf16_t, WS_R4); const bf16_t* Kh = WSP(bf16_t, WS_R3); const bf16_t* Vh = WSP(bf16_t, WS_R0); bf16_t* AO = WSP(bf16_t, WS_R0 + 32 * MiB);
    const int fr = c.lane & 15, g = c.lane >> 4, wid = c.wave;
    const size_t hb = (size_t)(b * H + h) * S;
    const int q0 = qb * 128 + wid * 16;
    const int nsup = qb + 1;
    bf16x8 qf[3];
#pragma unroll
    for (int ks = 0; ks < 3; ++ks) qf[ks] = *(const bf16x8*)(Qh + (hb + q0 + fr) * 96 + ks * 32 + g * 8);
    f32x4 o[4];
#pragma unroll
    for (int dt = 0; dt < 4; ++dt) o[dt] = (f32x4){0.f, 0.f, 0.f, 0.f};
    float mrun = -1e30f, lrun = 0.f;
    u32x4 kr[3], vr[2];
    const u32x4* Ksrc = (const u32x4*)(Kh + hb * 96); const u32x4* Vsrc = (const u32x4*)(Vh + hb * 64);
#pragma unroll
    for (int i = 0; i < 3; ++i) kr[i] = Ksrc[c.tid + 512 * i];
#pragma unroll
    for (int i = 0; i < 2; ++i) vr[i] = Vsrc[c.tid + 512 * i];
    for (int j = 0; j < nsup; ++j) {
        LAS unsigned char* kb = c.lds + (j & 1) * (KBUF + VBUF); LAS unsigned char* vb = kb + KBUF;
#pragma unroll
        for (int i = 0; i < 3; ++i) { const int kc = c.tid + 512 * i; *(LAS u32x4*)(kb + (kc / 12) * KROW + (kc % 12) * 16) = kr[i]; }
#pragma unroll
        for (int i = 0; i < 2; ++i) { const int vc = c.tid + 512 * i; *(LAS u32x4*)(vb + (vc >> 3) * VROW + (vc & 7) * 16) = vr[i]; }
        __syncthreads();
        if (j + 1 < nsup) {
#pragma unroll
            for (int i = 0; i < 3; ++i) kr[i] = Ksrc[(j + 1) * 1536 + c.tid + 512 * i];
#pragma unroll
            for (int i = 0; i < 2; ++i) vr[i] = Vsrc[(j + 1) * 1024 + c.tid + 512 * i];
        }
        attn_chunk(kb, vb, qf, o, mrun, lrun, fr, g);
        if (j + 1 < nsup || wid >= 4) attn_chunk(kb + 64 * KROW, vb + 64 * VROW, qf, o, mrun, lrun, fr, g);
    }
    float lt = lrun + __shfl_xor(lrun, 16); lt += __shfl_xor(lt, 32);
    const float inv = 1.f / lt;
    bf16_t* orow = AO + ((size_t)b * S + q0 + fr) * 512 + h * 64;
#pragma unroll
    for (int dt = 0; dt < 4; ++dt) { u32x2 w; w.x = pk2(o[dt][0] * inv, o[dt][1] * inv); w.y = pk2(o[dt][2] * inv, o[dt][3] * inv); *(u32x2*)(orow + 16 * dt + 4 * g) = w; }
    __syncthreads();
}
__device__ __forceinline__ void phase_attn(const Ctx& c0) {
    Ctx c = c0; c.lane = lane_id_v(); c.tid = c.wave * 64 + c.lane;
    for (int v = c.vcu; v < 256; v += c.G) {
        const int bh = v >> 1, odd = v & 1;
        for (int i = 0; i < 8; ++i) {
            const int setA[8] = {15, 12, 10, 9, 6, 5, 3, 0}, setB[8] = {14, 13, 11, 8, 7, 4, 2, 1};
            int qb = 0;
#pragma unroll
            for (int k = 0; k < 8; ++k) if (k == i) qb = odd ? setB[k] : setA[k];
            attn_unit(c, bh >> 3, bh & 7, qb);
        }
    }
}

__device__ __forceinline__ float wave_max(float v) {
#pragma unroll
    for (int o = 1; o < 64; o <<= 1) v = fmaxf(v, __shfl_xor(v, o));
    return v;
}
__device__ __forceinline__ int wave_min_i(int v) {
#pragma unroll
    for (int o = 1; o < 64; o <<= 1) v = min(v, __shfl_xor(v, o));
    return v;
}
__device__ __forceinline__ int prefix_cnt(unsigned long long m) { return (int)__builtin_amdgcn_mbcnt_hi((unsigned)(m >> 32), __builtin_amdgcn_mbcnt_lo((unsigned)m, 0u)); }
template <int NV, int NBITS> __device__ __forceinline__ void select16(const unsigned (&key)[NV], int (&slot)[NV]) {
    unsigned tau = 0u;
    for (int bit = NBITS - 1; bit >= 0; --bit) {
        const unsigned trial = tau | (1u << bit); int cnt = 0;
#pragma unroll
        for (int j = 0; j < NV; ++j) cnt += __popcll(__ballot(key[j] >= trial));
        if (cnt >= 16) { tau = trial; if (cnt == 16) break; }
    }
    int base = 0;
#pragma unroll
    for (int j = 0; j < NV; ++j) { const unsigned long long m = __ballot(key[j] > tau); slot[j] = (key[j] > tau) ? base + prefix_cnt(m) : -1; base += __popcll(m); }
#pragma unroll
    for (int j = 0; j < NV; ++j) { const unsigned long long m = __ballot(key[j] == tau); if (key[j] == tau) { const int s = base + prefix_cnt(m); slot[j] = s < 16 ? s : -1; } base += __popcll(m); }
}
template <int N> __device__ __forceinline__ void bitonic_stage_desc(unsigned (&x)[N], int k, int j) {
#pragma unroll
    for (int i = 0; i < N; ++i) { const int l = i ^ j; if (l > i) { const bool asc = ((i & k) != 0);
        const unsigned a = x[i], b = x[l]; const unsigned hi = a > b ? a : b, lo = a > b ? b : a; x[i] = asc ? lo : hi; x[l] = asc ? hi : lo; } }
}
__device__ __forceinline__ void sort16_desc(unsigned (&x)[16]) {
#pragma unroll
    for (int k = 2; k <= 16; k <<= 1)
#pragma unroll
        for (int j = k >> 1; j > 0; j >>= 1) bitonic_stage_desc<16>(x, k, j);
}
__device__ __forceinline__ void merge16_desc(unsigned (&run)[16], const unsigned (&ch)[16]) {
#pragma unroll
    for (int i = 0; i < 16; ++i) run[i] = run[i] > ch[15 - i] ? run[i] : ch[15 - i];
#pragma unroll
    for (int j = 8; j > 0; j >>= 1) bitonic_stage_desc<16>(run, 16, j);
}
__device__ __forceinline__ unsigned mono_hi(unsigned w) { return w ^ ((unsigned)((int)w >> 31) | 0x80000000u); }
__device__ __forceinline__ float demono_hi(unsigned k) { const unsigned kk = k & 0xffff0000u; return __builtin_bit_cast(float, (kk ^ ((unsigned)(~(int)kk >> 31) | 0x80000000u)) & 0xffff0000u); }
__device__ __forceinline__ void top16_list(const bf16_t* s, unsigned (&run)[16]) {
#pragma unroll
    for (int ck = 0; ck < 8; ++ck) {
        const u32x4 w0 = *(const u32x4*)(s + ck * 16), w1 = *(const u32x4*)(s + ck * 16 + 8);
        const unsigned w[8] = {w0.x, w0.y, w0.z, w0.w, w1.x, w1.y, w1.z, w1.w};
        unsigned ch[16];
#pragma unroll
        for (int i = 0; i < 8; ++i) { ch[2 * i] = (mono_hi(w[i] << 16) & 0xffff0000u) | (unsigned)(ck * 16 + 2 * i); ch[2 * i + 1] = (mono_hi(w[i]) & 0xffff0000u) | (unsigned)(ck * 16 + 2 * i + 1); }
        sort16_desc(ch);
        if (ck == 0) {
#pragma unroll
            for (int i = 0; i < 16; ++i) run[i] = ch[i];
        } else merge16_desc(run, ch);
    }
}
__device__ __forceinline__ void phase_topk(const Ctx& c0) {
    Ctx c = c0; c.lane = lane_id_v(); c.tid = c.wave * 64 + c.lane;
    const bf16_t* sc = WSP(bf16_t, WS_SC); int* IDX = WSP(int, WS_IDX); float* GW = WSP(float, WS_GW);
    const int gl = (c.vcu * 8 + c.wave) * 64 + c.lane, NL = c.G * 512;
    for (int e = gl; e < T * H; e += NL) {
        unsigned ka[16], kb[16];
        top16_list(sc + (size_t)e * 256, ka);
        top16_list(sc + (size_t)e * 256 + 128, kb);
        float sa[16], sb[16]; unsigned ia[16], ib[16];
#pragma unroll
        for (int i = 0; i < 16; ++i) { sa[i] = demono_hi(ka[i]); sb[i] = demono_hi(kb[i]); ia[i] = (ka[i] & 0x7fu) << 7; ib[i] = kb[i] & 0x7fu; }
        const float mx = sa[0] + sb[0];
        unsigned run[16], ch[16]; int n = 0, nc = 0;
#pragma unroll
        for (int a = 0; a < 16; ++a)
#pragma unroll
            for (int b = 0; b < 16; ++b) if ((a + 1) * (b + 1) <= 16) {
                const int k = 65535 + (int)((sa[a] + sb[b] - mx) * 1024.f);
                ch[n] = ((unsigned)(k < 0 ? 0 : k) << 16) | ia[a] | ib[b];
                if (++n == 16) { sort16_desc(ch); if (nc == 0) {
#pragma unroll
                        for (int i = 0; i < 16; ++i) run[i] = ch[i]; } else merge16_desc(run, ch);
                    n = 0; ++nc; }
            }
#pragma unroll
        for (int i = 2; i < 16; ++i) ch[i] = 0u;
        sort16_desc(ch); merge16_desc(run, ch);
        float ex[16]; float sum = 0.f;
#pragma unroll
        for (int i = 0; i < 16; ++i) { ex[i] = __expf((float)((int)(run[i] >> 16) - 65535) * (1.f / 1024.f)); sum += ex[i]; }
        const float inv = 1.f / sum;
        u32x4* oi = (u32x4*)(IDX + (size_t)e * 16); f32x4* og = (f32x4*)(GW + (size_t)e * 16);
#pragma unroll
        for (int q = 0; q < 4; ++q) { u32x4 vi; vi.x = run[4 * q] & 0x3fffu; vi.y = run[4 * q + 1] & 0x3fffu; vi.z = run[4 * q + 2] & 0x3fffu; vi.w = run[4 * q + 3] & 0x3fffu; oi[q] = vi;
            f32x4 vg; vg.x = ex[4 * q] * inv; vg.y = ex[4 * q + 1] * inv; vg.z = ex[4 * q + 2] * inv; vg.w = ex[4 * q + 3] * inv; og[q] = vg; }
    }
}

__device__ __forceinline__ void dec32_fp4(const u32x4 r, f32x2 (&f)[16]) {
    const unsigned w[4] = {r.x, r.y, r.z, r.w};
#pragma unroll
    for (int i = 0; i < 4; ++i) { f[4 * i] = __builtin_amdgcn_cvt_scalef32_pk_f32_fp4(w[i], 1.0f, 0); f[4 * i + 1] = __builtin_amdgcn_cvt_scalef32_pk_f32_fp4(w[i], 1.0f, 1);
        f[4 * i + 2] = __builtin_amdgcn_cvt_scalef32_pk_f32_fp4(w[i], 1.0f, 2); f[4 * i + 3] = __builtin_amdgcn_cvt_scalef32_pk_f32_fp4(w[i], 1.0f, 3); }
}
__device__ __forceinline__ float dot32_fp4(const f32x2 (&hv)[16], const u32x4 r) {
    f32x2 f[16]; dec32_fp4(r, f); f32x2 s = hv[0] * f[0];
#pragma unroll
    for (int j = 1; j < 16; ++j) s = s + hv[j] * f[j];
    return s.x + s.y;
}
__device__ __forceinline__ void phase_peer_u(const Ctx& c0) {
    Ctx c = c0; c.lane = lane_id_v(); c.tid = c.wave * 64 + c.lane;
    const bf16_t* h2 = WSP(bf16_t, WS_R0); const int* IDX = WSP(int, WS_IDX);
    const int L = c.lane, pp = blockIdx.x & 3, hh = (blockIdx.x >> 2) & 1, rank = blockIdx.x >> 3, nrank = c.G >> 3;
    const bool b2 = L & 4, b1 = L & 2, b0 = L & 1;
    LAS int* mb = (LAS int*)(c.lds + c.wave * 1024);
    const int kl = L >> 3;
    const unsigned char* EU4b = c.ws + WS_EU + (size_t)pp * NE * 128;
    float* PD = WSP(float, WS_PD) + (size_t)pp * T * 128;
    const int t0 = 2 * (rank * 8 + c.wave) + hh, ts = 2 * nrank * 8;
    if (t0 >= T) return;
    { const int g0 = IDX[(size_t)t0 * 128 + L], g1 = IDX[(size_t)t0 * 128 + 64 + L]; mb[L] = g0; mb[64 + L] = g1; }
    u32x4 rA[8], rB[8];
    { const unsigned char* EU4 = EU4b + (L & 7) * 16;
#pragma unroll
      for (int i = 0; i < 8; ++i) rA[i] = *(const u32x4*)(EU4 + (size_t)mb[8 * i + kl] * 128); }
    int cur = 0;
#pragma unroll 1
    for (int t = t0; t < T; t += ts) {
        int lo16 = (L & 7) * 16; asm volatile("" : "+v"(lo16)); const unsigned char* EU4 = EU4b + lo16;
        const int tn = (t + ts < T) ? t + ts : t;
        const int gn0 = IDX[(size_t)tn * 128 + L], gn1 = IDX[(size_t)tn * 128 + 64 + L];
        f32x2 hv[16];
        { const u32x4* ph = (const u32x4*)(h2 + (size_t)t * 1024 + pp * 256 + (L & 7) * 32);
#pragma unroll
          for (int q = 0; q < 4; ++q) { const u32x4 w = ph[q]; hv[4 * q] = (f32x2){bflo(w.x), bfhi(w.x)}; hv[4 * q + 1] = (f32x2){bflo(w.y), bfhi(w.y)}; hv[4 * q + 2] = (f32x2){bflo(w.z), bfhi(w.z)}; hv[4 * q + 3] = (f32x2){bflo(w.w), bfhi(w.w)}; } }
#pragma unroll
        for (int i = 0; i < 8; ++i) rB[i] = *(const u32x4*)(EU4 + (size_t)mb[cur * 128 + 64 + 8 * i + kl] * 128);
        float d[16];
#pragma unroll
        for (int i = 0; i < 8; ++i) d[i] = dot32_fp4(hv, rA[i]);
        mb[(cur ^ 1) * 128 + L] = gn0; mb[(cur ^ 1) * 128 + 64 + L] = gn1;
#pragma unroll
        for (int i = 0; i < 8; ++i) rA[i] = *(const u32x4*)(EU4 + (size_t)mb[(cur ^ 1) * 128 + 8 * i + kl] * 128);
#pragma unroll
        for (int i = 0; i < 8; ++i) d[8 + i] = dot32_fp4(hv, rB[i]);
        float n8[8], n4[4], n2[2];
#pragma unroll
        for (int i = 0; i < 8; ++i) { const float send = b2 ? d[i] : d[i + 8], keep = b2 ? d[i + 8] : d[i]; n8[i] = keep + __shfl_xor(send, 4); }
#pragma unroll
        for (int i = 0; i < 4; ++i) { const float send = b1 ? n8[i] : n8[i + 4], keep = b1 ? n8[i + 4] : n8[i]; n4[i] = keep + __shfl_xor(send, 2); }
#pragma unroll
        for (int i = 0; i < 2; ++i) { const float send = b0 ? n4[i] : n4[i + 2], keep = b0 ? n4[i + 2] : n4[i]; n2[i] = keep + __shfl_xor(send, 1); }
        const int i0 = (b2 ? 8 : 0) + (b1 ? 4 : 0) + (b0 ? 2 : 0);
        PD[(size_t)t * 128 + 8 * i0 + kl] = n2[0]; PD[(size_t)t * 128 + 8 * (i0 + 1) + kl] = n2[1];
        cur ^= 1;
    }
}
__device__ __forceinline__ void phase_peer_fin(const Ctx& c0) {
    Ctx c = c0; c.lane = lane_id_v(); c.tid = c.wave * 64 + c.lane;
    const int* IDX = WSP(int, WS_IDX); const float* GW = WSP(float, WS_GW); const float* PD = WSP(float, WS_PD); unsigned* WGT = WSP(unsigned, WS_WGT);
    const float* SU = WSP(float, WS_SU); const float* SV = WSP(float, WS_SV);
#pragma unroll 4
    for (int i = c.vcu * 512 + c.tid; i < T * 128; i += c.G * 512) {
        float d = 0.f;
#pragma unroll
        for (int p = 0; p < 4; ++p) d += PD[(size_t)p * T * 128 + i];
        const int e = IDX[i];
        WGT[i] = (f2bf(GW[i] * gelu_tanh(d * SU[e]) * SV[e]) << 16) | (unsigned)e;
    }
}
template <bool DRY> __device__ __forceinline__ void phase_peer_v(const Ctx& c0) {
    Ctx c = c0; c.lane = lane_id_v(); c.tid = c.wave * 64 + c.lane;
    const unsigned* WI = WSP(unsigned, WS_WGT); const float* mod = WSP(float, WS_MOD);
    const int L = c.lane, pp = blockIdx.x & 3, hh = (blockIdx.x >> 2) & 1, rank = blockIdx.x >> 3, nrank = c.G >> 3;
    const bool b5 = L & 32, b4 = L & 16, b3 = L & 8;
    LAS unsigned* mb = (LAS unsigned*)(c.lds + c.wave * 1024);
    const int kl = L >> 3;
    const unsigned char* EV4 = c.ws + WS_EV + (size_t)pp * NE * 128 + (L & 7) * 16;
    const int col = pp * 256 + (L & 7) * 32 + (b5 ? 16 : 0) + (b4 ? 8 : 0) + (b3 ? 4 : 0);
    const int t0 = 2 * (rank * 8 + c.wave) + hh, ts = 2 * nrank * 8;
    if (t0 >= T) return;
    { const unsigned g0 = WI[(size_t)t0 * 128 + L], g1 = WI[(size_t)t0 * 128 + 64 + L]; mb[L] = g0; mb[64 + L] = g1; }
    u32x4 rA[8], rB[8];
#pragma unroll
    for (int i = 0; i < 8; ++i) rA[i] = *(const u32x4*)(EV4 + (size_t)(mb[8 * i + kl] & 0xffffu) * 128);
    int cur = 0;
#pragma unroll 1
    for (int t = t0; t < T; t += ts) {
        const int tn = (t + ts < T) ? t + ts : t;
        const unsigned gn0 = WI[(size_t)tn * 128 + L], gn1 = WI[(size_t)tn * 128 + 64 + L];
        float* o = c.out + (size_t)t * 1024 + col; const float* g2 = mod + (t >> 11) * 6144 + 5120 + col;
        f32x4 xo = *(const f32x4*)o; const f32x4 gt = *(const f32x4*)g2;
#pragma unroll
        for (int i = 0; i < 8; ++i) rB[i] = *(const u32x4*)(EV4 + (size_t)(mb[cur * 128 + 64 + 8 * i + kl] & 0xffffu) * 128);
        f32x2 ac2[16];
#pragma unroll
        for (int j = 0; j < 16; ++j) ac2[j] = (f32x2){0.f, 0.f};
#pragma unroll
        for (int i = 0; i < 8; ++i) { const float w = bfhi(mb[cur * 128 + 8 * i + kl]); const f32x2 w2 = {w, w}; f32x2 f[16]; dec32_fp4(rA[i], f);
#pragma unroll
            for (int j = 0; j < 16; ++j) ac2[j] = ac2[j] + f[j] * w2; }
        mb[(cur ^ 1) * 128 + L] = gn0; mb[(cur ^ 1) * 128 + 64 + L] = gn1;
#pragma unroll
        for (int i = 0; i < 8; ++i) rA[i] = *(const u32x4*)(EV4 + (size_t)(mb[(cur ^ 1) * 128 + 8 * i + kl] & 0xffffu) * 128);
#pragma unroll
        for (int i = 0; i < 8; ++i) { const float w = bfhi(mb[cur * 128 + 64 + 8 * i + kl]); const f32x2 w2 = {w, w}; f32x2 f[16]; dec32_fp4(rB[i], f);
#pragma unroll
            for (int j = 0; j < 16; ++j) ac2[j] = ac2[j] + f[j] * w2; }
        float acc[32];
#pragma unroll
        for (int j = 0; j < 16; ++j) { acc[2 * j] = ac2[j].x; acc[2 * j + 1] = ac2[j].y; }
        float n16[16], n8[8], n4[4];
#pragma unroll
        for (int i = 0; i < 16; ++i) { const float send = b5 ? acc[i] : acc[i + 16], keep = b5 ? acc[i + 16] : acc[i]; n16[i] = keep + __shfl_xor(send, 32); }
#pragma unroll
        for (int i = 0; i < 8; ++i) { const float send = b4 ? n16[i] : n16[i + 8], keep = b4 ? n16[i + 8] : n16[i]; n8[i] = keep + __shfl_xor(send, 16); }
#pragma unroll
        for (int i = 0; i < 4; ++i) { const float send = b3 ? n8[i] : n8[i + 4], keep = b3 ? n8[i + 4] : n8[i]; n4[i] = keep + __shfl_xor(send, 8); }
        xo.x += gt.x * n4[0]; xo.y += gt.y * n4[1]; xo.z += gt.z * n4[2]; xo.w += gt.w * n4[3];
        if (DRY) asm volatile("" :: "v"(xo.x), "v"(xo.y), "v"(xo.z), "v"(xo.w)); else *(f32x4*)o = xo;
        cur ^= 1;
    }
}

struct FInProj { bf16_t *pa, *lx, *lg, *mg;
    __device__ __forceinline__ void operator()(int row, int pn, int cc, const float (&v0)[8], const float (&v1)[8]) const {
        bf16_t* d;
        if (pn < 2) d = pa + (size_t)row * 512 + pn * 256 + cc; else if (pn < 6) d = lx + (size_t)row * 1024 + (pn - 2) * 256 + cc;
        else if (pn < 10) d = lg + (size_t)row * 1024 + (pn - 6) * 256 + cc; else d = mg + (size_t)row * 2048 + (pn - 10) * 256 + cc;
        *(u32x4*)d = pack8(v0); *(u32x4*)(d + 128) = pack8(v1); } };
struct FRowScale { bf16_t* dst; int ldc; const float* rstd; int which;
    __device__ __forceinline__ void operator()(int row, int pn, int cc, const float (&v0)[8], const float (&v1)[8]) const {
        const float r = rstd[2 * row + which]; float a[8], b[8];
#pragma unroll
        for (int j = 0; j < 8; ++j) { a[j] = v0[j] * r; b[j] = v1[j] * r; }
        *(u32x4*)(dst + (size_t)row * ldc + pn * 256 + cc) = pack8(a); *(u32x4*)(dst + (size_t)row * ldc + pn * 256 + 128 + cc) = pack8(b); } };
struct FGates { const bf16_t* xc; bf16_t *LA, *Bv; const float *brg, *big, *c8sp;
    __device__ __forceinline__ void operator()(int row, int pn, int cc, const float (&v0)[8], const float (&v1)[8]) const {
        const int ch = pn * 128 + cc; float x[8], la[8], bv[8]; unpack8(*(const u32x4*)(xc + (size_t)row * 1024 + ch), x);
#pragma unroll
        for (int j = 0; j < 8; ++j) {
            const float r = __builtin_amdgcn_rcpf(1.f + __expf(-(v0[j] + brg[ch + j]))), ig = __builtin_amdgcn_rcpf(1.f + __expf(-(v1[j] + big[ch + j])));
            const float loga = r * c8sp[ch + j];
            const float z = 2.f * loga;
            const float ser = -z * (1.f + z * (0.5f + z * (0.16666667f + z * (0.041666668f + z * (0.008333334f + z * 0.0013888889f)))));
            const float om = (z > -0.25f) ? ser : (1.f - __expf(z));
            la[j] = loga * 1.4426950408889634f;
            bv[j] = sqrtf(om) * (ig * x[j]);
        }
        *(u32x4*)(LA + (size_t)row * 1024 + ch) = pack8(la); *(u32x4*)(Bv + (size_t)row * 1024 + ch) = pack8(bv); } };
struct FY1 { const bf16_t* mg; bf16_t* y; int goff; bool accum;
    __device__ __forceinline__ void one(int row, int col, const float (&v)[8]) const {
        float gt[8], o[8]; unpack8(*(const u32x4*)(mg + (size_t)row * 2048 + goff + col), gt);
        if (accum) unpack8(*(const u32x4*)(y + (size_t)row * 1024 + col), o);
#pragma unroll
        for (int j = 0; j < 8; ++j) o[j] = (accum ? o[j] : 0.f) + sigmoidf_(gt[j]) * v[j];
        *(u32x4*)(y + (size_t)row * 1024 + col) = pack8(o); }
    __device__ __forceinline__ void operator()(int row, int pn, int cc, const float (&v0)[8], const float (&v1)[8]) const { one(row, pn * 256 + cc, v0); one(row, pn * 256 + 128 + cc, v1); } };
struct FX1 { const float* x; float* out; const float* mod;
    __device__ __forceinline__ void one(int row, int col, const float (&v)[8]) const {
        const float* g1 = mod + (row >> 11) * 6144 + 2048 + col; const float* xr = x + (size_t)row * 1024 + col; float* o = out + (size_t)row * 1024 + col;
        const f32x4 x0 = *(const f32x4*)xr, x1 = *(const f32x4*)(xr + 4), a0 = *(const f32x4*)g1, a1 = *(const f32x4*)(g1 + 4);
        f32x4 r0, r1; r0.x = x0.x + a0.x * v[0]; r0.y = x0.y + a0.y * v[1]; r0.z = x0.z + a0.z * v[2]; r0.w = x0.w + a0.w * v[3];
        r1.x = x1.x + a1.x * v[4]; r1.y = x1.y + a1.y * v[5]; r1.z = x1.z + a1.z * v[6]; r1.w = x1.w + a1.w * v[7];
        *(f32x4*)o = r0; *(f32x4*)(o + 4) = r1; }
    __device__ __forceinline__ void operator()(int row, int pn, int cc, const float (&v0)[8], const float (&v1)[8]) const { one(row, pn * 256 + cc, v0); one(row, pn * 256 + 128 + cc, v1); } };
struct FStore { bf16_t* dst; int ldc;
    __device__ __forceinline__ void operator()(int row, int pn, int cc, const float (&v0)[8], const float (&v1)[8]) const {
        *(u32x4*)(dst + (size_t)row * ldc + pn * 256 + cc) = pack8(v0); *(u32x4*)(dst + (size_t)row * ldc + pn * 256 + 128 + cc) = pack8(v1); } };

template <int M, int N, int K, int LDA, int ACS, class F> __device__ __forceinline__ void run_gemm(const Ctx& c, const bf16_t* A, const bf16_t* Bt, const F& f) {
    pg8::Gemm g{A, Bt}; pg8::StaticOrder<M, N> So; So.init(c.G, (int)blockIdx.x);
    pg8::EpiF<F> E{f};
    pg8::gemm_phase<K, LDA, ACS, pg8::EpiF<F>, pg8::StaticOrder<M, N>>((PG8_LAS unsigned char*)c.lds, g, So, E, c.wave * 64 + lane_id_v());
}

__global__ void __launch_bounds__(512, 2) mk_fwd(Args args) {
    extern __shared__ __attribute__((aligned(16))) unsigned char lds_raw[];
    Ctx c;
    c.lds = (LAS unsigned char*)lds_raw;
    c.wave = __builtin_amdgcn_readfirstlane(threadIdx.x >> 6); c.lane = lane_id_v(); c.tid = c.wave * 64 + c.lane;
    c.G = gridDim.x; { const int bx = blockIdx.x; c.vcu = (c.G % 8 == 0) ? (bx % 8) * (c.G / 8) + bx / 8 : bx; }
    c.in = args.in; c.out = args.out; c.ws = args.ws;
    volatile LAS unsigned* MISC = (volatile LAS unsigned*)(c.lds + MISC_OFF);
    if (c.tid < 32) MISC[c.tid] = 0u;
    __syncthreads();
    XcdBarrier bar; bar.bar = (unsigned*)(c.ws + WS_CTL) + 4096; bar.x = 0; bar.st = nullptr;
    if (args.ph_hi - args.ph_lo > 1) bar = xcd_barrier_post((unsigned*)(c.ws + WS_CTL) + 4096, MISC + 8);

    const int lo = args.ph_lo, hi = args.ph_hi;
#ifndef ONLYP
#define ONLYP -1
#endif
#define IN(k) (lo <= (k) && (k) < hi && (ONLYP < 0 || ONLYP == (k)))
#define SEAM(k) do { if ((k) + 1 < hi) xcd_barrier(bar, c.wave); } while (0)
#ifndef REPEAT_MASK
#define REPEAT_MASK 0
#endif
#define PHASE(k, ...) if (IN(k)) { c.lane = lane_id_v(); c.tid = c.wave * 64 + c.lane; { __VA_ARGS__ } if ((REPEAT_MASK >> (k)) & 1) { xcd_barrier(bar, c.wave); { __VA_ARGS__ } } SEAM(k); }
    PHASE(0, phase_prep(c);)
    PHASE(1, phase_modnorm<false>(c, c.in[I_X], c.in[I_N1G], 0, 1024, WSP(bf16_t, WS_R0));)
    PHASE(2, FInProj f{WSP(bf16_t, WS_R1), WSP(bf16_t, WS_R2), WSP(bf16_t, WS_R3), (bf16_t*)c.out};
             run_gemm<T, 4608, 1024, 1024, 0>(c, WSP(bf16_t, WS_R0), WSP(bf16_t, WS_WIN), f);)
    PHASE(3, phase_conv(c);)
    PHASE(4, { FRowScale fq{WSP(bf16_t, WS_R5), 768, WSP(float, WS_RSTD), 0};
               run_gemm<T, 768, 256, 512, 0>(c, WSP(bf16_t, WS_R1), WSP(bf16_t, WS_WUQ), fq); }
             { FGates fg{WSP(bf16_t, WS_R4), WSP(bf16_t, WS_R0), WSP(bf16_t, WS_R6), c.in[I_BRG], c.in[I_BIG], WSP(float, WS_C8SP)};
               run_gemm<T, 2048, 128, 1024, 128>(c, WSP(bf16_t, WS_R4), WSP(bf16_t, WS_WG), fg); })
    PHASE(5, { FRowScale fkv{WSP(bf16_t, WS_R2), 1024, WSP(float, WS_RSTD), 1};
               run_gemm<T, 1024, 128, 512, 0>(c, WSP(bf16_t, WS_R1) + 256, WSP(bf16_t, WS_WUKV), fkv); }
             phase_scan(c);)
    PHASE(6, phase_qkv_layout(c);)
    PHASE(7, phase_attn(c);)
    PHASE(8, { FY1 f1{(const bf16_t*)c.out, WSP(bf16_t, WS_R2), 0, false};
               run_gemm<T, 1024, 512, 512, 0>(c, WSP(bf16_t, WS_R0 + 32 * MiB), WSP(bf16_t, WS_WOA), f1); }
             { FY1 f2{(const bf16_t*)c.out, WSP(bf16_t, WS_R2), 1024, true};
               run_gemm<T, 1024, 1024, 1024, 0>(c, WSP(bf16_t, WS_R6), WSP(bf16_t, WS_WOL), f2); })
    PHASE(9, FX1 f{c.in[I_X], c.out, WSP(float, WS_MOD)};
             run_gemm<T, 1024, 1024, 1024, 0>(c, WSP(bf16_t, WS_R2), WSP(bf16_t, WS_WOUT), f);)
    PHASE(10, phase_modnorm<false>(c, c.out, c.in[I_N2G], 3072, 4096, WSP(bf16_t, WS_R0));)
    PHASE(11, FStore f{WSP(bf16_t, WS_QP), 2048};
              run_gemm<T, 2048, 1024, 1024, 0>(c, WSP(bf16_t, WS_R0), WSP(bf16_t, WS_WQ), f);)
    PHASE(12, FStore f{WSP(bf16_t, WS_SC), 2048};
              run_gemm<T, 2048, 256, 2048, 256>(c, WSP(bf16_t, WS_QP), WSP(bf16_t, WS_SK), f);)
    PHASE(13, phase_topk(c);)
    PHASE(14, phase_peer_u(c);)
    PHASE(15, phase_peer_fin(c);)
#ifdef PROBE_VDRY
    if (IN(16)) { c.lane = lane_id_v(); c.tid = c.wave * 64 + c.lane; phase_peer_v<true>(c); xcd_barrier(bar, c.wave); }
#endif
    PHASE(16, phase_peer_v<false>(c);)
#undef PHASE
#undef IN
#undef SEAM
}

extern "C" void kernel_launch(void* const* d_in, const int* in_sizes, int n_in, void* d_out, int out_size, void* d_ws, size_t ws_size, hipStream_t stream) {
    static int grid = 0;
    if (grid == 0) {
        if (n_in != 28 || out_size != T * D || ws_size < WS_END) { fprintf(stderr, "kernel_launch: unexpected shapes (n_in %d out %d ws %zu)\n", n_in, out_size, ws_size); grid = -1; return; }
        int dev = 0, cus = 0, per_cu = 0;
        if (hipGetDevice(&dev) != hipSuccess || hipDeviceGetAttribute(&cus, hipDeviceAttributeMultiprocessorCount, dev) != hipSuccess) { grid = -1; return; }
        if (hipFuncSetAttribute((const void*)mk_fwd, hipFuncAttributeMaxDynamicSharedMemorySize, LDS_BYTES) != hipSuccess) { fprintf(stderr, "kernel_launch: hipFuncSetAttribute failed\n"); grid = -1; return; }
        if (hipOccupancyMaxActiveBlocksPerMultiprocessor(&per_cu, (const void*)mk_fwd, 512, LDS_BYTES) != hipSuccess || per_cu < 1) { fprintf(stderr, "kernel_launch: occupancy query says %d blocks per CU\n", per_cu); grid = -1; (void)hipGetLastError(); return; }
        grid = cus - (cus % 8);
        if (grid < 8) { fprintf(stderr, "kernel_launch: needs at least 8 CUs\n"); grid = -1; return; }
    }
    if (grid < 0) return;
    (void)hipMemsetAsync((char*)d_ws + WS_CTL, 0, CTL_ZERO_BYTES, stream);
    Args a{};
    for (int i = 0; i < 28; ++i) a.in[i] = (const float*)d_in[i];
    a.out = (float*)d_out; a.ws = (unsigned char*)d_ws;
#if MK_N_LAUNCHES == 1
    a.ph_lo = 0; a.ph_hi = N_PHASES;
    hipLaunchKernelGGL(mk_fwd, dim3(grid), dim3(512), LDS_BYTES, stream, a);
#else
    for (int ph = 0; ph < N_PHASES; ++ph) { a.ph_lo = ph; a.ph_hi = ph + 1; hipLaunchKernelGGL(mk_fwd, dim3(grid), dim3(512), LDS_BYTES, stream, a); }
#endif
}
```

```cpp
#include <hip/hip_runtime.h>
#include <cstdio>
#include <cstdint>

#define LAS __attribute__((address_space(3)))
#define GAS __attribute__((address_space(1)))
typedef unsigned short bf16_t;
typedef short bf16x8 __attribute__((ext_vector_type(8)));
typedef float f32x4 __attribute__((ext_vector_type(4)));
typedef float f32x2 __attribute__((ext_vector_type(2)));
typedef unsigned u32x4 __attribute__((ext_vector_type(4)));
typedef unsigned u32x2 __attribute__((ext_vector_type(2)));

#ifndef MK_N_LAUNCHES
#define MK_N_LAUNCHES 1
#endif

constexpr int T = 32768, D = 1024, NB_ = 16, S = 2048, H = 8;
constexpr int QKH = 96, VH = 64;
constexpr int NE = 16384;
constexpr float EPS = 1e-6f;

constexpr size_t MiB = 1u << 20;
constexpr size_t WS_CTL = 0, CTL_ZERO_BYTES = 65536;
constexpr size_t WS_MOD = 1 * MiB;
constexpr size_t WS_RSTD = 1 * MiB + 512 * 1024;
constexpr size_t WS_C8SP = 1 * MiB + 448 * 1024;
constexpr size_t WS_WIN = 2 * MiB;
constexpr size_t WS_WUQ = 11 * MiB;
constexpr size_t WS_WUKV = 11 * MiB + 512 * 1024;
constexpr size_t WS_WOA = 12 * MiB;
constexpr size_t WS_WOL = 13 * MiB;
constexpr size_t WS_WOUT = 15 * MiB;
constexpr size_t WS_WQ = 17 * MiB;
constexpr size_t WS_WG = 21 * MiB;
constexpr size_t WS_SK = 22 * MiB;
constexpr size_t WS_EU = 24 * MiB;
constexpr size_t WS_EV = 40 * MiB;
constexpr size_t WS_SU = 1 * MiB + 768 * 1024;
constexpr size_t WS_SV = 1 * MiB + 832 * 1024;
constexpr size_t WS_WGT = 440 * MiB;
constexpr size_t WS_CS = 56 * MiB;
constexpr size_t WS_H2Q = 456 * MiB;
constexpr size_t WS_SH = 1 * MiB + 896 * 1024;
constexpr size_t WS_PD = 280 * MiB;
constexpr size_t WS_R0 = 88 * MiB;
constexpr size_t WS_R1 = 152 * MiB;
constexpr size_t WS_R2 = 184 * MiB;
constexpr size_t WS_R3 = 248 * MiB;
constexpr size_t WS_R4 = 312 * MiB;
constexpr size_t WS_R5 = 376 * MiB;
constexpr size_t WS_R6 = 424 * MiB;
constexpr size_t WS_QP = 152 * MiB;
constexpr size_t WS_SC = 280 * MiB;
constexpr size_t WS_IDX = 408 * MiB;
constexpr size_t WS_GW = 424 * MiB;
constexpr size_t WS_END = 488 * MiB;

constexpr int LDS_BYTES = 147456;
constexpr int MISC_OFF = 131072 + 320;

__device__ __forceinline__ unsigned f2bf(float f) { unsigned u = __builtin_bit_cast(unsigned, f); return (u + 0x7fffu + ((u >> 16) & 1u)) >> 16; }
typedef __bf16 bf16x2_t __attribute__((ext_vector_type(2)));
__device__ __forceinline__ unsigned pk2(float lo, float hi) { f32x2 v = {lo, hi}; return __builtin_bit_cast(unsigned, __builtin_convertvector(v, bf16x2_t)); }
__device__ __forceinline__ float bf2f(unsigned h) { return __builtin_bit_cast(float, h << 16); }
__device__ __forceinline__ float bflo(unsigned w) { return __builtin_bit_cast(float, w << 16); }
__device__ __forceinline__ float bfhi(unsigned w) { return __builtin_bit_cast(float, w & 0xffff0000u); }
__device__ __forceinline__ float sigmoidf_(float x) { return 1.f / (1.f + __expf(-x)); }
__device__ __forceinline__ float gelu_tanh(float x) {
    const float u = 0.7978845608028654f * (x + 0.044715f * x * x * x);
    const float e = __expf(2.f * u);
    const float th = 1.f - 2.f / (e + 1.f);
    return 0.5f * x * (1.f + th);
}
__device__ __forceinline__ int lane_id_v() { int l; asm volatile("v_mbcnt_lo_u32_b32 %0, -1, 0\n\tv_mbcnt_hi_u32_b32 %0, -1, %0" : "=v"(l)); return l; }
__device__ __forceinline__ float wave_sum(float v) {
#pragma unroll
    for (int o = 1; o < 64; o <<= 1) v += __shfl_xor(v, o);
    return v;
}
__device__ __forceinline__ void unpack8(const u32x4 w, float (&v)[8]) {
    v[0] = bflo(w.x); v[1] = bfhi(w.x); v[2] = bflo(w.y); v[3] = bfhi(w.y); v[4] = bflo(w.z); v[5] = bfhi(w.z); v[6] = bflo(w.w); v[7] = bfhi(w.w);
}
__device__ __forceinline__ u32x4 pack8(const float (&v)[8]) {
    u32x4 w; w.x = pk2(v[0], v[1]); w.y = pk2(v[2], v[3]); w.z = pk2(v[4], v[5]); w.w = pk2(v[6], v[7]); return w;
}

namespace pg8 {
#define PG8_LAS __attribute__((address_space(3)))
constexpr int BM = 256, BK = 64, HALF = 128, HTB = HALF * BK * 2, STAGE_BYTES = 8 * HTB, NXCD = 8, WGM = 8;
__host__ __device__ __forceinline__ int lds_byte(int r, int c) { const int st = (r >> 4) * 2 + (c >> 5), rr = r & 15, cc = c & 31, ob = rr * 64 + cc * 2; return st * 1024 + (ob ^ (((ob >> 9) & 1) << 5)); }
__host__ __device__ __forceinline__ void stage_rc(int b, int& R, int& C) { const int st = b / 1024, sb = b % 1024, swz = sb ^ (((sb >> 9) & 1) << 5); R = (st >> 1) * 16 + swz / 64; C = (st & 1) * 32 + (swz % 64) / 2; }
__host__ __device__ __forceinline__ int perm32(int rho) { const int n = rho >> 4, i = rho & 15; return 8 * (i >> 2) + 4 * n + (i & 3); }

struct Unit { int pm, pn; };
struct Gemm { const bf16_t* A; const bf16_t* Bt; };

template <int M_, int N_> struct StaticOrder {
    static constexpr int nM = M_ / BM, nN = N_ / BM, nwg = nM * nN;
    int G, c;
    __host__ __device__ void init(int G_, int c_) { G = G_; c = c_; }
    __host__ __device__ bool next(int i, Unit& u) const {
        const long L = (long)i * G + c; if (L >= nwg) return false;
        int wgid = (int)L; { const int q = nwg / NXCD, r = nwg % NXCD, xcd = wgid % NXCD, off = wgid / NXCD; wgid = (xcd < r ? xcd * (q + 1) : r * (q + 1) + (xcd - r) * q) + off; }
        const int nig = WGM * nN, gid = wgid / nig, fm = gid * WGM, gsz = (nM - fm) < WGM ? (nM - fm) : WGM;
        u.pm = fm + ((wgid % nig) % gsz); u.pn = (wgid % nig) / gsz; return true;
    }
};

template <class F> struct EpiF {
    static constexpr bool PERM = true;
    F f;
    __device__ __forceinline__ void operator()(const f32x4 (&acc)[2][2][4][2], const Unit& u, int wr, int wc, int fr, int fq) const {
        const int c = wc * 32 + 8 * fq;
#pragma unroll
        for (int ai = 0; ai < 2; ++ai)
#pragma unroll
            for (int m = 0; m < 4; ++m) {
                const int row = u.pm * BM + ai * HALF + wr * 64 + m * 16 + fr;
                float v0[8], v1[8];
#pragma unroll
                for (int j = 0; j < 4; ++j) { v0[j] = acc[ai][0][m][0][j]; v0[4 + j] = acc[ai][0][m][1][j]; v1[j] = acc[ai][1][m][0][j]; v1[4 + j] = acc[ai][1][m][1][j]; }
                f(row, u.pn, c, v0, v1);
            }
    }
};

template <int K, int LDA, int ACS, class Epi, class Sched>
__device__ __forceinline__ void gemm_phase(PG8_LAS unsigned char* lds, const Gemm g, const Sched& S, const Epi& E, const int tid) {
    const int wid = __builtin_amdgcn_readfirstlane(tid >> 6), lane = tid & 63, wr = wid >> 2, wc = wid & 3, fr = lane & 15, fq = lane >> 4;
    constexpr int nt = K / BK;
    unsigned voffA[2], voffB[2];
#pragma unroll
    for (int i = 0; i < 2; ++i) { int R, C; stage_rc(tid * 16 + i * 8192, R, C); const int Rb = Epi::PERM ? ((R & ~31) + perm32(R & 31)) : R;
        voffA[i] = (unsigned)(R * LDA + C) * 2u; voffB[i] = (unsigned)(Rb * K + C) * 2u; }
    constexpr size_t kstep = (size_t)(BK * 2);
    constexpr size_t hstepA = (size_t)HALF * LDA * 2, hstepB = (size_t)HALF * K * 2;
    constexpr size_t tstepA = 2 * hstepA, tstepB = 2 * hstepB;
    constexpr size_t acsb = (size_t)ACS * 2;
    const unsigned ldsw = (unsigned)wid * 1024u;
    const int aoff = lds_byte(wr * 64 + fr, fq * 8), boff = lds_byte(wc * 32 + fr, fq * 8);
#define PG8_SA(b, h) (((b) * 2 + (h)) * HTB)
#define PG8_SB(b, h) ((4 + (b) * 2 + (h)) * HTB)
#define PG8_STAGE(bufoff, gbase, voff) do { _Pragma("unroll") for (int _i = 0; _i < 2; ++_i) \
        __builtin_amdgcn_global_load_lds((const unsigned*)((const char*)(gbase) + (voff)[_i]), (PG8_LAS unsigned*)(lds + (bufoff) + ldsw + _i * 8192), 16, 0, 0); } while (0)
#define PG8_LDA(dst, b, h) do { _Pragma("unroll") for (int m = 0; m < 4; ++m) _Pragma("unroll") for (int k = 0; k < 2; ++k) dst[m][k] = *(const PG8_LAS bf16x8*)(lds + PG8_SA(b, h) + aoff + m * 2048 + k * 1024); } while (0)
#define PG8_LDB(dst, b, h) do { _Pragma("unroll") for (int n = 0; n < 2; ++n) _Pragma("unroll") for (int k = 0; k < 2; ++k) dst[n][k] = *(const PG8_LAS bf16x8*)(lds + PG8_SB(b, h) + boff + n * 2048 + k * 1024); } while (0)
#define PG8_MMA(ai, bj, At, Bt) do { __builtin_amdgcn_s_setprio(1); _Pragma("unroll") for (int m = 0; m < 4; ++m) _Pragma("unroll") for (int n = 0; n < 2; ++n) _Pragma("unroll") for (int k = 0; k < 2; ++k) \
        acc[ai][bj][m][n] = __builtin_amdgcn_mfma_f32_16x16x32_bf16(Bt[n][k], At[m][k], acc[ai][bj][m][n], 0, 0, 0); __builtin_amdgcn_s_setprio(0); } while (0)
#define PG8_WAIT_V(n) asm volatile("s_waitcnt vmcnt(" #n ")" ::: "memory")
#define PG8_WAIT_L(n) asm volatile("s_waitcnt lgkmcnt(" #n ")" ::: "memory")
#define PG8_BAR __builtin_amdgcn_s_barrier()
#define PG8_SCHED __builtin_amdgcn_sched_barrier(0)
    Unit cur, nxt; int ui = 0;
    if (!S.next(0, cur)) return;
    f32x4 acc[2][2][4][2];
#pragma unroll
    for (int a = 0; a < 2; ++a)
#pragma unroll
        for (int b = 0; b < 2; ++b)
#pragma unroll
            for (int m = 0; m < 4; ++m)
#pragma unroll
                for (int n = 0; n < 2; ++n) acc[a][b][m][n] = (f32x4){0.f, 0.f, 0.f, 0.f};
    bf16x8 At[4][2], B0[2][2], B1[2][2];
    const char* cA = (const char*)g.A + (size_t)cur.pm * tstepA + (size_t)cur.pn * acsb; const char* cB = (const char*)g.Bt + (size_t)cur.pn * tstepB;
    PG8_STAGE(PG8_SB(0, 0), cB, voffB); PG8_STAGE(PG8_SB(0, 1), cB + hstepB, voffB); PG8_STAGE(PG8_SA(0, 0), cA, voffA); PG8_STAGE(PG8_SA(0, 1), cA + hstepA, voffA);
    if (wr == 1) PG8_BAR;
    PG8_WAIT_V(2); PG8_BAR;
    PG8_STAGE(PG8_SB(1, 0), cB + kstep, voffB); PG8_STAGE(PG8_SA(1, 0), cA + kstep, voffA); PG8_STAGE(PG8_SB(1, 1), cB + hstepB + kstep, voffB);
    PG8_WAIT_V(6); PG8_BAR;
    for (;;) {
        const bool has_next = S.next(ui + 1, nxt);
        const char* nA = has_next ? (const char*)g.A + (size_t)nxt.pm * tstepA + (size_t)nxt.pn * acsb : cA; const char* nB = has_next ? (const char*)g.Bt + (size_t)nxt.pn * tstepB : cB;
#pragma unroll 1
        for (int t = 0; t < nt; t += 2) {
            const bool last = (t == nt - 2);
            const char* a1 = cA + (size_t)(t + 1) * kstep;
            const char* a2 = last ? nA : cA + (size_t)(t + 2) * kstep; const char* b2 = last ? nB : cB + (size_t)(t + 2) * kstep;
            const char* a3 = a2 + kstep; const char* b3 = b2 + kstep;
            PG8_LDB(B0, 0, 0); PG8_LDB(B1, 0, 1); PG8_SCHED; PG8_LDA(At, 0, 0); PG8_STAGE(PG8_SA(1, 1), a1 + hstepA, voffA);
            PG8_WAIT_V(8); PG8_WAIT_L(0); PG8_BAR; PG8_MMA(0, 0, At, B0); PG8_MMA(0, 1, At, B1); PG8_BAR; PG8_SCHED;
            PG8_LDA(At, 0, 1); PG8_STAGE(PG8_SB(0, 0), b2, voffB); PG8_STAGE(PG8_SB(0, 1), b2 + hstepB, voffB); PG8_STAGE(PG8_SA(0, 0), a2, voffA);
            PG8_WAIT_V(8); PG8_WAIT_L(0); PG8_BAR; PG8_MMA(1, 0, At, B0); PG8_MMA(1, 1, At, B1); PG8_BAR; PG8_SCHED;
            PG8_LDB(B0, 1, 0); PG8_LDB(B1, 1, 1); PG8_SCHED; PG8_LDA(At, 1, 0); PG8_STAGE(PG8_SA(0, 1), a2 + hstepA, voffA);
            PG8_WAIT_V(8); PG8_WAIT_L(0); PG8_BAR; PG8_MMA(0, 0, At, B0); PG8_MMA(0, 1, At, B1); PG8_BAR; PG8_SCHED;
            PG8_LDA(At, 1, 1); PG8_STAGE(PG8_SB(1, 0), b3, voffB); PG8_STAGE(PG8_SB(1, 1), b3 + hstepB, voffB); PG8_STAGE(PG8_SA(1, 0), a3, voffA);
            PG8_WAIT_V(8); PG8_WAIT_L(0); PG8_BAR; PG8_MMA(1, 0, At, B0); PG8_MMA(1, 1, At, B1); PG8_BAR; PG8_SCHED;
        }
        if (wr == 0) PG8_BAR;
        E(acc, cur, wr, wc, fr, fq);
        if (!has_next) break;
#pragma unroll
        for (int a = 0; a < 2; ++a)
#pragma unroll
            for (int b = 0; b < 2; ++b)
#pragma unroll
                for (int m = 0; m < 4; ++m)
#pragma unroll
                    for (int n = 0; n < 2; ++n) acc[a][b][m][n] = (f32x4){0.f, 0.f, 0.f, 0.f};
        cur = nxt; cA = nA; cB = nB; ++ui;
        if (wr == 1) PG8_BAR;
    }
    PG8_WAIT_V(0);
    PG8_BAR;
#undef PG8_SA
#undef PG8_SB
#undef PG8_STAGE
#undef PG8_LDA
#undef PG8_LDB
#undef PG8_MMA
#undef PG8_WAIT_V
#undef PG8_WAIT_L
#undef PG8_BAR
#undef PG8_SCHED
}
}

#define XB_TMO      128
#define XB_XCNT(j)  (256  + 64 * (j))
#define XB_XSUB(j)  (1280 + 64 * (j))
#define XB_XGEN(j)  (2304 + 64 * (j))
#define XB_TOP      3328
#define XB_TOPGEN   3392
#define XCD_BAR_WORDS 3456
#define XB_SPIN_CAP (1u << 18)
__device__ __forceinline__ unsigned xb_ld(unsigned* p)              { return __hip_atomic_load(p, __ATOMIC_RELAXED, __HIP_MEMORY_SCOPE_AGENT); }
__device__ __forceinline__ unsigned xb_add(unsigned* p, unsigned v) { return __hip_atomic_fetch_add(p, v, __ATOMIC_RELAXED, __HIP_MEMORY_SCOPE_AGENT); }
__device__ __forceinline__ unsigned xb_xcc_id() { return (unsigned)__builtin_amdgcn_s_getreg((3 << 11) | 20) & 0xFu; }
#define XB_SPIN(cond, bar) do { unsigned _sp = 0; while (cond) { __builtin_amdgcn_s_sleep(1); \
    if ((++_sp & 255u) == 0u) { if (xb_ld(&(bar)[XB_TMO])) break; if (_sp > XB_SPIN_CAP) { atomicAdd(&(bar)[XB_TMO], 1u); break; } } } } while (0)
struct XcdBarrier { unsigned* bar; unsigned x; volatile LAS unsigned* st; };
__device__ __forceinline__ XcdBarrier xcd_barrier_post(unsigned* bar, volatile LAS unsigned* st) {
    XcdBarrier b; b.bar = bar; b.x = xb_xcc_id(); b.st = st;
    if (threadIdx.x == 0) (void)xb_add(&bar[XB_XCNT(b.x)], 1u);
    return b;
}
__device__ __forceinline__ void xcd_barrier_complete(unsigned* bar, unsigned x, unsigned& nloc, unsigned& nx) {
    const unsigned G = gridDim.x * gridDim.y * gridDim.z;
    unsigned sum, cnt, mine, sp = 0u;
    for (;;) {
        sum = 0u; cnt = 0u; mine = 0u;
#pragma unroll
        for (unsigned j = 0; j < 16; ++j) { const unsigned c = xb_ld(&bar[XB_XCNT(j)]); sum += c; cnt += (c > 0u) ? 1u : 0u; mine = (j == x) ? c : mine; }
        if (sum == G) break;
        __builtin_amdgcn_s_sleep(1);
        if ((++sp & 255u) == 0u) { if (xb_ld(&bar[XB_TMO])) break; if (sp > XB_SPIN_CAP) { atomicAdd(&bar[XB_TMO], 1u); break; } }
    }
    nloc = mine > 0u ? mine : 1u; nx = cnt > 0u ? cnt : 1u;
}
__device__ __forceinline__ void xcd_barrier(const XcdBarrier& b, int wave) {
    asm volatile("s_waitcnt vmcnt(0)" ::: "memory");
    __syncthreads();
    if (wave == 0 && lane_id_v() == 0) {
        unsigned* bar = b.bar;
        __builtin_amdgcn_s_waitcnt(0);
        unsigned nloc = b.st[0], nx = b.st[1];
        if (nloc == 0u) { xcd_barrier_complete(bar, b.x, nloc, nx); b.st[0] = nloc; b.st[1] = nx; }
        const unsigned old = xb_add(&bar[XB_XSUB(b.x)], 1u);
        const unsigned gen = old / nloc;
        if (old + 1u == (gen + 1u) * nloc) {
            __builtin_amdgcn_fence(__ATOMIC_RELEASE, "agent");
            asm volatile("s_waitcnt vmcnt(0)" ::: "memory");
            const unsigned og = xb_add(&bar[XB_TOP], 1u);
            const unsigned tg = og / nx;
            if (og + 1u == (tg + 1u) * nx) xb_add(&bar[XB_TOPGEN], 1u);
            else XB_SPIN(xb_ld(&bar[XB_TOPGEN]) == tg, bar);
            __builtin_amdgcn_fence(__ATOMIC_ACQUIRE, "agent");
            xb_add(&bar[XB_XGEN(b.x)], 1u);
            asm volatile("s_waitcnt vmcnt(0)" ::: "memory");
        } else {
            XB_SPIN(xb_ld(&bar[XB_XGEN(b.x)]) == gen, bar);
            __builtin_amdgcn_fence(__ATOMIC_ACQUIRE, "agent");
            asm volatile("s_waitcnt vmcnt(0)" ::: "memory");
        }
    }
    __syncthreads();
}

struct Args { const float* in[28]; float* out; unsigned char* ws; int ph_lo, ph_hi; };
enum { I_X = 0, I_C, I_POS, I_WADA, I_BADA, I_N1G, I_WIN, I_QAG, I_WUQ, I_KVAG, I_WUKV, I_QNG, I_KNG, I_WOA, I_CONVW, I_CONVB, I_WRG, I_BRG, I_WIG, I_BIG, I_LAM, I_WOL, I_WOUT, I_N2G, I_WQ, I_SUBK, I_EU, I_EV };
constexpr int N_PHASES = 17;

struct Ctx {
    LAS unsigned char* lds;
    int tid, lane, wave, vcu, G;
    const float* const* in; float* out; unsigned char* ws;
};
#define WSP(type, off) ((type*)(c.ws + (off)))

template <class F>
__device__ __forceinline__ void tr_tile(const Ctx& c, bf16_t* dst, int K, int n0, int k0, F f) {
    LAS float* scr = (LAS float*)c.lds;
#pragma unroll
    for (int i = 0; i < 8; ++i) { const int kk = i * 8 + (c.tid >> 6), nn = c.tid & 63; scr[kk * 65 + nn] = f(k0 + kk, n0 + nn); }
    __syncthreads();
    { const int kc = c.tid & 7, nn = c.tid >> 3;
      LAS const float* s = scr + (8 * kc) * 65 + nn;
      u32x4 o; o.x = pk2(s[0], s[65]); o.y = pk2(s[2 * 65], s[3 * 65]); o.z = pk2(s[4 * 65], s[5 * 65]); o.w = pk2(s[6 * 65], s[7 * 65]);
      *(u32x4*)(dst + (size_t)(n0 + nn) * K + k0 + 8 * kc) = o; }
    __syncthreads();
}

__device__ __forceinline__ void phase_prep(const Ctx& c0) {
    Ctx c = c0; c.lane = lane_id_v(); c.tid = c.wave * 64 + c.lane;
    const float* w_in = c.in[I_WIN]; const float* w_uq = c.in[I_WUQ]; const float* qag = c.in[I_QAG]; const float* w_ukv = c.in[I_WUKV]; const float* kvag = c.in[I_KVAG];
    const float* w_oa = c.in[I_WOA]; const float* w_ol = c.in[I_WOL]; const float* w_out = c.in[I_WOUT]; const float* w_q = c.in[I_WQ];
    const float* w_rg = c.in[I_WRG]; const float* w_ig = c.in[I_WIG];
    constexpr int T_WIN = 72 * 16, T_WUQ = 12 * 4, T_WUKV = 16 * 2, T_WOA = 16 * 8, T_WOL = 16 * 16, T_WOUT = 16 * 16, T_WQ = 32 * 16, T_WG = 8 * 4 * 2;
    constexpr int T_ALL = T_WIN + T_WUQ + T_WUKV + T_WOA + T_WOL + T_WOUT + T_WQ + T_WG;
    for (int it = c.vcu; it < T_ALL; it += c.G) {
        int r = it;
        if (r < T_WIN) { const int nb = r / 16, kb = r % 16;
            tr_tile(c, WSP(bf16_t, WS_WIN), 1024, nb * 64, kb * 64, [=](int k, int n) -> float { return n < 416 ? w_in[(size_t)k * 4512 + n] : (n < 512 ? 0.f : w_in[(size_t)k * 4512 + n - 96]); }); continue; }
        r -= T_WIN;
        if (r < T_WUQ) { const int nb = r / 4, kb = r % 4;
            tr_tile(c, WSP(bf16_t, WS_WUQ), 256, nb * 64, kb * 64, [=](int k, int n) -> float { return w_uq[(size_t)k * 768 + n] * qag[k]; }); continue; }
        r -= T_WUQ;
        if (r < T_WUKV) { const int nb = r / 2, kb = r % 2;
            tr_tile(c, WSP(bf16_t, WS_WUKV), 128, nb * 64, kb * 64, [=](int k, int n) -> float { return w_ukv[(size_t)k * 1024 + n] * kvag[k]; }); continue; }
        r -= T_WUKV;
        if (r < T_WOA) { const int nb = r / 8, kb = r % 8;
            tr_tile(c, WSP(bf16_t, WS_WOA), 512, nb * 64, kb * 64, [=](int k, int n) -> float { return w_oa[(size_t)k * 1024 + n]; }); continue; }
        r -= T_WOA;
        if (r < T_WOL) { const int nb = r / 16, kb = r % 16;
            tr_tile(c, WSP(bf16_t, WS_WOL), 1024, nb * 64, kb * 64, [=](int k, int n) -> float { return w_ol[(size_t)k * 1024 + n]; }); continue; }
        r -= T_WOL;
        if (r < T_WOUT) { const int nb = r / 16, kb = r % 16;
            tr_tile(c, WSP(bf16_t, WS_WOUT), 1024, nb * 64, kb * 64, [=](int k, int n) -> float { return w_out[(size_t)k * 1024 + n]; }); continue; }
        r -= T_WOUT;
        if (r < T_WQ) { const int nb = r / 16, kb = r % 16;
            tr_tile(c, WSP(bf16_t, WS_WQ), 1024, nb * 64, kb * 64, [=](int k, int n) -> float { return w_q[(size_t)k * 2048 + n]; }); continue; }
        r -= T_WQ;
        { const int blk = r / 8, q = r % 8, nb = q / 2, kb = q % 2;
            tr_tile(c, WSP(bf16_t, WS_WG) + (size_t)blk * 256 * 128, 128, nb * 64, kb * 64,
                    [=](int k, int n) -> float { return n < 128 ? w_rg[((size_t)blk * 128 + k) * 128 + n] : w_ig[((size_t)blk * 128 + k) * 128 + n - 128]; }); }
    }
    { const float* lam = c.in[I_LAM]; float* t8 = WSP(float, WS_C8SP);
      if (c.vcu == 0) for (int e = c.tid; e < 1024; e += 512) t8[e] = -8.f * log1pf(__expf(-lam[e])); }
    if (c.vcu == 0 && c.tid == 0) {
        const unsigned probe = __builtin_amdgcn_cvt_scalef32_pk_fp4_f32(0u, 1.0f, 0.0f, 1.0f, 0) & 0xffu;
        WSP(unsigned, WS_C8SP)[1024] = (probe == 0x02u) ? 0u : 1u; }
    { const float* sk = c.in[I_SUBK]; bf16_t* dst = WSP(bf16_t, WS_SK);
      for (int e = c.vcu * 512 + c.tid; e < 8 * 256 * 256; e += c.G * 512) {
          const int h = e >> 16, r = (e >> 8) & 255, cc = e & 255;
          float v = 0.f; if ((r >> 7) == (cc >> 7)) v = sk[(((size_t)h * 2 + (r >> 7)) * 128 + (r & 127)) * 128 + (cc & 127)];
          dst[e] = (bf16_t)f2bf(v); } }
    { const int gw = c.vcu * 8 + c.wave, NGW = c.G * 8, L = c.lane;
      for (int r = gw; r < 2 * NE; r += NGW) {
          const int isv = r >= NE, e = isv ? r - NE : r;
          const f32x4* src4 = (const f32x4*)((isv ? c.in[I_EV] : c.in[I_EU]) + (size_t)e * 1024 + 16 * L);
          f32x4 v[4]; float am = 0.f;
#pragma unroll
          for (int j = 0; j < 4; ++j) { v[j] = src4[j]; am = fmaxf(am, fmaxf(fmaxf(fabsf(v[j].x), fabsf(v[j].y)), fmaxf(fabsf(v[j].z), fabsf(v[j].w)))); }
#pragma unroll
          for (int o = 1; o < 64; o <<= 1) am = fmaxf(am, __shfl_xor(am, o));
          const float s = am > 0.f ? am * (1.f / 6.f) : 1.f, inv = 1.f / s;
          unsigned w0 = 0u, w1 = 0u;
          w0 = __builtin_amdgcn_cvt_scalef32_pk_fp4_f32(w0, v[0].x * inv, v[0].y * inv, 1.0f, 0); w0 = __builtin_amdgcn_cvt_scalef32_pk_fp4_f32(w0, v[0].z * inv, v[0].w * inv, 1.0f, 1);
          w0 = __builtin_amdgcn_cvt_scalef32_pk_fp4_f32(w0, v[1].x * inv, v[1].y * inv, 1.0f, 2); w0 = __builtin_amdgcn_cvt_scalef32_pk_fp4_f32(w0, v[1].z * inv, v[1].w * inv, 1.0f, 3);
          w1 = __builtin_amdgcn_cvt_scalef32_pk_fp4_f32(w1, v[2].x * inv, v[2].y * inv, 1.0f, 0); w1 = __builtin_amdgcn_cvt_scalef32_pk_fp4_f32(w1, v[2].z * inv, v[2].w * inv, 1.0f, 1);
          w1 = __builtin_amdgcn_cvt_scalef32_pk_fp4_f32(w1, v[3].x * inv, v[3].y * inv, 1.0f, 2); w1 = __builtin_amdgcn_cvt_scalef32_pk_fp4_f32(w1, v[3].z * inv, v[3].w * inv, 1.0f, 3);
          u32x2 q; q.x = w0; q.y = w1;
          *(u32x2*)(c.ws + (isv ? WS_EV : WS_EU) + ((size_t)(L >> 4) * NE + e) * 128 + (L & 15) * 8) = q;
          if (L == 0) WSP(float, isv ? WS_SV : WS_SU)[e] = s;
      } }
    { const float* cin = c.in[I_C]; const float* w_ada = c.in[I_WADA]; const float* b_ada = c.in[I_BADA]; float* mod = WSP(float, WS_MOD);
      LAS float* cs = (LAS float*)c.lds;
      LAS float* red = (LAS float*)(c.lds + 65536);
      bool have = false;
      for (int it = c.vcu; it < 192; it += c.G) {
          if (!have) { for (int e = c.tid; e < 16 * 1024; e += 512) { const float v = cin[e]; cs[e] = v / (1.f + __expf(-v)); } have = true; }
          __syncthreads();
          const int cl = c.tid & 31, ks = c.tid >> 5, j = it * 32 + cl;
          float acc[16];
#pragma unroll
          for (int b = 0; b < 16; ++b) acc[b] = 0.f;
          for (int kk = 0; kk < 64; ++kk) { const int k = ks * 64 + kk; const float w = w_ada[(size_t)k * 6144 + j];
#pragma unroll
              for (int b = 0; b < 16; ++b) acc[b] += cs[b * 1024 + k] * w; }
#pragma unroll
          for (int b = 0; b < 16; ++b) red[(ks * 16 + b) * 32 + cl] = acc[b];
          __syncthreads();
          { const int b = c.tid >> 5; float s = b_ada[j];
#pragma unroll
            for (int k2 = 0; k2 < 16; ++k2) s += red[(k2 * 16 + b) * 32 + cl];
            mod[b * 6144 + j] = s; }
          __syncthreads();
      } }
}

template <bool Q8>
__device__ __forceinline__ void phase_modnorm(const Ctx& c0, const float* x, const float* g, int shift_off, int scale_off, bf16_t* dst) {
    Ctx c = c0; c.lane = lane_id_v(); c.tid = c.wave * 64 + c.lane;
    const float* mod = WSP(float, WS_MOD);
    const int gw = c.vcu * 8 + c.wave, NGW = c.G * 8;
    for (int m = gw; m < T; m += NGW) {
        const int b = m >> 11;
        const f32x4* xr = (const f32x4*)(x + (size_t)m * D) + c.lane;
        f32x4 v[4]; float s = 0.f;
#pragma unroll
        for (int j = 0; j < 4; ++j) { v[j] = xr[64 * j]; s += (v[j].x * v[j].x + v[j].y * v[j].y) + (v[j].z * v[j].z + v[j].w * v[j].w); }
        const float rstd = rsqrtf(wave_sum(s) * (1.f / D) + EPS);
        u32x2* o8 = (u32x2*)(dst + (size_t)m * D) + c.lane;
        float am = 0.f;
#pragma unroll
        for (int j = 0; j < 4; ++j) {
            const int col = 4 * c.lane + 256 * j;
            const f32x4 gg = *(const f32x4*)(g + col), sc = *(const f32x4*)(mod + b * 6144 + scale_off + col), sh = *(const f32x4*)(mod + b * 6144 + shift_off + col);
            const float r0 = v[j].x * rstd * gg.x * (1.f + sc.x) + sh.x, r1 = v[j].y * rstd * gg.y * (1.f + sc.y) + sh.y;
            const float r2 = v[j].z * rstd * gg.z * (1.f + sc.z) + sh.z, r3 = v[j].w * rstd * gg.w * (1.f + sc.w) + sh.w;
            u32x2 w; w.x = pk2(r0, r1); w.y = pk2(r2, r3); o8[64 * j] = w;
            if (Q8) { v[j].x = r0; v[j].y = r1; v[j].z = r2; v[j].w = r3; am = fmaxf(am, fmaxf(fmaxf(fabsf(r0), fabsf(r1)), fmaxf(fabsf(r2), fabsf(r3)))); }
        }
        if (Q8) {
#pragma unroll
            for (int o = 1; o < 64; o <<= 1) am = fmaxf(am, __shfl_xor(am, o));
            const float sq = am > 0.f ? am * (1.f / 256.f) : 1.f, inv = 1.f / sq;
            unsigned* q8 = (unsigned*)(c.ws + WS_H2Q + (size_t)m * D) + c.lane;
#pragma unroll
            for (int j = 0; j < 4; ++j) { int w = __builtin_amdgcn_cvt_pk_fp8_f32(v[j].x * inv, v[j].y * inv, 0, false); w = __builtin_amdgcn_cvt_pk_fp8_f32(v[j].z * inv, v[j].w * inv, w, true); q8[64 * j] = (unsigned)w; }
            if (c.lane == 0) WSP(float, WS_SH)[m] = sq;
        }
    }
}

__device__ __forceinline__ void phase_conv(const Ctx& c0) {
    Ctx c = c0; c.lane = lane_id_v(); c.tid = c.wave * 64 + c.lane;
    const bf16_t* pa = WSP(bf16_t, WS_R1); const bf16_t* lx = WSP(bf16_t, WS_R2); bf16_t* xc = WSP(bf16_t, WS_R4); float* rstd = WSP(float, WS_RSTD);
    const float* cw = c.in[I_CONVW]; const float* cb = c.in[I_CONVB];
    const int gt = c.vcu * 512 + c.tid, NT = c.G * 512;
    { const int gw = c.vcu * 8 + c.wave, NGW = c.G * 8, L = c.lane;
      for (int t = gw; t < T; t += NGW) {
          float ss = 0.f;
          if (L < 48) { float v[8]; unpack8(*(const u32x4*)(pa + (size_t)t * 512 + 8 * L), v);
#pragma unroll
              for (int j = 0; j < 8; ++j) ss += v[j] * v[j]; }
          const float sq = wave_sum(L < 32 ? ss : 0.f), skv = wave_sum(L >= 32 ? ss : 0.f);
          if (L == 0) { rstd[2 * t] = rsqrtf(sq * (1.f / 256.f) + EPS); rstd[2 * t + 1] = rsqrtf(skv * (1.f / 128.f) + EPS); }
      } }
    { const int* pos = (const int*)c.in[I_POS]; float* CS = WSP(float, WS_CS);
      for (int e = gt; e < T * 16; e += NT) {
          const int t = e >> 4, jj = e & 15;
          const float invf = exp2f(-(float)jj * (13.287712379549449f / 16.f));
          const float ang = (float)pos[t] * invf; const float n = rintf(ang * 0.15915494309189535f);
          const float red = (float)((double)ang - (double)n * 6.283185307179586);
          CS[(size_t)t * 32 + jj] = __cosf(red); CS[(size_t)t * 32 + 16 + jj] = __sinf(red);
      } }
    {
        const int ch = (gt & 127) * 8;
        f32x4 wv[4][2]; f32x4 bv[2];
#pragma unroll
        for (int j = 0; j < 4; ++j) { wv[j][0] = *(const f32x4*)(cw + j * 1024 + ch); wv[j][1] = *(const f32x4*)(cw + j * 1024 + ch + 4); }
        bv[0] = *(const f32x4*)(cb + ch); bv[1] = *(const f32x4*)(cb + ch + 4);
        const int tstep = NT >> 7;
        for (int tq = gt >> 7; tq < T; tq += 4 * tstep) {
            u32x4 raw[4][4];
#pragma unroll
            for (int u = 0; u < 4; ++u) { const int t = tq + u * tstep; const int s = t & 2047;
#pragma unroll
                for (int j = 0; j < 4; ++j) { raw[u][j] = (u32x4){0u, 0u, 0u, 0u}; if (t < T && s - 3 + j >= 0) raw[u][j] = *(const u32x4*)(lx + (size_t)(t - 3 + j) * 1024 + ch); } }
#pragma unroll
            for (int u = 0; u < 4; ++u) { const int t = tq + u * tstep;
                float acc[8] = {bv[0].x, bv[0].y, bv[0].z, bv[0].w, bv[1].x, bv[1].y, bv[1].z, bv[1].w};
#pragma unroll
                for (int j = 0; j < 4; ++j) { float v[8]; unpack8(raw[u][j], v);
                    acc[0] += wv[j][0].x * v[0]; acc[1] += wv[j][0].y * v[1]; acc[2] += wv[j][0].z * v[2]; acc[3] += wv[j][0].w * v[3];
                    acc[4] += wv[j][1].x * v[4]; acc[5] += wv[j][1].y * v[5]; acc[6] += wv[j][1].z * v[6]; acc[7] += wv[j][1].w * v[7]; }
                if (t < T) *(u32x4*)(xc + (size_t)t * 1024 + ch) = pack8(acc); }
        }
    }
}

__device__ __forceinline__ void phase_scan(const Ctx& c0) {
    Ctx c = c0; c.lane = lane_id_v(); c.tid = c.wave * 64 + c.lane;
    const bf16_t* LA = WSP(bf16_t, WS_R0); bf16_t* Bv = WSP(bf16_t, WS_R6); const bf16_t* gate = WSP(bf16_t, WS_R3);
    LAS float* Ps = (LAS float*)c.lds; LAS float* Hs = Ps + 512;
    for (int it = c.vcu; it < 256; it += c.G) {
        const int b = it >> 4, cg = it & 15, seg = c.tid >> 6, ch = cg * 64 + (c.tid & 63);
        const size_t base = ((size_t)b * 2048 + seg * 256) * 1024 + ch;
        float P = 1.f, Hl = 0.f;
#pragma unroll 8
        for (int i = 0; i < 256; ++i) { const float a = __builtin_amdgcn_exp2f(bf2f(LA[base + (size_t)i * 1024])); const float bb = bf2f(Bv[base + (size_t)i * 1024]); Hl = a * Hl + bb; P *= a; }
        Ps[c.tid] = P; Hs[c.tid] = Hl;
        __syncthreads();
        float h = 0.f;
        for (int s2 = 0; s2 < seg; ++s2) h = Ps[s2 * 64 + (c.tid & 63)] * h + Hs[s2 * 64 + (c.tid & 63)];
#pragma unroll 8
        for (int i = 0; i < 256; ++i) { const float a = __builtin_amdgcn_exp2f(bf2f(LA[base + (size_t)i * 1024])); const float bb = bf2f(Bv[base + (size_t)i * 1024]); h = a * h + bb;
            const float gv = bf2f(gate[base + (size_t)i * 1024]); Bv[base + (size_t)i * 1024] = (bf16_t)f2bf(h * gelu_tanh(gv)); }
        __syncthreads();
    }
}

struct QkvRaw { u32x4 q[2], k[2], v[2]; f32x4 cs[4]; };
__device__ __forceinline__ void qkv_load(QkvRaw& r, const bf16_t* qraw, const bf16_t* kvraw, const bf16_t* pa, const float* CS, int t, int ch, int hq) {
    const bool act = ch < 12;
#pragma unroll
    for (int pass = 0; pass < 2; ++pass) { const int h = pass * 4 + hq;
        r.q[pass] = (u32x4){0u, 0u, 0u, 0u}; r.k[pass] = (u32x4){0u, 0u, 0u, 0u}; r.v[pass] = (u32x4){0u, 0u, 0u, 0u};
        if (act) r.q[pass] = *(const u32x4*)(qraw + (size_t)t * 768 + h * 96 + 8 * ch);
        if (ch < 8) { r.k[pass] = *(const u32x4*)(kvraw + (size_t)t * 1024 + h * 128 + 8 * ch); r.v[pass] = *(const u32x4*)(kvraw + (size_t)t * 1024 + h * 128 + 64 + 8 * ch); }
        else if (act) r.k[pass] = *(const u32x4*)(pa + (size_t)t * 512 + 384 + 8 * (ch - 8)); }
    const float* cp = CS + (size_t)t * 32 + 8 * (ch & 1);
    r.cs[0] = *(const f32x4*)cp; r.cs[1] = *(const f32x4*)(cp + 4); r.cs[2] = *(const f32x4*)(cp + 16); r.cs[3] = *(const f32x4*)(cp + 20);
}
__device__ __forceinline__ void phase_qkv_layout(const Ctx& c0) {
    Ctx c = c0; c.lane = lane_id_v(); c.tid = c.wave * 64 + c.lane;
    const bf16_t* qraw = WSP(bf16_t, WS_R5); const bf16_t* kvraw = WSP(bf16_t, WS_R2); const bf16_t* pa = WSP(bf16_t, WS_R1);
    bf16_t* Qh = WSP(bf16_t, WS_R4); bf16_t* Kh = WSP(bf16_t, WS_R3); bf16_t* Vh = WSP(bf16_t, WS_R0);
    const float* qng = c.in[I_QNG]; const float* kng = c.in[I_KNG]; const float* CS = WSP(float, WS_CS);
    const float qscale = 0.10206207261596577f * 1.4426950408889634f;
    const int gw = c.vcu * 8 + c.wave, NGW = c.G * 8, L = c.lane;
    const int ch = L & 15, hq = L >> 4;
    const bool act = ch < 12, isr = ch >= 8, hi2 = ch >= 10;
    float gq[8], gk[8];
#pragma unroll
    for (int j = 0; j < 8; ++j) { gq[j] = act ? qng[8 * ch + j] : 0.f; gk[j] = act ? kng[8 * ch + j] : 0.f; }
    if (gw >= T) return;
    QkvRaw cur, nxt;
    qkv_load(cur, qraw, kvraw, pa, CS, gw, ch, hq);
#pragma unroll 1
    for (int t = gw; t < T; t += NGW) {
        qkv_load(nxt, qraw, kvraw, pa, CS, (t + NGW < T) ? t + NGW : t, ch, hq);
        const int b = t >> 11, s = t & 2047;
        const float cs[8] = {cur.cs[0].x, cur.cs[0].y, cur.cs[0].z, cur.cs[0].w, cur.cs[1].x, cur.cs[1].y, cur.cs[1].z, cur.cs[1].w};
        const float sn[8] = {cur.cs[2].x, cur.cs[2].y, cur.cs[2].z, cur.cs[2].w, cur.cs[3].x, cur.cs[3].y, cur.cs[3].z, cur.cs[3].w};
#pragma unroll
        for (int pass = 0; pass < 2; ++pass) {
            const int h = pass * 4 + hq;
            const size_t orow = ((size_t)(b * H + h) * S + s);
#pragma unroll
            for (int qk = 0; qk < 2; ++qk) {
                float v[8]; unpack8(qk == 0 ? cur.q[pass] : cur.k[pass], v);
                float ss = 0.f;
#pragma unroll
                for (int j = 0; j < 8; ++j) ss += v[j] * v[j];
#pragma unroll
                for (int o = 1; o < 16; o <<= 1) ss += __shfl_xor(ss, o);
                const float r = rsqrtf(ss * (1.f / 96.f) + EPS) * (qk == 0 ? qscale : 1.f);
                float x[8], o8[8];
#pragma unroll
                for (int j = 0; j < 8; ++j) x[j] = v[j] * r * (qk == 0 ? gq[j] : gk[j]);
#pragma unroll
                for (int j = 0; j < 8; ++j) { const float px = __shfl_xor(x[j], 2);
                    o8[j] = !isr ? x[j] : (hi2 ? px * sn[j] + x[j] * cs[j] : x[j] * cs[j] - px * sn[j]); }
                if (act) *(u32x4*)((qk == 0 ? Qh : Kh) + orow * 96 + 8 * ch) = pack8(o8);
            }
            if (ch < 8) *(u32x4*)(Vh + orow * 64 + 8 * ch) = cur.v[pass];
        }
        cur = nxt;
    }
}

constexpr int KROW = 208, VROW = 160;
constexpr int KBUF = 128 * KROW, VBUF = 128 * VROW;
typedef short v4i16_t __attribute__((ext_vector_type(4)));
__device__ __forceinline__ void attn_chunk(LAS unsigned char* kb, LAS unsigned char* vb, const bf16x8 (&qf)[3], f32x4 (&o)[4], float& mrun, float& lrun, int fr, int g) {
    f32x4 sacc[4];
#pragma unroll
    for (int kt = 0; kt < 4; ++kt) { sacc[kt] = (f32x4){0.f, 0.f, 0.f, 0.f};
#pragma unroll
        for (int ks = 0; ks < 3; ++ks) { const bf16x8 kf = *(const LAS bf16x8*)(kb + (16 * kt + fr) * KROW + (ks * 32 + g * 8) * 2);
            sacc[kt] = __builtin_amdgcn_mfma_f32_16x16x32_bf16(kf, qf[ks], sacc[kt], 0, 0, 0); } }
    float mx = sacc[0][0];
#pragma unroll
    for (int kt = 0; kt < 4; ++kt)
#pragma unroll
        for (int r = 0; r < 4; ++r) mx = fmaxf(mx, sacc[kt][r]);
    mx = fmaxf(mx, __shfl_xor(mx, 16)); mx = fmaxf(mx, __shfl_xor(mx, 32));
    const float mnew = fmaxf(mrun, mx), alpha = __builtin_amdgcn_exp2f(mrun - mnew); mrun = mnew;
    float ps = 0.f;
#pragma unroll
    for (int kt = 0; kt < 4; ++kt)
#pragma unroll
        for (int r = 0; r < 4; ++r) { const float p = __builtin_amdgcn_exp2f(sacc[kt][r] - mnew); sacc[kt][r] = p; ps += p; }
    lrun = lrun * alpha + ps;
#pragma unroll
    for (int dt = 0; dt < 4; ++dt) o[dt] = o[dt] * alpha;
#pragma unroll
    for (int s2 = 0; s2 < 2; ++s2) {
        u32x4 pw; pw.x = pk2(sacc[2 * s2][0], sacc[2 * s2][1]); pw.y = pk2(sacc[2 * s2][2], sacc[2 * s2][3]); pw.z = pk2(sacc[2 * s2 + 1][0], sacc[2 * s2 + 1][1]); pw.w = pk2(sacc[2 * s2 + 1][2], sacc[2 * s2 + 1][3]);
        const bf16x8 pb = __builtin_bit_cast(bf16x8, pw);
#pragma unroll
        for (int dt = 0; dt < 4; ++dt) {
            LAS unsigned char* va = vb + (32 * s2 + 4 * g + (fr >> 2)) * VROW + (16 * dt + 4 * (fr & 3)) * 2;
            const v4i16_t t0 = __builtin_amdgcn_ds_read_tr16_b64_v4i16((LAS v4i16_t*)va), t1 = __builtin_amdgcn_ds_read_tr16_b64_v4i16((LAS v4i16_t*)(va + 16 * VROW));
            const bf16x8 vf = (bf16x8){t0[0], t0[1], t0[2], t0[3], t1[0], t1[1], t1[2], t1[3]};
            o[dt] = __builtin_amdgcn_mfma_f32_16x16x32_bf16(vf, pb, o[dt], 0, 0, 0); }
    }
}
__device__ __forceinline__ void attn_unit(const Ctx& c, int b, int h, int qb) {
    const bf16_t* Qh = WSP(bf16_t, WS_R4); const bf16_t* Kh = WSP(bf16_t, WS_R3); const bf16_t* Vh = WSP(bf16_t, WS_R0); bf16_t* AO = WSP(bf16_t, WS_R0 + 32 * MiB);
    const int fr = c.lane & 15, g = c.lane >> 4, wid = c.wave;
    const size_t hb = (size_t)(b * H + h) * S;
    const int q0 = qb * 128 + wid * 16;
    const int nsup = qb + 1;
    bf16x8 qf[3];
#pragma unroll
    for (int ks = 0; ks < 3; ++ks) qf[ks] = *(const bf16x8*)(Qh + (hb + q0 + fr) * 96 + ks * 32 + g * 8);
    f32x4 o[4];
#pragma unroll
    for (int dt = 0; dt < 4; ++dt) o[dt] = (f32x4){0.f, 0.f, 0.f, 0.f};
    float mrun = -1e30f, lrun = 0.f;
    u32x4 kr[3], vr[2];
    const u32x4* Ksrc = (const u32x4*)(Kh + hb * 96); const u32x4* Vsrc = (const u32x4*)(Vh + hb * 64);
#pragma unroll
    for (int i = 0; i < 3; ++i) kr[i] = Ksrc[c.tid + 512 * i];
#pragma unroll
    for (int i = 0; i < 2; ++i) vr[i] = Vsrc[c.tid + 512 * i];
    for (int j = 0; j < nsup; ++j) {
        LAS unsigned char* kb = c.lds + (j & 1) * (KBUF + VBUF); LAS unsigned char* vb = kb + KBUF;
#pragma unroll
        for (int i = 0; i < 3; ++i) { const int kc = c.tid + 512 * i; *(LAS u32x4*)(kb + (kc / 12) * KROW + (kc % 12) * 16) = kr[i]; }
#pragma unroll
        for (int i = 0; i < 2; ++i) { const int vc = c.tid + 512 * i; *(LAS u32x4*)(vb + (vc >> 3) * VROW + (vc & 7) * 16) = vr[i]; }
        __syncthreads();
        if (j + 1 < nsup) {
#pragma unroll
            for (int i = 0; i < 3; ++i) kr[i] = Ksrc[(j + 1) * 1536 + c.tid + 512 * i];
#pragma unroll
            for (int i = 0; i < 2; ++i) vr[i] = Vsrc[(j + 1) * 1024 + c.tid + 512 * i];
        }
        attn_chunk(kb, vb, qf, o, mrun, lrun, fr, g);
        if (j + 1 < nsup || wid >= 4) attn_chunk(kb + 64 * KROW, vb + 64 * VROW, qf, o, mrun, lrun, fr, g);
    }
    float lt = lrun + __shfl_xor(lrun, 16); lt += __shfl_xor(lt, 32);
    const float inv = 1.f / lt;
    bf16_t* orow = AO + ((size_t)b * S + q0 + fr) * 512 + h * 64;
#pragma unroll
    for (int dt = 0; dt < 4; ++dt) { u32x2 w; w.x = pk2(o[dt][0] * inv, o[dt][1] * inv); w.y = pk2(o[dt][2] * inv, o[dt][3] * inv); *(u32x2*)(orow + 16 * dt + 4 * g) = w; }
    __syncthreads();
}
__device__ __forceinline__ void phase_attn(const Ctx& c0) {
    Ctx c = c0; c.lane = lane_id_v(); c.tid = c.wave * 64 + c.lane;
    for (int v = c.vcu; v < 256; v += c.G) {
        const int bh = v >> 1, odd = v & 1;
        for (int i = 0; i < 8; ++i) {
            const int setA[8] = {15, 12, 10, 9, 6, 5, 3, 0}, setB[8] = {14, 13, 11, 8, 7, 4, 2, 1};
            int qb = 0;
#pragma unroll
            for (int k = 0; k < 8; ++k) if (k == i) qb = odd ? setB[k] : setA[k];
            attn_unit(c, bh >> 3, bh & 7, qb);
        }
    }
}

__device__ __forceinline__ float wave_max(float v) {
#pragma unroll
    for (int o = 1; o < 64; o <<= 1) v = fmaxf(v, __shfl_xor(v, o));
    return v;
}
__device__ __forceinline__ int wave_min_i(int v) {
#pragma unroll
    for (int o = 1; o < 64; o <<= 1) v = min(v, __shfl_xor(v, o));
    return v;
}
__device__ __forceinline__ int prefix_cnt(unsigned long long m) { return (int)__builtin_amdgcn_mbcnt_hi((unsigned)(m >> 32), __builtin_amdgcn_mbcnt_lo((unsigned)m, 0u)); }
template <int NV, int NBITS> __device__ __forceinline__ void select16(const unsigned (&key)[NV], int (&slot)[NV]) {
    unsigned tau = 0u;
    for (int bit = NBITS - 1; bit >= 0; --bit) {
        const unsigned trial = tau | (1u << bit); int cnt = 0;
#pragma unroll
        for (int j = 0; j < NV; ++j) cnt += __popcll(__ballot(key[j] >= trial));
        if (cnt >= 16) { tau = trial; if (cnt == 16) break; }
    }
    int base = 0;
#pragma unroll
    for (int j = 0; j < NV; ++j) { const unsigned long long m = __ballot(key[j] > tau); slot[j] = (key[j] > tau) ? base + prefix_cnt(m) : -1; base += __popcll(m); }
#pragma unroll
    for (int j = 0; j < NV; ++j) { const unsigned long long m = __ballot(key[j] == tau); if (key[j] == tau) { const int s = base + prefix_cnt(m); slot[j] = s < 16 ? s : -1; } base += __popcll(m); }
}
template <int N> __device__ __forceinline__ void bitonic_stage_desc(unsigned (&x)[N], int k, int j) {
#pragma unroll
    for (int i = 0; i < N; ++i) { const int l = i ^ j; if (l > i) { const bool asc = ((i & k) != 0);
        const unsigned a = x[i], b = x[l]; const unsigned hi = a > b ? a : b, lo = a > b ? b : a; x[i] = asc ? lo : hi; x[l] = asc ? hi : lo; } }
}
__device__ __forceinline__ void sort16_desc(unsigned (&x)[16]) {
#pragma unroll
    for (int k = 2; k <= 16; k <<= 1)
#pragma unroll
        for (int j = k >> 1; j > 0; j >>= 1) bitonic_stage_desc<16>(x, k, j);
}
__device__ __forceinline__ void merge16_desc(unsigned (&run)[16], const unsigned (&ch)[16]) {
#pragma unroll
    for (int i = 0; i < 16; ++i) run[i] = run[i] > ch[15 - i] ? run[i] : ch[15 - i];
#pragma unroll
    for (int j = 8; j > 0; j >>= 1) bitonic_stage_desc<16>(run, 16, j);
}
__device__ __forceinline__ unsigned mono_hi(unsigned w) { return w ^ ((unsigned)((int)w >> 31) | 0x80000000u); }
__device__ __forceinline__ float demono_hi(unsigned k) { const unsigned kk = k & 0xffff0000u; return __builtin_bit_cast(float, (kk ^ ((unsigned)(~(int)kk >> 31) | 0x80000000u)) & 0xffff0000u); }
__device__ __forceinline__ void top16_list(const bf16_t* s, unsigned (&run)[16]) {
#pragma unroll
    for (int ck = 0; ck < 8; ++ck) {
        const u32x4 w0 = *(const u32x4*)(s + ck * 16), w1 = *(const u32x4*)(s + ck * 16 + 8);
        const unsigned w[8] = {w0.x, w0.y, w0.z, w0.w, w1.x, w1.y, w1.z, w1.w};
        unsigned ch[16];
#pragma unroll
        for (int i = 0; i < 8; ++i) { ch[2 * i] = (mono_hi(w[i] << 16) & 0xffff0000u) | (unsigned)(ck * 16 + 2 * i); ch[2 * i + 1] = (mono_hi(w[i]) & 0xffff0000u) | (unsigned)(ck * 16 + 2 * i + 1); }
        sort16_desc(ch);
        if (ck == 0) {
#pragma unroll
            for (int i = 0; i < 16; ++i) run[i] = ch[i];
        } else merge16_desc(run, ch);
    }
}
__device__ __forceinline__ void phase_topk(const Ctx& c0) {
    Ctx c = c0; c.lane = lane_id_v(); c.tid = c.wave * 64 + c.lane;
    const bf16_t* sc = WSP(bf16_t, WS_SC); int* IDX = WSP(int, WS_IDX); float* GW = WSP(float, WS_GW);
    const int gl = (c.vcu * 8 + c.wave) * 64 + c.lane, NL = c.G * 512;
    for (int e = gl; e < T * H; e += NL) {
        unsigned ka[16], kb[16];
        top16_list(sc + (size_t)e * 256, ka);
        top16_list(sc + (size_t)e * 256 + 128, kb);
        float sa[16], sb[16]; unsigned ia[16], ib[16];
#pragma unroll
        for (int i = 0; i < 16; ++i) { sa[i] = demono_hi(ka[i]); sb[i] = demono_hi(kb[i]); ia[i] = (ka[i] & 0x7fu) << 7; ib[i] = kb[i] & 0x7fu; }
        const float mx = sa[0] + sb[0];
        unsigned run[16], ch[16]; int n = 0, nc = 0;
#pragma unroll
        for (int a = 0; a < 16; ++a)
#pragma unroll
            for (int b = 0; b < 16; ++b) if ((a + 1) * (b + 1) <= 16) {
                const int k = 65535 + (int)((sa[a] + sb[b] - mx) * 1024.f);
                ch[n] = ((unsigned)(k < 0 ? 0 : k) << 16) | ia[a] | ib[b];
                if (++n == 16) { sort16_desc(ch); if (nc == 0) {
#pragma unroll
                        for (int i = 0; i < 16; ++i) run[i] = ch[i]; } else merge16_desc(run, ch);
                    n = 0; ++nc; }
            }
#pragma unroll
        for (int i = 2; i < 16; ++i) ch[i] = 0u;
        sort16_desc(ch); merge16_desc(run, ch);
        float ex[16]; float sum = 0.f;
#pragma unroll
        for (int i = 0; i < 16; ++i) { ex[i] = __expf((float)((int)(run[i] >> 16) - 65535) * (1.f / 1024.f)); sum += ex[i]; }
        const float inv = 1.f / sum;
        u32x4* oi = (u32x4*)(IDX + (size_t)e * 16); f32x4* og = (f32x4*)(GW + (size_t)e * 16);
#pragma unroll
        for (int q = 0; q < 4; ++q) { u32x4 vi; vi.x = run[4 * q] & 0x3fffu; vi.y = run[4 * q + 1] & 0x3fffu; vi.z = run[4 * q + 2] & 0x3fffu; vi.w = run[4 * q + 3] & 0x3fffu; oi[q] = vi;
            f32x4 vg; vg.x = ex[4 * q] * inv; vg.y = ex[4 * q + 1] * inv; vg.z = ex[4 * q + 2] * inv; vg.w = ex[4 * q + 3] * inv; og[q] = vg; }
    }
}

__device__ __forceinline__ void dec32_fp4(const u32x4 r, f32x2 (&f)[16]) {
    const unsigned w[4] = {r.x, r.y, r.z, r.w};
#pragma unroll
    for (int i = 0; i < 4; ++i) { f[4 * i] = __builtin_amdgcn_cvt_scalef32_pk_f32_fp4(w[i], 1.0f, 0); f[4 * i + 1] = __builtin_amdgcn_cvt_scalef32_pk_f32_fp4(w[i], 1.0f, 1);
        f[4 * i + 2] = __builtin_amdgcn_cvt_scalef32_pk_f32_fp4(w[i], 1.0f, 2); f[4 * i + 3] = __builtin_amdgcn_cvt_scalef32_pk_f32_fp4(w[i], 1.0f, 3); }
}
__device__ __forceinline__ float dot32_fp4(const f32x2 (&hv)[16], const u32x4 r) {
    f32x2 f[16]; dec32_fp4(r, f); f32x2 s = hv[0] * f[0];
#pragma unroll
    for (int j = 1; j < 16; ++j) s = s + hv[j] * f[j];
    return s.x + s.y;
}
typedef int i32x8 __attribute__((ext_vector_type(8)));
__device__ __forceinline__ void phase_peer_u(const Ctx& c0) {
    Ctx c = c0; c.lane = lane_id_v(); c.tid = c.wave * 64 + c.lane;
    const int* IDX = WSP(int, WS_IDX);
    const int L = c.lane, pp = blockIdx.x & 3, hh = (blockIdx.x >> 2) & 1, rank = blockIdx.x >> 3, nrank = c.G >> 3;
    LAS int* mb = (LAS int*)(c.lds + c.wave * 1024);
    const int vr = L & 15, g4 = L >> 4;
    const unsigned char* EU4b = c.ws + WS_EU + (size_t)pp * NE * 128;
    const unsigned char* H8 = c.ws + WS_H2Q + pp * 256 + (vr & 1) * 128 + g4 * 16;
    float* PD = WSP(float, WS_PD) + (size_t)(2 * pp + (vr & 1)) * T * 128 + 2 * g4;
    const int t0 = 2 * (rank * 8 + c.wave) + hh, ts = 2 * nrank * 8;
    if (t0 >= T) return;
    int sc1 = 0x7f7f7f7f; asm volatile("" : "+v"(sc1));
    const bool swapb = WSP(unsigned, WS_C8SP)[1024] != 0u;
    { const int g0 = IDX[(size_t)t0 * 128 + L], g1 = IDX[(size_t)t0 * 128 + 64 + L]; mb[L] = g0; mb[64 + L] = g1; }
    u32x4 rA[16], rB[16];
    { const unsigned char* EU4 = EU4b + (vr & 1) * 64 + g4 * 16;
#pragma unroll
      for (int G = 0; G < 16; ++G) rA[G] = *(const u32x4*)(EU4 + (size_t)mb[8 * G + (vr >> 1)] * 128); }
    int cur = 0;
#define PEER_U_TOKEN(RC, RN, tcur, tnext, tnext2) do { \
        int lo = (vr & 1) * 64 + g4 * 16; asm volatile("" : "+v"(lo)); const unsigned char* EU4 = EU4b + lo; \
        const int gn0 = IDX[(size_t)(tnext2) * 128 + L], gn1 = IDX[(size_t)(tnext2) * 128 + 64 + L]; \
        i32x8 hb = (i32x8){0, 0, 0, 0, 0, 0, 0, 0}; \
        if (vr < 2) { const u32x4 h0 = *(const u32x4*)(H8 + (size_t)(tcur) * 1024), h1 = *(const u32x4*)(H8 + (size_t)(tcur) * 1024 + 64); \
            unsigned hw[8] = {h0.x, h0.y, h0.z, h0.w, h1.x, h1.y, h1.z, h1.w}; \
            if (swapb) { _Pragma("unroll") for (int q = 0; q < 8; ++q) hw[q] = ((hw[q] & 0x00ff00ffu) << 8) | ((hw[q] >> 8) & 0x00ff00ffu); } \
            hb = (i32x8){(int)hw[0], (int)hw[1], (int)hw[2], (int)hw[3], (int)hw[4], (int)hw[5], (int)hw[6], (int)hw[7]}; } \
          \
        _Pragma("unroll") for (int G = 0; G < 16; ++G) RN[G] = *(const u32x4*)(EU4 + (size_t)mb[(cur ^ 1) * 128 + 8 * G + (vr >> 1)] * 128); \
          \
        mb[cur * 128 + L] = gn0; mb[cur * 128 + 64 + L] = gn1; \
        f32x4 acc[16]; \
        _Pragma("unroll") for (int G = 0; G < 16; ++G) { const i32x8 a = (i32x8){(int)RC[G].x, (int)RC[G].y, (int)RC[G].z, (int)RC[G].w, 0, 0, 0, 0}; \
            acc[G] = __builtin_amdgcn_mfma_scale_f32_16x16x128_f8f6f4(a, hb, (f32x4){0.f, 0.f, 0.f, 0.f}, 4, 0, 0, sc1, 0, sc1); } \
        if (vr < 2) { _Pragma("unroll") for (int G = 0; G < 16; ++G) { f32x2 o; o.x = vr ? acc[G][1] : acc[G][0]; o.y = vr ? acc[G][3] : acc[G][2]; *(f32x2*)(PD + (size_t)(tcur) * 128 + 8 * G) = o; } } \
        cur ^= 1; } while (0)
    { const int t1 = (t0 + ts < T) ? t0 + ts : t0; const int g0 = IDX[(size_t)t1 * 128 + L], g1 = IDX[(size_t)t1 * 128 + 64 + L]; mb[128 + L] = g0; mb[128 + 64 + L] = g1; }
#pragma unroll 1
    for (int t = t0; t < T; t += 2 * ts) {
        const int ta = t, tb = (t + ts < T) ? t + ts : t, tc = (t + 2 * ts < T) ? t + 2 * ts : tb, td = (t + 3 * ts < T) ? t + 3 * ts : tc;
        PEER_U_TOKEN(rA, rB, ta, tb, tc);
        if (t + ts < T) PEER_U_TOKEN(rB, rA, tb, tc, td);
    }
#undef PEER_U_TOKEN
}
__device__ __forceinline__ void phase_peer_fin(const Ctx& c0) {
    Ctx c = c0; c.lane = lane_id_v(); c.tid = c.wave * 64 + c.lane;
    const int* IDX = WSP(int, WS_IDX); const float* GW = WSP(float, WS_GW); const float* PD = WSP(float, WS_PD); unsigned* WGT = WSP(unsigned, WS_WGT);
    const float* SU = WSP(float, WS_SU); const float* SV = WSP(float, WS_SV); const float* SH = WSP(float, WS_SH);
#pragma unroll 4
    for (int i = c.vcu * 512 + c.tid; i < T * 128; i += c.G * 512) {
        float d = 0.f;
#pragma unroll
        for (int p = 0; p < 8; ++p) d += PD[(size_t)p * T * 128 + i];
        const int e = IDX[i];
        WGT[i] = (f2bf(GW[i] * gelu_tanh(d * SU[e] * SH[i >> 7]) * SV[e]) << 16) | (unsigned)e;
    }
}
template <bool DRY> __device__ __forceinline__ void phase_peer_v(const Ctx& c0) {
    Ctx c = c0; c.lane = lane_id_v(); c.tid = c.wave * 64 + c.lane;
    const unsigned* WI = WSP(unsigned, WS_WGT); const float* mod = WSP(float, WS_MOD);
    const int L = c.lane, pp = blockIdx.x & 3, hh = (blockIdx.x >> 2) & 1, rank = blockIdx.x >> 3, nrank = c.G >> 3;
    const bool b5 = L & 32, b4 = L & 16, b3 = L & 8;
    LAS unsigned* mb = (LAS unsigned*)(c.lds + c.wave * 1024);
    const int kl = L >> 3;
    const unsigned char* EV4 = c.ws + WS_EV + (size_t)pp * NE * 128 + (L & 7) * 16;
    const int col = pp * 256 + (L & 7) * 32 + (b5 ? 16 : 0) + (b4 ? 8 : 0) + (b3 ? 4 : 0);
    const int t0 = 2 * (rank * 8 + c.wave) + hh, ts = 2 * nrank * 8;
    if (t0 >= T) return;
    { const unsigned g0 = WI[(size_t)t0 * 128 + L], g1 = WI[(size_t)t0 * 128 + 64 + L]; mb[L] = g0; mb[64 + L] = g1; }
    u32x4 rA[8], rB[8];
#pragma unroll
    for (int i = 0; i < 8; ++i) rA[i] = *(const u32x4*)(EV4 + (size_t)(mb[8 * i + kl] & 0xffffu) * 128);
    int cur = 0;
#pragma unroll 1
    for (int t = t0; t < T; t += ts) {
        const int tn = (t + ts < T) ? t + ts : t;
        const unsigned gn0 = WI[(size_t)tn * 128 + L], gn1 = WI[(size_t)tn * 128 + 64 + L];
        float* o = c.out + (size_t)t * 1024 + col; const float* g2 = mod + (t >> 11) * 6144 + 5120 + col;
        f32x4 xo = *(const f32x4*)o; const f32x4 gt = *(const f32x4*)g2;
#pragma unroll
        for (int i = 0; i < 8; ++i) rB[i] = *(const u32x4*)(EV4 + (size_t)(mb[cur * 128 + 64 + 8 * i + kl] & 0xffffu) * 128);
        f32x2 ac2[16];
#pragma unroll
        for (int j = 0; j < 16; ++j) ac2[j] = (f32x2){0.f, 0.f};
#pragma unroll
        for (int i = 0; i < 8; ++i) { const float w = bfhi(mb[cur * 128 + 8 * i + kl]); const f32x2 w2 = {w, w}; f32x2 f[16]; dec32_fp4(rA[i], f);
#pragma unroll
            for (int j = 0; j < 16; ++j) ac2[j] = ac2[j] + f[j] * w2; }
        mb[(cur ^ 1) * 128 + L] = gn0; mb[(cur ^ 1) * 128 + 64 + L] = gn1;
#pragma unroll
        for (int i = 0; i < 8; ++i) rA[i] = *(const u32x4*)(EV4 + (size_t)(mb[(cur ^ 1) * 128 + 8 * i + kl] & 0xffffu) * 128);
#pragma unroll
        for (int i = 0; i < 8; ++i) { const float w = bfhi(mb[cur * 128 + 64 + 8 * i + kl]); const f32x2 w2 = {w, w}; f32x2 f[16]; dec32_fp4(rB[i], f);
#pragma unroll
            for (int j = 0; j < 16; ++j) ac2[j] = ac2[j] + f[j] * w2; }
        float acc[32];
#pragma unroll
        for (int j = 0; j < 16; ++j) { acc[2 * j] = ac2[j].x; acc[2 * j + 1] = ac2[j].y; }
        float n16[16], n8[8], n4[4];
#pragma unroll
        for (int i = 0; i < 16; ++i) { const float send = b5 ? acc[i] : acc[i + 16], keep = b5 ? acc[i + 16] : acc[i]; n16[i] = keep + __shfl_xor(send, 32); }
#pragma unroll
        for (int i = 0; i < 8; ++i) { const float send = b4 ? n16[i] : n16[i + 8], keep = b4 ? n16[i + 8] : n16[i]; n8[i] = keep + __shfl_xor(send, 16); }
#pragma unroll
        for (int i = 0; i < 4; ++i) { const float send = b3 ? n8[i] : n8[i + 4], keep = b3 ? n8[i + 4] : n8[i]; n4[i] = keep + __shfl_xor(send, 8); }
        xo.x += gt.x * n4[0]; xo.y += gt.y * n4[1]; xo.z += gt.z * n4[2]; xo.w += gt.w * n4[3];
        if (DRY) asm volatile("" :: "v"(xo.x), "v"(xo.y), "v"(xo.z), "v"(xo.w)); else *(f32x4*)o = xo;
        cur ^= 1;
    }
}

struct FInProj { bf16_t *pa, *lx, *lg, *mg;
    __device__ __forceinline__ void operator()(int row, int pn, int cc, const float (&v0)[8], const float (&v1)[8]) const {
        bf16_t* d;
        if (pn < 2) d = pa + (size_t)row * 512 + pn * 256 + cc; else if (pn < 6) d = lx + (size_t)row * 1024 + (pn - 2) * 256 + cc;
        else if (pn < 10) d = lg + (size_t)row * 1024 + (pn - 6) * 256 + cc; else d = mg + (size_t)row * 2048 + (pn - 10) * 256 + cc;
        *(u32x4*)d = pack8(v0); *(u32x4*)(d + 128) = pack8(v1); } };
struct FRowScale { bf16_t* dst; int ldc; const float* rstd; int which;
    __device__ __forceinline__ void operator()(int row, int pn, int cc, const float (&v0)[8], const float (&v1)[8]) const {
        const float r = rstd[2 * row + which]; float a[8], b[8];
#pragma unroll
        for (int j = 0; j < 8; ++j) { a[j] = v0[j] * r; b[j] = v1[j] * r; }
        *(u32x4*)(dst + (size_t)row * ldc + pn * 256 + cc) = pack8(a); *(u32x4*)(dst + (size_t)row * ldc + pn * 256 + 128 + cc) = pack8(b); } };
struct FGates { const bf16_t* xc; bf16_t *LA, *Bv; const float *brg, *big, *c8sp;
    __device__ __forceinline__ void operator()(int row, int pn, int cc, const float (&v0)[8], const float (&v1)[8]) const {
        const int ch = pn * 128 + cc; float x[8], la[8], bv[8]; unpack8(*(const u32x4*)(xc + (size_t)row * 1024 + ch), x);
#pragma unroll
        for (int j = 0; j < 8; ++j) {
            const float r = __builtin_amdgcn_rcpf(1.f + __expf(-(v0[j] + brg[ch + j]))), ig = __builtin_amdgcn_rcpf(1.f + __expf(-(v1[j] + big[ch + j])));
            const float loga = r * c8sp[ch + j];
            const float z = 2.f * loga;
            const float ser = -z * (1.f + z * (0.5f + z * (0.16666667f + z * (0.041666668f + z * (0.008333334f + z * 0.0013888889f)))));
            const float om = (z > -0.25f) ? ser : (1.f - __expf(z));
            la[j] = loga * 1.4426950408889634f;
            bv[j] = sqrtf(om) * (ig * x[j]);
        }
        *(u32x4*)(LA + (size_t)row * 1024 + ch) = pack8(la); *(u32x4*)(Bv + (size_t)row * 1024 + ch) = pack8(bv); } };
struct FY1 { const bf16_t* mg; bf16_t* y; int goff; bool accum;
    __device__ __forceinline__ void one(int row, int col, const float (&v)[8]) const {
        float gt[8], o[8]; unpack8(*(const u32x4*)(mg + (size_t)row * 2048 + goff + col), gt);
        if (accum) unpack8(*(const u32x4*)(y + (size_t)row * 1024 + col), o);
#pragma unroll
        for (int j = 0; j < 8; ++j) o[j] = (accum ? o[j] : 0.f) + sigmoidf_(gt[j]) * v[j];
        *(u32x4*)(y + (size_t)row * 1024 + col) = pack8(o); }
    __device__ __forceinline__ void operator()(int row, int pn, int cc, const float (&v0)[8], const float (&v1)[8]) const { one(row, pn * 256 + cc, v0); one(row, pn * 256 + 128 + cc, v1); } };
struct FX1 { const float* x; float* out; const float* mod;
    __device__ __forceinline__ void one(int row, int col, const float (&v)[8]) const {
        const float* g1 = mod + (row >> 11) * 6144 + 2048 + col; const float* xr = x + (size_t)row * 1024 + col; float* o = out + (size_t)row * 1024 + col;
        const f32x4 x0 = *(const f32x4*)xr, x1 = *(const f32x4*)(xr + 4), a0 = *(const f32x4*)g1, a1 = *(const f32x4*)(g1 + 4);
        f32x4 r0, r1; r0.x = x0.x + a0.x * v[0]; r0.y = x0.y + a0.y * v[1]; r0.z = x0.z + a0.z * v[2]; r0.w = x0.w + a0.w * v[3];
        r1.x = x1.x + a1.x * v[4]; r1.y = x1.y + a1.y * v[5]; r1.z = x1.z + a1.z * v[6]; r1.w = x1.w + a1.w * v[7];
        *(f32x4*)o = r0; *(f32x4*)(o + 4) = r1; }
    __device__ __forceinline__ void operator()(int row, int pn, int cc, const float (&v0)[8], const float (&v1)[8]) const { one(row, pn * 256 + cc, v0); one(row, pn * 256 + 128 + cc, v1); } };
struct FStore { bf16_t* dst; int ldc;
    __device__ __forceinline__ void operator()(int row, int pn, int cc, const float (&v0)[8], const float (&v1)[8]) const {
        *(u32x4*)(dst + (size_t)row * ldc + pn * 256 + cc) = pack8(v0); *(u32x4*)(dst + (size_t)row * ldc + pn * 256 + 128 + cc) = pack8(v1); } };

template <int M, int N, int K, int LDA, int ACS, class F> __device__ __forceinline__ void run_gemm(const Ctx& c, const bf16_t* A, const bf16_t* Bt, const F& f) {
    pg8::Gemm g{A, Bt}; pg8::StaticOrder<M, N> So; So.init(c.G, (int)blockIdx.x);
    pg8::EpiF<F> E{f};
    pg8::gemm_phase<K, LDA, ACS, pg8::EpiF<F>, pg8::StaticOrder<M, N>>((PG8_LAS unsigned char*)c.lds, g, So, E, c.wave * 64 + lane_id_v());
}

__global__ void __launch_bounds__(512, 2) mk_fwd(Args args) {
    extern __shared__ __attribute__((aligned(16))) unsigned char lds_raw[];
    Ctx c;
    c.lds = (LAS unsigned char*)lds_raw;
    c.wave = __builtin_amdgcn_readfirstlane(threadIdx.x >> 6); c.lane = lane_id_v(); c.tid = c.wave * 64 + c.lane;
    c.G = gridDim.x; { const int bx = blockIdx.x; c.vcu = (c.G % 8 == 0) ? (bx % 8) * (c.G / 8) + bx / 8 : bx; }
    c.in = args.in; c.out = args.out; c.ws = args.ws;
    volatile LAS unsigned* MISC = (volatile LAS unsigned*)(c.lds + MISC_OFF);
    if (c.tid < 32) MISC[c.tid] = 0u;
    __syncthreads();
    XcdBarrier bar; bar.bar = (unsigned*)(c.ws + WS_CTL) + 4096; bar.x = 0; bar.st = nullptr;
    if (args.ph_hi - args.ph_lo > 1) bar = xcd_barrier_post((unsigned*)(c.ws + WS_CTL) + 4096, MISC + 8);

    const int lo = args.ph_lo, hi = args.ph_hi;
#ifndef ONLYP
#define ONLYP -1
#endif
#define IN(k) (lo <= (k) && (k) < hi && (ONLYP < 0 || ONLYP == (k)))
#define SEAM(k) do { if ((k) + 1 < hi) xcd_barrier(bar, c.wave); } while (0)
#ifndef REPEAT_MASK
#define REPEAT_MASK 0
#endif
#define PHASE(k, ...) if (IN(k)) { c.lane = lane_id_v(); c.tid = c.wave * 64 + c.lane; { __VA_ARGS__ } if ((REPEAT_MASK >> (k)) & 1) { xcd_barrier(bar, c.wave); { __VA_ARGS__ } } SEAM(k); }
    PHASE(0, phase_prep(c);)
    PHASE(1, phase_modnorm<false>(c, c.in[I_X], c.in[I_N1G], 0, 1024, WSP(bf16_t, WS_R0));)
    PHASE(2, FInProj f{WSP(bf16_t, WS_R1), WSP(bf16_t, WS_R2), WSP(bf16_t, WS_R3), (bf16_t*)c.out};
             run_gemm<T, 4608, 1024, 1024, 0>(c, WSP(bf16_t, WS_R0), WSP(bf16_t, WS_WIN), f);)
    PHASE(3, phase_conv(c);)
    PHASE(4, { FRowScale fq{WSP(bf16_t, WS_R5), 768, WSP(float, WS_RSTD), 0};
               run_gemm<T, 768, 256, 512, 0>(c, WSP(bf16_t, WS_R1), WSP(bf16_t, WS_WUQ), fq); }
             { FGates fg{WSP(bf16_t, WS_R4), WSP(bf16_t, WS_R0), WSP(bf16_t, WS_R6), c.in[I_BRG], c.in[I_BIG], WSP(float, WS_C8SP)};
               run_gemm<T, 2048, 128, 1024, 128>(c, WSP(bf16_t, WS_R4), WSP(bf16_t, WS_WG), fg); })
    PHASE(5, { FRowScale fkv{WSP(bf16_t, WS_R2), 1024, WSP(float, WS_RSTD), 1};
               run_gemm<T, 1024, 128, 512, 0>(c, WSP(bf16_t, WS_R1) + 256, WSP(bf16_t, WS_WUKV), fkv); }
             phase_scan(c);)
    PHASE(6, phase_qkv_layout(c);)
    PHASE(7, phase_attn(c);)
    PHASE(8, { FY1 f1{(const bf16_t*)c.out, WSP(bf16_t, WS_R2), 0, false};
               run_gemm<T, 1024, 512, 512, 0>(c, WSP(bf16_t, WS_R0 + 32 * MiB), WSP(bf16_t, WS_WOA), f1); }
             { FY1 f2{(const bf16_t*)c.out, WSP(bf16_t, WS_R2), 1024, true};
               run_gemm<T, 1024, 1024, 1024, 0>(c, WSP(bf16_t, WS_R6), WSP(bf16_t, WS_WOL), f2); })
    PHASE(9, FX1 f{c.in[I_X], c.out, WSP(float, WS_MOD)};
             run_gemm<T, 1024, 1024, 1024, 0>(c, WSP(bf16_t, WS_R2), WSP(bf16_t, WS_WOUT), f);)
    PHASE(10, phase_modnorm<true>(c, c.out, c.in[I_N2G], 3072, 4096, WSP(bf16_t, WS_R0));)
    PHASE(11, FStore f{WSP(bf16_t, WS_QP), 2048};
              run_gemm<T, 2048, 1024, 1024, 0>(c, WSP(bf16_t, WS_R0), WSP(bf16_t, WS_WQ), f);)
    PHASE(12, FStore f{WSP(bf16_t, WS_SC), 2048};
              run_gemm<T, 2048, 256, 2048, 256>(c, WSP(bf16_t, WS_QP), WSP(bf16_t, WS_SK), f);)
    PHASE(13, phase_topk(c);)
    PHASE(14, phase_peer_u(c);)
    PHASE(15, phase_peer_fin(c);)
#ifdef PROBE_VDRY
    if (IN(16)) { c.lane = lane_id_v(); c.tid = c.wave * 64 + c.lane; phase_peer_v<true>(c); xcd_barrier(bar, c.wave); }
#endif
    PHASE(16, phase_peer_v<false>(c);)
#undef PHASE
#undef IN
#undef SEAM
}

extern "C" void kernel_launch(void* const* d_in, const int* in_sizes, int n_in, void* d_out, int out_size, void* d_ws, size_t ws_size, hipStream_t stream) {
    static int grid = 0;
    if (grid == 0) {
        if (n_in != 28 || out_size != T * D || ws_size < WS_END) { fprintf(stderr, "kernel_launch: unexpected shapes (n_in %d out %d ws %zu)\n", n_in, out_size, ws_size); grid = -1; return; }
        int dev = 0, cus = 0, per_cu = 0;
        if (hipGetDevice(&dev) != hipSuccess || hipDeviceGetAttribute(&cus, hipDeviceAttributeMultiprocessorCount, dev) != hipSuccess) { grid = -1; return; }
        if (hipFuncSetAttribute((const void*)mk_fwd, hipFuncAttributeMaxDynamicSharedMemorySize, LDS_BYTES) != hipSuccess) { fprintf(stderr, "kernel_launch: hipFuncSetAttribute failed\n"); grid = -1; return; }
        if (hipOccupancyMaxActiveBlocksPerMultiprocessor(&per_cu, (const void*)mk_fwd, 512, LDS_BYTES) != hipSuccess || per_cu < 1) { fprintf(stderr, "kernel_launch: occupancy query says %d blocks per CU\n", per_cu); grid = -1; (void)hipGetLastError(); return; }
        grid = cus - (cus % 8);
        if (grid < 8) { fprintf(stderr, "kernel_launch: needs at least 8 CUs\n"); grid = -1; return; }
    }
    if (grid < 0) return;
    (void)hipMemsetAsync((char*)d_ws + WS_CTL, 0, CTL_ZERO_BYTES, stream);
    Args a{};
    for (int i = 0; i < 28; ++i) a.in[i] = (const float*)d_in[i];
    a.out = (float*)d_out; a.ws = (unsigned char*)d_ws;
#if MK_N_LAUNCHES == 1
    a.ph_lo = 0; a.ph_hi = N_PHASES;
    hipLaunchKernelGGL(mk_fwd, dim3(grid), dim3(512), LDS_BYTES, stream, a);
#else
    for (int ph = 0; ph < N_PHASES; ++ph) { a.ph_lo = ph; a.ph_hi = ph + 1; hipLaunchKernelGGL(mk_fwd, dim3(grid), dim3(512), LDS_BYTES, stream, a); }
#endif
}
```

```cpp
#include <hip/hip_runtime.h>
#include <cstdio>
#include <cstdint>

#define LAS __attribute__((address_space(3)))
#define GAS __attribute__((address_space(1)))
typedef unsigned short bf16_t;
typedef short bf16x8 __attribute__((ext_vector_type(8)));
typedef float f32x4 __attribute__((ext_vector_type(4)));
typedef float f32x2 __attribute__((ext_vector_type(2)));
typedef unsigned u32x4 __attribute__((ext_vector_type(4)));
typedef unsigned u32x2 __attribute__((ext_vector_type(2)));

#ifndef MK_N_LAUNCHES
#define MK_N_LAUNCHES 1
#endif

constexpr int T = 32768, D = 1024, NB_ = 16, S = 2048, H = 8;
constexpr int QKH = 96, VH = 64;
constexpr int NE = 16384;
constexpr float EPS = 1e-6f;

constexpr size_t MiB = 1u << 20;
constexpr size_t WS_CTL = 0, CTL_ZERO_BYTES = 65536;
constexpr size_t WS_MOD = 1 * MiB;
constexpr size_t WS_RSTD = 1 * MiB + 512 * 1024;
constexpr size_t WS_C8SP = 1 * MiB + 448 * 1024;
constexpr size_t WS_WIN = 2 * MiB;
constexpr size_t WS_WUQ = 11 * MiB;
constexpr size_t WS_WUKV = 11 * MiB + 512 * 1024;
constexpr size_t WS_WOA = 12 * MiB;
constexpr size_t WS_WOL = 13 * MiB;
constexpr size_t WS_WOUT = 15 * MiB;
constexpr size_t WS_WQ = 17 * MiB;
constexpr size_t WS_WG = 21 * MiB;
constexpr size_t WS_SK = 22 * MiB;
constexpr size_t WS_EU = 24 * MiB;
constexpr size_t WS_EV = 40 * MiB;
constexpr size_t WS_SU = 1 * MiB + 768 * 1024;
constexpr size_t WS_SV = 1 * MiB + 832 * 1024;
constexpr size_t WS_WGT = 440 * MiB;
constexpr size_t WS_CS = 56 * MiB;
constexpr size_t WS_H2Q = 456 * MiB;
constexpr size_t WS_SH = 1 * MiB + 896 * 1024;
constexpr size_t WS_PD = 280 * MiB;
constexpr size_t WS_R0 = 88 * MiB;
constexpr size_t WS_R1 = 152 * MiB;
constexpr size_t WS_R2 = 184 * MiB;
constexpr size_t WS_R3 = 248 * MiB;
constexpr size_t WS_R4 = 312 * MiB;
constexpr size_t WS_R5 = 376 * MiB;
constexpr size_t WS_R6 = 424 * MiB;
constexpr size_t WS_QP = 152 * MiB;
constexpr size_t WS_SC = 280 * MiB;
constexpr size_t WS_IDX = 408 * MiB;
constexpr size_t WS_GW = 424 * MiB;
constexpr size_t WS_END = 488 * MiB;

constexpr int LDS_BYTES = 147456;
constexpr int MISC_OFF = 131072 + 320;

__device__ __forceinline__ unsigned f2bf(float f) { unsigned u = __builtin_bit_cast(unsigned, f); return (u + 0x7fffu + ((u >> 16) & 1u)) >> 16; }
typedef __bf16 bf16x2_t __attribute__((ext_vector_type(2)));
__device__ __forceinline__ unsigned pk2(float lo, float hi) { f32x2 v = {lo, hi}; return __builtin_bit_cast(unsigned, __builtin_convertvector(v, bf16x2_t)); }
__device__ __forceinline__ float bf2f(unsigned h) { return __builtin_bit_cast(float, h << 16); }
__device__ __forceinline__ float bflo(unsigned w) { return __builtin_bit_cast(float, w << 16); }
__device__ __forceinline__ float bfhi(unsigned w) { return __builtin_bit_cast(float, w & 0xffff0000u); }
__device__ __forceinline__ float sigmoidf_(float x) { return 1.f / (1.f + __expf(-x)); }
__device__ __forceinline__ float gelu_tanh(float x) {
    const float u = 0.7978845608028654f * (x + 0.044715f * x * x * x);
    const float e = __expf(2.f * u);
    const float th = 1.f - 2.f / (e + 1.f);
    return 0.5f * x * (1.f + th);
}
__device__ __forceinline__ int lane_id_v() { int l; asm volatile("v_mbcnt_lo_u32_b32 %0, -1, 0\n\tv_mbcnt_hi_u32_b32 %0, -1, %0" : "=v"(l)); return l; }
__device__ __forceinline__ float wave_sum(float v) {
#pragma unroll
    for (int o = 1; o < 64; o <<= 1) v += __shfl_xor(v, o);
    return v;
}
__device__ __forceinline__ void unpack8(const u32x4 w, float (&v)[8]) {
    v[0] = bflo(w.x); v[1] = bfhi(w.x); v[2] = bflo(w.y); v[3] = bfhi(w.y); v[4] = bflo(w.z); v[5] = bfhi(w.z); v[6] = bflo(w.w); v[7] = bfhi(w.w);
}
__device__ __forceinline__ u32x4 pack8(const float (&v)[8]) {
    u32x4 w; w.x = pk2(v[0], v[1]); w.y = pk2(v[2], v[3]); w.z = pk2(v[4], v[5]); w.w = pk2(v[6], v[7]); return w;
}

namespace pg8 {
#define PG8_LAS __attribute__((address_space(3)))
constexpr int BM = 256, BK = 64, HALF = 128, HTB = HALF * BK * 2, STAGE_BYTES = 8 * HTB, NXCD = 8, WGM = 8;
__host__ __device__ __forceinline__ int lds_byte(int r, int c) { const int st = (r >> 4) * 2 + (c >> 5), rr = r & 15, cc = c & 31, ob = rr * 64 + cc * 2; return st * 1024 + (ob ^ (((ob >> 9) & 1) << 5)); }
__host__ __device__ __forceinline__ void stage_rc(int b, int& R, int& C) { const int st = b / 1024, sb = b % 1024, swz = sb ^ (((sb >> 9) & 1) << 5); R = (st >> 1) * 16 + swz / 64; C = (st & 1) * 32 + (swz % 64) / 2; }
__host__ __device__ __forceinline__ int perm32(int rho) { const int n = rho >> 4, i = rho & 15; return 8 * (i >> 2) + 4 * n + (i & 3); }

struct Unit { int pm, pn; };
struct Gemm { const bf16_t* A; const bf16_t* Bt; };

template <int M_, int N_> struct StaticOrder {
    static constexpr int nM = M_ / BM, nN = N_ / BM, nwg = nM * nN;
    int G, c;
    __host__ __device__ void init(int G_, int c_) { G = G_; c = c_; }
    __host__ __device__ bool next(int i, Unit& u) const {
        const long L = (long)i * G + c; if (L >= nwg) return false;
        int wgid = (int)L; { const int q = nwg / NXCD, r = nwg % NXCD, xcd = wgid % NXCD, off = wgid / NXCD; wgid = (xcd < r ? xcd * (q + 1) : r * (q + 1) + (xcd - r) * q) + off; }
        const int nig = WGM * nN, gid = wgid / nig, fm = gid * WGM, gsz = (nM - fm) < WGM ? (nM - fm) : WGM;
        u.pm = fm + ((wgid % nig) % gsz); u.pn = (wgid % nig) / gsz; return true;
    }
};

template <class F> struct EpiF {
    static constexpr bool PERM = true;
    F f;
    __device__ __forceinline__ void operator()(const f32x4 (&acc)[2][2][4][2], const Unit& u, int wr, int wc, int fr, int fq) const {
        const int c = wc * 32 + 8 * fq;
#pragma unroll
        for (int ai = 0; ai < 2; ++ai)
#pragma unroll
            for (int m = 0; m < 4; ++m) {
                const int row = u.pm * BM + ai * HALF + wr * 64 + m * 16 + fr;
                float v0[8], v1[8];
#pragma unroll
                for (int j = 0; j < 4; ++j) { v0[j] = acc[ai][0][m][0][j]; v0[4 + j] = acc[ai][0][m][1][j]; v1[j] = acc[ai][1][m][0][j]; v1[4 + j] = acc[ai][1][m][1][j]; }
                f(row, u.pn, c, v0, v1);
            }
    }
};

template <int K, int LDA, int ACS, class Epi, class Sched>
__device__ __forceinline__ void gemm_phase(PG8_LAS unsigned char* lds, const Gemm g, const Sched& S, const Epi& E, const int tid) {
    const int wid = __builtin_amdgcn_readfirstlane(tid >> 6), lane = tid & 63, wr = wid >> 2, wc = wid & 3, fr = lane & 15, fq = lane >> 4;
    constexpr int nt = K / BK;
    unsigned voffA[2], voffB[2];
#pragma unroll
    for (int i = 0; i < 2; ++i) { int R, C; stage_rc(tid * 16 + i * 8192, R, C); const int Rb = Epi::PERM ? ((R & ~31) + perm32(R & 31)) : R;
        voffA[i] = (unsigned)(R * LDA + C) * 2u; voffB[i] = (unsigned)(Rb * K + C) * 2u; }
    constexpr size_t kstep = (size_t)(BK * 2);
    constexpr size_t hstepA = (size_t)HALF * LDA * 2, hstepB = (size_t)HALF * K * 2;
    constexpr size_t tstepA = 2 * hstepA, tstepB = 2 * hstepB;
    constexpr size_t acsb = (size_t)ACS * 2;
    const unsigned ldsw = (unsigned)wid * 1024u;
    const int aoff = lds_byte(wr * 64 + fr, fq * 8), boff = lds_byte(wc * 32 + fr, fq * 8);
#define PG8_SA(b, h) (((b) * 2 + (h)) * HTB)
#define PG8_SB(b, h) ((4 + (b) * 2 + (h)) * HTB)
#define PG8_STAGE(bufoff, gbase, voff) do { _Pragma("unroll") for (int _i = 0; _i < 2; ++_i) \
        __builtin_amdgcn_global_load_lds((const unsigned*)((const char*)(gbase) + (voff)[_i]), (PG8_LAS unsigned*)(lds + (bufoff) + ldsw + _i * 8192), 16, 0, 0); } while (0)
#define PG8_LDA(dst, b, h) do { _Pragma("unroll") for (int m = 0; m < 4; ++m) _Pragma("unroll") for (int k = 0; k < 2; ++k) dst[m][k] = *(const PG8_LAS bf16x8*)(lds + PG8_SA(b, h) + aoff + m * 2048 + k * 1024); } while (0)
#define PG8_LDB(dst, b, h) do { _Pragma("unroll") for (int n = 0; n < 2; ++n) _Pragma("unroll") for (int k = 0; k < 2; ++k) dst[n][k] = *(const PG8_LAS bf16x8*)(lds + PG8_SB(b, h) + boff + n * 2048 + k * 1024); } while (0)
#define PG8_MMA(ai, bj, At, Bt) do { __builtin_amdgcn_s_setprio(1); _Pragma("unroll") for (int m = 0; m < 4; ++m) _Pragma("unroll") for (int n = 0; n < 2; ++n) _Pragma("unroll") for (int k = 0; k < 2; ++k) \
        acc[ai][bj][m][n] = __builtin_amdgcn_mfma_f32_16x16x32_bf16(Bt[n][k], At[m][k], acc[ai][bj][m][n], 0, 0, 0); __builtin_amdgcn_s_setprio(0); } while (0)
#define PG8_WAIT_V(n) asm volatile("s_waitcnt vmcnt(" #n ")" ::: "memory")
#define PG8_WAIT_L(n) asm volatile("s_waitcnt lgkmcnt(" #n ")" ::: "memory")
#define PG8_BAR __builtin_amdgcn_s_barrier()
#define PG8_SCHED __builtin_amdgcn_sched_barrier(0)
    Unit cur, nxt; int ui = 0;
    if (!S.next(0, cur)) return;
    f32x4 acc[2][2][4][2];
#pragma unroll
    for (int a = 0; a < 2; ++a)
#pragma unroll
        for (int b = 0; b < 2; ++b)
#pragma unroll
            for (int m = 0; m < 4; ++m)
#pragma unroll
                for (int n = 0; n < 2; ++n) acc[a][b][m][n] = (f32x4){0.f, 0.f, 0.f, 0.f};
    bf16x8 At[4][2], B0[2][2], B1[2][2];
    const char* cA = (const char*)g.A + (size_t)cur.pm * tstepA + (size_t)cur.pn * acsb; const char* cB = (const char*)g.Bt + (size_t)cur.pn * tstepB;
    PG8_STAGE(PG8_SB(0, 0), cB, voffB); PG8_STAGE(PG8_SB(0, 1), cB + hstepB, voffB); PG8_STAGE(PG8_SA(0, 0), cA, voffA); PG8_STAGE(PG8_SA(0, 1), cA + hstepA, voffA);
    if (wr == 1) PG8_BAR;
    PG8_WAIT_V(2); PG8_BAR;
    PG8_STAGE(PG8_SB(1, 0), cB + kstep, voffB); PG8_STAGE(PG8_SA(1, 0), cA + kstep, voffA); PG8_STAGE(PG8_SB(1, 1), cB + hstepB + kstep, voffB);
    PG8_WAIT_V(6); PG8_BAR;
    for (;;) {
        const bool has_next = S.next(ui + 1, nxt);
        const char* nA = has_next ? (const char*)g.A + (size_t)nxt.pm * tstepA + (size_t)nxt.pn * acsb : cA; const char* nB = has_next ? (const char*)g.Bt + (size_t)nxt.pn * tstepB : cB;
#pragma unroll 1
        for (int t = 0; t < nt; t += 2) {
            const bool last = (t == nt - 2);
            const char* a1 = cA + (size_t)(t + 1) * kstep;
            const char* a2 = last ? nA : cA + (size_t)(t + 2) * kstep; const char* b2 = last ? nB : cB + (size_t)(t + 2) * kstep;
            const char* a3 = a2 + kstep; const char* b3 = b2 + kstep;
            PG8_LDB(B0, 0, 0); PG8_LDB(B1, 0, 1); PG8_SCHED; PG8_LDA(At, 0, 0); PG8_STAGE(PG8_SA(1, 1), a1 + hstepA, voffA);
            PG8_WAIT_V(8); PG8_WAIT_L(0); PG8_BAR; PG8_MMA(0, 0, At, B0); PG8_MMA(0, 1, At, B1); PG8_BAR; PG8_SCHED;
            PG8_LDA(At, 0, 1); PG8_STAGE(PG8_SB(0, 0), b2, voffB); PG8_STAGE(PG8_SB(0, 1), b2 + hstepB, voffB); PG8_STAGE(PG8_SA(0, 0), a2, voffA);
            PG8_WAIT_V(8); PG8_WAIT_L(0); PG8_BAR; PG8_MMA(1, 0, At, B0); PG8_MMA(1, 1, At, B1); PG8_BAR; PG8_SCHED;
            PG8_LDB(B0, 1, 0); PG8_LDB(B1, 1, 1); PG8_SCHED; PG8_LDA(At, 1, 0); PG8_STAGE(PG8_SA(0, 1), a2 + hstepA, voffA);
            PG8_WAIT_V(8); PG8_WAIT_L(0); PG8_BAR; PG8_MMA(0, 0, At, B0); PG8_MMA(0, 1, At, B1); PG8_BAR; PG8_SCHED;
            PG8_LDA(At, 1, 1); PG8_STAGE(PG8_SB(1, 0), b3, voffB); PG8_STAGE(PG8_SB(1, 1), b3 + hstepB, voffB); PG8_STAGE(PG8_SA(1, 0), a3, voffA);
            PG8_WAIT_V(8); PG8_WAIT_L(0); PG8_BAR; PG8_MMA(1, 0, At, B0); PG8_MMA(1, 1, At, B1); PG8_BAR; PG8_SCHED;
        }
        if (wr == 0) PG8_BAR;
        E(acc, cur, wr, wc, fr, fq);
        if (!has_next) break;
#pragma unroll
        for (int a = 0; a < 2; ++a)
#pragma unroll
            for (int b = 0; b < 2; ++b)
#pragma unroll
                for (int m = 0; m < 4; ++m)
#pragma unroll
                    for (int n = 0; n < 2; ++n) acc[a][b][m][n] = (f32x4){0.f, 0.f, 0.f, 0.f};
        cur = nxt; cA = nA; cB = nB; ++ui;
        if (wr == 1) PG8_BAR;
    }
    PG8_WAIT_V(0);
    PG8_BAR;
#undef PG8_SA
#undef PG8_SB
#undef PG8_STAGE
#undef PG8_LDA
#undef PG8_LDB
#undef PG8_MMA
#undef PG8_WAIT_V
#undef PG8_WAIT_L
#undef PG8_BAR
#undef PG8_SCHED
}
}

#define XB_TMO      128
#define XB_XCNT(j)  (256  + 64 * (j))
#define XB_XSUB(j)  (1280 + 64 * (j))
#define XB_XGEN(j)  (2304 + 64 * (j))
#define XB_TOP      3328
#define XB_TOPGEN   3392
#define XCD_BAR_WORDS 3456
#define XB_SPIN_CAP (1u << 18)
__device__ __forceinline__ unsigned xb_ld(unsigned* p)              { return __hip_atomic_load(p, __ATOMIC_RELAXED, __HIP_MEMORY_SCOPE_AGENT); }
__device__ __forceinline__ unsigned xb_add(unsigned* p, unsigned v) { return __hip_atomic_fetch_add(p, v, __ATOMIC_RELAXED, __HIP_MEMORY_SCOPE_AGENT); }
__device__ __forceinline__ unsigned xb_xcc_id() { return (unsigned)__builtin_amdgcn_s_getreg((3 << 11) | 20) & 0xFu; }
#define XB_SPIN(cond, bar) do { unsigned _sp = 0; while (cond) { __builtin_amdgcn_s_sleep(1); \
    if ((++_sp & 255u) == 0u) { if (xb_ld(&(bar)[XB_TMO])) break; if (_sp > XB_SPIN_CAP) { atomicAdd(&(bar)[XB_TMO], 1u); break; } } } } while (0)
struct XcdBarrier { unsigned* bar; unsigned x; volatile LAS unsigned* st; };
__device__ __forceinline__ XcdBarrier xcd_barrier_post(unsigned* bar, volatile LAS unsigned* st) {
    XcdBarrier b; b.bar = bar; b.x = xb_xcc_id(); b.st = st;
    if (threadIdx.x == 0) (void)xb_add(&bar[XB_XCNT(b.x)], 1u);
    return b;
}
__device__ __forceinline__ void xcd_barrier_complete(unsigned* bar, unsigned x, unsigned& nloc, unsigned& nx) {
    const unsigned G = gridDim.x * gridDim.y * gridDim.z;
    unsigned sum, cnt, mine, sp = 0u;
    for (;;) {
        sum = 0u; cnt = 0u; mine = 0u;
#pragma unroll
        for (unsigned j = 0; j < 16; ++j) { const unsigned c = xb_ld(&bar[XB_XCNT(j)]); sum += c; cnt += (c > 0u) ? 1u : 0u; mine = (j == x) ? c : mine; }
        if (sum == G) break;
        __builtin_amdgcn_s_sleep(1);
        if ((++sp & 255u) == 0u) { if (xb_ld(&bar[XB_TMO])) break; if (sp > XB_SPIN_CAP) { atomicAdd(&bar[XB_TMO], 1u); break; } }
    }
    nloc = mine > 0u ? mine : 1u; nx = cnt > 0u ? cnt : 1u;
}
__device__ __forceinline__ void xcd_barrier(const XcdBarrier& b, int wave) {
    asm volatile("s_waitcnt vmcnt(0)" ::: "memory");
    __syncthreads();
    if (wave == 0 && lane_id_v() == 0) {
        unsigned* bar = b.bar;
        __builtin_amdgcn_s_waitcnt(0);
        unsigned nloc = b.st[0], nx = b.st[1];
        if (nloc == 0u) { xcd_barrier_complete(bar, b.x, nloc, nx); b.st[0] = nloc; b.st[1] = nx; }
        const unsigned old = xb_add(&bar[XB_XSUB(b.x)], 1u);
        const unsigned gen = old / nloc;
        if (old + 1u == (gen + 1u) * nloc) {
            __builtin_amdgcn_fence(__ATOMIC_RELEASE, "agent");
            asm volatile("s_waitcnt vmcnt(0)" ::: "memory");
            const unsigned og = xb_add(&bar[XB_TOP], 1u);
            const unsigned tg = og / nx;
            if (og + 1u == (tg + 1u) * nx) xb_add(&bar[XB_TOPGEN], 1u);
            else XB_SPIN(xb_ld(&bar[XB_TOPGEN]) == tg, bar);
            __builtin_amdgcn_fence(__ATOMIC_ACQUIRE, "agent");
            xb_add(&bar[XB_XGEN(b.x)], 1u);
            asm volatile("s_waitcnt vmcnt(0)" ::: "memory");
        } else {
            XB_SPIN(xb_ld(&bar[XB_XGEN(b.x)]) == gen, bar);
            __builtin_amdgcn_fence(__ATOMIC_ACQUIRE, "agent");
            asm volatile("s_waitcnt vmcnt(0)" ::: "memory");
        }
    }
    __syncthreads();
}

struct Args { const float* in[28]; float* out; unsigned char* ws; int ph_lo, ph_hi; };
enum { I_X = 0, I_C, I_POS, I_WADA, I_BADA, I_N1G, I_WIN, I_QAG, I_WUQ, I_KVAG, I_WUKV, I_QNG, I_KNG, I_WOA, I_CONVW, I_CONVB, I_WRG, I_BRG, I_WIG, I_BIG, I_LAM, I_WOL, I_WOUT, I_N2G, I_WQ, I_SUBK, I_EU, I_EV };
constexpr int N_PHASES = 17;

struct Ctx {
    LAS unsigned char* lds;
    int tid, lane, wave, vcu, G;
    const float* const* in; float* out; unsigned char* ws;
};
#define WSP(type, off) ((type*)(c.ws + (off)))

template <class F>
__device__ __forceinline__ void tr_tile(const Ctx& c, bf16_t* dst, int K, int n0, int k0, F f) {
    LAS float* scr = (LAS float*)c.lds;
#pragma unroll
    for (int i = 0; i < 8; ++i) { const int kk = i * 8 + (c.tid >> 6), nn = c.tid & 63; scr[kk * 65 + nn] = f(k0 + kk, n0 + nn); }
    __syncthreads();
    { const int kc = c.tid & 7, nn = c.tid >> 3;
      LAS const float* s = scr + (8 * kc) * 65 + nn;
      u32x4 o; o.x = pk2(s[0], s[65]); o.y = pk2(s[2 * 65], s[3 * 65]); o.z = pk2(s[4 * 65], s[5 * 65]); o.w = pk2(s[6 * 65], s[7 * 65]);
      *(u32x4*)(dst + (size_t)(n0 + nn) * K + k0 + 8 * kc) = o; }
    __syncthreads();
}

__device__ __forceinline__ void phase_prep(const Ctx& c0) {
    Ctx c = c0; c.lane = lane_id_v(); c.tid = c.wave * 64 + c.lane;
    const float* w_in = c.in[I_WIN]; const float* w_uq = c.in[I_WUQ]; const float* qag = c.in[I_QAG]; const float* w_ukv = c.in[I_WUKV]; const float* kvag = c.in[I_KVAG];
    const float* w_oa = c.in[I_WOA]; const float* w_ol = c.in[I_WOL]; const float* w_out = c.in[I_WOUT]; const float* w_q = c.in[I_WQ];
    const float* w_rg = c.in[I_WRG]; const float* w_ig = c.in[I_WIG];
    constexpr int T_WIN = 72 * 16, T_WUQ = 12 * 4, T_WUKV = 16 * 2, T_WOA = 16 * 8, T_WOL = 16 * 16, T_WOUT = 16 * 16, T_WQ = 32 * 16, T_WG = 8 * 4 * 2;
    constexpr int T_ALL = T_WIN + T_WUQ + T_WUKV + T_WOA + T_WOL + T_WOUT + T_WQ + T_WG;
    for (int it = c.vcu; it < T_ALL; it += c.G) {
        int r = it;
        if (r < T_WIN) { const int nb = r / 16, kb = r % 16;
            tr_tile(c, WSP(bf16_t, WS_WIN), 1024, nb * 64, kb * 64, [=](int k, int n) -> float { return n < 416 ? w_in[(size_t)k * 4512 + n] : (n < 512 ? 0.f : w_in[(size_t)k * 4512 + n - 96]); }); continue; }
        r -= T_WIN;
        if (r < T_WUQ) { const int nb = r / 4, kb = r % 4;
            tr_tile(c, WSP(bf16_t, WS_WUQ), 256, nb * 64, kb * 64, [=](int k, int n) -> float { return w_uq[(size_t)k * 768 + n] * qag[k]; }); continue; }
        r -= T_WUQ;
        if (r < T_WUKV) { const int nb = r / 2, kb = r % 2;
            tr_tile(c, WSP(bf16_t, WS_WUKV), 128, nb * 64, kb * 64, [=](int k, int n) -> float { return w_ukv[(size_t)k * 1024 + n] * kvag[k]; }); continue; }
        r -= T_WUKV;
        if (r < T_WOA) { const int nb = r / 8, kb = r % 8;
            tr_tile(c, WSP(bf16_t, WS_WOA), 512, nb * 64, kb * 64, [=](int k, int n) -> float { return w_oa[(size_t)k * 1024 + n]; }); continue; }
        r -= T_WOA;
        if (r < T_WOL) { const int nb = r / 16, kb = r % 16;
            tr_tile(c, WSP(bf16_t, WS_WOL), 1024, nb * 64, kb * 64, [=](int k, int n) -> float { return w_ol[(size_t)k * 1024 + n]; }); continue; }
        r -= T_WOL;
        if (r < T_WOUT) { const int nb = r / 16, kb = r % 16;
            tr_tile(c, WSP(bf16_t, WS_WOUT), 1024, nb * 64, kb * 64, [=](int k, int n) -> float { return w_out[(size_t)k * 1024 + n]; }); continue; }
        r -= T_WOUT;
        if (r < T_WQ) { const int nb = r / 16, kb = r % 16;
            tr_tile(c, WSP(bf16_t, WS_WQ), 1024, nb * 64, kb * 64, [=](int k, int n) -> float { return w_q[(size_t)k * 2048 + n]; }); continue; }
        r -= T_WQ;
        { const int blk = r / 8, q = r % 8, nb = q / 2, kb = q % 2;
            tr_tile(c, WSP(bf16_t, WS_WG) + (size_t)blk * 256 * 128, 128, nb * 64, kb * 64,
                    [=](int k, int n) -> float { return n < 128 ? w_rg[((size_t)blk * 128 + k) * 128 + n] : w_ig[((size_t)blk * 128 + k) * 128 + n - 128]; }); }
    }
    { const float* lam = c.in[I_LAM]; float* t8 = WSP(float, WS_C8SP);
      if (c.vcu == 0) for (int e = c.tid; e < 1024; e += 512) t8[e] = -8.f * log1pf(__expf(-lam[e])); }
    if (c.vcu == 0 && c.tid == 0) {
        const unsigned probe = __builtin_amdgcn_cvt_scalef32_pk_fp4_f32(0u, 1.0f, 0.0f, 1.0f, 0) & 0xffu;
        WSP(unsigned, WS_C8SP)[1024] = (probe == 0x02u) ? 0u : 1u; }
    { const f32x4* sk = (const f32x4*)c.in[I_SUBK]; u32x2* dst = WSP(u32x2, WS_SK);
      for (int e = c.vcu * 512 + c.tid; e < 16 * 128 * 128 / 4; e += c.G * 512) { const f32x4 v = sk[e]; u32x2 w; w.x = pk2(v.x, v.y); w.y = pk2(v.z, v.w); dst[e] = w; } }
    { const int gw = c.vcu * 8 + c.wave, NGW = c.G * 8, L = c.lane;
      for (int r = gw; r < 2 * NE; r += NGW) {
          const int isv = r >= NE, e = isv ? r - NE : r;
          const f32x4* src4 = (const f32x4*)((isv ? c.in[I_EV] : c.in[I_EU]) + (size_t)e * 1024 + 16 * L);
          f32x4 v[4]; float am = 0.f;
#pragma unroll
          for (int j = 0; j < 4; ++j) { v[j] = src4[j]; am = fmaxf(am, fmaxf(fmaxf(fabsf(v[j].x), fabsf(v[j].y)), fmaxf(fabsf(v[j].z), fabsf(v[j].w)))); }
#pragma unroll
          for (int o = 1; o < 64; o <<= 1) am = fmaxf(am, __shfl_xor(am, o));
          const float s = am > 0.f ? am * (1.f / 6.f) : 1.f, inv = 1.f / s;
          unsigned w0 = 0u, w1 = 0u;
          w0 = __builtin_amdgcn_cvt_scalef32_pk_fp4_f32(w0, v[0].x * inv, v[0].y * inv, 1.0f, 0); w0 = __builtin_amdgcn_cvt_scalef32_pk_fp4_f32(w0, v[0].z * inv, v[0].w * inv, 1.0f, 1);
          w0 = __builtin_amdgcn_cvt_scalef32_pk_fp4_f32(w0, v[1].x * inv, v[1].y * inv, 1.0f, 2); w0 = __builtin_amdgcn_cvt_scalef32_pk_fp4_f32(w0, v[1].z * inv, v[1].w * inv, 1.0f, 3);
          w1 = __builtin_amdgcn_cvt_scalef32_pk_fp4_f32(w1, v[2].x * inv, v[2].y * inv, 1.0f, 0); w1 = __builtin_amdgcn_cvt_scalef32_pk_fp4_f32(w1, v[2].z * inv, v[2].w * inv, 1.0f, 1);
          w1 = __builtin_amdgcn_cvt_scalef32_pk_fp4_f32(w1, v[3].x * inv, v[3].y * inv, 1.0f, 2); w1 = __builtin_amdgcn_cvt_scalef32_pk_fp4_f32(w1, v[3].z * inv, v[3].w * inv, 1.0f, 3);
          u32x2 q; q.x = w0; q.y = w1;
          *(u32x2*)(c.ws + (isv ? WS_EV : WS_EU) + ((size_t)(L >> 4) * NE + e) * 128 + (L & 15) * 8) = q;
          if (L == 0) WSP(float, isv ? WS_SV : WS_SU)[e] = s;
      } }
    { const float* cin = c.in[I_C]; const float* w_ada = c.in[I_WADA]; const float* b_ada = c.in[I_BADA]; float* mod = WSP(float, WS_MOD);
      LAS float* cs = (LAS float*)c.lds;
      LAS float* red = (LAS float*)(c.lds + 65536);
      bool have = false;
      for (int it = c.vcu; it < 192; it += c.G) {
          if (!have) { for (int e = c.tid; e < 16 * 1024; e += 512) { const float v = cin[e]; cs[e] = v / (1.f + __expf(-v)); } have = true; }
          __syncthreads();
          const int cl = c.tid & 31, ks = c.tid >> 5, j = it * 32 + cl;
          float acc[16];
#pragma unroll
          for (int b = 0; b < 16; ++b) acc[b] = 0.f;
          for (int kk = 0; kk < 64; ++kk) { const int k = ks * 64 + kk; const float w = w_ada[(size_t)k * 6144 + j];
#pragma unroll
              for (int b = 0; b < 16; ++b) acc[b] += cs[b * 1024 + k] * w; }
#pragma unroll
          for (int b = 0; b < 16; ++b) red[(ks * 16 + b) * 32 + cl] = acc[b];
          __syncthreads();
          { const int b = c.tid >> 5; float s = b_ada[j];
#pragma unroll
            for (int k2 = 0; k2 < 16; ++k2) s += red[(k2 * 16 + b) * 32 + cl];
            mod[b * 6144 + j] = s; }
          __syncthreads();
      } }
}

template <bool Q8>
__device__ __forceinline__ void phase_modnorm(const Ctx& c0, const float* x, const float* g, int shift_off, int scale_off, bf16_t* dst) {
    Ctx c = c0; c.lane = lane_id_v(); c.tid = c.wave * 64 + c.lane;
    const float* mod = WSP(float, WS_MOD);
    const int gw = c.vcu * 8 + c.wave, NGW = c.G * 8;
    for (int m = gw; m < T; m += NGW) {
        const int b = m >> 11;
        const f32x4* xr = (const f32x4*)(x + (size_t)m * D) + c.lane;
        f32x4 v[4]; float s = 0.f;
#pragma unroll
        for (int j = 0; j < 4; ++j) { v[j] = xr[64 * j]; s += (v[j].x * v[j].x + v[j].y * v[j].y) + (v[j].z * v[j].z + v[j].w * v[j].w); }
        const float rstd = rsqrtf(wave_sum(s) * (1.f / D) + EPS);
        u32x2* o8 = (u32x2*)(dst + (size_t)m * D) + c.lane;
        float am = 0.f;
#pragma unroll
        for (int j = 0; j < 4; ++j) {
            const int col = 4 * c.lane + 256 * j;
            const f32x4 gg = *(const f32x4*)(g + col), sc = *(const f32x4*)(mod + b * 6144 + scale_off + col), sh = *(const f32x4*)(mod + b * 6144 + shift_off + col);
            const float r0 = v[j].x * rstd * gg.x * (1.f + sc.x) + sh.x, r1 = v[j].y * rstd * gg.y * (1.f + sc.y) + sh.y;
            const float r2 = v[j].z * rstd * gg.z * (1.f + sc.z) + sh.z, r3 = v[j].w * rstd * gg.w * (1.f + sc.w) + sh.w;
            u32x2 w; w.x = pk2(r0, r1); w.y = pk2(r2, r3); o8[64 * j] = w;
            if (Q8) { v[j].x = r0; v[j].y = r1; v[j].z = r2; v[j].w = r3; am = fmaxf(am, fmaxf(fmaxf(fabsf(r0), fabsf(r1)), fmaxf(fabsf(r2), fabsf(r3)))); }
        }
        if (Q8) {
#pragma unroll
            for (int o = 1; o < 64; o <<= 1) am = fmaxf(am, __shfl_xor(am, o));
            const float sq = am > 0.f ? am * (1.f / 256.f) : 1.f, inv = 1.f / sq;
            unsigned* q8 = (unsigned*)(c.ws + WS_H2Q + (size_t)m * D) + c.lane;
#pragma unroll
            for (int j = 0; j < 4; ++j) { int w = __builtin_amdgcn_cvt_pk_fp8_f32(v[j].x * inv, v[j].y * inv, 0, false); w = __builtin_amdgcn_cvt_pk_fp8_f32(v[j].z * inv, v[j].w * inv, w, true); q8[64 * j] = (unsigned)w; }
            if (c.lane == 0) WSP(float, WS_SH)[m] = sq;
        }
    }
}

__device__ __forceinline__ void phase_conv(const Ctx& c0) {
    Ctx c = c0; c.lane = lane_id_v(); c.tid = c.wave * 64 + c.lane;
    const bf16_t* pa = WSP(bf16_t, WS_R1); const bf16_t* lx = WSP(bf16_t, WS_R2); bf16_t* xc = WSP(bf16_t, WS_R4); float* rstd = WSP(float, WS_RSTD);
    const float* cw = c.in[I_CONVW]; const float* cb = c.in[I_CONVB];
    const int gt = c.vcu * 512 + c.tid, NT = c.G * 512;
    { const int gw = c.vcu * 8 + c.wave, NGW = c.G * 8, L = c.lane;
      for (int t = gw; t < T; t += NGW) {
          float ss = 0.f;
          if (L < 48) { float v[8]; unpack8(*(const u32x4*)(pa + (size_t)t * 512 + 8 * L), v);
#pragma unroll
              for (int j = 0; j < 8; ++j) ss += v[j] * v[j]; }
          const float sq = wave_sum(L < 32 ? ss : 0.f), skv = wave_sum(L >= 32 ? ss : 0.f);
          if (L == 0) { rstd[2 * t] = rsqrtf(sq * (1.f / 256.f) + EPS); rstd[2 * t + 1] = rsqrtf(skv * (1.f / 128.f) + EPS); }
      } }
    { const int* pos = (const int*)c.in[I_POS]; float* CS = WSP(float, WS_CS);
      for (int e = gt; e < T * 16; e += NT) {
          const int t = e >> 4, jj = e & 15;
          const float invf = exp2f(-(float)jj * (13.287712379549449f / 16.f));
          const float ang = (float)pos[t] * invf; const float n = rintf(ang * 0.15915494309189535f);
          const float red = (float)((double)ang - (double)n * 6.283185307179586);
          CS[(size_t)t * 32 + jj] = __cosf(red); CS[(size_t)t * 32 + 16 + jj] = __sinf(red);
      } }
    {
        const int ch = (gt & 127) * 8;
        f32x4 wv[4][2]; f32x4 bv[2];
#pragma unroll
        for (int j = 0; j < 4; ++j) { wv[j][0] = *(const f32x4*)(cw + j * 1024 + ch); wv[j][1] = *(const f32x4*)(cw + j * 1024 + ch + 4); }
        bv[0] = *(const f32x4*)(cb + ch); bv[1] = *(const f32x4*)(cb + ch + 4);
        const int tstep = NT >> 7;
        for (int tq = gt >> 7; tq < T; tq += 4 * tstep) {
            u32x4 raw[4][4];
#pragma unroll
            for (int u = 0; u < 4; ++u) { const int t = tq + u * tstep; const int s = t & 2047;
#pragma unroll
                for (int j = 0; j < 4; ++j) { raw[u][j] = (u32x4){0u, 0u, 0u, 0u}; if (t < T && s - 3 + j >= 0) raw[u][j] = *(const u32x4*)(lx + (size_t)(t - 3 + j) * 1024 + ch); } }
#pragma unroll
            for (int u = 0; u < 4; ++u) { const int t = tq + u * tstep;
                float acc[8] = {bv[0].x, bv[0].y, bv[0].z, bv[0].w, bv[1].x, bv[1].y, bv[1].z, bv[1].w};
#pragma unroll
                for (int j = 0; j < 4; ++j) { float v[8]; unpack8(raw[u][j], v);
                    acc[0] += wv[j][0].x * v[0]; acc[1] += wv[j][0].y * v[1]; acc[2] += wv[j][0].z * v[2]; acc[3] += wv[j][0].w * v[3];
                    acc[4] += wv[j][1].x * v[4]; acc[5] += wv[j][1].y * v[5]; acc[6] += wv[j][1].z * v[6]; acc[7] += wv[j][1].w * v[7]; }
                if (t < T) *(u32x4*)(xc + (size_t)t * 1024 + ch) = pack8(acc); }
        }
    }
}

__device__ __forceinline__ void phase_scan(const Ctx& c0) {
    Ctx c = c0; c.lane = lane_id_v(); c.tid = c.wave * 64 + c.lane;
    const bf16_t* LA = WSP(bf16_t, WS_R0); bf16_t* Bv = WSP(bf16_t, WS_R6); const bf16_t* gate = WSP(bf16_t, WS_R3);
    LAS float* Ps = (LAS float*)c.lds; LAS float* Hs = Ps + 512;
    for (int it = c.vcu; it < 256; it += c.G) {
        const int b = it >> 4, cg = it & 15, seg = c.tid >> 6, ch = cg * 64 + (c.tid & 63);
        const size_t base = ((size_t)b * 2048 + seg * 256) * 1024 + ch;
        float P = 1.f, Hl = 0.f;
#pragma unroll 8
        for (int i = 0; i < 256; ++i) { const float a = __builtin_amdgcn_exp2f(bf2f(LA[base + (size_t)i * 1024])); const float bb = bf2f(Bv[base + (size_t)i * 1024]); Hl = a * Hl + bb; P *= a; }
        Ps[c.tid] = P; Hs[c.tid] = Hl;
        __syncthreads();
        float h = 0.f;
        for (int s2 = 0; s2 < seg; ++s2) h = Ps[s2 * 64 + (c.tid & 63)] * h + Hs[s2 * 64 + (c.tid & 63)];
#pragma unroll 8
        for (int i = 0; i < 256; ++i) { const float a = __builtin_amdgcn_exp2f(bf2f(LA[base + (size_t)i * 1024])); const float bb = bf2f(Bv[base + (size_t)i * 1024]); h = a * h + bb;
            const float gv = bf2f(gate[base + (size_t)i * 1024]); Bv[base + (size_t)i * 1024] = (bf16_t)f2bf(h * gelu_tanh(gv)); }
        __syncthreads();
    }
}

struct QkvRaw { u32x4 q[2], k[2], v[2]; f32x4 cs[4]; };
__device__ __forceinline__ void qkv_load(QkvRaw& r, const bf16_t* qraw, const bf16_t* kvraw, const bf16_t* pa, const float* CS, int t, int ch, int hq) {
    const bool act = ch < 12;
#pragma unroll
    for (int pass = 0; pass < 2; ++pass) { const int h = pass * 4 + hq;
        r.q[pass] = (u32x4){0u, 0u, 0u, 0u}; r.k[pass] = (u32x4){0u, 0u, 0u, 0u}; r.v[pass] = (u32x4){0u, 0u, 0u, 0u};
        if (act) r.q[pass] = *(const u32x4*)(qraw + (size_t)t * 768 + h * 96 + 8 * ch);
        if (ch < 8) { r.k[pass] = *(const u32x4*)(kvraw + (size_t)t * 1024 + h * 128 + 8 * ch); r.v[pass] = *(const u32x4*)(kvraw + (size_t)t * 1024 + h * 128 + 64 + 8 * ch); }
        else if (act) r.k[pass] = *(const u32x4*)(pa + (size_t)t * 512 + 384 + 8 * (ch - 8)); }
    const float* cp = CS + (size_t)t * 32 + 8 * (ch & 1);
    r.cs[0] = *(const f32x4*)cp; r.cs[1] = *(const f32x4*)(cp + 4); r.cs[2] = *(const f32x4*)(cp + 16); r.cs[3] = *(const f32x4*)(cp + 20);
}
__device__ __forceinline__ void phase_qkv_layout(const Ctx& c0) {
    Ctx c = c0; c.lane = lane_id_v(); c.tid = c.wave * 64 + c.lane;
    const bf16_t* qraw = WSP(bf16_t, WS_R5); const bf16_t* kvraw = WSP(bf16_t, WS_R2); const bf16_t* pa = WSP(bf16_t, WS_R1);
    bf16_t* Qh = WSP(bf16_t, WS_R4); bf16_t* Kh = WSP(bf16_t, WS_R3); bf16_t* Vh = WSP(bf16_t, WS_R0);
    const float* qng = c.in[I_QNG]; const float* kng = c.in[I_KNG]; const float* CS = WSP(float, WS_CS);
    const float qscale = 0.10206207261596577f * 1.4426950408889634f;
    const int gw = c.vcu * 8 + c.wave, NGW = c.G * 8, L = c.lane;
    const int ch = L & 15, hq = L >> 4;
    const bool act = ch < 12, isr = ch >= 8, hi2 = ch >= 10;
    float gq[8], gk[8];
#pragma unroll
    for (int j = 0; j < 8; ++j) { gq[j] = act ? qng[8 * ch + j] : 0.f; gk[j] = act ? kng[8 * ch + j] : 0.f; }
    if (gw >= T) return;
    QkvRaw cur, nxt;
    qkv_load(cur, qraw, kvraw, pa, CS, gw, ch, hq);
#pragma unroll 1
    for (int t = gw; t < T; t += NGW) {
        qkv_load(nxt, qraw, kvraw, pa, CS, (t + NGW < T) ? t + NGW : t, ch, hq);
        const int b = t >> 11, s = t & 2047;
        const float cs[8] = {cur.cs[0].x, cur.cs[0].y, cur.cs[0].z, cur.cs[0].w, cur.cs[1].x, cur.cs[1].y, cur.cs[1].z, cur.cs[1].w};
        const float sn[8] = {cur.cs[2].x, cur.cs[2].y, cur.cs[2].z, cur.cs[2].w, cur.cs[3].x, cur.cs[3].y, cur.cs[3].z, cur.cs[3].w};
#pragma unroll
        for (int pass = 0; pass < 2; ++pass) {
            const int h = pass * 4 + hq;
            const size_t orow = ((size_t)(b * H + h) * S + s);
#pragma unroll
            for (int qk = 0; qk < 2; ++qk) {
                float v[8]; unpack8(qk == 0 ? cur.q[pass] : cur.k[pass], v);
                float ss = 0.f;
#pragma unroll
                for (int j = 0; j < 8; ++j) ss += v[j] * v[j];
#pragma unroll
                for (int o = 1; o < 16; o <<= 1) ss += __shfl_xor(ss, o);
                const float r = rsqrtf(ss * (1.f / 96.f) + EPS) * (qk == 0 ? qscale : 1.f);
                float x[8], o8[8];
#pragma unroll
                for (int j = 0; j < 8; ++j) x[j] = v[j] * r * (qk == 0 ? gq[j] : gk[j]);
#pragma unroll
                for (int j = 0; j < 8; ++j) { const float px = __shfl_xor(x[j], 2);
                    o8[j] = !isr ? x[j] : (hi2 ? px * sn[j] + x[j] * cs[j] : x[j] * cs[j] - px * sn[j]); }
                if (act) *(u32x4*)((qk == 0 ? Qh : Kh) + orow * 96 + 8 * ch) = pack8(o8);
            }
            if (ch < 8) *(u32x4*)(Vh + orow * 64 + 8 * ch) = cur.v[pass];
        }
        cur = nxt;
    }
}

constexpr int KROW = 208, VROW = 160;
constexpr int KBUF = 128 * KROW, VBUF = 128 * VROW;
typedef short v4i16_t __attribute__((ext_vector_type(4)));
__device__ __forceinline__ void attn_chunk(LAS unsigned char* kb, LAS unsigned char* vb, const bf16x8 (&qf)[3], f32x4 (&o)[4], float& mrun, float& lrun, int fr, int g) {
    f32x4 sacc[4];
#pragma unroll
    for (int kt = 0; kt < 4; ++kt) { sacc[kt] = (f32x4){0.f, 0.f, 0.f, 0.f};
#pragma unroll
        for (int ks = 0; ks < 3; ++ks) { const bf16x8 kf = *(const LAS bf16x8*)(kb + (16 * kt + fr) * KROW + (ks * 32 + g * 8) * 2);
            sacc[kt] = __builtin_amdgcn_mfma_f32_16x16x32_bf16(kf, qf[ks], sacc[kt], 0, 0, 0); } }
    float mx = sacc[0][0];
#pragma unroll
    for (int kt = 0; kt < 4; ++kt)
#pragma unroll
        for (int r = 0; r < 4; ++r) mx = fmaxf(mx, sacc[kt][r]);
    mx = fmaxf(mx, __shfl_xor(mx, 16)); mx = fmaxf(mx, __shfl_xor(mx, 32));
    const float mnew = fmaxf(mrun, mx), alpha = __builtin_amdgcn_exp2f(mrun - mnew); mrun = mnew;
    float ps = 0.f;
#pragma unroll
    for (int kt = 0; kt < 4; ++kt)
#pragma unroll
        for (int r = 0; r < 4; ++r) { const float p = __builtin_amdgcn_exp2f(sacc[kt][r] - mnew); sacc[kt][r] = p; ps += p; }
    lrun = lrun * alpha + ps;
#pragma unroll
    for (int dt = 0; dt < 4; ++dt) o[dt] = o[dt] * alpha;
#pragma unroll
    for (int s2 = 0; s2 < 2; ++s2) {
        u32x4 pw; pw.x = pk2(sacc[2 * s2][0], sacc[2 * s2][1]); pw.y = pk2(sacc[2 * s2][2], sacc[2 * s2][3]); pw.z = pk2(sacc[2 * s2 + 1][0], sacc[2 * s2 + 1][1]); pw.w = pk2(sacc[2 * s2 + 1][2], sacc[2 * s2 + 1][3]);
        const bf16x8 pb = __builtin_bit_cast(bf16x8, pw);
#pragma unroll
        for (int dt = 0; dt < 4; ++dt) {
            LAS unsigned char* va = vb + (32 * s2 + 4 * g + (fr >> 2)) * VROW + (16 * dt + 4 * (fr & 3)) * 2;
            const v4i16_t t0 = __builtin_amdgcn_ds_read_tr16_b64_v4i16((LAS v4i16_t*)va), t1 = __builtin_amdgcn_ds_read_tr16_b64_v4i16((LAS v4i16_t*)(va + 16 * VROW));
            const bf16x8 vf = (bf16x8){t0[0], t0[1], t0[2], t0[3], t1[0], t1[1], t1[2], t1[3]};
            o[dt] = __builtin_amdgcn_mfma_f32_16x16x32_bf16(vf, pb, o[dt], 0, 0, 0); }
    }
}
__device__ __forceinline__ void attn_unit(const Ctx& c, int b, int h, int qb) {
    const bf16_t* Qh = WSP(bf16_t, WS_R4); const bf16_t* Kh = WSP(bf16_t, WS_R3); const bf16_t* Vh = WSP(bf16_t, WS_R0); bf16_t* AO = WSP(bf16_t, WS_R0 + 32 * MiB);
    const int fr = c.lane & 15, g = c.lane >> 4, wid = c.wave;
    const size_t hb = (size_t)(b * H + h) * S;
    const int q0 = qb * 128 + wid * 16;
    const int nsup = qb + 1;
    bf16x8 qf[3];
#pragma unroll
    for (int ks = 0; ks < 3; ++ks) qf[ks] = *(const bf16x8*)(Qh + (hb + q0 + fr) * 96 + ks * 32 + g * 8);
    f32x4 o[4];
#pragma unroll
    for (int dt = 0; dt < 4; ++dt) o[dt] = (f32x4){0.f, 0.f, 0.f, 0.f};
    float mrun = -1e30f, lrun = 0.f;
    u32x4 kr[3], vr[2];
    const u32x4* Ksrc = (const u32x4*)(Kh + hb * 96); const u32x4* Vsrc = (const u32x4*)(Vh + hb * 64);
#pragma unroll
    for (int i = 0; i < 3; ++i) kr[i] = Ksrc[c.tid + 512 * i];
#pragma unroll
    for (int i = 0; i < 2; ++i) vr[i] = Vsrc[c.tid + 512 * i];
    for (int j = 0; j < nsup; ++j) {
        LAS unsigned char* kb = c.lds + (j & 1) * (KBUF + VBUF); LAS unsigned char* vb = kb + KBUF;
#pragma unroll
        for (int i = 0; i < 3; ++i) { const int kc = c.tid + 512 * i; *(LAS u32x4*)(kb + (kc / 12) * KROW + (kc % 12) * 16) = kr[i]; }
#pragma unroll
        for (int i = 0; i < 2; ++i) { const int vc = c.tid + 512 * i; *(LAS u32x4*)(vb + (vc >> 3) * VROW + (vc & 7) * 16) = vr[i]; }
        __syncthreads();
        if (j + 1 < nsup) {
#pragma unroll
            for (int i = 0; i < 3; ++i) kr[i] = Ksrc[(j + 1) * 1536 + c.tid + 512 * i];
#pragma unroll
            for (int i = 0; i < 2; ++i) vr[i] = Vsrc[(j + 1) * 1024 + c.tid + 512 * i];
        }
        attn_chunk(kb, vb, qf, o, mrun, lrun, fr, g);
        if (j + 1 < nsup || wid >= 4) attn_chunk(kb + 64 * KROW, vb + 64 * VROW, qf, o, mrun, lrun, fr, g);
    }
    float lt = lrun + __shfl_xor(lrun, 16); lt += __shfl_xor(lt, 32);
    const float inv = 1.f / lt;
    bf16_t* orow = AO + ((size_t)b * S + q0 + fr) * 512 + h * 64;
#pragma unroll
    for (int dt = 0; dt < 4; ++dt) { u32x2 w; w.x = pk2(o[dt][0] * inv, o[dt][1] * inv); w.y = pk2(o[dt][2] * inv, o[dt][3] * inv); *(u32x2*)(orow + 16 * dt + 4 * g) = w; }
    __syncthreads();
}
__device__ __forceinline__ void phase_attn(const Ctx& c0) {
    Ctx c = c0; c.lane = lane_id_v(); c.tid = c.wave * 64 + c.lane;
    for (int v = c.vcu; v < 256; v += c.G) {
        const int bh = v >> 1, odd = v & 1;
        for (int i = 0; i < 8; ++i) {
            const int setA[8] = {15, 12, 10, 9, 6, 5, 3, 0}, setB[8] = {14, 13, 11, 8, 7, 4, 2, 1};
            int qb = 0;
#pragma unroll
            for (int k = 0; k < 8; ++k) if (k == i) qb = odd ? setB[k] : setA[k];
            attn_unit(c, bh >> 3, bh & 7, qb);
        }
    }
}

__device__ __forceinline__ float wave_max(float v) {
#pragma unroll
    for (int o = 1; o < 64; o <<= 1) v = fmaxf(v, __shfl_xor(v, o));
    return v;
}
__device__ __forceinline__ int wave_min_i(int v) {
#pragma unroll
    for (int o = 1; o < 64; o <<= 1) v = min(v, __shfl_xor(v, o));
    return v;
}
__device__ __forceinline__ int prefix_cnt(unsigned long long m) { return (int)__builtin_amdgcn_mbcnt_hi((unsigned)(m >> 32), __builtin_amdgcn_mbcnt_lo((unsigned)m, 0u)); }
template <int NV, int NBITS> __device__ __forceinline__ void select16(const unsigned (&key)[NV], int (&slot)[NV]) {
    unsigned tau = 0u;
    for (int bit = NBITS - 1; bit >= 0; --bit) {
        const unsigned trial = tau | (1u << bit); int cnt = 0;
#pragma unroll
        for (int j = 0; j < NV; ++j) cnt += __popcll(__ballot(key[j] >= trial));
        if (cnt >= 16) { tau = trial; if (cnt == 16) break; }
    }
    int base = 0;
#pragma unroll
    for (int j = 0; j < NV; ++j) { const unsigned long long m = __ballot(key[j] > tau); slot[j] = (key[j] > tau) ? base + prefix_cnt(m) : -1; base += __popcll(m); }
#pragma unroll
    for (int j = 0; j < NV; ++j) { const unsigned long long m = __ballot(key[j] == tau); if (key[j] == tau) { const int s = base + prefix_cnt(m); slot[j] = s < 16 ? s : -1; } base += __popcll(m); }
}
template <int N> __device__ __forceinline__ void bitonic_stage_desc(unsigned (&x)[N], int k, int j) {
#pragma unroll
    for (int i = 0; i < N; ++i) { const int l = i ^ j; if (l > i) { const bool asc = ((i & k) != 0);
        const unsigned a = x[i], b = x[l]; const unsigned hi = a > b ? a : b, lo = a > b ? b : a; x[i] = asc ? lo : hi; x[l] = asc ? hi : lo; } }
}
__device__ __forceinline__ void sort16_desc(unsigned (&x)[16]) {
#pragma unroll
    for (int k = 2; k <= 16; k <<= 1)
#pragma unroll
        for (int j = k >> 1; j > 0; j >>= 1) bitonic_stage_desc<16>(x, k, j);
}
__device__ __forceinline__ void merge16_desc(unsigned (&run)[16], const unsigned (&ch)[16]) {
#pragma unroll
    for (int i = 0; i < 16; ++i) run[i] = run[i] > ch[15 - i] ? run[i] : ch[15 - i];
#pragma unroll
    for (int j = 8; j > 0; j >>= 1) bitonic_stage_desc<16>(run, 16, j);
}
__device__ __forceinline__ unsigned mono_hi(unsigned w) { return w ^ ((unsigned)((int)w >> 31) | 0x80000000u); }
__device__ __forceinline__ float demono_hi(unsigned k) { const unsigned kk = k & 0xffff0000u; return __builtin_bit_cast(float, (kk ^ ((unsigned)(~(int)kk >> 31) | 0x80000000u)) & 0xffff0000u); }
__device__ __forceinline__ void top16_list(const bf16_t* s, unsigned (&run)[16]) {
#pragma unroll
    for (int ck = 0; ck < 8; ++ck) {
        const u32x4 w0 = *(const u32x4*)(s + ck * 16), w1 = *(const u32x4*)(s + ck * 16 + 8);
        const unsigned w[8] = {w0.x, w0.y, w0.z, w0.w, w1.x, w1.y, w1.z, w1.w};
        unsigned ch[16];
#pragma unroll
        for (int i = 0; i < 8; ++i) { ch[2 * i] = (mono_hi(w[i] << 16) & 0xffff0000u) | (unsigned)(ck * 16 + 2 * i); ch[2 * i + 1] = (mono_hi(w[i]) & 0xffff0000u) | (unsigned)(ck * 16 + 2 * i + 1); }
        sort16_desc(ch);
        if (ck == 0) {
#pragma unroll
            for (int i = 0; i < 16; ++i) run[i] = ch[i];
        } else merge16_desc(run, ch);
    }
}
constexpr int SKROW = 272;
__device__ __forceinline__ void xmerge16(unsigned (&run)[16], int xo) {
    unsigned ch[16];
#pragma unroll
    for (int i = 0; i < 16; ++i) ch[i] = (unsigned)__shfl_xor((int)run[i], xo);
    merge16_desc(run, ch);
}
__device__ __forceinline__ void phase_topk(const Ctx& c0) {
    Ctx c = c0; c.lane = lane_id_v(); c.tid = c.wave * 64 + c.lane;
    const bf16_t* qp = WSP(bf16_t, WS_QP); int* IDX = WSP(int, WS_IDX); float* GW = WSP(float, WS_GW);
    const int L = c.lane, tok = L & 15, g = L >> 4;
    const int h = blockIdx.x & 7, rank = blockIdx.x >> 3, nrank = c.G >> 3;
    { const u32x4* src = (const u32x4*)(WSP(bf16_t, WS_SK) + (size_t)h * 2 * 128 * 128);
      for (int e = c.tid; e < 256 * 16; e += 512) *(LAS u32x4*)(c.lds + (e >> 4) * SKROW + (e & 15) * 16) = src[e]; }
    __syncthreads();
    const int NTG = T / 16;
    const int tg0 = rank * 8 + c.wave, tgs = nrank * 8;
    if (tg0 >= NTG) return;
    bf16x8 qn[8];
    { const bf16_t* qb = qp + (size_t)(tg0 * 16 + tok) * 2048 + h * 256 + g * 8;
#pragma unroll
      for (int j = 0; j < 8; ++j) qn[j] = *(const bf16x8*)(qb + 32 * j); }
#pragma unroll 1
    for (int tg = tg0; tg < NTG; tg += tgs) {
        bf16x8 qf[8];
#pragma unroll
        for (int j = 0; j < 8; ++j) qf[j] = qn[j];
        { const int tgn = (tg + tgs < NTG) ? tg + tgs : tg; const bf16_t* qb = qp + (size_t)(tgn * 16 + tok) * 2048 + h * 256 + g * 8;
#pragma unroll
          for (int j = 0; j < 8; ++j) qn[j] = *(const bf16x8*)(qb + 32 * j); }
        unsigned kab[2][16];
        int koff = tok * SKROW + g * 16; asm volatile("" : "+v"(koff));
#pragma unroll
        for (int p = 0; p < 2; ++p) {
            unsigned lo[16], hi[16];
#pragma unroll
            for (int nt = 0; nt < 8; ++nt) { f32x4 a = (f32x4){0.f, 0.f, 0.f, 0.f};
#pragma unroll
                for (int ks = 0; ks < 4; ++ks) { const bf16x8 kf = *(const LAS bf16x8*)(c.lds + koff + (p * 128 + nt * 16) * SKROW + ks * 64);
                    a = __builtin_amdgcn_mfma_f32_16x16x32_bf16(kf, qf[p * 4 + ks], a, 0, 0, 0); }
#pragma unroll
                for (int i = 0; i < 4; ++i) { const float av = a[i];
                    const unsigned k = (mono_hi(__float_as_uint(av)) & 0xffffff80u) | (unsigned)(nt * 16 + 4 * g + i);
                    if (nt < 4) lo[nt * 4 + i] = k; else hi[(nt - 4) * 4 + i] = k; } }
            sort16_desc(lo); sort16_desc(hi); merge16_desc(lo, hi);
            xmerge16(lo, 16); xmerge16(lo, 32);
#pragma unroll
            for (int i = 0; i < 16; ++i) kab[p][i] = lo[i];
        }
        float sa[16], sb[16]; unsigned ia[16], ib[16];
#pragma unroll
        for (int i = 0; i < 16; ++i) { const unsigned ka = kab[0][i] & 0xffffff80u, kb = kab[1][i] & 0xffffff80u;
            sa[i] = __builtin_bit_cast(float, ka ^ ((unsigned)(~(int)ka >> 31) | 0x80000000u)); sb[i] = __builtin_bit_cast(float, kb ^ ((unsigned)(~(int)kb >> 31) | 0x80000000u));
            ia[i] = (kab[0][i] & 0x7fu) << 7; ib[i] = kab[1][i] & 0x7fu; }
        const float mx = sa[0] + sb[0];
        unsigned run[16], ch[16]; int n = 0, nc = 0;
#pragma unroll
        for (int a = 0; a < 16; ++a)
#pragma unroll
            for (int b = 0; b < 16; ++b) if ((a + 1) * (b + 1) <= 16) {
                const int k = 65535 + (int)((sa[a] + sb[b] - mx) * 1024.f);
                ch[n] = ((unsigned)(k < 0 ? 0 : k) << 16) | ia[a] | ib[b];
                if (++n == 16) { sort16_desc(ch); if (nc == 0) {
#pragma unroll
                        for (int i = 0; i < 16; ++i) run[i] = ch[i]; } else merge16_desc(run, ch);
                    n = 0; ++nc; }
            }
#pragma unroll
        for (int i = 2; i < 16; ++i) ch[i] = 0u;
        sort16_desc(ch); merge16_desc(run, ch);
        float ex[16]; float sum = 0.f;
#pragma unroll
        for (int i = 0; i < 16; ++i) { ex[i] = __expf((float)((int)(run[i] >> 16) - 65535) * (1.f / 1024.f)); sum += ex[i]; }
        const float inv = 1.f / sum;
        const size_t e = ((size_t)(tg * 16 + tok) * 8 + h) * 16 + 4 * g;
        u32x4 vi; f32x4 vg;
#pragma unroll
        for (int q = 0; q < 4; ++q) if (g == q) { vi.x = run[4 * q] & 0x3fffu; vi.y = run[4 * q + 1] & 0x3fffu; vi.z = run[4 * q + 2] & 0x3fffu; vi.w = run[4 * q + 3] & 0x3fffu;
            vg.x = ex[4 * q] * inv; vg.y = ex[4 * q + 1] * inv; vg.z = ex[4 * q + 2] * inv; vg.w = ex[4 * q + 3] * inv; }
        *(u32x4*)(IDX + e) = vi; *(f32x4*)(GW + e) = vg;
    }
}

__device__ __forceinline__ void dec32_fp4(const u32x4 r, f32x2 (&f)[16]) {
    const unsigned w[4] = {r.x, r.y, r.z, r.w};
#pragma unroll
    for (int i = 0; i < 4; ++i) { f[4 * i] = __builtin_amdgcn_cvt_scalef32_pk_f32_fp4(w[i], 1.0f, 0); f[4 * i + 1] = __builtin_amdgcn_cvt_scalef32_pk_f32_fp4(w[i], 1.0f, 1);
        f[4 * i + 2] = __builtin_amdgcn_cvt_scalef32_pk_f32_fp4(w[i], 1.0f, 2); f[4 * i + 3] = __builtin_amdgcn_cvt_scalef32_pk_f32_fp4(w[i], 1.0f, 3); }
}
__device__ __forceinline__ float dot32_fp4(const f32x2 (&hv)[16], const u32x4 r) {
    f32x2 f[16]; dec32_fp4(r, f); f32x2 s = hv[0] * f[0];
#pragma unroll
    for (int j = 1; j < 16; ++j) s = s + hv[j] * f[j];
    return s.x + s.y;
}
typedef int i32x8 __attribute__((ext_vector_type(8)));
__device__ __forceinline__ void phase_peer_u(const Ctx& c0) {
    Ctx c = c0; c.lane = lane_id_v(); c.tid = c.wave * 64 + c.lane;
    const int* IDX = WSP(int, WS_IDX);
    const int L = c.lane, pp = blockIdx.x & 3, hh = (blockIdx.x >> 2) & 1, rank = blockIdx.x >> 3, nrank = c.G >> 3;
    LAS int* mb = (LAS int*)(c.lds + c.wave * 1024);
    const int vr = L & 15, g4 = L >> 4;
    const unsigned char* EU4b = c.ws + WS_EU + (size_t)pp * NE * 128;
    const unsigned char* H8 = c.ws + WS_H2Q + pp * 256 + (vr & 1) * 128 + g4 * 16;
    float* PD = WSP(float, WS_PD) + (size_t)(2 * pp + (vr & 1)) * T * 128 + 2 * g4;
    const int t0 = 2 * (rank * 8 + c.wave) + hh, ts = 2 * nrank * 8;
    if (t0 >= T) return;
    int sc1 = 0x7f7f7f7f; asm volatile("" : "+v"(sc1));
    const bool swapb = WSP(unsigned, WS_C8SP)[1024] != 0u;
    { const int g0 = IDX[(size_t)t0 * 128 + L], g1 = IDX[(size_t)t0 * 128 + 64 + L]; mb[L] = g0; mb[64 + L] = g1; }
    u32x4 rA[16], rB[16];
    { const unsigned char* EU4 = EU4b + (vr & 1) * 64 + g4 * 16;
#pragma unroll
      for (int G = 0; G < 16; ++G) rA[G] = *(const u32x4*)(EU4 + (size_t)mb[8 * G + (vr >> 1)] * 128); }
    int cur = 0;
#define PEER_U_TOKEN(RC, RN, tcur, tnext, tnext2) do { \
        int lo = (vr & 1) * 64 + g4 * 16; asm volatile("" : "+v"(lo)); const unsigned char* EU4 = EU4b + lo; \
        const int gn0 = IDX[(size_t)(tnext2) * 128 + L], gn1 = IDX[(size_t)(tnext2) * 128 + 64 + L]; \
        i32x8 hb = (i32x8){0, 0, 0, 0, 0, 0, 0, 0}; \
        if (vr < 2) { const u32x4 h0 = *(const u32x4*)(H8 + (size_t)(tcur) * 1024), h1 = *(const u32x4*)(H8 + (size_t)(tcur) * 1024 + 64); \
            unsigned hw[8] = {h0.x, h0.y, h0.z, h0.w, h1.x, h1.y, h1.z, h1.w}; \
            if (swapb) { _Pragma("unroll") for (int q = 0; q < 8; ++q) hw[q] = ((hw[q] & 0x00ff00ffu) << 8) | ((hw[q] >> 8) & 0x00ff00ffu); } \
            hb = (i32x8){(int)hw[0], (int)hw[1], (int)hw[2], (int)hw[3], (int)hw[4], (int)hw[5], (int)hw[6], (int)hw[7]}; } \
          \
        _Pragma("unroll") for (int G = 0; G < 16; ++G) RN[G] = *(const u32x4*)(EU4 + (size_t)mb[(cur ^ 1) * 128 + 8 * G + (vr >> 1)] * 128); \
          \
        mb[cur * 128 + L] = gn0; mb[cur * 128 + 64 + L] = gn1; \
        f32x4 acc[16]; \
        _Pragma("unroll") for (int G = 0; G < 16; ++G) { const i32x8 a = (i32x8){(int)RC[G].x, (int)RC[G].y, (int)RC[G].z, (int)RC[G].w, 0, 0, 0, 0}; \
            acc[G] = __builtin_amdgcn_mfma_scale_f32_16x16x128_f8f6f4(a, hb, (f32x4){0.f, 0.f, 0.f, 0.f}, 4, 0, 0, sc1, 0, sc1); } \
        if (vr < 2) { _Pragma("unroll") for (int G = 0; G < 16; ++G) { f32x2 o; o.x = vr ? acc[G][1] : acc[G][0]; o.y = vr ? acc[G][3] : acc[G][2]; *(f32x2*)(PD + (size_t)(tcur) * 128 + 8 * G) = o; } } \
        cur ^= 1; } while (0)
    { const int t1 = (t0 + ts < T) ? t0 + ts : t0; const int g0 = IDX[(size_t)t1 * 128 + L], g1 = IDX[(size_t)t1 * 128 + 64 + L]; mb[128 + L] = g0; mb[128 + 64 + L] = g1; }
#pragma unroll 1
    for (int t = t0; t < T; t += 2 * ts) {
        const int ta = t, tb = (t + ts < T) ? t + ts : t, tc = (t + 2 * ts < T) ? t + 2 * ts : tb, td = (t + 3 * ts < T) ? t + 3 * ts : tc;
        PEER_U_TOKEN(rA, rB, ta, tb, tc);
        if (t + ts < T) PEER_U_TOKEN(rB, rA, tb, tc, td);
    }
#undef PEER_U_TOKEN
}
__device__ __forceinline__ void phase_peer_fin(const Ctx& c0) {
    Ctx c = c0; c.lane = lane_id_v(); c.tid = c.wave * 64 + c.lane;
    const int* IDX = WSP(int, WS_IDX); const float* GW = WSP(float, WS_GW); const float* PD = WSP(float, WS_PD); unsigned* WGT = WSP(unsigned, WS_WGT);
    const float* SU = WSP(float, WS_SU); const float* SV = WSP(float, WS_SV); const float* SH = WSP(float, WS_SH);
#pragma unroll 4
    for (int i = c.vcu * 512 + c.tid; i < T * 128; i += c.G * 512) {
        float d = 0.f;
#pragma unroll
        for (int p = 0; p < 8; ++p) d += PD[(size_t)p * T * 128 + i];
        const int e = IDX[i];
        WGT[i] = (f2bf(GW[i] * gelu_tanh(d * SU[e] * SH[i >> 7]) * SV[e]) << 16) | (unsigned)e;
    }
}
template <bool DRY> __device__ __forceinline__ void phase_peer_v(const Ctx& c0) {
    Ctx c = c0; c.lane = lane_id_v(); c.tid = c.wave * 64 + c.lane;
    const unsigned* WI = WSP(unsigned, WS_WGT); const float* mod = WSP(float, WS_MOD);
    const int L = c.lane, pp = blockIdx.x & 3, hh = (blockIdx.x >> 2) & 1, rank = blockIdx.x >> 3, nrank = c.G >> 3;
    const bool b5 = L & 32, b4 = L & 16, b3 = L & 8;
    LAS unsigned* mb = (LAS unsigned*)(c.lds + c.wave * 1024);
    const int kl = L >> 3;
    const unsigned char* EV4 = c.ws + WS_EV + (size_t)pp * NE * 128 + (L & 7) * 16;
    const int col = pp * 256 + (L & 7) * 32 + (b5 ? 16 : 0) + (b4 ? 8 : 0) + (b3 ? 4 : 0);
    const int t0 = 2 * (rank * 8 + c.wave) + hh, ts = 2 * nrank * 8;
    if (t0 >= T) return;
    { const unsigned g0 = WI[(size_t)t0 * 128 + L], g1 = WI[(size_t)t0 * 128 + 64 + L]; mb[L] = g0; mb[64 + L] = g1; }
    u32x4 rA[8], rB[8];
#pragma unroll
    for (int i = 0; i < 8; ++i) rA[i] = *(const u32x4*)(EV4 + (size_t)(mb[8 * i + kl] & 0xffffu) * 128);
    int cur = 0;
#pragma unroll 1
    for (int t = t0; t < T; t += ts) {
        const int tn = (t + ts < T) ? t + ts : t;
        const unsigned gn0 = WI[(size_t)tn * 128 + L], gn1 = WI[(size_t)tn * 128 + 64 + L];
        float* o = c.out + (size_t)t * 1024 + col; const float* g2 = mod + (t >> 11) * 6144 + 5120 + col;
        f32x4 xo = *(const f32x4*)o; const f32x4 gt = *(const f32x4*)g2;
#pragma unroll
        for (int i = 0; i < 8; ++i) rB[i] = *(const u32x4*)(EV4 + (size_t)(mb[cur * 128 + 64 + 8 * i + kl] & 0xffffu) * 128);
        f32x2 ac2[16];
#pragma unroll
        for (int j = 0; j < 16; ++j) ac2[j] = (f32x2){0.f, 0.f};
#pragma unroll
        for (int i = 0; i < 8; ++i) { const float w = bfhi(mb[cur * 128 + 8 * i + kl]); const f32x2 w2 = {w, w}; f32x2 f[16]; dec32_fp4(rA[i], f);
#pragma unroll
            for (int j = 0; j < 16; ++j) ac2[j] = ac2[j] + f[j] * w2; }
        mb[(cur ^ 1) * 128 + L] = gn0; mb[(cur ^ 1) * 128 + 64 + L] = gn1;
#pragma unroll
        for (int i = 0; i < 8; ++i) rA[i] = *(const u32x4*)(EV4 + (size_t)(mb[(cur ^ 1) * 128 + 8 * i + kl] & 0xffffu) * 128);
#pragma unroll
        for (int i = 0; i < 8; ++i) { const float w = bfhi(mb[cur * 128 + 64 + 8 * i + kl]); const f32x2 w2 = {w, w}; f32x2 f[16]; dec32_fp4(rB[i], f);
#pragma unroll
            for (int j = 0; j < 16; ++j) ac2[j] = ac2[j] + f[j] * w2; }
        float acc[32];
#pragma unroll
        for (int j = 0; j < 16; ++j) { acc[2 * j] = ac2[j].x; acc[2 * j + 1] = ac2[j].y; }
        float n16[16], n8[8], n4[4];
#pragma unroll
        for (int i = 0; i < 16; ++i) { const float send = b5 ? acc[i] : acc[i + 16], keep = b5 ? acc[i + 16] : acc[i]; n16[i] = keep + __shfl_xor(send, 32); }
#pragma unroll
        for (int i = 0; i < 8; ++i) { const float send = b4 ? n16[i] : n16[i + 8], keep = b4 ? n16[i + 8] : n16[i]; n8[i] = keep + __shfl_xor(send, 16); }
#pragma unroll
        for (int i = 0; i < 4; ++i) { const float send = b3 ? n8[i] : n8[i + 4], keep = b3 ? n8[i + 4] : n8[i]; n4[i] = keep + __shfl_xor(send, 8); }
        xo.x += gt.x * n4[0]; xo.y += gt.y * n4[1]; xo.z += gt.z * n4[2]; xo.w += gt.w * n4[3];
        if (DRY) asm volatile("" :: "v"(xo.x), "v"(xo.y), "v"(xo.z), "v"(xo.w)); else *(f32x4*)o = xo;
        cur ^= 1;
    }
}

struct FInProj { bf16_t *pa, *lx, *lg, *mg;
    __device__ __forceinline__ void operator()(int row, int pn, int cc, const float (&v0)[8], const float (&v1)[8]) const {
        bf16_t* d;
        if (pn < 2) d = pa + (size_t)row * 512 + pn * 256 + cc; else if (pn < 6) d = lx + (size_t)row * 1024 + (pn - 2) * 256 + cc;
        else if (pn < 10) d = lg + (size_t)row * 1024 + (pn - 6) * 256 + cc; else d = mg + (size_t)row * 2048 + (pn - 10) * 256 + cc;
        *(u32x4*)d = pack8(v0); *(u32x4*)(d + 128) = pack8(v1); } };
struct FRowScale { bf16_t* dst; int ldc; const float* rstd; int which;
    __device__ __forceinline__ void operator()(int row, int pn, int cc, const float (&v0)[8], const float (&v1)[8]) const {
        const float r = rstd[2 * row + which]; float a[8], b[8];
#pragma unroll
        for (int j = 0; j < 8; ++j) { a[j] = v0[j] * r; b[j] = v1[j] * r; }
        *(u32x4*)(dst + (size_t)row * ldc + pn * 256 + cc) = pack8(a); *(u32x4*)(dst + (size_t)row * ldc + pn * 256 + 128 + cc) = pack8(b); } };
struct FGates { const bf16_t* xc; bf16_t *LA, *Bv; const float *brg, *big, *c8sp;
    __device__ __forceinline__ void operator()(int row, int pn, int cc, const float (&v0)[8], const float (&v1)[8]) const {
        const int ch = pn * 128 + cc; float x[8], la[8], bv[8]; unpack8(*(const u32x4*)(xc + (size_t)row * 1024 + ch), x);
#pragma unroll
        for (int j = 0; j < 8; ++j) {
            const float r = __builtin_amdgcn_rcpf(1.f + __expf(-(v0[j] + brg[ch + j]))), ig = __builtin_amdgcn_rcpf(1.f + __expf(-(v1[j] + big[ch + j])));
            const float loga = r * c8sp[ch + j];
            const float z = 2.f * loga;
            const float ser = -z * (1.f + z * (0.5f + z * (0.16666667f + z * (0.041666668f + z * (0.008333334f + z * 0.0013888889f)))));
            const float om = (z > -0.25f) ? ser : (1.f - __expf(z));
            la[j] = loga * 1.4426950408889634f;
            bv[j] = sqrtf(om) * (ig * x[j]);
        }
        *(u32x4*)(LA + (size_t)row * 1024 + ch) = pack8(la); *(u32x4*)(Bv + (size_t)row * 1024 + ch) = pack8(bv); } };
struct FY1 { const bf16_t* mg; bf16_t* y; int goff; bool accum;
    __device__ __forceinline__ void one(int row, int col, const float (&v)[8]) const {
        float gt[8], o[8]; unpack8(*(const u32x4*)(mg + (size_t)row * 2048 + goff + col), gt);
        if (accum) unpack8(*(const u32x4*)(y + (size_t)row * 1024 + col), o);
#pragma unroll
        for (int j = 0; j < 8; ++j) o[j] = (accum ? o[j] : 0.f) + sigmoidf_(gt[j]) * v[j];
        *(u32x4*)(y + (size_t)row * 1024 + col) = pack8(o); }
    __device__ __forceinline__ void operator()(int row, int pn, int cc, const float (&v0)[8], const float (&v1)[8]) const { one(row, pn * 256 + cc, v0); one(row, pn * 256 + 128 + cc, v1); } };
struct FX1 { const float* x; float* out; const float* mod;
    __device__ __forceinline__ void one(int row, int col, const float (&v)[8]) const {
        const float* g1 = mod + (row >> 11) * 6144 + 2048 + col; const float* xr = x + (size_t)row * 1024 + col; float* o = out + (size_t)row * 1024 + col;
        const f32x4 x0 = *(const f32x4*)xr, x1 = *(const f32x4*)(xr + 4), a0 = *(const f32x4*)g1, a1 = *(const f32x4*)(g1 + 4);
        f32x4 r0, r1; r0.x = x0.x + a0.x * v[0]; r0.y = x0.y + a0.y * v[1]; r0.z = x0.z + a0.z * v[2]; r0.w = x0.w + a0.w * v[3];
        r1.x = x1.x + a1.x * v[4]; r1.y = x1.y + a1.y * v[5]; r1.z = x1.z + a1.z * v[6]; r1.w = x1.w + a1.w * v[7];
        *(f32x4*)o = r0; *(f32x4*)(o + 4) = r1; }
    __device__ __forceinline__ void operator()(int row, int pn, int cc, const float (&v0)[8], const float (&v1)[8]) const { one(row, pn * 256 + cc, v0); one(row, pn * 256 + 128 + cc, v1); } };
struct FStore { bf16_t* dst; int ldc;
    __device__ __forceinline__ void operator()(int row, int pn, int cc, const float (&v0)[8], const float (&v1)[8]) const {
        *(u32x4*)(dst + (size_t)row * ldc + pn * 256 + cc) = pack8(v0); *(u32x4*)(dst + (size_t)row * ldc + pn * 256 + 128 + cc) = pack8(v1); } };

template <int M, int N, int K, int LDA, int ACS, class F> __device__ __forceinline__ void run_gemm(const Ctx& c, const bf16_t* A, const bf16_t* Bt, const F& f) {
    pg8::Gemm g{A, Bt}; pg8::StaticOrder<M, N> So; So.init(c.G, (int)blockIdx.x);
    pg8::EpiF<F> E{f};
    pg8::gemm_phase<K, LDA, ACS, pg8::EpiF<F>, pg8::StaticOrder<M, N>>((PG8_LAS unsigned char*)c.lds, g, So, E, c.wave * 64 + lane_id_v());
}

__global__ void __launch_bounds__(512, 2) mk_fwd(Args args) {
    extern __shared__ __attribute__((aligned(16))) unsigned char lds_raw[];
    Ctx c;
    c.lds = (LAS unsigned char*)lds_raw;
    c.wave = __builtin_amdgcn_readfirstlane(threadIdx.x >> 6); c.lane = lane_id_v(); c.tid = c.wave * 64 + c.lane;
    c.G = gridDim.x; { const int bx = blockIdx.x; c.vcu = (c.G % 8 == 0) ? (bx % 8) * (c.G / 8) + bx / 8 : bx; }
    c.in = args.in; c.out = args.out; c.ws = args.ws;
    volatile LAS unsigned* MISC = (volatile LAS unsigned*)(c.lds + MISC_OFF);
    if (c.tid < 32) MISC[c.tid] = 0u;
    __syncthreads();
    XcdBarrier bar; bar.bar = (unsigned*)(c.ws + WS_CTL) + 4096; bar.x = 0; bar.st = nullptr;
    if (args.ph_hi - args.ph_lo > 1) bar = xcd_barrier_post((unsigned*)(c.ws + WS_CTL) + 4096, MISC + 8);

    const int lo = args.ph_lo, hi = args.ph_hi;
#ifndef ONLYP
#define ONLYP -1
#endif
#define IN(k) (lo <= (k) && (k) < hi && (ONLYP < 0 || ONLYP == (k)))
#define SEAM(k) do { if ((k) + 1 < hi) xcd_barrier(bar, c.wave); } while (0)
#ifndef REPEAT_MASK
#define REPEAT_MASK 0
#endif
#define PHASE(k, ...) if (IN(k)) { c.lane = lane_id_v(); c.tid = c.wave * 64 + c.lane; { __VA_ARGS__ } if ((REPEAT_MASK >> (k)) & 1) { xcd_barrier(bar, c.wave); { __VA_ARGS__ } } SEAM(k); }
    PHASE(0, phase_prep(c);)
    PHASE(1, phase_modnorm<false>(c, c.in[I_X], c.in[I_N1G], 0, 1024, WSP(bf16_t, WS_R0));)
    PHASE(2, FInProj f{WSP(bf16_t, WS_R1), WSP(bf16_t, WS_R2), WSP(bf16_t, WS_R3), (bf16_t*)c.out};
             run_gemm<T, 4608, 1024, 1024, 0>(c, WSP(bf16_t, WS_R0), WSP(bf16_t, WS_WIN), f);)
    PHASE(3, phase_conv(c);)
    PHASE(4, { FRowScale fq{WSP(bf16_t, WS_R5), 768, WSP(float, WS_RSTD), 0};
               run_gemm<T, 768, 256, 512, 0>(c, WSP(bf16_t, WS_R1), WSP(bf16_t, WS_WUQ), fq); }
             { FGates fg{WSP(bf16_t, WS_R4), WSP(bf16_t, WS_R0), WSP(bf16_t, WS_R6), c.in[I_BRG], c.in[I_BIG], WSP(float, WS_C8SP)};
               run_gemm<T, 2048, 128, 1024, 128>(c, WSP(bf16_t, WS_R4), WSP(bf16_t, WS_WG), fg); })
    PHASE(5, { FRowScale fkv{WSP(bf16_t, WS_R2), 1024, WSP(float, WS_RSTD), 1};
               run_gemm<T, 1024, 128, 512, 0>(c, WSP(bf16_t, WS_R1) + 256, WSP(bf16_t, WS_WUKV), fkv); }
             phase_scan(c);)
    PHASE(6, phase_qkv_layout(c);)
    PHASE(7, phase_attn(c);)
    PHASE(8, { FY1 f1{(const bf16_t*)c.out, WSP(bf16_t, WS_R2), 0, false};
               run_gemm<T, 1024, 512, 512, 0>(c, WSP(bf16_t, WS_R0 + 32 * MiB), WSP(bf16_t, WS_WOA), f1); }
             { FY1 f2{(const bf16_t*)c.out, WSP(bf16_t, WS_R2), 1024, true};
               run_gemm<T, 1024, 1024, 1024, 0>(c, WSP(bf16_t, WS_R6), WSP(bf16_t, WS_WOL), f2); })
    PHASE(9, FX1 f{c.in[I_X], c.out, WSP(float, WS_MOD)};
             run_gemm<T, 1024, 1024, 1024, 0>(c, WSP(bf16_t, WS_R2), WSP(bf16_t, WS_WOUT), f);)
    PHASE(10, phase_modnorm<true>(c, c.out, c.in[I_N2G], 3072, 4096, WSP(bf16_t, WS_R0));)
    PHASE(11, FStore f{WSP(bf16_t, WS_QP), 2048};
              run_gemm<T, 2048, 1024, 1024, 0>(c, WSP(bf16_t, WS_R0), WSP(bf16_t, WS_WQ), f);)
    PHASE(13, phase_topk(c);)
    PHASE(14, phase_peer_u(c);)
    PHASE(15, phase_peer_fin(c);)
#ifdef PROBE_VDRY
    if (IN(16)) { c.lane = lane_id_v(); c.tid = c.wave * 64 + c.lane; phase_peer_v<true>(c); xcd_barrier(bar, c.wave); }
#endif
    PHASE(16, phase_peer_v<false>(c);)
#undef PHASE
#undef IN
#undef SEAM
}

extern "C" void kernel_launch(void* const* d_in, const int* in_sizes, int n_in, void* d_out, int out_size, void* d_ws, size_t ws_size, hipStream_t stream) {
    static int grid = 0;
    if (grid == 0) {
        if (n_in != 28 || out_size != T * D || ws_size < WS_END) { fprintf(stderr, "kernel_launch: unexpected shapes (n_in %d out %d ws %zu)\n", n_in, out_size, ws_size); grid = -1; return; }
        int dev = 0, cus = 0, per_cu = 0;
        if (hipGetDevice(&dev) != hipSuccess || hipDeviceGetAttribute(&cus, hipDeviceAttributeMultiprocessorCount, dev) != hipSuccess) { grid = -1; return; }
        if (hipFuncSetAttribute((const void*)mk_fwd, hipFuncAttributeMaxDynamicSharedMemorySize, LDS_BYTES) != hipSuccess) { fprintf(stderr, "kernel_launch: hipFuncSetAttribute failed\n"); grid = -1; return; }
        if (hipOccupancyMaxActiveBlocksPerMultiprocessor(&per_cu, (const void*)mk_fwd, 512, LDS_BYTES) != hipSuccess || per_cu < 1) { fprintf(stderr, "kernel_launch: occupancy query says %d blocks per CU\n", per_cu); grid = -1; (void)hipGetLastError(); return; }
        grid = cus - (cus % 8);
        if (grid < 8) { fprintf(stderr, "kernel_launch: needs at least 8 CUs\n"); grid = -1; return; }
    }
    if (grid < 0) return;
    (void)hipMemsetAsync((char*)d_ws + WS_CTL, 0, CTL_ZERO_BYTES, stream);
    Args a{};
    for (int i = 0; i < 28; ++i) a.in[i] = (const float*)d_in[i];
    a.out = (float*)d_out; a.ws = (unsigned char*)d_ws;
#if MK_N_LAUNCHES == 1
    a.ph_lo = 0; a.ph_hi = N_PHASES;
    hipLaunchKernelGGL(mk_fwd, dim3(grid), dim3(512), LDS_BYTES, stream, a);
#else
    for (int ph = 0; ph < N_PHASES; ++ph) { a.ph_lo = ph; a.ph_hi = ph + 1; hipLaunchKernelGGL(mk_fwd, dim3(grid), dim3(512), LDS_BYTES, stream, a); }
#endif
}
```

```cpp
#include <hip/hip_runtime.h>
#include <cstdio>
#include <cstdint>

#define LAS __attribute__((address_space(3)))
#define GAS __attribute__((address_space(1)))
typedef unsigned short bf16_t;
typedef short bf16x8 __attribute__((ext_vector_type(8)));
typedef float f32x4 __attribute__((ext_vector_type(4)));
typedef float f32x2 __attribute__((ext_vector_type(2)));
typedef unsigned u32x4 __attribute__((ext_vector_type(4)));
typedef unsigned u32x2 __attribute__((ext_vector_type(2)));

#ifndef MK_N_LAUNCHES
#define MK_N_LAUNCHES 1
#endif

constexpr int T = 32768, D = 1024, NB_ = 16, S = 2048, H = 8;
constexpr int QKH = 96, VH = 64;
constexpr int NE = 16384;
constexpr float EPS = 1e-6f;

constexpr size_t MiB = 1u << 20;
constexpr size_t WS_CTL = 0, CTL_ZERO_BYTES = 65536;
constexpr size_t WS_MOD = 1 * MiB;
constexpr size_t WS_RSTD = 1 * MiB + 512 * 1024;
constexpr size_t WS_C8SP = 1 * MiB + 448 * 1024;
constexpr size_t WS_WIN = 2 * MiB;
constexpr size_t WS_WUQ = 11 * MiB;
constexpr size_t WS_WUKV = 11 * MiB + 512 * 1024;
constexpr size_t WS_WOA = 12 * MiB;
constexpr size_t WS_WOL = 13 * MiB;
constexpr size_t WS_WOUT = 15 * MiB;
constexpr size_t WS_WQ = 17 * MiB;
constexpr size_t WS_WG = 21 * MiB;
constexpr size_t WS_SK = 22 * MiB;
constexpr size_t WS_EU = 24 * MiB;
constexpr size_t WS_EV = 40 * MiB;
constexpr size_t WS_SU = 1 * MiB + 768 * 1024;
constexpr size_t WS_SV = 1 * MiB + 832 * 1024;
constexpr size_t WS_WGT = 440 * MiB;
constexpr size_t WS_CS = 56 * MiB;
constexpr size_t WS_H2Q = 456 * MiB;
constexpr size_t WS_SH = 1 * MiB + 896 * 1024;
constexpr size_t WS_PD = 280 * MiB;
constexpr size_t WS_R0 = 88 * MiB;
constexpr size_t WS_R1 = 152 * MiB;
constexpr size_t WS_R2 = 184 * MiB;
constexpr size_t WS_R3 = 248 * MiB;
constexpr size_t WS_R4 = 312 * MiB;
constexpr size_t WS_R5 = 376 * MiB;
constexpr size_t WS_R6 = 424 * MiB;
constexpr size_t WS_QP = 152 * MiB;
constexpr size_t WS_SC = 280 * MiB;
constexpr size_t WS_IDX = 408 * MiB;
constexpr size_t WS_GW = 424 * MiB;
constexpr size_t WS_END = 488 * MiB;

constexpr int LDS_BYTES = 147456;
constexpr int MISC_OFF = 131072 + 320;

__device__ __forceinline__ unsigned f2bf(float f) { unsigned u = __builtin_bit_cast(unsigned, f); return (u + 0x7fffu + ((u >> 16) & 1u)) >> 16; }
typedef __bf16 bf16x2_t __attribute__((ext_vector_type(2)));
__device__ __forceinline__ unsigned pk2(float lo, float hi) { f32x2 v = {lo, hi}; return __builtin_bit_cast(unsigned, __builtin_convertvector(v, bf16x2_t)); }
__device__ __forceinline__ float bf2f(unsigned h) { return __builtin_bit_cast(float, h << 16); }
__device__ __forceinline__ float bflo(unsigned w) { return __builtin_bit_cast(float, w << 16); }
__device__ __forceinline__ float bfhi(unsigned w) { return __builtin_bit_cast(float, w & 0xffff0000u); }
__device__ __forceinline__ float sigmoidf_(float x) { return 1.f / (1.f + __expf(-x)); }
__device__ __forceinline__ float gelu_tanh(float x) {
    const float u = 0.7978845608028654f * (x + 0.044715f * x * x * x);
    const float e = __expf(2.f * u);
    const float th = 1.f - 2.f / (e + 1.f);
    return 0.5f * x * (1.f + th);
}
__device__ __forceinline__ int lane_id_v() { int l; asm volatile("v_mbcnt_lo_u32_b32 %0, -1, 0\n\tv_mbcnt_hi_u32_b32 %0, -1, %0" : "=v"(l)); return l; }
__device__ __forceinline__ float wave_sum(float v) {
#pragma unroll
    for (int o = 1; o < 64; o <<= 1) v += __shfl_xor(v, o);
    return v;
}
__device__ __forceinline__ void unpack8(const u32x4 w, float (&v)[8]) {
    v[0] = bflo(w.x); v[1] = bfhi(w.x); v[2] = bflo(w.y); v[3] = bfhi(w.y); v[4] = bflo(w.z); v[5] = bfhi(w.z); v[6] = bflo(w.w); v[7] = bfhi(w.w);
}
__device__ __forceinline__ u32x4 pack8(const float (&v)[8]) {
    u32x4 w; w.x = pk2(v[0], v[1]); w.y = pk2(v[2], v[3]); w.z = pk2(v[4], v[5]); w.w = pk2(v[6], v[7]); return w;
}

namespace pg8 {
#define PG8_LAS __attribute__((address_space(3)))
constexpr int BM = 256, BK = 64, HALF = 128, HTB = HALF * BK * 2, STAGE_BYTES = 8 * HTB, NXCD = 8, WGM = 8;
__host__ __device__ __forceinline__ int lds_byte(int r, int c) { const int st = (r >> 4) * 2 + (c >> 5), rr = r & 15, cc = c & 31, ob = rr * 64 + cc * 2; return st * 1024 + (ob ^ (((ob >> 9) & 1) << 5)); }
__host__ __device__ __forceinline__ void stage_rc(int b, int& R, int& C) { const int st = b / 1024, sb = b % 1024, swz = sb ^ (((sb >> 9) & 1) << 5); R = (st >> 1) * 16 + swz / 64; C = (st & 1) * 32 + (swz % 64) / 2; }
__host__ __device__ __forceinline__ int perm32(int rho) { const int n = rho >> 4, i = rho & 15; return 8 * (i >> 2) + 4 * n + (i & 3); }

struct Unit { int pm, pn; };
struct Gemm { const bf16_t* A; const bf16_t* Bt; };

template <int M_, int N_> struct StaticOrder {
    static constexpr int nM = M_ / BM, nN = N_ / BM, nwg = nM * nN;
    int G, c;
    __host__ __device__ void init(int G_, int c_) { G = G_; c = c_; }
    __host__ __device__ bool next(int i, Unit& u) const {
        const long L = (long)i * G + c; if (L >= nwg) return false;
        int wgid = (int)L; { const int q = nwg / NXCD, r = nwg % NXCD, xcd = wgid % NXCD, off = wgid / NXCD; wgid = (xcd < r ? xcd * (q + 1) : r * (q + 1) + (xcd - r) * q) + off; }
        const int nig = WGM * nN, gid = wgid / nig, fm = gid * WGM, gsz = (nM - fm) < WGM ? (nM - fm) : WGM;
        u.pm = fm + ((wgid % nig) % gsz); u.pn = (wgid % nig) / gsz; return true;
    }
};

template <class F> struct EpiF {
    static constexpr bool PERM = true;
    F f;
    __device__ __forceinline__ void operator()(const f32x4 (&acc)[2][2][4][2], const Unit& u, int wr, int wc, int fr, int fq) const {
        { int l_; asm volatile("v_mbcnt_lo_u32_b32 %0, -1, 0\n\tv_mbcnt_hi_u32_b32 %0, -1, %0" : "=v"(l_)); fr = l_ & 15; fq = l_ >> 4; }
        const int c = wc * 32 + 8 * fq;
        const typename F::Tile tl = f.tile(u.pn, c, u.pm);
#pragma unroll
        for (int ai = 0; ai < 2; ++ai)
#pragma unroll
            for (int mb = 0; mb < 4; mb += F::NB) {
                typename F::Pre pre[F::NB];
#pragma unroll
                for (int m = 0; m < F::NB; ++m) pre[m] = f.pre(u.pm * BM + ai * HALF + wr * 64 + (mb + m) * 16 + fr, u.pn, c);
#pragma unroll
                for (int m = 0; m < F::NB; ++m) {
                    const int row = u.pm * BM + ai * HALF + wr * 64 + (mb + m) * 16 + fr;
                    float v0[8], v1[8];
#pragma unroll
                    for (int j = 0; j < 4; ++j) { v0[j] = acc[ai][0][mb + m][0][j]; v0[4 + j] = acc[ai][0][mb + m][1][j]; v1[j] = acc[ai][1][mb + m][0][j]; v1[4 + j] = acc[ai][1][mb + m][1][j]; }
                    f.apply(row, u.pn, c, v0, v1, pre[m], tl);
                }
            }
    }
};

template <int K, int LDA, int ACS, class Epi, class Sched>
__device__ __forceinline__ void gemm_phase(PG8_LAS unsigned char* lds, const Gemm g, const Sched& S, const Epi& E, const int tid) {
    const int wid = __builtin_amdgcn_readfirstlane(tid >> 6), lane = tid & 63, wr = wid >> 2, wc = wid & 3, fr = lane & 15, fq = lane >> 4;
    constexpr int nt = K / BK;
    unsigned voffA[2], voffB[2];
#pragma unroll
    for (int i = 0; i < 2; ++i) { int R, C; stage_rc(tid * 16 + i * 8192, R, C); const int Rb = Epi::PERM ? ((R & ~31) + perm32(R & 31)) : R;
        voffA[i] = (unsigned)(R * LDA + C) * 2u; voffB[i] = (unsigned)(Rb * K + C) * 2u; }
    constexpr size_t kstep = (size_t)(BK * 2);
    constexpr size_t hstepA = (size_t)HALF * LDA * 2, hstepB = (size_t)HALF * K * 2;
    constexpr size_t tstepA = 2 * hstepA, tstepB = 2 * hstepB;
    constexpr size_t acsb = (size_t)ACS * 2;
    const unsigned ldsw = (unsigned)wid * 1024u;
    const int aoff = lds_byte(wr * 64 + fr, fq * 8), boff = lds_byte(wc * 32 + fr, fq * 8);
#define PG8_SA(b, h) (((b) * 2 + (h)) * HTB)
#define PG8_SB(b, h) ((4 + (b) * 2 + (h)) * HTB)
#define PG8_STAGE(bufoff, gbase, voff) do { _Pragma("unroll") for (int _i = 0; _i < 2; ++_i) \
        __builtin_amdgcn_global_load_lds((const unsigned*)((const char*)(gbase) + (voff)[_i]), (PG8_LAS unsigned*)(lds + (bufoff) + ldsw + _i * 8192), 16, 0, 0); } while (0)
#define PG8_LDA(dst, b, h) do { _Pragma("unroll") for (int m = 0; m < 4; ++m) _Pragma("unroll") for (int k = 0; k < 2; ++k) dst[m][k] = *(const PG8_LAS bf16x8*)(lds + PG8_SA(b, h) + aoff + m * 2048 + k * 1024); } while (0)
#define PG8_LDB(dst, b, h) do { _Pragma("unroll") for (int n = 0; n < 2; ++n) _Pragma("unroll") for (int k = 0; k < 2; ++k) dst[n][k] = *(const PG8_LAS bf16x8*)(lds + PG8_SB(b, h) + boff + n * 2048 + k * 1024); } while (0)
#define PG8_MMA(ai, bj, At, Bt) do { __builtin_amdgcn_s_setprio(1); _Pragma("unroll") for (int m = 0; m < 4; ++m) _Pragma("unroll") for (int n = 0; n < 2; ++n) _Pragma("unroll") for (int k = 0; k < 2; ++k) \
        acc[ai][bj][m][n] = __builtin_amdgcn_mfma_f32_16x16x32_bf16(Bt[n][k], At[m][k], acc[ai][bj][m][n], 0, 0, 0); __builtin_amdgcn_s_setprio(0); } while (0)
#define PG8_WAIT_V(n) asm volatile("s_waitcnt vmcnt(" #n ")" ::: "memory")
#define PG8_WAIT_L(n) asm volatile("s_waitcnt lgkmcnt(" #n ")" ::: "memory")
#define PG8_BAR __builtin_amdgcn_s_barrier()
#define PG8_SCHED __builtin_amdgcn_sched_barrier(0)
    Unit cur, nxt; int ui = 0;
    if (!S.next(0, cur)) return;
    f32x4 acc[2][2][4][2];
#pragma unroll
    for (int a = 0; a < 2; ++a)
#pragma unroll
        for (int b = 0; b < 2; ++b)
#pragma unroll
            for (int m = 0; m < 4; ++m)
#pragma unroll
                for (int n = 0; n < 2; ++n) acc[a][b][m][n] = (f32x4){0.f, 0.f, 0.f, 0.f};
    bf16x8 At[4][2], B0[2][2], B1[2][2];
    const char* cA = (const char*)g.A + (size_t)cur.pm * tstepA + (size_t)cur.pn * acsb; const char* cB = (const char*)g.Bt + (size_t)cur.pn * tstepB;
    PG8_STAGE(PG8_SB(0, 0), cB, voffB); PG8_STAGE(PG8_SB(0, 1), cB + hstepB, voffB); PG8_STAGE(PG8_SA(0, 0), cA, voffA); PG8_STAGE(PG8_SA(0, 1), cA + hstepA, voffA);
    if (wr == 1) PG8_BAR;
    PG8_WAIT_V(2); PG8_BAR;
    PG8_STAGE(PG8_SB(1, 0), cB + kstep, voffB); PG8_STAGE(PG8_SA(1, 0), cA + kstep, voffA); PG8_STAGE(PG8_SB(1, 1), cB + hstepB + kstep, voffB);
    PG8_WAIT_V(6); PG8_BAR;
    for (;;) {
        const bool has_next = S.next(ui + 1, nxt);
        const char* nA = has_next ? (const char*)g.A + (size_t)nxt.pm * tstepA + (size_t)nxt.pn * acsb : cA; const char* nB = has_next ? (const char*)g.Bt + (size_t)nxt.pn * tstepB : cB;
#pragma unroll 1
        for (int t = 0; t < nt; t += 2) {
            const bool last = (t == nt - 2);
            const char* a1 = cA + (size_t)(t + 1) * kstep;
            const char* a2 = last ? nA : cA + (size_t)(t + 2) * kstep; const char* b2 = last ? nB : cB + (size_t)(t + 2) * kstep;
            const char* a3 = a2 + kstep; const char* b3 = b2 + kstep;
            PG8_LDB(B0, 0, 0); PG8_LDB(B1, 0, 1); PG8_SCHED; PG8_LDA(At, 0, 0); PG8_STAGE(PG8_SA(1, 1), a1 + hstepA, voffA);
            PG8_WAIT_V(8); PG8_WAIT_L(0); PG8_BAR; PG8_MMA(0, 0, At, B0); PG8_MMA(0, 1, At, B1); PG8_BAR; PG8_SCHED;
            PG8_LDA(At, 0, 1); PG8_STAGE(PG8_SB(0, 0), b2, voffB); PG8_STAGE(PG8_SB(0, 1), b2 + hstepB, voffB); PG8_STAGE(PG8_SA(0, 0), a2, voffA);
            PG8_WAIT_V(8); PG8_WAIT_L(0); PG8_BAR; PG8_MMA(1, 0, At, B0); PG8_MMA(1, 1, At, B1); PG8_BAR; PG8_SCHED;
            PG8_LDB(B0, 1, 0); PG8_LDB(B1, 1, 1); PG8_SCHED; PG8_LDA(At, 1, 0); PG8_STAGE(PG8_SA(0, 1), a2 + hstepA, voffA);
            PG8_WAIT_V(8); PG8_WAIT_L(0); PG8_BAR; PG8_MMA(0, 0, At, B0); PG8_MMA(0, 1, At, B1); PG8_BAR; PG8_SCHED;
            PG8_LDA(At, 1, 1); PG8_STAGE(PG8_SB(1, 0), b3, voffB); PG8_STAGE(PG8_SB(1, 1), b3 + hstepB, voffB); PG8_STAGE(PG8_SA(1, 0), a3, voffA);
            PG8_WAIT_V(8); PG8_WAIT_L(0); PG8_BAR; PG8_MMA(1, 0, At, B0); PG8_MMA(1, 1, At, B1); PG8_BAR; PG8_SCHED;
        }
        if (wr == 0) PG8_BAR;
        E(acc, cur, wr, wc, fr, fq);
        if (!has_next) break;
#pragma unroll
        for (int a = 0; a < 2; ++a)
#pragma unroll
            for (int b = 0; b < 2; ++b)
#pragma unroll
                for (int m = 0; m < 4; ++m)
#pragma unroll
                    for (int n = 0; n < 2; ++n) acc[a][b][m][n] = (f32x4){0.f, 0.f, 0.f, 0.f};
        cur = nxt; cA = nA; cB = nB; ++ui;
        if (wr == 1) PG8_BAR;
    }
    PG8_WAIT_V(0);
    PG8_BAR;
#undef PG8_SA
#undef PG8_SB
#undef PG8_STAGE
#undef PG8_LDA
#undef PG8_LDB
#undef PG8_MMA
#undef PG8_WAIT_V
#undef PG8_WAIT_L
#undef PG8_BAR
#undef PG8_SCHED
}
}

#define XB_TMO      128
#define XB_XCNT(j)  (256  + 64 * (j))
#define XB_XSUB(j)  (1280 + 64 * (j))
#define XB_XGEN(j)  (2304 + 64 * (j))
#define XB_TOP      3328
#define XB_TOPGEN   3392
#define XCD_BAR_WORDS 3456
#define XB_SPIN_CAP (1u << 18)
__device__ __forceinline__ unsigned xb_ld(unsigned* p)              { return __hip_atomic_load(p, __ATOMIC_RELAXED, __HIP_MEMORY_SCOPE_AGENT); }
__device__ __forceinline__ unsigned xb_add(unsigned* p, unsigned v) { return __hip_atomic_fetch_add(p, v, __ATOMIC_RELAXED, __HIP_MEMORY_SCOPE_AGENT); }
__device__ __forceinline__ unsigned xb_xcc_id() { return (unsigned)__builtin_amdgcn_s_getreg((3 << 11) | 20) & 0xFu; }
#define XB_SPIN(cond, bar) do { unsigned _sp = 0; while (cond) { __builtin_amdgcn_s_sleep(1); \
    if ((++_sp & 255u) == 0u) { if (xb_ld(&(bar)[XB_TMO])) break; if (_sp > XB_SPIN_CAP) { atomicAdd(&(bar)[XB_TMO], 1u); break; } } } } while (0)
struct XcdBarrier { unsigned* bar; unsigned x; volatile LAS unsigned* st; };
__device__ __forceinline__ XcdBarrier xcd_barrier_post(unsigned* bar, volatile LAS unsigned* st) {
    XcdBarrier b; b.bar = bar; b.x = xb_xcc_id(); b.st = st;
    if (threadIdx.x == 0) (void)xb_add(&bar[XB_XCNT(b.x)], 1u);
    return b;
}
__device__ __forceinline__ void xcd_barrier_complete(unsigned* bar, unsigned x, unsigned& nloc, unsigned& nx) {
    const unsigned G = gridDim.x * gridDim.y * gridDim.z;
    unsigned sum, cnt, mine, sp = 0u;
    for (;;) {
        sum = 0u; cnt = 0u; mine = 0u;
#pragma unroll
        for (unsigned j = 0; j < 16; ++j) { const unsigned c = xb_ld(&bar[XB_XCNT(j)]); sum += c; cnt += (c > 0u) ? 1u : 0u; mine = (j == x) ? c : mine; }
        if (sum == G) break;
        __builtin_amdgcn_s_sleep(1);
        if ((++sp & 255u) == 0u) { if (xb_ld(&bar[XB_TMO])) break; if (sp > XB_SPIN_CAP) { atomicAdd(&bar[XB_TMO], 1u); break; } }
    }
    nloc = mine > 0u ? mine : 1u; nx = cnt > 0u ? cnt : 1u;
}
__device__ __forceinline__ void xcd_barrier(const XcdBarrier& b, int wave) {
    asm volatile("s_waitcnt vmcnt(0)" ::: "memory");
    __syncthreads();
    if (wave == 0 && lane_id_v() == 0) {
        unsigned* bar = b.bar;
        __builtin_amdgcn_s_waitcnt(0);
        unsigned nloc = b.st[0], nx = b.st[1];
        if (nloc == 0u) { xcd_barrier_complete(bar, b.x, nloc, nx); b.st[0] = nloc; b.st[1] = nx; }
        const unsigned old = xb_add(&bar[XB_XSUB(b.x)], 1u);
        const unsigned gen = old / nloc;
        if (old + 1u == (gen + 1u) * nloc) {
            __builtin_amdgcn_fence(__ATOMIC_RELEASE, "agent");
            asm volatile("s_waitcnt vmcnt(0)" ::: "memory");
            const unsigned og = xb_add(&bar[XB_TOP], 1u);
            const unsigned tg = og / nx;
            if (og + 1u == (tg + 1u) * nx) xb_add(&bar[XB_TOPGEN], 1u);
            else XB_SPIN(xb_ld(&bar[XB_TOPGEN]) == tg, bar);
            __builtin_amdgcn_fence(__ATOMIC_ACQUIRE, "agent");
            xb_add(&bar[XB_XGEN(b.x)], 1u);
            asm volatile("s_waitcnt vmcnt(0)" ::: "memory");
        } else {
            XB_SPIN(xb_ld(&bar[XB_XGEN(b.x)]) == gen, bar);
            __builtin_amdgcn_fence(__ATOMIC_ACQUIRE, "agent");
            asm volatile("s_waitcnt vmcnt(0)" ::: "memory");
        }
    }
    __syncthreads();
}

struct Args { const float* in[28]; float* out; unsigned char* ws; int ph_lo, ph_hi; };
enum { I_X = 0, I_C, I_POS, I_WADA, I_BADA, I_N1G, I_WIN, I_QAG, I_WUQ, I_KVAG, I_WUKV, I_QNG, I_KNG, I_WOA, I_CONVW, I_CONVB, I_WRG, I_BRG, I_WIG, I_BIG, I_LAM, I_WOL, I_WOUT, I_N2G, I_WQ, I_SUBK, I_EU, I_EV };
constexpr int N_PHASES = 17;

struct Ctx {
    LAS unsigned char* lds;
    int tid, lane, wave, vcu, G;
    const float* const* in; float* out; unsigned char* ws;
};
#define WSP(type, off) ((type*)(c.ws + (off)))

template <class F>
__device__ __forceinline__ void tr_tile(const Ctx& c, bf16_t* dst, int K, int n0, int k0, F f) {
    LAS float* scr = (LAS float*)c.lds;
#pragma unroll
    for (int i = 0; i < 8; ++i) { const int kk = i * 8 + (c.tid >> 6), nn = c.tid & 63; scr[kk * 65 + nn] = f(k0 + kk, n0 + nn); }
    __syncthreads();
    { const int kc = c.tid & 7, nn = c.tid >> 3;
      LAS const float* s = scr + (8 * kc) * 65 + nn;
      u32x4 o; o.x = pk2(s[0], s[65]); o.y = pk2(s[2 * 65], s[3 * 65]); o.z = pk2(s[4 * 65], s[5 * 65]); o.w = pk2(s[6 * 65], s[7 * 65]);
      *(u32x4*)(dst + (size_t)(n0 + nn) * K + k0 + 8 * kc) = o; }
    __syncthreads();
}

__device__ __forceinline__ void phase_prep(const Ctx& c0) {
    Ctx c = c0; c.lane = lane_id_v(); c.tid = c.wave * 64 + c.lane;
    const float* w_in = c.in[I_WIN]; const float* w_uq = c.in[I_WUQ]; const float* qag = c.in[I_QAG]; const float* w_ukv = c.in[I_WUKV]; const float* kvag = c.in[I_KVAG];
    const float* w_oa = c.in[I_WOA]; const float* w_ol = c.in[I_WOL]; const float* w_out = c.in[I_WOUT]; const float* w_q = c.in[I_WQ];
    const float* w_rg = c.in[I_WRG]; const float* w_ig = c.in[I_WIG];
    constexpr int T_WIN = 72 * 16, T_WUQ = 12 * 4, T_WUKV = 16 * 2, T_WOA = 16 * 8, T_WOL = 16 * 16, T_WOUT = 16 * 16, T_WQ = 32 * 16, T_WG = 8 * 4 * 2;
    constexpr int T_ALL = T_WIN + T_WUQ + T_WUKV + T_WOA + T_WOL + T_WOUT + T_WQ + T_WG;
    for (int it = c.vcu; it < T_ALL; it += c.G) {
        int r = it;
        if (r < T_WIN) { const int nb = r / 16, kb = r % 16;
            tr_tile(c, WSP(bf16_t, WS_WIN), 1024, nb * 64, kb * 64, [=](int k, int n) -> float { return n < 416 ? w_in[(size_t)k * 4512 + n] : (n < 512 ? 0.f : w_in[(size_t)k * 4512 + n - 96]); }); continue; }
        r -= T_WIN;
        if (r < T_WUQ) { const int nb = r / 4, kb = r % 4;
            tr_tile(c, WSP(bf16_t, WS_WUQ), 256, nb * 64, kb * 64, [=](int k, int n) -> float { return w_uq[(size_t)k * 768 + n] * qag[k]; }); continue; }
        r -= T_WUQ;
        if (r < T_WUKV) { const int nb = r / 2, kb = r % 2;
            tr_tile(c, WSP(bf16_t, WS_WUKV), 128, nb * 64, kb * 64, [=](int k, int n) -> float { return w_ukv[(size_t)k * 1024 + n] * kvag[k]; }); continue; }
        r -= T_WUKV;
        if (r < T_WOA) { const int nb = r / 8, kb = r % 8;
            tr_tile(c, WSP(bf16_t, WS_WOA), 512, nb * 64, kb * 64, [=](int k, int n) -> float { return w_oa[(size_t)k * 1024 + n]; }); continue; }
        r -= T_WOA;
        if (r < T_WOL) { const int nb = r / 16, kb = r % 16;
            tr_tile(c, WSP(bf16_t, WS_WOL), 1024, nb * 64, kb * 64, [=](int k, int n) -> float { return w_ol[(size_t)k * 1024 + n]; }); continue; }
        r -= T_WOL;
        if (r < T_WOUT) { const int nb = r / 16, kb = r % 16;
            tr_tile(c, WSP(bf16_t, WS_WOUT), 1024, nb * 64, kb * 64, [=](int k, int n) -> float { return w_out[(size_t)k * 1024 + n]; }); continue; }
        r -= T_WOUT;
        if (r < T_WQ) { const int nb = r / 16, kb = r % 16;
            const int slot = nb >> 1, n0 = (nb & 1) * 64, k0 = kb * 64;
            LAS float* wq_s = (LAS float*)(c.lds + 32768);
            LAS float* sk_s = (LAS float*)(c.lds + 32768 + 64 * 129 * 4);
            const float* skp = c.in[I_SUBK] + ((size_t)slot * 128 + n0) * 128;
            for (int e = c.tid; e < 64 * 128; e += 512) { const int rr = e >> 7, cc = e & 127; wq_s[rr * 129 + cc] = w_q[(size_t)(k0 + rr) * 2048 + slot * 128 + cc]; sk_s[rr * 129 + cc] = skp[(size_t)rr * 128 + cc]; }
            __syncthreads();
            tr_tile(c, WSP(bf16_t, WS_WQ), 1024, nb * 64, k0, [=](int k, int n) -> float { const LAS float* a = wq_s + (k - k0) * 129; const LAS float* b = sk_s + (n - nb * 64) * 129; float s = 0.f;
#pragma unroll 16
                for (int d = 0; d < 128; ++d) s += a[d] * b[d];
                return s; });
            continue; }
        r -= T_WQ;
        { const int blk = r / 8, q = r % 8, nb = q / 2, kb = q % 2;
            tr_tile(c, WSP(bf16_t, WS_WG) + (size_t)blk * 256 * 128, 128, nb * 64, kb * 64,
                    [=](int k, int n) -> float { return n < 128 ? w_rg[((size_t)blk * 128 + k) * 128 + n] : w_ig[((size_t)blk * 128 + k) * 128 + n - 128]; }); }
    }
    { const float* lam = c.in[I_LAM]; float* t8 = WSP(float, WS_C8SP);
      if (c.vcu == 0) for (int e = c.tid; e < 1024; e += 512) t8[e] = -8.f * log1pf(__expf(-lam[e])); }
    if (c.vcu == 0 && c.tid == 0) {
        const unsigned probe = __builtin_amdgcn_cvt_scalef32_pk_fp4_f32(0u, 1.0f, 0.0f, 1.0f, 0) & 0xffu;
        WSP(unsigned, WS_C8SP)[1024] = (probe == 0x02u) ? 0u : 1u; }
    { const f32x4* sk = (const f32x4*)c.in[I_SUBK]; u32x2* dst = WSP(u32x2, WS_SK);
      for (int e = c.vcu * 512 + c.tid; e < 16 * 128 * 128 / 4; e += c.G * 512) { const f32x4 v = sk[e]; u32x2 w; w.x = pk2(v.x, v.y); w.y = pk2(v.z, v.w); dst[e] = w; } }
    { const int gw = c.vcu * 8 + c.wave, NGW = c.G * 8, L = c.lane;
      for (int r = gw; r < 2 * NE; r += NGW) {
          const int isv = r >= NE, e = isv ? r - NE : r;
          const f32x4* src4 = (const f32x4*)((isv ? c.in[I_EV] : c.in[I_EU]) + (size_t)e * 1024 + 16 * L);
          f32x4 v[4]; float am = 0.f;
#pragma unroll
          for (int j = 0; j < 4; ++j) { v[j] = src4[j]; am = fmaxf(am, fmaxf(fmaxf(fabsf(v[j].x), fabsf(v[j].y)), fmaxf(fabsf(v[j].z), fabsf(v[j].w)))); }
#pragma unroll
          for (int o = 1; o < 64; o <<= 1) am = fmaxf(am, __shfl_xor(am, o));
          const float s = am > 0.f ? am * (1.f / 6.f) : 1.f, inv = 1.f / s;
          unsigned w0 = 0u, w1 = 0u;
          w0 = __builtin_amdgcn_cvt_scalef32_pk_fp4_f32(w0, v[0].x * inv, v[0].y * inv, 1.0f, 0); w0 = __builtin_amdgcn_cvt_scalef32_pk_fp4_f32(w0, v[0].z * inv, v[0].w * inv, 1.0f, 1);
          w0 = __builtin_amdgcn_cvt_scalef32_pk_fp4_f32(w0, v[1].x * inv, v[1].y * inv, 1.0f, 2); w0 = __builtin_amdgcn_cvt_scalef32_pk_fp4_f32(w0, v[1].z * inv, v[1].w * inv, 1.0f, 3);
          w1 = __builtin_amdgcn_cvt_scalef32_pk_fp4_f32(w1, v[2].x * inv, v[2].y * inv, 1.0f, 0); w1 = __builtin_amdgcn_cvt_scalef32_pk_fp4_f32(w1, v[2].z * inv, v[2].w * inv, 1.0f, 1);
          w1 = __builtin_amdgcn_cvt_scalef32_pk_fp4_f32(w1, v[3].x * inv, v[3].y * inv, 1.0f, 2); w1 = __builtin_amdgcn_cvt_scalef32_pk_fp4_f32(w1, v[3].z * inv, v[3].w * inv, 1.0f, 3);
          u32x2 q; q.x = w0; q.y = w1;
          *(u32x2*)(c.ws + (isv ? WS_EV : WS_EU) + ((size_t)(L >> 4) * NE + e) * 128 + (L & 15) * 8) = q;
          if (L == 0) WSP(float, isv ? WS_SV : WS_SU)[e] = s;
      } }
    { const float* cin = c.in[I_C]; const float* w_ada = c.in[I_WADA]; const float* b_ada = c.in[I_BADA]; float* mod = WSP(float, WS_MOD);
      LAS float* cs = (LAS float*)c.lds;
      LAS float* red = (LAS float*)(c.lds + 65536);
      bool have = false;
      for (int it = c.vcu; it < 192; it += c.G) {
          if (!have) { for (int e = c.tid; e < 16 * 1024; e += 512) { const float v = cin[e]; cs[e] = v / (1.f + __expf(-v)); } have = true; }
          __syncthreads();
          const int cl = c.tid & 31, ks = c.tid >> 5, j = it * 32 + cl;
          float acc[16];
#pragma unroll
          for (int b = 0; b < 16; ++b) acc[b] = 0.f;
          for (int kk = 0; kk < 64; ++kk) { const int k = ks * 64 + kk; const float w = w_ada[(size_t)k * 6144 + j];
#pragma unroll
              for (int b = 0; b < 16; ++b) acc[b] += cs[b * 1024 + k] * w; }
#pragma unroll
          for (int b = 0; b < 16; ++b) red[(ks * 16 + b) * 32 + cl] = acc[b];
          __syncthreads();
          { const int b = c.tid >> 5; float s = b_ada[j];
#pragma unroll
            for (int k2 = 0; k2 < 16; ++k2) s += red[(k2 * 16 + b) * 32 + cl];
            mod[b * 6144 + j] = s; }
          __syncthreads();
      } }
}

template <bool Q8>
__device__ __forceinline__ void phase_modnorm(const Ctx& c0, const float* x, const float* g, int shift_off, int scale_off, bf16_t* dst) {
    Ctx c = c0; c.lane = lane_id_v(); c.tid = c.wave * 64 + c.lane;
    const float* mod = WSP(float, WS_MOD);
    const int gw = c.vcu * 8 + c.wave, NGW = c.G * 8;
    for (int m = gw; m < T; m += NGW) {
        const int b = m >> 11;
        const f32x4* xr = (const f32x4*)(x + (size_t)m * D) + c.lane;
        f32x4 v[4]; float s = 0.f;
#pragma unroll
        for (int j = 0; j < 4; ++j) { v[j] = xr[64 * j]; s += (v[j].x * v[j].x + v[j].y * v[j].y) + (v[j].z * v[j].z + v[j].w * v[j].w); }
        const float rstd = rsqrtf(wave_sum(s) * (1.f / D) + EPS);
        u32x2* o8 = (u32x2*)(dst + (size_t)m * D) + c.lane;
        float am = 0.f;
#pragma unroll
        for (int j = 0; j < 4; ++j) {
            const int col = 4 * c.lane + 256 * j;
            const f32x4 gg = *(const f32x4*)(g + col), sc = *(const f32x4*)(mod + b * 6144 + scale_off + col), sh = *(const f32x4*)(mod + b * 6144 + shift_off + col);
            const float r0 = v[j].x * rstd * gg.x * (1.f + sc.x) + sh.x, r1 = v[j].y * rstd * gg.y * (1.f + sc.y) + sh.y;
            const float r2 = v[j].z * rstd * gg.z * (1.f + sc.z) + sh.z, r3 = v[j].w * rstd * gg.w * (1.f + sc.w) + sh.w;
            u32x2 w; w.x = pk2(r0, r1); w.y = pk2(r2, r3); o8[64 * j] = w;
            if (Q8) { v[j].x = r0; v[j].y = r1; v[j].z = r2; v[j].w = r3; am = fmaxf(am, fmaxf(fmaxf(fabsf(r0), fabsf(r1)), fmaxf(fabsf(r2), fabsf(r3)))); }
        }
        if (Q8) {
#pragma unroll
            for (int o = 1; o < 64; o <<= 1) am = fmaxf(am, __shfl_xor(am, o));
            const float sq = am > 0.f ? am * (1.f / 256.f) : 1.f, inv = 1.f / sq;
            unsigned* q8 = (unsigned*)(c.ws + WS_H2Q + (size_t)m * D) + c.lane;
#pragma unroll
            for (int j = 0; j < 4; ++j) { int w = __builtin_amdgcn_cvt_pk_fp8_f32(v[j].x * inv, v[j].y * inv, 0, false); w = __builtin_amdgcn_cvt_pk_fp8_f32(v[j].z * inv, v[j].w * inv, w, true); q8[64 * j] = (unsigned)w; }
            if (c.lane == 0) WSP(float, WS_SH)[m] = sq;
        }
    }
}

__device__ __forceinline__ void phase_conv(const Ctx& c0) {
    Ctx c = c0; c.lane = lane_id_v(); c.tid = c.wave * 64 + c.lane;
    const bf16_t* pa = WSP(bf16_t, WS_R1); const bf16_t* lx = WSP(bf16_t, WS_R2); bf16_t* xc = WSP(bf16_t, WS_R4); float* rstd = WSP(float, WS_RSTD);
    const float* cw = c.in[I_CONVW]; const float* cb = c.in[I_CONVB];
    const int gt = c.vcu * 512 + c.tid, NT = c.G * 512;
    { const int gw = c.vcu * 8 + c.wave, NGW = c.G * 8, L = c.lane;
      for (int t = gw; t < T; t += NGW) {
          float ss = 0.f;
          if (L < 48) { float v[8]; unpack8(*(const u32x4*)(pa + (size_t)t * 512 + 8 * L), v);
#pragma unroll
              for (int j = 0; j < 8; ++j) ss += v[j] * v[j]; }
          const float sq = wave_sum(L < 32 ? ss : 0.f), skv = wave_sum(L >= 32 ? ss : 0.f);
          if (L == 0) { rstd[2 * t] = rsqrtf(sq * (1.f / 256.f) + EPS); rstd[2 * t + 1] = rsqrtf(skv * (1.f / 128.f) + EPS); }
      } }
    { const int* pos = (const int*)c.in[I_POS]; float* CS = WSP(float, WS_CS);
      for (int e = gt; e < T * 16; e += NT) {
          const int t = e >> 4, jj = e & 15;
          const float invf = exp2f(-(float)jj * (13.287712379549449f / 16.f));
          const float ang = (float)pos[t] * invf; const float n = rintf(ang * 0.15915494309189535f);
          const float red = (float)((double)ang - (double)n * 6.283185307179586);
          CS[(size_t)t * 32 + jj] = __cosf(red); CS[(size_t)t * 32 + 16 + jj] = __sinf(red);
      } }
    {
        const int ch = (gt & 127) * 8;
        f32x4 wv[4][2]; f32x4 bv[2];
#pragma unroll
        for (int j = 0; j < 4; ++j) { wv[j][0] = *(const f32x4*)(cw + j * 1024 + ch); wv[j][1] = *(const f32x4*)(cw + j * 1024 + ch + 4); }
        bv[0] = *(const f32x4*)(cb + ch); bv[1] = *(const f32x4*)(cb + ch + 4);
        const int tstep = NT >> 7;
        for (int tq = gt >> 7; tq < T; tq += 4 * tstep) {
            u32x4 raw[4][4];
#pragma unroll
            for (int u = 0; u < 4; ++u) { const int t = tq + u * tstep; const int s = t & 2047;
#pragma unroll
                for (int j = 0; j < 4; ++j) { raw[u][j] = (u32x4){0u, 0u, 0u, 0u}; if (t < T && s - 3 + j >= 0) raw[u][j] = *(const u32x4*)(lx + (size_t)(t - 3 + j) * 1024 + ch); } }
#pragma unroll
            for (int u = 0; u < 4; ++u) { const int t = tq + u * tstep;
                float acc[8] = {bv[0].x, bv[0].y, bv[0].z, bv[0].w, bv[1].x, bv[1].y, bv[1].z, bv[1].w};
#pragma unroll
                for (int j = 0; j < 4; ++j) { float v[8]; unpack8(raw[u][j], v);
                    acc[0] += wv[j][0].x * v[0]; acc[1] += wv[j][0].y * v[1]; acc[2] += wv[j][0].z * v[2]; acc[3] += wv[j][0].w * v[3];
                    acc[4] += wv[j][1].x * v[4]; acc[5] += wv[j][1].y * v[5]; acc[6] += wv[j][1].z * v[6]; acc[7] += wv[j][1].w * v[7]; }
                if (t < T) *(u32x4*)(xc + (size_t)t * 1024 + ch) = pack8(acc); }
        }
    }
}

__device__ __forceinline__ void phase_scan(const Ctx& c0) {
    Ctx c = c0; c.lane = lane_id_v(); c.tid = c.wave * 64 + c.lane;
    const bf16_t* LA = WSP(bf16_t, WS_R0); bf16_t* Bv = WSP(bf16_t, WS_R6); const bf16_t* gate = WSP(bf16_t, WS_R3);
    LAS float* Ps = (LAS float*)c.lds; LAS float* Hs = Ps + 512;
    for (int it = c.vcu; it < 256; it += c.G) {
        const int b = it >> 4, cg = it & 15, seg = c.tid >> 6, ch = cg * 64 + (c.tid & 63);
        const size_t base = ((size_t)b * 2048 + seg * 256) * 1024 + ch;
        float P = 1.f, Hl = 0.f;
#pragma unroll 8
        for (int i = 0; i < 256; ++i) { const float a = __builtin_amdgcn_exp2f(bf2f(LA[base + (size_t)i * 1024])); const float bb = bf2f(Bv[base + (size_t)i * 1024]); Hl = a * Hl + bb; P *= a; }
        Ps[c.tid] = P; Hs[c.tid] = Hl;
        __syncthreads();
        float h = 0.f;
        for (int s2 = 0; s2 < seg; ++s2) h = Ps[s2 * 64 + (c.tid & 63)] * h + Hs[s2 * 64 + (c.tid & 63)];
#pragma unroll 8
        for (int i = 0; i < 256; ++i) { const float a = __builtin_amdgcn_exp2f(bf2f(LA[base + (size_t)i * 1024])); const float bb = bf2f(Bv[base + (size_t)i * 1024]); h = a * h + bb;
            const float gv = bf2f(gate[base + (size_t)i * 1024]); Bv[base + (size_t)i * 1024] = (bf16_t)f2bf(h * gelu_tanh(gv)); }
        __syncthreads();
    }
}

struct QkvRaw { u32x4 q[2], k[2], v[2]; f32x4 cs[4]; };
__device__ __forceinline__ void qkv_load(QkvRaw& r, const bf16_t* qraw, const bf16_t* kvraw, const bf16_t* pa, const float* CS, int t, int ch, int hq) {
    const bool act = ch < 12;
#pragma unroll
    for (int pass = 0; pass < 2; ++pass) { const int h = pass * 4 + hq;
        r.q[pass] = (u32x4){0u, 0u, 0u, 0u}; r.k[pass] = (u32x4){0u, 0u, 0u, 0u}; r.v[pass] = (u32x4){0u, 0u, 0u, 0u};
        if (act) r.q[pass] = *(const u32x4*)(qraw + (size_t)t * 768 + h * 96 + 8 * ch);
        if (ch < 8) { r.k[pass] = *(const u32x4*)(kvraw + (size_t)t * 1024 + h * 128 + 8 * ch); r.v[pass] = *(const u32x4*)(kvraw + (size_t)t * 1024 + h * 128 + 64 + 8 * ch); }
        else if (act) r.k[pass] = *(const u32x4*)(pa + (size_t)t * 512 + 384 + 8 * (ch - 8)); }
    const float* cp = CS + (size_t)t * 32 + 8 * (ch & 1);
    r.cs[0] = *(const f32x4*)cp; r.cs[1] = *(const f32x4*)(cp + 4); r.cs[2] = *(const f32x4*)(cp + 16); r.cs[3] = *(const f32x4*)(cp + 20);
}
__device__ __forceinline__ void phase_qkv_layout(const Ctx& c0) {
    Ctx c = c0; c.lane = lane_id_v(); c.tid = c.wave * 64 + c.lane;
    const bf16_t* qraw = WSP(bf16_t, WS_R5); const bf16_t* kvraw = WSP(bf16_t, WS_R2); const bf16_t* pa = WSP(bf16_t, WS_R1);
    bf16_t* Qh = WSP(bf16_t, WS_R4); bf16_t* Kh = WSP(bf16_t, WS_R3); bf16_t* Vh = WSP(bf16_t, WS_R0);
    const float* qng = c.in[I_QNG]; const float* kng = c.in[I_KNG]; const float* CS = WSP(float, WS_CS);
    const float qscale = 0.10206207261596577f * 1.4426950408889634f;
    const int gw = c.vcu * 8 + c.wave, NGW = c.G * 8, L = c.lane;
    const int ch = L & 15, hq = L >> 4;
    const bool act = ch < 12, isr = ch >= 8, hi2 = ch >= 10;
    float gq[8], gk[8];
#pragma unroll
    for (int j = 0; j < 8; ++j) { gq[j] = act ? qng[8 * ch + j] : 0.f; gk[j] = act ? kng[8 * ch + j] : 0.f; }
    if (gw >= T) return;
    QkvRaw cur, nxt;
    qkv_load(cur, qraw, kvraw, pa, CS, gw, ch, hq);
#pragma unroll 1
    for (int t = gw; t < T; t += NGW) {
        qkv_load(nxt, qraw, kvraw, pa, CS, (t + NGW < T) ? t + NGW : t, ch, hq);
        const int b = t >> 11, s = t & 2047;
        const float cs[8] = {cur.cs[0].x, cur.cs[0].y, cur.cs[0].z, cur.cs[0].w, cur.cs[1].x, cur.cs[1].y, cur.cs[1].z, cur.cs[1].w};
        const float sn[8] = {cur.cs[2].x, cur.cs[2].y, cur.cs[2].z, cur.cs[2].w, cur.cs[3].x, cur.cs[3].y, cur.cs[3].z, cur.cs[3].w};
#pragma unroll
        for (int pass = 0; pass < 2; ++pass) {
            const int h = pass * 4 + hq;
            const size_t orow = ((size_t)(b * H + h) * S + s);
#pragma unroll
            for (int qk = 0; qk < 2; ++qk) {
                float v[8]; unpack8(qk == 0 ? cur.q[pass] : cur.k[pass], v);
                float ss = 0.f;
#pragma unroll
                for (int j = 0; j < 8; ++j) ss += v[j] * v[j];
#pragma unroll
                for (int o = 1; o < 16; o <<= 1) ss += __shfl_xor(ss, o);
                const float r = rsqrtf(ss * (1.f / 96.f) + EPS) * (qk == 0 ? qscale : 1.f);
                float x[8], o8[8];
#pragma unroll
                for (int j = 0; j < 8; ++j) x[j] = v[j] * r * (qk == 0 ? gq[j] : gk[j]);
#pragma unroll
                for (int j = 0; j < 8; ++j) { const float px = __shfl_xor(x[j], 2);
                    o8[j] = !isr ? x[j] : (hi2 ? px * sn[j] + x[j] * cs[j] : x[j] * cs[j] - px * sn[j]); }
                if (act) *(u32x4*)((qk == 0 ? Qh : Kh) + orow * 96 + 8 * ch) = pack8(o8);
            }
            if (ch < 8) *(u32x4*)(Vh + orow * 64 + 8 * ch) = cur.v[pass];
        }
        cur = nxt;
    }
}

constexpr int KROW = 208, VROW = 160;
constexpr int KBUF = 128 * KROW, VBUF = 128 * VROW;
typedef short v4i16_t __attribute__((ext_vector_type(4)));
__device__ __forceinline__ void attn_chunk(LAS unsigned char* kb, LAS unsigned char* vb, const bf16x8 (&qf)[3], f32x4 (&o)[4], float& mrun, float& lrun, int fr, int g) {
    f32x4 sacc[4];
#pragma unroll
    for (int kt = 0; kt < 4; ++kt) { sacc[kt] = (f32x4){0.f, 0.f, 0.f, 0.f};
#pragma unroll
        for (int ks = 0; ks < 3; ++ks) { const bf16x8 kf = *(const LAS bf16x8*)(kb + (16 * kt + fr) * KROW + (ks * 32 + g * 8) * 2);
            sacc[kt] = __builtin_amdgcn_mfma_f32_16x16x32_bf16(kf, qf[ks], sacc[kt], 0, 0, 0); } }
    float mx = sacc[0][0];
#pragma unroll
    for (int kt = 0; kt < 4; ++kt)
#pragma unroll
        for (int r = 0; r < 4; ++r) mx = fmaxf(mx, sacc[kt][r]);
    mx = fmaxf(mx, __shfl_xor(mx, 16)); mx = fmaxf(mx, __shfl_xor(mx, 32));
    const float mnew = fmaxf(mrun, mx), alpha = __builtin_amdgcn_exp2f(mrun - mnew); mrun = mnew;
    float ps = 0.f;
#pragma unroll
    for (int kt = 0; kt < 4; ++kt)
#pragma unroll
        for (int r = 0; r < 4; ++r) { const float p = __builtin_amdgcn_exp2f(sacc[kt][r] - mnew); sacc[kt][r] = p; ps += p; }
    lrun = lrun * alpha + ps;
#pragma unroll
    for (int dt = 0; dt < 4; ++dt) o[dt] = o[dt] * alpha;
#pragma unroll
    for (int s2 = 0; s2 < 2; ++s2) {
        u32x4 pw; pw.x = pk2(sacc[2 * s2][0], sacc[2 * s2][1]); pw.y = pk2(sacc[2 * s2][2], sacc[2 * s2][3]); pw.z = pk2(sacc[2 * s2 + 1][0], sacc[2 * s2 + 1][1]); pw.w = pk2(sacc[2 * s2 + 1][2], sacc[2 * s2 + 1][3]);
        const bf16x8 pb = __builtin_bit_cast(bf16x8, pw);
#pragma unroll
        for (int dt = 0; dt < 4; ++dt) {
            LAS unsigned char* va = vb + (32 * s2 + 4 * g + (fr >> 2)) * VROW + (16 * dt + 4 * (fr & 3)) * 2;
            const v4i16_t t0 = __builtin_amdgcn_ds_read_tr16_b64_v4i16((LAS v4i16_t*)va), t1 = __builtin_amdgcn_ds_read_tr16_b64_v4i16((LAS v4i16_t*)(va + 16 * VROW));
            const bf16x8 vf = (bf16x8){t0[0], t0[1], t0[2], t0[3], t1[0], t1[1], t1[2], t1[3]};
            o[dt] = __builtin_amdgcn_mfma_f32_16x16x32_bf16(vf, pb, o[dt], 0, 0, 0); }
    }
}
__device__ __forceinline__ void attn_unit(const Ctx& c, int b, int h, int qb) {
    const bf16_t* Qh = WSP(bf16_t, WS_R4); const bf16_t* Kh = WSP(bf16_t, WS_R3); const bf16_t* Vh = WSP(bf16_t, WS_R0); bf16_t* AO = WSP(bf16_t, WS_R0 + 32 * MiB);
    const int fr = c.lane & 15, g = c.lane >> 4, wid = c.wave;
    const size_t hb = (size_t)(b * H + h) * S;
    const int q0 = qb * 128 + wid * 16;
    const int nsup = qb + 1;
    bf16x8 qf[3];
#pragma unroll
    for (int ks = 0; ks < 3; ++ks) qf[ks] = *(const bf16x8*)(Qh + (hb + q0 + fr) * 96 + ks * 32 + g * 8);
    f32x4 o[4];
#pragma unroll
    for (int dt = 0; dt < 4; ++dt) o[dt] = (f32x4){0.f, 0.f, 0.f, 0.f};
    float mrun = -1e30f, lrun = 0.f;
    u32x4 kr[3], vr[2];
    const u32x4* Ksrc = (const u32x4*)(Kh + hb * 96); const u32x4* Vsrc = (const u32x4*)(Vh + hb * 64);
#pragma unroll
    for (int i = 0; i < 3; ++i) kr[i] = Ksrc[c.tid + 512 * i];
#pragma unroll
    for (int i = 0; i < 2; ++i) vr[i] = Vsrc[c.tid + 512 * i];
    for (int j = 0; j < nsup; ++j) {
        LAS unsigned char* kb = c.lds + (j & 1) * (KBUF + VBUF); LAS unsigned char* vb = kb + KBUF;
#pragma unroll
        for (int i = 0; i < 3; ++i) { const int kc = c.tid + 512 * i; *(LAS u32x4*)(kb + (kc / 12) * KROW + (kc % 12) * 16) = kr[i]; }
#pragma unroll
        for (int i = 0; i < 2; ++i) { const int vc = c.tid + 512 * i; *(LAS u32x4*)(vb + (vc >> 3) * VROW + (vc & 7) * 16) = vr[i]; }
        __syncthreads();
        if (j + 1 < nsup) {
#pragma unroll
            for (int i = 0; i < 3; ++i) kr[i] = Ksrc[(j + 1) * 1536 + c.tid + 512 * i];
#pragma unroll
            for (int i = 0; i < 2; ++i) vr[i] = Vsrc[(j + 1) * 1024 + c.tid + 512 * i];
        }
        attn_chunk(kb, vb, qf, o, mrun, lrun, fr, g);
        if (j + 1 < nsup || wid >= 4) attn_chunk(kb + 64 * KROW, vb + 64 * VROW, qf, o, mrun, lrun, fr, g);
    }
    float lt = lrun + __shfl_xor(lrun, 16); lt += __shfl_xor(lt, 32);
    const float inv = 1.f / lt;
    bf16_t* orow = AO + ((size_t)b * S + q0 + fr) * 512 + h * 64;
#pragma unroll
    for (int dt = 0; dt < 4; ++dt) { u32x2 w; w.x = pk2(o[dt][0] * inv, o[dt][1] * inv); w.y = pk2(o[dt][2] * inv, o[dt][3] * inv); *(u32x2*)(orow + 16 * dt + 4 * g) = w; }
    __syncthreads();
}
__device__ __forceinline__ void phase_attn(const Ctx& c0) {
    Ctx c = c0; c.lane = lane_id_v(); c.tid = c.wave * 64 + c.lane;
    for (int v = c.vcu; v < 256; v += c.G) {
        const int bh = v >> 1, odd = v & 1;
        for (int i = 0; i < 8; ++i) {
            const int setA[8] = {15, 12, 10, 9, 6, 5, 3, 0}, setB[8] = {14, 13, 11, 8, 7, 4, 2, 1};
            int qb = 0;
#pragma unroll
            for (int k = 0; k < 8; ++k) if (k == i) qb = odd ? setB[k] : setA[k];
            attn_unit(c, bh >> 3, bh & 7, qb);
        }
    }
}

__device__ __forceinline__ float wave_max(float v) {
#pragma unroll
    for (int o = 1; o < 64; o <<= 1) v = fmaxf(v, __shfl_xor(v, o));
    return v;
}
__device__ __forceinline__ int wave_min_i(int v) {
#pragma unroll
    for (int o = 1; o < 64; o <<= 1) v = min(v, __shfl_xor(v, o));
    return v;
}
__device__ __forceinline__ int prefix_cnt(unsigned long long m) { return (int)__builtin_amdgcn_mbcnt_hi((unsigned)(m >> 32), __builtin_amdgcn_mbcnt_lo((unsigned)m, 0u)); }
template <int NV, int NBITS> __device__ __forceinline__ void select16(const unsigned (&key)[NV], int (&slot)[NV]) {
    unsigned tau = 0u;
    for (int bit = NBITS - 1; bit >= 0; --bit) {
        const unsigned trial = tau | (1u << bit); int cnt = 0;
#pragma unroll
        for (int j = 0; j < NV; ++j) cnt += __popcll(__ballot(key[j] >= trial));
        if (cnt >= 16) { tau = trial; if (cnt == 16) break; }
    }
    int base = 0;
#pragma unroll
    for (int j = 0; j < NV; ++j) { const unsigned long long m = __ballot(key[j] > tau); slot[j] = (key[j] > tau) ? base + prefix_cnt(m) : -1; base += __popcll(m); }
#pragma unroll
    for (int j = 0; j < NV; ++j) { const unsigned long long m = __ballot(key[j] == tau); if (key[j] == tau) { const int s = base + prefix_cnt(m); slot[j] = s < 16 ? s : -1; } base += __popcll(m); }
}
template <int N> __device__ __forceinline__ void bitonic_stage_desc(unsigned (&x)[N], int k, int j) {
#pragma unroll
    for (int i = 0; i < N; ++i) { const int l = i ^ j; if (l > i) { const bool asc = ((i & k) != 0);
        const unsigned a = x[i], b = x[l]; const unsigned hi = a > b ? a : b, lo = a > b ? b : a; x[i] = asc ? lo : hi; x[l] = asc ? hi : lo; } }
}
__device__ __forceinline__ void sort16_desc(unsigned (&x)[16]) {
#pragma unroll
    for (int k = 2; k <= 16; k <<= 1)
#pragma unroll
        for (int j = k >> 1; j > 0; j >>= 1) bitonic_stage_desc<16>(x, k, j);
}
__device__ __forceinline__ void merge16_desc(unsigned (&run)[16], const unsigned (&ch)[16]) {
#pragma unroll
    for (int i = 0; i < 16; ++i) run[i] = run[i] > ch[15 - i] ? run[i] : ch[15 - i];
#pragma unroll
    for (int j = 8; j > 0; j >>= 1) bitonic_stage_desc<16>(run, 16, j);
}
__device__ __forceinline__ unsigned mono_hi(unsigned w) { return w ^ ((unsigned)((int)w >> 31) | 0x80000000u); }
__device__ __forceinline__ float demono_hi(unsigned k) { const unsigned kk = k & 0xffff0000u; return __builtin_bit_cast(float, (kk ^ ((unsigned)(~(int)kk >> 31) | 0x80000000u)) & 0xffff0000u); }
__device__ __forceinline__ void top16_list(const bf16_t* s, unsigned (&run)[16]) {
#pragma unroll
    for (int ck = 0; ck < 8; ++ck) {
        const u32x4 w0 = *(const u32x4*)(s + ck * 16), w1 = *(const u32x4*)(s + ck * 16 + 8);
        const unsigned w[8] = {w0.x, w0.y, w0.z, w0.w, w1.x, w1.y, w1.z, w1.w};
        unsigned ch[16];
#pragma unroll
        for (int i = 0; i < 8; ++i) { ch[2 * i] = (mono_hi(w[i] << 16) & 0xffff0000u) | (unsigned)(ck * 16 + 2 * i); ch[2 * i + 1] = (mono_hi(w[i]) & 0xffff0000u) | (unsigned)(ck * 16 + 2 * i + 1); }
        sort16_desc(ch);
        if (ck == 0) {
#pragma unroll
            for (int i = 0; i < 16; ++i) run[i] = ch[i];
        } else merge16_desc(run, ch);
    }
}
__device__ __forceinline__ void phase_topk(const Ctx& c0) {
    Ctx c = c0; c.lane = lane_id_v(); c.tid = c.wave * 64 + c.lane;
    const bf16_t* sc = WSP(bf16_t, WS_SC); int* IDX = WSP(int, WS_IDX); float* GW = WSP(float, WS_GW);
    const int gl = (c.vcu * 8 + c.wave) * 64 + c.lane, NL = c.G * 512;
    for (int e = gl; e < T * H; e += NL) {
        unsigned ka[16], kb[16];
        top16_list(sc + (size_t)e * 256, ka);
        top16_list(sc + (size_t)e * 256 + 128, kb);
        float sa[16], sb[16]; unsigned ia[16], ib[16];
#pragma unroll
        for (int i = 0; i < 16; ++i) { sa[i] = demono_hi(ka[i]); sb[i] = demono_hi(kb[i]); ia[i] = (ka[i] & 0x7fu) << 7; ib[i] = kb[i] & 0x7fu; }
        const float mx = sa[0] + sb[0];
        unsigned run[16], ch[16]; int n = 0, nc = 0;
#pragma unroll
        for (int a = 0; a < 16; ++a)
#pragma unroll
            for (int b = 0; b < 16; ++b) if ((a + 1) * (b + 1) <= 16) {
                const int k = 65535 + (int)((sa[a] + sb[b] - mx) * 1024.f);
                ch[n] = ((unsigned)(k < 0 ? 0 : k) << 16) | ia[a] | ib[b];
                if (++n == 16) { sort16_desc(ch); if (nc == 0) {
#pragma unroll
                        for (int i = 0; i < 16; ++i) run[i] = ch[i]; } else merge16_desc(run, ch);
                    n = 0; ++nc; }
            }
#pragma unroll
        for (int i = 2; i < 16; ++i) ch[i] = 0u;
        sort16_desc(ch); merge16_desc(run, ch);
        float ex[16]; float sum = 0.f;
#pragma unroll
        for (int i = 0; i < 16; ++i) { ex[i] = __expf((float)((int)(run[i] >> 16) - 65535) * (1.f / 1024.f)); sum += ex[i]; }
        const float inv = 1.f / sum;
        u32x4* oi = (u32x4*)(IDX + (size_t)e * 16); f32x4* og = (f32x4*)(GW + (size_t)e * 16);
#pragma unroll
        for (int q = 0; q < 4; ++q) { u32x4 vi; vi.x = run[4 * q] & 0x3fffu; vi.y = run[4 * q + 1] & 0x3fffu; vi.z = run[4 * q + 2] & 0x3fffu; vi.w = run[4 * q + 3] & 0x3fffu; oi[q] = vi;
            f32x4 vg; vg.x = ex[4 * q] * inv; vg.y = ex[4 * q + 1] * inv; vg.z = ex[4 * q + 2] * inv; vg.w = ex[4 * q + 3] * inv; og[q] = vg; }
    }
}

__device__ __forceinline__ void dec32_fp4(const u32x4 r, f32x2 (&f)[16]) {
    const unsigned w[4] = {r.x, r.y, r.z, r.w};
#pragma unroll
    for (int i = 0; i < 4; ++i) { f[4 * i] = __builtin_amdgcn_cvt_scalef32_pk_f32_fp4(w[i], 1.0f, 0); f[4 * i + 1] = __builtin_amdgcn_cvt_scalef32_pk_f32_fp4(w[i], 1.0f, 1);
        f[4 * i + 2] = __builtin_amdgcn_cvt_scalef32_pk_f32_fp4(w[i], 1.0f, 2); f[4 * i + 3] = __builtin_amdgcn_cvt_scalef32_pk_f32_fp4(w[i], 1.0f, 3); }
}
__device__ __forceinline__ float dot32_fp4(const f32x2 (&hv)[16], const u32x4 r) {
    f32x2 f[16]; dec32_fp4(r, f); f32x2 s = hv[0] * f[0];
#pragma unroll
    for (int j = 1; j < 16; ++j) s = s + hv[j] * f[j];
    return s.x + s.y;
}
typedef int i32x8 __attribute__((ext_vector_type(8)));
__device__ __forceinline__ void phase_peer_u(const Ctx& c0) {
    Ctx c = c0; c.lane = lane_id_v(); c.tid = c.wave * 64 + c.lane;
    const int* IDX = WSP(int, WS_IDX);
    const int L = c.lane, pp = blockIdx.x & 3, hh = (blockIdx.x >> 2) & 1, rank = blockIdx.x >> 3, nrank = c.G >> 3;
    LAS int* mb = (LAS int*)(c.lds + c.wave * 1024);
    const int vr = L & 15, g4 = L >> 4;
    const unsigned char* EU4b = c.ws + WS_EU + (size_t)pp * NE * 128;
    const unsigned char* H8 = c.ws + WS_H2Q + pp * 256 + (vr & 1) * 128 + g4 * 16;
    float* PD = WSP(float, WS_PD) + (size_t)(2 * pp + (vr & 1)) * T * 128 + 2 * g4;
    const int t0 = 2 * (rank * 8 + c.wave) + hh, ts = 2 * nrank * 8;
    if (t0 >= T) return;
    int sc1 = 0x7f7f7f7f; asm volatile("" : "+v"(sc1));
    const bool swapb = WSP(unsigned, WS_C8SP)[1024] != 0u;
    { const int g0 = IDX[(size_t)t0 * 128 + L], g1 = IDX[(size_t)t0 * 128 + 64 + L]; mb[L] = g0; mb[64 + L] = g1; }
    u32x4 rA[16], rB[16];
    { const unsigned char* EU4 = EU4b + (vr & 1) * 64 + g4 * 16;
#pragma unroll
      for (int G = 0; G < 16; ++G) rA[G] = *(const u32x4*)(EU4 + (size_t)mb[8 * G + (vr >> 1)] * 128); }
    int cur = 0;
#define PEER_U_TOKEN(RC, RN, tcur, tnext, tnext2) do { \
        int lo = (vr & 1) * 64 + g4 * 16; asm volatile("" : "+v"(lo)); const unsigned char* EU4 = EU4b + lo; \
        const int gn0 = IDX[(size_t)(tnext2) * 128 + L], gn1 = IDX[(size_t)(tnext2) * 128 + 64 + L]; \
        i32x8 hb = (i32x8){0, 0, 0, 0, 0, 0, 0, 0}; \
        if (vr < 2) { const u32x4 h0 = *(const u32x4*)(H8 + (size_t)(tcur) * 1024), h1 = *(const u32x4*)(H8 + (size_t)(tcur) * 1024 + 64); \
            unsigned hw[8] = {h0.x, h0.y, h0.z, h0.w, h1.x, h1.y, h1.z, h1.w}; \
            if (swapb) { _Pragma("unroll") for (int q = 0; q < 8; ++q) hw[q] = ((hw[q] & 0x00ff00ffu) << 8) | ((hw[q] >> 8) & 0x00ff00ffu); } \
            hb = (i32x8){(int)hw[0], (int)hw[1], (int)hw[2], (int)hw[3], (int)hw[4], (int)hw[5], (int)hw[6], (int)hw[7]}; } \
          \
        _Pragma("unroll") for (int G = 0; G < 16; ++G) RN[G] = *(const u32x4*)(EU4 + (size_t)mb[(cur ^ 1) * 128 + 8 * G + (vr >> 1)] * 128); \
          \
        mb[cur * 128 + L] = gn0; mb[cur * 128 + 64 + L] = gn1; \
        f32x4 acc[16]; \
        _Pragma("unroll") for (int G = 0; G < 16; ++G) { const i32x8 a = (i32x8){(int)RC[G].x, (int)RC[G].y, (int)RC[G].z, (int)RC[G].w, 0, 0, 0, 0}; \
            acc[G] = __builtin_amdgcn_mfma_scale_f32_16x16x128_f8f6f4(a, hb, (f32x4){0.f, 0.f, 0.f, 0.f}, 4, 0, 0, sc1, 0, sc1); } \
        if (vr < 2) { _Pragma("unroll") for (int G = 0; G < 16; ++G) { f32x2 o; o.x = vr ? acc[G][1] : acc[G][0]; o.y = vr ? acc[G][3] : acc[G][2]; *(f32x2*)(PD + (size_t)(tcur) * 128 + 8 * G) = o; } } \
        cur ^= 1; } while (0)
    { const int t1 = (t0 + ts < T) ? t0 + ts : t0; const int g0 = IDX[(size_t)t1 * 128 + L], g1 = IDX[(size_t)t1 * 128 + 64 + L]; mb[128 + L] = g0; mb[128 + 64 + L] = g1; }
#pragma unroll 1
    for (int t = t0; t < T; t += 2 * ts) {
        const int ta = t, tb = (t + ts < T) ? t + ts : t, tc = (t + 2 * ts < T) ? t + 2 * ts : tb, td = (t + 3 * ts < T) ? t + 3 * ts : tc;
        PEER_U_TOKEN(rA, rB, ta, tb, tc);
        if (t + ts < T) PEER_U_TOKEN(rB, rA, tb, tc, td);
    }
#undef PEER_U_TOKEN
}
__device__ __forceinline__ void phase_peer_fin(const Ctx& c0) {
    Ctx c = c0; c.lane = lane_id_v(); c.tid = c.wave * 64 + c.lane;
    const int* IDX = WSP(int, WS_IDX); const float* GW = WSP(float, WS_GW); const float* PD = WSP(float, WS_PD); unsigned* WGT = WSP(unsigned, WS_WGT);
    const float* SU = WSP(float, WS_SU); const float* SV = WSP(float, WS_SV); const float* SH = WSP(float, WS_SH);
#pragma unroll 4
    for (int i = c.vcu * 512 + c.tid; i < T * 128; i += c.G * 512) {
        float d = 0.f;
#pragma unroll
        for (int p = 0; p < 8; ++p) d += PD[(size_t)p * T * 128 + i];
        const int e = IDX[i];
        WGT[i] = (f2bf(GW[i] * gelu_tanh(d * SU[e] * SH[i >> 7]) * SV[e]) << 16) | (unsigned)e;
    }
}
template <bool DRY> __device__ __forceinline__ void phase_peer_v(const Ctx& c0) {
    Ctx c = c0; c.lane = lane_id_v(); c.tid = c.wave * 64 + c.lane;
    const unsigned* WI = WSP(unsigned, WS_WGT); const float* mod = WSP(float, WS_MOD);
    const int L = c.lane, pp = blockIdx.x & 3, hh = (blockIdx.x >> 2) & 1, rank = blockIdx.x >> 3, nrank = c.G >> 3;
    const bool b5 = L & 32, b4 = L & 16, b3 = L & 8;
    LAS unsigned* mb = (LAS unsigned*)(c.lds + c.wave * 1024);
    const int kl = L >> 3;
    const unsigned char* EV4 = c.ws + WS_EV + (size_t)pp * NE * 128 + (L & 7) * 16;
    const int col = pp * 256 + (L & 7) * 32 + (b5 ? 16 : 0) + (b4 ? 8 : 0) + (b3 ? 4 : 0);
    const int t0 = 2 * (rank * 8 + c.wave) + hh, ts = 2 * nrank * 8;
    if (t0 >= T) return;
    { const unsigned g0 = WI[(size_t)t0 * 128 + L], g1 = WI[(size_t)t0 * 128 + 64 + L]; mb[L] = g0; mb[64 + L] = g1; }
    u32x4 rA[8], rB[8];
#pragma unroll
    for (int i = 0; i < 8; ++i) rA[i] = *(const u32x4*)(EV4 + (size_t)(mb[8 * i + kl] & 0xffffu) * 128);
    int cur = 0;
#pragma unroll 1
    for (int t = t0; t < T; t += ts) {
        const int tn = (t + ts < T) ? t + ts : t;
        const unsigned gn0 = WI[(size_t)tn * 128 + L], gn1 = WI[(size_t)tn * 128 + 64 + L];
        float* o = c.out + (size_t)t * 1024 + col; const float* g2 = mod + (t >> 11) * 6144 + 5120 + col;
        f32x4 xo = *(const f32x4*)o; const f32x4 gt = *(const f32x4*)g2;
#pragma unroll
        for (int i = 0; i < 8; ++i) rB[i] = *(const u32x4*)(EV4 + (size_t)(mb[cur * 128 + 64 + 8 * i + kl] & 0xffffu) * 128);
        f32x2 ac2[16];
#pragma unroll
        for (int j = 0; j < 16; ++j) ac2[j] = (f32x2){0.f, 0.f};
#pragma unroll
        for (int i = 0; i < 8; ++i) { const float w = bfhi(mb[cur * 128 + 8 * i + kl]); const f32x2 w2 = {w, w}; f32x2 f[16]; dec32_fp4(rA[i], f);
#pragma unroll
            for (int j = 0; j < 16; ++j) ac2[j] = ac2[j] + f[j] * w2; }
        mb[(cur ^ 1) * 128 + L] = gn0; mb[(cur ^ 1) * 128 + 64 + L] = gn1;
#pragma unroll
        for (int i = 0; i < 8; ++i) rA[i] = *(const u32x4*)(EV4 + (size_t)(mb[(cur ^ 1) * 128 + 8 * i + kl] & 0xffffu) * 128);
#pragma unroll
        for (int i = 0; i < 8; ++i) { const float w = bfhi(mb[cur * 128 + 64 + 8 * i + kl]); const f32x2 w2 = {w, w}; f32x2 f[16]; dec32_fp4(rB[i], f);
#pragma unroll
            for (int j = 0; j < 16; ++j) ac2[j] = ac2[j] + f[j] * w2; }
        float acc[32];
#pragma unroll
        for (int j = 0; j < 16; ++j) { acc[2 * j] = ac2[j].x; acc[2 * j + 1] = ac2[j].y; }
        float n16[16], n8[8], n4[4];
#pragma unroll
        for (int i = 0; i < 16; ++i) { const float send = b5 ? acc[i] : acc[i + 16], keep = b5 ? acc[i + 16] : acc[i]; n16[i] = keep + __shfl_xor(send, 32); }
#pragma unroll
        for (int i = 0; i < 8; ++i) { const float send = b4 ? n16[i] : n16[i + 8], keep = b4 ? n16[i + 8] : n16[i]; n8[i] = keep + __shfl_xor(send, 16); }
#pragma unroll
        for (int i = 0; i < 4; ++i) { const float send = b3 ? n8[i] : n8[i + 4], keep = b3 ? n8[i + 4] : n8[i]; n4[i] = keep + __shfl_xor(send, 8); }
        xo.x += gt.x * n4[0]; xo.y += gt.y * n4[1]; xo.z += gt.z * n4[2]; xo.w += gt.w * n4[3];
        if (DRY) asm volatile("" :: "v"(xo.x), "v"(xo.y), "v"(xo.z), "v"(xo.w)); else *(f32x4*)o = xo;
        cur ^= 1;
    }
}

struct ENone {};
struct FInProj { static constexpr int NB = 4; bf16_t *pa, *lx, *lg, *mg; typedef ENone Tile; typedef ENone Pre;
    __device__ __forceinline__ Tile tile(int, int, int) const { return Tile{}; }
    __device__ __forceinline__ Pre pre(int, int, int) const { return Pre{}; }
    __device__ __forceinline__ void apply(int row, int pn, int cc, const float (&v0)[8], const float (&v1)[8], const Pre&, const Tile&) const {
        bf16_t* d;
        if (pn < 2) d = pa + (size_t)row * 512 + pn * 256 + cc; else if (pn < 6) d = lx + (size_t)row * 1024 + (pn - 2) * 256 + cc;
        else if (pn < 10) d = lg + (size_t)row * 1024 + (pn - 6) * 256 + cc; else d = mg + (size_t)row * 2048 + (pn - 10) * 256 + cc;
        *(u32x4*)d = pack8(v0); *(u32x4*)(d + 128) = pack8(v1); } };
struct FRowScale { static constexpr int NB = 4; bf16_t* dst; int ldc; const float* rstd; int which; typedef ENone Tile; struct Pre { float r; };
    __device__ __forceinline__ Tile tile(int, int, int) const { return Tile{}; }
    __device__ __forceinline__ Pre pre(int row, int, int) const { return Pre{rstd[2 * row + which]}; }
    __device__ __forceinline__ void apply(int row, int pn, int cc, const float (&v0)[8], const float (&v1)[8], const Pre& p, const Tile&) const {
        float a[8], b[8];
#pragma unroll
        for (int j = 0; j < 8; ++j) { a[j] = v0[j] * p.r; b[j] = v1[j] * p.r; }
        *(u32x4*)(dst + (size_t)row * ldc + pn * 256 + cc) = pack8(a); *(u32x4*)(dst + (size_t)row * ldc + pn * 256 + 128 + cc) = pack8(b); } };
constexpr int GT_OFF = 132096;
struct FGates { static constexpr int NB = 2; const bf16_t* xc; bf16_t *LA, *Bv; LAS const float* gt;
    typedef ENone Tile; struct Pre { u32x4 x; };
    __device__ __forceinline__ Tile tile(int, int, int) const { return Tile{}; }
    __device__ __forceinline__ Pre pre(int row, int pn, int cc) const { return Pre{*(const u32x4*)(xc + (size_t)row * 1024 + pn * 128 + cc)}; }
    __device__ __forceinline__ void apply(int row, int pn, int cc, const float (&v0)[8], const float (&v1)[8], const Pre& p, const Tile&) const {
        const int ch = pn * 128 + cc; float x[8], la[8], bv[8]; unpack8(p.x, x);
        const f32x4 br0 = *(LAS const f32x4*)(gt + ch), br1 = *(LAS const f32x4*)(gt + ch + 4), bi0 = *(LAS const f32x4*)(gt + 1024 + ch), bi1 = *(LAS const f32x4*)(gt + 1024 + ch + 4),
                    c80 = *(LAS const f32x4*)(gt + 2048 + ch), c81 = *(LAS const f32x4*)(gt + 2048 + ch + 4);
        const float br[8] = {br0.x, br0.y, br0.z, br0.w, br1.x, br1.y, br1.z, br1.w}, bi[8] = {bi0.x, bi0.y, bi0.z, bi0.w, bi1.x, bi1.y, bi1.z, bi1.w}, c8[8] = {c80.x, c80.y, c80.z, c80.w, c81.x, c81.y, c81.z, c81.w};
#pragma unroll
        for (int j = 0; j < 8; ++j) {
            const float r = __builtin_amdgcn_rcpf(1.f + __expf(-(v0[j] + br[j]))), ig = __builtin_amdgcn_rcpf(1.f + __expf(-(v1[j] + bi[j])));
            const float loga = r * c8[j];
            const float z = 2.f * loga;
            const float ser = -z * (1.f + z * (0.5f + z * (0.16666667f + z * (0.041666668f + z * (0.008333334f + z * 0.0013888889f)))));
            const float om = (z > -0.25f) ? ser : (1.f - __expf(z));
            la[j] = loga * 1.4426950408889634f;
            bv[j] = sqrtf(om) * (ig * x[j]);
        }
        *(u32x4*)(LA + (size_t)row * 1024 + ch) = pack8(la); *(u32x4*)(Bv + (size_t)row * 1024 + ch) = pack8(bv); } };
struct FY1 { static constexpr int NB = 4; const bf16_t* mg; bf16_t* y; int goff; bool accum; typedef ENone Tile; struct Pre { u32x4 g0, g1, y0, y1; };
    __device__ __forceinline__ Tile tile(int, int, int) const { return Tile{}; }
    __device__ __forceinline__ Pre pre(int row, int pn, int cc) const { Pre p; const int col = pn * 256 + cc;
        p.g0 = *(const u32x4*)(mg + (size_t)row * 2048 + goff + col); p.g1 = *(const u32x4*)(mg + (size_t)row * 2048 + goff + col + 128);
        if (accum) { p.y0 = *(const u32x4*)(y + (size_t)row * 1024 + col); p.y1 = *(const u32x4*)(y + (size_t)row * 1024 + col + 128); } else { p.y0 = (u32x4){0u, 0u, 0u, 0u}; p.y1 = p.y0; }
        return p; }
    __device__ __forceinline__ void one(bf16_t* dst, const u32x4 g, const u32x4 yo, const float (&v)[8]) const {
        float gt[8], o[8]; unpack8(g, gt); unpack8(yo, o);
#pragma unroll
        for (int j = 0; j < 8; ++j) o[j] = o[j] + sigmoidf_(gt[j]) * v[j];
        *(u32x4*)dst = pack8(o); }
    __device__ __forceinline__ void apply(int row, int pn, int cc, const float (&v0)[8], const float (&v1)[8], const Pre& p, const Tile&) const {
        bf16_t* d = y + (size_t)row * 1024 + pn * 256 + cc; one(d, p.g0, p.y0, v0); one(d + 128, p.g1, p.y1, v1); } };
struct FX1 { static constexpr int NB = 4; const float* x; float* out; const float* mod; struct Tile { f32x4 a[4]; }; struct Pre { f32x4 x[4]; };
    __device__ __forceinline__ Tile tile(int pn, int cc, int pm) const { Tile t; const float* g1 = mod + ((pm * 256) >> 11) * 6144 + 2048 + pn * 256 + cc;
        t.a[0] = *(const f32x4*)g1; t.a[1] = *(const f32x4*)(g1 + 4); t.a[2] = *(const f32x4*)(g1 + 128); t.a[3] = *(const f32x4*)(g1 + 132); return t; }
    __device__ __forceinline__ Pre pre(int row, int pn, int cc) const { Pre p; const float* xr = x + (size_t)row * 1024 + pn * 256 + cc;
        p.x[0] = *(const f32x4*)xr; p.x[1] = *(const f32x4*)(xr + 4); p.x[2] = *(const f32x4*)(xr + 128); p.x[3] = *(const f32x4*)(xr + 132); return p; }
    __device__ __forceinline__ void apply(int row, int pn, int cc, const float (&v0)[8], const float (&v1)[8], const Pre& p, const Tile& t) const {
        float* o = out + (size_t)row * 1024 + pn * 256 + cc;
        f32x4 r0, r1, r2, r3;
        r0.x = p.x[0].x + t.a[0].x * v0[0]; r0.y = p.x[0].y + t.a[0].y * v0[1]; r0.z = p.x[0].z + t.a[0].z * v0[2]; r0.w = p.x[0].w + t.a[0].w * v0[3];
        r1.x = p.x[1].x + t.a[1].x * v0[4]; r1.y = p.x[1].y + t.a[1].y * v0[5]; r1.z = p.x[1].z + t.a[1].z * v0[6]; r1.w = p.x[1].w + t.a[1].w * v0[7];
        r2.x = p.x[2].x + t.a[2].x * v1[0]; r2.y = p.x[2].y + t.a[2].y * v1[1]; r2.z = p.x[2].z + t.a[2].z * v1[2]; r2.w = p.x[2].w + t.a[2].w * v1[3];
        r3.x = p.x[3].x + t.a[3].x * v1[4]; r3.y = p.x[3].y + t.a[3].y * v1[5]; r3.z = p.x[3].z + t.a[3].z * v1[6]; r3.w = p.x[3].w + t.a[3].w * v1[7];
        *(f32x4*)o = r0; *(f32x4*)(o + 4) = r1; *(f32x4*)(o + 128) = r2; *(f32x4*)(o + 132) = r3; } };
struct FStore { static constexpr int NB = 4; bf16_t* dst; int ldc; typedef ENone Tile; typedef ENone Pre;
    __device__ __forceinline__ Tile tile(int, int, int) const { return Tile{}; }
    __device__ __forceinline__ Pre pre(int, int, int) const { return Pre{}; }
    __device__ __forceinline__ void apply(int row, int pn, int cc, const float (&v0)[8], const float (&v1)[8], const Pre&, const Tile&) const {
        *(u32x4*)(dst + (size_t)row * ldc + pn * 256 + cc) = pack8(v0); *(u32x4*)(dst + (size_t)row * ldc + pn * 256 + 128 + cc) = pack8(v1); } };

template <int M, int N, int K, int LDA, int ACS, class F> __device__ __forceinline__ void run_gemm(const Ctx& c, const bf16_t* A, const bf16_t* Bt, const F& f) {
    pg8::Gemm g{A, Bt}; pg8::StaticOrder<M, N> So; So.init(c.G, (int)blockIdx.x);
    pg8::EpiF<F> E{f};
    pg8::gemm_phase<K, LDA, ACS, pg8::EpiF<F>, pg8::StaticOrder<M, N>>((PG8_LAS unsigned char*)c.lds, g, So, E, c.wave * 64 + lane_id_v());
}

__global__ void __launch_bounds__(512, 2) mk_fwd(Args args) {
    extern __shared__ __attribute__((aligned(16))) unsigned char lds_raw[];
    Ctx c;
    c.lds = (LAS unsigned char*)lds_raw;
    c.wave = __builtin_amdgcn_readfirstlane(threadIdx.x >> 6); c.lane = lane_id_v(); c.tid = c.wave * 64 + c.lane;
    c.G = gridDim.x; { const int bx = blockIdx.x; c.vcu = (c.G % 8 == 0) ? (bx % 8) * (c.G / 8) + bx / 8 : bx; }
    c.in = args.in; c.out = args.out; c.ws = args.ws;
    volatile LAS unsigned* MISC = (volatile LAS unsigned*)(c.lds + MISC_OFF);
    if (c.tid < 32) MISC[c.tid] = 0u;
    __syncthreads();
    XcdBarrier bar; bar.bar = (unsigned*)(c.ws + WS_CTL) + 4096; bar.x = 0; bar.st = nullptr;
    if (args.ph_hi - args.ph_lo > 1) bar = xcd_barrier_post((unsigned*)(c.ws + WS_CTL) + 4096, MISC + 8);

    const int lo = args.ph_lo, hi = args.ph_hi;
#ifndef ONLYP
#define ONLYP -1
#endif
#define IN(k) (lo <= (k) && (k) < hi && (ONLYP < 0 || ONLYP == (k)))
#define SEAM(k) do { if ((k) + 1 < hi) xcd_barrier(bar, c.wave); } while (0)
#ifndef REPEAT_MASK
#define REPEAT_MASK 0
#endif
#define PHASE(k, ...) if (IN(k)) { c.lane = lane_id_v(); c.tid = c.wave * 64 + c.lane; { __VA_ARGS__ } if ((REPEAT_MASK >> (k)) & 1) { xcd_barrier(bar, c.wave); { __VA_ARGS__ } } SEAM(k); }
    PHASE(0, phase_prep(c);)
    PHASE(1, phase_modnorm<false>(c, c.in[I_X], c.in[I_N1G], 0, 1024, WSP(bf16_t, WS_R0));)
    PHASE(2, FInProj f{WSP(bf16_t, WS_R1), WSP(bf16_t, WS_R2), WSP(bf16_t, WS_R3), (bf16_t*)c.out};
             run_gemm<T, 4608, 1024, 1024, 0>(c, WSP(bf16_t, WS_R0), WSP(bf16_t, WS_WIN), f);)
    PHASE(3, phase_conv(c);)
    PHASE(4, { LAS float* gtl = (LAS float*)(c.lds + GT_OFF);
               for (int e = c.tid; e < 1024; e += 512) { gtl[e] = c.in[I_BRG][e]; gtl[1024 + e] = c.in[I_BIG][e]; gtl[2048 + e] = WSP(float, WS_C8SP)[e]; }
               __syncthreads();
               FGates fg{WSP(bf16_t, WS_R4), WSP(bf16_t, WS_R0), WSP(bf16_t, WS_R6), gtl};
               run_gemm<T, 2048, 128, 1024, 128>(c, WSP(bf16_t, WS_R4), WSP(bf16_t, WS_WG), fg); }
             { FRowScale fq{WSP(bf16_t, WS_R5), 768, WSP(float, WS_RSTD), 0};
               run_gemm<T, 768, 256, 512, 0>(c, WSP(bf16_t, WS_R1), WSP(bf16_t, WS_WUQ), fq); })
    PHASE(5, { FRowScale fkv{WSP(bf16_t, WS_R2), 1024, WSP(float, WS_RSTD), 1};
               run_gemm<T, 1024, 128, 512, 0>(c, WSP(bf16_t, WS_R1) + 256, WSP(bf16_t, WS_WUKV), fkv); }
             phase_scan(c);)
    PHASE(6, phase_qkv_layout(c);)
    PHASE(7, phase_attn(c);)
    PHASE(8, { FY1 f1{(const bf16_t*)c.out, WSP(bf16_t, WS_R2), 0, false};
               run_gemm<T, 1024, 512, 512, 0>(c, WSP(bf16_t, WS_R0 + 32 * MiB), WSP(bf16_t, WS_WOA), f1); }
             { FY1 f2{(const bf16_t*)c.out, WSP(bf16_t, WS_R2), 1024, true};
               run_gemm<T, 1024, 1024, 1024, 0>(c, WSP(bf16_t, WS_R6), WSP(bf16_t, WS_WOL), f2); })
    PHASE(9, FX1 f{c.in[I_X], c.out, WSP(float, WS_MOD)};
             run_gemm<T, 1024, 1024, 1024, 0>(c, WSP(bf16_t, WS_R2), WSP(bf16_t, WS_WOUT), f);)
    PHASE(10, phase_modnorm<true>(c, c.out, c.in[I_N2G], 3072, 4096, WSP(bf16_t, WS_R0));)
    PHASE(11, FStore f{WSP(bf16_t, WS_SC), 2048};
              run_gemm<T, 2048, 1024, 1024, 0>(c, WSP(bf16_t, WS_R0), WSP(bf16_t, WS_WQ), f);)
    PHASE(13, phase_topk(c);)
    PHASE(14, phase_peer_u(c);)
    PHASE(15, phase_peer_fin(c);)
#ifdef PROBE_VDRY
    if (IN(16)) { c.lane = lane_id_v(); c.tid = c.wave * 64 + c.lane; phase_peer_v<true>(c); xcd_barrier(bar, c.wave); }
#endif
    PHASE(16, phase_peer_v<false>(c);)
#undef PHASE
#undef IN
#undef SEAM
}

extern "C" void kernel_launch(void* const* d_in, const int* in_sizes, int n_in, void* d_out, int out_size, void* d_ws, size_t ws_size, hipStream_t stream) {
    static int grid = 0;
    if (grid == 0) {
        if (n_in != 28 || out_size != T * D || ws_size < WS_END) { fprintf(stderr, "kernel_launch: unexpected shapes (n_in %d out %d ws %zu)\n", n_in, out_size, ws_size); grid = -1; return; }
        int dev = 0, cus = 0, per_cu = 0;
        if (hipGetDevice(&dev) != hipSuccess || hipDeviceGetAttribute(&cus, hipDeviceAttributeMultiprocessorCount, dev) != hipSuccess) { grid = -1; return; }
        if (hipFuncSetAttribute((const void*)mk_fwd, hipFuncAttributeMaxDynamicSharedMemorySize, LDS_BYTES) != hipSuccess) { fprintf(stderr, "kernel_launch: hipFuncSetAttribute failed\n"); grid = -1; return; }
        if (hipOccupancyMaxActiveBlocksPerMultiprocessor(&per_cu, (const void*)mk_fwd, 512, LDS_BYTES) != hipSuccess || per_cu < 1) { fprintf(stderr, "kernel_launch: occupancy query says %d blocks per CU\n", per_cu); grid = -1; (void)hipGetLastError(); return; }
        grid = cus - (cus % 8);
        if (grid < 8) { fprintf(stderr, "kernel_launch: needs at least 8 CUs\n"); grid = -1; return; }
    }
    if (grid < 0) return;
    (void)hipMemsetAsync((char*)d_ws + WS_CTL, 0, CTL_ZERO_BYTES, stream);
    Args a{};
    for (int i = 0; i < 28; ++i) a.in[i] = (const float*)d_in[i];
    a.out = (float*)d_out; a.ws = (unsigned char*)d_ws;
#if MK_N_LAUNCHES == 1
    a.ph_lo = 0; a.ph_hi = N_PHASES;
    hipLaunchKernelGGL(mk_fwd, dim3(grid), dim3(512), LDS_BYTES, stream, a);
#else
    for (int ph = 0; ph < N_PHASES; ++ph) { a.ph_lo = ph; a.ph_hi = ph + 1; hipLaunchKernelGGL(mk_fwd, dim3(grid), dim3(512), LDS_BYTES, stream, a); }
#endif
}
```

```cpp
#include <hip/hip_runtime.h>
#include <cstdio>
#include <cstdint>

#define LAS __attribute__((address_space(3)))
#define GAS __attribute__((address_space(1)))
typedef unsigned short bf16_t;
typedef short bf16x8 __attribute__((ext_vector_type(8)));
typedef float f32x4 __attribute__((ext_vector_type(4)));
typedef float f32x2 __attribute__((ext_vector_type(2)));
typedef unsigned u32x4 __attribute__((ext_vector_type(4)));
typedef unsigned u32x2 __attribute__((ext_vector_type(2)));

#ifndef MK_N_LAUNCHES
#define MK_N_LAUNCHES 1
#endif

constexpr int T = 32768, D = 1024, NB_ = 16, S = 2048, H = 8;
constexpr int QKH = 96, VH = 64;
constexpr int NE = 16384;
constexpr float EPS = 1e-6f;

constexpr size_t MiB = 1u << 20;
constexpr size_t WS_CTL = 0, CTL_ZERO_BYTES = 65536;
constexpr size_t WS_MOD = 1 * MiB;
constexpr size_t WS_RSTD = 1 * MiB + 512 * 1024;
constexpr size_t WS_C8SP = 1 * MiB + 448 * 1024;
constexpr size_t WS_WIN = 2 * MiB;
constexpr size_t WS_WUQ = 11 * MiB;
constexpr size_t WS_WUKV = 11 * MiB + 512 * 1024;
constexpr size_t WS_WOA = 12 * MiB;
constexpr size_t WS_WOL = 13 * MiB;
constexpr size_t WS_WOUT = 15 * MiB;
constexpr size_t WS_WQ = 17 * MiB;
constexpr size_t WS_WG = 21 * MiB;
constexpr size_t WS_SK = 22 * MiB;
constexpr size_t WS_EU = 24 * MiB;
constexpr size_t WS_EV = 40 * MiB;
constexpr size_t WS_SU = 1 * MiB + 768 * 1024;
constexpr size_t WS_SV = 1 * MiB + 832 * 1024;
constexpr size_t WS_WGT = 440 * MiB;
constexpr size_t WS_CS = 56 * MiB;
constexpr size_t WS_H2Q = 456 * MiB;
constexpr size_t WS_SH = 1 * MiB + 896 * 1024;
constexpr size_t WS_PD = 280 * MiB;
constexpr size_t WS_R0 = 88 * MiB;
constexpr size_t WS_R1 = 152 * MiB;
constexpr size_t WS_R2 = 184 * MiB;
constexpr size_t WS_R3 = 248 * MiB;
constexpr size_t WS_R4 = 312 * MiB;
constexpr size_t WS_R5 = 376 * MiB;
constexpr size_t WS_R6 = 424 * MiB;
constexpr size_t WS_QP = 152 * MiB;
constexpr size_t WS_SC = 280 * MiB;
constexpr size_t WS_IDX = 408 * MiB;
constexpr size_t WS_GW = 424 * MiB;
constexpr size_t WS_END = 488 * MiB;

constexpr int LDS_BYTES = 155648;
constexpr int MISC_OFF = 131072 + 320;

__device__ __forceinline__ unsigned f2bf(float f) { unsigned u = __builtin_bit_cast(unsigned, f); return (u + 0x7fffu + ((u >> 16) & 1u)) >> 16; }
typedef __bf16 bf16x2_t __attribute__((ext_vector_type(2)));
__device__ __forceinline__ unsigned pk2(float lo, float hi) { f32x2 v = {lo, hi}; return __builtin_bit_cast(unsigned, __builtin_convertvector(v, bf16x2_t)); }
__device__ __forceinline__ float bf2f(unsigned h) { return __builtin_bit_cast(float, h << 16); }
__device__ __forceinline__ float bflo(unsigned w) { return __builtin_bit_cast(float, w << 16); }
__device__ __forceinline__ float bfhi(unsigned w) { return __builtin_bit_cast(float, w & 0xffff0000u); }
__device__ __forceinline__ float sigmoidf_(float x) { return 1.f / (1.f + __expf(-x)); }
__device__ __forceinline__ float gelu_tanh(float x) {
    const float u = 0.7978845608028654f * (x + 0.044715f * x * x * x);
    const float e = __expf(2.f * u);
    const float th = 1.f - 2.f / (e + 1.f);
    return 0.5f * x * (1.f + th);
}
__device__ __forceinline__ int lane_id_v() { int l; asm volatile("v_mbcnt_lo_u32_b32 %0, -1, 0\n\tv_mbcnt_hi_u32_b32 %0, -1, %0" : "=v"(l)); return l; }
__device__ __forceinline__ float wave_sum(float v) {
#pragma unroll
    for (int o = 1; o < 64; o <<= 1) v += __shfl_xor(v, o);
    return v;
}
__device__ __forceinline__ void unpack8(const u32x4 w, float (&v)[8]) {
    v[0] = bflo(w.x); v[1] = bfhi(w.x); v[2] = bflo(w.y); v[3] = bfhi(w.y); v[4] = bflo(w.z); v[5] = bfhi(w.z); v[6] = bflo(w.w); v[7] = bfhi(w.w);
}
__device__ __forceinline__ u32x4 pack8(const float (&v)[8]) {
    u32x4 w; w.x = pk2(v[0], v[1]); w.y = pk2(v[2], v[3]); w.z = pk2(v[4], v[5]); w.w = pk2(v[6], v[7]); return w;
}

namespace pg8 {
#define PG8_LAS __attribute__((address_space(3)))
constexpr int BM = 256, BK = 64, HALF = 128, HTB = HALF * BK * 2, STAGE_BYTES = 8 * HTB, NXCD = 8, WGM = 8;
__host__ __device__ __forceinline__ int lds_byte(int r, int c) { const int st = (r >> 4) * 2 + (c >> 5), rr = r & 15, cc = c & 31, ob = rr * 64 + cc * 2; return st * 1024 + (ob ^ (((ob >> 9) & 1) << 5)); }
__host__ __device__ __forceinline__ void stage_rc(int b, int& R, int& C) { const int st = b / 1024, sb = b % 1024, swz = sb ^ (((sb >> 9) & 1) << 5); R = (st >> 1) * 16 + swz / 64; C = (st & 1) * 32 + (swz % 64) / 2; }
__host__ __device__ __forceinline__ int perm32(int rho) { const int n = rho >> 4, i = rho & 15; return 8 * (i >> 2) + 4 * n + (i & 3); }

struct Unit { int pm, pn; };
struct Gemm { const bf16_t* A; const bf16_t* Bt; };

template <int M_, int N_> struct StaticOrder {
    static constexpr int nM = M_ / BM, nN = N_ / BM, nwg = nM * nN;
    int G, c;
    __host__ __device__ void init(int G_, int c_) { G = G_; c = c_; }
    __host__ __device__ bool next(int i, Unit& u) const {
        const long L = (long)i * G + c; if (L >= nwg) return false;
        int wgid = (int)L; { const int q = nwg / NXCD, r = nwg % NXCD, xcd = wgid % NXCD, off = wgid / NXCD; wgid = (xcd < r ? xcd * (q + 1) : r * (q + 1) + (xcd - r) * q) + off; }
        const int nig = WGM * nN, gid = wgid / nig, fm = gid * WGM, gsz = (nM - fm) < WGM ? (nM - fm) : WGM;
        u.pm = fm + ((wgid % nig) % gsz); u.pn = (wgid % nig) / gsz; return true;
    }
};

template <class F> struct EpiF {
    static constexpr bool PERM = true;
    F f;
    __device__ __forceinline__ void operator()(const f32x4 (&acc)[2][2][4][2], const Unit& u, int wr, int wc, int fr, int fq) const {
        { int l_; asm volatile("v_mbcnt_lo_u32_b32 %0, -1, 0\n\tv_mbcnt_hi_u32_b32 %0, -1, %0" : "=v"(l_)); fr = l_ & 15; fq = l_ >> 4; }
        const int c = wc * 32 + 8 * fq;
        const typename F::Tile tl = f.tile(u.pn, c, u.pm);
#pragma unroll
        for (int ai = 0; ai < 2; ++ai)
#pragma unroll
            for (int mb = 0; mb < 4; mb += F::NB) {
                typename F::Pre pre[F::NB];
#pragma unroll
                for (int m = 0; m < F::NB; ++m) pre[m] = f.pre(u.pm * BM + ai * HALF + wr * 64 + (mb + m) * 16 + fr, u.pn, c);
#pragma unroll
                for (int m = 0; m < F::NB; ++m) {
                    const int row = u.pm * BM + ai * HALF + wr * 64 + (mb + m) * 16 + fr;
                    float v0[8], v1[8];
#pragma unroll
                    for (int j = 0; j < 4; ++j) { v0[j] = acc[ai][0][mb + m][0][j]; v0[4 + j] = acc[ai][0][mb + m][1][j]; v1[j] = acc[ai][1][mb + m][0][j]; v1[4 + j] = acc[ai][1][mb + m][1][j]; }
                    f.apply(row, u.pn, c, v0, v1, pre[m], tl);
                }
            }
    }
};

template <int K, int LDA, int ACS, class Epi, class Sched>
__device__ __forceinline__ void gemm_phase(PG8_LAS unsigned char* lds, const Gemm g, const Sched& S, const Epi& E, const int tid) {
    const int wid = __builtin_amdgcn_readfirstlane(tid >> 6), lane = tid & 63, wr = wid >> 2, wc = wid & 3, fr = lane & 15, fq = lane >> 4;
    constexpr int nt = K / BK;
    unsigned voffA[2], voffB[2];
#pragma unroll
    for (int i = 0; i < 2; ++i) { int R, C; stage_rc(tid * 16 + i * 8192, R, C); const int Rb = Epi::PERM ? ((R & ~31) + perm32(R & 31)) : R;
        voffA[i] = (unsigned)(R * LDA + C) * 2u; voffB[i] = (unsigned)(Rb * K + C) * 2u; }
    constexpr size_t kstep = (size_t)(BK * 2);
    constexpr size_t hstepA = (size_t)HALF * LDA * 2, hstepB = (size_t)HALF * K * 2;
    constexpr size_t tstepA = 2 * hstepA, tstepB = 2 * hstepB;
    constexpr size_t acsb = (size_t)ACS * 2;
    const unsigned ldsw = (unsigned)wid * 1024u;
    const int aoff = lds_byte(wr * 64 + fr, fq * 8), boff = lds_byte(wc * 32 + fr, fq * 8);
#define PG8_SA(b, h) (((b) * 2 + (h)) * HTB)
#define PG8_SB(b, h) ((4 + (b) * 2 + (h)) * HTB)
#define PG8_STAGE(bufoff, gbase, voff) do { _Pragma("unroll") for (int _i = 0; _i < 2; ++_i) \
        __builtin_amdgcn_global_load_lds((const unsigned*)((const char*)(gbase) + (voff)[_i]), (PG8_LAS unsigned*)(lds + (bufoff) + ldsw + _i * 8192), 16, 0, 0); } while (0)
#define PG8_LDA(dst, b, h) do { _Pragma("unroll") for (int m = 0; m < 4; ++m) _Pragma("unroll") for (int k = 0; k < 2; ++k) dst[m][k] = *(const PG8_LAS bf16x8*)(lds + PG8_SA(b, h) + aoff + m * 2048 + k * 1024); } while (0)
#define PG8_LDB(dst, b, h) do { _Pragma("unroll") for (int n = 0; n < 2; ++n) _Pragma("unroll") for (int k = 0; k < 2; ++k) dst[n][k] = *(const PG8_LAS bf16x8*)(lds + PG8_SB(b, h) + boff + n * 2048 + k * 1024); } while (0)
#define PG8_MMA(ai, bj, At, Bt) do { __builtin_amdgcn_s_setprio(1); _Pragma("unroll") for (int m = 0; m < 4; ++m) _Pragma("unroll") for (int n = 0; n < 2; ++n) _Pragma("unroll") for (int k = 0; k < 2; ++k) \
        acc[ai][bj][m][n] = __builtin_amdgcn_mfma_f32_16x16x32_bf16(Bt[n][k], At[m][k], acc[ai][bj][m][n], 0, 0, 0); __builtin_amdgcn_s_setprio(0); } while (0)
#define PG8_WAIT_V(n) asm volatile("s_waitcnt vmcnt(" #n ")" ::: "memory")
#define PG8_WAIT_L(n) asm volatile("s_waitcnt lgkmcnt(" #n ")" ::: "memory")
#define PG8_BAR __builtin_amdgcn_s_barrier()
#define PG8_SCHED __builtin_amdgcn_sched_barrier(0)
    Unit cur, nxt; int ui = 0;
    if (!S.next(0, cur)) return;
    f32x4 acc[2][2][4][2];
#pragma unroll
    for (int a = 0; a < 2; ++a)
#pragma unroll
        for (int b = 0; b < 2; ++b)
#pragma unroll
            for (int m = 0; m < 4; ++m)
#pragma unroll
                for (int n = 0; n < 2; ++n) acc[a][b][m][n] = (f32x4){0.f, 0.f, 0.f, 0.f};
    bf16x8 At[4][2], B0[2][2], B1[2][2];
    const char* cA = (const char*)g.A + (size_t)cur.pm * tstepA + (size_t)cur.pn * acsb; const char* cB = (const char*)g.Bt + (size_t)cur.pn * tstepB;
    PG8_STAGE(PG8_SB(0, 0), cB, voffB); PG8_STAGE(PG8_SB(0, 1), cB + hstepB, voffB); PG8_STAGE(PG8_SA(0, 0), cA, voffA); PG8_STAGE(PG8_SA(0, 1), cA + hstepA, voffA);
    if (wr == 1) PG8_BAR;
    PG8_WAIT_V(2); PG8_BAR;
    PG8_STAGE(PG8_SB(1, 0), cB + kstep, voffB); PG8_STAGE(PG8_SA(1, 0), cA + kstep, voffA); PG8_STAGE(PG8_SB(1, 1), cB + hstepB + kstep, voffB);
    PG8_WAIT_V(6); PG8_BAR;
    for (;;) {
        const bool has_next = S.next(ui + 1, nxt);
        const char* nA = has_next ? (const char*)g.A + (size_t)nxt.pm * tstepA + (size_t)nxt.pn * acsb : cA; const char* nB = has_next ? (const char*)g.Bt + (size_t)nxt.pn * tstepB : cB;
#pragma unroll 1
        for (int t = 0; t < nt; t += 2) {
            const bool last = (t == nt - 2);
            const char* a1 = cA + (size_t)(t + 1) * kstep;
            const char* a2 = last ? nA : cA + (size_t)(t + 2) * kstep; const char* b2 = last ? nB : cB + (size_t)(t + 2) * kstep;
            const char* a3 = a2 + kstep; const char* b3 = b2 + kstep;
            PG8_LDB(B0, 0, 0); PG8_LDB(B1, 0, 1); PG8_SCHED; PG8_LDA(At, 0, 0); PG8_STAGE(PG8_SA(1, 1), a1 + hstepA, voffA);
            PG8_WAIT_V(8); PG8_WAIT_L(0); PG8_BAR; PG8_MMA(0, 0, At, B0); PG8_MMA(0, 1, At, B1); PG8_BAR; PG8_SCHED;
            PG8_LDA(At, 0, 1); PG8_STAGE(PG8_SB(0, 0), b2, voffB); PG8_STAGE(PG8_SB(0, 1), b2 + hstepB, voffB); PG8_STAGE(PG8_SA(0, 0), a2, voffA);
            PG8_WAIT_V(8); PG8_WAIT_L(0); PG8_BAR; PG8_MMA(1, 0, At, B0); PG8_MMA(1, 1, At, B1); PG8_BAR; PG8_SCHED;
            PG8_LDB(B0, 1, 0); PG8_LDB(B1, 1, 1); PG8_SCHED; PG8_LDA(At, 1, 0); PG8_STAGE(PG8_SA(0, 1), a2 + hstepA, voffA);
            PG8_WAIT_V(8); PG8_WAIT_L(0); PG8_BAR; PG8_MMA(0, 0, At, B0); PG8_MMA(0, 1, At, B1); PG8_BAR; PG8_SCHED;
            PG8_LDA(At, 1, 1); PG8_STAGE(PG8_SB(1, 0), b3, voffB); PG8_STAGE(PG8_SB(1, 1), b3 + hstepB, voffB); PG8_STAGE(PG8_SA(1, 0), a3, voffA);
            PG8_WAIT_V(8); PG8_WAIT_L(0); PG8_BAR; PG8_MMA(1, 0, At, B0); PG8_MMA(1, 1, At, B1); PG8_BAR; PG8_SCHED;
        }
        if (wr == 0) PG8_BAR;
        E(acc, cur, wr, wc, fr, fq);
        if (!has_next) break;
#pragma unroll
        for (int a = 0; a < 2; ++a)
#pragma unroll
            for (int b = 0; b < 2; ++b)
#pragma unroll
                for (int m = 0; m < 4; ++m)
#pragma unroll
                    for (int n = 0; n < 2; ++n) acc[a][b][m][n] = (f32x4){0.f, 0.f, 0.f, 0.f};
        cur = nxt; cA = nA; cB = nB; ++ui;
        if (wr == 1) PG8_BAR;
    }
    PG8_WAIT_V(0);
    PG8_BAR;
#undef PG8_SA
#undef PG8_SB
#undef PG8_STAGE
#undef PG8_LDA
#undef PG8_LDB
#undef PG8_MMA
#undef PG8_WAIT_V
#undef PG8_WAIT_L
#undef PG8_BAR
#undef PG8_SCHED
}
}

#define XB_TMO      128
#define XB_XCNT(j)  (256  + 64 * (j))
#define XB_XSUB(j)  (1280 + 64 * (j))
#define XB_XGEN(j)  (2304 + 64 * (j))
#define XB_TOP      3328
#define XB_TOPGEN   3392
#define XCD_BAR_WORDS 3456
#define XB_SPIN_CAP (1u << 18)
__device__ __forceinline__ unsigned xb_ld(unsigned* p)              { return __hip_atomic_load(p, __ATOMIC_RELAXED, __HIP_MEMORY_SCOPE_AGENT); }
__device__ __forceinline__ unsigned xb_add(unsigned* p, unsigned v) { return __hip_atomic_fetch_add(p, v, __ATOMIC_RELAXED, __HIP_MEMORY_SCOPE_AGENT); }
__device__ __forceinline__ unsigned xb_xcc_id() { return (unsigned)__builtin_amdgcn_s_getreg((3 << 11) | 20) & 0xFu; }
#define XB_SPIN(cond, bar) do { unsigned _sp = 0; while (cond) { __builtin_amdgcn_s_sleep(1); \
    if ((++_sp & 255u) == 0u) { if (xb_ld(&(bar)[XB_TMO])) break; if (_sp > XB_SPIN_CAP) { atomicAdd(&(bar)[XB_TMO], 1u); break; } } } } while (0)
struct XcdBarrier { unsigned* bar; unsigned x; volatile LAS unsigned* st; };
__device__ __forceinline__ XcdBarrier xcd_barrier_post(unsigned* bar, volatile LAS unsigned* st) {
    XcdBarrier b; b.bar = bar; b.x = xb_xcc_id(); b.st = st;
    if (threadIdx.x == 0) (void)xb_add(&bar[XB_XCNT(b.x)], 1u);
    return b;
}
__device__ __forceinline__ void xcd_barrier_complete(unsigned* bar, unsigned x, unsigned& nloc, unsigned& nx) {
    const unsigned G = gridDim.x * gridDim.y * gridDim.z;
    unsigned sum, cnt, mine, sp = 0u;
    for (;;) {
        sum = 0u; cnt = 0u; mine = 0u;
#pragma unroll
        for (unsigned j = 0; j < 16; ++j) { const unsigned c = xb_ld(&bar[XB_XCNT(j)]); sum += c; cnt += (c > 0u) ? 1u : 0u; mine = (j == x) ? c : mine; }
        if (sum == G) break;
        __builtin_amdgcn_s_sleep(1);
        if ((++sp & 255u) == 0u) { if (xb_ld(&bar[XB_TMO])) break; if (sp > XB_SPIN_CAP) { atomicAdd(&bar[XB_TMO], 1u); break; } }
    }
    nloc = mine > 0u ? mine : 1u; nx = cnt > 0u ? cnt : 1u;
}
__device__ __forceinline__ void xcd_barrier(const XcdBarrier& b, int wave) {
    asm volatile("s_waitcnt vmcnt(0)" ::: "memory");
    __syncthreads();
    if (wave == 0 && lane_id_v() == 0) {
        unsigned* bar = b.bar;
        __builtin_amdgcn_s_waitcnt(0);
        unsigned nloc = b.st[0], nx = b.st[1];
        if (nloc == 0u) { xcd_barrier_complete(bar, b.x, nloc, nx); b.st[0] = nloc; b.st[1] = nx; }
        const unsigned old = xb_add(&bar[XB_XSUB(b.x)], 1u);
        const unsigned gen = old / nloc;
        if (old + 1u == (gen + 1u) * nloc) {
            __builtin_amdgcn_fence(__ATOMIC_RELEASE, "agent");
            asm volatile("s_waitcnt vmcnt(0)" ::: "memory");
            const unsigned og = xb_add(&bar[XB_TOP], 1u);
            const unsigned tg = og / nx;
            if (og + 1u == (tg + 1u) * nx) xb_add(&bar[XB_TOPGEN], 1u);
            else XB_SPIN(xb_ld(&bar[XB_TOPGEN]) == tg, bar);
            __builtin_amdgcn_fence(__ATOMIC_ACQUIRE, "agent");
            xb_add(&bar[XB_XGEN(b.x)], 1u);
            asm volatile("s_waitcnt vmcnt(0)" ::: "memory");
        } else {
            XB_SPIN(xb_ld(&bar[XB_XGEN(b.x)]) == gen, bar);
            __builtin_amdgcn_fence(__ATOMIC_ACQUIRE, "agent");
            asm volatile("s_waitcnt vmcnt(0)" ::: "memory");
        }
    }
    __syncthreads();
}

struct Args { const float* in[28]; float* out; unsigned char* ws; int ph_lo, ph_hi; };
enum { I_X = 0, I_C, I_POS, I_WADA, I_BADA, I_N1G, I_WIN, I_QAG, I_WUQ, I_KVAG, I_WUKV, I_QNG, I_KNG, I_WOA, I_CONVW, I_CONVB, I_WRG, I_BRG, I_WIG, I_BIG, I_LAM, I_WOL, I_WOUT, I_N2G, I_WQ, I_SUBK, I_EU, I_EV };
constexpr int N_PHASES = 17;

struct Ctx {
    LAS unsigned char* lds;
    int tid, lane, wave, vcu, G;
    const float* const* in; float* out; unsigned char* ws;
};
#define WSP(type, off) ((type*)(c.ws + (off)))

template <class F>
__device__ __forceinline__ void tr_tile(const Ctx& c, bf16_t* dst, int K, int n0, int k0, F f) {
    LAS float* scr = (LAS float*)c.lds;
#pragma unroll
    for (int i = 0; i < 8; ++i) { const int kk = i * 8 + (c.tid >> 6), nn = c.tid & 63; scr[kk * 65 + nn] = f(k0 + kk, n0 + nn); }
    __syncthreads();
    { const int kc = c.tid & 7, nn = c.tid >> 3;
      LAS const float* s = scr + (8 * kc) * 65 + nn;
      u32x4 o; o.x = pk2(s[0], s[65]); o.y = pk2(s[2 * 65], s[3 * 65]); o.z = pk2(s[4 * 65], s[5 * 65]); o.w = pk2(s[6 * 65], s[7 * 65]);
      *(u32x4*)(dst + (size_t)(n0 + nn) * K + k0 + 8 * kc) = o; }
    __syncthreads();
}

template <class F>
__device__ __forceinline__ void tr_tile_wave(LAS float* scr, int L, bf16_t* dst, int K, int n0, int k0, F f) {
#pragma unroll 16
    for (int kk = 0; kk < 64; ++kk) scr[kk * 65 + L] = f(k0 + kk, n0 + L);
    asm volatile("s_waitcnt lgkmcnt(0)" ::: "memory");
    const int kc = L & 7;
#pragma unroll
    for (int j = 0; j < 8; ++j) { const int nn = (L >> 3) + 8 * j; LAS const float* s = scr + (8 * kc) * 65 + nn;
        u32x4 o; o.x = pk2(s[0], s[65]); o.y = pk2(s[2 * 65], s[3 * 65]); o.z = pk2(s[4 * 65], s[5 * 65]); o.w = pk2(s[6 * 65], s[7 * 65]);
        *(u32x4*)(dst + (size_t)(n0 + nn) * K + k0 + 8 * kc) = o; }
    asm volatile("s_waitcnt lgkmcnt(0)" ::: "memory");
}
__device__ __forceinline__ void phase_prep(const Ctx& c0) {
    Ctx c = c0; c.lane = lane_id_v(); c.tid = c.wave * 64 + c.lane;
    const float* w_in = c.in[I_WIN]; const float* w_uq = c.in[I_WUQ]; const float* qag = c.in[I_QAG]; const float* w_ukv = c.in[I_WUKV]; const float* kvag = c.in[I_KVAG];
    const float* w_oa = c.in[I_WOA]; const float* w_ol = c.in[I_WOL]; const float* w_out = c.in[I_WOUT]; const float* w_q = c.in[I_WQ];
    const float* w_rg = c.in[I_WRG]; const float* w_ig = c.in[I_WIG];
    constexpr int T_WIN = 72 * 16, T_WUQ = 12 * 4, T_WUKV = 16 * 2, T_WOA = 16 * 8, T_WOL = 16 * 16, T_WOUT = 16 * 16, T_WQ = 32 * 16, T_WG = 8 * 4 * 2;
    constexpr int T_WAVE = T_WIN + T_WUQ + T_WUKV + T_WOA + T_WOL + T_WOUT + T_WG;
    { LAS float* scr = (LAS float*)(c.lds + (c.wave < 7 ? c.wave * 16640 : 131584)); const int L = c.lane;
      static_assert(7 * 16640 <= 131072 && 131584 + 16640 <= LDS_BYTES && 131584 >= MISC_OFF + 128, "prep LDS tiles");
      for (int it = c.vcu * 8 + c.wave; it < T_WAVE; it += c.G * 8) {
        int r = it;
        if (r < T_WIN) { const int nb = r / 16, kb = r % 16;
            tr_tile_wave(scr, L, WSP(bf16_t, WS_WIN), 1024, nb * 64, kb * 64, [=](int k, int n) -> float { return n < 416 ? w_in[(size_t)k * 4512 + n] : (n < 512 ? 0.f : w_in[(size_t)k * 4512 + n - 96]); }); continue; }
        r -= T_WIN;
        if (r < T_WUQ) { const int nb = r / 4, kb = r % 4;
            tr_tile_wave(scr, L, WSP(bf16_t, WS_WUQ), 256, nb * 64, kb * 64, [=](int k, int n) -> float { return w_uq[(size_t)k * 768 + n] * qag[k]; }); continue; }
        r -= T_WUQ;
        if (r < T_WUKV) { const int nb = r / 2, kb = r % 2;
            tr_tile_wave(scr, L, WSP(bf16_t, WS_WUKV), 128, nb * 64, kb * 64, [=](int k, int n) -> float { return w_ukv[(size_t)k * 1024 + n] * kvag[k]; }); continue; }
        r -= T_WUKV;
        if (r < T_WOA) { const int nb = r / 8, kb = r % 8;
            tr_tile_wave(scr, L, WSP(bf16_t, WS_WOA), 512, nb * 64, kb * 64, [=](int k, int n) -> float { return w_oa[(size_t)k * 1024 + n]; }); continue; }
        r -= T_WOA;
        if (r < T_WOL) { const int nb = r / 16, kb = r % 16;
            tr_tile_wave(scr, L, WSP(bf16_t, WS_WOL), 1024, nb * 64, kb * 64, [=](int k, int n) -> float { return w_ol[(size_t)k * 1024 + n]; }); continue; }
        r -= T_WOL;
        if (r < T_WOUT) { const int nb = r / 16, kb = r % 16;
            tr_tile_wave(scr, L, WSP(bf16_t, WS_WOUT), 1024, nb * 64, kb * 64, [=](int k, int n) -> float { return w_out[(size_t)k * 1024 + n]; }); continue; }
        r -= T_WOUT;
        { const int blk = r / 8, q = r % 8, nb = q / 2, kb = q % 2;
            tr_tile_wave(scr, L, WSP(bf16_t, WS_WG) + (size_t)blk * 256 * 128, 128, nb * 64, kb * 64,
                    [=](int k, int n) -> float { return n < 128 ? w_rg[((size_t)blk * 128 + k) * 128 + n] : w_ig[((size_t)blk * 128 + k) * 128 + n - 128]; }); }
      } }
    __syncthreads();
    for (int r = c.vcu; r < T_WQ; r += c.G) {
        const int nb = r / 16, kb = r % 16;
        const int slot = nb >> 1, n0 = (nb & 1) * 64, k0 = kb * 64;
        LAS float* wq_s = (LAS float*)(c.lds + 32768);
        LAS float* sk_s = (LAS float*)(c.lds + 32768 + 64 * 129 * 4);
        const float* skp = c.in[I_SUBK] + ((size_t)slot * 128 + n0) * 128;
        for (int e = c.tid; e < 64 * 128; e += 512) { const int rr = e >> 7, cc = e & 127; wq_s[rr * 129 + cc] = w_q[(size_t)(k0 + rr) * 2048 + slot * 128 + cc]; sk_s[rr * 129 + cc] = skp[(size_t)rr * 128 + cc]; }
        __syncthreads();
        tr_tile(c, WSP(bf16_t, WS_WQ), 1024, nb * 64, k0, [=](int k, int n) -> float { const LAS float* a = wq_s + (k - k0) * 129; const LAS float* b = sk_s + (n - nb * 64) * 129; float s = 0.f;
#pragma unroll 16
            for (int d = 0; d < 128; ++d) s += a[d] * b[d];
            return s; });
    }
    { const float* lam = c.in[I_LAM]; float* t8 = WSP(float, WS_C8SP);
      if (c.vcu == 0) for (int e = c.tid; e < 1024; e += 512) t8[e] = -8.f * log1pf(__expf(-lam[e])); }
    if (c.vcu == 0 && c.tid == 0) {
        const unsigned probe = __builtin_amdgcn_cvt_scalef32_pk_fp4_f32(0u, 1.0f, 0.0f, 1.0f, 0) & 0xffu;
        WSP(unsigned, WS_C8SP)[1024] = (probe == 0x02u) ? 0u : 1u; }
    { const int gw = c.vcu * 8 + c.wave, NGW = c.G * 8, L = c.lane;
      f32x4 vn[4];
      if (gw < 2 * NE) { const f32x4* s4 = (const f32x4*)((gw >= NE ? c.in[I_EV] : c.in[I_EU]) + (size_t)(gw >= NE ? gw - NE : gw) * 1024 + 16 * L);
#pragma unroll
          for (int j = 0; j < 4; ++j) vn[j] = s4[j]; }
#pragma unroll 1
      for (int r = gw; r < 2 * NE; r += NGW) {
          const int isv = r >= NE, e = isv ? r - NE : r;
          f32x4 v[4]; float am = 0.f;
#pragma unroll
          for (int j = 0; j < 4; ++j) { v[j] = vn[j]; am = fmaxf(am, fmaxf(fmaxf(fabsf(v[j].x), fabsf(v[j].y)), fmaxf(fabsf(v[j].z), fabsf(v[j].w)))); }
          { const int rn = (r + NGW < 2 * NE) ? r + NGW : r; const f32x4* s4 = (const f32x4*)((rn >= NE ? c.in[I_EV] : c.in[I_EU]) + (size_t)(rn >= NE ? rn - NE : rn) * 1024 + 16 * L);
#pragma unroll
            for (int j = 0; j < 4; ++j) vn[j] = s4[j]; }
#pragma unroll
          for (int o = 1; o < 64; o <<= 1) am = fmaxf(am, __shfl_xor(am, o));
          const float s = am > 0.f ? am * (1.f / 6.f) : 1.f, inv = 1.f / s;
          unsigned w0 = 0u, w1 = 0u;
          w0 = __builtin_amdgcn_cvt_scalef32_pk_fp4_f32(w0, v[0].x * inv, v[0].y * inv, 1.0f, 0); w0 = __builtin_amdgcn_cvt_scalef32_pk_fp4_f32(w0, v[0].z * inv, v[0].w * inv, 1.0f, 1);
          w0 = __builtin_amdgcn_cvt_scalef32_pk_fp4_f32(w0, v[1].x * inv, v[1].y * inv, 1.0f, 2); w0 = __builtin_amdgcn_cvt_scalef32_pk_fp4_f32(w0, v[1].z * inv, v[1].w * inv, 1.0f, 3);
          w1 = __builtin_amdgcn_cvt_scalef32_pk_fp4_f32(w1, v[2].x * inv, v[2].y * inv, 1.0f, 0); w1 = __builtin_amdgcn_cvt_scalef32_pk_fp4_f32(w1, v[2].z * inv, v[2].w * inv, 1.0f, 1);
          w1 = __builtin_amdgcn_cvt_scalef32_pk_fp4_f32(w1, v[3].x * inv, v[3].y * inv, 1.0f, 2); w1 = __builtin_amdgcn_cvt_scalef32_pk_fp4_f32(w1, v[3].z * inv, v[3].w * inv, 1.0f, 3);
          u32x2 q; q.x = w0; q.y = w1;
          *(u32x2*)(c.ws + (isv ? WS_EV : WS_EU) + ((size_t)(L >> 4) * NE + e) * 128 + (L & 15) * 8) = q;
          if (L == 0) WSP(float, isv ? WS_SV : WS_SU)[e] = s;
      } }
    { const float* cin = c.in[I_C]; const float* w_ada = c.in[I_WADA]; const float* b_ada = c.in[I_BADA]; float* mod = WSP(float, WS_MOD);
      LAS float* cs = (LAS float*)c.lds;
      LAS float* red = (LAS float*)(c.lds + 65536);
      bool have = false;
      for (int it = c.vcu; it < 192; it += c.G) {
          if (!have) { for (int e = c.tid; e < 16 * 1024; e += 512) { const float v = cin[e]; cs[e] = v / (1.f + __expf(-v)); } have = true; }
          __syncthreads();
          const int cl = c.tid & 31, ks = c.tid >> 5, j = it * 32 + cl;
          float acc[16];
#pragma unroll
          for (int b = 0; b < 16; ++b) acc[b] = 0.f;
          for (int kk = 0; kk < 64; ++kk) { const int k = ks * 64 + kk; const float w = w_ada[(size_t)k * 6144 + j];
#pragma unroll
              for (int b = 0; b < 16; ++b) acc[b] += cs[b * 1024 + k] * w; }
#pragma unroll
          for (int b = 0; b < 16; ++b) red[(ks * 16 + b) * 32 + cl] = acc[b];
          __syncthreads();
          { const int b = c.tid >> 5; float s = b_ada[j];
#pragma unroll
            for (int k2 = 0; k2 < 16; ++k2) s += red[(k2 * 16 + b) * 32 + cl];
            mod[b * 6144 + j] = s; }
          __syncthreads();
      } }
}

template <bool Q8>
__device__ __forceinline__ void phase_modnorm(const Ctx& c0, const float* x, const float* g, int shift_off, int scale_off, bf16_t* dst) {
    Ctx c = c0; c.lane = lane_id_v(); c.tid = c.wave * 64 + c.lane;
    const float* mod = WSP(float, WS_MOD);
    const int gw = c.vcu * 8 + c.wave, NGW = c.G * 8;
    if (gw >= T) return;
    f32x4 vn[4];
    { const f32x4* xr = (const f32x4*)(x + (size_t)gw * D) + c.lane;
#pragma unroll
      for (int j = 0; j < 4; ++j) vn[j] = xr[64 * j]; }
#pragma unroll 1
    for (int m = gw; m < T; m += NGW) {
        const int b = m >> 11;
        f32x4 v[4]; float s = 0.f;
#pragma unroll
        for (int j = 0; j < 4; ++j) { v[j] = vn[j]; s += (v[j].x * v[j].x + v[j].y * v[j].y) + (v[j].z * v[j].z + v[j].w * v[j].w); }
        { const int mn = (m + NGW < T) ? m + NGW : m; const f32x4* xr = (const f32x4*)(x + (size_t)mn * D) + c.lane;
#pragma unroll
          for (int j = 0; j < 4; ++j) vn[j] = xr[64 * j]; }
        const float rstd = rsqrtf(wave_sum(s) * (1.f / D) + EPS);
        u32x2* o8 = (u32x2*)(dst + (size_t)m * D) + c.lane;
        float am = 0.f;
#pragma unroll
        for (int j = 0; j < 4; ++j) {
            const int col = 4 * c.lane + 256 * j;
            const f32x4 gg = *(const f32x4*)(g + col), sc = *(const f32x4*)(mod + b * 6144 + scale_off + col), sh = *(const f32x4*)(mod + b * 6144 + shift_off + col);
            const float r0 = v[j].x * rstd * gg.x * (1.f + sc.x) + sh.x, r1 = v[j].y * rstd * gg.y * (1.f + sc.y) + sh.y;
            const float r2 = v[j].z * rstd * gg.z * (1.f + sc.z) + sh.z, r3 = v[j].w * rstd * gg.w * (1.f + sc.w) + sh.w;
            u32x2 w; w.x = pk2(r0, r1); w.y = pk2(r2, r3); o8[64 * j] = w;
            if (Q8) { v[j].x = r0; v[j].y = r1; v[j].z = r2; v[j].w = r3; am = fmaxf(am, fmaxf(fmaxf(fabsf(r0), fabsf(r1)), fmaxf(fabsf(r2), fabsf(r3)))); }
        }
        if (Q8) {
#pragma unroll
            for (int o = 1; o < 64; o <<= 1) am = fmaxf(am, __shfl_xor(am, o));
            const float sq = am > 0.f ? am * (1.f / 256.f) : 1.f, inv = 1.f / sq;
            unsigned* q8 = (unsigned*)(c.ws + WS_H2Q + (size_t)m * D) + c.lane;
#pragma unroll
            for (int j = 0; j < 4; ++j) { int w = __builtin_amdgcn_cvt_pk_fp8_f32(v[j].x * inv, v[j].y * inv, 0, false); w = __builtin_amdgcn_cvt_pk_fp8_f32(v[j].z * inv, v[j].w * inv, w, true); q8[64 * j] = (unsigned)w; }
            if (c.lane == 0) WSP(float, WS_SH)[m] = sq;
        }
    }
}

__device__ __forceinline__ void phase_conv(const Ctx& c0) {
    Ctx c = c0; c.lane = lane_id_v(); c.tid = c.wave * 64 + c.lane;
    const bf16_t* pa = WSP(bf16_t, WS_R1); const bf16_t* lx = WSP(bf16_t, WS_R2); bf16_t* xc = WSP(bf16_t, WS_R4); float* rstd = WSP(float, WS_RSTD);
    const float* cw = c.in[I_CONVW]; const float* cb = c.in[I_CONVB];
    const int gt = c.vcu * 512 + c.tid, NT = c.G * 512;
    { const int gw = c.vcu * 8 + c.wave, NGW = c.G * 8, L = c.lane;
      for (int t = gw; t < T; t += NGW) {
          float ss = 0.f;
          if (L < 48) { float v[8]; unpack8(*(const u32x4*)(pa + (size_t)t * 512 + 8 * L), v);
#pragma unroll
              for (int j = 0; j < 8; ++j) ss += v[j] * v[j]; }
          const float sq = wave_sum(L < 32 ? ss : 0.f), skv = wave_sum(L >= 32 ? ss : 0.f);
          if (L == 0) { rstd[2 * t] = rsqrtf(sq * (1.f / 256.f) + EPS); rstd[2 * t + 1] = rsqrtf(skv * (1.f / 128.f) + EPS); }
      } }
    { const int* pos = (const int*)c.in[I_POS]; float* CS = WSP(float, WS_CS);
      for (int e = gt; e < T * 16; e += NT) {
          const int t = e >> 4, jj = e & 15;
          const float invf = exp2f(-(float)jj * (13.287712379549449f / 16.f));
          const float ang = (float)pos[t] * invf; const float n = rintf(ang * 0.15915494309189535f);
          const float red = (float)((double)ang - (double)n * 6.283185307179586);
          CS[(size_t)t * 32 + jj] = __cosf(red); CS[(size_t)t * 32 + 16 + jj] = __sinf(red);
      } }
    {
        const int ch = (gt & 127) * 8;
        f32x4 wv[4][2]; f32x4 bv[2];
#pragma unroll
        for (int j = 0; j < 4; ++j) { wv[j][0] = *(const f32x4*)(cw + j * 1024 + ch); wv[j][1] = *(const f32x4*)(cw + j * 1024 + ch + 4); }
        bv[0] = *(const f32x4*)(cb + ch); bv[1] = *(const f32x4*)(cb + ch + 4);
        const int tstep = NT >> 7;
        for (int tq = gt >> 7; tq < T; tq += 4 * tstep) {
            u32x4 raw[4][4];
#pragma unroll
            for (int u = 0; u < 4; ++u) { const int t = tq + u * tstep; const int s = t & 2047;
#pragma unroll
                for (int j = 0; j < 4; ++j) { raw[u][j] = (u32x4){0u, 0u, 0u, 0u}; if (t < T && s - 3 + j >= 0) raw[u][j] = *(const u32x4*)(lx + (size_t)(t - 3 + j) * 1024 + ch); } }
#pragma unroll
            for (int u = 0; u < 4; ++u) { const int t = tq + u * tstep;
                float acc[8] = {bv[0].x, bv[0].y, bv[0].z, bv[0].w, bv[1].x, bv[1].y, bv[1].z, bv[1].w};
#pragma unroll
                for (int j = 0; j < 4; ++j) { float v[8]; unpack8(raw[u][j], v);
                    acc[0] += wv[j][0].x * v[0]; acc[1] += wv[j][0].y * v[1]; acc[2] += wv[j][0].z * v[2]; acc[3] += wv[j][0].w * v[3];
                    acc[4] += wv[j][1].x * v[4]; acc[5] += wv[j][1].y * v[5]; acc[6] += wv[j][1].z * v[6]; acc[7] += wv[j][1].w * v[7]; }
                if (t < T) *(u32x4*)(xc + (size_t)t * 1024 + ch) = pack8(acc); }
        }
    }
}

__device__ __forceinline__ void phase_scan(const Ctx& c0) {
    Ctx c = c0; c.lane = lane_id_v(); c.tid = c.wave * 64 + c.lane;
    const bf16_t* LA = WSP(bf16_t, WS_R0); bf16_t* Bv = WSP(bf16_t, WS_R6); const bf16_t* gate = WSP(bf16_t, WS_R3);
    LAS float* Ps = (LAS float*)c.lds; LAS float* Hs = Ps + 512;
    for (int it = c.vcu; it < 256; it += c.G) {
        const int b = it >> 4, cg = it & 15, seg = c.tid >> 6, ch = cg * 64 + (c.tid & 63);
        const size_t base = ((size_t)b * 2048 + seg * 256) * 1024 + ch;
        float P = 1.f, Hl = 0.f;
#pragma unroll 1
        for (int i0 = 0; i0 < 256; i0 += 16) {
            unsigned la[16], bv[16];
#pragma unroll
            for (int i = 0; i < 16; ++i) { la[i] = LA[base + (size_t)(i0 + i) * 1024]; bv[i] = Bv[base + (size_t)(i0 + i) * 1024]; }
#pragma unroll
            for (int i = 0; i < 16; ++i) { const float a = __builtin_amdgcn_exp2f(bf2f(la[i])); Hl = a * Hl + bf2f(bv[i]); P *= a; }
        }
        Ps[c.tid] = P; Hs[c.tid] = Hl;
        __syncthreads();
        float h = 0.f;
        for (int s2 = 0; s2 < seg; ++s2) h = Ps[s2 * 64 + (c.tid & 63)] * h + Hs[s2 * 64 + (c.tid & 63)];
#pragma unroll 1
        for (int i0 = 0; i0 < 256; i0 += 16) {
            unsigned la[16], bv[16], gv[16]; unsigned ov[16];
#pragma unroll
            for (int i = 0; i < 16; ++i) { la[i] = LA[base + (size_t)(i0 + i) * 1024]; bv[i] = Bv[base + (size_t)(i0 + i) * 1024]; gv[i] = gate[base + (size_t)(i0 + i) * 1024]; }
#pragma unroll
            for (int i = 0; i < 16; ++i) { const float a = __builtin_amdgcn_exp2f(bf2f(la[i])); h = a * h + bf2f(bv[i]); ov[i] = f2bf(h * gelu_tanh(bf2f(gv[i]))); }
#pragma unroll
            for (int i = 0; i < 16; ++i) Bv[base + (size_t)(i0 + i) * 1024] = (bf16_t)ov[i];
        }
        __syncthreads();
    }
}

struct QkvRaw { u32x4 q[2], k[2], v[2]; f32x4 cs[4]; };
__device__ __forceinline__ void qkv_load(QkvRaw& r, const bf16_t* qraw, const bf16_t* kvraw, const bf16_t* pa, const float* CS, int t, int ch, int hq) {
    const bool act = ch < 12;
#pragma unroll
    for (int pass = 0; pass < 2; ++pass) { const int h = pass * 4 + hq;
        r.q[pass] = (u32x4){0u, 0u, 0u, 0u}; r.k[pass] = (u32x4){0u, 0u, 0u, 0u}; r.v[pass] = (u32x4){0u, 0u, 0u, 0u};
        if (act) r.q[pass] = *(const u32x4*)(qraw + (size_t)t * 768 + h * 96 + 8 * ch);
        if (ch < 8) { r.k[pass] = *(const u32x4*)(kvraw + (size_t)t * 1024 + h * 128 + 8 * ch); r.v[pass] = *(const u32x4*)(kvraw + (size_t)t * 1024 + h * 128 + 64 + 8 * ch); }
        else if (act) r.k[pass] = *(const u32x4*)(pa + (size_t)t * 512 + 384 + 8 * (ch - 8)); }
    const float* cp = CS + (size_t)t * 32 + 8 * (ch & 1);
    r.cs[0] = *(const f32x4*)cp; r.cs[1] = *(const f32x4*)(cp + 4); r.cs[2] = *(const f32x4*)(cp + 16); r.cs[3] = *(const f32x4*)(cp + 20);
}
__device__ __forceinline__ void phase_qkv_layout(const Ctx& c0) {
    Ctx c = c0; c.lane = lane_id_v(); c.tid = c.wave * 64 + c.lane;
    const bf16_t* qraw = WSP(bf16_t, WS_R5); const bf16_t* kvraw = WSP(bf16_t, WS_R2); const bf16_t* pa = WSP(bf16_t, WS_R1);
    bf16_t* Qh = WSP(bf16_t, WS_R4); bf16_t* Kh = WSP(bf16_t, WS_R3); bf16_t* Vh = WSP(bf16_t, WS_R0);
    const float* qng = c.in[I_QNG]; const float* kng = c.in[I_KNG]; const float* CS = WSP(float, WS_CS);
    const float qscale = 0.10206207261596577f * 1.4426950408889634f;
    const int gw = c.vcu * 8 + c.wave, NGW = c.G * 8, L = c.lane;
    const int ch = L & 15, hq = L >> 4;
    const bool act = ch < 12, isr = ch >= 8, hi2 = ch >= 10;
    float gq[8], gk[8];
#pragma unroll
    for (int j = 0; j < 8; ++j) { gq[j] = act ? qng[8 * ch + j] : 0.f; gk[j] = act ? kng[8 * ch + j] : 0.f; }
    if (gw >= T) return;
    QkvRaw cur, nxt;
    qkv_load(cur, qraw, kvraw, pa, CS, gw, ch, hq);
#pragma unroll 1
    for (int t = gw; t < T; t += NGW) {
        qkv_load(nxt, qraw, kvraw, pa, CS, (t + NGW < T) ? t + NGW : t, ch, hq);
        const int b = t >> 11, s = t & 2047;
        const float cs[8] = {cur.cs[0].x, cur.cs[0].y, cur.cs[0].z, cur.cs[0].w, cur.cs[1].x, cur.cs[1].y, cur.cs[1].z, cur.cs[1].w};
        const float sn[8] = {cur.cs[2].x, cur.cs[2].y, cur.cs[2].z, cur.cs[2].w, cur.cs[3].x, cur.cs[3].y, cur.cs[3].z, cur.cs[3].w};
#pragma unroll
        for (int pass = 0; pass < 2; ++pass) {
            const int h = pass * 4 + hq;
            const size_t orow = ((size_t)(b * H + h) * S + s);
#pragma unroll
            for (int qk = 0; qk < 2; ++qk) {
                float v[8]; unpack8(qk == 0 ? cur.q[pass] : cur.k[pass], v);
                float ss = 0.f;
#pragma unroll
                for (int j = 0; j < 8; ++j) ss += v[j] * v[j];
#pragma unroll
                for (int o = 1; o < 16; o <<= 1) ss += __shfl_xor(ss, o);
                const float r = rsqrtf(ss * (1.f / 96.f) + EPS) * (qk == 0 ? qscale : 1.f);
                float x[8], o8[8];
#pragma unroll
                for (int j = 0; j < 8; ++j) x[j] = v[j] * r * (qk == 0 ? gq[j] : gk[j]);
#pragma unroll
                for (int j = 0; j < 8; ++j) { const float px = __shfl_xor(x[j], 2);
                    o8[j] = !isr ? x[j] : (hi2 ? px * sn[j] + x[j] * cs[j] : x[j] * cs[j] - px * sn[j]); }
                if (act) *(u32x4*)((qk == 0 ? Qh : Kh) + orow * 96 + 8 * ch) = pack8(o8);
            }
            if (ch < 8) *(u32x4*)(Vh + orow * 64 + 8 * ch) = cur.v[pass];
        }
        cur = nxt;
    }
}

constexpr int KROW = 208, VROW = 160;
constexpr int KBUF = 128 * KROW, VBUF = 128 * VROW;
typedef short v4i16_t __attribute__((ext_vector_type(4)));
__device__ __forceinline__ void attn_chunk(LAS unsigned char* kb, LAS unsigned char* vb, const bf16x8 (&qf)[3], f32x4 (&o)[4], float& mrun, float& lrun, int fr, int g) {
    f32x4 sacc[4];
#pragma unroll
    for (int kt = 0; kt < 4; ++kt) { sacc[kt] = (f32x4){0.f, 0.f, 0.f, 0.f};
#pragma unroll
        for (int ks = 0; ks < 3; ++ks) { const bf16x8 kf = *(const LAS bf16x8*)(kb + (16 * kt + fr) * KROW + (ks * 32 + g * 8) * 2);
            sacc[kt] = __builtin_amdgcn_mfma_f32_16x16x32_bf16(kf, qf[ks], sacc[kt], 0, 0, 0); } }
    float mx = sacc[0][0];
#pragma unroll
    for (int kt = 0; kt < 4; ++kt)
#pragma unroll
        for (int r = 0; r < 4; ++r) mx = fmaxf(mx, sacc[kt][r]);
    mx = fmaxf(mx, __shfl_xor(mx, 16)); mx = fmaxf(mx, __shfl_xor(mx, 32));
    const float mnew = fmaxf(mrun, mx), alpha = __builtin_amdgcn_exp2f(mrun - mnew); mrun = mnew;
    float ps = 0.f;
#pragma unroll
    for (int kt = 0; kt < 4; ++kt)
#pragma unroll
        for (int r = 0; r < 4; ++r) { const float p = __builtin_amdgcn_exp2f(sacc[kt][r] - mnew); sacc[kt][r] = p; ps += p; }
    lrun = lrun * alpha + ps;
#pragma unroll
    for (int dt = 0; dt < 4; ++dt) o[dt] = o[dt] * alpha;
#pragma unroll
    for (int s2 = 0; s2 < 2; ++s2) {
        u32x4 pw; pw.x = pk2(sacc[2 * s2][0], sacc[2 * s2][1]); pw.y = pk2(sacc[2 * s2][2], sacc[2 * s2][3]); pw.z = pk2(sacc[2 * s2 + 1][0], sacc[2 * s2 + 1][1]); pw.w = pk2(sacc[2 * s2 + 1][2], sacc[2 * s2 + 1][3]);
        const bf16x8 pb = __builtin_bit_cast(bf16x8, pw);
#pragma unroll
        for (int dt = 0; dt < 4; ++dt) {
            LAS unsigned char* va = vb + (32 * s2 + 4 * g + (fr >> 2)) * VROW + (16 * dt + 4 * (fr & 3)) * 2;
            const v4i16_t t0 = __builtin_amdgcn_ds_read_tr16_b64_v4i16((LAS v4i16_t*)va), t1 = __builtin_amdgcn_ds_read_tr16_b64_v4i16((LAS v4i16_t*)(va + 16 * VROW));
            const bf16x8 vf = (bf16x8){t0[0], t0[1], t0[2], t0[3], t1[0], t1[1], t1[2], t1[3]};
            o[dt] = __builtin_amdgcn_mfma_f32_16x16x32_bf16(vf, pb, o[dt], 0, 0, 0); }
    }
}
__device__ __forceinline__ void attn_unit(const Ctx& c, int b, int h, int qb) {
    const bf16_t* Qh = WSP(bf16_t, WS_R4); const bf16_t* Kh = WSP(bf16_t, WS_R3); const bf16_t* Vh = WSP(bf16_t, WS_R0); bf16_t* AO = WSP(bf16_t, WS_R0 + 32 * MiB);
    const int fr = c.lane & 15, g = c.lane >> 4, wid = c.wave;
    const size_t hb = (size_t)(b * H + h) * S;
    const int q0 = qb * 128 + wid * 16;
    const int nsup = qb + 1;
    bf16x8 qf[3];
#pragma unroll
    for (int ks = 0; ks < 3; ++ks) qf[ks] = *(const bf16x8*)(Qh + (hb + q0 + fr) * 96 + ks * 32 + g * 8);
    f32x4 o[4];
#pragma unroll
    for (int dt = 0; dt < 4; ++dt) o[dt] = (f32x4){0.f, 0.f, 0.f, 0.f};
    float mrun = -1e30f, lrun = 0.f;
    u32x4 kr[3], vr[2];
    const u32x4* Ksrc = (const u32x4*)(Kh + hb * 96); const u32x4* Vsrc = (const u32x4*)(Vh + hb * 64);
#pragma unroll
    for (int i = 0; i < 3; ++i) kr[i] = Ksrc[c.tid + 512 * i];
#pragma unroll
    for (int i = 0; i < 2; ++i) vr[i] = Vsrc[c.tid + 512 * i];
    for (int j = 0; j < nsup; ++j) {
        LAS unsigned char* kb = c.lds + (j & 1) * (KBUF + VBUF); LAS unsigned char* vb = kb + KBUF;
#pragma unroll
        for (int i = 0; i < 3; ++i) { const int kc = c.tid + 512 * i; *(LAS u32x4*)(kb + (kc / 12) * KROW + (kc % 12) * 16) = kr[i]; }
#pragma unroll
        for (int i = 0; i < 2; ++i) { const int vc = c.tid + 512 * i; *(LAS u32x4*)(vb + (vc >> 3) * VROW + (vc & 7) * 16) = vr[i]; }
        __syncthreads();
        if (j + 1 < nsup) {
#pragma unroll
            for (int i = 0; i < 3; ++i) kr[i] = Ksrc[(j + 1) * 1536 + c.tid + 512 * i];
#pragma unroll
            for (int i = 0; i < 2; ++i) vr[i] = Vsrc[(j + 1) * 1024 + c.tid + 512 * i];
        }
        attn_chunk(kb, vb, qf, o, mrun, lrun, fr, g);
        if (j + 1 < nsup || wid >= 4) attn_chunk(kb + 64 * KROW, vb + 64 * VROW, qf, o, mrun, lrun, fr, g);
    }
    float lt = lrun + __shfl_xor(lrun, 16); lt += __shfl_xor(lt, 32);
    const float inv = 1.f / lt;
    bf16_t* orow = AO + ((size_t)b * S + q0 + fr) * 512 + h * 64;
#pragma unroll
    for (int dt = 0; dt < 4; ++dt) { u32x2 w; w.x = pk2(o[dt][0] * inv, o[dt][1] * inv); w.y = pk2(o[dt][2] * inv, o[dt][3] * inv); *(u32x2*)(orow + 16 * dt + 4 * g) = w; }
    __syncthreads();
}
__device__ __forceinline__ void phase_attn(const Ctx& c0) {
    Ctx c = c0; c.lane = lane_id_v(); c.tid = c.wave * 64 + c.lane;
    for (int v = c.vcu; v < 256; v += c.G) {
        const int bh = v >> 1, odd = v & 1;
        for (int i = 0; i < 8; ++i) {
            const int setA[8] = {15, 12, 10, 9, 6, 5, 3, 0}, setB[8] = {14, 13, 11, 8, 7, 4, 2, 1};
            int qb = 0;
#pragma unroll
            for (int k = 0; k < 8; ++k) if (k == i) qb = odd ? setB[k] : setA[k];
            attn_unit(c, bh >> 3, bh & 7, qb);
        }
    }
}

__device__ __forceinline__ float wave_max(float v) {
#pragma unroll
    for (int o = 1; o < 64; o <<= 1) v = fmaxf(v, __shfl_xor(v, o));
    return v;
}
__device__ __forceinline__ int wave_min_i(int v) {
#pragma unroll
    for (int o = 1; o < 64; o <<= 1) v = min(v, __shfl_xor(v, o));
    return v;
}
__device__ __forceinline__ int prefix_cnt(unsigned long long m) { return (int)__builtin_amdgcn_mbcnt_hi((unsigned)(m >> 32), __builtin_amdgcn_mbcnt_lo((unsigned)m, 0u)); }
template <int NV, int NBITS> __device__ __forceinline__ void select16(const unsigned (&key)[NV], int (&slot)[NV]) {
    unsigned tau = 0u;
    for (int bit = NBITS - 1; bit >= 0; --bit) {
        const unsigned trial = tau | (1u << bit); int cnt = 0;
#pragma unroll
        for (int j = 0; j < NV; ++j) cnt += __popcll(__ballot(key[j] >= trial));
        if (cnt >= 16) { tau = trial; if (cnt == 16) break; }
    }
    int base = 0;
#pragma unroll
    for (int j = 0; j < NV; ++j) { const unsigned long long m = __ballot(key[j] > tau); slot[j] = (key[j] > tau) ? base + prefix_cnt(m) : -1; base += __popcll(m); }
#pragma unroll
    for (int j = 0; j < NV; ++j) { const unsigned long long m = __ballot(key[j] == tau); if (key[j] == tau) { const int s = base + prefix_cnt(m); slot[j] = s < 16 ? s : -1; } base += __popcll(m); }
}
template <int N> __device__ __forceinline__ void bitonic_stage_desc(unsigned (&x)[N], int k, int j) {
#pragma unroll
    for (int i = 0; i < N; ++i) { const int l = i ^ j; if (l > i) { const bool asc = ((i & k) != 0);
        const unsigned a = x[i], b = x[l]; const unsigned hi = a > b ? a : b, lo = a > b ? b : a; x[i] = asc ? lo : hi; x[l] = asc ? hi : lo; } }
}
__device__ __forceinline__ void sort16_desc(unsigned (&x)[16]) {
#pragma unroll
    for (int k = 2; k <= 16; k <<= 1)
#pragma unroll
        for (int j = k >> 1; j > 0; j >>= 1) bitonic_stage_desc<16>(x, k, j);
}
__device__ __forceinline__ void merge16_desc(unsigned (&run)[16], const unsigned (&ch)[16]) {
#pragma unroll
    for (int i = 0; i < 16; ++i) run[i] = run[i] > ch[15 - i] ? run[i] : ch[15 - i];
#pragma unroll
    for (int j = 8; j > 0; j >>= 1) bitonic_stage_desc<16>(run, 16, j);
}
__device__ __forceinline__ unsigned mono_hi(unsigned w) { return w ^ ((unsigned)((int)w >> 31) | 0x80000000u); }
__device__ __forceinline__ float demono_hi(unsigned k) { const unsigned kk = k & 0xffff0000u; return __builtin_bit_cast(float, (kk ^ ((unsigned)(~(int)kk >> 31) | 0x80000000u)) & 0xffff0000u); }
__device__ __forceinline__ void top16_list(LAS const unsigned char* row, int sw, unsigned (&run)[16]) {
#pragma unroll
    for (int ck = 0; ck < 8; ++ck) {
        const u32x4 w0 = *(LAS const u32x4*)(row + (((2 * ck) ^ sw) << 4)), w1 = *(LAS const u32x4*)(row + (((2 * ck + 1) ^ sw) << 4));
        const unsigned w[8] = {w0.x, w0.y, w0.z, w0.w, w1.x, w1.y, w1.z, w1.w};
        unsigned ch[16];
#pragma unroll
        for (int i = 0; i < 8; ++i) { ch[2 * i] = (mono_hi(w[i] << 16) & 0xffff0000u) | (unsigned)(ck * 16 + 2 * i); ch[2 * i + 1] = (mono_hi(w[i]) & 0xffff0000u) | (unsigned)(ck * 16 + 2 * i + 1); }
        sort16_desc(ch);
        if (ck == 0) {
#pragma unroll
            for (int i = 0; i < 16; ++i) run[i] = ch[i];
        } else merge16_desc(run, ch);
    }
}
__device__ __forceinline__ void topk_fetch(const bf16_t* src, u32x4 (&r)[16], int L) {
#pragma unroll
    for (int i = 0; i < 16; ++i) r[i] = *(const u32x4*)(src + (size_t)(4 * i + (L >> 4)) * 256 + (L & 15) * 8);
}
__device__ __forceinline__ void topk_stage(LAS unsigned char* tile, const u32x4 (&r)[16], int L) {
#pragma unroll
    for (int i = 0; i < 16; ++i) { const int row = 4 * i + (L >> 4); *(LAS u32x4*)(tile + row * 256 + ((((L & 15) ^ (row & 15))) << 4)) = r[i]; }
}
__device__ __forceinline__ void phase_topk(const Ctx& c0) {
    Ctx c = c0; c.lane = lane_id_v(); c.tid = c.wave * 64 + c.lane;
    const bf16_t* sc = WSP(bf16_t, WS_SC); int* IDX = WSP(int, WS_IDX); float* GW = WSP(float, WS_GW);
    const int L = c.lane, gw0 = (c.vcu * 8 + c.wave) * 64, NL = c.G * 512;
    LAS unsigned char* tile = c.lds + c.wave * 16384;
    LAS const unsigned char* myrow = tile + L * 256; const int sw = L & 15;
    for (int eb = gw0; eb < T * H; eb += NL) {
        const int e = eb + L;
        unsigned ka[16], kb[16];
        u32x4 ra[16], rb[16];
        topk_fetch(sc + (size_t)eb * 256, ra, L);
        topk_fetch(sc + (size_t)eb * 256 + 128, rb, L);
        topk_stage(tile, ra, L);
        top16_list(myrow, sw, ka);
        topk_stage(tile, rb, L);
        top16_list(myrow, sw, kb);
        float sa[16], sb[16]; unsigned ia[16], ib[16];
#pragma unroll
        for (int i = 0; i < 16; ++i) { sa[i] = demono_hi(ka[i]); sb[i] = demono_hi(kb[i]); ia[i] = (ka[i] & 0x7fu) << 7; ib[i] = kb[i] & 0x7fu; }
        const float mx = sa[0] + sb[0];
        unsigned run[16], ch[16]; int n = 0, nc = 0;
#pragma unroll
        for (int a = 0; a < 16; ++a)
#pragma unroll
            for (int b = 0; b < 16; ++b) if ((a + 1) * (b + 1) <= 16) {
                const int k = 65535 + (int)((sa[a] + sb[b] - mx) * 1024.f);
                ch[n] = ((unsigned)(k < 0 ? 0 : k) << 16) | ia[a] | ib[b];
                if (++n == 16) { sort16_desc(ch); if (nc == 0) {
#pragma unroll
                        for (int i = 0; i < 16; ++i) run[i] = ch[i]; } else merge16_desc(run, ch);
                    n = 0; ++nc; }
            }
#pragma unroll
        for (int i = 2; i < 16; ++i) ch[i] = 0u;
        sort16_desc(ch); merge16_desc(run, ch);
        float ex[16]; float sum = 0.f;
#pragma unroll
        for (int i = 0; i < 16; ++i) { ex[i] = __expf((float)((int)(run[i] >> 16) - 65535) * (1.f / 1024.f)); sum += ex[i]; }
        const float inv = 1.f / sum;
        u32x4* oi = (u32x4*)(IDX + (size_t)e * 16); f32x4* og = (f32x4*)(GW + (size_t)e * 16);
#pragma unroll
        for (int q = 0; q < 4; ++q) { u32x4 vi; vi.x = run[4 * q] & 0x3fffu; vi.y = run[4 * q + 1] & 0x3fffu; vi.z = run[4 * q + 2] & 0x3fffu; vi.w = run[4 * q + 3] & 0x3fffu; oi[q] = vi;
            f32x4 vg; vg.x = ex[4 * q] * inv; vg.y = ex[4 * q + 1] * inv; vg.z = ex[4 * q + 2] * inv; vg.w = ex[4 * q + 3] * inv; og[q] = vg; }
    }
}

__device__ __forceinline__ void dec32_fp4(const u32x4 r, f32x2 (&f)[16]) {
    const unsigned w[4] = {r.x, r.y, r.z, r.w};
#pragma unroll
    for (int i = 0; i < 4; ++i) { f[4 * i] = __builtin_amdgcn_cvt_scalef32_pk_f32_fp4(w[i], 1.0f, 0); f[4 * i + 1] = __builtin_amdgcn_cvt_scalef32_pk_f32_fp4(w[i], 1.0f, 1);
        f[4 * i + 2] = __builtin_amdgcn_cvt_scalef32_pk_f32_fp4(w[i], 1.0f, 2); f[4 * i + 3] = __builtin_amdgcn_cvt_scalef32_pk_f32_fp4(w[i], 1.0f, 3); }
}
__device__ __forceinline__ float dot32_fp4(const f32x2 (&hv)[16], const u32x4 r) {
    f32x2 f[16]; dec32_fp4(r, f); f32x2 s = hv[0] * f[0];
#pragma unroll
    for (int j = 1; j < 16; ++j) s = s + hv[j] * f[j];
    return s.x + s.y;
}
typedef int i32x8 __attribute__((ext_vector_type(8)));
__device__ __forceinline__ void phase_peer_u(const Ctx& c0) {
    Ctx c = c0; c.lane = lane_id_v(); c.tid = c.wave * 64 + c.lane;
    const int* IDX = WSP(int, WS_IDX);
    const int L = c.lane, pp = blockIdx.x & 3, hh = (blockIdx.x >> 2) & 1, rank = blockIdx.x >> 3, nrank = c.G >> 3;
    LAS int* mb = (LAS int*)(c.lds + c.wave * 1024);
    const int vr = L & 15, g4 = L >> 4;
    const unsigned char* EU4b = c.ws + WS_EU + (size_t)pp * NE * 128;
    const unsigned char* H8 = c.ws + WS_H2Q + pp * 256 + (vr & 1) * 128 + g4 * 16;
    float* PD = WSP(float, WS_PD) + (size_t)(2 * pp + (vr & 1)) * T * 128 + 2 * g4;
    const int t0 = 2 * (rank * 8 + c.wave) + hh, ts = 2 * nrank * 8;
    if (t0 >= T) return;
    int sc1 = 0x7f7f7f7f; asm volatile("" : "+v"(sc1));
    const bool swapb = WSP(unsigned, WS_C8SP)[1024] != 0u;
    { const int g0 = IDX[(size_t)t0 * 128 + L], g1 = IDX[(size_t)t0 * 128 + 64 + L]; mb[L] = g0; mb[64 + L] = g1; }
    u32x4 rA[16], rB[16];
    { const unsigned char* EU4 = EU4b + (vr & 1) * 64 + g4 * 16;
#pragma unroll
      for (int G = 0; G < 16; ++G) rA[G] = *(const u32x4*)(EU4 + (size_t)mb[8 * G + (vr >> 1)] * 128); }
    int cur = 0;
#define PEER_U_TOKEN(RC, RN, tcur, tnext, tnext2) do { \
        int lo = (vr & 1) * 64 + g4 * 16; asm volatile("" : "+v"(lo)); const unsigned char* EU4 = EU4b + lo; \
        const int gn0 = IDX[(size_t)(tnext2) * 128 + L], gn1 = IDX[(size_t)(tnext2) * 128 + 64 + L]; \
        i32x8 hb = (i32x8){0, 0, 0, 0, 0, 0, 0, 0}; \
        if (vr < 2) { const u32x4 h0 = *(const u32x4*)(H8 + (size_t)(tcur) * 1024), h1 = *(const u32x4*)(H8 + (size_t)(tcur) * 1024 + 64); \
            unsigned hw[8] = {h0.x, h0.y, h0.z, h0.w, h1.x, h1.y, h1.z, h1.w}; \
            if (swapb) { _Pragma("unroll") for (int q = 0; q < 8; ++q) hw[q] = ((hw[q] & 0x00ff00ffu) << 8) | ((hw[q] >> 8) & 0x00ff00ffu); } \
            hb = (i32x8){(int)hw[0], (int)hw[1], (int)hw[2], (int)hw[3], (int)hw[4], (int)hw[5], (int)hw[6], (int)hw[7]}; } \
          \
        _Pragma("unroll") for (int G = 0; G < 16; ++G) RN[G] = *(const u32x4*)(EU4 + (size_t)mb[(cur ^ 1) * 128 + 8 * G + (vr >> 1)] * 128); \
          \
        mb[cur * 128 + L] = gn0; mb[cur * 128 + 64 + L] = gn1; \
        f32x4 acc[16]; \
        _Pragma("unroll") for (int G = 0; G < 16; ++G) { const i32x8 a = (i32x8){(int)RC[G].x, (int)RC[G].y, (int)RC[G].z, (int)RC[G].w, 0, 0, 0, 0}; \
            acc[G] = __builtin_amdgcn_mfma_scale_f32_16x16x128_f8f6f4(a, hb, (f32x4){0.f, 0.f, 0.f, 0.f}, 4, 0, 0, sc1, 0, sc1); } \
        if (vr < 2) { _Pragma("unroll") for (int G = 0; G < 16; ++G) { f32x2 o; o.x = vr ? acc[G][1] : acc[G][0]; o.y = vr ? acc[G][3] : acc[G][2]; *(f32x2*)(PD + (size_t)(tcur) * 128 + 8 * G) = o; } } \
        cur ^= 1; } while (0)
    { const int t1 = (t0 + ts < T) ? t0 + ts : t0; const int g0 = IDX[(size_t)t1 * 128 + L], g1 = IDX[(size_t)t1 * 128 + 64 + L]; mb[128 + L] = g0; mb[128 + 64 + L] = g1; }
#pragma unroll 1
    for (int t = t0; t < T; t += 2 * ts) {
        const int ta = t, tb = (t + ts < T) ? t + ts : t, tc = (t + 2 * ts < T) ? t + 2 * ts : tb, td = (t + 3 * ts < T) ? t + 3 * ts : tc;
        PEER_U_TOKEN(rA, rB, ta, tb, tc);
        if (t + ts < T) PEER_U_TOKEN(rB, rA, tb, tc, td);
    }
#undef PEER_U_TOKEN
}
__device__ __forceinline__ void phase_peer_fin(const Ctx& c0) {
    Ctx c = c0; c.lane = lane_id_v(); c.tid = c.wave * 64 + c.lane;
    const int* IDX = WSP(int, WS_IDX); const float* GW = WSP(float, WS_GW); const float* PD = WSP(float, WS_PD); unsigned* WGT = WSP(unsigned, WS_WGT);
    const float* SU = WSP(float, WS_SU); const float* SV = WSP(float, WS_SV); const float* SH = WSP(float, WS_SH);
    const int NTH = c.G * 512;
    for (int i0 = c.vcu * 512 + c.tid; i0 < T * 128; i0 += 4 * NTH) {
        float d[4]; int e[4]; float g[4];
#pragma unroll
        for (int u = 0; u < 4; ++u) { const int i = (i0 + u * NTH < T * 128) ? i0 + u * NTH : i0; float s = 0.f;
#pragma unroll
            for (int p = 0; p < 8; ++p) s += PD[(size_t)p * T * 128 + i];
            d[u] = s; e[u] = IDX[i]; g[u] = GW[i]; }
        float su[4], sv[4], sh[4];
#pragma unroll
        for (int u = 0; u < 4; ++u) { const int i = (i0 + u * NTH < T * 128) ? i0 + u * NTH : i0; su[u] = SU[e[u]]; sv[u] = SV[e[u]]; sh[u] = SH[i >> 7]; }
#pragma unroll
        for (int u = 0; u < 4; ++u) { const int i = i0 + u * NTH; if (i < T * 128) WGT[i] = (f2bf(g[u] * gelu_tanh(d[u] * su[u] * sh[u]) * sv[u]) << 16) | (unsigned)e[u]; }
    }
}
template <bool DRY> __device__ __forceinline__ void phase_peer_v(const Ctx& c0) {
    Ctx c = c0; c.lane = lane_id_v(); c.tid = c.wave * 64 + c.lane;
    const unsigned* WI = WSP(unsigned, WS_WGT); const float* mod = WSP(float, WS_MOD);
    const int L = c.lane, pp = blockIdx.x & 3, hh = (blockIdx.x >> 2) & 1, rank = blockIdx.x >> 3, nrank = c.G >> 3;
    const bool b5 = L & 32, b4 = L & 16, b3 = L & 8;
    LAS unsigned* mb = (LAS unsigned*)(c.lds + c.wave * 1024);
    const int kl = L >> 3;
    const unsigned char* EV4 = c.ws + WS_EV + (size_t)pp * NE * 128 + (L & 7) * 16;
    const int col = pp * 256 + (L & 7) * 32 + (b5 ? 16 : 0) + (b4 ? 8 : 0) + (b3 ? 4 : 0);
    const int t0 = 2 * (rank * 8 + c.wave) + hh, ts = 2 * nrank * 8;
    if (t0 >= T) return;
    { const unsigned g0 = WI[(size_t)t0 * 128 + L], g1 = WI[(size_t)t0 * 128 + 64 + L]; mb[L] = g0; mb[64 + L] = g1; }
    u32x4 rA[8], rB[8];
#pragma unroll
    for (int i = 0; i < 8; ++i) rA[i] = *(const u32x4*)(EV4 + (size_t)(mb[8 * i + kl] & 0xffffu) * 128);
    int cur = 0;
#pragma unroll 1
    for (int t = t0; t < T; t += ts) {
        const int tn = (t + ts < T) ? t + ts : t;
        const unsigned gn0 = WI[(size_t)tn * 128 + L], gn1 = WI[(size_t)tn * 128 + 64 + L];
        float* o = c.out + (size_t)t * 1024 + col; const float* g2 = mod + (t >> 11) * 6144 + 5120 + col;
        f32x4 xo = *(const f32x4*)o; const f32x4 gt = *(const f32x4*)g2;
#pragma unroll
        for (int i = 0; i < 8; ++i) rB[i] = *(const u32x4*)(EV4 + (size_t)(mb[cur * 128 + 64 + 8 * i + kl] & 0xffffu) * 128);
        f32x2 ac2[16];
#pragma unroll
        for (int j = 0; j < 16; ++j) ac2[j] = (f32x2){0.f, 0.f};
#pragma unroll
        for (int i = 0; i < 8; ++i) { const float w = bfhi(mb[cur * 128 + 8 * i + kl]); const f32x2 w2 = {w, w}; f32x2 f[16]; dec32_fp4(rA[i], f);
#pragma unroll
            for (int j = 0; j < 16; ++j) ac2[j] = ac2[j] + f[j] * w2; }
        mb[(cur ^ 1) * 128 + L] = gn0; mb[(cur ^ 1) * 128 + 64 + L] = gn1;
#pragma unroll
        for (int i = 0; i < 8; ++i) rA[i] = *(const u32x4*)(EV4 + (size_t)(mb[(cur ^ 1) * 128 + 8 * i + kl] & 0xffffu) * 128);
#pragma unroll
        for (int i = 0; i < 8; ++i) { const float w = bfhi(mb[cur * 128 + 64 + 8 * i + kl]); const f32x2 w2 = {w, w}; f32x2 f[16]; dec32_fp4(rB[i], f);
#pragma unroll
            for (int j = 0; j < 16; ++j) ac2[j] = ac2[j] + f[j] * w2; }
        float acc[32];
#pragma unroll
        for (int j = 0; j < 16; ++j) { acc[2 * j] = ac2[j].x; acc[2 * j + 1] = ac2[j].y; }
        float n16[16], n8[8], n4[4];
#pragma unroll
        for (int i = 0; i < 16; ++i) { const float send = b5 ? acc[i] : acc[i + 16], keep = b5 ? acc[i + 16] : acc[i]; n16[i] = keep + __shfl_xor(send, 32); }
#pragma unroll
        for (int i = 0; i < 8; ++i) { const float send = b4 ? n16[i] : n16[i + 8], keep = b4 ? n16[i + 8] : n16[i]; n8[i] = keep + __shfl_xor(send, 16); }
#pragma unroll
        for (int i = 0; i < 4; ++i) { const float send = b3 ? n8[i] : n8[i + 4], keep = b3 ? n8[i + 4] : n8[i]; n4[i] = keep + __shfl_xor(send, 8); }
        xo.x += gt.x * n4[0]; xo.y += gt.y * n4[1]; xo.z += gt.z * n4[2]; xo.w += gt.w * n4[3];
        if (DRY) asm volatile("" :: "v"(xo.x), "v"(xo.y), "v"(xo.z), "v"(xo.w)); else *(f32x4*)o = xo;
        cur ^= 1;
    }
}

struct ENone {};
struct FInProj { static constexpr int NB = 4; bf16_t *pa, *lx, *lg, *mg; typedef ENone Tile; typedef ENone Pre;
    __device__ __forceinline__ Tile tile(int, int, int) const { return Tile{}; }
    __device__ __forceinline__ Pre pre(int, int, int) const { return Pre{}; }
    __device__ __forceinline__ void apply(int row, int pn, int cc, const float (&v0)[8], const float (&v1)[8], const Pre&, const Tile&) const {
        bf16_t* d;
        if (pn < 2) d = pa + (size_t)row * 512 + pn * 256 + cc; else if (pn < 6) d = lx + (size_t)row * 1024 + (pn - 2) * 256 + cc;
        else if (pn < 10) d = lg + (size_t)row * 1024 + (pn - 6) * 256 + cc; else d = mg + (size_t)row * 2048 + (pn - 10) * 256 + cc;
        *(u32x4*)d = pack8(v0); *(u32x4*)(d + 128) = pack8(v1); } };
struct FRowScale { static constexpr int NB = 4; bf16_t* dst; int ldc; const float* rstd; int which; typedef ENone Tile; struct Pre { float r; };
    __device__ __forceinline__ Tile tile(int, int, int) const { return Tile{}; }
    __device__ __forceinline__ Pre pre(int row, int, int) const { return Pre{rstd[2 * row + which]}; }
    __device__ __forceinline__ void apply(int row, int pn, int cc, const float (&v0)[8], const float (&v1)[8], const Pre& p, const Tile&) const {
        float a[8], b[8];
#pragma unroll
        for (int j = 0; j < 8; ++j) { a[j] = v0[j] * p.r; b[j] = v1[j] * p.r; }
        *(u32x4*)(dst + (size_t)row * ldc + pn * 256 + cc) = pack8(a); *(u32x4*)(dst + (size_t)row * ldc + pn * 256 + 128 + cc) = pack8(b); } };
constexpr int GT_OFF = 132096;
struct FGates { static constexpr int NB = 2; const bf16_t* xc; bf16_t *LA, *Bv; LAS const float* gt;
    typedef ENone Tile; struct Pre { u32x4 x; };
    __device__ __forceinline__ Tile tile(int, int, int) const { return Tile{}; }
    __device__ __forceinline__ Pre pre(int row, int pn, int cc) const { return Pre{*(const u32x4*)(xc + (size_t)row * 1024 + pn * 128 + cc)}; }
    __device__ __forceinline__ void apply(int row, int pn, int cc, const float (&v0)[8], const float (&v1)[8], const Pre& p, const Tile&) const {
        const int ch = pn * 128 + cc; float x[8], la[8], bv[8]; unpack8(p.x, x);
        const f32x4 br0 = *(LAS const f32x4*)(gt + ch), br1 = *(LAS const f32x4*)(gt + ch + 4), bi0 = *(LAS const f32x4*)(gt + 1024 + ch), bi1 = *(LAS const f32x4*)(gt + 1024 + ch + 4),
                    c80 = *(LAS const f32x4*)(gt + 2048 + ch), c81 = *(LAS const f32x4*)(gt + 2048 + ch + 4);
        const float br[8] = {br0.x, br0.y, br0.z, br0.w, br1.x, br1.y, br1.z, br1.w}, bi[8] = {bi0.x, bi0.y, bi0.z, bi0.w, bi1.x, bi1.y, bi1.z, bi1.w}, c8[8] = {c80.x, c80.y, c80.z, c80.w, c81.x, c81.y, c81.z, c81.w};
#pragma unroll
        for (int j = 0; j < 8; ++j) {
            const float r = __builtin_amdgcn_rcpf(1.f + __expf(-(v0[j] + br[j]))), ig = __builtin_amdgcn_rcpf(1.f + __expf(-(v1[j] + bi[j])));
            const float loga = r * c8[j];
            const float z = 2.f * loga;
            const float ser = -z * (1.f + z * (0.5f + z * (0.16666667f + z * (0.041666668f + z * (0.008333334f + z * 0.0013888889f)))));
            const float om = (z > -0.25f) ? ser : (1.f - __expf(z));
            la[j] = loga * 1.4426950408889634f;
            bv[j] = sqrtf(om) * (ig * x[j]);
        }
        *(u32x4*)(LA + (size_t)row * 1024 + ch) = pack8(la); *(u32x4*)(Bv + (size_t)row * 1024 + ch) = pack8(bv); } };
struct FY1 { static constexpr int NB = 4; const bf16_t* mg; bf16_t* y; int goff; bool accum; typedef ENone Tile; struct Pre { u32x4 g0, g1, y0, y1; };
    __device__ __forceinline__ Tile tile(int, int, int) const { return Tile{}; }
    __device__ __forceinline__ Pre pre(int row, int pn, int cc) const { Pre p; const int col = pn * 256 + cc;
        p.g0 = *(const u32x4*)(mg + (size_t)row * 2048 + goff + col); p.g1 = *(const u32x4*)(mg + (size_t)row * 2048 + goff + col + 128);
        if (accum) { p.y0 = *(const u32x4*)(y + (size_t)row * 1024 + col); p.y1 = *(const u32x4*)(y + (size_t)row * 1024 + col + 128); } else { p.y0 = (u32x4){0u, 0u, 0u, 0u}; p.y1 = p.y0; }
        return p; }
    __device__ __forceinline__ void one(bf16_t* dst, const u32x4 g, const u32x4 yo, const float (&v)[8]) const {
        float gt[8], o[8]; unpack8(g, gt); unpack8(yo, o);
#pragma unroll
        for (int j = 0; j < 8; ++j) o[j] = o[j] + sigmoidf_(gt[j]) * v[j];
        *(u32x4*)dst = pack8(o); }
    __device__ __forceinline__ void apply(int row, int pn, int cc, const float (&v0)[8], const float (&v1)[8], const Pre& p, const Tile&) const {
        bf16_t* d = y + (size_t)row * 1024 + pn * 256 + cc; one(d, p.g0, p.y0, v0); one(d + 128, p.g1, p.y1, v1); } };
struct FX1 { static constexpr int NB = 4; const float* x; float* out; const float* mod; struct Tile { f32x4 a[4]; }; struct Pre { f32x4 x[4]; };
    __device__ __forceinline__ Tile tile(int pn, int cc, int pm) const { Tile t; const float* g1 = mod + ((pm * 256) >> 11) * 6144 + 2048 + pn * 256 + cc;
        t.a[0] = *(const f32x4*)g1; t.a[1] = *(const f32x4*)(g1 + 4); t.a[2] = *(const f32x4*)(g1 + 128); t.a[3] = *(const f32x4*)(g1 + 132); return t; }
    __device__ __forceinline__ Pre pre(int row, int pn, int cc) const { Pre p; const float* xr = x + (size_t)row * 1024 + pn * 256 + cc;
        p.x[0] = *(const f32x4*)xr; p.x[1] = *(const f32x4*)(xr + 4); p.x[2] = *(const f32x4*)(xr + 128); p.x[3] = *(const f32x4*)(xr + 132); return p; }
    __device__ __forceinline__ void apply(int row, int pn, int cc, const float (&v0)[8], const float (&v1)[8], const Pre& p, const Tile& t) const {
        float* o = out + (size_t)row * 1024 + pn * 256 + cc;
        f32x4 r0, r1, r2, r3;
        r0.x = p.x[0].x + t.a[0].x * v0[0]; r0.y = p.x[0].y + t.a[0].y * v0[1]; r0.z = p.x[0].z + t.a[0].z * v0[2]; r0.w = p.x[0].w + t.a[0].w * v0[3];
        r1.x = p.x[1].x + t.a[1].x * v0[4]; r1.y = p.x[1].y + t.a[1].y * v0[5]; r1.z = p.x[1].z + t.a[1].z * v0[6]; r1.w = p.x[1].w + t.a[1].w * v0[7];
        r2.x = p.x[2].x + t.a[2].x * v1[0]; r2.y = p.x[2].y + t.a[2].y * v1[1]; r2.z = p.x[2].z + t.a[2].z * v1[2]; r2.w = p.x[2].w + t.a[2].w * v1[3];
        r3.x = p.x[3].x + t.a[3].x * v1[4]; r3.y = p.x[3].y + t.a[3].y * v1[5]; r3.z = p.x[3].z + t.a[3].z * v1[6]; r3.w = p.x[3].w + t.a[3].w * v1[7];
        *(f32x4*)o = r0; *(f32x4*)(o + 4) = r1; *(f32x4*)(o + 128) = r2; *(f32x4*)(o + 132) = r3; } };
struct FStore { static constexpr int NB = 4; bf16_t* dst; int ldc; typedef ENone Tile; typedef ENone Pre;
    __device__ __forceinline__ Tile tile(int, int, int) const { return Tile{}; }
    __device__ __forceinline__ Pre pre(int, int, int) const { return Pre{}; }
    __device__ __forceinline__ void apply(int row, int pn, int cc, const float (&v0)[8], const float (&v1)[8], const Pre&, const Tile&) const {
        *(u32x4*)(dst + (size_t)row * ldc + pn * 256 + cc) = pack8(v0); *(u32x4*)(dst + (size_t)row * ldc + pn * 256 + 128 + cc) = pack8(v1); } };

template <int M, int N, int K, int LDA, int ACS, class F> __device__ __forceinline__ void run_gemm(const Ctx& c, const bf16_t* A, const bf16_t* Bt, const F& f) {
    pg8::Gemm g{A, Bt}; pg8::StaticOrder<M, N> So; So.init(c.G, (int)blockIdx.x);
    pg8::EpiF<F> E{f};
    pg8::gemm_phase<K, LDA, ACS, pg8::EpiF<F>, pg8::StaticOrder<M, N>>((PG8_LAS unsigned char*)c.lds, g, So, E, c.wave * 64 + lane_id_v());
}

__global__ void __launch_bounds__(512, 2) mk_fwd(Args args) {
    extern __shared__ __attribute__((aligned(16))) unsigned char lds_raw[];
    Ctx c;
    c.lds = (LAS unsigned char*)lds_raw;
    c.wave = __builtin_amdgcn_readfirstlane(threadIdx.x >> 6); c.lane = lane_id_v(); c.tid = c.wave * 64 + c.lane;
    c.G = gridDim.x; { const int bx = blockIdx.x; c.vcu = (c.G % 8 == 0) ? (bx % 8) * (c.G / 8) + bx / 8 : bx; }
    c.in = args.in; c.out = args.out; c.ws = args.ws;
    volatile LAS unsigned* MISC = (volatile LAS unsigned*)(c.lds + MISC_OFF);
    if (c.tid < 32) MISC[c.tid] = 0u;
    __syncthreads();
    XcdBarrier bar; bar.bar = (unsigned*)(c.ws + WS_CTL) + 4096; bar.x = 0; bar.st = nullptr;
    if (args.ph_hi - args.ph_lo > 1) bar = xcd_barrier_post((unsigned*)(c.ws + WS_CTL) + 4096, MISC + 8);

    const int lo = args.ph_lo, hi = args.ph_hi;
#ifndef ONLYP
#define ONLYP -1
#endif
#define IN(k) (lo <= (k) && (k) < hi && (ONLYP < 0 || ONLYP == (k)))
#define SEAM(k) do { if ((k) + 1 < hi) xcd_barrier(bar, c.wave); } while (0)
#ifndef REPEAT_MASK
#define REPEAT_MASK 0
#endif
#define PHASE(k, ...) if (IN(k)) { c.lane = lane_id_v(); c.tid = c.wave * 64 + c.lane; { __VA_ARGS__ } if ((REPEAT_MASK >> (k)) & 1) { xcd_barrier(bar, c.wave); { __VA_ARGS__ } } SEAM(k); }
    PHASE(0, phase_prep(c);)
    PHASE(1, phase_modnorm<false>(c, c.in[I_X], c.in[I_N1G], 0, 1024, WSP(bf16_t, WS_R0));)
    PHASE(2, FInProj f{WSP(bf16_t, WS_R1), WSP(bf16_t, WS_R2), WSP(bf16_t, WS_R3), (bf16_t*)c.out};
             run_gemm<T, 4608, 1024, 1024, 0>(c, WSP(bf16_t, WS_R0), WSP(bf16_t, WS_WIN), f);)
    PHASE(3, phase_conv(c);)
    PHASE(4, { LAS float* gtl = (LAS float*)(c.lds + GT_OFF);
               for (int e = c.tid; e < 1024; e += 512) { gtl[e] = c.in[I_BRG][e]; gtl[1024 + e] = c.in[I_BIG][e]; gtl[2048 + e] = WSP(float, WS_C8SP)[e]; }
               __syncthreads();
               FGates fg{WSP(bf16_t, WS_R4), WSP(bf16_t, WS_R0), WSP(bf16_t, WS_R6), gtl};
               run_gemm<T, 2048, 128, 1024, 128>(c, WSP(bf16_t, WS_R4), WSP(bf16_t, WS_WG), fg); }
             { FRowScale fq{WSP(bf16_t, WS_R5), 768, WSP(float, WS_RSTD), 0};
               run_gemm<T, 768, 256, 512, 0>(c, WSP(bf16_t, WS_R1), WSP(bf16_t, WS_WUQ), fq); })
    PHASE(5, { FRowScale fkv{WSP(bf16_t, WS_R2), 1024, WSP(float, WS_RSTD), 1};
               run_gemm<T, 1024, 128, 512, 0>(c, WSP(bf16_t, WS_R1) + 256, WSP(bf16_t, WS_WUKV), fkv); }
             phase_scan(c);)
    PHASE(6, phase_qkv_layout(c);)
    PHASE(7, phase_attn(c);)
    PHASE(8, { FY1 f1{(const bf16_t*)c.out, WSP(bf16_t, WS_R2), 0, false};
               run_gemm<T, 1024, 512, 512, 0>(c, WSP(bf16_t, WS_R0 + 32 * MiB), WSP(bf16_t, WS_WOA), f1); }
             { FY1 f2{(const bf16_t*)c.out, WSP(bf16_t, WS_R2), 1024, true};
               run_gemm<T, 1024, 1024, 1024, 0>(c, WSP(bf16_t, WS_R6), WSP(bf16_t, WS_WOL), f2); })
    PHASE(9, FX1 f{c.in[I_X], c.out, WSP(float, WS_MOD)};
             run_gemm<T, 1024, 1024, 1024, 0>(c, WSP(bf16_t, WS_R2), WSP(bf16_t, WS_WOUT), f);)
    PHASE(10, phase_modnorm<true>(c, c.out, c.in[I_N2G], 3072, 4096, WSP(bf16_t, WS_R0));)
    PHASE(11, FStore f{WSP(bf16_t, WS_SC), 2048};
              run_gemm<T, 2048, 1024, 1024, 0>(c, WSP(bf16_t, WS_R0), WSP(bf16_t, WS_WQ), f);)
    PHASE(13, phase_topk(c);)
    PHASE(14, phase_peer_u(c);)
    PHASE(15, phase_peer_fin(c);)
#ifdef PROBE_VDRY
    if (IN(16)) { c.lane = lane_id_v(); c.tid = c.wave * 64 + c.lane; phase_peer_v<true>(c); xcd_barrier(bar, c.wave); }
#endif
    PHASE(16, phase_peer_v<false>(c);)
#undef PHASE
#undef IN
#undef SEAM
}

extern "C" void kernel_launch(void* const* d_in, const int* in_sizes, int n_in, void* d_out, int out_size, void* d_ws, size_t ws_size, hipStream_t stream) {
    static int grid = 0;
    if (grid == 0) {
        if (n_in != 28 || out_size != T * D || ws_size < WS_END) { fprintf(stderr, "kernel_launch: unexpected shapes (n_in %d out %d ws %zu)\n", n_in, out_size, ws_size); grid = -1; return; }
        int dev = 0, cus = 0, per_cu = 0;
        if (hipGetDevice(&dev) != hipSuccess || hipDeviceGetAttribute(&cus, hipDeviceAttributeMultiprocessorCount, dev) != hipSuccess) { grid = -1; return; }
        if (hipFuncSetAttribute((const void*)mk_fwd, hipFuncAttributeMaxDynamicSharedMemorySize, LDS_BYTES) != hipSuccess) { fprintf(stderr, "kernel_launch: hipFuncSetAttribute failed\n"); grid = -1; return; }
        if (hipOccupancyMaxActiveBlocksPerMultiprocessor(&per_cu, (const void*)mk_fwd, 512, LDS_BYTES) != hipSuccess || per_cu < 1) { fprintf(stderr, "kernel_launch: occupancy query says %d blocks per CU\n", per_cu); grid = -1; (void)hipGetLastError(); return; }
        grid = cus - (cus % 8);
        if (grid < 8) { fprintf(stderr, "kernel_launch: needs at least 8 CUs\n"); grid = -1; return; }
    }
    if (grid < 0) return;
    (void)hipMemsetAsync((char*)d_ws + WS_CTL, 0, CTL_ZERO_BYTES, stream);
    Args a{};
    for (int i = 0; i < 28; ++i) a.in[i] = (const float*)d_in[i];
    a.out = (float*)d_out; a.ws = (unsigned char*)d_ws;
#if MK_N_LAUNCHES == 1
    a.ph_lo = 0; a.ph_hi = N_PHASES;
    hipLaunchKernelGGL(mk_fwd, dim3(grid), dim3(512), LDS_BYTES, stream, a);
#else
    for (int ph = 0; ph < N_PHASES; ++ph) { a.ph_lo = ph; a.ph_hi = ph + 1; hipLaunchKernelGGL(mk_fwd, dim3(grid), dim3(512), LDS_BYTES, stream, a); }
#endif
}
```

```cpp
#include <hip/hip_runtime.h>
#include <cstdio>
#include <cstdint>

#define LAS __attribute__((address_space(3)))
#define GAS __attribute__((address_space(1)))
typedef unsigned short bf16_t;
typedef short bf16x8 __attribute__((ext_vector_type(8)));
typedef float f32x4 __attribute__((ext_vector_type(4)));
typedef float f32x2 __attribute__((ext_vector_type(2)));
typedef unsigned u32x4 __attribute__((ext_vector_type(4)));
typedef unsigned u32x2 __attribute__((ext_vector_type(2)));

#ifndef MK_N_LAUNCHES
#define MK_N_LAUNCHES 1
#endif

constexpr int T = 32768, D = 1024, NB_ = 16, S = 2048, H = 8;
constexpr int QKH = 96, VH = 64;
constexpr int NE = 16384;
constexpr float EPS = 1e-6f;

constexpr size_t MiB = 1u << 20;
constexpr size_t WS_CTL = 0, CTL_ZERO_BYTES = 65536;
constexpr size_t WS_MOD = 1 * MiB;
constexpr size_t WS_RSTD = 1 * MiB + 512 * 1024;
constexpr size_t WS_C8SP = 1 * MiB + 448 * 1024;
constexpr size_t WS_WIN = 2 * MiB;
constexpr size_t WS_WUQ = 11 * MiB;
constexpr size_t WS_WUKV = 11 * MiB + 512 * 1024;
constexpr size_t WS_WOA = 12 * MiB;
constexpr size_t WS_WOL = 13 * MiB;
constexpr size_t WS_WOUT = 15 * MiB;
constexpr size_t WS_WQ = 17 * MiB;
constexpr size_t WS_WG = 21 * MiB;
constexpr size_t WS_SK = 22 * MiB;
constexpr size_t WS_EU = 24 * MiB;
constexpr size_t WS_EV = 40 * MiB;
constexpr size_t WS_SU = 1 * MiB + 768 * 1024;
constexpr size_t WS_SV = 1 * MiB + 832 * 1024;
constexpr size_t WS_WGT = 440 * MiB;
constexpr size_t WS_CS = 56 * MiB;
constexpr size_t WS_H2Q = 456 * MiB;
constexpr size_t WS_SH = 1 * MiB + 896 * 1024;
constexpr size_t WS_PD = 280 * MiB;
constexpr size_t WS_R0 = 88 * MiB;
constexpr size_t WS_R1 = 152 * MiB;
constexpr size_t WS_R2 = 184 * MiB;
constexpr size_t WS_R3 = 248 * MiB;
constexpr size_t WS_R4 = 312 * MiB;
constexpr size_t WS_R5 = 376 * MiB;
constexpr size_t WS_R6 = 424 * MiB;
constexpr size_t WS_QP = 152 * MiB;
constexpr size_t WS_SC = 280 * MiB;
constexpr size_t WS_IDX = 408 * MiB;
constexpr size_t WS_GW = 424 * MiB;
constexpr size_t WS_END = 488 * MiB;

constexpr int LDS_BYTES = 155648;
constexpr int MISC_OFF = 131072 + 320;

__device__ __forceinline__ unsigned f2bf(float f) { unsigned u = __builtin_bit_cast(unsigned, f); return (u + 0x7fffu + ((u >> 16) & 1u)) >> 16; }
typedef __bf16 bf16x2_t __attribute__((ext_vector_type(2)));
__device__ __forceinline__ unsigned pk2(float lo, float hi) { f32x2 v = {lo, hi}; return __builtin_bit_cast(unsigned, __builtin_convertvector(v, bf16x2_t)); }
__device__ __forceinline__ float bf2f(unsigned h) { return __builtin_bit_cast(float, h << 16); }
__device__ __forceinline__ float bflo(unsigned w) { return __builtin_bit_cast(float, w << 16); }
__device__ __forceinline__ float bfhi(unsigned w) { return __builtin_bit_cast(float, w & 0xffff0000u); }
__device__ __forceinline__ float sigmoidf_(float x) { return 1.f / (1.f + __expf(-x)); }
__device__ __forceinline__ float gelu_tanh(float x) {
    const float u = 0.7978845608028654f * (x + 0.044715f * x * x * x);
    const float e = __expf(2.f * u);
    const float th = 1.f - 2.f / (e + 1.f);
    return 0.5f * x * (1.f + th);
}
__device__ __forceinline__ int lane_id_v() { int l; asm volatile("v_mbcnt_lo_u32_b32 %0, -1, 0\n\tv_mbcnt_hi_u32_b32 %0, -1, %0" : "=v"(l)); return l; }
__device__ __forceinline__ float wave_sum(float v) {
#pragma unroll
    for (int o = 1; o < 64; o <<= 1) v += __shfl_xor(v, o);
    return v;
}
__device__ __forceinline__ void unpack8(const u32x4 w, float (&v)[8]) {
    v[0] = bflo(w.x); v[1] = bfhi(w.x); v[2] = bflo(w.y); v[3] = bfhi(w.y); v[4] = bflo(w.z); v[5] = bfhi(w.z); v[6] = bflo(w.w); v[7] = bfhi(w.w);
}
__device__ __forceinline__ u32x4 pack8(const float (&v)[8]) {
    u32x4 w; w.x = pk2(v[0], v[1]); w.y = pk2(v[2], v[3]); w.z = pk2(v[4], v[5]); w.w = pk2(v[6], v[7]); return w;
}

namespace pg8 {
#define PG8_LAS __attribute__((address_space(3)))
constexpr int BM = 256, BK = 64, HALF = 128, HTB = HALF * BK * 2, STAGE_BYTES = 8 * HTB, NXCD = 8, WGM = 8;
__host__ __device__ __forceinline__ int lds_byte(int r, int c) { const int st = (r >> 4) * 2 + (c >> 5), rr = r & 15, cc = c & 31, ob = rr * 64 + cc * 2; return st * 1024 + (ob ^ (((ob >> 9) & 1) << 5)); }
__host__ __device__ __forceinline__ void stage_rc(int b, int& R, int& C) { const int st = b / 1024, sb = b % 1024, swz = sb ^ (((sb >> 9) & 1) << 5); R = (st >> 1) * 16 + swz / 64; C = (st & 1) * 32 + (swz % 64) / 2; }
__host__ __device__ __forceinline__ int perm32(int rho) { const int n = rho >> 4, i = rho & 15; return 8 * (i >> 2) + 4 * n + (i & 3); }

struct Unit { int pm, pn; };
struct Gemm { const bf16_t* A; const bf16_t* Bt; };

template <int M_, int N_> struct StaticOrder {
    static constexpr int nM = M_ / BM, nN = N_ / BM, nwg = nM * nN;
    int G, c;
    __host__ __device__ void init(int G_, int c_) { G = G_; c = c_; }
    __host__ __device__ bool next(int i, Unit& u) const {
        const long L = (long)i * G + c; if (L >= nwg) return false;
        int wgid = (int)L; { const int q = nwg / NXCD, r = nwg % NXCD, xcd = wgid % NXCD, off = wgid / NXCD; wgid = (xcd < r ? xcd * (q + 1) : r * (q + 1) + (xcd - r) * q) + off; }
        const int nig = WGM * nN, gid = wgid / nig, fm = gid * WGM, gsz = (nM - fm) < WGM ? (nM - fm) : WGM;
        u.pm = fm + ((wgid % nig) % gsz); u.pn = (wgid % nig) / gsz; return true;
    }
};

template <class F> struct EpiF {
    static constexpr bool PERM = true;
    F f;
    __device__ __forceinline__ void operator()(const f32x4 (&acc)[2][2][4][2], const Unit& u, int wr, int wc, int fr, int fq) const {
        { int l_; asm volatile("v_mbcnt_lo_u32_b32 %0, -1, 0\n\tv_mbcnt_hi_u32_b32 %0, -1, %0" : "=v"(l_)); fr = l_ & 15; fq = l_ >> 4; }
        const int c = wc * 32 + 8 * fq;
        const typename F::Tile tl = f.tile(u.pn, c, u.pm);
#pragma unroll
        for (int ai = 0; ai < 2; ++ai)
#pragma unroll
            for (int mb = 0; mb < 4; mb += F::NB) {
                typename F::Pre pre[F::NB];
#pragma unroll
                for (int m = 0; m < F::NB; ++m) pre[m] = f.pre(u.pm * BM + ai * HALF + wr * 64 + (mb + m) * 16 + fr, u.pn, c);
#pragma unroll
                for (int m = 0; m < F::NB; ++m) {
                    const int row = u.pm * BM + ai * HALF + wr * 64 + (mb + m) * 16 + fr;
                    float v0[8], v1[8];
#pragma unroll
                    for (int j = 0; j < 4; ++j) { v0[j] = acc[ai][0][mb + m][0][j]; v0[4 + j] = acc[ai][0][mb + m][1][j]; v1[j] = acc[ai][1][mb + m][0][j]; v1[4 + j] = acc[ai][1][mb + m][1][j]; }
                    f.apply(row, u.pn, c, v0, v1, pre[m], tl);
                }
            }
    }
};

template <int K, int LDA, int ACS, class Epi, class Sched>
__device__ __forceinline__ void gemm_phase(PG8_LAS unsigned char* lds, const Gemm g, const Sched& S, const Epi& E, const int tid) {
    const int wid = __builtin_amdgcn_readfirstlane(tid >> 6), lane = tid & 63, wr = wid >> 2, wc = wid & 3, fr = lane & 15, fq = lane >> 4;
    constexpr int nt = K / BK;
    unsigned voffA[2], voffB[2];
#pragma unroll
    for (int i = 0; i < 2; ++i) { int R, C; stage_rc(tid * 16 + i * 8192, R, C); const int Rb = Epi::PERM ? ((R & ~31) + perm32(R & 31)) : R;
        voffA[i] = (unsigned)(R * LDA + C) * 2u; voffB[i] = (unsigned)(Rb * K + C) * 2u; }
    constexpr size_t kstep = (size_t)(BK * 2);
    constexpr size_t hstepA = (size_t)HALF * LDA * 2, hstepB = (size_t)HALF * K * 2;
    constexpr size_t tstepA = 2 * hstepA, tstepB = 2 * hstepB;
    constexpr size_t acsb = (size_t)ACS * 2;
    const unsigned ldsw = (unsigned)wid * 1024u;
    const int aoff = lds_byte(wr * 64 + fr, fq * 8), boff = lds_byte(wc * 32 + fr, fq * 8);
#define PG8_SA(b, h) (((b) * 2 + (h)) * HTB)
#define PG8_SB(b, h) ((4 + (b) * 2 + (h)) * HTB)
#define PG8_STAGE(bufoff, gbase, voff) do { _Pragma("unroll") for (int _i = 0; _i < 2; ++_i) \
        __builtin_amdgcn_global_load_lds((const unsigned*)((const char*)(gbase) + (voff)[_i]), (PG8_LAS unsigned*)(lds + (bufoff) + ldsw + _i * 8192), 16, 0, 0); } while (0)
#define PG8_LDA(dst, b, h) do { _Pragma("unroll") for (int m = 0; m < 4; ++m) _Pragma("unroll") for (int k = 0; k < 2; ++k) dst[m][k] = *(const PG8_LAS bf16x8*)(lds + PG8_SA(b, h) + aoff + m * 2048 + k * 1024); } while (0)
#define PG8_LDB(dst, b, h) do { _Pragma("unroll") for (int n = 0; n < 2; ++n) _Pragma("unroll") for (int k = 0; k < 2; ++k) dst[n][k] = *(const PG8_LAS bf16x8*)(lds + PG8_SB(b, h) + boff + n * 2048 + k * 1024); } while (0)
#define PG8_MMA(ai, bj, At, Bt) do { __builtin_amdgcn_s_setprio(1); _Pragma("unroll") for (int m = 0; m < 4; ++m) _Pragma("unroll") for (int n = 0; n < 2; ++n) _Pragma("unroll") for (int k = 0; k < 2; ++k) \
        acc[ai][bj][m][n] = __builtin_amdgcn_mfma_f32_16x16x32_bf16(Bt[n][k], At[m][k], acc[ai][bj][m][n], 0, 0, 0); __builtin_amdgcn_s_setprio(0); } while (0)
#define PG8_WAIT_V(n) asm volatile("s_waitcnt vmcnt(" #n ")" ::: "memory")
#define PG8_WAIT_L(n) asm volatile("s_waitcnt lgkmcnt(" #n ")" ::: "memory")
#define PG8_BAR __builtin_amdgcn_s_barrier()
#define PG8_SCHED __builtin_amdgcn_sched_barrier(0)
    Unit cur, nxt; int ui = 0;
    if (!S.next(0, cur)) return;
    f32x4 acc[2][2][4][2];
#pragma unroll
    for (int a = 0; a < 2; ++a)
#pragma unroll
        for (int b = 0; b < 2; ++b)
#pragma unroll
            for (int m = 0; m < 4; ++m)
#pragma unroll
                for (int n = 0; n < 2; ++n) acc[a][b][m][n] = (f32x4){0.f, 0.f, 0.f, 0.f};
    bf16x8 At[4][2], B0[2][2], B1[2][2];
    const char* cA = (const char*)g.A + (size_t)cur.pm * tstepA + (size_t)cur.pn * acsb; const char* cB = (const char*)g.Bt + (size_t)cur.pn * tstepB;
    PG8_STAGE(PG8_SB(0, 0), cB, voffB); PG8_STAGE(PG8_SB(0, 1), cB + hstepB, voffB); PG8_STAGE(PG8_SA(0, 0), cA, voffA); PG8_STAGE(PG8_SA(0, 1), cA + hstepA, voffA);
    if (wr == 1) PG8_BAR;
    PG8_WAIT_V(2); PG8_BAR;
    PG8_STAGE(PG8_SB(1, 0), cB + kstep, voffB); PG8_STAGE(PG8_SA(1, 0), cA + kstep, voffA); PG8_STAGE(PG8_SB(1, 1), cB + hstepB + kstep, voffB);
    PG8_WAIT_V(6); PG8_BAR;
    for (;;) {
        const bool has_next = S.next(ui + 1, nxt);
        const char* nA = has_next ? (const char*)g.A + (size_t)nxt.pm * tstepA + (size_t)nxt.pn * acsb : cA; const char* nB = has_next ? (const char*)g.Bt + (size_t)nxt.pn * tstepB : cB;
#pragma unroll 1
        for (int t = 0; t < nt; t += 2) {
            const bool last = (t == nt - 2);
            const char* a1 = cA + (size_t)(t + 1) * kstep;
            const char* a2 = last ? nA : cA + (size_t)(t + 2) * kstep; const char* b2 = last ? nB : cB + (size_t)(t + 2) * kstep;
            const char* a3 = a2 + kstep; const char* b3 = b2 + kstep;
            PG8_LDB(B0, 0, 0); PG8_LDB(B1, 0, 1); PG8_SCHED; PG8_LDA(At, 0, 0); PG8_STAGE(PG8_SA(1, 1), a1 + hstepA, voffA);
            PG8_WAIT_V(8); PG8_WAIT_L(0); PG8_BAR; PG8_MMA(0, 0, At, B0); PG8_MMA(0, 1, At, B1); PG8_BAR; PG8_SCHED;
            PG8_LDA(At, 0, 1); PG8_STAGE(PG8_SB(0, 0), b2, voffB); PG8_STAGE(PG8_SB(0, 1), b2 + hstepB, voffB); PG8_STAGE(PG8_SA(0, 0), a2, voffA);
            PG8_WAIT_V(8); PG8_WAIT_L(0); PG8_BAR; PG8_MMA(1, 0, At, B0); PG8_MMA(1, 1, At, B1); PG8_BAR; PG8_SCHED;
            PG8_LDB(B0, 1, 0); PG8_LDB(B1, 1, 1); PG8_SCHED; PG8_LDA(At, 1, 0); PG8_STAGE(PG8_SA(0, 1), a2 + hstepA, voffA);
            PG8_WAIT_V(8); PG8_WAIT_L(0); PG8_BAR; PG8_MMA(0, 0, At, B0); PG8_MMA(0, 1, At, B1); PG8_BAR; PG8_SCHED;
            PG8_LDA(At, 1, 1); PG8_STAGE(PG8_SB(1, 0), b3, voffB); PG8_STAGE(PG8_SB(1, 1), b3 + hstepB, voffB); PG8_STAGE(PG8_SA(1, 0), a3, voffA);
            PG8_WAIT_V(8); PG8_WAIT_L(0); PG8_BAR; PG8_MMA(1, 0, At, B0); PG8_MMA(1, 1, At, B1); PG8_BAR; PG8_SCHED;
        }
        if (wr == 0) PG8_BAR;
        E(acc, cur, wr, wc, fr, fq);
        if (!has_next) break;
#pragma unroll
        for (int a = 0; a < 2; ++a)
#pragma unroll
            for (int b = 0; b < 2; ++b)
#pragma unroll
                for (int m = 0; m < 4; ++m)
#pragma unroll
                    for (int n = 0; n < 2; ++n) acc[a][b][m][n] = (f32x4){0.f, 0.f, 0.f, 0.f};
        cur = nxt; cA = nA; cB = nB; ++ui;
        if (wr == 1) PG8_BAR;
    }
    PG8_WAIT_V(0);
    PG8_BAR;
#undef PG8_SA
#undef PG8_SB
#undef PG8_STAGE
#undef PG8_LDA
#undef PG8_LDB
#undef PG8_MMA
#undef PG8_WAIT_V
#undef PG8_WAIT_L
#undef PG8_BAR
#undef PG8_SCHED
}
}

#define XB_TMO      128
#define XB_XCNT(j)  (256  + 64 * (j))
#define XB_XSUB(j)  (1280 + 64 * (j))
#define XB_XGEN(j)  (2304 + 64 * (j))
#define XB_TOP      3328
#define XB_TOPGEN   3392
#define XCD_BAR_WORDS 3456
#define XB_SPIN_CAP (1u << 18)
__device__ __forceinline__ unsigned xb_ld(unsigned* p)              { return __hip_atomic_load(p, __ATOMIC_RELAXED, __HIP_MEMORY_SCOPE_AGENT); }
__device__ __forceinline__ unsigned xb_add(unsigned* p, unsigned v) { return __hip_atomic_fetch_add(p, v, __ATOMIC_RELAXED, __HIP_MEMORY_SCOPE_AGENT); }
__device__ __forceinline__ unsigned xb_xcc_id() { return (unsigned)__builtin_amdgcn_s_getreg((3 << 11) | 20) & 0xFu; }
#define XB_SPIN(cond, bar) do { unsigned _sp = 0; while (cond) { __builtin_amdgcn_s_sleep(1); \
    if ((++_sp & 255u) == 0u) { if (xb_ld(&(bar)[XB_TMO])) break; if (_sp > XB_SPIN_CAP) { atomicAdd(&(bar)[XB_TMO], 1u); break; } } } } while (0)
struct XcdBarrier { unsigned* bar; unsigned x; volatile LAS unsigned* st; };
__device__ __forceinline__ XcdBarrier xcd_barrier_post(unsigned* bar, volatile LAS unsigned* st) {
    XcdBarrier b; b.bar = bar; b.x = xb_xcc_id(); b.st = st;
    if (threadIdx.x == 0) (void)xb_add(&bar[XB_XCNT(b.x)], 1u);
    return b;
}
__device__ __forceinline__ void xcd_barrier_complete(unsigned* bar, unsigned x, unsigned& nloc, unsigned& nx) {
    const unsigned G = gridDim.x * gridDim.y * gridDim.z;
    unsigned sum, cnt, mine, sp = 0u;
    for (;;) {
        sum = 0u; cnt = 0u; mine = 0u;
#pragma unroll
        for (unsigned j = 0; j < 16; ++j) { const unsigned c = xb_ld(&bar[XB_XCNT(j)]); sum += c; cnt += (c > 0u) ? 1u : 0u; mine = (j == x) ? c : mine; }
        if (sum == G) break;
        __builtin_amdgcn_s_sleep(1);
        if ((++sp & 255u) == 0u) { if (xb_ld(&bar[XB_TMO])) break; if (sp > XB_SPIN_CAP) { atomicAdd(&bar[XB_TMO], 1u); break; } }
    }
    nloc = mine > 0u ? mine : 1u; nx = cnt > 0u ? cnt : 1u;
}
__device__ __forceinline__ void xcd_barrier(const XcdBarrier& b, int wave) {
    asm volatile("s_waitcnt vmcnt(0)" ::: "memory");
    __syncthreads();
    if (wave == 0 && lane_id_v() == 0) {
        unsigned* bar = b.bar;
        __builtin_amdgcn_s_waitcnt(0);
        unsigned nloc = b.st[0], nx = b.st[1];
        if (nloc == 0u) { xcd_barrier_complete(bar, b.x, nloc, nx); b.st[0] = nloc; b.st[1] = nx; }
        const unsigned old = xb_add(&bar[XB_XSUB(b.x)], 1u);
        const unsigned gen = old / nloc;
        if (old + 1u == (gen + 1u) * nloc) {
            __builtin_amdgcn_fence(__ATOMIC_RELEASE, "agent");
            asm volatile("s_waitcnt vmcnt(0)" ::: "memory");
            const unsigned og = xb_add(&bar[XB_TOP], 1u);
            const unsigned tg = og / nx;
            if (og + 1u == (tg + 1u) * nx) xb_add(&bar[XB_TOPGEN], 1u);
            else XB_SPIN(xb_ld(&bar[XB_TOPGEN]) == tg, bar);
            __builtin_amdgcn_fence(__ATOMIC_ACQUIRE, "agent");
            xb_add(&bar[XB_XGEN(b.x)], 1u);
            asm volatile("s_waitcnt vmcnt(0)" ::: "memory");
        } else {
            XB_SPIN(xb_ld(&bar[XB_XGEN(b.x)]) == gen, bar);
            __builtin_amdgcn_fence(__ATOMIC_ACQUIRE, "agent");
            asm volatile("s_waitcnt vmcnt(0)" ::: "memory");
        }
    }
    __syncthreads();
}

struct Args { const float* in[28]; float* out; unsigned char* ws; int ph_lo, ph_hi; };
enum { I_X = 0, I_C, I_POS, I_WADA, I_BADA, I_N1G, I_WIN, I_QAG, I_WUQ, I_KVAG, I_WUKV, I_QNG, I_KNG, I_WOA, I_CONVW, I_CONVB, I_WRG, I_BRG, I_WIG, I_BIG, I_LAM, I_WOL, I_WOUT, I_N2G, I_WQ, I_SUBK, I_EU, I_EV };
constexpr int N_PHASES = 17;

struct Ctx {
    LAS unsigned char* lds;
    int tid, lane, wave, vcu, G;
    const float* const* in; float* out; unsigned char* ws;
};
#define WSP(type, off) ((type*)(c.ws + (off)))

template <class F>
__device__ __forceinline__ void tr_tile(const Ctx& c, bf16_t* dst, int K, int n0, int k0, F f) {
    LAS float* scr = (LAS float*)c.lds;
#pragma unroll
    for (int i = 0; i < 8; ++i) { const int kk = i * 8 + (c.tid >> 6), nn = c.tid & 63; scr[kk * 65 + nn] = f(k0 + kk, n0 + nn); }
    __syncthreads();
    { const int kc = c.tid & 7, nn = c.tid >> 3;
      LAS const float* s = scr + (8 * kc) * 65 + nn;
      u32x4 o; o.x = pk2(s[0], s[65]); o.y = pk2(s[2 * 65], s[3 * 65]); o.z = pk2(s[4 * 65], s[5 * 65]); o.w = pk2(s[6 * 65], s[7 * 65]);
      *(u32x4*)(dst + (size_t)(n0 + nn) * K + k0 + 8 * kc) = o; }
    __syncthreads();
}

template <class F>
__device__ __forceinline__ void tr_tile_wave(LAS float* scr, int L, bf16_t* dst, int K, int n0, int k0, F f) {
#pragma unroll 16
    for (int kk = 0; kk < 64; ++kk) scr[kk * 65 + L] = f(k0 + kk, n0 + L);
    asm volatile("s_waitcnt lgkmcnt(0)" ::: "memory");
    const int kc = L & 7;
#pragma unroll
    for (int j = 0; j < 8; ++j) { const int nn = (L >> 3) + 8 * j; LAS const float* s = scr + (8 * kc) * 65 + nn;
        u32x4 o; o.x = pk2(s[0], s[65]); o.y = pk2(s[2 * 65], s[3 * 65]); o.z = pk2(s[4 * 65], s[5 * 65]); o.w = pk2(s[6 * 65], s[7 * 65]);
        *(u32x4*)(dst + (size_t)(n0 + nn) * K + k0 + 8 * kc) = o; }
    asm volatile("s_waitcnt lgkmcnt(0)" ::: "memory");
}
__device__ __forceinline__ void phase_prep(const Ctx& c0) {
    Ctx c = c0; c.lane = lane_id_v(); c.tid = c.wave * 64 + c.lane;
    const float* w_in = c.in[I_WIN]; const float* w_uq = c.in[I_WUQ]; const float* qag = c.in[I_QAG]; const float* w_ukv = c.in[I_WUKV]; const float* kvag = c.in[I_KVAG];
    const float* w_oa = c.in[I_WOA]; const float* w_ol = c.in[I_WOL]; const float* w_out = c.in[I_WOUT]; const float* w_q = c.in[I_WQ];
    const float* w_rg = c.in[I_WRG]; const float* w_ig = c.in[I_WIG];
    constexpr int T_WIN = 72 * 16, T_WUQ = 12 * 4, T_WUKV = 16 * 2, T_WOA = 16 * 8, T_WOL = 16 * 16, T_WOUT = 16 * 16, T_WQ = 32 * 16, T_WG = 8 * 4 * 2;
    constexpr int T_WAVE = T_WIN + T_WUQ + T_WUKV + T_WOA + T_WOL + T_WOUT + T_WG;
    { LAS float* scr = (LAS float*)(c.lds + (c.wave < 7 ? c.wave * 16640 : 131584)); const int L = c.lane;
      static_assert(7 * 16640 <= 131072 && 131584 + 16640 <= LDS_BYTES && 131584 >= MISC_OFF + 128, "prep LDS tiles");
      for (int it = c.vcu * 8 + c.wave; it < T_WAVE; it += c.G * 8) {
        int r = it;
        if (r < T_WIN) { const int nb = r / 16, kb = r % 16;
            tr_tile_wave(scr, L, WSP(bf16_t, WS_WIN), 1024, nb * 64, kb * 64, [=](int k, int n) -> float { return n < 416 ? w_in[(size_t)k * 4512 + n] : (n < 512 ? 0.f : w_in[(size_t)k * 4512 + n - 96]); }); continue; }
        r -= T_WIN;
        if (r < T_WUQ) { const int nb = r / 4, kb = r % 4;
            tr_tile_wave(scr, L, WSP(bf16_t, WS_WUQ), 256, nb * 64, kb * 64, [=](int k, int n) -> float { return w_uq[(size_t)k * 768 + n] * qag[k]; }); continue; }
        r -= T_WUQ;
        if (r < T_WUKV) { const int nb = r / 2, kb = r % 2;
            tr_tile_wave(scr, L, WSP(bf16_t, WS_WUKV), 128, nb * 64, kb * 64, [=](int k, int n) -> float { return w_ukv[(size_t)k * 1024 + n] * kvag[k]; }); continue; }
        r -= T_WUKV;
        if (r < T_WOA) { const int nb = r / 8, kb = r % 8;
            tr_tile_wave(scr, L, WSP(bf16_t, WS_WOA), 512, nb * 64, kb * 64, [=](int k, int n) -> float { return w_oa[(size_t)k * 1024 + n]; }); continue; }
        r -= T_WOA;
        if (r < T_WOL) { const int nb = r / 16, kb = r % 16;
            tr_tile_wave(scr, L, WSP(bf16_t, WS_WOL), 1024, nb * 64, kb * 64, [=](int k, int n) -> float { return w_ol[(size_t)k * 1024 + n]; }); continue; }
        r -= T_WOL;
        if (r < T_WOUT) { const int nb = r / 16, kb = r % 16;
            tr_tile_wave(scr, L, WSP(bf16_t, WS_WOUT), 1024, nb * 64, kb * 64, [=](int k, int n) -> float { return w_out[(size_t)k * 1024 + n]; }); continue; }
        r -= T_WOUT;
        { const int blk = r / 8, q = r % 8, nb = q / 2, kb = q % 2;
            tr_tile_wave(scr, L, WSP(bf16_t, WS_WG) + (size_t)blk * 256 * 128, 128, nb * 64, kb * 64,
                    [=](int k, int n) -> float { return n < 128 ? w_rg[((size_t)blk * 128 + k) * 128 + n] : w_ig[((size_t)blk * 128 + k) * 128 + n - 128]; }); }
      } }
    __syncthreads();
    for (int r = c.vcu; r < T_WQ; r += c.G) {
        const int nb = r / 16, kb = r % 16;
        const int slot = nb >> 1, n0 = (nb & 1) * 64, k0 = kb * 64;
        LAS float* wq_s = (LAS float*)(c.lds + 32768);
        LAS float* sk_s = (LAS float*)(c.lds + 32768 + 64 * 129 * 4);
        const float* skp = c.in[I_SUBK] + ((size_t)slot * 128 + n0) * 128;
        for (int e = c.tid; e < 64 * 128; e += 512) { const int rr = e >> 7, cc = e & 127; wq_s[rr * 129 + cc] = w_q[(size_t)(k0 + rr) * 2048 + slot * 128 + cc]; sk_s[rr * 129 + cc] = skp[(size_t)rr * 128 + cc]; }
        __syncthreads();
        tr_tile(c, WSP(bf16_t, WS_WQ), 1024, nb * 64, k0, [=](int k, int n) -> float { const LAS float* a = wq_s + (k - k0) * 129; const LAS float* b = sk_s + (n - nb * 64) * 129; float s = 0.f;
#pragma unroll 16
            for (int d = 0; d < 128; ++d) s += a[d] * b[d];
            return s; });
    }
    { const float* lam = c.in[I_LAM]; float* t8 = WSP(float, WS_C8SP);
      if (c.vcu == 0) for (int e = c.tid; e < 1024; e += 512) t8[e] = -8.f * log1pf(__expf(-lam[e])); }
    if (c.vcu == 0 && c.tid == 0) {
        const unsigned probe = __builtin_amdgcn_cvt_scalef32_pk_fp4_f32(0u, 1.0f, 0.0f, 1.0f, 0) & 0xffu;
        WSP(unsigned, WS_C8SP)[1024] = (probe == 0x02u) ? 0u : 1u; }
    { const int gw = c.vcu * 8 + c.wave, NGW = c.G * 8, L = c.lane;
      f32x4 vn[4];
      if (gw < 2 * NE) { const f32x4* s4 = (const f32x4*)((gw >= NE ? c.in[I_EV] : c.in[I_EU]) + (size_t)(gw >= NE ? gw - NE : gw) * 1024 + 16 * L);
#pragma unroll
          for (int j = 0; j < 4; ++j) vn[j] = s4[j]; }
#pragma unroll 1
      for (int r = gw; r < 2 * NE; r += NGW) {
          const int isv = r >= NE, e = isv ? r - NE : r;
          f32x4 v[4]; float am = 0.f;
#pragma unroll
          for (int j = 0; j < 4; ++j) { v[j] = vn[j]; am = fmaxf(am, fmaxf(fmaxf(fabsf(v[j].x), fabsf(v[j].y)), fmaxf(fabsf(v[j].z), fabsf(v[j].w)))); }
          { const int rn = (r + NGW < 2 * NE) ? r + NGW : r; const f32x4* s4 = (const f32x4*)((rn >= NE ? c.in[I_EV] : c.in[I_EU]) + (size_t)(rn >= NE ? rn - NE : rn) * 1024 + 16 * L);
#pragma unroll
            for (int j = 0; j < 4; ++j) vn[j] = s4[j]; }
#pragma unroll
          for (int o = 1; o < 64; o <<= 1) am = fmaxf(am, __shfl_xor(am, o));
          const float s = am > 0.f ? am * (1.f / 6.f) : 1.f, inv = 1.f / s;
          unsigned w0 = 0u, w1 = 0u;
          w0 = __builtin_amdgcn_cvt_scalef32_pk_fp4_f32(w0, v[0].x * inv, v[0].y * inv, 1.0f, 0); w0 = __builtin_amdgcn_cvt_scalef32_pk_fp4_f32(w0, v[0].z * inv, v[0].w * inv, 1.0f, 1);
          w0 = __builtin_amdgcn_cvt_scalef32_pk_fp4_f32(w0, v[1].x * inv, v[1].y * inv, 1.0f, 2); w0 = __builtin_amdgcn_cvt_scalef32_pk_fp4_f32(w0, v[1].z * inv, v[1].w * inv, 1.0f, 3);
          w1 = __builtin_amdgcn_cvt_scalef32_pk_fp4_f32(w1, v[2].x * inv, v[2].y * inv, 1.0f, 0); w1 = __builtin_amdgcn_cvt_scalef32_pk_fp4_f32(w1, v[2].z * inv, v[2].w * inv, 1.0f, 1);
          w1 = __builtin_amdgcn_cvt_scalef32_pk_fp4_f32(w1, v[3].x * inv, v[3].y * inv, 1.0f, 2); w1 = __builtin_amdgcn_cvt_scalef32_pk_fp4_f32(w1, v[3].z * inv, v[3].w * inv, 1.0f, 3);
          u32x2 q; q.x = w0; q.y = w1;
          *(u32x2*)(c.ws + (isv ? WS_EV : WS_EU) + ((size_t)(L >> 4) * NE + e) * 128 + (L & 15) * 8) = q;
          if (L == 0) WSP(float, isv ? WS_SV : WS_SU)[e] = s;
      } }
    { const float* cin = c.in[I_C]; const float* w_ada = c.in[I_WADA]; const float* b_ada = c.in[I_BADA]; float* mod = WSP(float, WS_MOD);
      LAS float* cs = (LAS float*)c.lds;
      LAS float* red = (LAS float*)(c.lds + 65536);
      bool have = false;
      for (int it = c.vcu; it < 192; it += c.G) {
          if (!have) { for (int e = c.tid; e < 16 * 1024; e += 512) { const float v = cin[e]; cs[e] = v / (1.f + __expf(-v)); } have = true; }
          __syncthreads();
          const int cl = c.tid & 31, ks = c.tid >> 5, j = it * 32 + cl;
          float acc[16];
#pragma unroll
          for (int b = 0; b < 16; ++b) acc[b] = 0.f;
          for (int kk = 0; kk < 64; ++kk) { const int k = ks * 64 + kk; const float w = w_ada[(size_t)k * 6144 + j];
#pragma unroll
              for (int b = 0; b < 16; ++b) acc[b] += cs[b * 1024 + k] * w; }
#pragma unroll
          for (int b = 0; b < 16; ++b) red[(ks * 16 + b) * 32 + cl] = acc[b];
          __syncthreads();
          { const int b = c.tid >> 5; float s = b_ada[j];
#pragma unroll
            for (int k2 = 0; k2 < 16; ++k2) s += red[(k2 * 16 + b) * 32 + cl];
            mod[b * 6144 + j] = s; }
          __syncthreads();
      } }
}

template <bool Q8>
__device__ __forceinline__ void phase_modnorm(const Ctx& c0, const float* x, const float* g, int shift_off, int scale_off, bf16_t* dst) {
    Ctx c = c0; c.lane = lane_id_v(); c.tid = c.wave * 64 + c.lane;
    const float* mod = WSP(float, WS_MOD);
    const int gw = c.vcu * 8 + c.wave, NGW = c.G * 8;
    if (gw >= T) return;
    f32x4 vn[4];
    { const f32x4* xr = (const f32x4*)(x + (size_t)gw * D) + c.lane;
#pragma unroll
      for (int j = 0; j < 4; ++j) vn[j] = xr[64 * j]; }
#pragma unroll 1
    for (int m = gw; m < T; m += NGW) {
        const int b = m >> 11;
        f32x4 v[4]; float s = 0.f;
#pragma unroll
        for (int j = 0; j < 4; ++j) { v[j] = vn[j]; s += (v[j].x * v[j].x + v[j].y * v[j].y) + (v[j].z * v[j].z + v[j].w * v[j].w); }
        { const int mn = (m + NGW < T) ? m + NGW : m; const f32x4* xr = (const f32x4*)(x + (size_t)mn * D) + c.lane;
#pragma unroll
          for (int j = 0; j < 4; ++j) vn[j] = xr[64 * j]; }
        const float rstd = rsqrtf(wave_sum(s) * (1.f / D) + EPS);
        u32x2* o8 = (u32x2*)(dst + (size_t)m * D) + c.lane;
        float am = 0.f;
#pragma unroll
        for (int j = 0; j < 4; ++j) {
            const int col = 4 * c.lane + 256 * j;
            const f32x4 gg = *(const f32x4*)(g + col), sc = *(const f32x4*)(mod + b * 6144 + scale_off + col), sh = *(const f32x4*)(mod + b * 6144 + shift_off + col);
            const float r0 = v[j].x * rstd * gg.x * (1.f + sc.x) + sh.x, r1 = v[j].y * rstd * gg.y * (1.f + sc.y) + sh.y;
            const float r2 = v[j].z * rstd * gg.z * (1.f + sc.z) + sh.z, r3 = v[j].w * rstd * gg.w * (1.f + sc.w) + sh.w;
            u32x2 w; w.x = pk2(r0, r1); w.y = pk2(r2, r3); o8[64 * j] = w;
            if (Q8) { v[j].x = r0; v[j].y = r1; v[j].z = r2; v[j].w = r3; am = fmaxf(am, fmaxf(fmaxf(fabsf(r0), fabsf(r1)), fmaxf(fabsf(r2), fabsf(r3)))); }
        }
        if (Q8) {
#pragma unroll
            for (int o = 1; o < 64; o <<= 1) am = fmaxf(am, __shfl_xor(am, o));
            const float sq = am > 0.f ? am * (1.f / 256.f) : 1.f, inv = 1.f / sq;
            unsigned* q8 = (unsigned*)(c.ws + WS_H2Q + (size_t)m * D) + c.lane;
#pragma unroll
            for (int j = 0; j < 4; ++j) { int w = __builtin_amdgcn_cvt_pk_fp8_f32(v[j].x * inv, v[j].y * inv, 0, false); w = __builtin_amdgcn_cvt_pk_fp8_f32(v[j].z * inv, v[j].w * inv, w, true); q8[64 * j] = (unsigned)w; }
            if (c.lane == 0) WSP(float, WS_SH)[m] = sq;
        }
    }
}

__device__ __forceinline__ void phase_conv(const Ctx& c0) {
    Ctx c = c0; c.lane = lane_id_v(); c.tid = c.wave * 64 + c.lane;
    const bf16_t* pa = WSP(bf16_t, WS_R1); const bf16_t* lx = WSP(bf16_t, WS_R2); bf16_t* xc = WSP(bf16_t, WS_R4); float* rstd = WSP(float, WS_RSTD);
    const float* cw = c.in[I_CONVW]; const float* cb = c.in[I_CONVB];
    const int gt = c.vcu * 512 + c.tid, NT = c.G * 512;
    { const int gw = c.vcu * 8 + c.wave, NGW = c.G * 8, L = c.lane;
      for (int t = gw; t < T; t += NGW) {
          float ss = 0.f;
          if (L < 48) { float v[8]; unpack8(*(const u32x4*)(pa + (size_t)t * 512 + 8 * L), v);
#pragma unroll
              for (int j = 0; j < 8; ++j) ss += v[j] * v[j]; }
          const float sq = wave_sum(L < 32 ? ss : 0.f), skv = wave_sum(L >= 32 ? ss : 0.f);
          if (L == 0) { rstd[2 * t] = rsqrtf(sq * (1.f / 256.f) + EPS); rstd[2 * t + 1] = rsqrtf(skv * (1.f / 128.f) + EPS); }
      } }
    { const int* pos = (const int*)c.in[I_POS]; float* CS = WSP(float, WS_CS);
      for (int e = gt; e < T * 16; e += NT) {
          const int t = e >> 4, jj = e & 15;
          const float invf = exp2f(-(float)jj * (13.287712379549449f / 16.f));
          const float ang = (float)pos[t] * invf; const float n = rintf(ang * 0.15915494309189535f);
          const float red = (float)((double)ang - (double)n * 6.283185307179586);
          CS[(size_t)t * 32 + jj] = __cosf(red); CS[(size_t)t * 32 + 16 + jj] = __sinf(red);
      } }
    {
        const int ch = (gt & 127) * 8;
        f32x4 wv[4][2]; f32x4 bv[2];
#pragma unroll
        for (int j = 0; j < 4; ++j) { wv[j][0] = *(const f32x4*)(cw + j * 1024 + ch); wv[j][1] = *(const f32x4*)(cw + j * 1024 + ch + 4); }
        bv[0] = *(const f32x4*)(cb + ch); bv[1] = *(const f32x4*)(cb + ch + 4);
        const int tstep = NT >> 7;
        for (int tq = gt >> 7; tq < T; tq += 4 * tstep) {
            u32x4 raw[4][4];
#pragma unroll
            for (int u = 0; u < 4; ++u) { const int t = tq + u * tstep; const int s = t & 2047;
#pragma unroll
                for (int j = 0; j < 4; ++j) { raw[u][j] = (u32x4){0u, 0u, 0u, 0u}; if (t < T && s - 3 + j >= 0) raw[u][j] = *(const u32x4*)(lx + (size_t)(t - 3 + j) * 1024 + ch); } }
#pragma unroll
            for (int u = 0; u < 4; ++u) { const int t = tq + u * tstep;
                float acc[8] = {bv[0].x, bv[0].y, bv[0].z, bv[0].w, bv[1].x, bv[1].y, bv[1].z, bv[1].w};
#pragma unroll
                for (int j = 0; j < 4; ++j) { float v[8]; unpack8(raw[u][j], v);
                    acc[0] += wv[j][0].x * v[0]; acc[1] += wv[j][0].y * v[1]; acc[2] += wv[j][0].z * v[2]; acc[3] += wv[j][0].w * v[3];
                    acc[4] += wv[j][1].x * v[4]; acc[5] += wv[j][1].y * v[5]; acc[6] += wv[j][1].z * v[6]; acc[7] += wv[j][1].w * v[7]; }
                if (t < T) *(u32x4*)(xc + (size_t)t * 1024 + ch) = pack8(acc); }
        }
    }
}

__device__ __forceinline__ void phase_scan(const Ctx& c0) {
    Ctx c = c0; c.lane = lane_id_v(); c.tid = c.wave * 64 + c.lane;
    const bf16_t* LA = WSP(bf16_t, WS_R0); bf16_t* Bv = WSP(bf16_t, WS_R6); const bf16_t* gate = WSP(bf16_t, WS_R3);
    LAS float* Ps = (LAS float*)c.lds; LAS float* Hs = Ps + 512;
    for (int it = c.vcu; it < 256; it += c.G) {
        const int b = it >> 4, cg = it & 15, seg = c.tid >> 6, ch = cg * 64 + (c.tid & 63);
        const size_t base = ((size_t)b * 2048 + seg * 256) * 1024 + ch;
        float P = 1.f, Hl = 0.f;
#pragma unroll 1
        for (int i0 = 0; i0 < 256; i0 += 16) {
            unsigned la[16], bv[16];
#pragma unroll
            for (int i = 0; i < 16; ++i) { la[i] = LA[base + (size_t)(i0 + i) * 1024]; bv[i] = Bv[base + (size_t)(i0 + i) * 1024]; }
#pragma unroll
            for (int i = 0; i < 16; ++i) { const float a = __builtin_amdgcn_exp2f(bf2f(la[i])); Hl = a * Hl + bf2f(bv[i]); P *= a; }
        }
        Ps[c.tid] = P; Hs[c.tid] = Hl;
        __syncthreads();
        float h = 0.f;
        for (int s2 = 0; s2 < seg; ++s2) h = Ps[s2 * 64 + (c.tid & 63)] * h + Hs[s2 * 64 + (c.tid & 63)];
#pragma unroll 1
        for (int i0 = 0; i0 < 256; i0 += 16) {
            unsigned la[16], bv[16], gv[16]; unsigned ov[16];
#pragma unroll
            for (int i = 0; i < 16; ++i) { la[i] = LA[base + (size_t)(i0 + i) * 1024]; bv[i] = Bv[base + (size_t)(i0 + i) * 1024]; gv[i] = gate[base + (size_t)(i0 + i) * 1024]; }
#pragma unroll
            for (int i = 0; i < 16; ++i) { const float a = __builtin_amdgcn_exp2f(bf2f(la[i])); h = a * h + bf2f(bv[i]); ov[i] = f2bf(h * gelu_tanh(bf2f(gv[i]))); }
#pragma unroll
            for (int i = 0; i < 16; ++i) Bv[base + (size_t)(i0 + i) * 1024] = (bf16_t)ov[i];
        }
        __syncthreads();
    }
}

struct QkvRaw { u32x4 q[2], k[2], v[2]; f32x4 cs[4]; };
__device__ __forceinline__ void qkv_load(QkvRaw& r, const bf16_t* qraw, const bf16_t* kvraw, const bf16_t* pa, const float* CS, int t, int ch, int hq) {
    const bool act = ch < 12;
#pragma unroll
    for (int pass = 0; pass < 2; ++pass) { const int h = pass * 4 + hq;
        r.q[pass] = (u32x4){0u, 0u, 0u, 0u}; r.k[pass] = (u32x4){0u, 0u, 0u, 0u}; r.v[pass] = (u32x4){0u, 0u, 0u, 0u};
        if (act) r.q[pass] = *(const u32x4*)(qraw + (size_t)t * 768 + h * 96 + 8 * ch);
        if (ch < 8) { r.k[pass] = *(const u32x4*)(kvraw + (size_t)t * 1024 + h * 128 + 8 * ch); r.v[pass] = *(const u32x4*)(kvraw + (size_t)t * 1024 + h * 128 + 64 + 8 * ch); }
        else if (act) r.k[pass] = *(const u32x4*)(pa + (size_t)t * 512 + 384 + 8 * (ch - 8)); }
    const float* cp = CS + (size_t)t * 32 + 8 * (ch & 1);
    r.cs[0] = *(const f32x4*)cp; r.cs[1] = *(const f32x4*)(cp + 4); r.cs[2] = *(const f32x4*)(cp + 16); r.cs[3] = *(const f32x4*)(cp + 20);
}
__device__ __forceinline__ void phase_qkv_layout(const Ctx& c0) {
    Ctx c = c0; c.lane = lane_id_v(); c.tid = c.wave * 64 + c.lane;
    const bf16_t* qraw = WSP(bf16_t, WS_R5); const bf16_t* kvraw = WSP(bf16_t, WS_R2); const bf16_t* pa = WSP(bf16_t, WS_R1);
    bf16_t* Qh = WSP(bf16_t, WS_R4); bf16_t* Kh = WSP(bf16_t, WS_R3); bf16_t* Vh = WSP(bf16_t, WS_R0);
    const float* qng = c.in[I_QNG]; const float* kng = c.in[I_KNG]; const float* CS = WSP(float, WS_CS);
    const float qscale = 0.10206207261596577f * 1.4426950408889634f;
    const int gw = c.vcu * 8 + c.wave, NGW = c.G * 8, L = c.lane;
    const int ch = L & 15, hq = L >> 4;
    const bool act = ch < 12, isr = ch >= 8, hi2 = ch >= 10;
    float gq[8], gk[8];
#pragma unroll
    for (int j = 0; j < 8; ++j) { gq[j] = act ? qng[8 * ch + j] : 0.f; gk[j] = act ? kng[8 * ch + j] : 0.f; }
    if (gw >= T) return;
    QkvRaw cur, nxt;
    qkv_load(cur, qraw, kvraw, pa, CS, gw, ch, hq);
#pragma unroll 1
    for (int t = gw; t < T; t += NGW) {
        qkv_load(nxt, qraw, kvraw, pa, CS, (t + NGW < T) ? t + NGW : t, ch, hq);
        const int b = t >> 11, s = t & 2047;
        const float cs[8] = {cur.cs[0].x, cur.cs[0].y, cur.cs[0].z, cur.cs[0].w, cur.cs[1].x, cur.cs[1].y, cur.cs[1].z, cur.cs[1].w};
        const float sn[8] = {cur.cs[2].x, cur.cs[2].y, cur.cs[2].z, cur.cs[2].w, cur.cs[3].x, cur.cs[3].y, cur.cs[3].z, cur.cs[3].w};
#pragma unroll
        for (int pass = 0; pass < 2; ++pass) {
            const int h = pass * 4 + hq;
            const size_t orow = ((size_t)(b * H + h) * S + s);
#pragma unroll
            for (int qk = 0; qk < 2; ++qk) {
                float v[8]; unpack8(qk == 0 ? cur.q[pass] : cur.k[pass], v);
                float ss = 0.f;
#pragma unroll
                for (int j = 0; j < 8; ++j) ss += v[j] * v[j];
#pragma unroll
                for (int o = 1; o < 16; o <<= 1) ss += __shfl_xor(ss, o);
                const float r = rsqrtf(ss * (1.f / 96.f) + EPS) * (qk == 0 ? qscale : 1.f);
                float x[8], o8[8];
#pragma unroll
                for (int j = 0; j < 8; ++j) x[j] = v[j] * r * (qk == 0 ? gq[j] : gk[j]);
#pragma unroll
                for (int j = 0; j < 8; ++j) { const float px = __shfl_xor(x[j], 2);
                    o8[j] = !isr ? x[j] : (hi2 ? px * sn[j] + x[j] * cs[j] : x[j] * cs[j] - px * sn[j]); }
                if (act) *(u32x4*)((qk == 0 ? Qh : Kh) + orow * 96 + 8 * ch) = pack8(o8);
            }
            if (ch < 8) *(u32x4*)(Vh + orow * 64 + 8 * ch) = cur.v[pass];
        }
        cur = nxt;
    }
}

constexpr int KROW = 208, VROW = 160;
constexpr int KBUF = 128 * KROW, VBUF = 128 * VROW;
typedef short v4i16_t __attribute__((ext_vector_type(4)));
__device__ __forceinline__ void attn_chunk2(LAS unsigned char* kb, LAS unsigned char* vb, const bf16x8 (&qf)[2][3], f32x4 (&o)[2][4], float (&mrun)[2], float (&lrun)[2], int fr, int g) {
    f32x4 sacc[2][4];
#pragma unroll
    for (int kt = 0; kt < 4; ++kt) { sacc[0][kt] = (f32x4){0.f, 0.f, 0.f, 0.f}; sacc[1][kt] = (f32x4){0.f, 0.f, 0.f, 0.f};
#pragma unroll
        for (int ks = 0; ks < 3; ++ks) { const bf16x8 kf = *(const LAS bf16x8*)(kb + (16 * kt + fr) * KROW + (ks * 32 + g * 8) * 2);
            sacc[0][kt] = __builtin_amdgcn_mfma_f32_16x16x32_bf16(kf, qf[0][ks], sacc[0][kt], 0, 0, 0);
            sacc[1][kt] = __builtin_amdgcn_mfma_f32_16x16x32_bf16(kf, qf[1][ks], sacc[1][kt], 0, 0, 0); } }
    bf16x8 pb[2][2];
#pragma unroll
    for (int t = 0; t < 2; ++t) {
        float mx = sacc[t][0][0];
#pragma unroll
        for (int kt = 0; kt < 4; ++kt)
#pragma unroll
            for (int r = 0; r < 4; ++r) mx = fmaxf(mx, sacc[t][kt][r]);
        mx = fmaxf(mx, __shfl_xor(mx, 16)); mx = fmaxf(mx, __shfl_xor(mx, 32));
        const float mnew = fmaxf(mrun[t], mx), alpha = __builtin_amdgcn_exp2f(mrun[t] - mnew); mrun[t] = mnew;
        float ps = 0.f;
#pragma unroll
        for (int kt = 0; kt < 4; ++kt)
#pragma unroll
            for (int r = 0; r < 4; ++r) { const float p = __builtin_amdgcn_exp2f(sacc[t][kt][r] - mnew); sacc[t][kt][r] = p; ps += p; }
        lrun[t] = lrun[t] * alpha + ps;
#pragma unroll
        for (int dt = 0; dt < 4; ++dt) o[t][dt] = o[t][dt] * alpha;
#pragma unroll
        for (int s2 = 0; s2 < 2; ++s2) { u32x4 pw; pw.x = pk2(sacc[t][2 * s2][0], sacc[t][2 * s2][1]); pw.y = pk2(sacc[t][2 * s2][2], sacc[t][2 * s2][3]); pw.z = pk2(sacc[t][2 * s2 + 1][0], sacc[t][2 * s2 + 1][1]); pw.w = pk2(sacc[t][2 * s2 + 1][2], sacc[t][2 * s2 + 1][3]);
            pb[t][s2] = __builtin_bit_cast(bf16x8, pw); }
    }
#pragma unroll
    for (int s2 = 0; s2 < 2; ++s2)
#pragma unroll
        for (int dt = 0; dt < 4; ++dt) {
            LAS unsigned char* va = vb + (32 * s2 + 4 * g + (fr >> 2)) * VROW + (16 * dt + 4 * (fr & 3)) * 2;
            const v4i16_t t0 = __builtin_amdgcn_ds_read_tr16_b64_v4i16((LAS v4i16_t*)va), t1 = __builtin_amdgcn_ds_read_tr16_b64_v4i16((LAS v4i16_t*)(va + 16 * VROW));
            const bf16x8 vf = (bf16x8){t0[0], t0[1], t0[2], t0[3], t1[0], t1[1], t1[2], t1[3]};
            o[0][dt] = __builtin_amdgcn_mfma_f32_16x16x32_bf16(vf, pb[0][s2], o[0][dt], 0, 0, 0);
            o[1][dt] = __builtin_amdgcn_mfma_f32_16x16x32_bf16(vf, pb[1][s2], o[1][dt], 0, 0, 0); }
}
__device__ __forceinline__ void attn_unit(const Ctx& c, int b, int h, int qb) {
    const bf16_t* Qh = WSP(bf16_t, WS_R4); const bf16_t* Kh = WSP(bf16_t, WS_R3); const bf16_t* Vh = WSP(bf16_t, WS_R0); bf16_t* AO = WSP(bf16_t, WS_R0 + 32 * MiB);
    const int fr = c.lane & 15, g = c.lane >> 4, wid = c.wave;
    const size_t hb = (size_t)(b * H + h) * S;
    const int q0 = qb * 256 + wid * 32;
    const int nsup = 2 * qb + 2;
    const int nch = 4 * qb + (wid >> 1) + 1;
    bf16x8 qf[2][3];
#pragma unroll
    for (int t = 0; t < 2; ++t)
#pragma unroll
        for (int ks = 0; ks < 3; ++ks) qf[t][ks] = *(const bf16x8*)(Qh + (hb + q0 + 16 * t + fr) * 96 + ks * 32 + g * 8);
    f32x4 o[2][4];
#pragma unroll
    for (int t = 0; t < 2; ++t)
#pragma unroll
        for (int dt = 0; dt < 4; ++dt) o[t][dt] = (f32x4){0.f, 0.f, 0.f, 0.f};
    float mrun[2] = {-1e30f, -1e30f}, lrun[2] = {0.f, 0.f};
    u32x4 kr[3], vr[2];
    const u32x4* Ksrc = (const u32x4*)(Kh + hb * 96); const u32x4* Vsrc = (const u32x4*)(Vh + hb * 64);
#pragma unroll
    for (int i = 0; i < 3; ++i) kr[i] = Ksrc[c.tid + 512 * i];
#pragma unroll
    for (int i = 0; i < 2; ++i) vr[i] = Vsrc[c.tid + 512 * i];
    for (int j = 0; j < nsup; ++j) {
        LAS unsigned char* kb = c.lds + (j & 1) * (KBUF + VBUF); LAS unsigned char* vb = kb + KBUF;
#pragma unroll
        for (int i = 0; i < 3; ++i) { const int kc = c.tid + 512 * i; *(LAS u32x4*)(kb + (kc / 12) * KROW + (kc % 12) * 16) = kr[i]; }
#pragma unroll
        for (int i = 0; i < 2; ++i) { const int vc = c.tid + 512 * i; *(LAS u32x4*)(vb + (vc >> 3) * VROW + (vc & 7) * 16) = vr[i]; }
        __syncthreads();
        if (j + 1 < nsup) {
#pragma unroll
            for (int i = 0; i < 3; ++i) kr[i] = Ksrc[(j + 1) * 1536 + c.tid + 512 * i];
#pragma unroll
            for (int i = 0; i < 2; ++i) vr[i] = Vsrc[(j + 1) * 1024 + c.tid + 512 * i];
        }
        if (2 * j < nch) attn_chunk2(kb, vb, qf, o, mrun, lrun, fr, g);
        if (2 * j + 1 < nch) attn_chunk2(kb + 64 * KROW, vb + 64 * VROW, qf, o, mrun, lrun, fr, g);
    }
#pragma unroll
    for (int t = 0; t < 2; ++t) {
        float lt = lrun[t] + __shfl_xor(lrun[t], 16); lt += __shfl_xor(lt, 32);
        const float inv = 1.f / lt;
        bf16_t* orow = AO + ((size_t)b * S + q0 + 16 * t + fr) * 512 + h * 64;
#pragma unroll
        for (int dt = 0; dt < 4; ++dt) { u32x2 w; w.x = pk2(o[t][dt][0] * inv, o[t][dt][1] * inv); w.y = pk2(o[t][dt][2] * inv, o[t][dt][3] * inv); *(u32x2*)(orow + 16 * dt + 4 * g) = w; }
    }
    __syncthreads();
}
__device__ __forceinline__ void phase_attn(const Ctx& c0) {
    Ctx c = c0; c.lane = lane_id_v(); c.tid = c.wave * 64 + c.lane;
    for (int v = c.vcu; v < 256; v += c.G) {
        const int bh = v >> 1, odd = v & 1;
        for (int i = 0; i < 4; ++i) {
            const int setA[4] = {7, 4, 3, 0}, setB[4] = {6, 5, 2, 1};
            int qb = 0;
#pragma unroll
            for (int k = 0; k < 4; ++k) if (k == i) qb = odd ? setB[k] : setA[k];
            attn_unit(c, bh >> 3, bh & 7, qb);
        }
    }
}

__device__ __forceinline__ float wave_max(float v) {
#pragma unroll
    for (int o = 1; o < 64; o <<= 1) v = fmaxf(v, __shfl_xor(v, o));
    return v;
}
__device__ __forceinline__ int wave_min_i(int v) {
#pragma unroll
    for (int o = 1; o < 64; o <<= 1) v = min(v, __shfl_xor(v, o));
    return v;
}
__device__ __forceinline__ int prefix_cnt(unsigned long long m) { return (int)__builtin_amdgcn_mbcnt_hi((unsigned)(m >> 32), __builtin_amdgcn_mbcnt_lo((unsigned)m, 0u)); }
template <int NV, int NBITS> __device__ __forceinline__ void select16(const unsigned (&key)[NV], int (&slot)[NV]) {
    unsigned tau = 0u;
    for (int bit = NBITS - 1; bit >= 0; --bit) {
        const unsigned trial = tau | (1u << bit); int cnt = 0;
#pragma unroll
        for (int j = 0; j < NV; ++j) cnt += __popcll(__ballot(key[j] >= trial));
        if (cnt >= 16) { tau = trial; if (cnt == 16) break; }
    }
    int base = 0;
#pragma unroll
    for (int j = 0; j < NV; ++j) { const unsigned long long m = __ballot(key[j] > tau); slot[j] = (key[j] > tau) ? base + prefix_cnt(m) : -1; base += __popcll(m); }
#pragma unroll
    for (int j = 0; j < NV; ++j) { const unsigned long long m = __ballot(key[j] == tau); if (key[j] == tau) { const int s = base + prefix_cnt(m); slot[j] = s < 16 ? s : -1; } base += __popcll(m); }
}
template <int N> __device__ __forceinline__ void bitonic_stage_desc(unsigned (&x)[N], int k, int j) {
#pragma unroll
    for (int i = 0; i < N; ++i) { const int l = i ^ j; if (l > i) { const bool asc = ((i & k) != 0);
        const unsigned a = x[i], b = x[l]; const unsigned hi = a > b ? a : b, lo = a > b ? b : a; x[i] = asc ? lo : hi; x[l] = asc ? hi : lo; } }
}
__device__ __forceinline__ void sort16_desc(unsigned (&x)[16]) {
#pragma unroll
    for (int k = 2; k <= 16; k <<= 1)
#pragma unroll
        for (int j = k >> 1; j > 0; j >>= 1) bitonic_stage_desc<16>(x, k, j);
}
__device__ __forceinline__ void merge16_desc(unsigned (&run)[16], const unsigned (&ch)[16]) {
#pragma unroll
    for (int i = 0; i < 16; ++i) run[i] = run[i] > ch[15 - i] ? run[i] : ch[15 - i];
#pragma unroll
    for (int j = 8; j > 0; j >>= 1) bitonic_stage_desc<16>(run, 16, j);
}
__device__ __forceinline__ unsigned mono_hi(unsigned w) { return w ^ ((unsigned)((int)w >> 31) | 0x80000000u); }
__device__ __forceinline__ float demono_hi(unsigned k) { const unsigned kk = k & 0xffff0000u; return __builtin_bit_cast(float, (kk ^ ((unsigned)(~(int)kk >> 31) | 0x80000000u)) & 0xffff0000u); }
__device__ __forceinline__ void top16_list(LAS const unsigned char* row, int sw, unsigned (&run)[16]) {
#pragma unroll
    for (int ck = 0; ck < 8; ++ck) {
        const u32x4 w0 = *(LAS const u32x4*)(row + (((2 * ck) ^ sw) << 4)), w1 = *(LAS const u32x4*)(row + (((2 * ck + 1) ^ sw) << 4));
        const unsigned w[8] = {w0.x, w0.y, w0.z, w0.w, w1.x, w1.y, w1.z, w1.w};
        unsigned ch[16];
#pragma unroll
        for (int i = 0; i < 8; ++i) { ch[2 * i] = (mono_hi(w[i] << 16) & 0xffff0000u) | (unsigned)(ck * 16 + 2 * i); ch[2 * i + 1] = (mono_hi(w[i]) & 0xffff0000u) | (unsigned)(ck * 16 + 2 * i + 1); }
        sort16_desc(ch);
        if (ck == 0) {
#pragma unroll
            for (int i = 0; i < 16; ++i) run[i] = ch[i];
        } else merge16_desc(run, ch);
    }
}
__device__ __forceinline__ void topk_fetch(const bf16_t* src, u32x4 (&r)[16], int L) {
#pragma unroll
    for (int i = 0; i < 16; ++i) r[i] = *(const u32x4*)(src + (size_t)(4 * i + (L >> 4)) * 256 + (L & 15) * 8);
}
__device__ __forceinline__ void topk_stage(LAS unsigned char* tile, const u32x4 (&r)[16], int L) {
#pragma unroll
    for (int i = 0; i < 16; ++i) { const int row = 4 * i + (L >> 4); *(LAS u32x4*)(tile + row * 256 + ((((L & 15) ^ (row & 15))) << 4)) = r[i]; }
}
__device__ __forceinline__ void phase_topk(const Ctx& c0) {
    Ctx c = c0; c.lane = lane_id_v(); c.tid = c.wave * 64 + c.lane;
    const bf16_t* sc = WSP(bf16_t, WS_SC); int* IDX = WSP(int, WS_IDX); float* GW = WSP(float, WS_GW);
    const int L = c.lane, gw0 = (c.vcu * 8 + c.wave) * 64, NL = c.G * 512;
    LAS unsigned char* tile = c.lds + c.wave * 16384;
    LAS const unsigned char* myrow = tile + L * 256; const int sw = L & 15;
    for (int eb = gw0; eb < T * H; eb += NL) {
        const int e = eb + L;
        unsigned ka[16], kb[16];
        u32x4 ra[16], rb[16];
        topk_fetch(sc + (size_t)eb * 256, ra, L);
        topk_fetch(sc + (size_t)eb * 256 + 128, rb, L);
        topk_stage(tile, ra, L);
        top16_list(myrow, sw, ka);
        topk_stage(tile, rb, L);
        top16_list(myrow, sw, kb);
        float sa[16], sb[16]; unsigned ia[16], ib[16];
#pragma unroll
        for (int i = 0; i < 16; ++i) { sa[i] = demono_hi(ka[i]); sb[i] = demono_hi(kb[i]); ia[i] = (ka[i] & 0x7fu) << 7; ib[i] = kb[i] & 0x7fu; }
        const float mx = sa[0] + sb[0];
        unsigned run[16], ch[16]; int n = 0, nc = 0;
#pragma unroll
        for (int a = 0; a < 16; ++a)
#pragma unroll
            for (int b = 0; b < 16; ++b) if ((a + 1) * (b + 1) <= 16) {
                const int k = 65535 + (int)((sa[a] + sb[b] - mx) * 1024.f);
                ch[n] = ((unsigned)(k < 0 ? 0 : k) << 16) | ia[a] | ib[b];
                if (++n == 16) { sort16_desc(ch); if (nc == 0) {
#pragma unroll
                        for (int i = 0; i < 16; ++i) run[i] = ch[i]; } else merge16_desc(run, ch);
                    n = 0; ++nc; }
            }
#pragma unroll
        for (int i = 2; i < 16; ++i) ch[i] = 0u;
        sort16_desc(ch); merge16_desc(run, ch);
        float ex[16]; float sum = 0.f;
#pragma unroll
        for (int i = 0; i < 16; ++i) { ex[i] = __expf((float)((int)(run[i] >> 16) - 65535) * (1.f / 1024.f)); sum += ex[i]; }
        const float inv = 1.f / sum;
        u32x4* oi = (u32x4*)(IDX + (size_t)e * 16); f32x4* og = (f32x4*)(GW + (size_t)e * 16);
#pragma unroll
        for (int q = 0; q < 4; ++q) { u32x4 vi; vi.x = run[4 * q] & 0x3fffu; vi.y = run[4 * q + 1] & 0x3fffu; vi.z = run[4 * q + 2] & 0x3fffu; vi.w = run[4 * q + 3] & 0x3fffu; oi[q] = vi;
            f32x4 vg; vg.x = ex[4 * q] * inv; vg.y = ex[4 * q + 1] * inv; vg.z = ex[4 * q + 2] * inv; vg.w = ex[4 * q + 3] * inv; og[q] = vg; }
    }
}

__device__ __forceinline__ void dec32_fp4(const u32x4 r, f32x2 (&f)[16]) {
    const unsigned w[4] = {r.x, r.y, r.z, r.w};
#pragma unroll
    for (int i = 0; i < 4; ++i) { f[4 * i] = __builtin_amdgcn_cvt_scalef32_pk_f32_fp4(w[i], 1.0f, 0); f[4 * i + 1] = __builtin_amdgcn_cvt_scalef32_pk_f32_fp4(w[i], 1.0f, 1);
        f[4 * i + 2] = __builtin_amdgcn_cvt_scalef32_pk_f32_fp4(w[i], 1.0f, 2); f[4 * i + 3] = __builtin_amdgcn_cvt_scalef32_pk_f32_fp4(w[i], 1.0f, 3); }
}
__device__ __forceinline__ float dot32_fp4(const f32x2 (&hv)[16], const u32x4 r) {
    f32x2 f[16]; dec32_fp4(r, f); f32x2 s = hv[0] * f[0];
#pragma unroll
    for (int j = 1; j < 16; ++j) s = s + hv[j] * f[j];
    return s.x + s.y;
}
typedef int i32x8 __attribute__((ext_vector_type(8)));
__device__ __forceinline__ void phase_peer_u(const Ctx& c0) {
    Ctx c = c0; c.lane = lane_id_v(); c.tid = c.wave * 64 + c.lane;
    const int* IDX = WSP(int, WS_IDX);
    const int L = c.lane, pp = blockIdx.x & 3, hh = (blockIdx.x >> 2) & 1, rank = blockIdx.x >> 3, nrank = c.G >> 3;
    LAS int* mb = (LAS int*)(c.lds + c.wave * 1024);
    const int vr = L & 15, g4 = L >> 4;
    const unsigned char* EU4b = c.ws + WS_EU + (size_t)pp * NE * 128;
    const unsigned char* H8 = c.ws + WS_H2Q + pp * 256 + (vr & 1) * 128 + g4 * 16;
    float* PD = WSP(float, WS_PD) + (size_t)(2 * pp + (vr & 1)) * T * 128 + 2 * g4;
    const int t0 = 2 * (rank * 8 + c.wave) + hh, ts = 2 * nrank * 8;
    if (t0 >= T) return;
    int sc1 = 0x7f7f7f7f; asm volatile("" : "+v"(sc1));
    const bool swapb = WSP(unsigned, WS_C8SP)[1024] != 0u;
    { const int g0 = IDX[(size_t)t0 * 128 + L], g1 = IDX[(size_t)t0 * 128 + 64 + L]; mb[L] = g0; mb[64 + L] = g1; }
    u32x4 rA[16], rB[16];
    { const unsigned char* EU4 = EU4b + (vr & 1) * 64 + g4 * 16;
#pragma unroll
      for (int G = 0; G < 16; ++G) rA[G] = *(const u32x4*)(EU4 + (size_t)mb[8 * G + (vr >> 1)] * 128); }
    int cur = 0;
#define PEER_U_TOKEN(RC, RN, tcur, tnext, tnext2) do { \
        int lo = (vr & 1) * 64 + g4 * 16; asm volatile("" : "+v"(lo)); const unsigned char* EU4 = EU4b + lo; \
        const int gn0 = IDX[(size_t)(tnext2) * 128 + L], gn1 = IDX[(size_t)(tnext2) * 128 + 64 + L]; \
        i32x8 hb = (i32x8){0, 0, 0, 0, 0, 0, 0, 0}; \
        if (vr < 2) { const u32x4 h0 = *(const u32x4*)(H8 + (size_t)(tcur) * 1024), h1 = *(const u32x4*)(H8 + (size_t)(tcur) * 1024 + 64); \
            unsigned hw[8] = {h0.x, h0.y, h0.z, h0.w, h1.x, h1.y, h1.z, h1.w}; \
            if (swapb) { _Pragma("unroll") for (int q = 0; q < 8; ++q) hw[q] = ((hw[q] & 0x00ff00ffu) << 8) | ((hw[q] >> 8) & 0x00ff00ffu); } \
            hb = (i32x8){(int)hw[0], (int)hw[1], (int)hw[2], (int)hw[3], (int)hw[4], (int)hw[5], (int)hw[6], (int)hw[7]}; } \
          \
        _Pragma("unroll") for (int G = 0; G < 16; ++G) RN[G] = *(const u32x4*)(EU4 + (size_t)mb[(cur ^ 1) * 128 + 8 * G + (vr >> 1)] * 128); \
          \
        mb[cur * 128 + L] = gn0; mb[cur * 128 + 64 + L] = gn1; \
        f32x4 acc[16]; \
        _Pragma("unroll") for (int G = 0; G < 16; ++G) { const i32x8 a = (i32x8){(int)RC[G].x, (int)RC[G].y, (int)RC[G].z, (int)RC[G].w, 0, 0, 0, 0}; \
            acc[G] = __builtin_amdgcn_mfma_scale_f32_16x16x128_f8f6f4(a, hb, (f32x4){0.f, 0.f, 0.f, 0.f}, 4, 0, 0, sc1, 0, sc1); } \
        if (vr < 2) { _Pragma("unroll") for (int G = 0; G < 16; ++G) { f32x2 o; o.x = vr ? acc[G][1] : acc[G][0]; o.y = vr ? acc[G][3] : acc[G][2]; *(f32x2*)(PD + (size_t)(tcur) * 128 + 8 * G) = o; } } \
        cur ^= 1; } while (0)
    { const int t1 = (t0 + ts < T) ? t0 + ts : t0; const int g0 = IDX[(size_t)t1 * 128 + L], g1 = IDX[(size_t)t1 * 128 + 64 + L]; mb[128 + L] = g0; mb[128 + 64 + L] = g1; }
#pragma unroll 1
    for (int t = t0; t < T; t += 2 * ts) {
        const int ta = t, tb = (t + ts < T) ? t + ts : t, tc = (t + 2 * ts < T) ? t + 2 * ts : tb, td = (t + 3 * ts < T) ? t + 3 * ts : tc;
        PEER_U_TOKEN(rA, rB, ta, tb, tc);
        if (t + ts < T) PEER_U_TOKEN(rB, rA, tb, tc, td);
    }
#undef PEER_U_TOKEN
}
__device__ __forceinline__ void phase_peer_fin(const Ctx& c0) {
    Ctx c = c0; c.lane = lane_id_v(); c.tid = c.wave * 64 + c.lane;
    const int* IDX = WSP(int, WS_IDX); const float* GW = WSP(float, WS_GW); const float* PD = WSP(float, WS_PD); unsigned* WGT = WSP(unsigned, WS_WGT);
    const float* SU = WSP(float, WS_SU); const float* SV = WSP(float, WS_SV); const float* SH = WSP(float, WS_SH);
    const int NTH = c.G * 512;
    for (int i0 = c.vcu * 512 + c.tid; i0 < T * 128; i0 += 4 * NTH) {
        float d[4]; int e[4]; float g[4];
#pragma unroll
        for (int u = 0; u < 4; ++u) { const int i = (i0 + u * NTH < T * 128) ? i0 + u * NTH : i0; float s = 0.f;
#pragma unroll
            for (int p = 0; p < 8; ++p) s += PD[(size_t)p * T * 128 + i];
            d[u] = s; e[u] = IDX[i]; g[u] = GW[i]; }
        float su[4], sv[4], sh[4];
#pragma unroll
        for (int u = 0; u < 4; ++u) { const int i = (i0 + u * NTH < T * 128) ? i0 + u * NTH : i0; su[u] = SU[e[u]]; sv[u] = SV[e[u]]; sh[u] = SH[i >> 7]; }
#pragma unroll
        for (int u = 0; u < 4; ++u) { const int i = i0 + u * NTH; if (i < T * 128) WGT[i] = (f2bf(g[u] * gelu_tanh(d[u] * su[u] * sh[u]) * sv[u]) << 16) | (unsigned)e[u]; }
    }
}
template <bool DRY> __device__ __forceinline__ void phase_peer_v(const Ctx& c0) {
    Ctx c = c0; c.lane = lane_id_v(); c.tid = c.wave * 64 + c.lane;
    const unsigned* WI = WSP(unsigned, WS_WGT); const float* mod = WSP(float, WS_MOD);
    const int L = c.lane, pp = blockIdx.x & 3, hh = (blockIdx.x >> 2) & 1, rank = blockIdx.x >> 3, nrank = c.G >> 3;
    const bool b5 = L & 32, b4 = L & 16, b3 = L & 8;
    LAS unsigned* mb = (LAS unsigned*)(c.lds + c.wave * 1024);
    const int kl = L >> 3;
    const unsigned char* EV4 = c.ws + WS_EV + (size_t)pp * NE * 128 + (L & 7) * 16;
    const int col = pp * 256 + (L & 7) * 32 + (b5 ? 16 : 0) + (b4 ? 8 : 0) + (b3 ? 4 : 0);
    const int t0 = 2 * (rank * 8 + c.wave) + hh, ts = 2 * nrank * 8;
    if (t0 >= T) return;
    { const unsigned g0 = WI[(size_t)t0 * 128 + L], g1 = WI[(size_t)t0 * 128 + 64 + L]; mb[L] = g0; mb[64 + L] = g1; }
    u32x4 rA[8], rB[8];
#pragma unroll
    for (int i = 0; i < 8; ++i) rA[i] = *(const u32x4*)(EV4 + (size_t)(mb[8 * i + kl] & 0xffffu) * 128);
    int cur = 0;
#pragma unroll 1
    for (int t = t0; t < T; t += ts) {
        const int tn = (t + ts < T) ? t + ts : t;
        const unsigned gn0 = WI[(size_t)tn * 128 + L], gn1 = WI[(size_t)tn * 128 + 64 + L];
        float* o = c.out + (size_t)t * 1024 + col; const float* g2 = mod + (t >> 11) * 6144 + 5120 + col;
        f32x4 xo = *(const f32x4*)o; const f32x4 gt = *(const f32x4*)g2;
#pragma unroll
        for (int i = 0; i < 8; ++i) rB[i] = *(const u32x4*)(EV4 + (size_t)(mb[cur * 128 + 64 + 8 * i + kl] & 0xffffu) * 128);
        f32x2 ac2[16];
#pragma unroll
        for (int j = 0; j < 16; ++j) ac2[j] = (f32x2){0.f, 0.f};
#pragma unroll
        for (int i = 0; i < 8; ++i) { const float w = bfhi(mb[cur * 128 + 8 * i + kl]); const f32x2 w2 = {w, w}; f32x2 f[16]; dec32_fp4(rA[i], f);
#pragma unroll
            for (int j = 0; j < 16; ++j) ac2[j] = ac2[j] + f[j] * w2; }
        mb[(cur ^ 1) * 128 + L] = gn0; mb[(cur ^ 1) * 128 + 64 + L] = gn1;
#pragma unroll
        for (int i = 0; i < 8; ++i) rA[i] = *(const u32x4*)(EV4 + (size_t)(mb[(cur ^ 1) * 128 + 8 * i + kl] & 0xffffu) * 128);
#pragma unroll
        for (int i = 0; i < 8; ++i) { const float w = bfhi(mb[cur * 128 + 64 + 8 * i + kl]); const f32x2 w2 = {w, w}; f32x2 f[16]; dec32_fp4(rB[i], f);
#pragma unroll
            for (int j = 0; j < 16; ++j) ac2[j] = ac2[j] + f[j] * w2; }
        float acc[32];
#pragma unroll
        for (int j = 0; j < 16; ++j) { acc[2 * j] = ac2[j].x; acc[2 * j + 1] = ac2[j].y; }
        float n16[16], n8[8], n4[4];
#pragma unroll
        for (int i = 0; i < 16; ++i) { const float send = b5 ? acc[i] : acc[i + 16], keep = b5 ? acc[i + 16] : acc[i]; n16[i] = keep + __shfl_xor(send, 32); }
#pragma unroll
        for (int i = 0; i < 8; ++i) { const float send = b4 ? n16[i] : n16[i + 8], keep = b4 ? n16[i + 8] : n16[i]; n8[i] = keep + __shfl_xor(send, 16); }
#pragma unroll
        for (int i = 0; i < 4; ++i) { const float send = b3 ? n8[i] : n8[i + 4], keep = b3 ? n8[i + 4] : n8[i]; n4[i] = keep + __shfl_xor(send, 8); }
        xo.x += gt.x * n4[0]; xo.y += gt.y * n4[1]; xo.z += gt.z * n4[2]; xo.w += gt.w * n4[3];
        if (DRY) asm volatile("" :: "v"(xo.x), "v"(xo.y), "v"(xo.z), "v"(xo.w)); else *(f32x4*)o = xo;
        cur ^= 1;
    }
}

struct ENone {};
struct FInProj { static constexpr int NB = 4; bf16_t *pa, *lx, *lg, *mg; typedef ENone Tile; typedef ENone Pre;
    __device__ __forceinline__ Tile tile(int, int, int) const { return Tile{}; }
    __device__ __forceinline__ Pre pre(int, int, int) const { return Pre{}; }
    __device__ __forceinline__ void apply(int row, int pn, int cc, const float (&v0)[8], const float (&v1)[8], const Pre&, const Tile&) const {
        bf16_t* d;
        if (pn < 2) d = pa + (size_t)row * 512 + pn * 256 + cc; else if (pn < 6) d = lx + (size_t)row * 1024 + (pn - 2) * 256 + cc;
        else if (pn < 10) d = lg + (size_t)row * 1024 + (pn - 6) * 256 + cc; else d = mg + (size_t)row * 2048 + (pn - 10) * 256 + cc;
        *(u32x4*)d = pack8(v0); *(u32x4*)(d + 128) = pack8(v1); } };
struct FRowScale { static constexpr int NB = 4; bf16_t* dst; int ldc; const float* rstd; int which; typedef ENone Tile; struct Pre { float r; };
    __device__ __forceinline__ Tile tile(int, int, int) const { return Tile{}; }
    __device__ __forceinline__ Pre pre(int row, int, int) const { return Pre{rstd[2 * row + which]}; }
    __device__ __forceinline__ void apply(int row, int pn, int cc, const float (&v0)[8], const float (&v1)[8], const Pre& p, const Tile&) const {
        float a[8], b[8];
#pragma unroll
        for (int j = 0; j < 8; ++j) { a[j] = v0[j] * p.r; b[j] = v1[j] * p.r; }
        *(u32x4*)(dst + (size_t)row * ldc + pn * 256 + cc) = pack8(a); *(u32x4*)(dst + (size_t)row * ldc + pn * 256 + 128 + cc) = pack8(b); } };
constexpr int GT_OFF = 132096;
struct FGates { static constexpr int NB = 2; const bf16_t* xc; bf16_t *LA, *Bv; LAS const float* gt;
    typedef ENone Tile; struct Pre { u32x4 x; };
    __device__ __forceinline__ Tile tile(int, int, int) const { return Tile{}; }
    __device__ __forceinline__ Pre pre(int row, int pn, int cc) const { return Pre{*(const u32x4*)(xc + (size_t)row * 1024 + pn * 128 + cc)}; }
    __device__ __forceinline__ void apply(int row, int pn, int cc, const float (&v0)[8], const float (&v1)[8], const Pre& p, const Tile&) const {
        const int ch = pn * 128 + cc; float x[8], la[8], bv[8]; unpack8(p.x, x);
        const f32x4 br0 = *(LAS const f32x4*)(gt + ch), br1 = *(LAS const f32x4*)(gt + ch + 4), bi0 = *(LAS const f32x4*)(gt + 1024 + ch), bi1 = *(LAS const f32x4*)(gt + 1024 + ch + 4),
                    c80 = *(LAS const f32x4*)(gt + 2048 + ch), c81 = *(LAS const f32x4*)(gt + 2048 + ch + 4);
        const float br[8] = {br0.x, br0.y, br0.z, br0.w, br1.x, br1.y, br1.z, br1.w}, bi[8] = {bi0.x, bi0.y, bi0.z, bi0.w, bi1.x, bi1.y, bi1.z, bi1.w}, c8[8] = {c80.x, c80.y, c80.z, c80.w, c81.x, c81.y, c81.z, c81.w};
#pragma unroll
        for (int j = 0; j < 8; ++j) {
            const float r = __builtin_amdgcn_rcpf(1.f + __expf(-(v0[j] + br[j]))), ig = __builtin_amdgcn_rcpf(1.f + __expf(-(v1[j] + bi[j])));
            const float loga = r * c8[j];
            const float z = 2.f * loga;
            const float ser = -z * (1.f + z * (0.5f + z * (0.16666667f + z * (0.041666668f + z * (0.008333334f + z * 0.0013888889f)))));
            const float om = (z > -0.25f) ? ser : (1.f - __expf(z));
            la[j] = loga * 1.4426950408889634f;
            bv[j] = sqrtf(om) * (ig * x[j]);
        }
        *(u32x4*)(LA + (size_t)row * 1024 + ch) = pack8(la); *(u32x4*)(Bv + (size_t)row * 1024 + ch) = pack8(bv); } };
struct FY1 { static constexpr int NB = 4; const bf16_t* mg; bf16_t* y; int goff; bool accum; typedef ENone Tile; struct Pre { u32x4 g0, g1, y0, y1; };
    __device__ __forceinline__ Tile tile(int, int, int) const { return Tile{}; }
    __device__ __forceinline__ Pre pre(int row, int pn, int cc) const { Pre p; const int col = pn * 256 + cc;
        p.g0 = *(const u32x4*)(mg + (size_t)row * 2048 + goff + col); p.g1 = *(const u32x4*)(mg + (size_t)row * 2048 + goff + col + 128);
        if (accum) { p.y0 = *(const u32x4*)(y + (size_t)row * 1024 + col); p.y1 = *(const u32x4*)(y + (size_t)row * 1024 + col + 128); } else { p.y0 = (u32x4){0u, 0u, 0u, 0u}; p.y1 = p.y0; }
        return p; }
    __device__ __forceinline__ void one(bf16_t* dst, const u32x4 g, const u32x4 yo, const float (&v)[8]) const {
        float gt[8], o[8]; unpack8(g, gt); unpack8(yo, o);
#pragma unroll
        for (int j = 0; j < 8; ++j) o[j] = o[j] + sigmoidf_(gt[j]) * v[j];
        *(u32x4*)dst = pack8(o); }
    __device__ __forceinline__ void apply(int row, int pn, int cc, const float (&v0)[8], const float (&v1)[8], const Pre& p, const Tile&) const {
        bf16_t* d = y + (size_t)row * 1024 + pn * 256 + cc; one(d, p.g0, p.y0, v0); one(d + 128, p.g1, p.y1, v1); } };
struct FX1 { static constexpr int NB = 4; const float* x; float* out; const float* mod; struct Tile { f32x4 a[4]; }; struct Pre { f32x4 x[4]; };
    __device__ __forceinline__ Tile tile(int pn, int cc, int pm) const { Tile t; const float* g1 = mod + ((pm * 256) >> 11) * 6144 + 2048 + pn * 256 + cc;
        t.a[0] = *(const f32x4*)g1; t.a[1] = *(const f32x4*)(g1 + 4); t.a[2] = *(const f32x4*)(g1 + 128); t.a[3] = *(const f32x4*)(g1 + 132); return t; }
    __device__ __forceinline__ Pre pre(int row, int pn, int cc) const { Pre p; const float* xr = x + (size_t)row * 1024 + pn * 256 + cc;
        p.x[0] = *(const f32x4*)xr; p.x[1] = *(const f32x4*)(xr + 4); p.x[2] = *(const f32x4*)(xr + 128); p.x[3] = *(const f32x4*)(xr + 132); return p; }
    __device__ __forceinline__ void apply(int row, int pn, int cc, const float (&v0)[8], const float (&v1)[8], const Pre& p, const Tile& t) const {
        float* o = out + (size_t)row * 1024 + pn * 256 + cc;
        f32x4 r0, r1, r2, r3;
        r0.x = p.x[0].x + t.a[0].x * v0[0]; r0.y = p.x[0].y + t.a[0].y * v0[1]; r0.z = p.x[0].z + t.a[0].z * v0[2]; r0.w = p.x[0].w + t.a[0].w * v0[3];
        r1.x = p.x[1].x + t.a[1].x * v0[4]; r1.y = p.x[1].y + t.a[1].y * v0[5]; r1.z = p.x[1].z + t.a[1].z * v0[6]; r1.w = p.x[1].w + t.a[1].w * v0[7];
        r2.x = p.x[2].x + t.a[2].x * v1[0]; r2.y = p.x[2].y + t.a[2].y * v1[1]; r2.z = p.x[2].z + t.a[2].z * v1[2]; r2.w = p.x[2].w + t.a[2].w * v1[3];
        r3.x = p.x[3].x + t.a[3].x * v1[4]; r3.y = p.x[3].y + t.a[3].y * v1[5]; r3.z = p.x[3].z + t.a[3].z * v1[6]; r3.w = p.x[3].w + t.a[3].w * v1[7];
        *(f32x4*)o = r0; *(f32x4*)(o + 4) = r1; *(f32x4*)(o + 128) = r2; *(f32x4*)(o + 132) = r3; } };
struct FStore { static constexpr int NB = 4; bf16_t* dst; int ldc; typedef ENone Tile; typedef ENone Pre;
    __device__ __forceinline__ Tile tile(int, int, int) const { return Tile{}; }
    __device__ __forceinline__ Pre pre(int, int, int) const { return Pre{}; }
    __device__ __forceinline__ void apply(int row, int pn, int cc, const float (&v0)[8], const float (&v1)[8], const Pre&, const Tile&) const {
        *(u32x4*)(dst + (size_t)row * ldc + pn * 256 + cc) = pack8(v0); *(u32x4*)(dst + (size_t)row * ldc + pn * 256 + 128 + cc) = pack8(v1); } };

template <int M, int N, int K, int LDA, int ACS, class F> __device__ __forceinline__ void run_gemm(const Ctx& c, const bf16_t* A, const bf16_t* Bt, const F& f) {
    pg8::Gemm g{A, Bt}; pg8::StaticOrder<M, N> So; So.init(c.G, (int)blockIdx.x);
    pg8::EpiF<F> E{f};
    pg8::gemm_phase<K, LDA, ACS, pg8::EpiF<F>, pg8::StaticOrder<M, N>>((PG8_LAS unsigned char*)c.lds, g, So, E, c.wave * 64 + lane_id_v());
}

__global__ void __launch_bounds__(512, 2) mk_fwd(Args args) {
    extern __shared__ __attribute__((aligned(16))) unsigned char lds_raw[];
    Ctx c;
    c.lds = (LAS unsigned char*)lds_raw;
    c.wave = __builtin_amdgcn_readfirstlane(threadIdx.x >> 6); c.lane = lane_id_v(); c.tid = c.wave * 64 + c.lane;
    c.G = gridDim.x; { const int bx = blockIdx.x; c.vcu = (c.G % 8 == 0) ? (bx % 8) * (c.G / 8) + bx / 8 : bx; }
    c.in = args.in; c.out = args.out; c.ws = args.ws;
    volatile LAS unsigned* MISC = (volatile LAS unsigned*)(c.lds + MISC_OFF);
    if (c.tid < 32) MISC[c.tid] = 0u;
    __syncthreads();
    XcdBarrier bar; bar.bar = (unsigned*)(c.ws + WS_CTL) + 4096; bar.x = 0; bar.st = nullptr;
    if (args.ph_hi - args.ph_lo > 1) bar = xcd_barrier_post((unsigned*)(c.ws + WS_CTL) + 4096, MISC + 8);

    const int lo = args.ph_lo, hi = args.ph_hi;
#ifndef ONLYP
#define ONLYP -1
#endif
#define IN(k) (lo <= (k) && (k) < hi && (ONLYP < 0 || ONLYP == (k)))
#define SEAM(k) do { if ((k) + 1 < hi) xcd_barrier(bar, c.wave); } while (0)
#ifndef REPEAT_MASK
#define REPEAT_MASK 0
#endif
#define PHASE(k, ...) if (IN(k)) { c.lane = lane_id_v(); c.tid = c.wave * 64 + c.lane; { __VA_ARGS__ } if ((REPEAT_MASK >> (k)) & 1) { xcd_barrier(bar, c.wave); { __VA_ARGS__ } } SEAM(k); }
    PHASE(0, phase_prep(c);)
    PHASE(1, phase_modnorm<false>(c, c.in[I_X], c.in[I_N1G], 0, 1024, WSP(bf16_t, WS_R0));)
    PHASE(2, FInProj f{WSP(bf16_t, WS_R1), WSP(bf16_t, WS_R2), WSP(bf16_t, WS_R3), (bf16_t*)c.out};
             run_gemm<T, 4608, 1024, 1024, 0>(c, WSP(bf16_t, WS_R0), WSP(bf16_t, WS_WIN), f);)
    PHASE(3, phase_conv(c);)
    PHASE(4, { LAS float* gtl = (LAS float*)(c.lds + GT_OFF);
               for (int e = c.tid; e < 1024; e += 512) { gtl[e] = c.in[I_BRG][e]; gtl[1024 + e] = c.in[I_BIG][e]; gtl[2048 + e] = WSP(float, WS_C8SP)[e]; }
               __syncthreads();
               FGates fg{WSP(bf16_t, WS_R4), WSP(bf16_t, WS_R0), WSP(bf16_t, WS_R6), gtl};
               run_gemm<T, 2048, 128, 1024, 128>(c, WSP(bf16_t, WS_R4), WSP(bf16_t, WS_WG), fg); }
             { FRowScale fq{WSP(bf16_t, WS_R5), 768, WSP(float, WS_RSTD), 0};
               run_gemm<T, 768, 256, 512, 0>(c, WSP(bf16_t, WS_R1), WSP(bf16_t, WS_WUQ), fq); })
    PHASE(5, { FRowScale fkv{WSP(bf16_t, WS_R2), 1024, WSP(float, WS_RSTD), 1};
               run_gemm<T, 1024, 128, 512, 0>(c, WSP(bf16_t, WS_R1) + 256, WSP(bf16_t, WS_WUKV), fkv); }
             phase_scan(c);)
    PHASE(6, phase_qkv_layout(c);)
    PHASE(7, phase_attn(c);)
    PHASE(8, { FY1 f1{(const bf16_t*)c.out, WSP(bf16_t, WS_R2), 0, false};
               run_gemm<T, 1024, 512, 512, 0>(c, WSP(bf16_t, WS_R0 + 32 * MiB), WSP(bf16_t, WS_WOA), f1); }
             { FY1 f2{(const bf16_t*)c.out, WSP(bf16_t, WS_R2), 1024, true};
               run_gemm<T, 1024, 1024, 1024, 0>(c, WSP(bf16_t, WS_R6), WSP(bf16_t, WS_WOL), f2); })
    PHASE(9, FX1 f{c.in[I_X], c.out, WSP(float, WS_MOD)};
             run_gemm<T, 1024, 1024, 1024, 0>(c, WSP(bf16_t, WS_R2), WSP(bf16_t, WS_WOUT), f);)
    PHASE(10, phase_modnorm<true>(c, c.out, c.in[I_N2G], 3072, 4096, WSP(bf16_t, WS_R0));)
    PHASE(11, FStore f{WSP(bf16_t, WS_SC), 2048};
              run_gemm<T, 2048, 1024, 1024, 0>(c, WSP(bf16_t, WS_R0), WSP(bf16_t, WS_WQ), f);)
    PHASE(13, phase_topk(c);)
    PHASE(14, phase_peer_u(c);)
    PHASE(15, phase_peer_fin(c);)
#ifdef PROBE_VDRY
    if (IN(16)) { c.lane = lane_id_v(); c.tid = c.wave * 64 + c.lane; phase_peer_v<true>(c); xcd_barrier(bar, c.wave); }
#endif
    PHASE(16, phase_peer_v<false>(c);)
#undef PHASE
#undef IN
#undef SEAM
}

extern "C" void kernel_launch(void* const* d_in, const int* in_sizes, int n_in, void* d_out, int out_size, void* d_ws, size_t ws_size, hipStream_t stream) {
    static int grid = 0;
    if (grid == 0) {
        if (n_in != 28 || out_size != T * D || ws_size < WS_END) { fprintf(stderr, "kernel_launch: unexpected shapes (n_in %d out %d ws %zu)\n", n_in, out_size, ws_size); grid = -1; return; }
        int dev = 0, cus = 0, per_cu = 0;
        if (hipGetDevice(&dev) != hipSuccess || hipDeviceGetAttribute(&cus, hipDeviceAttributeMultiprocessorCount, dev) != hipSuccess) { grid = -1; return; }
        if (hipFuncSetAttribute((const void*)mk_fwd, hipFuncAttributeMaxDynamicSharedMemorySize, LDS_BYTES) != hipSuccess) { fprintf(stderr, "kernel_launch: hipFuncSetAttribute failed\n"); grid = -1; return; }
        if (hipOccupancyMaxActiveBlocksPerMultiprocessor(&per_cu, (const void*)mk_fwd, 512, LDS_BYTES) != hipSuccess || per_cu < 1) { fprintf(stderr, "kernel_launch: occupancy query says %d blocks per CU\n", per_cu); grid = -1; (void)hipGetLastError(); return; }
        grid = cus - (cus % 8);
        if (grid < 8) { fprintf(stderr, "kernel_launch: needs at least 8 CUs\n"); grid = -1; return; }
    }
    if (grid < 0) return;
    (void)hipMemsetAsync((char*)d_ws + WS_CTL, 0, CTL_ZERO_BYTES, stream);
    Args a{};
    for (int i = 0; i < 28; ++i) a.in[i] = (const float*)d_in[i];
    a.out = (float*)d_out; a.ws = (unsigned char*)d_ws;
#if MK_N_LAUNCHES == 1
    a.ph_lo = 0; a.ph_hi = N_PHASES;
    hipLaunchKernelGGL(mk_fwd, dim3(grid), dim3(512), LDS_BYTES, stream, a);
#else
    for (int ph = 0; ph < N_PHASES; ++ph) { a.ph_lo = ph; a.ph_hi = ph + 1; hipLaunchKernelGGL(mk_fwd, dim3(grid), dim3(512), LDS_BYTES, stream, a); }
#endif
}
```

```cpp
#include <hip/hip_runtime.h>
#include <cstdio>
#include <cstdint>

#define LAS __attribute__((address_space(3)))
#define GAS __attribute__((address_space(1)))
typedef unsigned short bf16_t;
typedef short bf16x8 __attribute__((ext_vector_type(8)));
typedef float f32x4 __attribute__((ext_vector_type(4)));
typedef float f32x2 __attribute__((ext_vector_type(2)));
typedef unsigned u32x4 __attribute__((ext_vector_type(4)));
typedef unsigned u32x2 __attribute__((ext_vector_type(2)));

#ifndef MK_N_LAUNCHES
#define MK_N_LAUNCHES 1
#endif

constexpr int T = 32768, D = 1024, NB_ = 16, S = 2048, H = 8;
constexpr int QKH = 96, VH = 64;
constexpr int NE = 16384;
constexpr float EPS = 1e-6f;

constexpr size_t MiB = 1u << 20;
constexpr size_t WS_CTL = 0, CTL_ZERO_BYTES = 65536;
constexpr size_t WS_MOD = 1 * MiB;
constexpr size_t WS_RSTD = 1 * MiB + 512 * 1024;
constexpr size_t WS_C8SP = 1 * MiB + 448 * 1024;
constexpr size_t WS_WIN = 2 * MiB;
constexpr size_t WS_WUQ = 11 * MiB;
constexpr size_t WS_WUKV = 11 * MiB + 512 * 1024;
constexpr size_t WS_WOA = 12 * MiB;
constexpr size_t WS_WOL = 13 * MiB;
constexpr size_t WS_WOUT = 15 * MiB;
constexpr size_t WS_WQ = 17 * MiB;
constexpr size_t WS_WG = 21 * MiB;
constexpr size_t WS_SK = 22 * MiB;
constexpr size_t WS_EU = 24 * MiB;
constexpr size_t WS_EV = 40 * MiB;
constexpr size_t WS_SU = 1 * MiB + 768 * 1024;
constexpr size_t WS_SV = 1 * MiB + 832 * 1024;
constexpr size_t WS_WGT = 440 * MiB;
constexpr size_t WS_CS = 56 * MiB;
constexpr size_t WS_H2Q = 456 * MiB;
constexpr size_t WS_SH = 1 * MiB + 896 * 1024;
constexpr size_t WS_PD = 280 * MiB;
constexpr size_t WS_R0 = 88 * MiB;
constexpr size_t WS_R1 = 152 * MiB;
constexpr size_t WS_R2 = 184 * MiB;
constexpr size_t WS_R3 = 248 * MiB;
constexpr size_t WS_R4 = 312 * MiB;
constexpr size_t WS_R5 = 376 * MiB;
constexpr size_t WS_R6 = 424 * MiB;
constexpr size_t WS_QP = 152 * MiB;
constexpr size_t WS_SC = 280 * MiB;
constexpr size_t WS_IDX = 408 * MiB;
constexpr size_t WS_GW = 424 * MiB;
constexpr size_t WS_END = 488 * MiB;

constexpr int LDS_BYTES = 155648;
constexpr int MISC_OFF = 131072 + 320;

__device__ __forceinline__ unsigned f2bf(float f) { unsigned u = __builtin_bit_cast(unsigned, f); return (u + 0x7fffu + ((u >> 16) & 1u)) >> 16; }
typedef __bf16 bf16x2_t __attribute__((ext_vector_type(2)));
__device__ __forceinline__ unsigned pk2(float lo, float hi) { f32x2 v = {lo, hi}; return __builtin_bit_cast(unsigned, __builtin_convertvector(v, bf16x2_t)); }
__device__ __forceinline__ float bf2f(unsigned h) { return __builtin_bit_cast(float, h << 16); }
__device__ __forceinline__ float bflo(unsigned w) { return __builtin_bit_cast(float, w << 16); }
__device__ __forceinline__ float bfhi(unsigned w) { return __builtin_bit_cast(float, w & 0xffff0000u); }
__device__ __forceinline__ float sigmoidf_(float x) { return 1.f / (1.f + __expf(-x)); }
__device__ __forceinline__ float gelu_tanh(float x) {
    const float u = 0.7978845608028654f * (x + 0.044715f * x * x * x);
    const float e = __expf(2.f * u);
    const float th = 1.f - 2.f / (e + 1.f);
    return 0.5f * x * (1.f + th);
}
__device__ __forceinline__ int lane_id_v() { int l; asm volatile("v_mbcnt_lo_u32_b32 %0, -1, 0\n\tv_mbcnt_hi_u32_b32 %0, -1, %0" : "=v"(l)); return l; }
__device__ __forceinline__ float wave_sum(float v) {
#pragma unroll
    for (int o = 1; o < 64; o <<= 1) v += __shfl_xor(v, o);
    return v;
}
__device__ __forceinline__ void unpack8(const u32x4 w, float (&v)[8]) {
    v[0] = bflo(w.x); v[1] = bfhi(w.x); v[2] = bflo(w.y); v[3] = bfhi(w.y); v[4] = bflo(w.z); v[5] = bfhi(w.z); v[6] = bflo(w.w); v[7] = bfhi(w.w);
}
__device__ __forceinline__ u32x4 pack8(const float (&v)[8]) {
    u32x4 w; w.x = pk2(v[0], v[1]); w.y = pk2(v[2], v[3]); w.z = pk2(v[4], v[5]); w.w = pk2(v[6], v[7]); return w;
}

namespace pg8 {
#define PG8_LAS __attribute__((address_space(3)))
constexpr int BM = 256, BK = 64, HALF = 128, HTB = HALF * BK * 2, STAGE_BYTES = 8 * HTB, NXCD = 8, WGM = 8;
__host__ __device__ __forceinline__ int lds_byte(int r, int c) { const int st = (r >> 4) * 2 + (c >> 5), rr = r & 15, cc = c & 31, ob = rr * 64 + cc * 2; return st * 1024 + (ob ^ (((ob >> 9) & 1) << 5)); }
__host__ __device__ __forceinline__ void stage_rc(int b, int& R, int& C) { const int st = b / 1024, sb = b % 1024, swz = sb ^ (((sb >> 9) & 1) << 5); R = (st >> 1) * 16 + swz / 64; C = (st & 1) * 32 + (swz % 64) / 2; }
__host__ __device__ __forceinline__ int perm32(int rho) { const int n = rho >> 4, i = rho & 15; return 8 * (i >> 2) + 4 * n + (i & 3); }

struct Unit { int pm, pn; };
struct Gemm { const bf16_t* A; const bf16_t* Bt; };

template <int M_, int N_> struct StaticOrder {
    static constexpr int nM = M_ / BM, nN = N_ / BM, nwg = nM * nN;
    int G, c;
    __host__ __device__ void init(int G_, int c_) { G = G_; c = c_; }
    __host__ __device__ bool next(int i, Unit& u) const {
        const long L = (long)i * G + c; if (L >= nwg) return false;
        int wgid = (int)L; { const int q = nwg / NXCD, r = nwg % NXCD, xcd = wgid % NXCD, off = wgid / NXCD; wgid = (xcd < r ? xcd * (q + 1) : r * (q + 1) + (xcd - r) * q) + off; }
        const int nig = WGM * nN, gid = wgid / nig, fm = gid * WGM, gsz = (nM - fm) < WGM ? (nM - fm) : WGM;
        u.pm = fm + ((wgid % nig) % gsz); u.pn = (wgid % nig) / gsz; return true;
    }
};

template <class F> struct EpiF {
    static constexpr bool PERM = true;
    F f;
    __device__ __forceinline__ void operator()(const f32x4 (&acc)[2][2][4][2], const Unit& u, int wr, int wc, int fr, int fq) const {
        { int l_; asm volatile("v_mbcnt_lo_u32_b32 %0, -1, 0\n\tv_mbcnt_hi_u32_b32 %0, -1, %0" : "=v"(l_)); fr = l_ & 15; fq = l_ >> 4; }
        const int c = wc * 32 + 8 * fq;
        const typename F::Tile tl = f.tile(u.pn, c, u.pm);
#pragma unroll
        for (int ai = 0; ai < 2; ++ai)
#pragma unroll
            for (int mb = 0; mb < 4; mb += F::NB) {
                typename F::Pre pre[F::NB];
#pragma unroll
                for (int m = 0; m < F::NB; ++m) pre[m] = f.pre(u.pm * BM + ai * HALF + wr * 64 + (mb + m) * 16 + fr, u.pn, c);
#pragma unroll
                for (int m = 0; m < F::NB; ++m) {
                    const int row = u.pm * BM + ai * HALF + wr * 64 + (mb + m) * 16 + fr;
                    float v0[8], v1[8];
#pragma unroll
                    for (int j = 0; j < 4; ++j) { v0[j] = acc[ai][0][mb + m][0][j]; v0[4 + j] = acc[ai][0][mb + m][1][j]; v1[j] = acc[ai][1][mb + m][0][j]; v1[4 + j] = acc[ai][1][mb + m][1][j]; }
                    f.apply(row, u.pn, c, v0, v1, pre[m], tl);
                }
            }
    }
};

template <int K, int LDA, int ACS, class Epi, class Sched>
__device__ __forceinline__ void gemm_phase(PG8_LAS unsigned char* lds, const Gemm g, const Sched& S, const Epi& E, const int tid) {
    const int wid = __builtin_amdgcn_readfirstlane(tid >> 6), lane = tid & 63, wr = wid >> 2, wc = wid & 3, fr = lane & 15, fq = lane >> 4;
    constexpr int nt = K / BK;
    unsigned voffA[2], voffB[2];
#pragma unroll
    for (int i = 0; i < 2; ++i) { int R, C; stage_rc(tid * 16 + i * 8192, R, C); const int Rb = Epi::PERM ? ((R & ~31) + perm32(R & 31)) : R;
        voffA[i] = (unsigned)(R * LDA + C) * 2u; voffB[i] = (unsigned)(Rb * K + C) * 2u; }
    constexpr size_t kstep = (size_t)(BK * 2);
    constexpr size_t hstepA = (size_t)HALF * LDA * 2, hstepB = (size_t)HALF * K * 2;
    constexpr size_t tstepA = 2 * hstepA, tstepB = 2 * hstepB;
    constexpr size_t acsb = (size_t)ACS * 2;
    const unsigned ldsw = (unsigned)wid * 1024u;
    const int aoff = lds_byte(wr * 64 + fr, fq * 8), boff = lds_byte(wc * 32 + fr, fq * 8);
#define PG8_SA(b, h) (((b) * 2 + (h)) * HTB)
#define PG8_SB(b, h) ((4 + (b) * 2 + (h)) * HTB)
#define PG8_STAGE(bufoff, gbase, voff) do { _Pragma("unroll") for (int _i = 0; _i < 2; ++_i) \
        __builtin_amdgcn_global_load_lds((const unsigned*)((const char*)(gbase) + (voff)[_i]), (PG8_LAS unsigned*)(lds + (bufoff) + ldsw + _i * 8192), 16, 0, 0); } while (0)
#define PG8_LDA(dst, b, h) do { _Pragma("unroll") for (int m = 0; m < 4; ++m) _Pragma("unroll") for (int k = 0; k < 2; ++k) dst[m][k] = *(const PG8_LAS bf16x8*)(lds + PG8_SA(b, h) + aoff + m * 2048 + k * 1024); } while (0)
#define PG8_LDB(dst, b, h) do { _Pragma("unroll") for (int n = 0; n < 2; ++n) _Pragma("unroll") for (int k = 0; k < 2; ++k) dst[n][k] = *(const PG8_LAS bf16x8*)(lds + PG8_SB(b, h) + boff + n * 2048 + k * 1024); } while (0)
#define PG8_MMA(ai, bj, At, Bt) do { __builtin_amdgcn_s_setprio(1); _Pragma("unroll") for (int m = 0; m < 4; ++m) _Pragma("unroll") for (int n = 0; n < 2; ++n) _Pragma("unroll") for (int k = 0; k < 2; ++k) \
        acc[ai][bj][m][n] = __builtin_amdgcn_mfma_f32_16x16x32_bf16(Bt[n][k], At[m][k], acc[ai][bj][m][n], 0, 0, 0); __builtin_amdgcn_s_setprio(0); } while (0)
#define PG8_WAIT_V(n) asm volatile("s_waitcnt vmcnt(" #n ")" ::: "memory")
#define PG8_WAIT_L(n) asm volatile("s_waitcnt lgkmcnt(" #n ")" ::: "memory")
#define PG8_BAR __builtin_amdgcn_s_barrier()
#define PG8_SCHED __builtin_amdgcn_sched_barrier(0)
    Unit cur, nxt; int ui = 0;
    if (!S.next(0, cur)) return;
    f32x4 acc[2][2][4][2];
#pragma unroll
    for (int a = 0; a < 2; ++a)
#pragma unroll
        for (int b = 0; b < 2; ++b)
#pragma unroll
            for (int m = 0; m < 4; ++m)
#pragma unroll
                for (int n = 0; n < 2; ++n) acc[a][b][m][n] = (f32x4){0.f, 0.f, 0.f, 0.f};
    bf16x8 At[4][2], B0[2][2], B1[2][2];
    const char* cA = (const char*)g.A + (size_t)cur.pm * tstepA + (size_t)cur.pn * acsb; const char* cB = (const char*)g.Bt + (size_t)cur.pn * tstepB;
    PG8_STAGE(PG8_SB(0, 0), cB, voffB); PG8_STAGE(PG8_SB(0, 1), cB + hstepB, voffB); PG8_STAGE(PG8_SA(0, 0), cA, voffA); PG8_STAGE(PG8_SA(0, 1), cA + hstepA, voffA);
    if (wr == 1) PG8_BAR;
    PG8_WAIT_V(2); PG8_BAR;
    PG8_STAGE(PG8_SB(1, 0), cB + kstep, voffB); PG8_STAGE(PG8_SA(1, 0), cA + kstep, voffA); PG8_STAGE(PG8_SB(1, 1), cB + hstepB + kstep, voffB);
    PG8_WAIT_V(6); PG8_BAR;
    for (;;) {
        const bool has_next = S.next(ui + 1, nxt);
        const char* nA = has_next ? (const char*)g.A + (size_t)nxt.pm * tstepA + (size_t)nxt.pn * acsb : cA; const char* nB = has_next ? (const char*)g.Bt + (size_t)nxt.pn * tstepB : cB;
#pragma unroll 1
        for (int t = 0; t < nt; t += 2) {
            const bool last = (t == nt - 2);
            const char* a1 = cA + (size_t)(t + 1) * kstep;
            const char* a2 = last ? nA : cA + (size_t)(t + 2) * kstep; const char* b2 = last ? nB : cB + (size_t)(t + 2) * kstep;
            const char* a3 = a2 + kstep; const char* b3 = b2 + kstep;
            PG8_LDB(B0, 0, 0); PG8_LDB(B1, 0, 1); PG8_SCHED; PG8_LDA(At, 0, 0); PG8_STAGE(PG8_SA(1, 1), a1 + hstepA, voffA);
            PG8_WAIT_V(8); PG8_WAIT_L(0); PG8_BAR; PG8_MMA(0, 0, At, B0); PG8_MMA(0, 1, At, B1); PG8_BAR; PG8_SCHED;
            PG8_LDA(At, 0, 1); PG8_STAGE(PG8_SB(0, 0), b2, voffB); PG8_STAGE(PG8_SB(0, 1), b2 + hstepB, voffB); PG8_STAGE(PG8_SA(0, 0), a2, voffA);
            PG8_WAIT_V(8); PG8_WAIT_L(0); PG8_BAR; PG8_MMA(1, 0, At, B0); PG8_MMA(1, 1, At, B1); PG8_BAR; PG8_SCHED;
            PG8_LDB(B0, 1, 0); PG8_LDB(B1, 1, 1); PG8_SCHED; PG8_LDA(At, 1, 0); PG8_STAGE(PG8_SA(0, 1), a2 + hstepA, voffA);
            PG8_WAIT_V(8); PG8_WAIT_L(0); PG8_BAR; PG8_MMA(0, 0, At, B0); PG8_MMA(0, 1, At, B1); PG8_BAR; PG8_SCHED;
            PG8_LDA(At, 1, 1); PG8_STAGE(PG8_SB(1, 0), b3, voffB); PG8_STAGE(PG8_SB(1, 1), b3 + hstepB, voffB); PG8_STAGE(PG8_SA(1, 0), a3, voffA);
            PG8_WAIT_V(8); PG8_WAIT_L(0); PG8_BAR; PG8_MMA(1, 0, At, B0); PG8_MMA(1, 1, At, B1); PG8_BAR; PG8_SCHED;
        }
        if (wr == 0) PG8_BAR;
        E(acc, cur, wr, wc, fr, fq);
        if (!has_next) break;
#pragma unroll
        for (int a = 0; a < 2; ++a)
#pragma unroll
            for (int b = 0; b < 2; ++b)
#pragma unroll
                for (int m = 0; m < 4; ++m)
#pragma unroll
                    for (int n = 0; n < 2; ++n) acc[a][b][m][n] = (f32x4){0.f, 0.f, 0.f, 0.f};
        cur = nxt; cA = nA; cB = nB; ++ui;
        if (wr == 1) PG8_BAR;
    }
    PG8_WAIT_V(0);
    PG8_BAR;
#undef PG8_SA
#undef PG8_SB
#undef PG8_STAGE
#undef PG8_LDA
#undef PG8_LDB
#undef PG8_MMA
#undef PG8_WAIT_V
#undef PG8_WAIT_L
#undef PG8_BAR
#undef PG8_SCHED
}
}

#define XB_TMO      128
#define XB_XCNT(j)  (256  + 64 * (j))
#define XB_XSUB(j)  (1280 + 64 * (j))
#define XB_XGEN(j)  (2304 + 64 * (j))
#define XB_TOP      3328
#define XB_TOPGEN   3392
#define XCD_BAR_WORDS 3456
#define XB_SPIN_CAP (1u << 18)
__device__ __forceinline__ unsigned xb_ld(unsigned* p)              { return __hip_atomic_load(p, __ATOMIC_RELAXED, __HIP_MEMORY_SCOPE_AGENT); }
__device__ __forceinline__ unsigned xb_add(unsigned* p, unsigned v) { return __hip_atomic_fetch_add(p, v, __ATOMIC_RELAXED, __HIP_MEMORY_SCOPE_AGENT); }
__device__ __forceinline__ unsigned xb_xcc_id() { return (unsigned)__builtin_amdgcn_s_getreg((3 << 11) | 20) & 0xFu; }
#define XB_SPIN(cond, bar) do { unsigned _sp = 0; while (cond) { __builtin_amdgcn_s_sleep(1); \
    if ((++_sp & 255u) == 0u) { if (xb_ld(&(bar)[XB_TMO])) break; if (_sp > XB_SPIN_CAP) { atomicAdd(&(bar)[XB_TMO], 1u); break; } } } } while (0)
struct XcdBarrier { unsigned* bar; unsigned x; volatile LAS unsigned* st; };
__device__ __forceinline__ XcdBarrier xcd_barrier_post(unsigned* bar, volatile LAS unsigned* st) {
    XcdBarrier b; b.bar = bar; b.x = xb_xcc_id(); b.st = st;
    if (threadIdx.x == 0) (void)xb_add(&bar[XB_XCNT(b.x)], 1u);
    return b;
}
__device__ __forceinline__ void xcd_barrier_complete(unsigned* bar, unsigned x, unsigned& nloc, unsigned& nx) {
    const unsigned G = gridDim.x * gridDim.y * gridDim.z;
    unsigned sum, cnt, mine, sp = 0u;
    for (;;) {
        sum = 0u; cnt = 0u; mine = 0u;
#pragma unroll
        for (unsigned j = 0; j < 16; ++j) { const unsigned c = xb_ld(&bar[XB_XCNT(j)]); sum += c; cnt += (c > 0u) ? 1u : 0u; mine = (j == x) ? c : mine; }
        if (sum == G) break;
        __builtin_amdgcn_s_sleep(1);
        if ((++sp & 255u) == 0u) { if (xb_ld(&bar[XB_TMO])) break; if (sp > XB_SPIN_CAP) { atomicAdd(&bar[XB_TMO], 1u); break; } }
    }
    nloc = mine > 0u ? mine : 1u; nx = cnt > 0u ? cnt : 1u;
}
__device__ __forceinline__ void xcd_barrier(const XcdBarrier& b, int wave) {
    asm volatile("s_waitcnt vmcnt(0)" ::: "memory");
    __syncthreads();
    if (wave == 0 && lane_id_v() == 0) {
        unsigned* bar = b.bar;
        __builtin_amdgcn_s_waitcnt(0);
        unsigned nloc = b.st[0], nx = b.st[1];
        if (nloc == 0u) { xcd_barrier_complete(bar, b.x, nloc, nx); b.st[0] = nloc; b.st[1] = nx; }
        const unsigned old = xb_add(&bar[XB_XSUB(b.x)], 1u);
        const unsigned gen = old / nloc;
        if (old + 1u == (gen + 1u) * nloc) {
            __builtin_amdgcn_fence(__ATOMIC_RELEASE, "agent");
            asm volatile("s_waitcnt vmcnt(0)" ::: "memory");
            const unsigned og = xb_add(&bar[XB_TOP], 1u);
            const unsigned tg = og / nx;
            if (og + 1u == (tg + 1u) * nx) xb_add(&bar[XB_TOPGEN], 1u);
            else XB_SPIN(xb_ld(&bar[XB_TOPGEN]) == tg, bar);
            __builtin_amdgcn_fence(__ATOMIC_ACQUIRE, "agent");
            xb_add(&bar[XB_XGEN(b.x)], 1u);
            asm volatile("s_waitcnt vmcnt(0)" ::: "memory");
        } else {
            XB_SPIN(xb_ld(&bar[XB_XGEN(b.x)]) == gen, bar);
            __builtin_amdgcn_fence(__ATOMIC_ACQUIRE, "agent");
            asm volatile("s_waitcnt vmcnt(0)" ::: "memory");
        }
    }
    __syncthreads();
}

struct Args { const float* in[28]; float* out; unsigned char* ws; int ph_lo, ph_hi; };
enum { I_X = 0, I_C, I_POS, I_WADA, I_BADA, I_N1G, I_WIN, I_QAG, I_WUQ, I_KVAG, I_WUKV, I_QNG, I_KNG, I_WOA, I_CONVW, I_CONVB, I_WRG, I_BRG, I_WIG, I_BIG, I_LAM, I_WOL, I_WOUT, I_N2G, I_WQ, I_SUBK, I_EU, I_EV };
constexpr int N_PHASES = 17;

struct Ctx {
    LAS unsigned char* lds;
    int tid, lane, wave, vcu, G;
    const float* const* in; float* out; unsigned char* ws;
};
#define WSP(type, off) ((type*)(c.ws + (off)))

template <class F>
__device__ __forceinline__ void tr_tile(const Ctx& c, bf16_t* dst, int K, int n0, int k0, F f) {
    LAS float* scr = (LAS float*)c.lds;
#pragma unroll
    for (int i = 0; i < 8; ++i) { const int kk = i * 8 + (c.tid >> 6), nn = c.tid & 63; scr[kk * 65 + nn] = f(k0 + kk, n0 + nn); }
    __syncthreads();
    { const int kc = c.tid & 7, nn = c.tid >> 3;
      LAS const float* s = scr + (8 * kc) * 65 + nn;
      u32x4 o; o.x = pk2(s[0], s[65]); o.y = pk2(s[2 * 65], s[3 * 65]); o.z = pk2(s[4 * 65], s[5 * 65]); o.w = pk2(s[6 * 65], s[7 * 65]);
      *(u32x4*)(dst + (size_t)(n0 + nn) * K + k0 + 8 * kc) = o; }
    __syncthreads();
}

template <class F>
__device__ __forceinline__ void tr_tile_wave(LAS float* scr, int L, bf16_t* dst, int K, int n0, int k0, F f) {
#pragma unroll 16
    for (int kk = 0; kk < 64; ++kk) scr[kk * 65 + L] = f(k0 + kk, n0 + L);
    asm volatile("s_waitcnt lgkmcnt(0)" ::: "memory");
    const int kc = L & 7;
#pragma unroll
    for (int j = 0; j < 8; ++j) { const int nn = (L >> 3) + 8 * j; LAS const float* s = scr + (8 * kc) * 65 + nn;
        u32x4 o; o.x = pk2(s[0], s[65]); o.y = pk2(s[2 * 65], s[3 * 65]); o.z = pk2(s[4 * 65], s[5 * 65]); o.w = pk2(s[6 * 65], s[7 * 65]);
        *(u32x4*)(dst + (size_t)(n0 + nn) * K + k0 + 8 * kc) = o; }
    asm volatile("s_waitcnt lgkmcnt(0)" ::: "memory");
}
__device__ __forceinline__ void phase_prep(const Ctx& c0) {
    Ctx c = c0; c.lane = lane_id_v(); c.tid = c.wave * 64 + c.lane;
    const float* w_in = c.in[I_WIN]; const float* w_uq = c.in[I_WUQ]; const float* qag = c.in[I_QAG]; const float* w_ukv = c.in[I_WUKV]; const float* kvag = c.in[I_KVAG];
    const float* w_oa = c.in[I_WOA]; const float* w_ol = c.in[I_WOL]; const float* w_out = c.in[I_WOUT]; const float* w_q = c.in[I_WQ];
    const float* w_rg = c.in[I_WRG]; const float* w_ig = c.in[I_WIG];
    constexpr int T_WIN = 72 * 16, T_WUQ = 12 * 4, T_WUKV = 16 * 2, T_WOA = 16 * 8, T_WOL = 16 * 16, T_WOUT = 16 * 16, T_WQ = 32 * 16, T_WG = 8 * 4 * 2;
    constexpr int T_WAVE = T_WIN + T_WUQ + T_WUKV + T_WOA + T_WOL + T_WOUT + T_WG;
    { LAS float* scr = (LAS float*)(c.lds + (c.wave < 7 ? c.wave * 16640 : 131584)); const int L = c.lane;
      static_assert(7 * 16640 <= 131072 && 131584 + 16640 <= LDS_BYTES && 131584 >= MISC_OFF + 128, "prep LDS tiles");
      for (int it = c.vcu * 8 + c.wave; it < T_WAVE; it += c.G * 8) {
        int r = it;
        if (r < T_WIN) { const int nb = r / 16, kb = r % 16;
            tr_tile_wave(scr, L, WSP(bf16_t, WS_WIN), 1024, nb * 64, kb * 64, [=](int k, int n) -> float { return n < 416 ? w_in[(size_t)k * 4512 + n] : (n < 512 ? 0.f : w_in[(size_t)k * 4512 + n - 96]); }); continue; }
        r -= T_WIN;
        if (r < T_WUQ) { const int nb = r / 4, kb = r % 4;
            tr_tile_wave(scr, L, WSP(bf16_t, WS_WUQ), 256, nb * 64, kb * 64, [=](int k, int n) -> float { return w_uq[(size_t)k * 768 + n] * qag[k]; }); continue; }
        r -= T_WUQ;
        if (r < T_WUKV) { const int nb = r / 2, kb = r % 2;
            tr_tile_wave(scr, L, WSP(bf16_t, WS_WUKV), 128, nb * 64, kb * 64, [=](int k, int n) -> float { return w_ukv[(size_t)k * 1024 + n] * kvag[k]; }); continue; }
        r -= T_WUKV;
        if (r < T_WOA) { const int nb = r / 8, kb = r % 8;
            tr_tile_wave(scr, L, WSP(bf16_t, WS_WOA), 512, nb * 64, kb * 64, [=](int k, int n) -> float { return w_oa[(size_t)k * 1024 + n]; }); continue; }
        r -= T_WOA;
        if (r < T_WOL) { const int nb = r / 16, kb = r % 16;
            tr_tile_wave(scr, L, WSP(bf16_t, WS_WOL), 1024, nb * 64, kb * 64, [=](int k, int n) -> float { return w_ol[(size_t)k * 1024 + n]; }); continue; }
        r -= T_WOL;
        if (r < T_WOUT) { const int nb = r / 16, kb = r % 16;
            tr_tile_wave(scr, L, WSP(bf16_t, WS_WOUT), 1024, nb * 64, kb * 64, [=](int k, int n) -> float { return w_out[(size_t)k * 1024 + n]; }); continue; }
        r -= T_WOUT;
        { const int blk = r / 8, q = r % 8, nb = q / 2, kb = q % 2;
            tr_tile_wave(scr, L, WSP(bf16_t, WS_WG) + (size_t)blk * 256 * 128, 128, nb * 64, kb * 64,
                    [=](int k, int n) -> float { return n < 128 ? w_rg[((size_t)blk * 128 + k) * 128 + n] : w_ig[((size_t)blk * 128 + k) * 128 + n - 128]; }); }
      } }
    __syncthreads();
    for (int r = c.vcu; r < T_WQ; r += c.G) {
        const int nb = r / 16, kb = r % 16;
        const int slot = nb >> 1, n0 = (nb & 1) * 64, k0 = kb * 64;
        LAS float* wq_s = (LAS float*)(c.lds + 32768);
        LAS float* sk_s = (LAS float*)(c.lds + 32768 + 64 * 129 * 4);
        const float* skp = c.in[I_SUBK] + ((size_t)slot * 128 + n0) * 128;
        for (int e = c.tid; e < 64 * 128; e += 512) { const int rr = e >> 7, cc = e & 127; wq_s[rr * 129 + cc] = w_q[(size_t)(k0 + rr) * 2048 + slot * 128 + cc]; sk_s[rr * 129 + cc] = skp[(size_t)rr * 128 + cc]; }
        __syncthreads();
        tr_tile(c, WSP(bf16_t, WS_WQ), 1024, nb * 64, k0, [=](int k, int n) -> float { const LAS float* a = wq_s + (k - k0) * 129; const LAS float* b = sk_s + (n - nb * 64) * 129; float s = 0.f;
#pragma unroll 16
            for (int d = 0; d < 128; ++d) s += a[d] * b[d];
            return s; });
    }
    { const float* lam = c.in[I_LAM]; float* t8 = WSP(float, WS_C8SP);
      if (c.vcu == 0) for (int e = c.tid; e < 1024; e += 512) t8[e] = -8.f * log1pf(__expf(-lam[e])); }
    if (c.vcu == 0 && c.tid == 0) {
        const unsigned probe = __builtin_amdgcn_cvt_scalef32_pk_fp4_f32(0u, 1.0f, 0.0f, 1.0f, 0) & 0xffu;
        WSP(unsigned, WS_C8SP)[1024] = (probe == 0x02u) ? 0u : 1u; }
    { const int gw = c.vcu * 8 + c.wave, NGW = c.G * 8, L = c.lane;
      f32x4 vn[4];
      if (gw < 2 * NE) { const f32x4* s4 = (const f32x4*)((gw >= NE ? c.in[I_EV] : c.in[I_EU]) + (size_t)(gw >= NE ? gw - NE : gw) * 1024 + 16 * L);
#pragma unroll
          for (int j = 0; j < 4; ++j) vn[j] = s4[j]; }
#pragma unroll 1
      for (int r = gw; r < 2 * NE; r += NGW) {
          const int isv = r >= NE, e = isv ? r - NE : r;
          f32x4 v[4]; float am = 0.f;
#pragma unroll
          for (int j = 0; j < 4; ++j) { v[j] = vn[j]; am = fmaxf(am, fmaxf(fmaxf(fabsf(v[j].x), fabsf(v[j].y)), fmaxf(fabsf(v[j].z), fabsf(v[j].w)))); }
          { const int rn = (r + NGW < 2 * NE) ? r + NGW : r; const f32x4* s4 = (const f32x4*)((rn >= NE ? c.in[I_EV] : c.in[I_EU]) + (size_t)(rn >= NE ? rn - NE : rn) * 1024 + 16 * L);
#pragma unroll
            for (int j = 0; j < 4; ++j) vn[j] = s4[j]; }
#pragma unroll
          for (int o = 1; o < 64; o <<= 1) am = fmaxf(am, __shfl_xor(am, o));
          const float s = am > 0.f ? am * (1.f / 6.f) : 1.f, inv = 1.f / s;
          unsigned w0 = 0u, w1 = 0u;
          w0 = __builtin_amdgcn_cvt_scalef32_pk_fp4_f32(w0, v[0].x * inv, v[0].y * inv, 1.0f, 0); w0 = __builtin_amdgcn_cvt_scalef32_pk_fp4_f32(w0, v[0].z * inv, v[0].w * inv, 1.0f, 1);
          w0 = __builtin_amdgcn_cvt_scalef32_pk_fp4_f32(w0, v[1].x * inv, v[1].y * inv, 1.0f, 2); w0 = __builtin_amdgcn_cvt_scalef32_pk_fp4_f32(w0, v[1].z * inv, v[1].w * inv, 1.0f, 3);
          w1 = __builtin_amdgcn_cvt_scalef32_pk_fp4_f32(w1, v[2].x * inv, v[2].y * inv, 1.0f, 0); w1 = __builtin_amdgcn_cvt_scalef32_pk_fp4_f32(w1, v[2].z * inv, v[2].w * inv, 1.0f, 1);
          w1 = __builtin_amdgcn_cvt_scalef32_pk_fp4_f32(w1, v[3].x * inv, v[3].y * inv, 1.0f, 2); w1 = __builtin_amdgcn_cvt_scalef32_pk_fp4_f32(w1, v[3].z * inv, v[3].w * inv, 1.0f, 3);
          u32x2 q; q.x = w0; q.y = w1;
          *(u32x2*)(c.ws + (isv ? WS_EV : WS_EU) + ((size_t)(L >> 4) * NE + e) * 128 + (L & 15) * 8) = q;
          if (L == 0) WSP(float, isv ? WS_SV : WS_SU)[e] = s;
      } }
    { const float* cin = c.in[I_C]; const float* w_ada = c.in[I_WADA]; const float* b_ada = c.in[I_BADA]; float* mod = WSP(float, WS_MOD);
      LAS float* cs = (LAS float*)c.lds;
      LAS float* red = (LAS float*)(c.lds + 65536);
      bool have = false;
      for (int it = c.vcu; it < 192; it += c.G) {
          if (!have) { for (int e = c.tid; e < 16 * 1024; e += 512) { const float v = cin[e]; cs[e] = v / (1.f + __expf(-v)); } have = true; }
          __syncthreads();
          const int cl = c.tid & 31, ks = c.tid >> 5, j = it * 32 + cl;
          float acc[16];
#pragma unroll
          for (int b = 0; b < 16; ++b) acc[b] = 0.f;
          for (int kk = 0; kk < 64; ++kk) { const int k = ks * 64 + kk; const float w = w_ada[(size_t)k * 6144 + j];
#pragma unroll
              for (int b = 0; b < 16; ++b) acc[b] += cs[b * 1024 + k] * w; }
#pragma unroll
          for (int b = 0; b < 16; ++b) red[(ks * 16 + b) * 32 + cl] = acc[b];
          __syncthreads();
          { const int b = c.tid >> 5; float s = b_ada[j];
#pragma unroll
            for (int k2 = 0; k2 < 16; ++k2) s += red[(k2 * 16 + b) * 32 + cl];
            mod[b * 6144 + j] = s; }
          __syncthreads();
      } }
}

template <bool Q8>
__device__ __forceinline__ void phase_modnorm(const Ctx& c0, const float* x, const float* g, int shift_off, int scale_off, bf16_t* dst) {
    Ctx c = c0; c.lane = lane_id_v(); c.tid = c.wave * 64 + c.lane;
    const float* mod = WSP(float, WS_MOD);
    const int gw = c.vcu * 8 + c.wave, NGW = c.G * 8;
    if (gw >= T) return;
    f32x4 vn[4];
    { const f32x4* xr = (const f32x4*)(x + (size_t)gw * D) + c.lane;
#pragma unroll
      for (int j = 0; j < 4; ++j) vn[j] = xr[64 * j]; }
#pragma unroll 1
    for (int m = gw; m < T; m += NGW) {
        const int b = m >> 11;
        f32x4 v[4]; float s = 0.f;
#pragma unroll
        for (int j = 0; j < 4; ++j) { v[j] = vn[j]; s += (v[j].x * v[j].x + v[j].y * v[j].y) + (v[j].z * v[j].z + v[j].w * v[j].w); }
        { const int mn = (m + NGW < T) ? m + NGW : m; const f32x4* xr = (const f32x4*)(x + (size_t)mn * D) + c.lane;
#pragma unroll
          for (int j = 0; j < 4; ++j) vn[j] = xr[64 * j]; }
        const float rstd = rsqrtf(wave_sum(s) * (1.f / D) + EPS);
        u32x2* o8 = (u32x2*)(dst + (size_t)m * D) + c.lane;
        float am = 0.f;
#pragma unroll
        for (int j = 0; j < 4; ++j) {
            const int col = 4 * c.lane + 256 * j;
            const f32x4 gg = *(const f32x4*)(g + col), sc = *(const f32x4*)(mod + b * 6144 + scale_off + col), sh = *(const f32x4*)(mod + b * 6144 + shift_off + col);
            const float r0 = v[j].x * rstd * gg.x * (1.f + sc.x) + sh.x, r1 = v[j].y * rstd * gg.y * (1.f + sc.y) + sh.y;
            const float r2 = v[j].z * rstd * gg.z * (1.f + sc.z) + sh.z, r3 = v[j].w * rstd * gg.w * (1.f + sc.w) + sh.w;
            u32x2 w; w.x = pk2(r0, r1); w.y = pk2(r2, r3); o8[64 * j] = w;
            if (Q8) { v[j].x = r0; v[j].y = r1; v[j].z = r2; v[j].w = r3; am = fmaxf(am, fmaxf(fmaxf(fabsf(r0), fabsf(r1)), fmaxf(fabsf(r2), fabsf(r3)))); }
        }
        if (Q8) {
#pragma unroll
            for (int o = 1; o < 64; o <<= 1) am = fmaxf(am, __shfl_xor(am, o));
            const float sq = am > 0.f ? am * (1.f / 256.f) : 1.f, inv = 1.f / sq;
            unsigned* q8 = (unsigned*)(c.ws + WS_H2Q + (size_t)m * D) + c.lane;
#pragma unroll
            for (int j = 0; j < 4; ++j) { int w = __builtin_amdgcn_cvt_pk_fp8_f32(v[j].x * inv, v[j].y * inv, 0, false); w = __builtin_amdgcn_cvt_pk_fp8_f32(v[j].z * inv, v[j].w * inv, w, true); q8[64 * j] = (unsigned)w; }
            if (c.lane == 0) WSP(float, WS_SH)[m] = sq;
        }
    }
}

__device__ __forceinline__ void phase_conv(const Ctx& c0) {
    Ctx c = c0; c.lane = lane_id_v(); c.tid = c.wave * 64 + c.lane;
    const bf16_t* pa = WSP(bf16_t, WS_R1); const bf16_t* lx = WSP(bf16_t, WS_R2); bf16_t* xc = WSP(bf16_t, WS_R4); float* rstd = WSP(float, WS_RSTD);
    const float* cw = c.in[I_CONVW]; const float* cb = c.in[I_CONVB];
    const int gt = c.vcu * 512 + c.tid, NT = c.G * 512;
    { const int gw = c.vcu * 8 + c.wave, NGW = c.G * 8, L = c.lane;
      for (int t = gw; t < T; t += NGW) {
          float ss = 0.f;
          if (L < 48) { float v[8]; unpack8(*(const u32x4*)(pa + (size_t)t * 512 + 8 * L), v);
#pragma unroll
              for (int j = 0; j < 8; ++j) ss += v[j] * v[j]; }
          const float sq = wave_sum(L < 32 ? ss : 0.f), skv = wave_sum(L >= 32 ? ss : 0.f);
          if (L == 0) { rstd[2 * t] = rsqrtf(sq * (1.f / 256.f) + EPS); rstd[2 * t + 1] = rsqrtf(skv * (1.f / 128.f) + EPS); }
      } }
    { const int* pos = (const int*)c.in[I_POS]; float* CS = WSP(float, WS_CS);
      for (int e = gt; e < T * 16; e += NT) {
          const int t = e >> 4, jj = e & 15;
          const float invf = exp2f(-(float)jj * (13.287712379549449f / 16.f));
          const float ang = (float)pos[t] * invf; const float n = rintf(ang * 0.15915494309189535f);
          const float red = (float)((double)ang - (double)n * 6.283185307179586);
          CS[(size_t)t * 32 + jj] = __cosf(red); CS[(size_t)t * 32 + 16 + jj] = __sinf(red);
      } }
    {
        const int ch = (gt & 127) * 8;
        f32x4 wv[4][2]; f32x4 bv[2];
#pragma unroll
        for (int j = 0; j < 4; ++j) { wv[j][0] = *(const f32x4*)(cw + j * 1024 + ch); wv[j][1] = *(const f32x4*)(cw + j * 1024 + ch + 4); }
        bv[0] = *(const f32x4*)(cb + ch); bv[1] = *(const f32x4*)(cb + ch + 4);
        const int tstep = NT >> 7;
        for (int tq = gt >> 7; tq < T; tq += 4 * tstep) {
            u32x4 raw[4][4];
#pragma unroll
            for (int u = 0; u < 4; ++u) { const int t = tq + u * tstep; const int s = t & 2047;
#pragma unroll
                for (int j = 0; j < 4; ++j) { raw[u][j] = (u32x4){0u, 0u, 0u, 0u}; if (t < T && s - 3 + j >= 0) raw[u][j] = *(const u32x4*)(lx + (size_t)(t - 3 + j) * 1024 + ch); } }
#pragma unroll
            for (int u = 0; u < 4; ++u) { const int t = tq + u * tstep;
                float acc[8] = {bv[0].x, bv[0].y, bv[0].z, bv[0].w, bv[1].x, bv[1].y, bv[1].z, bv[1].w};
#pragma unroll
                for (int j = 0; j < 4; ++j) { float v[8]; unpack8(raw[u][j], v);
                    acc[0] += wv[j][0].x * v[0]; acc[1] += wv[j][0].y * v[1]; acc[2] += wv[j][0].z * v[2]; acc[3] += wv[j][0].w * v[3];
                    acc[4] += wv[j][1].x * v[4]; acc[5] += wv[j][1].y * v[5]; acc[6] += wv[j][1].z * v[6]; acc[7] += wv[j][1].w * v[7]; }
                if (t < T) *(u32x4*)(xc + (size_t)t * 1024 + ch) = pack8(acc); }
        }
    }
}

__device__ __forceinline__ void phase_scan(const Ctx& c0) {
    Ctx c = c0; c.lane = lane_id_v(); c.tid = c.wave * 64 + c.lane;
    const bf16_t* LA = WSP(bf16_t, WS_R0); bf16_t* Bv = WSP(bf16_t, WS_R6); const bf16_t* gate = WSP(bf16_t, WS_R3);
    LAS float* Ps = (LAS float*)c.lds; LAS float* Hs = Ps + 512;
    for (int it = c.vcu; it < 256; it += c.G) {
        const int b = it >> 4, cg = it & 15, seg = c.tid >> 6, ch = cg * 64 + (c.tid & 63);
        const size_t base = ((size_t)b * 2048 + seg * 256) * 1024 + ch;
        float P = 1.f, Hl = 0.f;
#pragma unroll 1
        for (int i0 = 0; i0 < 256; i0 += 16) {
            unsigned la[16], bv[16];
#pragma unroll
            for (int i = 0; i < 16; ++i) { la[i] = LA[base + (size_t)(i0 + i) * 1024]; bv[i] = Bv[base + (size_t)(i0 + i) * 1024]; }
#pragma unroll
            for (int i = 0; i < 16; ++i) { const float a = __builtin_amdgcn_exp2f(bf2f(la[i])); Hl = a * Hl + bf2f(bv[i]); P *= a; }
        }
        Ps[c.tid] = P; Hs[c.tid] = Hl;
        __syncthreads();
        float h = 0.f;
        for (int s2 = 0; s2 < seg; ++s2) h = Ps[s2 * 64 + (c.tid & 63)] * h + Hs[s2 * 64 + (c.tid & 63)];
#pragma unroll 1
        for (int i0 = 0; i0 < 256; i0 += 16) {
            unsigned la[16], bv[16], gv[16]; unsigned ov[16];
#pragma unroll
            for (int i = 0; i < 16; ++i) { la[i] = LA[base + (size_t)(i0 + i) * 1024]; bv[i] = Bv[base + (size_t)(i0 + i) * 1024]; gv[i] = gate[base + (size_t)(i0 + i) * 1024]; }
#pragma unroll
            for (int i = 0; i < 16; ++i) { const float a = __builtin_amdgcn_exp2f(bf2f(la[i])); h = a * h + bf2f(bv[i]); ov[i] = f2bf(h * gelu_tanh(bf2f(gv[i]))); }
#pragma unroll
            for (int i = 0; i < 16; ++i) Bv[base + (size_t)(i0 + i) * 1024] = (bf16_t)ov[i];
        }
        __syncthreads();
    }
}

struct QkvRaw { u32x4 k[2]; f32x4 cs[4]; };
__device__ __forceinline__ void qkv_load(QkvRaw& r, const bf16_t* kvraw, const bf16_t* pa, const float* CS, int t, int ch, int hq) {
    const bool act = ch < 12;
#pragma unroll
    for (int pass = 0; pass < 2; ++pass) { const int h = pass * 4 + hq;
        r.k[pass] = (u32x4){0u, 0u, 0u, 0u};
        if (ch < 8) r.k[pass] = *(const u32x4*)(kvraw + (size_t)t * 1024 + h * 128 + 8 * ch);
        else if (act) r.k[pass] = *(const u32x4*)(pa + (size_t)t * 512 + 384 + 8 * (ch - 8)); }
    const float* cp = CS + (size_t)t * 32 + 8 * (ch & 1);
    r.cs[0] = *(const f32x4*)cp; r.cs[1] = *(const f32x4*)(cp + 4); r.cs[2] = *(const f32x4*)(cp + 16); r.cs[3] = *(const f32x4*)(cp + 20);
}
__device__ __forceinline__ void phase_qkv_layout(const Ctx& c0) {
    Ctx c = c0; c.lane = lane_id_v(); c.tid = c.wave * 64 + c.lane;
    const bf16_t* kvraw = WSP(bf16_t, WS_R2); const bf16_t* pa = WSP(bf16_t, WS_R1);
    bf16_t* Kh = WSP(bf16_t, WS_R3);
    const float* kng = c.in[I_KNG]; const float* CS = WSP(float, WS_CS);
    const int gw = c.vcu * 8 + c.wave, NGW = c.G * 8, L = c.lane;
    const int ch = L & 15, hq = L >> 4;
    const bool act = ch < 12, isr = ch >= 8, hi2 = ch >= 10;
    float gk[8];
#pragma unroll
    for (int j = 0; j < 8; ++j) gk[j] = act ? kng[8 * ch + j] : 0.f;
    if (gw >= T) return;
    QkvRaw cur, nxt;
    qkv_load(cur, kvraw, pa, CS, gw, ch, hq);
#pragma unroll 1
    for (int t = gw; t < T; t += NGW) {
        qkv_load(nxt, kvraw, pa, CS, (t + NGW < T) ? t + NGW : t, ch, hq);
        const int b = t >> 11, s = t & 2047;
        const float cs[8] = {cur.cs[0].x, cur.cs[0].y, cur.cs[0].z, cur.cs[0].w, cur.cs[1].x, cur.cs[1].y, cur.cs[1].z, cur.cs[1].w};
        const float sn[8] = {cur.cs[2].x, cur.cs[2].y, cur.cs[2].z, cur.cs[2].w, cur.cs[3].x, cur.cs[3].y, cur.cs[3].z, cur.cs[3].w};
#pragma unroll
        for (int pass = 0; pass < 2; ++pass) {
            const int h = pass * 4 + hq;
            const size_t orow = ((size_t)(b * H + h) * S + s);
            float v[8]; unpack8(cur.k[pass], v);
            float ss = 0.f;
#pragma unroll
            for (int j = 0; j < 8; ++j) ss += v[j] * v[j];
#pragma unroll
            for (int o = 1; o < 16; o <<= 1) ss += __shfl_xor(ss, o);
            const float r = rsqrtf(ss * (1.f / 96.f) + EPS);
            float x[8], o8[8];
#pragma unroll
            for (int j = 0; j < 8; ++j) x[j] = v[j] * r * gk[j];
#pragma unroll
            for (int j = 0; j < 8; ++j) { const float px = __shfl_xor(x[j], 2);
                o8[j] = !isr ? x[j] : (hi2 ? px * sn[j] + x[j] * cs[j] : x[j] * cs[j] - px * sn[j]); }
            if (act) *(u32x4*)(Kh + orow * 96 + 8 * ch) = pack8(o8);
        }
        cur = nxt;
    }
}

constexpr int KROW = 208, VROW = 160;
constexpr int KBUF = 128 * KROW, VBUF = 128 * VROW;
typedef short v4i16_t __attribute__((ext_vector_type(4)));
__device__ __forceinline__ void attn_chunk2(LAS unsigned char* kb, LAS unsigned char* vb, const bf16x8 (&qf)[2][3], f32x4 (&o)[2][4], float (&mrun)[2], float (&lrun)[2], int fr, int g) {
    f32x4 sacc[2][4];
#pragma unroll
    for (int kt = 0; kt < 4; ++kt) { sacc[0][kt] = (f32x4){0.f, 0.f, 0.f, 0.f}; sacc[1][kt] = (f32x4){0.f, 0.f, 0.f, 0.f};
#pragma unroll
        for (int ks = 0; ks < 3; ++ks) { const bf16x8 kf = *(const LAS bf16x8*)(kb + (16 * kt + fr) * KROW + (ks * 32 + g * 8) * 2);
            sacc[0][kt] = __builtin_amdgcn_mfma_f32_16x16x32_bf16(kf, qf[0][ks], sacc[0][kt], 0, 0, 0);
            sacc[1][kt] = __builtin_amdgcn_mfma_f32_16x16x32_bf16(kf, qf[1][ks], sacc[1][kt], 0, 0, 0); } }
    bf16x8 pb[2][2];
#pragma unroll
    for (int t = 0; t < 2; ++t) {
        float mx = sacc[t][0][0];
#pragma unroll
        for (int kt = 0; kt < 4; ++kt)
#pragma unroll
            for (int r = 0; r < 4; ++r) mx = fmaxf(mx, sacc[t][kt][r]);
        mx = fmaxf(mx, __shfl_xor(mx, 16)); mx = fmaxf(mx, __shfl_xor(mx, 32));
        const float mnew = fmaxf(mrun[t], mx), alpha = __builtin_amdgcn_exp2f(mrun[t] - mnew); mrun[t] = mnew;
        float ps = 0.f;
#pragma unroll
        for (int kt = 0; kt < 4; ++kt)
#pragma unroll
            for (int r = 0; r < 4; ++r) { const float p = __builtin_amdgcn_exp2f(sacc[t][kt][r] - mnew); sacc[t][kt][r] = p; ps += p; }
        lrun[t] = lrun[t] * alpha + ps;
#pragma unroll
        for (int dt = 0; dt < 4; ++dt) o[t][dt] = o[t][dt] * alpha;
#pragma unroll
        for (int s2 = 0; s2 < 2; ++s2) { u32x4 pw; pw.x = pk2(sacc[t][2 * s2][0], sacc[t][2 * s2][1]); pw.y = pk2(sacc[t][2 * s2][2], sacc[t][2 * s2][3]); pw.z = pk2(sacc[t][2 * s2 + 1][0], sacc[t][2 * s2 + 1][1]); pw.w = pk2(sacc[t][2 * s2 + 1][2], sacc[t][2 * s2 + 1][3]);
            pb[t][s2] = __builtin_bit_cast(bf16x8, pw); }
    }
#pragma unroll
    for (int s2 = 0; s2 < 2; ++s2)
#pragma unroll
        for (int dt = 0; dt < 4; ++dt) {
            LAS unsigned char* va = vb + (32 * s2 + 4 * g + (fr >> 2)) * VROW + (16 * dt + 4 * (fr & 3)) * 2;
            const v4i16_t t0 = __builtin_amdgcn_ds_read_tr16_b64_v4i16((LAS v4i16_t*)va), t1 = __builtin_amdgcn_ds_read_tr16_b64_v4i16((LAS v4i16_t*)(va + 16 * VROW));
            const bf16x8 vf = (bf16x8){t0[0], t0[1], t0[2], t0[3], t1[0], t1[1], t1[2], t1[3]};
            o[0][dt] = __builtin_amdgcn_mfma_f32_16x16x32_bf16(vf, pb[0][s2], o[0][dt], 0, 0, 0);
            o[1][dt] = __builtin_amdgcn_mfma_f32_16x16x32_bf16(vf, pb[1][s2], o[1][dt], 0, 0, 0); }
}
__device__ __forceinline__ void attn_unit(const Ctx& c, int b, int h, int qb) {
    const bf16_t* qraw = WSP(bf16_t, WS_R5); const bf16_t* Kh = WSP(bf16_t, WS_R3); const bf16_t* kvraw = WSP(bf16_t, WS_R2); bf16_t* AO = WSP(bf16_t, WS_R0 + 32 * MiB);
    const float* qng = c.in[I_QNG]; const float* CS = WSP(float, WS_CS);
    const int fr = c.lane & 15, g = c.lane >> 4, wid = c.wave;
    const size_t hb = (size_t)(b * H + h) * S;
    const int q0 = qb * 256 + wid * 32;
    const int nsup = 2 * qb + 2;
    const int nch = 4 * qb + (wid >> 1) + 1;
    bf16x8 qf[2][3];
    { const float qscale = 0.10206207261596577f * 1.4426950408889634f;
#pragma unroll
      for (int t = 0; t < 2; ++t) {
          const size_t tok = (size_t)b * S + q0 + 16 * t + fr;
          float v[3][8]; float ss = 0.f;
#pragma unroll
          for (int ks = 0; ks < 3; ++ks) { unpack8(*(const u32x4*)(qraw + tok * 768 + h * 96 + ks * 32 + g * 8), v[ks]);
#pragma unroll
              for (int j = 0; j < 8; ++j) ss += v[ks][j] * v[ks][j]; }
          ss += __shfl_xor(ss, 16); ss += __shfl_xor(ss, 32);
          const float r = rsqrtf(ss * (1.f / 96.f) + EPS) * qscale;
#pragma unroll
          for (int ks = 0; ks < 3; ++ks)
#pragma unroll
              for (int j = 0; j < 8; ++j) v[ks][j] *= r * qng[ks * 32 + g * 8 + j];
          { const float* cp = CS + tok * 32 + 8 * (g & 1);
            const f32x4 c0v = *(const f32x4*)cp, c1v = *(const f32x4*)(cp + 4), s0v = *(const f32x4*)(cp + 16), s1v = *(const f32x4*)(cp + 20);
            const float cs[8] = {c0v.x, c0v.y, c0v.z, c0v.w, c1v.x, c1v.y, c1v.z, c1v.w}, sn[8] = {s0v.x, s0v.y, s0v.z, s0v.w, s1v.x, s1v.y, s1v.z, s1v.w};
#pragma unroll
            for (int j = 0; j < 8; ++j) { const float px = __shfl_xor(v[2][j], 32); v[2][j] = (g >= 2) ? px * sn[j] + v[2][j] * cs[j] : v[2][j] * cs[j] - px * sn[j]; } }
#pragma unroll
          for (int ks = 0; ks < 3; ++ks) qf[t][ks] = __builtin_bit_cast(bf16x8, pack8(v[ks]));
      } }
    f32x4 o[2][4];
#pragma unroll
    for (int t = 0; t < 2; ++t)
#pragma unroll
        for (int dt = 0; dt < 4; ++dt) o[t][dt] = (f32x4){0.f, 0.f, 0.f, 0.f};
    float mrun[2] = {-1e30f, -1e30f}, lrun[2] = {0.f, 0.f};
    u32x4 kr[3], vr[2];
    const u32x4* Ksrc = (const u32x4*)(Kh + hb * 96);
    const bf16_t* Vsrc = kvraw + ((size_t)b * S) * 1024 + h * 128 + 64;
#pragma unroll
    for (int i = 0; i < 3; ++i) kr[i] = Ksrc[c.tid + 512 * i];
#pragma unroll
    for (int i = 0; i < 2; ++i) { const int vc = c.tid + 512 * i; vr[i] = *(const u32x4*)(Vsrc + (size_t)(vc >> 3) * 1024 + (vc & 7) * 8); }
    for (int j = 0; j < nsup; ++j) {
        LAS unsigned char* kb = c.lds + (j & 1) * (KBUF + VBUF); LAS unsigned char* vb = kb + KBUF;
#pragma unroll
        for (int i = 0; i < 3; ++i) { const int kc = c.tid + 512 * i; *(LAS u32x4*)(kb + (kc / 12) * KROW + (kc % 12) * 16) = kr[i]; }
#pragma unroll
        for (int i = 0; i < 2; ++i) { const int vc = c.tid + 512 * i; *(LAS u32x4*)(vb + (vc >> 3) * VROW + (vc & 7) * 16) = vr[i]; }
        __syncthreads();
        if (j + 1 < nsup) {
#pragma unroll
            for (int i = 0; i < 3; ++i) kr[i] = Ksrc[(j + 1) * 1536 + c.tid + 512 * i];
#pragma unroll
            for (int i = 0; i < 2; ++i) { const int vc = c.tid + 512 * i; vr[i] = *(const u32x4*)(Vsrc + (size_t)((j + 1) * 128 + (vc >> 3)) * 1024 + (vc & 7) * 8); }
        }
        if (2 * j < nch) attn_chunk2(kb, vb, qf, o, mrun, lrun, fr, g);
        if (2 * j + 1 < nch) attn_chunk2(kb + 64 * KROW, vb + 64 * VROW, qf, o, mrun, lrun, fr, g);
    }
#pragma unroll
    for (int t = 0; t < 2; ++t) {
        float lt = lrun[t] + __shfl_xor(lrun[t], 16); lt += __shfl_xor(lt, 32);
        const float inv = 1.f / lt;
        bf16_t* orow = AO + ((size_t)b * S + q0 + 16 * t + fr) * 512 + h * 64;
#pragma unroll
        for (int dt = 0; dt < 4; ++dt) { u32x2 w; w.x = pk2(o[t][dt][0] * inv, o[t][dt][1] * inv); w.y = pk2(o[t][dt][2] * inv, o[t][dt][3] * inv); *(u32x2*)(orow + 16 * dt + 4 * g) = w; }
    }
    __syncthreads();
}
__device__ __forceinline__ void phase_attn(const Ctx& c0) {
    Ctx c = c0; c.lane = lane_id_v(); c.tid = c.wave * 64 + c.lane;
    for (int v = c.vcu; v < 256; v += c.G) {
        const int bh = v >> 1, odd = v & 1;
        for (int i = 0; i < 4; ++i) {
            const int setA[4] = {7, 4, 3, 0}, setB[4] = {6, 5, 2, 1};
            int qb = 0;
#pragma unroll
            for (int k = 0; k < 4; ++k) if (k == i) qb = odd ? setB[k] : setA[k];
            attn_unit(c, bh >> 3, bh & 7, qb);
        }
    }
}

__device__ __forceinline__ float wave_max(float v) {
#pragma unroll
    for (int o = 1; o < 64; o <<= 1) v = fmaxf(v, __shfl_xor(v, o));
    return v;
}
__device__ __forceinline__ int wave_min_i(int v) {
#pragma unroll
    for (int o = 1; o < 64; o <<= 1) v = min(v, __shfl_xor(v, o));
    return v;
}
__device__ __forceinline__ int prefix_cnt(unsigned long long m) { return (int)__builtin_amdgcn_mbcnt_hi((unsigned)(m >> 32), __builtin_amdgcn_mbcnt_lo((unsigned)m, 0u)); }
template <int NV, int NBITS> __device__ __forceinline__ void select16(const unsigned (&key)[NV], int (&slot)[NV]) {
    unsigned tau = 0u;
    for (int bit = NBITS - 1; bit >= 0; --bit) {
        const unsigned trial = tau | (1u << bit); int cnt = 0;
#pragma unroll
        for (int j = 0; j < NV; ++j) cnt += __popcll(__ballot(key[j] >= trial));
        if (cnt >= 16) { tau = trial; if (cnt == 16) break; }
    }
    int base = 0;
#pragma unroll
    for (int j = 0; j < NV; ++j) { const unsigned long long m = __ballot(key[j] > tau); slot[j] = (key[j] > tau) ? base + prefix_cnt(m) : -1; base += __popcll(m); }
#pragma unroll
    for (int j = 0; j < NV; ++j) { const unsigned long long m = __ballot(key[j] == tau); if (key[j] == tau) { const int s = base + prefix_cnt(m); slot[j] = s < 16 ? s : -1; } base += __popcll(m); }
}
template <int N> __device__ __forceinline__ void bitonic_stage_desc(unsigned (&x)[N], int k, int j) {
#pragma unroll
    for (int i = 0; i < N; ++i) { const int l = i ^ j; if (l > i) { const bool asc = ((i & k) != 0);
        const unsigned a = x[i], b = x[l]; const unsigned hi = a > b ? a : b, lo = a > b ? b : a; x[i] = asc ? lo : hi; x[l] = asc ? hi : lo; } }
}
__device__ __forceinline__ void sort16_desc(unsigned (&x)[16]) {
#pragma unroll
    for (int k = 2; k <= 16; k <<= 1)
#pragma unroll
        for (int j = k >> 1; j > 0; j >>= 1) bitonic_stage_desc<16>(x, k, j);
}
__device__ __forceinline__ void merge16_desc(unsigned (&run)[16], const unsigned (&ch)[16]) {
#pragma unroll
    for (int i = 0; i < 16; ++i) run[i] = run[i] > ch[15 - i] ? run[i] : ch[15 - i];
#pragma unroll
    for (int j = 8; j > 0; j >>= 1) bitonic_stage_desc<16>(run, 16, j);
}
__device__ __forceinline__ unsigned mono_hi(unsigned w) { return w ^ ((unsigned)((int)w >> 31) | 0x80000000u); }
__device__ __forceinline__ float demono_hi(unsigned k) { const unsigned kk = k & 0xffff0000u; return __builtin_bit_cast(float, (kk ^ ((unsigned)(~(int)kk >> 31) | 0x80000000u)) & 0xffff0000u); }
__device__ __forceinline__ void top16_list(LAS const unsigned char* row, int sw, unsigned (&run)[16]) {
#pragma unroll
    for (int ck = 0; ck < 8; ++ck) {
        const u32x4 w0 = *(LAS const u32x4*)(row + (((2 * ck) ^ sw) << 4)), w1 = *(LAS const u32x4*)(row + (((2 * ck + 1) ^ sw) << 4));
        const unsigned w[8] = {w0.x, w0.y, w0.z, w0.w, w1.x, w1.y, w1.z, w1.w};
        unsigned ch[16];
#pragma unroll
        for (int i = 0; i < 8; ++i) { ch[2 * i] = (mono_hi(w[i] << 16) & 0xffff0000u) | (unsigned)(ck * 16 + 2 * i); ch[2 * i + 1] = (mono_hi(w[i]) & 0xffff0000u) | (unsigned)(ck * 16 + 2 * i + 1); }
        sort16_desc(ch);
        if (ck == 0) {
#pragma unroll
            for (int i = 0; i < 16; ++i) run[i] = ch[i];
        } else merge16_desc(run, ch);
    }
}
__device__ __forceinline__ void topk_fetch(const bf16_t* src, u32x4 (&r)[16], int L) {
#pragma unroll
    for (int i = 0; i < 16; ++i) r[i] = *(const u32x4*)(src + (size_t)(4 * i + (L >> 4)) * 256 + (L & 15) * 8);
}
__device__ __forceinline__ void topk_stage(LAS unsigned char* tile, const u32x4 (&r)[16], int L) {
#pragma unroll
    for (int i = 0; i < 16; ++i) { const int row = 4 * i + (L >> 4); *(LAS u32x4*)(tile + row * 256 + ((((L & 15) ^ (row & 15))) << 4)) = r[i]; }
}
__device__ __forceinline__ void phase_topk(const Ctx& c0) {
    Ctx c = c0; c.lane = lane_id_v(); c.tid = c.wave * 64 + c.lane;
    const bf16_t* sc = WSP(bf16_t, WS_SC); int* IDX = WSP(int, WS_IDX); float* GW = WSP(float, WS_GW);
    const int L = c.lane, gw0 = (c.vcu * 8 + c.wave) * 64, NL = c.G * 512;
    LAS unsigned char* tile = c.lds + c.wave * 16384;
    LAS const unsigned char* myrow = tile + L * 256; const int sw = L & 15;
    for (int eb = gw0; eb < T * H; eb += NL) {
        const int e = eb + L;
        unsigned ka[16], kb[16];
        u32x4 ra[16], rb[16];
        topk_fetch(sc + (size_t)eb * 256, ra, L);
        topk_fetch(sc + (size_t)eb * 256 + 128, rb, L);
        topk_stage(tile, ra, L);
        top16_list(myrow, sw, ka);
        topk_stage(tile, rb, L);
        top16_list(myrow, sw, kb);
        float sa[16], sb[16]; unsigned ia[16], ib[16];
#pragma unroll
        for (int i = 0; i < 16; ++i) { sa[i] = demono_hi(ka[i]); sb[i] = demono_hi(kb[i]); ia[i] = (ka[i] & 0x7fu) << 7; ib[i] = kb[i] & 0x7fu; }
        const float mx = sa[0] + sb[0];
        unsigned run[16], ch[16]; int n = 0, nc = 0;
#pragma unroll
        for (int a = 0; a < 16; ++a)
#pragma unroll
            for (int b = 0; b < 16; ++b) if ((a + 1) * (b + 1) <= 16) {
                const int k = 65535 + (int)((sa[a] + sb[b] - mx) * 1024.f);
                ch[n] = ((unsigned)(k < 0 ? 0 : k) << 16) | ia[a] | ib[b];
                if (++n == 16) { sort16_desc(ch); if (nc == 0) {
#pragma unroll
                        for (int i = 0; i < 16; ++i) run[i] = ch[i]; } else merge16_desc(run, ch);
                    n = 0; ++nc; }
            }
#pragma unroll
        for (int i = 2; i < 16; ++i) ch[i] = 0u;
        sort16_desc(ch); merge16_desc(run, ch);
        float ex[16]; float sum = 0.f;
#pragma unroll
        for (int i = 0; i < 16; ++i) { ex[i] = __expf((float)((int)(run[i] >> 16) - 65535) * (1.f / 1024.f)); sum += ex[i]; }
        const float inv = 1.f / sum;
        u32x4* oi = (u32x4*)(IDX + (size_t)e * 16); f32x4* og = (f32x4*)(GW + (size_t)e * 16);
#pragma unroll
        for (int q = 0; q < 4; ++q) { u32x4 vi; vi.x = run[4 * q] & 0x3fffu; vi.y = run[4 * q + 1] & 0x3fffu; vi.z = run[4 * q + 2] & 0x3fffu; vi.w = run[4 * q + 3] & 0x3fffu; oi[q] = vi;
            f32x4 vg; vg.x = ex[4 * q] * inv; vg.y = ex[4 * q + 1] * inv; vg.z = ex[4 * q + 2] * inv; vg.w = ex[4 * q + 3] * inv; og[q] = vg; }
    }
}

__device__ __forceinline__ void dec32_fp4(const u32x4 r, f32x2 (&f)[16]) {
    const unsigned w[4] = {r.x, r.y, r.z, r.w};
#pragma unroll
    for (int i = 0; i < 4; ++i) { f[4 * i] = __builtin_amdgcn_cvt_scalef32_pk_f32_fp4(w[i], 1.0f, 0); f[4 * i + 1] = __builtin_amdgcn_cvt_scalef32_pk_f32_fp4(w[i], 1.0f, 1);
        f[4 * i + 2] = __builtin_amdgcn_cvt_scalef32_pk_f32_fp4(w[i], 1.0f, 2); f[4 * i + 3] = __builtin_amdgcn_cvt_scalef32_pk_f32_fp4(w[i], 1.0f, 3); }
}
__device__ __forceinline__ float dot32_fp4(const f32x2 (&hv)[16], const u32x4 r) {
    f32x2 f[16]; dec32_fp4(r, f); f32x2 s = hv[0] * f[0];
#pragma unroll
    for (int j = 1; j < 16; ++j) s = s + hv[j] * f[j];
    return s.x + s.y;
}
typedef int i32x8 __attribute__((ext_vector_type(8)));
__device__ __forceinline__ void phase_peer_u(const Ctx& c0) {
    Ctx c = c0; c.lane = lane_id_v(); c.tid = c.wave * 64 + c.lane;
    const int* IDX = WSP(int, WS_IDX);
    const int L = c.lane, pp = blockIdx.x & 3, hh = (blockIdx.x >> 2) & 1, rank = blockIdx.x >> 3, nrank = c.G >> 3;
    LAS int* mb = (LAS int*)(c.lds + c.wave * 1024);
    const int vr = L & 15, g4 = L >> 4;
    const unsigned char* EU4b = c.ws + WS_EU + (size_t)pp * NE * 128;
    const unsigned char* H8 = c.ws + WS_H2Q + pp * 256 + (vr & 1) * 128 + g4 * 16;
    float* PD = WSP(float, WS_PD) + (size_t)(2 * pp + (vr & 1)) * T * 128 + 2 * g4;
    const int t0 = 2 * (rank * 8 + c.wave) + hh, ts = 2 * nrank * 8;
    if (t0 >= T) return;
    int sc1 = 0x7f7f7f7f; asm volatile("" : "+v"(sc1));
    const bool swapb = WSP(unsigned, WS_C8SP)[1024] != 0u;
    { const int g0 = IDX[(size_t)t0 * 128 + L], g1 = IDX[(size_t)t0 * 128 + 64 + L]; mb[L] = g0; mb[64 + L] = g1; }
    u32x4 rA[16], rB[16];
    { const unsigned char* EU4 = EU4b + (vr & 1) * 64 + g4 * 16;
#pragma unroll
      for (int G = 0; G < 16; ++G) rA[G] = *(const u32x4*)(EU4 + (size_t)mb[8 * G + (vr >> 1)] * 128); }
    int cur = 0;
#define PEER_U_TOKEN(RC, RN, tcur, tnext, tnext2) do { \
        int lo = (vr & 1) * 64 + g4 * 16; asm volatile("" : "+v"(lo)); const unsigned char* EU4 = EU4b + lo; \
        const int gn0 = IDX[(size_t)(tnext2) * 128 + L], gn1 = IDX[(size_t)(tnext2) * 128 + 64 + L]; \
        i32x8 hb = (i32x8){0, 0, 0, 0, 0, 0, 0, 0}; \
        if (vr < 2) { const u32x4 h0 = *(const u32x4*)(H8 + (size_t)(tcur) * 1024), h1 = *(const u32x4*)(H8 + (size_t)(tcur) * 1024 + 64); \
            unsigned hw[8] = {h0.x, h0.y, h0.z, h0.w, h1.x, h1.y, h1.z, h1.w}; \
            if (swapb) { _Pragma("unroll") for (int q = 0; q < 8; ++q) hw[q] = ((hw[q] & 0x00ff00ffu) << 8) | ((hw[q] >> 8) & 0x00ff00ffu); } \
            hb = (i32x8){(int)hw[0], (int)hw[1], (int)hw[2], (int)hw[3], (int)hw[4], (int)hw[5], (int)hw[6], (int)hw[7]}; } \
          \
        _Pragma("unroll") for (int G = 0; G < 16; ++G) RN[G] = *(const u32x4*)(EU4 + (size_t)mb[(cur ^ 1) * 128 + 8 * G + (vr >> 1)] * 128); \
          \
        mb[cur * 128 + L] = gn0; mb[cur * 128 + 64 + L] = gn1; \
        f32x4 acc[16]; \
        _Pragma("unroll") for (int G = 0; G < 16; ++G) { const i32x8 a = (i32x8){(int)RC[G].x, (int)RC[G].y, (int)RC[G].z, (int)RC[G].w, 0, 0, 0, 0}; \
            acc[G] = __builtin_amdgcn_mfma_scale_f32_16x16x128_f8f6f4(a, hb, (f32x4){0.f, 0.f, 0.f, 0.f}, 4, 0, 0, sc1, 0, sc1); } \
        if (vr < 2) { _Pragma("unroll") for (int G = 0; G < 16; ++G) { f32x2 o; o.x = vr ? acc[G][1] : acc[G][0]; o.y = vr ? acc[G][3] : acc[G][2]; *(f32x2*)(PD + (size_t)(tcur) * 128 + 8 * G) = o; } } \
        cur ^= 1; } while (0)
    { const int t1 = (t0 + ts < T) ? t0 + ts : t0; const int g0 = IDX[(size_t)t1 * 128 + L], g1 = IDX[(size_t)t1 * 128 + 64 + L]; mb[128 + L] = g0; mb[128 + 64 + L] = g1; }
#pragma unroll 1
    for (int t = t0; t < T; t += 2 * ts) {
        const int ta = t, tb = (t + ts < T) ? t + ts : t, tc = (t + 2 * ts < T) ? t + 2 * ts : tb, td = (t + 3 * ts < T) ? t + 3 * ts : tc;
        PEER_U_TOKEN(rA, rB, ta, tb, tc);
        if (t + ts < T) PEER_U_TOKEN(rB, rA, tb, tc, td);
    }
#undef PEER_U_TOKEN
}
__device__ __forceinline__ void phase_peer_fin(const Ctx& c0) {
    Ctx c = c0; c.lane = lane_id_v(); c.tid = c.wave * 64 + c.lane;
    const int* IDX = WSP(int, WS_IDX); const float* GW = WSP(float, WS_GW); const float* PD = WSP(float, WS_PD); unsigned* WGT = WSP(unsigned, WS_WGT);
    const float* SU = WSP(float, WS_SU); const float* SV = WSP(float, WS_SV); const float* SH = WSP(float, WS_SH);
    const int NTH = c.G * 512;
    for (int i0 = c.vcu * 512 + c.tid; i0 < T * 128; i0 += 4 * NTH) {
        float d[4]; int e[4]; float g[4];
#pragma unroll
        for (int u = 0; u < 4; ++u) { const int i = (i0 + u * NTH < T * 128) ? i0 + u * NTH : i0; float s = 0.f;
#pragma unroll
            for (int p = 0; p < 8; ++p) s += PD[(size_t)p * T * 128 + i];
            d[u] = s; e[u] = IDX[i]; g[u] = GW[i]; }
        float su[4], sv[4], sh[4];
#pragma unroll
        for (int u = 0; u < 4; ++u) { const int i = (i0 + u * NTH < T * 128) ? i0 + u * NTH : i0; su[u] = SU[e[u]]; sv[u] = SV[e[u]]; sh[u] = SH[i >> 7]; }
#pragma unroll
        for (int u = 0; u < 4; ++u) { const int i = i0 + u * NTH; if (i < T * 128) WGT[i] = (f2bf(g[u] * gelu_tanh(d[u] * su[u] * sh[u]) * sv[u]) << 16) | (unsigned)e[u]; }
    }
}
template <bool DRY> __device__ __forceinline__ void phase_peer_v(const Ctx& c0) {
    Ctx c = c0; c.lane = lane_id_v(); c.tid = c.wave * 64 + c.lane;
    const unsigned* WI = WSP(unsigned, WS_WGT); const float* mod = WSP(float, WS_MOD);
    const int L = c.lane, pp = blockIdx.x & 3, hh = (blockIdx.x >> 2) & 1, rank = blockIdx.x >> 3, nrank = c.G >> 3;
    const bool b5 = L & 32, b4 = L & 16, b3 = L & 8;
    LAS unsigned* mb = (LAS unsigned*)(c.lds + c.wave * 1024);
    const int kl = L >> 3;
    const unsigned char* EV4 = c.ws + WS_EV + (size_t)pp * NE * 128 + (L & 7) * 16;
    const int col = pp * 256 + (L & 7) * 32 + (b5 ? 16 : 0) + (b4 ? 8 : 0) + (b3 ? 4 : 0);
    const int t0 = 2 * (rank * 8 + c.wave) + hh, ts = 2 * nrank * 8;
    if (t0 >= T) return;
    { const unsigned g0 = WI[(size_t)t0 * 128 + L], g1 = WI[(size_t)t0 * 128 + 64 + L]; mb[L] = g0; mb[64 + L] = g1; }
    u32x4 rA[8], rB[8];
#pragma unroll
    for (int i = 0; i < 8; ++i) rA[i] = *(const u32x4*)(EV4 + (size_t)(mb[8 * i + kl] & 0xffffu) * 128);
    int cur = 0;
#pragma unroll 1
    for (int t = t0; t < T; t += ts) {
        const int tn = (t + ts < T) ? t + ts : t;
        const unsigned gn0 = WI[(size_t)tn * 128 + L], gn1 = WI[(size_t)tn * 128 + 64 + L];
        float* o = c.out + (size_t)t * 1024 + col; const float* g2 = mod + (t >> 11) * 6144 + 5120 + col;
        f32x4 xo = *(const f32x4*)o; const f32x4 gt = *(const f32x4*)g2;
#pragma unroll
        for (int i = 0; i < 8; ++i) rB[i] = *(const u32x4*)(EV4 + (size_t)(mb[cur * 128 + 64 + 8 * i + kl] & 0xffffu) * 128);
        f32x2 ac2[16];
#pragma unroll
        for (int j = 0; j < 16; ++j) ac2[j] = (f32x2){0.f, 0.f};
#pragma unroll
        for (int i = 0; i < 8; ++i) { const float w = bfhi(mb[cur * 128 + 8 * i + kl]); const f32x2 w2 = {w, w}; f32x2 f[16]; dec32_fp4(rA[i], f);
#pragma unroll
            for (int j = 0; j < 16; ++j) ac2[j] = ac2[j] + f[j] * w2; }
        mb[(cur ^ 1) * 128 + L] = gn0; mb[(cur ^ 1) * 128 + 64 + L] = gn1;
#pragma unroll
        for (int i = 0; i < 8; ++i) rA[i] = *(const u32x4*)(EV4 + (size_t)(mb[(cur ^ 1) * 128 + 8 * i + kl] & 0xffffu) * 128);
#pragma unroll
        for (int i = 0; i < 8; ++i) { const float w = bfhi(mb[cur * 128 + 64 + 8 * i + kl]); const f32x2 w2 = {w, w}; f32x2 f[16]; dec32_fp4(rB[i], f);
#pragma unroll
            for (int j = 0; j < 16; ++j) ac2[j] = ac2[j] + f[j] * w2; }
        float acc[32];
#pragma unroll
        for (int j = 0; j < 16; ++j) { acc[2 * j] = ac2[j].x; acc[2 * j + 1] = ac2[j].y; }
        float n16[16], n8[8], n4[4];
#pragma unroll
        for (int i = 0; i < 16; ++i) { const float send = b5 ? acc[i] : acc[i + 16], keep = b5 ? acc[i + 16] : acc[i]; n16[i] = keep + __shfl_xor(send, 32); }
#pragma unroll
        for (int i = 0; i < 8; ++i) { const float send = b4 ? n16[i] : n16[i + 8], keep = b4 ? n16[i + 8] : n16[i]; n8[i] = keep + __shfl_xor(send, 16); }
#pragma unroll
        for (int i = 0; i < 4; ++i) { const float send = b3 ? n8[i] : n8[i + 4], keep = b3 ? n8[i + 4] : n8[i]; n4[i] = keep + __shfl_xor(send, 8); }
        xo.x += gt.x * n4[0]; xo.y += gt.y * n4[1]; xo.z += gt.z * n4[2]; xo.w += gt.w * n4[3];
        if (DRY) asm volatile("" :: "v"(xo.x), "v"(xo.y), "v"(xo.z), "v"(xo.w)); else *(f32x4*)o = xo;
        cur ^= 1;
    }
}

struct ENone {};
struct FInProj { static constexpr int NB = 4; bf16_t *pa, *lx, *lg, *mg; typedef ENone Tile; typedef ENone Pre;
    __device__ __forceinline__ Tile tile(int, int, int) const { return Tile{}; }
    __device__ __forceinline__ Pre pre(int, int, int) const { return Pre{}; }
    __device__ __forceinline__ void apply(int row, int pn, int cc, const float (&v0)[8], const float (&v1)[8], const Pre&, const Tile&) const {
        bf16_t* d;
        if (pn < 2) d = pa + (size_t)row * 512 + pn * 256 + cc; else if (pn < 6) d = lx + (size_t)row * 1024 + (pn - 2) * 256 + cc;
        else if (pn < 10) d = lg + (size_t)row * 1024 + (pn - 6) * 256 + cc; else d = mg + (size_t)row * 2048 + (pn - 10) * 256 + cc;
        *(u32x4*)d = pack8(v0); *(u32x4*)(d + 128) = pack8(v1); } };
struct FRowScale { static constexpr int NB = 4; bf16_t* dst; int ldc; const float* rstd; int which; typedef ENone Tile; struct Pre { float r; };
    __device__ __forceinline__ Tile tile(int, int, int) const { return Tile{}; }
    __device__ __forceinline__ Pre pre(int row, int, int) const { return Pre{rstd[2 * row + which]}; }
    __device__ __forceinline__ void apply(int row, int pn, int cc, const float (&v0)[8], const float (&v1)[8], const Pre& p, const Tile&) const {
        float a[8], b[8];
#pragma unroll
        for (int j = 0; j < 8; ++j) { a[j] = v0[j] * p.r; b[j] = v1[j] * p.r; }
        *(u32x4*)(dst + (size_t)row * ldc + pn * 256 + cc) = pack8(a); *(u32x4*)(dst + (size_t)row * ldc + pn * 256 + 128 + cc) = pack8(b); } };
constexpr int GT_OFF = 132096;
struct FGates { static constexpr int NB = 2; const bf16_t* xc; bf16_t *LA, *Bv; LAS const float* gt;
    typedef ENone Tile; struct Pre { u32x4 x; };
    __device__ __forceinline__ Tile tile(int, int, int) const { return Tile{}; }
    __device__ __forceinline__ Pre pre(int row, int pn, int cc) const { return Pre{*(const u32x4*)(xc + (size_t)row * 1024 + pn * 128 + cc)}; }
    __device__ __forceinline__ void apply(int row, int pn, int cc, const float (&v0)[8], const float (&v1)[8], const Pre& p, const Tile&) const {
        const int ch = pn * 128 + cc; float x[8], la[8], bv[8]; unpack8(p.x, x);
        const f32x4 br0 = *(LAS const f32x4*)(gt + ch), br1 = *(LAS const f32x4*)(gt + ch + 4), bi0 = *(LAS const f32x4*)(gt + 1024 + ch), bi1 = *(LAS const f32x4*)(gt + 1024 + ch + 4),
                    c80 = *(LAS const f32x4*)(gt + 2048 + ch), c81 = *(LAS const f32x4*)(gt + 2048 + ch + 4);
        const float br[8] = {br0.x, br0.y, br0.z, br0.w, br1.x, br1.y, br1.z, br1.w}, bi[8] = {bi0.x, bi0.y, bi0.z, bi0.w, bi1.x, bi1.y, bi1.z, bi1.w}, c8[8] = {c80.x, c80.y, c80.z, c80.w, c81.x, c81.y, c81.z, c81.w};
#pragma unroll
        for (int j = 0; j < 8; ++j) {
            const float r = __builtin_amdgcn_rcpf(1.f + __expf(-(v0[j] + br[j]))), ig = __builtin_amdgcn_rcpf(1.f + __expf(-(v1[j] + bi[j])));
            const float loga = r * c8[j];
            const float z = 2.f * loga;
            const float ser = -z * (1.f + z * (0.5f + z * (0.16666667f + z * (0.041666668f + z * (0.008333334f + z * 0.0013888889f)))));
            const float om = (z > -0.25f) ? ser : (1.f - __expf(z));
            la[j] = loga * 1.4426950408889634f;
            bv[j] = sqrtf(om) * (ig * x[j]);
        }
        *(u32x4*)(LA + (size_t)row * 1024 + ch) = pack8(la); *(u32x4*)(Bv + (size_t)row * 1024 + ch) = pack8(bv); } };
struct FY1 { static constexpr int NB = 4; const bf16_t* mg; bf16_t* y; int goff; bool accum; typedef ENone Tile; struct Pre { u32x4 g0, g1, y0, y1; };
    __device__ __forceinline__ Tile tile(int, int, int) const { return Tile{}; }
    __device__ __forceinline__ Pre pre(int row, int pn, int cc) const { Pre p; const int col = pn * 256 + cc;
        p.g0 = *(const u32x4*)(mg + (size_t)row * 2048 + goff + col); p.g1 = *(const u32x4*)(mg + (size_t)row * 2048 + goff + col + 128);
        if (accum) { p.y0 = *(const u32x4*)(y + (size_t)row * 1024 + col); p.y1 = *(const u32x4*)(y + (size_t)row * 1024 + col + 128); } else { p.y0 = (u32x4){0u, 0u, 0u, 0u}; p.y1 = p.y0; }
        return p; }
    __device__ __forceinline__ void one(bf16_t* dst, const u32x4 g, const u32x4 yo, const float (&v)[8]) const {
        float gt[8], o[8]; unpack8(g, gt); unpack8(yo, o);
#pragma unroll
        for (int j = 0; j < 8; ++j) o[j] = o[j] + sigmoidf_(gt[j]) * v[j];
        *(u32x4*)dst = pack8(o); }
    __device__ __forceinline__ void apply(int row, int pn, int cc, const float (&v0)[8], const float (&v1)[8], const Pre& p, const Tile&) const {
        bf16_t* d = y + (size_t)row * 1024 + pn * 256 + cc; one(d, p.g0, p.y0, v0); one(d + 128, p.g1, p.y1, v1); } };
struct FX1 { static constexpr int NB = 4; const float* x; float* out; const float* mod; struct Tile { f32x4 a[4]; }; struct Pre { f32x4 x[4]; };
    __device__ __forceinline__ Tile tile(int pn, int cc, int pm) const { Tile t; const float* g1 = mod + ((pm * 256) >> 11) * 6144 + 2048 + pn * 256 + cc;
        t.a[0] = *(const f32x4*)g1; t.a[1] = *(const f32x4*)(g1 + 4); t.a[2] = *(const f32x4*)(g1 + 128); t.a[3] = *(const f32x4*)(g1 + 132); return t; }
    __device__ __forceinline__ Pre pre(int row, int pn, int cc) const { Pre p; const float* xr = x + (size_t)row * 1024 + pn * 256 + cc;
        p.x[0] = *(const f32x4*)xr; p.x[1] = *(const f32x4*)(xr + 4); p.x[2] = *(const f32x4*)(xr + 128); p.x[3] = *(const f32x4*)(xr + 132); return p; }
    __device__ __forceinline__ void apply(int row, int pn, int cc, const float (&v0)[8], const float (&v1)[8], const Pre& p, const Tile& t) const {
        float* o = out + (size_t)row * 1024 + pn * 256 + cc;
        f32x4 r0, r1, r2, r3;
        r0.x = p.x[0].x + t.a[0].x * v0[0]; r0.y = p.x[0].y + t.a[0].y * v0[1]; r0.z = p.x[0].z + t.a[0].z * v0[2]; r0.w = p.x[0].w + t.a[0].w * v0[3];
        r1.x = p.x[1].x + t.a[1].x * v0[4]; r1.y = p.x[1].y + t.a[1].y * v0[5]; r1.z = p.x[1].z + t.a[1].z * v0[6]; r1.w = p.x[1].w + t.a[1].w * v0[7];
        r2.x = p.x[2].x + t.a[2].x * v1[0]; r2.y = p.x[2].y + t.a[2].y * v1[1]; r2.z = p.x[2].z + t.a[2].z * v1[2]; r2.w = p.x[2].w + t.a[2].w * v1[3];
        r3.x = p.x[3].x + t.a[3].x * v1[4]; r3.y = p.x[3].y + t.a[3].y * v1[5]; r3.z = p.x[3].z + t.a[3].z * v1[6]; r3.w = p.x[3].w + t.a[3].w * v1[7];
        *(f32x4*)o = r0; *(f32x4*)(o + 4) = r1; *(f32x4*)(o + 128) = r2; *(f32x4*)(o + 132) = r3; } };
struct FStore { static constexpr int NB = 4; bf16_t* dst; int ldc; typedef ENone Tile; typedef ENone Pre;
    __device__ __forceinline__ Tile tile(int, int, int) const { return Tile{}; }
    __device__ __forceinline__ Pre pre(int, int, int) const { return Pre{}; }
    __device__ __forceinline__ void apply(int row, int pn, int cc, const float (&v0)[8], const float (&v1)[8], const Pre&, const Tile&) const {
        *(u32x4*)(dst + (size_t)row * ldc + pn * 256 + cc) = pack8(v0); *(u32x4*)(dst + (size_t)row * ldc + pn * 256 + 128 + cc) = pack8(v1); } };

template <int M, int N, int K, int LDA, int ACS, class F> __device__ __forceinline__ void run_gemm(const Ctx& c, const bf16_t* A, const bf16_t* Bt, const F& f) {
    pg8::Gemm g{A, Bt}; pg8::StaticOrder<M, N> So; So.init(c.G, (int)blockIdx.x);
    pg8::EpiF<F> E{f};
    pg8::gemm_phase<K, LDA, ACS, pg8::EpiF<F>, pg8::StaticOrder<M, N>>((PG8_LAS unsigned char*)c.lds, g, So, E, c.wave * 64 + lane_id_v());
}

__global__ void __launch_bounds__(512, 2) mk_fwd(Args args) {
    extern __shared__ __attribute__((aligned(16))) unsigned char lds_raw[];
    Ctx c;
    c.lds = (LAS unsigned char*)lds_raw;
    c.wave = __builtin_amdgcn_readfirstlane(threadIdx.x >> 6); c.lane = lane_id_v(); c.tid = c.wave * 64 + c.lane;
    c.G = gridDim.x; { const int bx = blockIdx.x; c.vcu = (c.G % 8 == 0) ? (bx % 8) * (c.G / 8) + bx / 8 : bx; }
    c.in = args.in; c.out = args.out; c.ws = args.ws;
    volatile LAS unsigned* MISC = (volatile LAS unsigned*)(c.lds + MISC_OFF);
    if (c.tid < 32) MISC[c.tid] = 0u;
    __syncthreads();
    XcdBarrier bar; bar.bar = (unsigned*)(c.ws + WS_CTL) + 4096; bar.x = 0; bar.st = nullptr;
    if (args.ph_hi - args.ph_lo > 1) bar = xcd_barrier_post((unsigned*)(c.ws + WS_CTL) + 4096, MISC + 8);

    const int lo = args.ph_lo, hi = args.ph_hi;
#ifndef ONLYP
#define ONLYP -1
#endif
#define IN(k) (lo <= (k) && (k) < hi && (ONLYP < 0 || ONLYP == (k)))
#define SEAM(k) do { if ((k) + 1 < hi) xcd_barrier(bar, c.wave); } while (0)
#ifndef REPEAT_MASK
#define REPEAT_MASK 0
#endif
#define PHASE(k, ...) if (IN(k)) { c.lane = lane_id_v(); c.tid = c.wave * 64 + c.lane; { __VA_ARGS__ } if ((REPEAT_MASK >> (k)) & 1) { xcd_barrier(bar, c.wave); { __VA_ARGS__ } } SEAM(k); }
    PHASE(0, phase_prep(c);)
    PHASE(1, phase_modnorm<false>(c, c.in[I_X], c.in[I_N1G], 0, 1024, WSP(bf16_t, WS_R0));)
    PHASE(2, FInProj f{WSP(bf16_t, WS_R1), WSP(bf16_t, WS_R2), WSP(bf16_t, WS_R3), (bf16_t*)c.out};
             run_gemm<T, 4608, 1024, 1024, 0>(c, WSP(bf16_t, WS_R0), WSP(bf16_t, WS_WIN), f);)
    PHASE(3, phase_conv(c);)
    PHASE(4, { LAS float* gtl = (LAS float*)(c.lds + GT_OFF);
               for (int e = c.tid; e < 1024; e += 512) { gtl[e] = c.in[I_BRG][e]; gtl[1024 + e] = c.in[I_BIG][e]; gtl[2048 + e] = WSP(float, WS_C8SP)[e]; }
               __syncthreads();
               FGates fg{WSP(bf16_t, WS_R4), WSP(bf16_t, WS_R0), WSP(bf16_t, WS_R6), gtl};
               run_gemm<T, 2048, 128, 1024, 128>(c, WSP(bf16_t, WS_R4), WSP(bf16_t, WS_WG), fg); }
             { FRowScale fq{WSP(bf16_t, WS_R5), 768, WSP(float, WS_RSTD), 0};
               run_gemm<T, 768, 256, 512, 0>(c, WSP(bf16_t, WS_R1), WSP(bf16_t, WS_WUQ), fq); })
    PHASE(5, { FRowScale fkv{WSP(bf16_t, WS_R2), 1024, WSP(float, WS_RSTD), 1};
               run_gemm<T, 1024, 128, 512, 0>(c, WSP(bf16_t, WS_R1) + 256, WSP(bf16_t, WS_WUKV), fkv); }
             phase_scan(c);)
    PHASE(6, phase_qkv_layout(c);)
    PHASE(7, phase_attn(c);)
    PHASE(8, { FY1 f1{(const bf16_t*)c.out, WSP(bf16_t, WS_R2), 0, false};
               run_gemm<T, 1024, 512, 512, 0>(c, WSP(bf16_t, WS_R0 + 32 * MiB), WSP(bf16_t, WS_WOA), f1); }
             { FY1 f2{(const bf16_t*)c.out, WSP(bf16_t, WS_R2), 1024, true};
               run_gemm<T, 1024, 1024, 1024, 0>(c, WSP(bf16_t, WS_R6), WSP(bf16_t, WS_WOL), f2); })
    PHASE(9, FX1 f{c.in[I_X], c.out, WSP(float, WS_MOD)};
             run_gemm<T, 1024, 1024, 1024, 0>(c, WSP(bf16_t, WS_R2), WSP(bf16_t, WS_WOUT), f);)
    PHASE(10, phase_modnorm<true>(c, c.out, c.in[I_N2G], 3072, 4096, WSP(bf16_t, WS_R0));)
    PHASE(11, FStore f{WSP(bf16_t, WS_SC), 2048};
              run_gemm<T, 2048, 1024, 1024, 0>(c, WSP(bf16_t, WS_R0), WSP(bf16_t, WS_WQ), f);)
    PHASE(13, phase_topk(c);)
    PHASE(14, phase_peer_u(c);)
    PHASE(15, phase_peer_fin(c);)
#ifdef PROBE_VDRY
    if (IN(16)) { c.lane = lane_id_v(); c.tid = c.wave * 64 + c.lane; phase_peer_v<true>(c); xcd_barrier(bar, c.wave); }
#endif
    PHASE(16, phase_peer_v<false>(c);)
#undef PHASE
#undef IN
#undef SEAM
}

extern "C" void kernel_launch(void* const* d_in, const int* in_sizes, int n_in, void* d_out, int out_size, void* d_ws, size_t ws_size, hipStream_t stream) {
    static int grid = 0;
    if (grid == 0) {
        if (n_in != 28 || out_size != T * D || ws_size < WS_END) { fprintf(stderr, "kernel_launch: unexpected shapes (n_in %d out %d ws %zu)\n", n_in, out_size, ws_size); grid = -1; return; }
        int dev = 0, cus = 0, per_cu = 0;
        if (hipGetDevice(&dev) != hipSuccess || hipDeviceGetAttribute(&cus, hipDeviceAttributeMultiprocessorCount, dev) != hipSuccess) { grid = -1; return; }
        if (hipFuncSetAttribute((const void*)mk_fwd, hipFuncAttributeMaxDynamicSharedMemorySize, LDS_BYTES) != hipSuccess) { fprintf(stderr, "kernel_launch: hipFuncSetAttribute failed\n"); grid = -1; return; }
        if (hipOccupancyMaxActiveBlocksPerMultiprocessor(&per_cu, (const void*)mk_fwd, 512, LDS_BYTES) != hipSuccess || per_cu < 1) { fprintf(stderr, "kernel_launch: occupancy query says %d blocks per CU\n", per_cu); grid = -1; (void)hipGetLastError(); return; }
        grid = cus - (cus % 8);
        if (grid < 8) { fprintf(stderr, "kernel_launch: needs at least 8 CUs\n"); grid = -1; return; }
    }
    if (grid < 0) return;
    (void)hipMemsetAsync((char*)d_ws + WS_CTL, 0, CTL_ZERO_BYTES, stream);
    Args a{};
    for (int i = 0; i < 28; ++i) a.in[i] = (const float*)d_in[i];
    a.out = (float*)d_out; a.ws = (unsigned char*)d_ws;
#if MK_N_LAUNCHES == 1
    a.ph_lo = 0; a.ph_hi = N_PHASES;
    hipLaunchKernelGGL(mk_fwd, dim3(grid), dim3(512), LDS_BYTES, stream, a);
#else
    for (int ph = 0; ph < N_PHASES; ++ph) { a.ph_lo = ph; a.ph_hi = ph + 1; hipLaunchKernelGGL(mk_fwd, dim3(grid), dim3(512), LDS_BYTES, stream, a); }
#endif
}
```

```cpp
#include <hip/hip_runtime.h>
#include <cstdio>
#include <cstdint>

#define LAS __attribute__((address_space(3)))
#define GAS __attribute__((address_space(1)))
typedef unsigned short bf16_t;
typedef short bf16x8 __attribute__((ext_vector_type(8)));
typedef float f32x4 __attribute__((ext_vector_type(4)));
typedef float f32x2 __attribute__((ext_vector_type(2)));
typedef unsigned u32x4 __attribute__((ext_vector_type(4)));
typedef unsigned u32x2 __attribute__((ext_vector_type(2)));

#ifndef MK_N_LAUNCHES
#define MK_N_LAUNCHES 1
#endif

constexpr int T = 32768, D = 1024, NB_ = 16, S = 2048, H = 8;
constexpr int QKH = 96, VH = 64;
constexpr int NE = 16384;
constexpr float EPS = 1e-6f;

constexpr size_t MiB = 1u << 20;
constexpr size_t WS_CTL = 0, CTL_ZERO_BYTES = 65536;
constexpr size_t WS_MOD = 1 * MiB;
constexpr size_t WS_RSTD = 1 * MiB + 512 * 1024;
constexpr size_t WS_C8SP = 1 * MiB + 448 * 1024;
constexpr size_t WS_WIN = 2 * MiB;
constexpr size_t WS_WUQ = 11 * MiB;
constexpr size_t WS_WUKV = 11 * MiB + 512 * 1024;
constexpr size_t WS_WOA = 12 * MiB;
constexpr size_t WS_WOL = 13 * MiB;
constexpr size_t WS_WOUT = 15 * MiB;
constexpr size_t WS_WQ = 17 * MiB;
constexpr size_t WS_WG = 21 * MiB;
constexpr size_t WS_SK = 22 * MiB;
constexpr size_t WS_EU = 24 * MiB;
constexpr size_t WS_EV = 40 * MiB;
constexpr size_t WS_SU = 1 * MiB + 768 * 1024;
constexpr size_t WS_SV = 1 * MiB + 832 * 1024;
constexpr size_t WS_WGT = 440 * MiB;
constexpr size_t WS_CS = 56 * MiB;
constexpr size_t WS_H2Q = 456 * MiB;
constexpr size_t WS_SH = 1 * MiB + 896 * 1024;
constexpr size_t WS_PD = 280 * MiB;
constexpr size_t WS_R0 = 88 * MiB;
constexpr size_t WS_R1 = 152 * MiB;
constexpr size_t WS_R2 = 184 * MiB;
constexpr size_t WS_R3 = 248 * MiB;
constexpr size_t WS_R4 = 312 * MiB;
constexpr size_t WS_R5 = 376 * MiB;
constexpr size_t WS_R6 = 424 * MiB;
constexpr size_t WS_QP = 152 * MiB;
constexpr size_t WS_SC = 280 * MiB;
constexpr size_t WS_IDX = 408 * MiB;
constexpr size_t WS_GW = 424 * MiB;
constexpr size_t WS_END = 488 * MiB;

constexpr int LDS_BYTES = 155648;
constexpr int MISC_OFF = 131072 + 320;

__device__ __forceinline__ unsigned f2bf(float f) { unsigned u = __builtin_bit_cast(unsigned, f); return (u + 0x7fffu + ((u >> 16) & 1u)) >> 16; }
typedef __bf16 bf16x2_t __attribute__((ext_vector_type(2)));
__device__ __forceinline__ unsigned pk2(float lo, float hi) { f32x2 v = {lo, hi}; return __builtin_bit_cast(unsigned, __builtin_convertvector(v, bf16x2_t)); }
__device__ __forceinline__ float bf2f(unsigned h) { return __builtin_bit_cast(float, h << 16); }
__device__ __forceinline__ float bflo(unsigned w) { return __builtin_bit_cast(float, w << 16); }
__device__ __forceinline__ float bfhi(unsigned w) { return __builtin_bit_cast(float, w & 0xffff0000u); }
__device__ __forceinline__ float sigmoidf_(float x) { return 1.f / (1.f + __expf(-x)); }
__device__ __forceinline__ float gelu_tanh(float x) {
    const float u = 0.7978845608028654f * (x + 0.044715f * x * x * x);
    const float e = __expf(2.f * u);
    const float th = 1.f - 2.f / (e + 1.f);
    return 0.5f * x * (1.f + th);
}
__device__ __forceinline__ int lane_id_v() { int l; asm volatile("v_mbcnt_lo_u32_b32 %0, -1, 0\n\tv_mbcnt_hi_u32_b32 %0, -1, %0" : "=v"(l)); return l; }
__device__ __forceinline__ float wave_sum(float v) {
#pragma unroll
    for (int o = 1; o < 64; o <<= 1) v += __shfl_xor(v, o);
    return v;
}
__device__ __forceinline__ void unpack8(const u32x4 w, float (&v)[8]) {
    v[0] = bflo(w.x); v[1] = bfhi(w.x); v[2] = bflo(w.y); v[3] = bfhi(w.y); v[4] = bflo(w.z); v[5] = bfhi(w.z); v[6] = bflo(w.w); v[7] = bfhi(w.w);
}
__device__ __forceinline__ u32x4 pack8(const float (&v)[8]) {
    u32x4 w; w.x = pk2(v[0], v[1]); w.y = pk2(v[2], v[3]); w.z = pk2(v[4], v[5]); w.w = pk2(v[6], v[7]); return w;
}

namespace pg8 {
#define PG8_LAS __attribute__((address_space(3)))
constexpr int BM = 256, BK = 64, HALF = 128, HTB = HALF * BK * 2, STAGE_BYTES = 8 * HTB, NXCD = 8, WGM = 8;
__host__ __device__ __forceinline__ int lds_byte(int r, int c) { const int st = (r >> 4) * 2 + (c >> 5), rr = r & 15, cc = c & 31, ob = rr * 64 + cc * 2; return st * 1024 + (ob ^ (((ob >> 9) & 1) << 5)); }
__host__ __device__ __forceinline__ void stage_rc(int b, int& R, int& C) { const int st = b / 1024, sb = b % 1024, swz = sb ^ (((sb >> 9) & 1) << 5); R = (st >> 1) * 16 + swz / 64; C = (st & 1) * 32 + (swz % 64) / 2; }
__host__ __device__ __forceinline__ int perm32(int rho) { const int n = rho >> 4, i = rho & 15; return 8 * (i >> 2) + 4 * n + (i & 3); }

struct Unit { int pm, pn; };
struct Gemm { const bf16_t* A; const bf16_t* Bt; };

template <int M_, int N_> struct StaticOrder {
    static constexpr int nM = M_ / BM, nN = N_ / BM, nwg = nM * nN;
    int G, c;
    __host__ __device__ void init(int G_, int c_) { G = G_; c = c_; }
    __host__ __device__ bool next(int i, Unit& u) const {
        const long L = (long)i * G + c; if (L >= nwg) return false;
        int wgid = (int)L; { const int q = nwg / NXCD, r = nwg % NXCD, xcd = wgid % NXCD, off = wgid / NXCD; wgid = (xcd < r ? xcd * (q + 1) : r * (q + 1) + (xcd - r) * q) + off; }
        const int nig = WGM * nN, gid = wgid / nig, fm = gid * WGM, gsz = (nM - fm) < WGM ? (nM - fm) : WGM;
        u.pm = fm + ((wgid % nig) % gsz); u.pn = (wgid % nig) / gsz; return true;
    }
};

template <class F> struct EpiF {
    static constexpr bool PERM = true;
    F f;
    __device__ __forceinline__ void operator()(const f32x4 (&acc)[2][2][4][2], const Unit& u, int wr, int wc, int fr, int fq) const {
        { int l_; asm volatile("v_mbcnt_lo_u32_b32 %0, -1, 0\n\tv_mbcnt_hi_u32_b32 %0, -1, %0" : "=v"(l_)); fr = l_ & 15; fq = l_ >> 4; }
        const int c = wc * 32 + 8 * fq;
        const typename F::Tile tl = f.tile(u.pn, c, u.pm);
#pragma unroll
        for (int ai = 0; ai < 2; ++ai)
#pragma unroll
            for (int mb = 0; mb < 4; mb += F::NB) {
                typename F::Pre pre[F::NB];
#pragma unroll
                for (int m = 0; m < F::NB; ++m) pre[m] = f.pre(u.pm * BM + ai * HALF + wr * 64 + (mb + m) * 16 + fr, u.pn, c);
#pragma unroll
                for (int m = 0; m < F::NB; ++m) {
                    const int row = u.pm * BM + ai * HALF + wr * 64 + (mb + m) * 16 + fr;
                    float v0[8], v1[8];
#pragma unroll
                    for (int j = 0; j < 4; ++j) { v0[j] = acc[ai][0][mb + m][0][j]; v0[4 + j] = acc[ai][0][mb + m][1][j]; v1[j] = acc[ai][1][mb + m][0][j]; v1[4 + j] = acc[ai][1][mb + m][1][j]; }
                    f.apply(row, u.pn, c, v0, v1, pre[m], tl);
                }
            }
    }
};

template <int K, int LDA, int ACS, class Epi, class Sched>
__device__ __forceinline__ void gemm_phase(PG8_LAS unsigned char* lds, const Gemm g, const Sched& S, const Epi& E, const int tid) {
    const int wid = __builtin_amdgcn_readfirstlane(tid >> 6), lane = tid & 63, wr = wid >> 2, wc = wid & 3, fr = lane & 15, fq = lane >> 4;
    constexpr int nt = K / BK;
    unsigned voffA[2], voffB[2];
#pragma unroll
    for (int i = 0; i < 2; ++i) { int R, C; stage_rc(tid * 16 + i * 8192, R, C); const int Rb = Epi::PERM ? ((R & ~31) + perm32(R & 31)) : R;
        voffA[i] = (unsigned)(R * LDA + C) * 2u; voffB[i] = (unsigned)(Rb * K + C) * 2u; }
    constexpr size_t kstep = (size_t)(BK * 2);
    constexpr size_t hstepA = (size_t)HALF * LDA * 2, hstepB = (size_t)HALF * K * 2;
    constexpr size_t tstepA = 2 * hstepA, tstepB = 2 * hstepB;
    constexpr size_t acsb = (size_t)ACS * 2;
    const unsigned ldsw = (unsigned)wid * 1024u;
    const int aoff = lds_byte(wr * 64 + fr, fq * 8), boff = lds_byte(wc * 32 + fr, fq * 8);
#define PG8_SA(b, h) (((b) * 2 + (h)) * HTB)
#define PG8_SB(b, h) ((4 + (b) * 2 + (h)) * HTB)
#define PG8_STAGE(bufoff, gbase, voff) do { _Pragma("unroll") for (int _i = 0; _i < 2; ++_i) \
        __builtin_amdgcn_global_load_lds((const unsigned*)((const char*)(gbase) + (voff)[_i]), (PG8_LAS unsigned*)(lds + (bufoff) + ldsw + _i * 8192), 16, 0, 0); } while (0)
#define PG8_LDA(dst, b, h) do { _Pragma("unroll") for (int m = 0; m < 4; ++m) _Pragma("unroll") for (int k = 0; k < 2; ++k) dst[m][k] = *(const PG8_LAS bf16x8*)(lds + PG8_SA(b, h) + aoff + m * 2048 + k * 1024); } while (0)
#define PG8_LDB(dst, b, h) do { _Pragma("unroll") for (int n = 0; n < 2; ++n) _Pragma("unroll") for (int k = 0; k < 2; ++k) dst[n][k] = *(const PG8_LAS bf16x8*)(lds + PG8_SB(b, h) + boff + n * 2048 + k * 1024); } while (0)
#define PG8_MMA(ai, bj, At, Bt) do { __builtin_amdgcn_s_setprio(1); _Pragma("unroll") for (int m = 0; m < 4; ++m) _Pragma("unroll") for (int n = 0; n < 2; ++n) _Pragma("unroll") for (int k = 0; k < 2; ++k) \
        acc[ai][bj][m][n] = __builtin_amdgcn_mfma_f32_16x16x32_bf16(Bt[n][k], At[m][k], acc[ai][bj][m][n], 0, 0, 0); __builtin_amdgcn_s_setprio(0); } while (0)
#define PG8_WAIT_V(n) asm volatile("s_waitcnt vmcnt(" #n ")" ::: "memory")
#define PG8_WAIT_L(n) asm volatile("s_waitcnt lgkmcnt(" #n ")" ::: "memory")
#define PG8_BAR __builtin_amdgcn_s_barrier()
#define PG8_SCHED __builtin_amdgcn_sched_barrier(0)
    Unit cur, nxt; int ui = 0;
    if (!S.next(0, cur)) return;
    f32x4 acc[2][2][4][2];
#pragma unroll
    for (int a = 0; a < 2; ++a)
#pragma unroll
        for (int b = 0; b < 2; ++b)
#pragma unroll
            for (int m = 0; m < 4; ++m)
#pragma unroll
                for (int n = 0; n < 2; ++n) acc[a][b][m][n] = (f32x4){0.f, 0.f, 0.f, 0.f};
    bf16x8 At[4][2], B0[2][2], B1[2][2];
    const char* cA = (const char*)g.A + (size_t)cur.pm * tstepA + (size_t)cur.pn * acsb; const char* cB = (const char*)g.Bt + (size_t)cur.pn * tstepB;
    PG8_STAGE(PG8_SB(0, 0), cB, voffB); PG8_STAGE(PG8_SB(0, 1), cB + hstepB, voffB); PG8_STAGE(PG8_SA(0, 0), cA, voffA); PG8_STAGE(PG8_SA(0, 1), cA + hstepA, voffA);
    if (wr == 1) PG8_BAR;
    PG8_WAIT_V(2); PG8_BAR;
    PG8_STAGE(PG8_SB(1, 0), cB + kstep, voffB); PG8_STAGE(PG8_SA(1, 0), cA + kstep, voffA); PG8_STAGE(PG8_SB(1, 1), cB + hstepB + kstep, voffB);
    PG8_WAIT_V(6); PG8_BAR;
    for (;;) {
        const bool has_next = S.next(ui + 1, nxt);
        const char* nA = has_next ? (const char*)g.A + (size_t)nxt.pm * tstepA + (size_t)nxt.pn * acsb : cA; const char* nB = has_next ? (const char*)g.Bt + (size_t)nxt.pn * tstepB : cB;
#pragma unroll 1
        for (int t = 0; t < nt; t += 2) {
            const bool last = (t == nt - 2);
            const char* a1 = cA + (size_t)(t + 1) * kstep;
            const char* a2 = last ? nA : cA + (size_t)(t + 2) * kstep; const char* b2 = last ? nB : cB + (size_t)(t + 2) * kstep;
            const char* a3 = a2 + kstep; const char* b3 = b2 + kstep;
            PG8_LDB(B0, 0, 0); PG8_LDB(B1, 0, 1); PG8_SCHED; PG8_LDA(At, 0, 0); PG8_STAGE(PG8_SA(1, 1), a1 + hstepA, voffA);
            PG8_WAIT_V(8); PG8_WAIT_L(0); PG8_BAR; PG8_MMA(0, 0, At, B0); PG8_MMA(0, 1, At, B1); PG8_BAR; PG8_SCHED;
            PG8_LDA(At, 0, 1); PG8_STAGE(PG8_SB(0, 0), b2, voffB); PG8_STAGE(PG8_SB(0, 1), b2 + hstepB, voffB); PG8_STAGE(PG8_SA(0, 0), a2, voffA);
            PG8_WAIT_V(8); PG8_WAIT_L(0); PG8_BAR; PG8_MMA(1, 0, At, B0); PG8_MMA(1, 1, At, B1); PG8_BAR; PG8_SCHED;
            PG8_LDB(B0, 1, 0); PG8_LDB(B1, 1, 1); PG8_SCHED; PG8_LDA(At, 1, 0); PG8_STAGE(PG8_SA(0, 1), a2 + hstepA, voffA);
            PG8_WAIT_V(8); PG8_WAIT_L(0); PG8_BAR; PG8_MMA(0, 0, At, B0); PG8_MMA(0, 1, At, B1); PG8_BAR; PG8_SCHED;
            PG8_LDA(At, 1, 1); PG8_STAGE(PG8_SB(1, 0), b3, voffB); PG8_STAGE(PG8_SB(1, 1), b3 + hstepB, voffB); PG8_STAGE(PG8_SA(1, 0), a3, voffA);
            PG8_WAIT_V(8); PG8_WAIT_L(0); PG8_BAR; PG8_MMA(1, 0, At, B0); PG8_MMA(1, 1, At, B1); PG8_BAR; PG8_SCHED;
        }
        if (wr == 0) PG8_BAR;
        E(acc, cur, wr, wc, fr, fq);
        if (!has_next) break;
#pragma unroll
        for (int a = 0; a < 2; ++a)
#pragma unroll
            for (int b = 0; b < 2; ++b)
#pragma unroll
                for (int m = 0; m < 4; ++m)
#pragma unroll
                    for (int n = 0; n < 2; ++n) acc[a][b][m][n] = (f32x4){0.f, 0.f, 0.f, 0.f};
        cur = nxt; cA = nA; cB = nB; ++ui;
        if (wr == 1) PG8_BAR;
    }
    PG8_WAIT_V(0);
    PG8_BAR;
#undef PG8_SA
#undef PG8_SB
#undef PG8_STAGE
#undef PG8_LDA
#undef PG8_LDB
#undef PG8_MMA
#undef PG8_WAIT_V
#undef PG8_WAIT_L
#undef PG8_BAR
#undef PG8_SCHED
}
}

#define XB_TMO      128
#define XB_XCNT(j)  (256  + 64 * (j))
#define XB_XSUB(j)  (1280 + 64 * (j))
#define XB_XGEN(j)  (2304 + 64 * (j))
#define XB_TOP      3328
#define XB_TOPGEN   3392
#define XCD_BAR_WORDS 3456
#define XB_SPIN_CAP (1u << 18)
__device__ __forceinline__ unsigned xb_ld(unsigned* p)              { return __hip_atomic_load(p, __ATOMIC_RELAXED, __HIP_MEMORY_SCOPE_AGENT); }
__device__ __forceinline__ unsigned xb_add(unsigned* p, unsigned v) { return __hip_atomic_fetch_add(p, v, __ATOMIC_RELAXED, __HIP_MEMORY_SCOPE_AGENT); }
__device__ __forceinline__ unsigned xb_xcc_id() { return (unsigned)__builtin_amdgcn_s_getreg((3 << 11) | 20) & 0xFu; }
#define XB_SPIN(cond, bar) do { unsigned _sp = 0; while (cond) { __builtin_amdgcn_s_sleep(1); \
    if ((++_sp & 255u) == 0u) { if (xb_ld(&(bar)[XB_TMO])) break; if (_sp > XB_SPIN_CAP) { atomicAdd(&(bar)[XB_TMO], 1u); break; } } } } while (0)
struct XcdBarrier { unsigned* bar; unsigned x; volatile LAS unsigned* st; };
__device__ __forceinline__ XcdBarrier xcd_barrier_post(unsigned* bar, volatile LAS unsigned* st) {
    XcdBarrier b; b.bar = bar; b.x = xb_xcc_id(); b.st = st;
    if (threadIdx.x == 0) (void)xb_add(&bar[XB_XCNT(b.x)], 1u);
    return b;
}
__device__ __forceinline__ void xcd_barrier_complete(unsigned* bar, unsigned x, unsigned& nloc, unsigned& nx) {
    const unsigned G = gridDim.x * gridDim.y * gridDim.z;
    unsigned sum, cnt, mine, sp = 0u;
    for (;;) {
        sum = 0u; cnt = 0u; mine = 0u;
#pragma unroll
        for (unsigned j = 0; j < 16; ++j) { const unsigned c = xb_ld(&bar[XB_XCNT(j)]); sum += c; cnt += (c > 0u) ? 1u : 0u; mine = (j == x) ? c : mine; }
        if (sum == G) break;
        __builtin_amdgcn_s_sleep(1);
        if ((++sp & 255u) == 0u) { if (xb_ld(&bar[XB_TMO])) break; if (sp > XB_SPIN_CAP) { atomicAdd(&bar[XB_TMO], 1u); break; } }
    }
    nloc = mine > 0u ? mine : 1u; nx = cnt > 0u ? cnt : 1u;
}
__device__ __forceinline__ void xcd_barrier(const XcdBarrier& b, int wave) {
    asm volatile("s_waitcnt vmcnt(0)" ::: "memory");
    __syncthreads();
    if (wave == 0 && lane_id_v() == 0) {
        unsigned* bar = b.bar;
        __builtin_amdgcn_s_waitcnt(0);
        unsigned nloc = b.st[0], nx = b.st[1];
        if (nloc == 0u) { xcd_barrier_complete(bar, b.x, nloc, nx); b.st[0] = nloc; b.st[1] = nx; }
        const unsigned old = xb_add(&bar[XB_XSUB(b.x)], 1u);
        const unsigned gen = old / nloc;
        if (old + 1u == (gen + 1u) * nloc) {
            __builtin_amdgcn_fence(__ATOMIC_RELEASE, "agent");
            asm volatile("s_waitcnt vmcnt(0)" ::: "memory");
            const unsigned og = xb_add(&bar[XB_TOP], 1u);
            const unsigned tg = og / nx;
            if (og + 1u == (tg + 1u) * nx) xb_add(&bar[XB_TOPGEN], 1u);
            else XB_SPIN(xb_ld(&bar[XB_TOPGEN]) == tg, bar);
            __builtin_amdgcn_fence(__ATOMIC_ACQUIRE, "agent");
            xb_add(&bar[XB_XGEN(b.x)], 1u);
            asm volatile("s_waitcnt vmcnt(0)" ::: "memory");
        } else {
            XB_SPIN(xb_ld(&bar[XB_XGEN(b.x)]) == gen, bar);
            __builtin_amdgcn_fence(__ATOMIC_ACQUIRE, "agent");
            asm volatile("s_waitcnt vmcnt(0)" ::: "memory");
        }
    }
    __syncthreads();
}

struct Args { const float* in[28]; float* out; unsigned char* ws; int ph_lo, ph_hi; };
enum { I_X = 0, I_C, I_POS, I_WADA, I_BADA, I_N1G, I_WIN, I_QAG, I_WUQ, I_KVAG, I_WUKV, I_QNG, I_KNG, I_WOA, I_CONVW, I_CONVB, I_WRG, I_BRG, I_WIG, I_BIG, I_LAM, I_WOL, I_WOUT, I_N2G, I_WQ, I_SUBK, I_EU, I_EV };
constexpr int N_PHASES = 17;

struct Ctx {
    LAS unsigned char* lds;
    int tid, lane, wave, vcu, G;
    const float* const* in; float* out; unsigned char* ws;
};
#define WSP(type, off) ((type*)(c.ws + (off)))

template <class F>
__device__ __forceinline__ void tr_tile(const Ctx& c, bf16_t* dst, int K, int n0, int k0, F f) {
    LAS float* scr = (LAS float*)c.lds;
#pragma unroll
    for (int i = 0; i < 8; ++i) { const int kk = i * 8 + (c.tid >> 6), nn = c.tid & 63; scr[kk * 65 + nn] = f(k0 + kk, n0 + nn); }
    __syncthreads();
    { const int kc = c.tid & 7, nn = c.tid >> 3;
      LAS const float* s = scr + (8 * kc) * 65 + nn;
      u32x4 o; o.x = pk2(s[0], s[65]); o.y = pk2(s[2 * 65], s[3 * 65]); o.z = pk2(s[4 * 65], s[5 * 65]); o.w = pk2(s[6 * 65], s[7 * 65]);
      *(u32x4*)(dst + (size_t)(n0 + nn) * K + k0 + 8 * kc) = o; }
    __syncthreads();
}

template <class F>
__device__ __forceinline__ void tr_tile_wave(LAS float* scr, int L, bf16_t* dst, int K, int n0, int k0, F f) {
#pragma unroll 16
    for (int kk = 0; kk < 64; ++kk) scr[kk * 65 + L] = f(k0 + kk, n0 + L);
    asm volatile("s_waitcnt lgkmcnt(0)" ::: "memory");
    const int kc = L & 7;
#pragma unroll
    for (int j = 0; j < 8; ++j) { const int nn = (L >> 3) + 8 * j; LAS const float* s = scr + (8 * kc) * 65 + nn;
        u32x4 o; o.x = pk2(s[0], s[65]); o.y = pk2(s[2 * 65], s[3 * 65]); o.z = pk2(s[4 * 65], s[5 * 65]); o.w = pk2(s[6 * 65], s[7 * 65]);
        *(u32x4*)(dst + (size_t)(n0 + nn) * K + k0 + 8 * kc) = o; }
    asm volatile("s_waitcnt lgkmcnt(0)" ::: "memory");
}
__device__ __forceinline__ void phase_prep(const Ctx& c0) {
    Ctx c = c0; c.lane = lane_id_v(); c.tid = c.wave * 64 + c.lane;
    const float* w_in = c.in[I_WIN]; const float* w_uq = c.in[I_WUQ]; const float* qag = c.in[I_QAG]; const float* w_ukv = c.in[I_WUKV]; const float* kvag = c.in[I_KVAG];
    const float* w_oa = c.in[I_WOA]; const float* w_ol = c.in[I_WOL]; const float* w_out = c.in[I_WOUT]; const float* w_q = c.in[I_WQ];
    const float* w_rg = c.in[I_WRG]; const float* w_ig = c.in[I_WIG];
    constexpr int T_WIN = 72 * 16, T_WUQ = 12 * 4, T_WUKV = 16 * 2, T_WOA = 16 * 8, T_WOL = 16 * 16, T_WOUT = 16 * 16, T_WQ = 32 * 16, T_WG = 8 * 4 * 2;
    constexpr int T_WAVE = T_WIN + T_WUQ + T_WUKV + T_WOA + T_WOL + T_WOUT + T_WG;
    { LAS float* scr = (LAS float*)(c.lds + (c.wave < 7 ? c.wave * 16640 : 131584)); const int L = c.lane;
      static_assert(7 * 16640 <= 131072 && 131584 + 16640 <= LDS_BYTES && 131584 >= MISC_OFF + 128, "prep LDS tiles");
      for (int it = c.vcu * 8 + c.wave; it < T_WAVE; it += c.G * 8) {
        int r = it;
        if (r < T_WIN) { const int nb = r / 16, kb = r % 16;
            tr_tile_wave(scr, L, WSP(bf16_t, WS_WIN), 1024, nb * 64, kb * 64, [=](int k, int n) -> float { return n < 416 ? w_in[(size_t)k * 4512 + n] : (n < 512 ? 0.f : w_in[(size_t)k * 4512 + n - 96]); }); continue; }
        r -= T_WIN;
        if (r < T_WUQ) { const int nb = r / 4, kb = r % 4;
            tr_tile_wave(scr, L, WSP(bf16_t, WS_WUQ), 256, nb * 64, kb * 64, [=](int k, int n) -> float { return w_uq[(size_t)k * 768 + n] * qag[k]; }); continue; }
        r -= T_WUQ;
        if (r < T_WUKV) { const int nb = r / 2, kb = r % 2;
            tr_tile_wave(scr, L, WSP(bf16_t, WS_WUKV), 128, nb * 64, kb * 64, [=](int k, int n) -> float { return w_ukv[(size_t)k * 1024 + n] * kvag[k]; }); continue; }
        r -= T_WUKV;
        if (r < T_WOA) { const int nb = r / 8, kb = r % 8;
            tr_tile_wave(scr, L, WSP(bf16_t, WS_WOA), 512, nb * 64, kb * 64, [=](int k, int n) -> float { return w_oa[(size_t)k * 1024 + n]; }); continue; }
        r -= T_WOA;
        if (r < T_WOL) { const int nb = r / 16, kb = r % 16;
            tr_tile_wave(scr, L, WSP(bf16_t, WS_WOL), 1024, nb * 64, kb * 64, [=](int k, int n) -> float { return w_ol[(size_t)k * 1024 + n]; }); continue; }
        r -= T_WOL;
        if (r < T_WOUT) { const int nb = r / 16, kb = r % 16;
            tr_tile_wave(scr, L, WSP(bf16_t, WS_WOUT), 1024, nb * 64, kb * 64, [=](int k, int n) -> float { return w_out[(size_t)k * 1024 + n]; }); continue; }
        r -= T_WOUT;
        { const int blk = r / 8, q = r % 8, nb = q / 2, kb = q % 2;
            tr_tile_wave(scr, L, WSP(bf16_t, WS_WG) + (size_t)blk * 256 * 128, 128, nb * 64, kb * 64,
                    [=](int k, int n) -> float { return n < 128 ? w_rg[((size_t)blk * 128 + k) * 128 + n] : w_ig[((size_t)blk * 128 + k) * 128 + n - 128]; }); }
      } }
    __syncthreads();
    for (int r = c.vcu; r < T_WQ; r += c.G) {
        const int nb = r / 16, kb = r % 16;
        const int slot = nb >> 1, n0 = (nb & 1) * 64, k0 = kb * 64;
        LAS float* wq_s = (LAS float*)(c.lds + 32768);
        LAS float* sk_s = (LAS float*)(c.lds + 32768 + 64 * 129 * 4);
        const float* skp = c.in[I_SUBK] + ((size_t)slot * 128 + n0) * 128;
        for (int e = c.tid; e < 64 * 128; e += 512) { const int rr = e >> 7, cc = e & 127; wq_s[rr * 129 + cc] = w_q[(size_t)(k0 + rr) * 2048 + slot * 128 + cc]; sk_s[rr * 129 + cc] = skp[(size_t)rr * 128 + cc]; }
        __syncthreads();
        tr_tile(c, WSP(bf16_t, WS_WQ), 1024, nb * 64, k0, [=](int k, int n) -> float { const LAS float* a = wq_s + (k - k0) * 129; const LAS float* b = sk_s + (n - nb * 64) * 129; float s = 0.f;
#pragma unroll 16
            for (int d = 0; d < 128; ++d) s += a[d] * b[d];
            return s; });
    }
    { const float* lam = c.in[I_LAM]; float* t8 = WSP(float, WS_C8SP);
      if (c.vcu == 0) for (int e = c.tid; e < 1024; e += 512) t8[e] = -8.f * log1pf(__expf(-lam[e])); }
    if (c.vcu == 0 && c.tid == 0) {
        const unsigned probe = __builtin_amdgcn_cvt_scalef32_pk_fp4_f32(0u, 1.0f, 0.0f, 1.0f, 0) & 0xffu;
        WSP(unsigned, WS_C8SP)[1024] = (probe == 0x02u) ? 0u : 1u; }
    { const int gw = c.vcu * 8 + c.wave, NGW = c.G * 8, L = c.lane;
      f32x4 vn[4];
      if (gw < 2 * NE) { const f32x4* s4 = (const f32x4*)((gw >= NE ? c.in[I_EV] : c.in[I_EU]) + (size_t)(gw >= NE ? gw - NE : gw) * 1024 + 16 * L);
#pragma unroll
          for (int j = 0; j < 4; ++j) vn[j] = s4[j]; }
#pragma unroll 1
      for (int r = gw; r < 2 * NE; r += NGW) {
          const int isv = r >= NE, e = isv ? r - NE : r;
          f32x4 v[4]; float am = 0.f;
#pragma unroll
          for (int j = 0; j < 4; ++j) { v[j] = vn[j]; am = fmaxf(am, fmaxf(fmaxf(fabsf(v[j].x), fabsf(v[j].y)), fmaxf(fabsf(v[j].z), fabsf(v[j].w)))); }
          { const int rn = (r + NGW < 2 * NE) ? r + NGW : r; const f32x4* s4 = (const f32x4*)((rn >= NE ? c.in[I_EV] : c.in[I_EU]) + (size_t)(rn >= NE ? rn - NE : rn) * 1024 + 16 * L);
#pragma unroll
            for (int j = 0; j < 4; ++j) vn[j] = s4[j]; }
#pragma unroll
          for (int o = 1; o < 64; o <<= 1) am = fmaxf(am, __shfl_xor(am, o));
          const float s = am > 0.f ? am * (1.f / 6.f) : 1.f, inv = 1.f / s;
          unsigned w0 = 0u, w1 = 0u;
          w0 = __builtin_amdgcn_cvt_scalef32_pk_fp4_f32(w0, v[0].x * inv, v[0].y * inv, 1.0f, 0); w0 = __builtin_amdgcn_cvt_scalef32_pk_fp4_f32(w0, v[0].z * inv, v[0].w * inv, 1.0f, 1);
          w0 = __builtin_amdgcn_cvt_scalef32_pk_fp4_f32(w0, v[1].x * inv, v[1].y * inv, 1.0f, 2); w0 = __builtin_amdgcn_cvt_scalef32_pk_fp4_f32(w0, v[1].z * inv, v[1].w * inv, 1.0f, 3);
          w1 = __builtin_amdgcn_cvt_scalef32_pk_fp4_f32(w1, v[2].x * inv, v[2].y * inv, 1.0f, 0); w1 = __builtin_amdgcn_cvt_scalef32_pk_fp4_f32(w1, v[2].z * inv, v[2].w * inv, 1.0f, 1);
          w1 = __builtin_amdgcn_cvt_scalef32_pk_fp4_f32(w1, v[3].x * inv, v[3].y * inv, 1.0f, 2); w1 = __builtin_amdgcn_cvt_scalef32_pk_fp4_f32(w1, v[3].z * inv, v[3].w * inv, 1.0f, 3);
          u32x2 q; q.x = w0; q.y = w1;
          *(u32x2*)(c.ws + (isv ? WS_EV : WS_EU) + ((size_t)(L >> 4) * NE + e) * 128 + (L & 15) * 8) = q;
          if (L == 0) WSP(float, isv ? WS_SV : WS_SU)[e] = s;
      } }
    { const float* cin = c.in[I_C]; const float* w_ada = c.in[I_WADA]; const float* b_ada = c.in[I_BADA]; float* mod = WSP(float, WS_MOD);
      LAS float* cs = (LAS float*)c.lds;
      LAS float* red = (LAS float*)(c.lds + 65536);
      bool have = false;
      for (int it = c.vcu; it < 192; it += c.G) {
          if (!have) { for (int e = c.tid; e < 16 * 1024; e += 512) { const float v = cin[e]; cs[e] = v / (1.f + __expf(-v)); } have = true; }
          __syncthreads();
          const int cl = c.tid & 31, ks = c.tid >> 5, j = it * 32 + cl;
          float acc[16];
#pragma unroll
          for (int b = 0; b < 16; ++b) acc[b] = 0.f;
          for (int kk = 0; kk < 64; ++kk) { const int k = ks * 64 + kk; const float w = w_ada[(size_t)k * 6144 + j];
#pragma unroll
              for (int b = 0; b < 16; ++b) acc[b] += cs[b * 1024 + k] * w; }
#pragma unroll
          for (int b = 0; b < 16; ++b) red[(ks * 16 + b) * 32 + cl] = acc[b];
          __syncthreads();
          { const int b = c.tid >> 5; float s = b_ada[j];
#pragma unroll
            for (int k2 = 0; k2 < 16; ++k2) s += red[(k2 * 16 + b) * 32 + cl];
            mod[b * 6144 + j] = s; }
          __syncthreads();
      } }
}

template <bool Q8>
__device__ __forceinline__ void phase_modnorm(const Ctx& c0, const float* x, const float* g, int shift_off, int scale_off, bf16_t* dst) {
    Ctx c = c0; c.lane = lane_id_v(); c.tid = c.wave * 64 + c.lane;
    const float* mod = WSP(float, WS_MOD);
    const int gw = c.vcu * 8 + c.wave, NGW = c.G * 8;
    if (gw >= T) return;
    f32x4 vn[4];
    { const f32x4* xr = (const f32x4*)(x + (size_t)gw * D) + c.lane;
#pragma unroll
      for (int j = 0; j < 4; ++j) vn[j] = xr[64 * j]; }
#pragma unroll 1
    for (int m = gw; m < T; m += NGW) {
        const int b = m >> 11;
        f32x4 v[4]; float s = 0.f;
#pragma unroll
        for (int j = 0; j < 4; ++j) { v[j] = vn[j]; s += (v[j].x * v[j].x + v[j].y * v[j].y) + (v[j].z * v[j].z + v[j].w * v[j].w); }
        { const int mn = (m + NGW < T) ? m + NGW : m; const f32x4* xr = (const f32x4*)(x + (size_t)mn * D) + c.lane;
#pragma unroll
          for (int j = 0; j < 4; ++j) vn[j] = xr[64 * j]; }
        const float rstd = rsqrtf(wave_sum(s) * (1.f / D) + EPS);
        u32x2* o8 = (u32x2*)(dst + (size_t)m * D) + c.lane;
        float am = 0.f;
#pragma unroll
        for (int j = 0; j < 4; ++j) {
            const int col = 4 * c.lane + 256 * j;
            const f32x4 gg = *(const f32x4*)(g + col), sc = *(const f32x4*)(mod + b * 6144 + scale_off + col), sh = *(const f32x4*)(mod + b * 6144 + shift_off + col);
            const float r0 = v[j].x * rstd * gg.x * (1.f + sc.x) + sh.x, r1 = v[j].y * rstd * gg.y * (1.f + sc.y) + sh.y;
            const float r2 = v[j].z * rstd * gg.z * (1.f + sc.z) + sh.z, r3 = v[j].w * rstd * gg.w * (1.f + sc.w) + sh.w;
            u32x2 w; w.x = pk2(r0, r1); w.y = pk2(r2, r3); o8[64 * j] = w;
            if (Q8) { v[j].x = r0; v[j].y = r1; v[j].z = r2; v[j].w = r3; am = fmaxf(am, fmaxf(fmaxf(fabsf(r0), fabsf(r1)), fmaxf(fabsf(r2), fabsf(r3)))); }
        }
        if (Q8) {
#pragma unroll
            for (int o = 1; o < 64; o <<= 1) am = fmaxf(am, __shfl_xor(am, o));
            const float sq = am > 0.f ? am * (1.f / 256.f) : 1.f, inv = 1.f / sq;
            unsigned* q8 = (unsigned*)(c.ws + WS_H2Q + (size_t)m * D) + c.lane;
#pragma unroll
            for (int j = 0; j < 4; ++j) { int w = __builtin_amdgcn_cvt_pk_fp8_f32(v[j].x * inv, v[j].y * inv, 0, false); w = __builtin_amdgcn_cvt_pk_fp8_f32(v[j].z * inv, v[j].w * inv, w, true); q8[64 * j] = (unsigned)w; }
            if (c.lane == 0) WSP(float, WS_SH)[m] = sq;
        }
    }
}

__device__ __forceinline__ void phase_conv(const Ctx& c0) {
    Ctx c = c0; c.lane = lane_id_v(); c.tid = c.wave * 64 + c.lane;
    const bf16_t* pa = WSP(bf16_t, WS_R1); const bf16_t* lx = WSP(bf16_t, WS_R2); bf16_t* xc = WSP(bf16_t, WS_R4); float* rstd = WSP(float, WS_RSTD);
    const float* cw = c.in[I_CONVW]; const float* cb = c.in[I_CONVB];
    const int gt = c.vcu * 512 + c.tid, NT = c.G * 512;
    { const int gw = c.vcu * 8 + c.wave, NGW = c.G * 8, L = c.lane;
      for (int t = gw; t < T; t += NGW) {
          float ss = 0.f;
          if (L < 48) { float v[8]; unpack8(*(const u32x4*)(pa + (size_t)t * 512 + 8 * L), v);
#pragma unroll
              for (int j = 0; j < 8; ++j) ss += v[j] * v[j]; }
          const float sq = wave_sum(L < 32 ? ss : 0.f), skv = wave_sum(L >= 32 ? ss : 0.f);
          if (L == 0) { rstd[2 * t] = rsqrtf(sq * (1.f / 256.f) + EPS); rstd[2 * t + 1] = rsqrtf(skv * (1.f / 128.f) + EPS); }
      } }
    { const int* pos = (const int*)c.in[I_POS]; float* CS = WSP(float, WS_CS);
      for (int e = gt; e < T * 16; e += NT) {
          const int t = e >> 4, jj = e & 15;
          const float invf = exp2f(-(float)jj * (13.287712379549449f / 16.f));
          const float ang = (float)pos[t] * invf; const float n = rintf(ang * 0.15915494309189535f);
          const float red = (float)((double)ang - (double)n * 6.283185307179586);
          CS[(size_t)t * 32 + jj] = __cosf(red); CS[(size_t)t * 32 + 16 + jj] = __sinf(red);
      } }
    {
        const int ch = (gt & 127) * 8;
        f32x4 wv[4][2]; f32x4 bv[2];
#pragma unroll
        for (int j = 0; j < 4; ++j) { wv[j][0] = *(const f32x4*)(cw + j * 1024 + ch); wv[j][1] = *(const f32x4*)(cw + j * 1024 + ch + 4); }
        bv[0] = *(const f32x4*)(cb + ch); bv[1] = *(const f32x4*)(cb + ch + 4);
        const int tstep = NT >> 7;
        for (int tq = gt >> 7; tq < T; tq += 4 * tstep) {
            u32x4 raw[4][4];
#pragma unroll
            for (int u = 0; u < 4; ++u) { const int t = tq + u * tstep; const int s = t & 2047;
#pragma unroll
                for (int j = 0; j < 4; ++j) { raw[u][j] = (u32x4){0u, 0u, 0u, 0u}; if (t < T && s - 3 + j >= 0) raw[u][j] = *(const u32x4*)(lx + (size_t)(t - 3 + j) * 1024 + ch); } }
#pragma unroll
            for (int u = 0; u < 4; ++u) { const int t = tq + u * tstep;
                float acc[8] = {bv[0].x, bv[0].y, bv[0].z, bv[0].w, bv[1].x, bv[1].y, bv[1].z, bv[1].w};
#pragma unroll
                for (int j = 0; j < 4; ++j) { float v[8]; unpack8(raw[u][j], v);
                    acc[0] += wv[j][0].x * v[0]; acc[1] += wv[j][0].y * v[1]; acc[2] += wv[j][0].z * v[2]; acc[3] += wv[j][0].w * v[3];
                    acc[4] += wv[j][1].x * v[4]; acc[5] += wv[j][1].y * v[5]; acc[6] += wv[j][1].z * v[6]; acc[7] += wv[j][1].w * v[7]; }
                if (t < T) *(u32x4*)(xc + (size_t)t * 1024 + ch) = pack8(acc); }
        }
    }
}

__device__ __forceinline__ void phase_scan(const Ctx& c0) {
    Ctx c = c0; c.lane = lane_id_v(); c.tid = c.wave * 64 + c.lane;
    const bf16_t* LA = WSP(bf16_t, WS_R0); bf16_t* Bv = WSP(bf16_t, WS_R6); const bf16_t* gate = WSP(bf16_t, WS_R3);
    LAS float* Ps = (LAS float*)c.lds; LAS float* Hs = Ps + 512;
    for (int it = c.vcu; it < 256; it += c.G) {
        const int b = it >> 4, cg = it & 15, seg = c.tid >> 6, ch = cg * 64 + (c.tid & 63);
        const size_t base = ((size_t)b * 2048 + seg * 256) * 1024 + ch;
        float P = 1.f, Hl = 0.f;
#pragma unroll 1
        for (int i0 = 0; i0 < 256; i0 += 16) {
            unsigned la[16], bv[16];
#pragma unroll
            for (int i = 0; i < 16; ++i) { la[i] = LA[base + (size_t)(i0 + i) * 1024]; bv[i] = Bv[base + (size_t)(i0 + i) * 1024]; }
#pragma unroll
            for (int i = 0; i < 16; ++i) { const float a = __builtin_amdgcn_exp2f(bf2f(la[i])); Hl = a * Hl + bf2f(bv[i]); P *= a; }
        }
        Ps[c.tid] = P; Hs[c.tid] = Hl;
        __syncthreads();
        float h = 0.f;
        for (int s2 = 0; s2 < seg; ++s2) h = Ps[s2 * 64 + (c.tid & 63)] * h + Hs[s2 * 64 + (c.tid & 63)];
#pragma unroll 1
        for (int i0 = 0; i0 < 256; i0 += 16) {
            unsigned la[16], bv[16], gv[16]; unsigned ov[16];
#pragma unroll
            for (int i = 0; i < 16; ++i) { la[i] = LA[base + (size_t)(i0 + i) * 1024]; bv[i] = Bv[base + (size_t)(i0 + i) * 1024]; gv[i] = gate[base + (size_t)(i0 + i) * 1024]; }
#pragma unroll
            for (int i = 0; i < 16; ++i) { const float a = __builtin_amdgcn_exp2f(bf2f(la[i])); h = a * h + bf2f(bv[i]); ov[i] = f2bf(h * gelu_tanh(bf2f(gv[i]))); }
#pragma unroll
            for (int i = 0; i < 16; ++i) Bv[base + (size_t)(i0 + i) * 1024] = (bf16_t)ov[i];
        }
        __syncthreads();
    }
}

struct QkvRaw { u32x4 k[2]; f32x4 cs[4]; };
__device__ __forceinline__ void qkv_load(QkvRaw& r, const bf16_t* kvraw, const bf16_t* pa, const float* CS, int t, int ch, int hq) {
    const bool act = ch < 12;
#pragma unroll
    for (int pass = 0; pass < 2; ++pass) { const int h = pass * 4 + hq;
        r.k[pass] = (u32x4){0u, 0u, 0u, 0u};
        if (ch < 8) r.k[pass] = *(const u32x4*)(kvraw + (size_t)t * 1024 + h * 128 + 8 * ch);
        else if (act) r.k[pass] = *(const u32x4*)(pa + (size_t)t * 512 + 384 + 8 * (ch - 8)); }
    const float* cp = CS + (size_t)t * 32 + 8 * (ch & 1);
    r.cs[0] = *(const f32x4*)cp; r.cs[1] = *(const f32x4*)(cp + 4); r.cs[2] = *(const f32x4*)(cp + 16); r.cs[3] = *(const f32x4*)(cp + 20);
}
__device__ __forceinline__ void phase_qkv_layout(const Ctx& c0) {
    Ctx c = c0; c.lane = lane_id_v(); c.tid = c.wave * 64 + c.lane;
    const bf16_t* kvraw = WSP(bf16_t, WS_R2); const bf16_t* pa = WSP(bf16_t, WS_R1);
    bf16_t* Kh = WSP(bf16_t, WS_R3);
    const float* kng = c.in[I_KNG]; const float* CS = WSP(float, WS_CS);
    const int gw = c.vcu * 8 + c.wave, NGW = c.G * 8, L = c.lane;
    const int ch = L & 15, hq = L >> 4;
    const bool act = ch < 12, isr = ch >= 8, hi2 = ch >= 10;
    float gk[8];
#pragma unroll
    for (int j = 0; j < 8; ++j) gk[j] = act ? kng[8 * ch + j] : 0.f;
    if (gw >= T) return;
    QkvRaw cur, nxt;
    qkv_load(cur, kvraw, pa, CS, gw, ch, hq);
#pragma unroll 1
    for (int t = gw; t < T; t += NGW) {
        qkv_load(nxt, kvraw, pa, CS, (t + NGW < T) ? t + NGW : t, ch, hq);
        const int b = t >> 11, s = t & 2047;
        const float cs[8] = {cur.cs[0].x, cur.cs[0].y, cur.cs[0].z, cur.cs[0].w, cur.cs[1].x, cur.cs[1].y, cur.cs[1].z, cur.cs[1].w};
        const float sn[8] = {cur.cs[2].x, cur.cs[2].y, cur.cs[2].z, cur.cs[2].w, cur.cs[3].x, cur.cs[3].y, cur.cs[3].z, cur.cs[3].w};
#pragma unroll
        for (int pass = 0; pass < 2; ++pass) {
            const int h = pass * 4 + hq;
            const size_t orow = ((size_t)(b * H + h) * S + s);
            float v[8]; unpack8(cur.k[pass], v);
            float ss = 0.f;
#pragma unroll
            for (int j = 0; j < 8; ++j) ss += v[j] * v[j];
#pragma unroll
            for (int o = 1; o < 16; o <<= 1) ss += __shfl_xor(ss, o);
            const float r = rsqrtf(ss * (1.f / 96.f) + EPS);
            float x[8], o8[8];
#pragma unroll
            for (int j = 0; j < 8; ++j) x[j] = v[j] * r * gk[j];
#pragma unroll
            for (int j = 0; j < 8; ++j) { const float px = __shfl_xor(x[j], 2);
                o8[j] = !isr ? x[j] : (hi2 ? px * sn[j] + x[j] * cs[j] : x[j] * cs[j] - px * sn[j]); }
            if (act) *(u32x4*)(Kh + orow * 96 + 8 * ch) = pack8(o8);
        }
        cur = nxt;
    }
}

constexpr int KROW = 208, VROW = 160;
constexpr int KBUF = 128 * KROW, VBUF = 128 * VROW;
typedef short v4i16_t __attribute__((ext_vector_type(4)));
__device__ __forceinline__ void attn_chunk2(LAS unsigned char* kb, LAS unsigned char* vb, const bf16x8 (&qf)[2][3], f32x4 (&o)[2][4], float (&mrun)[2], float (&lrun)[2], int fr, int g) {
    f32x4 sacc[2][4];
#pragma unroll
    for (int kt = 0; kt < 4; ++kt) { sacc[0][kt] = (f32x4){0.f, 0.f, 0.f, 0.f}; sacc[1][kt] = (f32x4){0.f, 0.f, 0.f, 0.f};
#pragma unroll
        for (int ks = 0; ks < 3; ++ks) { const bf16x8 kf = *(const LAS bf16x8*)(kb + (16 * kt + fr) * KROW + (ks * 32 + g * 8) * 2);
            sacc[0][kt] = __builtin_amdgcn_mfma_f32_16x16x32_bf16(kf, qf[0][ks], sacc[0][kt], 0, 0, 0);
            sacc[1][kt] = __builtin_amdgcn_mfma_f32_16x16x32_bf16(kf, qf[1][ks], sacc[1][kt], 0, 0, 0); } }
    bf16x8 pb[2][2];
#pragma unroll
    for (int t = 0; t < 2; ++t) {
        float mx = sacc[t][0][0];
#pragma unroll
        for (int kt = 0; kt < 4; ++kt)
#pragma unroll
            for (int r = 0; r < 4; ++r) mx = fmaxf(mx, sacc[t][kt][r]);
        mx = fmaxf(mx, __shfl_xor(mx, 16)); mx = fmaxf(mx, __shfl_xor(mx, 32));
        const float mnew = fmaxf(mrun[t], mx), alpha = __builtin_amdgcn_exp2f(mrun[t] - mnew); mrun[t] = mnew;
        float ps = 0.f;
#pragma unroll
        for (int kt = 0; kt < 4; ++kt)
#pragma unroll
            for (int r = 0; r < 4; ++r) { const float p = __builtin_amdgcn_exp2f(sacc[t][kt][r] - mnew); sacc[t][kt][r] = p; ps += p; }
        lrun[t] = lrun[t] * alpha + ps;
#pragma unroll
        for (int dt = 0; dt < 4; ++dt) o[t][dt] = o[t][dt] * alpha;
#pragma unroll
        for (int s2 = 0; s2 < 2; ++s2) { u32x4 pw; pw.x = pk2(sacc[t][2 * s2][0], sacc[t][2 * s2][1]); pw.y = pk2(sacc[t][2 * s2][2], sacc[t][2 * s2][3]); pw.z = pk2(sacc[t][2 * s2 + 1][0], sacc[t][2 * s2 + 1][1]); pw.w = pk2(sacc[t][2 * s2 + 1][2], sacc[t][2 * s2 + 1][3]);
            pb[t][s2] = __builtin_bit_cast(bf16x8, pw); }
    }
#pragma unroll
    for (int s2 = 0; s2 < 2; ++s2)
#pragma unroll
        for (int dt = 0; dt < 4; ++dt) {
            LAS unsigned char* va = vb + (32 * s2 + 4 * g + (fr >> 2)) * VROW + (16 * dt + 4 * (fr & 3)) * 2;
            const v4i16_t t0 = __builtin_amdgcn_ds_read_tr16_b64_v4i16((LAS v4i16_t*)va), t1 = __builtin_amdgcn_ds_read_tr16_b64_v4i16((LAS v4i16_t*)(va + 16 * VROW));
            const bf16x8 vf = (bf16x8){t0[0], t0[1], t0[2], t0[3], t1[0], t1[1], t1[2], t1[3]};
            o[0][dt] = __builtin_amdgcn_mfma_f32_16x16x32_bf16(vf, pb[0][s2], o[0][dt], 0, 0, 0);
            o[1][dt] = __builtin_amdgcn_mfma_f32_16x16x32_bf16(vf, pb[1][s2], o[1][dt], 0, 0, 0); }
}
__device__ __forceinline__ void attn_unit(const Ctx& c, int b, int h, int qb) {
    const bf16_t* qraw = WSP(bf16_t, WS_R5); const bf16_t* Kh = WSP(bf16_t, WS_R3); const bf16_t* kvraw = WSP(bf16_t, WS_R2); bf16_t* AO = WSP(bf16_t, WS_R0 + 32 * MiB);
    const float* qng = c.in[I_QNG]; const float* CS = WSP(float, WS_CS);
    const int fr = c.lane & 15, g = c.lane >> 4, wid = c.wave;
    const size_t hb = (size_t)(b * H + h) * S;
    const int q0 = qb * 256 + wid * 32;
    const int nsup = 2 * qb + 2;
    const int nch = 4 * qb + (wid >> 1) + 1;
    bf16x8 qf[2][3];
    { const float qscale = 0.10206207261596577f * 1.4426950408889634f;
#pragma unroll
      for (int t = 0; t < 2; ++t) {
          const size_t tok = (size_t)b * S + q0 + 16 * t + fr;
          float v[3][8]; float ss = 0.f;
#pragma unroll
          for (int ks = 0; ks < 3; ++ks) { unpack8(*(const u32x4*)(qraw + tok * 768 + h * 96 + ks * 32 + g * 8), v[ks]);
#pragma unroll
              for (int j = 0; j < 8; ++j) ss += v[ks][j] * v[ks][j]; }
          ss += __shfl_xor(ss, 16); ss += __shfl_xor(ss, 32);
          const float r = rsqrtf(ss * (1.f / 96.f) + EPS) * qscale;
#pragma unroll
          for (int ks = 0; ks < 3; ++ks)
#pragma unroll
              for (int j = 0; j < 8; ++j) v[ks][j] *= r * qng[ks * 32 + g * 8 + j];
          { const float* cp = CS + tok * 32 + 8 * (g & 1);
            const f32x4 c0v = *(const f32x4*)cp, c1v = *(const f32x4*)(cp + 4), s0v = *(const f32x4*)(cp + 16), s1v = *(const f32x4*)(cp + 20);
            const float cs[8] = {c0v.x, c0v.y, c0v.z, c0v.w, c1v.x, c1v.y, c1v.z, c1v.w}, sn[8] = {s0v.x, s0v.y, s0v.z, s0v.w, s1v.x, s1v.y, s1v.z, s1v.w};
#pragma unroll
            for (int j = 0; j < 8; ++j) { const float px = __shfl_xor(v[2][j], 32); v[2][j] = (g >= 2) ? px * sn[j] + v[2][j] * cs[j] : v[2][j] * cs[j] - px * sn[j]; } }
#pragma unroll
          for (int ks = 0; ks < 3; ++ks) qf[t][ks] = __builtin_bit_cast(bf16x8, pack8(v[ks]));
      } }
    f32x4 o[2][4];
#pragma unroll
    for (int t = 0; t < 2; ++t)
#pragma unroll
        for (int dt = 0; dt < 4; ++dt) o[t][dt] = (f32x4){0.f, 0.f, 0.f, 0.f};
    float mrun[2] = {-1e30f, -1e30f}, lrun[2] = {0.f, 0.f};
    u32x4 kr[3], vr[2];
    const u32x4* Ksrc = (const u32x4*)(Kh + hb * 96);
    const bf16_t* Vsrc = kvraw + ((size_t)b * S) * 1024 + h * 128 + 64;
#pragma unroll
    for (int i = 0; i < 3; ++i) kr[i] = Ksrc[c.tid + 512 * i];
#pragma unroll
    for (int i = 0; i < 2; ++i) { const int vc = c.tid + 512 * i; vr[i] = *(const u32x4*)(Vsrc + (size_t)(vc >> 3) * 1024 + (vc & 7) * 8); }
    for (int j = 0; j < nsup; ++j) {
        LAS unsigned char* kb = c.lds + (j & 1) * (KBUF + VBUF); LAS unsigned char* vb = kb + KBUF;
#pragma unroll
        for (int i = 0; i < 3; ++i) { const int kc = c.tid + 512 * i; *(LAS u32x4*)(kb + (kc / 12) * KROW + (kc % 12) * 16) = kr[i]; }
#pragma unroll
        for (int i = 0; i < 2; ++i) { const int vc = c.tid + 512 * i; *(LAS u32x4*)(vb + (vc >> 3) * VROW + (vc & 7) * 16) = vr[i]; }
        __syncthreads();
        if (j + 1 < nsup) {
#pragma unroll
            for (int i = 0; i < 3; ++i) kr[i] = Ksrc[(j + 1) * 1536 + c.tid + 512 * i];
#pragma unroll
            for (int i = 0; i < 2; ++i) { const int vc = c.tid + 512 * i; vr[i] = *(const u32x4*)(Vsrc + (size_t)((j + 1) * 128 + (vc >> 3)) * 1024 + (vc & 7) * 8); }
        }
        if (2 * j < nch) attn_chunk2(kb, vb, qf, o, mrun, lrun, fr, g);
        if (2 * j + 1 < nch) attn_chunk2(kb + 64 * KROW, vb + 64 * VROW, qf, o, mrun, lrun, fr, g);
    }
#pragma unroll
    for (int t = 0; t < 2; ++t) {
        float lt = lrun[t] + __shfl_xor(lrun[t], 16); lt += __shfl_xor(lt, 32);
        const float inv = 1.f / lt;
        bf16_t* orow = AO + ((size_t)b * S + q0 + 16 * t + fr) * 512 + h * 64;
#pragma unroll
        for (int dt = 0; dt < 4; ++dt) { u32x2 w; w.x = pk2(o[t][dt][0] * inv, o[t][dt][1] * inv); w.y = pk2(o[t][dt][2] * inv, o[t][dt][3] * inv); *(u32x2*)(orow + 16 * dt + 4 * g) = w; }
    }
    __syncthreads();
}
__device__ __forceinline__ void phase_attn(const Ctx& c0) {
    Ctx c = c0; c.lane = lane_id_v(); c.tid = c.wave * 64 + c.lane;
    for (int v = c.vcu; v < 256; v += c.G) {
        const int bh = v >> 1, odd = v & 1;
        for (int i = 0; i < 4; ++i) {
            const int setA[4] = {7, 4, 3, 0}, setB[4] = {6, 5, 2, 1};
            int qb = 0;
#pragma unroll
            for (int k = 0; k < 4; ++k) if (k == i) qb = odd ? setB[k] : setA[k];
            attn_unit(c, bh >> 3, bh & 7, qb);
        }
    }
}

__device__ __forceinline__ float wave_max(float v) {
#pragma unroll
    for (int o = 1; o < 64; o <<= 1) v = fmaxf(v, __shfl_xor(v, o));
    return v;
}
__device__ __forceinline__ int wave_min_i(int v) {
#pragma unroll
    for (int o = 1; o < 64; o <<= 1) v = min(v, __shfl_xor(v, o));
    return v;
}
__device__ __forceinline__ int prefix_cnt(unsigned long long m) { return (int)__builtin_amdgcn_mbcnt_hi((unsigned)(m >> 32), __builtin_amdgcn_mbcnt_lo((unsigned)m, 0u)); }
template <int NV, int NBITS> __device__ __forceinline__ void select16(const unsigned (&key)[NV], int (&slot)[NV]) {
    unsigned tau = 0u;
    for (int bit = NBITS - 1; bit >= 0; --bit) {
        const unsigned trial = tau | (1u << bit); int cnt = 0;
#pragma unroll
        for (int j = 0; j < NV; ++j) cnt += __popcll(__ballot(key[j] >= trial));
        if (cnt >= 16) { tau = trial; if (cnt == 16) break; }
    }
    int base = 0;
#pragma unroll
    for (int j = 0; j < NV; ++j) { const unsigned long long m = __ballot(key[j] > tau); slot[j] = (key[j] > tau) ? base + prefix_cnt(m) : -1; base += __popcll(m); }
#pragma unroll
    for (int j = 0; j < NV; ++j) { const unsigned long long m = __ballot(key[j] == tau); if (key[j] == tau) { const int s = base + prefix_cnt(m); slot[j] = s < 16 ? s : -1; } base += __popcll(m); }
}
template <int N> __device__ __forceinline__ void bitonic_stage_desc(unsigned (&x)[N], int k, int j) {
#pragma unroll
    for (int i = 0; i < N; ++i) { const int l = i ^ j; if (l > i) { const bool asc = ((i & k) != 0);
        const unsigned a = x[i], b = x[l]; const unsigned hi = a > b ? a : b, lo = a > b ? b : a; x[i] = asc ? lo : hi; x[l] = asc ? hi : lo; } }
}
__device__ __forceinline__ void sort16_desc(unsigned (&x)[16]) {
#pragma unroll
    for (int k = 2; k <= 16; k <<= 1)
#pragma unroll
        for (int j = k >> 1; j > 0; j >>= 1) bitonic_stage_desc<16>(x, k, j);
}
__device__ __forceinline__ void merge16_desc(unsigned (&run)[16], const unsigned (&ch)[16]) {
#pragma unroll
    for (int i = 0; i < 16; ++i) run[i] = run[i] > ch[15 - i] ? run[i] : ch[15 - i];
#pragma unroll
    for (int j = 8; j > 0; j >>= 1) bitonic_stage_desc<16>(run, 16, j);
}
__device__ __forceinline__ unsigned mono_hi(unsigned w) { return w ^ ((unsigned)((int)w >> 31) | 0x80000000u); }
__device__ __forceinline__ float demono_hi(unsigned k) { const unsigned kk = k & 0xffff0000u; return __builtin_bit_cast(float, (kk ^ ((unsigned)(~(int)kk >> 31) | 0x80000000u)) & 0xffff0000u); }
__device__ __forceinline__ void top16_list(LAS const unsigned char* row, int sw, unsigned (&run)[16]) {
#pragma unroll
    for (int ck = 0; ck < 8; ++ck) {
        const u32x4 w0 = *(LAS const u32x4*)(row + (((2 * ck) ^ sw) << 4)), w1 = *(LAS const u32x4*)(row + (((2 * ck + 1) ^ sw) << 4));
        const unsigned w[8] = {w0.x, w0.y, w0.z, w0.w, w1.x, w1.y, w1.z, w1.w};
        unsigned ch[16];
#pragma unroll
        for (int i = 0; i < 8; ++i) { ch[2 * i] = (mono_hi(w[i] << 16) & 0xffff0000u) | (unsigned)(ck * 16 + 2 * i); ch[2 * i + 1] = (mono_hi(w[i]) & 0xffff0000u) | (unsigned)(ck * 16 + 2 * i + 1); }
        sort16_desc(ch);
        if (ck == 0) {
#pragma unroll
            for (int i = 0; i < 16; ++i) run[i] = ch[i];
        } else merge16_desc(run, ch);
    }
}
__device__ __forceinline__ void topk_fetch(const bf16_t* src, u32x4 (&r)[16], int L) {
#pragma unroll
    for (int i = 0; i < 16; ++i) r[i] = *(const u32x4*)(src + (size_t)(4 * i + (L >> 4)) * 256 + (L & 15) * 8);
}
__device__ __forceinline__ void topk_stage(LAS unsigned char* tile, const u32x4 (&r)[16], int L) {
#pragma unroll
    for (int i = 0; i < 16; ++i) { const int row = 4 * i + (L >> 4); *(LAS u32x4*)(tile + row * 256 + ((((L & 15) ^ (row & 15))) << 4)) = r[i]; }
}
__device__ __forceinline__ void phase_topk(const Ctx& c0) {
    Ctx c = c0; c.lane = lane_id_v(); c.tid = c.wave * 64 + c.lane;
    const bf16_t* sc = WSP(bf16_t, WS_SC); int* IDX = WSP(int, WS_IDX); float* GW = WSP(float, WS_GW);
    const int L = c.lane, gw0 = (c.vcu * 8 + c.wave) * 64, NL = c.G * 512;
    LAS unsigned char* tile = c.lds + c.wave * 16384;
    LAS const unsigned char* myrow = tile + L * 256; const int sw = L & 15;
    for (int eb = gw0; eb < T * H; eb += NL) {
        const int e = eb + L;
        unsigned ka[16], kb[16];
        u32x4 ra[16], rb[16];
        topk_fetch(sc + (size_t)eb * 256, ra, L);
        topk_fetch(sc + (size_t)eb * 256 + 128, rb, L);
        topk_stage(tile, ra, L);
        top16_list(myrow, sw, ka);
        topk_stage(tile, rb, L);
        top16_list(myrow, sw, kb);
        float sa[16], sb[16]; unsigned ia[16], ib[16];
#pragma unroll
        for (int i = 0; i < 16; ++i) { sa[i] = demono_hi(ka[i]); sb[i] = demono_hi(kb[i]); ia[i] = (ka[i] & 0x7fu) << 7; ib[i] = kb[i] & 0x7fu; }
        const float mx = sa[0] + sb[0];
        unsigned run[16], ch[16]; int n = 0, nc = 0;
#pragma unroll
        for (int a = 0; a < 16; ++a)
#pragma unroll
            for (int b = 0; b < 16; ++b) if ((a + 1) * (b + 1) <= 16) {
                const int k = 65535 + (int)((sa[a] + sb[b] - mx) * 1024.f);
                ch[n] = ((unsigned)(k < 0 ? 0 : k) << 16) | ia[a] | ib[b];
                if (++n == 16) { sort16_desc(ch); if (nc == 0) {
#pragma unroll
                        for (int i = 0; i < 16; ++i) run[i] = ch[i]; } else merge16_desc(run, ch);
                    n = 0; ++nc; }
            }
#pragma unroll
        for (int i = 2; i < 16; ++i) ch[i] = 0u;
        sort16_desc(ch); merge16_desc(run, ch);
        float ex[16]; float sum = 0.f;
#pragma unroll
        for (int i = 0; i < 16; ++i) { ex[i] = __expf((float)((int)(run[i] >> 16) - 65535) * (1.f / 1024.f)); sum += ex[i]; }
        const float inv = 1.f / sum;
        u32x4* oi = (u32x4*)(IDX + (size_t)e * 16); f32x4* og = (f32x4*)(GW + (size_t)e * 16);
#pragma unroll
        for (int q = 0; q < 4; ++q) { u32x4 vi; vi.x = run[4 * q] & 0x3fffu; vi.y = run[4 * q + 1] & 0x3fffu; vi.z = run[4 * q + 2] & 0x3fffu; vi.w = run[4 * q + 3] & 0x3fffu; oi[q] = vi;
            f32x4 vg; vg.x = ex[4 * q] * inv; vg.y = ex[4 * q + 1] * inv; vg.z = ex[4 * q + 2] * inv; vg.w = ex[4 * q + 3] * inv; og[q] = vg; }
    }
}

__device__ __forceinline__ void dec32_fp4(const u32x4 r, f32x2 (&f)[16]) {
    const unsigned w[4] = {r.x, r.y, r.z, r.w};
#pragma unroll
    for (int i = 0; i < 4; ++i) { f[4 * i] = __builtin_amdgcn_cvt_scalef32_pk_f32_fp4(w[i], 1.0f, 0); f[4 * i + 1] = __builtin_amdgcn_cvt_scalef32_pk_f32_fp4(w[i], 1.0f, 1);
        f[4 * i + 2] = __builtin_amdgcn_cvt_scalef32_pk_f32_fp4(w[i], 1.0f, 2); f[4 * i + 3] = __builtin_amdgcn_cvt_scalef32_pk_f32_fp4(w[i], 1.0f, 3); }
}
__device__ __forceinline__ float dot32_fp4(const f32x2 (&hv)[16], const u32x4 r) {
    f32x2 f[16]; dec32_fp4(r, f); f32x2 s = hv[0] * f[0];
#pragma unroll
    for (int j = 1; j < 16; ++j) s = s + hv[j] * f[j];
    return s.x + s.y;
}
typedef int i32x8 __attribute__((ext_vector_type(8)));
__device__ __forceinline__ void phase_peer_u(const Ctx& c0) {
    Ctx c = c0; c.lane = lane_id_v(); c.tid = c.wave * 64 + c.lane;
    const int* IDX = WSP(int, WS_IDX);
    const int L = c.lane, pp = blockIdx.x & 3, hh = (blockIdx.x >> 2) & 1, rank = blockIdx.x >> 3, nrank = c.G >> 3;
    LAS int* mb = (LAS int*)(c.lds + c.wave * 1024);
    const int vr = L & 15, g4 = L >> 4;
    const unsigned char* EU4b = c.ws + WS_EU + (size_t)pp * NE * 128;
    const unsigned char* H8 = c.ws + WS_H2Q + pp * 256 + (vr & 1) * 128 + g4 * 16;
    float* PD = WSP(float, WS_PD) + (size_t)(2 * pp + (vr & 1)) * T * 128 + 32 * g4;
    const int t0 = 2 * (rank * 8 + c.wave) + hh, ts = 2 * nrank * 8;
    if (t0 >= T) return;
    int sc1 = 0x7f7f7f7f; asm volatile("" : "+v"(sc1));
    const bool swapb = WSP(unsigned, WS_C8SP)[1024] != 0u;
    { const int g0 = IDX[(size_t)t0 * 128 + L], g1 = IDX[(size_t)t0 * 128 + 64 + L]; mb[L] = g0; mb[64 + L] = g1; }
    u32x4 rA[16], rB[16];
    { const unsigned char* EU4 = EU4b + (vr & 1) * 64 + g4 * 16;
#pragma unroll
      for (int G = 0; G < 16; ++G) rA[G] = *(const u32x4*)(EU4 + (size_t)mb[8 * G + (vr >> 1)] * 128); }
    int cur = 0;
#define PEER_U_TOKEN(RC, RN, tcur, tnext, tnext2) do { \
        int lo = (vr & 1) * 64 + g4 * 16; asm volatile("" : "+v"(lo)); const unsigned char* EU4 = EU4b + lo; \
        const int gn0 = IDX[(size_t)(tnext2) * 128 + L], gn1 = IDX[(size_t)(tnext2) * 128 + 64 + L]; \
        i32x8 hb = (i32x8){0, 0, 0, 0, 0, 0, 0, 0}; \
        if (vr < 2) { const u32x4 h0 = *(const u32x4*)(H8 + (size_t)(tcur) * 1024), h1 = *(const u32x4*)(H8 + (size_t)(tcur) * 1024 + 64); \
            unsigned hw[8] = {h0.x, h0.y, h0.z, h0.w, h1.x, h1.y, h1.z, h1.w}; \
            if (swapb) { _Pragma("unroll") for (int q = 0; q < 8; ++q) hw[q] = ((hw[q] & 0x00ff00ffu) << 8) | ((hw[q] >> 8) & 0x00ff00ffu); } \
            hb = (i32x8){(int)hw[0], (int)hw[1], (int)hw[2], (int)hw[3], (int)hw[4], (int)hw[5], (int)hw[6], (int)hw[7]}; } \
          \
        _Pragma("unroll") for (int G = 0; G < 16; ++G) RN[G] = *(const u32x4*)(EU4 + (size_t)mb[(cur ^ 1) * 128 + 8 * G + (vr >> 1)] * 128); \
          \
        mb[cur * 128 + L] = gn0; mb[cur * 128 + 64 + L] = gn1; \
        f32x4 acc[16]; \
        _Pragma("unroll") for (int G = 0; G < 16; ++G) { const i32x8 a = (i32x8){(int)RC[G].x, (int)RC[G].y, (int)RC[G].z, (int)RC[G].w, 0, 0, 0, 0}; \
            acc[G] = __builtin_amdgcn_mfma_scale_f32_16x16x128_f8f6f4(a, hb, (f32x4){0.f, 0.f, 0.f, 0.f}, 4, 0, 0, sc1, 0, sc1); } \
        if (vr < 2) { _Pragma("unroll") for (int G = 0; G < 16; G += 2) { f32x4 o; o.x = vr ? acc[G][1] : acc[G][0]; o.y = vr ? acc[G][3] : acc[G][2]; o.z = vr ? acc[G + 1][1] : acc[G + 1][0]; o.w = vr ? acc[G + 1][3] : acc[G + 1][2]; *(f32x4*)(PD + (size_t)(tcur) * 128 + 2 * G) = o; } } \
        cur ^= 1; } while (0)
    { const int t1 = (t0 + ts < T) ? t0 + ts : t0; const int g0 = IDX[(size_t)t1 * 128 + L], g1 = IDX[(size_t)t1 * 128 + 64 + L]; mb[128 + L] = g0; mb[128 + 64 + L] = g1; }
#pragma unroll 1
    for (int t = t0; t < T; t += 2 * ts) {
        const int ta = t, tb = (t + ts < T) ? t + ts : t, tc = (t + 2 * ts < T) ? t + 2 * ts : tb, td = (t + 3 * ts < T) ? t + 3 * ts : tc;
        PEER_U_TOKEN(rA, rB, ta, tb, tc);
        if (t + ts < T) PEER_U_TOKEN(rB, rA, tb, tc, td);
    }
#undef PEER_U_TOKEN
}
__device__ __forceinline__ void phase_peer_fin(const Ctx& c0) {
    Ctx c = c0; c.lane = lane_id_v(); c.tid = c.wave * 64 + c.lane;
    const int* IDX = WSP(int, WS_IDX); const float* GW = WSP(float, WS_GW); const float* PD = WSP(float, WS_PD); unsigned* WGT = WSP(unsigned, WS_WGT);
    const float* SU = WSP(float, WS_SU); const float* SV = WSP(float, WS_SV); const float* SH = WSP(float, WS_SH);
    const int NTH = c.G * 512;
    for (int i0 = c.vcu * 512 + c.tid; i0 < T * 128; i0 += 4 * NTH) {
        float d[4]; int e[4]; float g[4];
#pragma unroll
        for (int u = 0; u < 4; ++u) { const int i = (i0 + u * NTH < T * 128) ? i0 + u * NTH : i0; float s = 0.f;
            const int k = i & 127, pi = (i & ~127) + ((k >> 1) & 3) * 32 + (k >> 3) * 2 + (k & 1);
#pragma unroll
            for (int p = 0; p < 8; ++p) s += PD[(size_t)p * T * 128 + pi];
            d[u] = s; e[u] = IDX[i]; g[u] = GW[i]; }
        float su[4], sv[4], sh[4];
#pragma unroll
        for (int u = 0; u < 4; ++u) { const int i = (i0 + u * NTH < T * 128) ? i0 + u * NTH : i0; su[u] = SU[e[u]]; sv[u] = SV[e[u]]; sh[u] = SH[i >> 7]; }
#pragma unroll
        for (int u = 0; u < 4; ++u) { const int i = i0 + u * NTH; if (i < T * 128) WGT[i] = (f2bf(g[u] * gelu_tanh(d[u] * su[u] * sh[u]) * sv[u]) << 16) | (unsigned)e[u]; }
    }
}
template <bool DRY> __device__ __forceinline__ void phase_peer_v(const Ctx& c0) {
    Ctx c = c0; c.lane = lane_id_v(); c.tid = c.wave * 64 + c.lane;
    const unsigned* WI = WSP(unsigned, WS_WGT); const float* mod = WSP(float, WS_MOD);
    const int L = c.lane, pp = blockIdx.x & 3, hh = (blockIdx.x >> 2) & 1, rank = blockIdx.x >> 3, nrank = c.G >> 3;
    const bool b5 = L & 32, b4 = L & 16, b3 = L & 8;
    LAS unsigned* mb = (LAS unsigned*)(c.lds + c.wave * 1024);
    const int kl = L >> 3;
    const unsigned char* EV4 = c.ws + WS_EV + (size_t)pp * NE * 128 + (L & 7) * 16;
    const int col = pp * 256 + (L & 7) * 32 + (b5 ? 16 : 0) + (b4 ? 8 : 0) + (b3 ? 4 : 0);
    const int t0 = 2 * (rank * 8 + c.wave) + hh, ts = 2 * nrank * 8;
    if (t0 >= T) return;
    { const unsigned g0 = WI[(size_t)t0 * 128 + L], g1 = WI[(size_t)t0 * 128 + 64 + L]; mb[L] = g0; mb[64 + L] = g1; }
    u32x4 rA[8], rB[8];
#pragma unroll
    for (int i = 0; i < 8; ++i) rA[i] = *(const u32x4*)(EV4 + (size_t)(mb[8 * i + kl] & 0xffffu) * 128);
    int cur = 0;
#pragma unroll 1
    for (int t = t0; t < T; t += ts) {
        const int tn = (t + ts < T) ? t + ts : t;
        const unsigned gn0 = WI[(size_t)tn * 128 + L], gn1 = WI[(size_t)tn * 128 + 64 + L];
        float* o = c.out + (size_t)t * 1024 + col; const float* g2 = mod + (t >> 11) * 6144 + 5120 + col;
        f32x4 xo = *(const f32x4*)o; const f32x4 gt = *(const f32x4*)g2;
#pragma unroll
        for (int i = 0; i < 8; ++i) rB[i] = *(const u32x4*)(EV4 + (size_t)(mb[cur * 128 + 64 + 8 * i + kl] & 0xffffu) * 128);
        f32x2 ac2[16];
#pragma unroll
        for (int j = 0; j < 16; ++j) ac2[j] = (f32x2){0.f, 0.f};
#pragma unroll
        for (int i = 0; i < 8; ++i) { const float w = bfhi(mb[cur * 128 + 8 * i + kl]); const f32x2 w2 = {w, w}; f32x2 f[16]; dec32_fp4(rA[i], f);
#pragma unroll
            for (int j = 0; j < 16; ++j) ac2[j] = ac2[j] + f[j] * w2; }
        mb[(cur ^ 1) * 128 + L] = gn0; mb[(cur ^ 1) * 128 + 64 + L] = gn1;
#pragma unroll
        for (int i = 0; i < 8; ++i) rA[i] = *(const u32x4*)(EV4 + (size_t)(mb[(cur ^ 1) * 128 + 8 * i + kl] & 0xffffu) * 128);
#pragma unroll
        for (int i = 0; i < 8; ++i) { const float w = bfhi(mb[cur * 128 + 64 + 8 * i + kl]); const f32x2 w2 = {w, w}; f32x2 f[16]; dec32_fp4(rB[i], f);
#pragma unroll
            for (int j = 0; j < 16; ++j) ac2[j] = ac2[j] + f[j] * w2; }
        float acc[32];
#pragma unroll
        for (int j = 0; j < 16; ++j) { acc[2 * j] = ac2[j].x; acc[2 * j + 1] = ac2[j].y; }
        float n16[16], n8[8], n4[4];
#pragma unroll
        for (int i = 0; i < 16; ++i) { const float send = b5 ? acc[i] : acc[i + 16], keep = b5 ? acc[i + 16] : acc[i]; n16[i] = keep + __shfl_xor(send, 32); }
#pragma unroll
        for (int i = 0; i < 8; ++i) { const float send = b4 ? n16[i] : n16[i + 8], keep = b4 ? n16[i + 8] : n16[i]; n8[i] = keep + __shfl_xor(send, 16); }
#pragma unroll
        for (int i = 0; i < 4; ++i) { const float send = b3 ? n8[i] : n8[i + 4], keep = b3 ? n8[i + 4] : n8[i]; n4[i] = keep + __shfl_xor(send, 8); }
        xo.x += gt.x * n4[0]; xo.y += gt.y * n4[1]; xo.z += gt.z * n4[2]; xo.w += gt.w * n4[3];
        if (DRY) asm volatile("" :: "v"(xo.x), "v"(xo.y), "v"(xo.z), "v"(xo.w)); else *(f32x4*)o = xo;
        cur ^= 1;
    }
}

struct ENone {};
struct FInProj { static constexpr int NB = 4; bf16_t *pa, *lx, *lg, *mg; typedef ENone Tile; typedef ENone Pre;
    __device__ __forceinline__ Tile tile(int, int, int) const { return Tile{}; }
    __device__ __forceinline__ Pre pre(int, int, int) const { return Pre{}; }
    __device__ __forceinline__ void apply(int row, int pn, int cc, const float (&v0)[8], const float (&v1)[8], const Pre&, const Tile&) const {
        bf16_t* d;
        if (pn < 2) d = pa + (size_t)row * 512 + pn * 256 + cc; else if (pn < 6) d = lx + (size_t)row * 1024 + (pn - 2) * 256 + cc;
        else if (pn < 10) d = lg + (size_t)row * 1024 + (pn - 6) * 256 + cc; else d = mg + (size_t)row * 2048 + (pn - 10) * 256 + cc;
        *(u32x4*)d = pack8(v0); *(u32x4*)(d + 128) = pack8(v1); } };
struct FRowScale { static constexpr int NB = 4; bf16_t* dst; int ldc; const float* rstd; int which; typedef ENone Tile; struct Pre { float r; };
    __device__ __forceinline__ Tile tile(int, int, int) const { return Tile{}; }
    __device__ __forceinline__ Pre pre(int row, int, int) const { return Pre{rstd[2 * row + which]}; }
    __device__ __forceinline__ void apply(int row, int pn, int cc, const float (&v0)[8], const float (&v1)[8], const Pre& p, const Tile&) const {
        float a[8], b[8];
#pragma unroll
        for (int j = 0; j < 8; ++j) { a[j] = v0[j] * p.r; b[j] = v1[j] * p.r; }
        *(u32x4*)(dst + (size_t)row * ldc + pn * 256 + cc) = pack8(a); *(u32x4*)(dst + (size_t)row * ldc + pn * 256 + 128 + cc) = pack8(b); } };
constexpr int GT_OFF = 132096;
struct FGates { static constexpr int NB = 2; const bf16_t* xc; bf16_t *LA, *Bv; LAS const float* gt;
    typedef ENone Tile; struct Pre { u32x4 x; };
    __device__ __forceinline__ Tile tile(int, int, int) const { return Tile{}; }
    __device__ __forceinline__ Pre pre(int row, int pn, int cc) const { return Pre{*(const u32x4*)(xc + (size_t)row * 1024 + pn * 128 + cc)}; }
    __device__ __forceinline__ void apply(int row, int pn, int cc, const float (&v0)[8], const float (&v1)[8], const Pre& p, const Tile&) const {
        const int ch = pn * 128 + cc; float x[8], la[8], bv[8]; unpack8(p.x, x);
        const f32x4 br0 = *(LAS const f32x4*)(gt + ch), br1 = *(LAS const f32x4*)(gt + ch + 4), bi0 = *(LAS const f32x4*)(gt + 1024 + ch), bi1 = *(LAS const f32x4*)(gt + 1024 + ch + 4),
                    c80 = *(LAS const f32x4*)(gt + 2048 + ch), c81 = *(LAS const f32x4*)(gt + 2048 + ch + 4);
        const float br[8] = {br0.x, br0.y, br0.z, br0.w, br1.x, br1.y, br1.z, br1.w}, bi[8] = {bi0.x, bi0.y, bi0.z, bi0.w, bi1.x, bi1.y, bi1.z, bi1.w}, c8[8] = {c80.x, c80.y, c80.z, c80.w, c81.x, c81.y, c81.z, c81.w};
#pragma unroll
        for (int j = 0; j < 8; ++j) {
            const float r = __builtin_amdgcn_rcpf(1.f + __expf(-(v0[j] + br[j]))), ig = __builtin_amdgcn_rcpf(1.f + __expf(-(v1[j] + bi[j])));
            const float loga = r * c8[j];
            const float z = 2.f * loga;
            const float ser = -z * (1.f + z * (0.5f + z * (0.16666667f + z * (0.041666668f + z * (0.008333334f + z * 0.0013888889f)))));
            const float om = (z > -0.25f) ? ser : (1.f - __expf(z));
            la[j] = loga * 1.4426950408889634f;
            bv[j] = sqrtf(om) * (ig * x[j]);
        }
        *(u32x4*)(LA + (size_t)row * 1024 + ch) = pack8(la); *(u32x4*)(Bv + (size_t)row * 1024 + ch) = pack8(bv); } };
struct FY1 { static constexpr int NB = 4; const bf16_t* mg; bf16_t* y; int goff; bool accum; typedef ENone Tile; struct Pre { u32x4 g0, g1, y0, y1; };
    __device__ __forceinline__ Tile tile(int, int, int) const { return Tile{}; }
    __device__ __forceinline__ Pre pre(int row, int pn, int cc) const { Pre p; const int col = pn * 256 + cc;
        p.g0 = *(const u32x4*)(mg + (size_t)row * 2048 + goff + col); p.g1 = *(const u32x4*)(mg + (size_t)row * 2048 + goff + col + 128);
        if (accum) { p.y0 = *(const u32x4*)(y + (size_t)row * 1024 + col); p.y1 = *(const u32x4*)(y + (size_t)row * 1024 + col + 128); } else { p.y0 = (u32x4){0u, 0u, 0u, 0u}; p.y1 = p.y0; }
        return p; }
    __device__ __forceinline__ void one(bf16_t* dst, const u32x4 g, const u32x4 yo, const float (&v)[8]) const {
        float gt[8], o[8]; unpack8(g, gt); unpack8(yo, o);
#pragma unroll
        for (int j = 0; j < 8; ++j) o[j] = o[j] + sigmoidf_(gt[j]) * v[j];
        *(u32x4*)dst = pack8(o); }
    __device__ __forceinline__ void apply(int row, int pn, int cc, const float (&v0)[8], const float (&v1)[8], const Pre& p, const Tile&) const {
        bf16_t* d = y + (size_t)row * 1024 + pn * 256 + cc; one(d, p.g0, p.y0, v0); one(d + 128, p.g1, p.y1, v1); } };
struct FX1 { static constexpr int NB = 4; const float* x; float* out; const float* mod; struct Tile { f32x4 a[4]; }; struct Pre { f32x4 x[4]; };
    __device__ __forceinline__ Tile tile(int pn, int cc, int pm) const { Tile t; const float* g1 = mod + ((pm * 256) >> 11) * 6144 + 2048 + pn * 256 + cc;
        t.a[0] = *(const f32x4*)g1; t.a[1] = *(const f32x4*)(g1 + 4); t.a[2] = *(const f32x4*)(g1 + 128); t.a[3] = *(const f32x4*)(g1 + 132); return t; }
    __device__ __forceinline__ Pre pre(int row, int pn, int cc) const { Pre p; const float* xr = x + (size_t)row * 1024 + pn * 256 + cc;
        p.x[0] = *(const f32x4*)xr; p.x[1] = *(const f32x4*)(xr + 4); p.x[2] = *(const f32x4*)(xr + 128); p.x[3] = *(const f32x4*)(xr + 132); return p; }
    __device__ __forceinline__ void apply(int row, int pn, int cc, const float (&v0)[8], const float (&v1)[8], const Pre& p, const Tile& t) const {
        float* o = out + (size_t)row * 1024 + pn * 256 + cc;
        f32x4 r0, r1, r2, r3;
        r0.x = p.x[0].x + t.a[0].x * v0[0]; r0.y = p.x[0].y + t.a[0].y * v0[1]; r0.z = p.x[0].z + t.a[0].z * v0[2]; r0.w = p.x[0].w + t.a[0].w * v0[3];
        r1.x = p.x[1].x + t.a[1].x * v0[4]; r1.y = p.x[1].y + t.a[1].y * v0[5]; r1.z = p.x[1].z + t.a[1].z * v0[6]; r1.w = p.x[1].w + t.a[1].w * v0[7];
        r2.x = p.x[2].x + t.a[2].x * v1[0]; r2.y = p.x[2].y + t.a[2].y * v1[1]; r2.z = p.x[2].z + t.a[2].z * v1[2]; r2.w = p.x[2].w + t.a[2].w * v1[3];
        r3.x = p.x[3].x + t.a[3].x * v1[4]; r3.y = p.x[3].y + t.a[3].y * v1[5]; r3.z = p.x[3].z + t.a[3].z * v1[6]; r3.w = p.x[3].w + t.a[3].w * v1[7];
        *(f32x4*)o = r0; *(f32x4*)(o + 4) = r1; *(f32x4*)(o + 128) = r2; *(f32x4*)(o + 132) = r3; } };
struct FStore { static constexpr int NB = 4; bf16_t* dst; int ldc; typedef ENone Tile; typedef ENone Pre;
    __device__ __forceinline__ Tile tile(int, int, int) const { return Tile{}; }
    __device__ __forceinline__ Pre pre(int, int, int) const { return Pre{}; }
    __device__ __forceinline__ void apply(int row, int pn, int cc, const float (&v0)[8], const float (&v1)[8], const Pre&, const Tile&) const {
        *(u32x4*)(dst + (size_t)row * ldc + pn * 256 + cc) = pack8(v0); *(u32x4*)(dst + (size_t)row * ldc + pn * 256 + 128 + cc) = pack8(v1); } };

template <int M, int N, int K, int LDA, int ACS, class F> __device__ __forceinline__ void run_gemm(const Ctx& c, const bf16_t* A, const bf16_t* Bt, const F& f) {
    pg8::Gemm g{A, Bt}; pg8::StaticOrder<M, N> So; So.init(c.G, (int)blockIdx.x);
    pg8::EpiF<F> E{f};
    pg8::gemm_phase<K, LDA, ACS, pg8::EpiF<F>, pg8::StaticOrder<M, N>>((PG8_LAS unsigned char*)c.lds, g, So, E, c.wave * 64 + lane_id_v());
}

__global__ void __launch_bounds__(512, 2) mk_fwd(Args args) {
    extern __shared__ __attribute__((aligned(16))) unsigned char lds_raw[];
    Ctx c;
    c.lds = (LAS unsigned char*)lds_raw;
    c.wave = __builtin_amdgcn_readfirstlane(threadIdx.x >> 6); c.lane = lane_id_v(); c.tid = c.wave * 64 + c.lane;
    c.G = gridDim.x; { const int bx = blockIdx.x; c.vcu = (c.G % 8 == 0) ? (bx % 8) * (c.G / 8) + bx / 8 : bx; }
    c.in = args.in; c.out = args.out; c.ws = args.ws;
    volatile LAS unsigned* MISC = (volatile LAS unsigned*)(c.lds + MISC_OFF);
    if (c.tid < 32) MISC[c.tid] = 0u;
    __syncthreads();
    XcdBarrier bar; bar.bar = (unsigned*)(c.ws + WS_CTL) + 4096; bar.x = 0; bar.st = nullptr;
    if (args.ph_hi - args.ph_lo > 1) bar = xcd_barrier_post((unsigned*)(c.ws + WS_CTL) + 4096, MISC + 8);

    const int lo = args.ph_lo, hi = args.ph_hi;
#ifndef ONLYP
#define ONLYP -1
#endif
#define IN(k) (lo <= (k) && (k) < hi && (ONLYP < 0 || ONLYP == (k)))
#define SEAM(k) do { if ((k) + 1 < hi) xcd_barrier(bar, c.wave); } while (0)
#ifndef REPEAT_MASK
#define REPEAT_MASK 0
#endif
#define PHASE(k, ...) if (IN(k)) { c.lane = lane_id_v(); c.tid = c.wave * 64 + c.lane; { __VA_ARGS__ } if ((REPEAT_MASK >> (k)) & 1) { xcd_barrier(bar, c.wave); { __VA_ARGS__ } } SEAM(k); }
    PHASE(0, phase_prep(c);)
    PHASE(1, phase_modnorm<false>(c, c.in[I_X], c.in[I_N1G], 0, 1024, WSP(bf16_t, WS_R0));)
    PHASE(2, FInProj f{WSP(bf16_t, WS_R1), WSP(bf16_t, WS_R2), WSP(bf16_t, WS_R3), (bf16_t*)c.out};
             run_gemm<T, 4608, 1024, 1024, 0>(c, WSP(bf16_t, WS_R0), WSP(bf16_t, WS_WIN), f);)
    PHASE(3, phase_conv(c);)
    PHASE(4, { LAS float* gtl = (LAS float*)(c.lds + GT_OFF);
               for (int e = c.tid; e < 1024; e += 512) { gtl[e] = c.in[I_BRG][e]; gtl[1024 + e] = c.in[I_BIG][e]; gtl[2048 + e] = WSP(float, WS_C8SP)[e]; }
               __syncthreads();
               FGates fg{WSP(bf16_t, WS_R4), WSP(bf16_t, WS_R0), WSP(bf16_t, WS_R6), gtl};
               run_gemm<T, 2048, 128, 1024, 128>(c, WSP(bf16_t, WS_R4), WSP(bf16_t, WS_WG), fg); }
             { FRowScale fq{WSP(bf16_t, WS_R5), 768, WSP(float, WS_RSTD), 0};
               run_gemm<T, 768, 256, 512, 0>(c, WSP(bf16_t, WS_R1), WSP(bf16_t, WS_WUQ), fq); })
    PHASE(5, { FRowScale fkv{WSP(bf16_t, WS_R2), 1024, WSP(float, WS_RSTD), 1};
               run_gemm<T, 1024, 128, 512, 0>(c, WSP(bf16_t, WS_R1) + 256, WSP(bf16_t, WS_WUKV), fkv); }
             phase_scan(c);)
    PHASE(6, phase_qkv_layout(c);)
    PHASE(7, phase_attn(c);)
    PHASE(8, { FY1 f1{(const bf16_t*)c.out, WSP(bf16_t, WS_R2), 0, false};
               run_gemm<T, 1024, 512, 512, 0>(c, WSP(bf16_t, WS_R0 + 32 * MiB), WSP(bf16_t, WS_WOA), f1); }
             { FY1 f2{(const bf16_t*)c.out, WSP(bf16_t, WS_R2), 1024, true};
               run_gemm<T, 1024, 1024, 1024, 0>(c, WSP(bf16_t, WS_R6), WSP(bf16_t, WS_WOL), f2); })
    PHASE(9, FX1 f{c.in[I_X], c.out, WSP(float, WS_MOD)};
             run_gemm<T, 1024, 1024, 1024, 0>(c, WSP(bf16_t, WS_R2), WSP(bf16_t, WS_WOUT), f);)
    PHASE(10, phase_modnorm<true>(c, c.out, c.in[I_N2G], 3072, 4096, WSP(bf16_t, WS_R0));)
    PHASE(11, FStore f{WSP(bf16_t, WS_SC), 2048};
              run_gemm<T, 2048, 1024, 1024, 0>(c, WSP(bf16_t, WS_R0), WSP(bf16_t, WS_WQ), f);)
    PHASE(13, phase_topk(c);)
    PHASE(14, phase_peer_u(c);)
    PHASE(15, phase_peer_fin(c);)
#ifdef PROBE_VDRY
    if (IN(16)) { c.lane = lane_id_v(); c.tid = c.wave * 64 + c.lane; phase_peer_v<true>(c); xcd_barrier(bar, c.wave); }
#endif
    PHASE(16, phase_peer_v<false>(c);)
#undef PHASE
#undef IN
#undef SEAM
}

extern "C" void kernel_launch(void* const* d_in, const int* in_sizes, int n_in, void* d_out, int out_size, void* d_ws, size_t ws_size, hipStream_t stream) {
    static int grid = 0;
    if (grid == 0) {
        if (n_in != 28 || out_size != T * D || ws_size < WS_END) { fprintf(stderr, "kernel_launch: unexpected shapes (n_in %d out %d ws %zu)\n", n_in, out_size, ws_size); grid = -1; return; }
        int dev = 0, cus = 0, per_cu = 0;
        if (hipGetDevice(&dev) != hipSuccess || hipDeviceGetAttribute(&cus, hipDeviceAttributeMultiprocessorCount, dev) != hipSuccess) { grid = -1; return; }
        if (hipFuncSetAttribute((const void*)mk_fwd, hipFuncAttributeMaxDynamicSharedMemorySize, LDS_BYTES) != hipSuccess) { fprintf(stderr, "kernel_launch: hipFuncSetAttribute failed\n"); grid = -1; return; }
        if (hipOccupancyMaxActiveBlocksPerMultiprocessor(&per_cu, (const void*)mk_fwd, 512, LDS_BYTES) != hipSuccess || per_cu < 1) { fprintf(stderr, "kernel_launch: occupancy query says %d blocks per CU\n", per_cu); grid = -1; (void)hipGetLastError(); return; }
        grid = cus - (cus % 8);
        if (grid < 8) { fprintf(stderr, "kernel_launch: needs at least 8 CUs\n"); grid = -1; return; }
    }
    if (grid < 0) return;
    (void)hipMemsetAsync((char*)d_ws + WS_CTL, 0, CTL_ZERO_BYTES, stream);
    Args a{};
    for (int i = 0; i < 28; ++i) a.in[i] = (const float*)d_in[i];
    a.out = (float*)d_out; a.ws = (unsigned char*)d_ws;
#if MK_N_LAUNCHES == 1
    a.ph_lo = 0; a.ph_hi = N_PHASES;
    hipLaunchKernelGGL(mk_fwd, dim3(grid), dim3(512), LDS_BYTES, stream, a);
#else
    for (int ph = 0; ph < N_PHASES; ++ph) { a.ph_lo = ph; a.ph_hi = ph + 1; hipLaunchKernelGGL(mk_fwd, dim3(grid), dim3(512), LDS_BYTES, stream, a); }
#endif
}
```

```cpp
#include <hip/hip_runtime.h>
#include <cstdio>
#include <cstdint>

#define LAS __attribute__((address_space(3)))
#define GAS __attribute__((address_space(1)))
typedef unsigned short bf16_t;
typedef short bf16x8 __attribute__((ext_vector_type(8)));
typedef float f32x4 __attribute__((ext_vector_type(4)));
typedef float f32x2 __attribute__((ext_vector_type(2)));
typedef unsigned u32x4 __attribute__((ext_vector_type(4)));
typedef unsigned u32x2 __attribute__((ext_vector_type(2)));
typedef int i32x2 __attribute__((ext_vector_type(2)));

#ifndef MK_N_LAUNCHES
#define MK_N_LAUNCHES 1
#endif

constexpr int T = 32768, D = 1024, NB_ = 16, S = 2048, H = 8;
constexpr int QKH = 96, VH = 64;
constexpr int NE = 16384;
constexpr float EPS = 1e-6f;

constexpr size_t MiB = 1u << 20;
constexpr size_t WS_CTL = 0, CTL_ZERO_BYTES = 65536;
constexpr size_t WS_MOD = 1 * MiB;
constexpr size_t WS_RSTD = 1 * MiB + 512 * 1024;
constexpr size_t WS_C8SP = 1 * MiB + 448 * 1024;
constexpr size_t WS_WIN = 2 * MiB;
constexpr size_t WS_WUQ = 11 * MiB;
constexpr size_t WS_WUKV = 11 * MiB + 512 * 1024;
constexpr size_t WS_WOA = 12 * MiB;
constexpr size_t WS_WOL = 13 * MiB;
constexpr size_t WS_WOUT = 15 * MiB;
constexpr size_t WS_WQ = 17 * MiB;
constexpr size_t WS_WG = 21 * MiB;
constexpr size_t WS_SK = 22 * MiB;
constexpr size_t WS_EU = 24 * MiB;
constexpr size_t WS_EV = 40 * MiB;
constexpr size_t WS_SU = 1 * MiB + 768 * 1024;
constexpr size_t WS_SV = 1 * MiB + 832 * 1024;
constexpr size_t WS_WGT = 440 * MiB;
constexpr size_t WS_CS = 56 * MiB;
constexpr size_t WS_H2Q = 456 * MiB;
constexpr size_t WS_SH = 1 * MiB + 896 * 1024;
constexpr size_t WS_PD = 280 * MiB;
constexpr size_t WS_R0 = 88 * MiB;
constexpr size_t WS_R1 = 152 * MiB;
constexpr size_t WS_R2 = 184 * MiB;
constexpr size_t WS_R3 = 248 * MiB;
constexpr size_t WS_R4 = 312 * MiB;
constexpr size_t WS_R5 = 376 * MiB;
constexpr size_t WS_R6 = 424 * MiB;
constexpr size_t WS_QP = 152 * MiB;
constexpr size_t WS_SC = 280 * MiB;
constexpr size_t WS_IDX = 408 * MiB;
constexpr size_t WS_GW = 424 * MiB;
constexpr size_t WS_W8 = 440 * MiB;
constexpr size_t WS_SWT = 448 * MiB;
constexpr size_t WS_END = 488 * MiB;

constexpr int LDS_BYTES = 157696;
constexpr int MISC_OFF = 131072 + 320;

__device__ __forceinline__ unsigned f2bf(float f) { unsigned u = __builtin_bit_cast(unsigned, f); return (u + 0x7fffu + ((u >> 16) & 1u)) >> 16; }
typedef __bf16 bf16x2_t __attribute__((ext_vector_type(2)));
__device__ __forceinline__ unsigned pk2(float lo, float hi) { f32x2 v = {lo, hi}; return __builtin_bit_cast(unsigned, __builtin_convertvector(v, bf16x2_t)); }
__device__ __forceinline__ float bf2f(unsigned h) { return __builtin_bit_cast(float, h << 16); }
__device__ __forceinline__ float bflo(unsigned w) { return __builtin_bit_cast(float, w << 16); }
__device__ __forceinline__ float bfhi(unsigned w) { return __builtin_bit_cast(float, w & 0xffff0000u); }
__device__ __forceinline__ float sigmoidf_(float x) { return 1.f / (1.f + __expf(-x)); }
__device__ __forceinline__ float gelu_tanh(float x) {
    const float u = 0.7978845608028654f * (x + 0.044715f * x * x * x);
    const float e = __expf(2.f * u);
    const float th = 1.f - 2.f / (e + 1.f);
    return 0.5f * x * (1.f + th);
}
__device__ __forceinline__ int lane_id_v() { int l; asm volatile("v_mbcnt_lo_u32_b32 %0, -1, 0\n\tv_mbcnt_hi_u32_b32 %0, -1, %0" : "=v"(l)); return l; }
__device__ __forceinline__ float wave_sum(float v) {
#pragma unroll
    for (int o = 1; o < 64; o <<= 1) v += __shfl_xor(v, o);
    return v;
}
__device__ __forceinline__ void unpack8(const u32x4 w, float (&v)[8]) {
    v[0] = bflo(w.x); v[1] = bfhi(w.x); v[2] = bflo(w.y); v[3] = bfhi(w.y); v[4] = bflo(w.z); v[5] = bfhi(w.z); v[6] = bflo(w.w); v[7] = bfhi(w.w);
}
__device__ __forceinline__ u32x4 pack8(const float (&v)[8]) {
    u32x4 w; w.x = pk2(v[0], v[1]); w.y = pk2(v[2], v[3]); w.z = pk2(v[4], v[5]); w.w = pk2(v[6], v[7]); return w;
}

namespace pg8 {
#define PG8_LAS __attribute__((address_space(3)))
constexpr int BM = 256, BK = 64, HALF = 128, HTB = HALF * BK * 2, STAGE_BYTES = 8 * HTB, NXCD = 8, WGM = 8;
__host__ __device__ __forceinline__ int lds_byte(int r, int c) { const int st = (r >> 4) * 2 + (c >> 5), rr = r & 15, cc = c & 31, ob = rr * 64 + cc * 2; return st * 1024 + (ob ^ (((ob >> 9) & 1) << 5)); }
__host__ __device__ __forceinline__ void stage_rc(int b, int& R, int& C) { const int st = b / 1024, sb = b % 1024, swz = sb ^ (((sb >> 9) & 1) << 5); R = (st >> 1) * 16 + swz / 64; C = (st & 1) * 32 + (swz % 64) / 2; }
__host__ __device__ __forceinline__ int perm32(int rho) { const int n = rho >> 4, i = rho & 15; return 8 * (i >> 2) + 4 * n + (i & 3); }

struct Unit { int pm, pn; };
struct Gemm { const bf16_t* A; const bf16_t* Bt; };

template <int M_, int N_> struct StaticOrder {
    static constexpr int nM = M_ / BM, nN = N_ / BM, nwg = nM * nN;
    int G, c;
    __host__ __device__ void init(int G_, int c_) { G = G_; c = c_; }
    __host__ __device__ bool next(int i, Unit& u) const {
        const long L = (long)i * G + c; if (L >= nwg) return false;
        int wgid = (int)L; { const int q = nwg / NXCD, r = nwg % NXCD, xcd = wgid % NXCD, off = wgid / NXCD; wgid = (xcd < r ? xcd * (q + 1) : r * (q + 1) + (xcd - r) * q) + off; }
        const int nig = WGM * nN, gid = wgid / nig, fm = gid * WGM, gsz = (nM - fm) < WGM ? (nM - fm) : WGM;
        u.pm = fm + ((wgid % nig) % gsz); u.pn = (wgid % nig) / gsz; return true;
    }
};

template <class F> struct EpiF {
    static constexpr bool PERM = true;
    F f;
    __device__ __forceinline__ void operator()(const f32x4 (&acc)[2][2][4][2], const Unit& u, int wr, int wc, int fr, int fq) const {
        { int l_; asm volatile("v_mbcnt_lo_u32_b32 %0, -1, 0\n\tv_mbcnt_hi_u32_b32 %0, -1, %0" : "=v"(l_)); fr = l_ & 15; fq = l_ >> 4; }
        const int c = wc * 32 + 8 * fq;
        const typename F::Tile tl = f.tile(u.pn, c, u.pm);
#pragma unroll
        for (int ai = 0; ai < 2; ++ai)
#pragma unroll
            for (int mb = 0; mb < 4; mb += F::NB) {
                typename F::Pre pre[F::NB];
#pragma unroll
                for (int m = 0; m < F::NB; ++m) pre[m] = f.pre(u.pm * BM + ai * HALF + wr * 64 + (mb + m) * 16 + fr, u.pn, c);
#pragma unroll
                for (int m = 0; m < F::NB; ++m) {
                    const int row = u.pm * BM + ai * HALF + wr * 64 + (mb + m) * 16 + fr;
                    float v0[8], v1[8];
#pragma unroll
                    for (int j = 0; j < 4; ++j) { v0[j] = acc[ai][0][mb + m][0][j]; v0[4 + j] = acc[ai][0][mb + m][1][j]; v1[j] = acc[ai][1][mb + m][0][j]; v1[4 + j] = acc[ai][1][mb + m][1][j]; }
                    f.apply(row, u.pn, c, v0, v1, pre[m], tl);
                }
            }
    }
};

template <int K, int LDA, int ACS, class Epi, class Sched>
__device__ __forceinline__ void gemm_phase(PG8_LAS unsigned char* lds, const Gemm g, const Sched& S, const Epi& E, const int tid) {
    const int wid = __builtin_amdgcn_readfirstlane(tid >> 6), lane = tid & 63, wr = wid >> 2, wc = wid & 3, fr = lane & 15, fq = lane >> 4;
    constexpr int nt = K / BK;
    unsigned voffA[2], voffB[2];
#pragma unroll
    for (int i = 0; i < 2; ++i) { int R, C; stage_rc(tid * 16 + i * 8192, R, C); const int Rb = Epi::PERM ? ((R & ~31) + perm32(R & 31)) : R;
        voffA[i] = (unsigned)(R * LDA + C) * 2u; voffB[i] = (unsigned)(Rb * K + C) * 2u; }
    constexpr size_t kstep = (size_t)(BK * 2);
    constexpr size_t hstepA = (size_t)HALF * LDA * 2, hstepB = (size_t)HALF * K * 2;
    constexpr size_t tstepA = 2 * hstepA, tstepB = 2 * hstepB;
    constexpr size_t acsb = (size_t)ACS * 2;
    const unsigned ldsw = (unsigned)wid * 1024u;
    const int aoff = lds_byte(wr * 64 + fr, fq * 8), boff = lds_byte(wc * 32 + fr, fq * 8);
#define PG8_SA(b, h) (((b) * 2 + (h)) * HTB)
#define PG8_SB(b, h) ((4 + (b) * 2 + (h)) * HTB)
#define PG8_STAGE(bufoff, gbase, voff) do { _Pragma("unroll") for (int _i = 0; _i < 2; ++_i) \
        __builtin_amdgcn_global_load_lds((const unsigned*)((const char*)(gbase) + (voff)[_i]), (PG8_LAS unsigned*)(lds + (bufoff) + ldsw + _i * 8192), 16, 0, 0); } while (0)
#define PG8_LDA(dst, b, h) do { _Pragma("unroll") for (int m = 0; m < 4; ++m) _Pragma("unroll") for (int k = 0; k < 2; ++k) dst[m][k] = *(const PG8_LAS bf16x8*)(lds + PG8_SA(b, h) + aoff + m * 2048 + k * 1024); } while (0)
#define PG8_LDB(dst, b, h) do { _Pragma("unroll") for (int n = 0; n < 2; ++n) _Pragma("unroll") for (int k = 0; k < 2; ++k) dst[n][k] = *(const PG8_LAS bf16x8*)(lds + PG8_SB(b, h) + boff + n * 2048 + k * 1024); } while (0)
#define PG8_MMA(ai, bj, At, Bt) do { __builtin_amdgcn_s_setprio(1); _Pragma("unroll") for (int m = 0; m < 4; ++m) _Pragma("unroll") for (int n = 0; n < 2; ++n) _Pragma("unroll") for (int k = 0; k < 2; ++k) \
        acc[ai][bj][m][n] = __builtin_amdgcn_mfma_f32_16x16x32_bf16(Bt[n][k], At[m][k], acc[ai][bj][m][n], 0, 0, 0); __builtin_amdgcn_s_setprio(0); } while (0)
#define PG8_WAIT_V(n) asm volatile("s_waitcnt vmcnt(" #n ")" ::: "memory")
#define PG8_WAIT_L(n) asm volatile("s_waitcnt lgkmcnt(" #n ")" ::: "memory")
#define PG8_BAR __builtin_amdgcn_s_barrier()
#define PG8_SCHED __builtin_amdgcn_sched_barrier(0)
    Unit cur, nxt; int ui = 0;
    if (!S.next(0, cur)) return;
    f32x4 acc[2][2][4][2];
#pragma unroll
    for (int a = 0; a < 2; ++a)
#pragma unroll
        for (int b = 0; b < 2; ++b)
#pragma unroll
            for (int m = 0; m < 4; ++m)
#pragma unroll
                for (int n = 0; n < 2; ++n) acc[a][b][m][n] = (f32x4){0.f, 0.f, 0.f, 0.f};
    bf16x8 At[4][2], B0[2][2], B1[2][2];
    const char* cA = (const char*)g.A + (size_t)cur.pm * tstepA + (size_t)cur.pn * acsb; const char* cB = (const char*)g.Bt + (size_t)cur.pn * tstepB;
    PG8_STAGE(PG8_SB(0, 0), cB, voffB); PG8_STAGE(PG8_SB(0, 1), cB + hstepB, voffB); PG8_STAGE(PG8_SA(0, 0), cA, voffA); PG8_STAGE(PG8_SA(0, 1), cA + hstepA, voffA);
    if (wr == 1) PG8_BAR;
    PG8_WAIT_V(2); PG8_BAR;
    PG8_STAGE(PG8_SB(1, 0), cB + kstep, voffB); PG8_STAGE(PG8_SA(1, 0), cA + kstep, voffA); PG8_STAGE(PG8_SB(1, 1), cB + hstepB + kstep, voffB);
    PG8_WAIT_V(6); PG8_BAR;
    for (;;) {
        const bool has_next = S.next(ui + 1, nxt);
        const char* nA = has_next ? (const char*)g.A + (size_t)nxt.pm * tstepA + (size_t)nxt.pn * acsb : cA; const char* nB = has_next ? (const char*)g.Bt + (size_t)nxt.pn * tstepB : cB;
#pragma unroll 1
        for (int t = 0; t < nt; t += 2) {
            const bool last = (t == nt - 2);
            const char* a1 = cA + (size_t)(t + 1) * kstep;
            const char* a2 = last ? nA : cA + (size_t)(t + 2) * kstep; const char* b2 = last ? nB : cB + (size_t)(t + 2) * kstep;
            const char* a3 = a2 + kstep; const char* b3 = b2 + kstep;
            PG8_LDB(B0, 0, 0); PG8_LDB(B1, 0, 1); PG8_SCHED; PG8_LDA(At, 0, 0); PG8_STAGE(PG8_SA(1, 1), a1 + hstepA, voffA);
            PG8_WAIT_V(8); PG8_WAIT_L(0); PG8_BAR; PG8_MMA(0, 0, At, B0); PG8_MMA(0, 1, At, B1); PG8_BAR; PG8_SCHED;
            PG8_LDA(At, 0, 1); PG8_STAGE(PG8_SB(0, 0), b2, voffB); PG8_STAGE(PG8_SB(0, 1), b2 + hstepB, voffB); PG8_STAGE(PG8_SA(0, 0), a2, voffA);
            PG8_WAIT_V(8); PG8_WAIT_L(0); PG8_BAR; PG8_MMA(1, 0, At, B0); PG8_MMA(1, 1, At, B1); PG8_BAR; PG8_SCHED;
            PG8_LDB(B0, 1, 0); PG8_LDB(B1, 1, 1); PG8_SCHED; PG8_LDA(At, 1, 0); PG8_STAGE(PG8_SA(0, 1), a2 + hstepA, voffA);
            PG8_WAIT_V(8); PG8_WAIT_L(0); PG8_BAR; PG8_MMA(0, 0, At, B0); PG8_MMA(0, 1, At, B1); PG8_BAR; PG8_SCHED;
            PG8_LDA(At, 1, 1); PG8_STAGE(PG8_SB(1, 0), b3, voffB); PG8_STAGE(PG8_SB(1, 1), b3 + hstepB, voffB); PG8_STAGE(PG8_SA(1, 0), a3, voffA);
            PG8_WAIT_V(8); PG8_WAIT_L(0); PG8_BAR; PG8_MMA(1, 0, At, B0); PG8_MMA(1, 1, At, B1); PG8_BAR; PG8_SCHED;
        }
        if (wr == 0) PG8_BAR;
        E(acc, cur, wr, wc, fr, fq);
        if (!has_next) break;
#pragma unroll
        for (int a = 0; a < 2; ++a)
#pragma unroll
            for (int b = 0; b < 2; ++b)
#pragma unroll
                for (int m = 0; m < 4; ++m)
#pragma unroll
                    for (int n = 0; n < 2; ++n) acc[a][b][m][n] = (f32x4){0.f, 0.f, 0.f, 0.f};
        cur = nxt; cA = nA; cB = nB; ++ui;
        if (wr == 1) PG8_BAR;
    }
    PG8_WAIT_V(0);
    PG8_BAR;
#undef PG8_SA
#undef PG8_SB
#undef PG8_STAGE
#undef PG8_LDA
#undef PG8_LDB
#undef PG8_MMA
#undef PG8_WAIT_V
#undef PG8_WAIT_L
#undef PG8_BAR
#undef PG8_SCHED
}
}

#define XB_TMO      128
#define XB_XCNT(j)  (256  + 64 * (j))
#define XB_XSUB(j)  (1280 + 64 * (j))
#define XB_XGEN(j)  (2304 + 64 * (j))
#define XB_TOP      3328
#define XB_TOPGEN   3392
#define XCD_BAR_WORDS 3456
#define XB_SPIN_CAP (1u << 18)
__device__ __forceinline__ unsigned xb_ld(unsigned* p)              { return __hip_atomic_load(p, __ATOMIC_RELAXED, __HIP_MEMORY_SCOPE_AGENT); }
__device__ __forceinline__ unsigned xb_add(unsigned* p, unsigned v) { return __hip_atomic_fetch_add(p, v, __ATOMIC_RELAXED, __HIP_MEMORY_SCOPE_AGENT); }
__device__ __forceinline__ unsigned xb_xcc_id() { return (unsigned)__builtin_amdgcn_s_getreg((3 << 11) | 20) & 0xFu; }
#define XB_SPIN(cond, bar) do { unsigned _sp = 0; while (cond) { __builtin_amdgcn_s_sleep(1); \
    if ((++_sp & 255u) == 0u) { if (xb_ld(&(bar)[XB_TMO])) break; if (_sp > XB_SPIN_CAP) { atomicAdd(&(bar)[XB_TMO], 1u); break; } } } } while (0)
struct XcdBarrier { unsigned* bar; unsigned x; volatile LAS unsigned* st; };
__device__ __forceinline__ XcdBarrier xcd_barrier_post(unsigned* bar, volatile LAS unsigned* st) {
    XcdBarrier b; b.bar = bar; b.x = xb_xcc_id(); b.st = st;
    if (threadIdx.x == 0) (void)xb_add(&bar[XB_XCNT(b.x)], 1u);
    return b;
}
__device__ __forceinline__ void xcd_barrier_complete(unsigned* bar, unsigned x, unsigned& nloc, unsigned& nx) {
    const unsigned G = gridDim.x * gridDim.y * gridDim.z;
    unsigned sum, cnt, mine, sp = 0u;
    for (;;) {
        sum = 0u; cnt = 0u; mine = 0u;
#pragma unroll
        for (unsigned j = 0; j < 16; ++j) { const unsigned c = xb_ld(&bar[XB_XCNT(j)]); sum += c; cnt += (c > 0u) ? 1u : 0u; mine = (j == x) ? c : mine; }
        if (sum == G) break;
        __builtin_amdgcn_s_sleep(1);
        if ((++sp & 255u) == 0u) { if (xb_ld(&bar[XB_TMO])) break; if (sp > XB_SPIN_CAP) { atomicAdd(&bar[XB_TMO], 1u); break; } }
    }
    nloc = mine > 0u ? mine : 1u; nx = cnt > 0u ? cnt : 1u;
}
__device__ __forceinline__ void xcd_barrier(const XcdBarrier& b, int wave) {
    asm volatile("s_waitcnt vmcnt(0)" ::: "memory");
    __syncthreads();
    if (wave == 0 && lane_id_v() == 0) {
        unsigned* bar = b.bar;
        __builtin_amdgcn_s_waitcnt(0);
        unsigned nloc = b.st[0], nx = b.st[1];
        if (nloc == 0u) { xcd_barrier_complete(bar, b.x, nloc, nx); b.st[0] = nloc; b.st[1] = nx; }
        const unsigned old = xb_add(&bar[XB_XSUB(b.x)], 1u);
        const unsigned gen = old / nloc;
        if (old + 1u == (gen + 1u) * nloc) {
            __builtin_amdgcn_fence(__ATOMIC_RELEASE, "agent");
            asm volatile("s_waitcnt vmcnt(0)" ::: "memory");
            const unsigned og = xb_add(&bar[XB_TOP], 1u);
            const unsigned tg = og / nx;
            if (og + 1u == (tg + 1u) * nx) xb_add(&bar[XB_TOPGEN], 1u);
            else XB_SPIN(xb_ld(&bar[XB_TOPGEN]) == tg, bar);
            __builtin_amdgcn_fence(__ATOMIC_ACQUIRE, "agent");
            xb_add(&bar[XB_XGEN(b.x)], 1u);
            asm volatile("s_waitcnt vmcnt(0)" ::: "memory");
        } else {
            XB_SPIN(xb_ld(&bar[XB_XGEN(b.x)]) == gen, bar);
            __builtin_amdgcn_fence(__ATOMIC_ACQUIRE, "agent");
            asm volatile("s_waitcnt vmcnt(0)" ::: "memory");
        }
    }
    __syncthreads();
}

struct Args { const float* in[28]; float* out; unsigned char* ws; int ph_lo, ph_hi; };
enum { I_X = 0, I_C, I_POS, I_WADA, I_BADA, I_N1G, I_WIN, I_QAG, I_WUQ, I_KVAG, I_WUKV, I_QNG, I_KNG, I_WOA, I_CONVW, I_CONVB, I_WRG, I_BRG, I_WIG, I_BIG, I_LAM, I_WOL, I_WOUT, I_N2G, I_WQ, I_SUBK, I_EU, I_EV };
constexpr int N_PHASES = 17;

struct Ctx {
    LAS unsigned char* lds;
    int tid, lane, wave, vcu, G;
    const float* const* in; float* out; unsigned char* ws;
};
#define WSP(type, off) ((type*)(c.ws + (off)))

template <class F>
__device__ __forceinline__ void tr_tile(const Ctx& c, bf16_t* dst, int K, int n0, int k0, F f) {
    LAS float* scr = (LAS float*)c.lds;
#pragma unroll
    for (int i = 0; i < 8; ++i) { const int kk = i * 8 + (c.tid >> 6), nn = c.tid & 63; scr[kk * 65 + nn] = f(k0 + kk, n0 + nn); }
    __syncthreads();
    { const int kc = c.tid & 7, nn = c.tid >> 3;
      LAS const float* s = scr + (8 * kc) * 65 + nn;
      u32x4 o; o.x = pk2(s[0], s[65]); o.y = pk2(s[2 * 65], s[3 * 65]); o.z = pk2(s[4 * 65], s[5 * 65]); o.w = pk2(s[6 * 65], s[7 * 65]);
      *(u32x4*)(dst + (size_t)(n0 + nn) * K + k0 + 8 * kc) = o; }
    __syncthreads();
}

template <class F>
__device__ __forceinline__ void tr_tile_wave(LAS float* scr, int L, bf16_t* dst, int K, int n0, int k0, F f) {
#pragma unroll 16
    for (int kk = 0; kk < 64; ++kk) scr[kk * 65 + L] = f(k0 + kk, n0 + L);
    asm volatile("s_waitcnt lgkmcnt(0)" ::: "memory");
    const int kc = L & 7;
#pragma unroll
    for (int j = 0; j < 8; ++j) { const int nn = (L >> 3) + 8 * j; LAS const float* s = scr + (8 * kc) * 65 + nn;
        u32x4 o; o.x = pk2(s[0], s[65]); o.y = pk2(s[2 * 65], s[3 * 65]); o.z = pk2(s[4 * 65], s[5 * 65]); o.w = pk2(s[6 * 65], s[7 * 65]);
        *(u32x4*)(dst + (size_t)(n0 + nn) * K + k0 + 8 * kc) = o; }
    asm volatile("s_waitcnt lgkmcnt(0)" ::: "memory");
}
__device__ __forceinline__ void phase_prep(const Ctx& c0) {
    Ctx c = c0; c.lane = lane_id_v(); c.tid = c.wave * 64 + c.lane;
    const float* w_in = c.in[I_WIN]; const float* w_uq = c.in[I_WUQ]; const float* qag = c.in[I_QAG]; const float* w_ukv = c.in[I_WUKV]; const float* kvag = c.in[I_KVAG];
    const float* w_oa = c.in[I_WOA]; const float* w_ol = c.in[I_WOL]; const float* w_out = c.in[I_WOUT]; const float* w_q = c.in[I_WQ];
    const float* w_rg = c.in[I_WRG]; const float* w_ig = c.in[I_WIG];
    constexpr int T_WIN = 72 * 16, T_WUQ = 12 * 4, T_WUKV = 16 * 2, T_WOA = 16 * 8, T_WOL = 16 * 16, T_WOUT = 16 * 16, T_WQ = 32 * 16, T_WG = 8 * 4 * 2;
    constexpr int T_WAVE = T_WIN + T_WUQ + T_WUKV + T_WOA + T_WOL + T_WOUT + T_WG;
    { LAS float* scr = (LAS float*)(c.lds + (c.wave < 7 ? c.wave * 16640 : 131584)); const int L = c.lane;
      static_assert(7 * 16640 <= 131072 && 131584 + 16640 <= LDS_BYTES && 131584 >= MISC_OFF + 128, "prep LDS tiles");
      for (int it = c.vcu * 8 + c.wave; it < T_WAVE; it += c.G * 8) {
        int r = it;
        if (r < T_WIN) { const int nb = r / 16, kb = r % 16;
            tr_tile_wave(scr, L, WSP(bf16_t, WS_WIN), 1024, nb * 64, kb * 64, [=](int k, int n) -> float { return n < 416 ? w_in[(size_t)k * 4512 + n] : (n < 512 ? 0.f : w_in[(size_t)k * 4512 + n - 96]); }); continue; }
        r -= T_WIN;
        if (r < T_WUQ) { const int nb = r / 4, kb = r % 4;
            tr_tile_wave(scr, L, WSP(bf16_t, WS_WUQ), 256, nb * 64, kb * 64, [=](int k, int n) -> float { return w_uq[(size_t)k * 768 + n] * qag[k]; }); continue; }
        r -= T_WUQ;
        if (r < T_WUKV) { const int nb = r / 2, kb = r % 2;
            tr_tile_wave(scr, L, WSP(bf16_t, WS_WUKV), 128, nb * 64, kb * 64, [=](int k, int n) -> float { return w_ukv[(size_t)k * 1024 + n] * kvag[k]; }); continue; }
        r -= T_WUKV;
        if (r < T_WOA) { const int nb = r / 8, kb = r % 8;
            tr_tile_wave(scr, L, WSP(bf16_t, WS_WOA), 512, nb * 64, kb * 64, [=](int k, int n) -> float { return w_oa[(size_t)k * 1024 + n]; }); continue; }
        r -= T_WOA;
        if (r < T_WOL) { const int nb = r / 16, kb = r % 16;
            tr_tile_wave(scr, L, WSP(bf16_t, WS_WOL), 1024, nb * 64, kb * 64, [=](int k, int n) -> float { return w_ol[(size_t)k * 1024 + n]; }); continue; }
        r -= T_WOL;
        if (r < T_WOUT) { const int nb = r / 16, kb = r % 16;
            tr_tile_wave(scr, L, WSP(bf16_t, WS_WOUT), 1024, nb * 64, kb * 64, [=](int k, int n) -> float { return w_out[(size_t)k * 1024 + n]; }); continue; }
        r -= T_WOUT;
        { const int blk = r / 8, q = r % 8, nb = q / 2, kb = q % 2;
            tr_tile_wave(scr, L, WSP(bf16_t, WS_WG) + (size_t)blk * 256 * 128, 128, nb * 64, kb * 64,
                    [=](int k, int n) -> float { return n < 128 ? w_rg[((size_t)blk * 128 + k) * 128 + n] : w_ig[((size_t)blk * 128 + k) * 128 + n - 128]; }); }
      } }
    __syncthreads();
    for (int r = c.vcu; r < T_WQ; r += c.G) {
        const int nb = r / 16, kb = r % 16;
        const int slot = nb >> 1, n0 = (nb & 1) * 64, k0 = kb * 64;
        LAS float* wq_s = (LAS float*)(c.lds + 32768);
        LAS float* sk_s = (LAS float*)(c.lds + 32768 + 64 * 129 * 4);
        const float* skp = c.in[I_SUBK] + ((size_t)slot * 128 + n0) * 128;
        for (int e = c.tid; e < 64 * 128; e += 512) { const int rr = e >> 7, cc = e & 127; wq_s[rr * 129 + cc] = w_q[(size_t)(k0 + rr) * 2048 + slot * 128 + cc]; sk_s[rr * 129 + cc] = skp[(size_t)rr * 128 + cc]; }
        __syncthreads();
        tr_tile(c, WSP(bf16_t, WS_WQ), 1024, nb * 64, k0, [=](int k, int n) -> float { const LAS float* a = wq_s + (k - k0) * 129; const LAS float* b = sk_s + (n - nb * 64) * 129; float s = 0.f;
#pragma unroll 16
            for (int d = 0; d < 128; ++d) s += a[d] * b[d];
            return s; });
    }
    { const float* lam = c.in[I_LAM]; float* t8 = WSP(float, WS_C8SP);
      if (c.vcu == 0) for (int e = c.tid; e < 1024; e += 512) t8[e] = -8.f * log1pf(__expf(-lam[e])); }
    if (c.vcu == 0 && c.tid == 0) {
        const unsigned probe = __builtin_amdgcn_cvt_scalef32_pk_fp4_f32(0u, 1.0f, 0.0f, 1.0f, 0) & 0xffu;
        WSP(unsigned, WS_C8SP)[1024] = (probe == 0x02u) ? 0u : 1u; }
    { const int gw = c.vcu * 8 + c.wave, NGW = c.G * 8, L = c.lane;
      f32x4 vn[4];
      if (gw < 2 * NE) { const f32x4* s4 = (const f32x4*)((gw >= NE ? c.in[I_EV] : c.in[I_EU]) + (size_t)(gw >= NE ? gw - NE : gw) * 1024 + 16 * L);
#pragma unroll
          for (int j = 0; j < 4; ++j) vn[j] = s4[j]; }
#pragma unroll 1
      for (int r = gw; r < 2 * NE; r += NGW) {
          const int isv = r >= NE, e = isv ? r - NE : r;
          f32x4 v[4]; float am = 0.f;
#pragma unroll
          for (int j = 0; j < 4; ++j) { v[j] = vn[j]; am = fmaxf(am, fmaxf(fmaxf(fabsf(v[j].x), fabsf(v[j].y)), fmaxf(fabsf(v[j].z), fabsf(v[j].w)))); }
          { const int rn = (r + NGW < 2 * NE) ? r + NGW : r; const f32x4* s4 = (const f32x4*)((rn >= NE ? c.in[I_EV] : c.in[I_EU]) + (size_t)(rn >= NE ? rn - NE : rn) * 1024 + 16 * L);
#pragma unroll
            for (int j = 0; j < 4; ++j) vn[j] = s4[j]; }
#pragma unroll
          for (int o = 1; o < 64; o <<= 1) am = fmaxf(am, __shfl_xor(am, o));
          const float s = am > 0.f ? am * (1.f / 6.f) : 1.f, inv = 1.f / s;
          unsigned w0 = 0u, w1 = 0u;
          w0 = __builtin_amdgcn_cvt_scalef32_pk_fp4_f32(w0, v[0].x * inv, v[0].y * inv, 1.0f, 0); w0 = __builtin_amdgcn_cvt_scalef32_pk_fp4_f32(w0, v[0].z * inv, v[0].w * inv, 1.0f, 1);
          w0 = __builtin_amdgcn_cvt_scalef32_pk_fp4_f32(w0, v[1].x * inv, v[1].y * inv, 1.0f, 2); w0 = __builtin_amdgcn_cvt_scalef32_pk_fp4_f32(w0, v[1].z * inv, v[1].w * inv, 1.0f, 3);
          w1 = __builtin_amdgcn_cvt_scalef32_pk_fp4_f32(w1, v[2].x * inv, v[2].y * inv, 1.0f, 0); w1 = __builtin_amdgcn_cvt_scalef32_pk_fp4_f32(w1, v[2].z * inv, v[2].w * inv, 1.0f, 1);
          w1 = __builtin_amdgcn_cvt_scalef32_pk_fp4_f32(w1, v[3].x * inv, v[3].y * inv, 1.0f, 2); w1 = __builtin_amdgcn_cvt_scalef32_pk_fp4_f32(w1, v[3].z * inv, v[3].w * inv, 1.0f, 3);
          u32x2 q; q.x = w0; q.y = w1;
          *(u32x2*)(c.ws + (isv ? WS_EV : WS_EU) + ((size_t)(L >> 4) * NE + e) * 128 + (L & 15) * 8) = q;
          if (L == 0) WSP(float, isv ? WS_SV : WS_SU)[e] = s;
      } }
    { const float* cin = c.in[I_C]; const float* w_ada = c.in[I_WADA]; const float* b_ada = c.in[I_BADA]; float* mod = WSP(float, WS_MOD);
      LAS float* cs = (LAS float*)c.lds;
      LAS float* red = (LAS float*)(c.lds + 65536);
      bool have = false;
      for (int it = c.vcu; it < 192; it += c.G) {
          if (!have) { for (int e = c.tid; e < 16 * 1024; e += 512) { const float v = cin[e]; cs[e] = v / (1.f + __expf(-v)); } have = true; }
          __syncthreads();
          const int cl = c.tid & 31, ks = c.tid >> 5, j = it * 32 + cl;
          float acc[16];
#pragma unroll
          for (int b = 0; b < 16; ++b) acc[b] = 0.f;
          for (int kk = 0; kk < 64; ++kk) { const int k = ks * 64 + kk; const float w = w_ada[(size_t)k * 6144 + j];
#pragma unroll
              for (int b = 0; b < 16; ++b) acc[b] += cs[b * 1024 + k] * w; }
#pragma unroll
          for (int b = 0; b < 16; ++b) red[(ks * 16 + b) * 32 + cl] = acc[b];
          __syncthreads();
          { const int b = c.tid >> 5; float s = b_ada[j];
#pragma unroll
            for (int k2 = 0; k2 < 16; ++k2) s += red[(k2 * 16 + b) * 32 + cl];
            mod[b * 6144 + j] = s; }
          __syncthreads();
      } }
}

template <bool Q8>
__device__ __forceinline__ void phase_modnorm(const Ctx& c0, const float* x, const float* g, int shift_off, int scale_off, bf16_t* dst) {
    Ctx c = c0; c.lane = lane_id_v(); c.tid = c.wave * 64 + c.lane;
    const float* mod = WSP(float, WS_MOD);
    const int gw = c.vcu * 8 + c.wave, NGW = c.G * 8;
    if (gw >= T) return;
    f32x4 vn[4];
    { const f32x4* xr = (const f32x4*)(x + (size_t)gw * D) + c.lane;
#pragma unroll
      for (int j = 0; j < 4; ++j) vn[j] = xr[64 * j]; }
#pragma unroll 1
    for (int m = gw; m < T; m += NGW) {
        const int b = m >> 11;
        f32x4 v[4]; float s = 0.f;
#pragma unroll
        for (int j = 0; j < 4; ++j) { v[j] = vn[j]; s += (v[j].x * v[j].x + v[j].y * v[j].y) + (v[j].z * v[j].z + v[j].w * v[j].w); }
        { const int mn = (m + NGW < T) ? m + NGW : m; const f32x4* xr = (const f32x4*)(x + (size_t)mn * D) + c.lane;
#pragma unroll
          for (int j = 0; j < 4; ++j) vn[j] = xr[64 * j]; }
        const float rstd = rsqrtf(wave_sum(s) * (1.f / D) + EPS);
        u32x2* o8 = (u32x2*)(dst + (size_t)m * D) + c.lane;
        float am = 0.f;
#pragma unroll
        for (int j = 0; j < 4; ++j) {
            const int col = 4 * c.lane + 256 * j;
            const f32x4 gg = *(const f32x4*)(g + col), sc = *(const f32x4*)(mod + b * 6144 + scale_off + col), sh = *(const f32x4*)(mod + b * 6144 + shift_off + col);
            const float r0 = v[j].x * rstd * gg.x * (1.f + sc.x) + sh.x, r1 = v[j].y * rstd * gg.y * (1.f + sc.y) + sh.y;
            const float r2 = v[j].z * rstd * gg.z * (1.f + sc.z) + sh.z, r3 = v[j].w * rstd * gg.w * (1.f + sc.w) + sh.w;
            u32x2 w; w.x = pk2(r0, r1); w.y = pk2(r2, r3); o8[64 * j] = w;
            if (Q8) { v[j].x = r0; v[j].y = r1; v[j].z = r2; v[j].w = r3; am = fmaxf(am, fmaxf(fmaxf(fabsf(r0), fabsf(r1)), fmaxf(fabsf(r2), fabsf(r3)))); }
        }
        if (Q8) {
#pragma unroll
            for (int o = 1; o < 64; o <<= 1) am = fmaxf(am, __shfl_xor(am, o));
            const float sq = am > 0.f ? am * (1.f / 256.f) : 1.f, inv = 1.f / sq;
            unsigned* q8 = (unsigned*)(c.ws + WS_H2Q + (size_t)m * D) + c.lane;
#pragma unroll
            for (int j = 0; j < 4; ++j) { int w = __builtin_amdgcn_cvt_pk_fp8_f32(v[j].x * inv, v[j].y * inv, 0, false); w = __builtin_amdgcn_cvt_pk_fp8_f32(v[j].z * inv, v[j].w * inv, w, true); q8[64 * j] = (unsigned)w; }
            if (c.lane == 0) WSP(float, WS_SH)[m] = sq;
        }
    }
}

__device__ __forceinline__ void phase_conv(const Ctx& c0) {
    Ctx c = c0; c.lane = lane_id_v(); c.tid = c.wave * 64 + c.lane;
    const bf16_t* pa = WSP(bf16_t, WS_R1); const bf16_t* lx = WSP(bf16_t, WS_R2); bf16_t* xc = WSP(bf16_t, WS_R4); float* rstd = WSP(float, WS_RSTD);
    const float* cw = c.in[I_CONVW]; const float* cb = c.in[I_CONVB];
    const int gt = c.vcu * 512 + c.tid, NT = c.G * 512;
    { const int gw = c.vcu * 8 + c.wave, NGW = c.G * 8, L = c.lane;
      for (int t = gw; t < T; t += NGW) {
          float ss = 0.f;
          if (L < 48) { float v[8]; unpack8(*(const u32x4*)(pa + (size_t)t * 512 + 8 * L), v);
#pragma unroll
              for (int j = 0; j < 8; ++j) ss += v[j] * v[j]; }
          const float sq = wave_sum(L < 32 ? ss : 0.f), skv = wave_sum(L >= 32 ? ss : 0.f);
          if (L == 0) { rstd[2 * t] = rsqrtf(sq * (1.f / 256.f) + EPS); rstd[2 * t + 1] = rsqrtf(skv * (1.f / 128.f) + EPS); }
      } }
    { const int* pos = (const int*)c.in[I_POS]; float* CS = WSP(float, WS_CS);
      for (int e = gt; e < T * 16; e += NT) {
          const int t = e >> 4, jj = e & 15;
          const float invf = exp2f(-(float)jj * (13.287712379549449f / 16.f));
          const float ang = (float)pos[t] * invf; const float n = rintf(ang * 0.15915494309189535f);
          const float red = (float)((double)ang - (double)n * 6.283185307179586);
          CS[(size_t)t * 32 + jj] = __cosf(red); CS[(size_t)t * 32 + 16 + jj] = __sinf(red);
      } }
    {
        const int ch = (gt & 127) * 8;
        f32x4 wv[4][2]; f32x4 bv[2];
#pragma unroll
        for (int j = 0; j < 4; ++j) { wv[j][0] = *(const f32x4*)(cw + j * 1024 + ch); wv[j][1] = *(const f32x4*)(cw + j * 1024 + ch + 4); }
        bv[0] = *(const f32x4*)(cb + ch); bv[1] = *(const f32x4*)(cb + ch + 4);
        const int tstep = NT >> 7;
        for (int tq = gt >> 7; tq < T; tq += 4 * tstep) {
            u32x4 raw[4][4];
#pragma unroll
            for (int u = 0; u < 4; ++u) { const int t = tq + u * tstep; const int s = t & 2047;
#pragma unroll
                for (int j = 0; j < 4; ++j) { raw[u][j] = (u32x4){0u, 0u, 0u, 0u}; if (t < T && s - 3 + j >= 0) raw[u][j] = *(const u32x4*)(lx + (size_t)(t - 3 + j) * 1024 + ch); } }
#pragma unroll
            for (int u = 0; u < 4; ++u) { const int t = tq + u * tstep;
                float acc[8] = {bv[0].x, bv[0].y, bv[0].z, bv[0].w, bv[1].x, bv[1].y, bv[1].z, bv[1].w};
#pragma unroll
                for (int j = 0; j < 4; ++j) { float v[8]; unpack8(raw[u][j], v);
                    acc[0] += wv[j][0].x * v[0]; acc[1] += wv[j][0].y * v[1]; acc[2] += wv[j][0].z * v[2]; acc[3] += wv[j][0].w * v[3];
                    acc[4] += wv[j][1].x * v[4]; acc[5] += wv[j][1].y * v[5]; acc[6] += wv[j][1].z * v[6]; acc[7] += wv[j][1].w * v[7]; }
                if (t < T) *(u32x4*)(xc + (size_t)t * 1024 + ch) = pack8(acc); }
        }
    }
}

__device__ __forceinline__ void phase_scan(const Ctx& c0) {
    Ctx c = c0; c.lane = lane_id_v(); c.tid = c.wave * 64 + c.lane;
    const bf16_t* LA = WSP(bf16_t, WS_R0); bf16_t* Bv = WSP(bf16_t, WS_R6); const bf16_t* gate = WSP(bf16_t, WS_R3);
    LAS float* Ps = (LAS float*)c.lds; LAS float* Hs = Ps + 512;
    for (int it = c.vcu; it < 256; it += c.G) {
        const int b = it >> 4, cg = it & 15, seg = c.tid >> 6, ch = cg * 64 + (c.tid & 63);
        const size_t base = ((size_t)b * 2048 + seg * 256) * 1024 + ch;
        float P = 1.f, Hl = 0.f;
#pragma unroll 1
        for (int i0 = 0; i0 < 256; i0 += 16) {
            unsigned la[16], bv[16];
#pragma unroll
            for (int i = 0; i < 16; ++i) { la[i] = LA[base + (size_t)(i0 + i) * 1024]; bv[i] = Bv[base + (size_t)(i0 + i) * 1024]; }
#pragma unroll
            for (int i = 0; i < 16; ++i) { const float a = __builtin_amdgcn_exp2f(bf2f(la[i])); Hl = a * Hl + bf2f(bv[i]); P *= a; }
        }
        Ps[c.tid] = P; Hs[c.tid] = Hl;
        __syncthreads();
        float h = 0.f;
        for (int s2 = 0; s2 < seg; ++s2) h = Ps[s2 * 64 + (c.tid & 63)] * h + Hs[s2 * 64 + (c.tid & 63)];
#pragma unroll 1
        for (int i0 = 0; i0 < 256; i0 += 16) {
            unsigned la[16], bv[16], gv[16]; unsigned ov[16];
#pragma unroll
            for (int i = 0; i < 16; ++i) { la[i] = LA[base + (size_t)(i0 + i) * 1024]; bv[i] = Bv[base + (size_t)(i0 + i) * 1024]; gv[i] = gate[base + (size_t)(i0 + i) * 1024]; }
#pragma unroll
            for (int i = 0; i < 16; ++i) { const float a = __builtin_amdgcn_exp2f(bf2f(la[i])); h = a * h + bf2f(bv[i]); ov[i] = f2bf(h * gelu_tanh(bf2f(gv[i]))); }
#pragma unroll
            for (int i = 0; i < 16; ++i) Bv[base + (size_t)(i0 + i) * 1024] = (bf16_t)ov[i];
        }
        __syncthreads();
    }
}

struct QkvRaw { u32x4 k[2]; f32x4 cs[4]; };
__device__ __forceinline__ void qkv_load(QkvRaw& r, const bf16_t* kvraw, const bf16_t* pa, const float* CS, int t, int ch, int hq) {
    const bool act = ch < 12;
#pragma unroll
    for (int pass = 0; pass < 2; ++pass) { const int h = pass * 4 + hq;
        r.k[pass] = (u32x4){0u, 0u, 0u, 0u};
        if (ch < 8) r.k[pass] = *(const u32x4*)(kvraw + (size_t)t * 1024 + h * 128 + 8 * ch);
        else if (act) r.k[pass] = *(const u32x4*)(pa + (size_t)t * 512 + 384 + 8 * (ch - 8)); }
    const float* cp = CS + (size_t)t * 32 + 8 * (ch & 1);
    r.cs[0] = *(const f32x4*)cp; r.cs[1] = *(const f32x4*)(cp + 4); r.cs[2] = *(const f32x4*)(cp + 16); r.cs[3] = *(const f32x4*)(cp + 20);
}
__device__ __forceinline__ void phase_qkv_layout(const Ctx& c0) {
    Ctx c = c0; c.lane = lane_id_v(); c.tid = c.wave * 64 + c.lane;
    const bf16_t* kvraw = WSP(bf16_t, WS_R2); const bf16_t* pa = WSP(bf16_t, WS_R1);
    bf16_t* Kh = WSP(bf16_t, WS_R3);
    const float* kng = c.in[I_KNG]; const float* CS = WSP(float, WS_CS);
    const int gw = c.vcu * 8 + c.wave, NGW = c.G * 8, L = c.lane;
    const int ch = L & 15, hq = L >> 4;
    const bool act = ch < 12, isr = ch >= 8, hi2 = ch >= 10;
    float gk[8];
#pragma unroll
    for (int j = 0; j < 8; ++j) gk[j] = act ? kng[8 * ch + j] : 0.f;
    if (gw >= T) return;
    QkvRaw cur, nxt;
    qkv_load(cur, kvraw, pa, CS, gw, ch, hq);
#pragma unroll 1
    for (int t = gw; t < T; t += NGW) {
        qkv_load(nxt, kvraw, pa, CS, (t + NGW < T) ? t + NGW : t, ch, hq);
        const int b = t >> 11, s = t & 2047;
        const float cs[8] = {cur.cs[0].x, cur.cs[0].y, cur.cs[0].z, cur.cs[0].w, cur.cs[1].x, cur.cs[1].y, cur.cs[1].z, cur.cs[1].w};
        const float sn[8] = {cur.cs[2].x, cur.cs[2].y, cur.cs[2].z, cur.cs[2].w, cur.cs[3].x, cur.cs[3].y, cur.cs[3].z, cur.cs[3].w};
#pragma unroll
        for (int pass = 0; pass < 2; ++pass) {
            const int h = pass * 4 + hq;
            const size_t orow = ((size_t)(b * H + h) * S + s);
            float v[8]; unpack8(cur.k[pass], v);
            float ss = 0.f;
#pragma unroll
            for (int j = 0; j < 8; ++j) ss += v[j] * v[j];
#pragma unroll
            for (int o = 1; o < 16; o <<= 1) ss += __shfl_xor(ss, o);
            const float r = rsqrtf(ss * (1.f / 96.f) + EPS);
            float x[8], o8[8];
#pragma unroll
            for (int j = 0; j < 8; ++j) x[j] = v[j] * r * gk[j];
#pragma unroll
            for (int j = 0; j < 8; ++j) { const float px = __shfl_xor(x[j], 2);
                o8[j] = !isr ? x[j] : (hi2 ? px * sn[j] + x[j] * cs[j] : x[j] * cs[j] - px * sn[j]); }
            if (act) *(u32x4*)(Kh + orow * 96 + 8 * ch) = pack8(o8);
        }
        cur = nxt;
    }
}

constexpr int KROW = 208, VROW = 160;
constexpr int KBUF = 128 * KROW, VBUF = 128 * VROW;
typedef short v4i16_t __attribute__((ext_vector_type(4)));
__device__ __forceinline__ void attn_chunk2(LAS unsigned char* kb, LAS unsigned char* vb, const bf16x8 (&qf)[2][3], f32x4 (&o)[2][4], float (&mrun)[2], float (&lrun)[2], int fr, int g) {
    f32x4 sacc[2][4];
#pragma unroll
    for (int kt = 0; kt < 4; ++kt) { sacc[0][kt] = (f32x4){0.f, 0.f, 0.f, 0.f}; sacc[1][kt] = (f32x4){0.f, 0.f, 0.f, 0.f};
#pragma unroll
        for (int ks = 0; ks < 3; ++ks) { const bf16x8 kf = *(const LAS bf16x8*)(kb + (16 * kt + fr) * KROW + (ks * 32 + g * 8) * 2);
            sacc[0][kt] = __builtin_amdgcn_mfma_f32_16x16x32_bf16(kf, qf[0][ks], sacc[0][kt], 0, 0, 0);
            sacc[1][kt] = __builtin_amdgcn_mfma_f32_16x16x32_bf16(kf, qf[1][ks], sacc[1][kt], 0, 0, 0); } }
    bf16x8 pb[2][2];
#pragma unroll
    for (int t = 0; t < 2; ++t) {
        float mx = sacc[t][0][0];
#pragma unroll
        for (int kt = 0; kt < 4; ++kt)
#pragma unroll
            for (int r = 0; r < 4; ++r) mx = fmaxf(mx, sacc[t][kt][r]);
        mx = fmaxf(mx, __shfl_xor(mx, 16)); mx = fmaxf(mx, __shfl_xor(mx, 32));
        const float mnew = fmaxf(mrun[t], mx), alpha = __builtin_amdgcn_exp2f(mrun[t] - mnew); mrun[t] = mnew;
        float ps = 0.f;
#pragma unroll
        for (int kt = 0; kt < 4; ++kt)
#pragma unroll
            for (int r = 0; r < 4; ++r) { const float p = __builtin_amdgcn_exp2f(sacc[t][kt][r] - mnew); sacc[t][kt][r] = p; ps += p; }
        lrun[t] = lrun[t] * alpha + ps;
#pragma unroll
        for (int dt = 0; dt < 4; ++dt) o[t][dt] = o[t][dt] * alpha;
#pragma unroll
        for (int s2 = 0; s2 < 2; ++s2) { u32x4 pw; pw.x = pk2(sacc[t][2 * s2][0], sacc[t][2 * s2][1]); pw.y = pk2(sacc[t][2 * s2][2], sacc[t][2 * s2][3]); pw.z = pk2(sacc[t][2 * s2 + 1][0], sacc[t][2 * s2 + 1][1]); pw.w = pk2(sacc[t][2 * s2 + 1][2], sacc[t][2 * s2 + 1][3]);
            pb[t][s2] = __builtin_bit_cast(bf16x8, pw); }
    }
#pragma unroll
    for (int s2 = 0; s2 < 2; ++s2)
#pragma unroll
        for (int dt = 0; dt < 4; ++dt) {
            LAS unsigned char* va = vb + (32 * s2 + 4 * g + (fr >> 2)) * VROW + (16 * dt + 4 * (fr & 3)) * 2;
            const v4i16_t t0 = __builtin_amdgcn_ds_read_tr16_b64_v4i16((LAS v4i16_t*)va), t1 = __builtin_amdgcn_ds_read_tr16_b64_v4i16((LAS v4i16_t*)(va + 16 * VROW));
            const bf16x8 vf = (bf16x8){t0[0], t0[1], t0[2], t0[3], t1[0], t1[1], t1[2], t1[3]};
            o[0][dt] = __builtin_amdgcn_mfma_f32_16x16x32_bf16(vf, pb[0][s2], o[0][dt], 0, 0, 0);
            o[1][dt] = __builtin_amdgcn_mfma_f32_16x16x32_bf16(vf, pb[1][s2], o[1][dt], 0, 0, 0); }
}
__device__ __forceinline__ void attn_unit(const Ctx& c, int b, int h, int qb) {
    const bf16_t* qraw = WSP(bf16_t, WS_R5); const bf16_t* Kh = WSP(bf16_t, WS_R3); const bf16_t* kvraw = WSP(bf16_t, WS_R2); bf16_t* AO = WSP(bf16_t, WS_R0 + 32 * MiB);
    const float* qng = c.in[I_QNG]; const float* CS = WSP(float, WS_CS);
    const int fr = c.lane & 15, g = c.lane >> 4, wid = c.wave;
    const size_t hb = (size_t)(b * H + h) * S;
    const int q0 = qb * 256 + wid * 32;
    const int nsup = 2 * qb + 2;
    const int nch = 4 * qb + (wid >> 1) + 1;
    bf16x8 qf[2][3];
    { const float qscale = 0.10206207261596577f * 1.4426950408889634f;
#pragma unroll
      for (int t = 0; t < 2; ++t) {
          const size_t tok = (size_t)b * S + q0 + 16 * t + fr;
          float v[3][8]; float ss = 0.f;
#pragma unroll
          for (int ks = 0; ks < 3; ++ks) { unpack8(*(const u32x4*)(qraw + tok * 768 + h * 96 + ks * 32 + g * 8), v[ks]);
#pragma unroll
              for (int j = 0; j < 8; ++j) ss += v[ks][j] * v[ks][j]; }
          ss += __shfl_xor(ss, 16); ss += __shfl_xor(ss, 32);
          const float r = rsqrtf(ss * (1.f / 96.f) + EPS) * qscale;
#pragma unroll
          for (int ks = 0; ks < 3; ++ks)
#pragma unroll
              for (int j = 0; j < 8; ++j) v[ks][j] *= r * qng[ks * 32 + g * 8 + j];
          { const float* cp = CS + tok * 32 + 8 * (g & 1);
            const f32x4 c0v = *(const f32x4*)cp, c1v = *(const f32x4*)(cp + 4), s0v = *(const f32x4*)(cp + 16), s1v = *(const f32x4*)(cp + 20);
            const float cs[8] = {c0v.x, c0v.y, c0v.z, c0v.w, c1v.x, c1v.y, c1v.z, c1v.w}, sn[8] = {s0v.x, s0v.y, s0v.z, s0v.w, s1v.x, s1v.y, s1v.z, s1v.w};
#pragma unroll
            for (int j = 0; j < 8; ++j) { const float px = __shfl_xor(v[2][j], 32); v[2][j] = (g >= 2) ? px * sn[j] + v[2][j] * cs[j] : v[2][j] * cs[j] - px * sn[j]; } }
#pragma unroll
          for (int ks = 0; ks < 3; ++ks) qf[t][ks] = __builtin_bit_cast(bf16x8, pack8(v[ks]));
      } }
    f32x4 o[2][4];
#pragma unroll
    for (int t = 0; t < 2; ++t)
#pragma unroll
        for (int dt = 0; dt < 4; ++dt) o[t][dt] = (f32x4){0.f, 0.f, 0.f, 0.f};
    float mrun[2] = {-1e30f, -1e30f}, lrun[2] = {0.f, 0.f};
    u32x4 kr[3], vr[2];
    const u32x4* Ksrc = (const u32x4*)(Kh + hb * 96);
    const bf16_t* Vsrc = kvraw + ((size_t)b * S) * 1024 + h * 128 + 64;
#pragma unroll
    for (int i = 0; i < 3; ++i) kr[i] = Ksrc[c.tid + 512 * i];
#pragma unroll
    for (int i = 0; i < 2; ++i) { const int vc = c.tid + 512 * i; vr[i] = *(const u32x4*)(Vsrc + (size_t)(vc >> 3) * 1024 + (vc & 7) * 8); }
    for (int j = 0; j < nsup; ++j) {
        LAS unsigned char* kb = c.lds + (j & 1) * (KBUF + VBUF); LAS unsigned char* vb = kb + KBUF;
#pragma unroll
        for (int i = 0; i < 3; ++i) { const int kc = c.tid + 512 * i; *(LAS u32x4*)(kb + (kc / 12) * KROW + (kc % 12) * 16) = kr[i]; }
#pragma unroll
        for (int i = 0; i < 2; ++i) { const int vc = c.tid + 512 * i; *(LAS u32x4*)(vb + (vc >> 3) * VROW + (vc & 7) * 16) = vr[i]; }
        __syncthreads();
        if (j + 1 < nsup) {
#pragma unroll
            for (int i = 0; i < 3; ++i) kr[i] = Ksrc[(j + 1) * 1536 + c.tid + 512 * i];
#pragma unroll
            for (int i = 0; i < 2; ++i) { const int vc = c.tid + 512 * i; vr[i] = *(const u32x4*)(Vsrc + (size_t)((j + 1) * 128 + (vc >> 3)) * 1024 + (vc & 7) * 8); }
        }
        if (2 * j < nch) attn_chunk2(kb, vb, qf, o, mrun, lrun, fr, g);
        if (2 * j + 1 < nch) attn_chunk2(kb + 64 * KROW, vb + 64 * VROW, qf, o, mrun, lrun, fr, g);
    }
#pragma unroll
    for (int t = 0; t < 2; ++t) {
        float lt = lrun[t] + __shfl_xor(lrun[t], 16); lt += __shfl_xor(lt, 32);
        const float inv = 1.f / lt;
        bf16_t* orow = AO + ((size_t)b * S + q0 + 16 * t + fr) * 512 + h * 64;
#pragma unroll
        for (int dt = 0; dt < 4; ++dt) { u32x2 w; w.x = pk2(o[t][dt][0] * inv, o[t][dt][1] * inv); w.y = pk2(o[t][dt][2] * inv, o[t][dt][3] * inv); *(u32x2*)(orow + 16 * dt + 4 * g) = w; }
    }
    __syncthreads();
}
__device__ __forceinline__ void phase_attn(const Ctx& c0) {
    Ctx c = c0; c.lane = lane_id_v(); c.tid = c.wave * 64 + c.lane;
    for (int v = c.vcu; v < 256; v += c.G) {
        const int bh = v >> 1, odd = v & 1;
        for (int i = 0; i < 4; ++i) {
            const int setA[4] = {7, 4, 3, 0}, setB[4] = {6, 5, 2, 1};
            int qb = 0;
#pragma unroll
            for (int k = 0; k < 4; ++k) if (k == i) qb = odd ? setB[k] : setA[k];
            attn_unit(c, bh >> 3, bh & 7, qb);
        }
    }
}

__device__ __forceinline__ float wave_max(float v) {
#pragma unroll
    for (int o = 1; o < 64; o <<= 1) v = fmaxf(v, __shfl_xor(v, o));
    return v;
}
__device__ __forceinline__ int wave_min_i(int v) {
#pragma unroll
    for (int o = 1; o < 64; o <<= 1) v = min(v, __shfl_xor(v, o));
    return v;
}
__device__ __forceinline__ int prefix_cnt(unsigned long long m) { return (int)__builtin_amdgcn_mbcnt_hi((unsigned)(m >> 32), __builtin_amdgcn_mbcnt_lo((unsigned)m, 0u)); }
template <int NV, int NBITS> __device__ __forceinline__ void select16(const unsigned (&key)[NV], int (&slot)[NV]) {
    unsigned tau = 0u;
    for (int bit = NBITS - 1; bit >= 0; --bit) {
        const unsigned trial = tau | (1u << bit); int cnt = 0;
#pragma unroll
        for (int j = 0; j < NV; ++j) cnt += __popcll(__ballot(key[j] >= trial));
        if (cnt >= 16) { tau = trial; if (cnt == 16) break; }
    }
    int base = 0;
#pragma unroll
    for (int j = 0; j < NV; ++j) { const unsigned long long m = __ballot(key[j] > tau); slot[j] = (key[j] > tau) ? base + prefix_cnt(m) : -1; base += __popcll(m); }
#pragma unroll
    for (int j = 0; j < NV; ++j) { const unsigned long long m = __ballot(key[j] == tau); if (key[j] == tau) { const int s = base + prefix_cnt(m); slot[j] = s < 16 ? s : -1; } base += __popcll(m); }
}
template <int N> __device__ __forceinline__ void bitonic_stage_desc(unsigned (&x)[N], int k, int j) {
#pragma unroll
    for (int i = 0; i < N; ++i) { const int l = i ^ j; if (l > i) { const bool asc = ((i & k) != 0);
        const unsigned a = x[i], b = x[l]; const unsigned hi = a > b ? a : b, lo = a > b ? b : a; x[i] = asc ? lo : hi; x[l] = asc ? hi : lo; } }
}
__device__ __forceinline__ void sort16_desc(unsigned (&x)[16]) {
#pragma unroll
    for (int k = 2; k <= 16; k <<= 1)
#pragma unroll
        for (int j = k >> 1; j > 0; j >>= 1) bitonic_stage_desc<16>(x, k, j);
}
__device__ __forceinline__ void merge16_desc(unsigned (&run)[16], const unsigned (&ch)[16]) {
#pragma unroll
    for (int i = 0; i < 16; ++i) run[i] = run[i] > ch[15 - i] ? run[i] : ch[15 - i];
#pragma unroll
    for (int j = 8; j > 0; j >>= 1) bitonic_stage_desc<16>(run, 16, j);
}
__device__ __forceinline__ unsigned mono_hi(unsigned w) { return w ^ ((unsigned)((int)w >> 31) | 0x80000000u); }
__device__ __forceinline__ float demono_hi(unsigned k) { const unsigned kk = k & 0xffff0000u; return __builtin_bit_cast(float, (kk ^ ((unsigned)(~(int)kk >> 31) | 0x80000000u)) & 0xffff0000u); }
__device__ __forceinline__ void top16_list(LAS const unsigned char* row, int sw, unsigned (&run)[16]) {
#pragma unroll
    for (int ck = 0; ck < 8; ++ck) {
        const u32x4 w0 = *(LAS const u32x4*)(row + (((2 * ck) ^ sw) << 4)), w1 = *(LAS const u32x4*)(row + (((2 * ck + 1) ^ sw) << 4));
        const unsigned w[8] = {w0.x, w0.y, w0.z, w0.w, w1.x, w1.y, w1.z, w1.w};
        unsigned ch[16];
#pragma unroll
        for (int i = 0; i < 8; ++i) { ch[2 * i] = (mono_hi(w[i] << 16) & 0xffff0000u) | (unsigned)(ck * 16 + 2 * i); ch[2 * i + 1] = (mono_hi(w[i]) & 0xffff0000u) | (unsigned)(ck * 16 + 2 * i + 1); }
        sort16_desc(ch);
        if (ck == 0) {
#pragma unroll
            for (int i = 0; i < 16; ++i) run[i] = ch[i];
        } else merge16_desc(run, ch);
    }
}
__device__ __forceinline__ void topk_fetch(const bf16_t* src, u32x4 (&r)[16], int L) {
#pragma unroll
    for (int i = 0; i < 16; ++i) r[i] = *(const u32x4*)(src + (size_t)(4 * i + (L >> 4)) * 256 + (L & 15) * 8);
}
__device__ __forceinline__ void topk_stage(LAS unsigned char* tile, const u32x4 (&r)[16], int L) {
#pragma unroll
    for (int i = 0; i < 16; ++i) { const int row = 4 * i + (L >> 4); *(LAS u32x4*)(tile + row * 256 + ((((L & 15) ^ (row & 15))) << 4)) = r[i]; }
}
__device__ __forceinline__ void phase_topk(const Ctx& c0) {
    Ctx c = c0; c.lane = lane_id_v(); c.tid = c.wave * 64 + c.lane;
    const bf16_t* sc = WSP(bf16_t, WS_SC); int* IDX = WSP(int, WS_IDX); float* GW = WSP(float, WS_GW);
    const int L = c.lane, gw0 = (c.vcu * 8 + c.wave) * 64, NL = c.G * 512;
    LAS unsigned char* tile = c.lds + c.wave * 16384;
    LAS const unsigned char* myrow = tile + L * 256; const int sw = L & 15;
    for (int eb = gw0; eb < T * H; eb += NL) {
        const int e = eb + L;
        unsigned ka[16], kb[16];
        u32x4 ra[16], rb[16];
        topk_fetch(sc + (size_t)eb * 256, ra, L);
        topk_fetch(sc + (size_t)eb * 256 + 128, rb, L);
        topk_stage(tile, ra, L);
        top16_list(myrow, sw, ka);
        topk_stage(tile, rb, L);
        top16_list(myrow, sw, kb);
        float sa[16], sb[16]; unsigned ia[16], ib[16];
#pragma unroll
        for (int i = 0; i < 16; ++i) { sa[i] = demono_hi(ka[i]); sb[i] = demono_hi(kb[i]); ia[i] = (ka[i] & 0x7fu) << 7; ib[i] = kb[i] & 0x7fu; }
        const float mx = sa[0] + sb[0];
        unsigned run[16], ch[16]; int n = 0, nc = 0;
#pragma unroll
        for (int a = 0; a < 16; ++a)
#pragma unroll
            for (int b = 0; b < 16; ++b) if ((a + 1) * (b + 1) <= 16) {
                const int k = 65535 + (int)((sa[a] + sb[b] - mx) * 1024.f);
                ch[n] = ((unsigned)(k < 0 ? 0 : k) << 16) | ia[a] | ib[b];
                if (++n == 16) { sort16_desc(ch); if (nc == 0) {
#pragma unroll
                        for (int i = 0; i < 16; ++i) run[i] = ch[i]; } else merge16_desc(run, ch);
                    n = 0; ++nc; }
            }
#pragma unroll
        for (int i = 2; i < 16; ++i) ch[i] = 0u;
        sort16_desc(ch); merge16_desc(run, ch);
        float ex[16]; float sum = 0.f;
#pragma unroll
        for (int i = 0; i < 16; ++i) { ex[i] = __expf((float)((int)(run[i] >> 16) - 65535) * (1.f / 1024.f)); sum += ex[i]; }
        const float inv = 1.f / sum;
        u32x4* oi = (u32x4*)(IDX + (size_t)e * 16); f32x4* og = (f32x4*)(GW + (size_t)e * 16);
#pragma unroll
        for (int q = 0; q < 4; ++q) { u32x4 vi; vi.x = run[4 * q] & 0x3fffu; vi.y = run[4 * q + 1] & 0x3fffu; vi.z = run[4 * q + 2] & 0x3fffu; vi.w = run[4 * q + 3] & 0x3fffu; oi[q] = vi;
            f32x4 vg; vg.x = ex[4 * q] * inv; vg.y = ex[4 * q + 1] * inv; vg.z = ex[4 * q + 2] * inv; vg.w = ex[4 * q + 3] * inv; og[q] = vg; }
    }
}

__device__ __forceinline__ void dec32_fp4(const u32x4 r, f32x2 (&f)[16]) {
    const unsigned w[4] = {r.x, r.y, r.z, r.w};
#pragma unroll
    for (int i = 0; i < 4; ++i) { f[4 * i] = __builtin_amdgcn_cvt_scalef32_pk_f32_fp4(w[i], 1.0f, 0); f[4 * i + 1] = __builtin_amdgcn_cvt_scalef32_pk_f32_fp4(w[i], 1.0f, 1);
        f[4 * i + 2] = __builtin_amdgcn_cvt_scalef32_pk_f32_fp4(w[i], 1.0f, 2); f[4 * i + 3] = __builtin_amdgcn_cvt_scalef32_pk_f32_fp4(w[i], 1.0f, 3); }
}
__device__ __forceinline__ float dot32_fp4(const f32x2 (&hv)[16], const u32x4 r) {
    f32x2 f[16]; dec32_fp4(r, f); f32x2 s = hv[0] * f[0];
#pragma unroll
    for (int j = 1; j < 16; ++j) s = s + hv[j] * f[j];
    return s.x + s.y;
}
typedef int i32x8 __attribute__((ext_vector_type(8)));
template <int UV> __device__ __forceinline__ void phase_peer_u(const Ctx& c0) {
    Ctx c = c0; c.lane = lane_id_v(); c.tid = c.wave * 64 + c.lane;
    const int L = c.lane, pp = blockIdx.x & 3, hh = (blockIdx.x >> 2) & 1, rank = blockIdx.x >> 3, nrank = c.G >> 3;
    LAS unsigned char* meta = c.lds + 131584 + c.wave * 2048;
    LAS int* mb = (LAS int*)meta;
    LAS unsigned char* hq = meta + 1536;
    LAS unsigned char* tile = c.lds + c.wave * 16384;
    const int n = L & 15, g4 = L >> 4, lr = L >> 3, lc = L & 7;
    const unsigned char* EUs = c.ws + WS_EU + (size_t)pp * NE * 128 + ((lc ^ (lr >> 1)) << 4);
    const int* IDXl = WSP(int, WS_IDX) + L;
    const unsigned char* H8l = c.ws + WS_H2Q + pp * 256 + 4 * L;
    float* PD = WSP(float, WS_PD) + (size_t)(2 * pp + (n & 1)) * T * 128 + 32 * g4 + 4 * (n >> 1);
    const int t0 = 2 * (rank * 8 + c.wave) + hh, ts = 2 * nrank * 8;
    if (t0 >= T) return;
    const int nk = (T - t0 + ts - 1) / ts;
    int sc1 = 0x7f7f7f7f; asm volatile("" : "+v"(sc1));
    const bool swapb = WSP(unsigned, WS_C8SP)[1024] != 0u;
    const int roff = (n >> 1) * 128 + (((4 * (n & 1) + g4) ^ (n >> 2)) << 4);
    const int hoff = (n & 1) * 128 + g4 * 16;
    const int i0 = n & 1, myP = n >> 1;
#define PEER_U_DMA(m3, q) do { unsigned id_[4]; _Pragma("unroll") for (int Gq = 0; Gq < 4; ++Gq) id_[Gq] = (unsigned)mb[(m3) * 128 + 8 * (4 * (q) + Gq) + lr]; \
        _Pragma("unroll") for (int Gq = 0; Gq < 4; ++Gq) __builtin_amdgcn_global_load_lds((const unsigned*)(EUs + (id_[Gq] << 7)), (LAS unsigned*)(tile + (q) * 4096 + Gq * 1024), 16, 0, 0); } while (0)
#define PEER_U_IDS(m3, tk) do { __builtin_amdgcn_global_load_lds((const unsigned*)(IDXl + (size_t)(tk) * 128), (LAS unsigned*)(mb + (m3) * 128), 4, 0, 0); \
        __builtin_amdgcn_global_load_lds((const unsigned*)(IDXl + (size_t)(tk) * 128 + 64), (LAS unsigned*)(mb + (m3) * 128 + 64), 4, 0, 0); } while (0)
#define PEER_U_HQ(par, tk) __builtin_amdgcn_global_load_lds((const unsigned*)(H8l + (size_t)(tk) * 1024), (LAS unsigned*)(hq + (par) * 256), 4, 0, 0)
#define PEER_U_HB(dst, par) do { int ho = hoff; asm volatile("" : "+v"(ho)); const u32x4 h0 = *(const LAS u32x4*)(hq + (par) * 256 + ho), h1 = *(const LAS u32x4*)(hq + (par) * 256 + ho + 64); \
        unsigned hw[8] = {h0.x, h0.y, h0.z, h0.w, h1.x, h1.y, h1.z, h1.w}; \
        if (swapb) { _Pragma("unroll") for (int q_ = 0; q_ < 8; ++q_) hw[q_] = ((hw[q_] & 0x00ff00ffu) << 8) | ((hw[q_] >> 8) & 0x00ff00ffu); } \
        dst = (i32x8){(int)hw[0], (int)hw[1], (int)hw[2], (int)hw[3], (int)hw[4], (int)hw[5], (int)hw[6], (int)hw[7]}; } while (0)
#define PEER_U_STEP(q, dm3, dq, WAITN) do { \
        PEER_U_DMA(dm3, dq); \
        asm volatile("s_waitcnt vmcnt(" #WAITN ")" ::: "memory"); \
        int ro = roff; asm volatile("" : "+v"(ro)); \
        f32x4 a4[4]; \
        _Pragma("unroll") for (int Gq = 0; Gq < 4; ++Gq) { const u32x4 av = *(const LAS u32x4*)(tile + (q) * 4096 + Gq * 1024 + ro); \
            const i32x8 a = (i32x8){(int)av.x, (int)av.y, (int)av.z, (int)av.w, 0, 0, 0, 0}; \
            a4[Gq] = __builtin_amdgcn_mfma_scale_f32_16x16x128_f8f6f4(a, hb, (f32x4){0.f, 0.f, 0.f, 0.f}, 4, 0, 0, sc1, 0, sc1); } \
        _Pragma("unroll") for (int P = 0; P < 2; ++P) { const f32x4 x0 = a4[2 * P], x1 = a4[2 * P + 1]; \
            const f32x4 cand = (f32x4){i0 ? x0[1] : x0[0], i0 ? x0[3] : x0[2], i0 ? x1[1] : x1[0], i0 ? x1[3] : x1[2]}; \
            if (myP == 2 * (q) + P) o = cand; } \
        asm volatile("s_waitcnt lgkmcnt(0)" ::: "memory"); } while (0)
    PEER_U_IDS(0, t0); PEER_U_IDS(1, (nk > 1) ? t0 + ts : t0); PEER_U_HQ(0, t0);
    asm volatile("s_waitcnt vmcnt(0)" ::: "memory");
    PEER_U_DMA(0, 0); PEER_U_DMA(0, 1); PEER_U_DMA(0, 2);
    i32x8 hb; PEER_U_HB(hb, 0);
    int m0 = 0;
#pragma unroll 1
    for (int k = 0; k < nk; ++k) {
        const int p = k & 1, tk = t0 + k * ts, tn1 = t0 + ((k + 1 < nk) ? k + 1 : nk - 1) * ts, tn2 = t0 + ((k + 2 < nk) ? k + 2 : nk - 1) * ts;
        const int m1 = (m0 == 2) ? 0 : m0 + 1, m2 = (m1 == 2) ? 0 : m1 + 1;
        PEER_U_IDS(m2, tn2); PEER_U_HQ(p ^ 1, tn1);
        f32x4 o = (f32x4){0.f, 0.f, 0.f, 0.f};
        PEER_U_STEP(0, m0, 3, 15);
        PEER_U_STEP(1, m1, 0, 15);
        PEER_U_STEP(2, m1, 1, 15);
        PEER_U_STEP(3, m1, 2, 12);
        *(f32x4*)(PD + (size_t)tk * 128) = o;
        PEER_U_HB(hb, p ^ 1);
        m0 = m1;
    }
    asm volatile("s_waitcnt vmcnt(0)" ::: "memory");
#undef PEER_U_DMA
#undef PEER_U_IDS
#undef PEER_U_HQ
#undef PEER_U_HB
#undef PEER_U_STEP
}
__device__ __forceinline__ void phase_peer_fin_old(const Ctx& c0) {
    Ctx c = c0; c.lane = lane_id_v(); c.tid = c.wave * 64 + c.lane;
    const int* IDX = WSP(int, WS_IDX); const float* GW = WSP(float, WS_GW); const float* PD = WSP(float, WS_PD); unsigned* WGT = WSP(unsigned, WS_WGT);
    const float* SU = WSP(float, WS_SU); const float* SV = WSP(float, WS_SV); const float* SH = WSP(float, WS_SH);
    const int NTH = c.G * 512;
    for (int i0 = c.vcu * 512 + c.tid; i0 < T * 128; i0 += 4 * NTH) {
        float d[4]; int e[4]; float g[4];
#pragma unroll
        for (int u = 0; u < 4; ++u) { const int i = (i0 + u * NTH < T * 128) ? i0 + u * NTH : i0; float s = 0.f;
            const int k = i & 127, pi = (i & ~127) + ((k >> 1) & 3) * 32 + (k >> 3) * 2 + (k & 1);
#pragma unroll
            for (int p = 0; p < 8; ++p) s += PD[(size_t)p * T * 128 + pi];
            d[u] = s; e[u] = IDX[i]; g[u] = GW[i]; }
        float su[4], sv[4], sh[4];
#pragma unroll
        for (int u = 0; u < 4; ++u) { const int i = (i0 + u * NTH < T * 128) ? i0 + u * NTH : i0; su[u] = SU[e[u]]; sv[u] = SV[e[u]]; sh[u] = SH[i >> 7]; }
#pragma unroll
        for (int u = 0; u < 4; ++u) { const int i = i0 + u * NTH; if (i < T * 128) WGT[i] = (f2bf(g[u] * gelu_tanh(d[u] * su[u] * sh[u]) * sv[u]) << 16) | (unsigned)e[u]; }
    }
}
template <bool DRY> __device__ __forceinline__ void phase_peer_v_old(const Ctx& c0) {
    Ctx c = c0; c.lane = lane_id_v(); c.tid = c.wave * 64 + c.lane;
    const unsigned* WI = WSP(unsigned, WS_WGT); const float* mod = WSP(float, WS_MOD);
    const int L = c.lane, pp = blockIdx.x & 3, hh = (blockIdx.x >> 2) & 1, rank = blockIdx.x >> 3, nrank = c.G >> 3;
    const bool b5 = L & 32, b4 = L & 16, b3 = L & 8;
    LAS unsigned* mb = (LAS unsigned*)(c.lds + c.wave * 1024);
    const int kl = L >> 3;
    const unsigned char* EV4 = c.ws + WS_EV + (size_t)pp * NE * 128 + (L & 7) * 16;
    const int col = pp * 256 + (L & 7) * 32 + (b5 ? 16 : 0) + (b4 ? 8 : 0) + (b3 ? 4 : 0);
    const int t0 = 2 * (rank * 8 + c.wave) + hh, ts = 2 * nrank * 8;
    if (t0 >= T) return;
    { const unsigned g0 = WI[(size_t)t0 * 128 + L], g1 = WI[(size_t)t0 * 128 + 64 + L]; mb[L] = g0; mb[64 + L] = g1; }
    u32x4 rA[8], rB[8];
#pragma unroll
    for (int i = 0; i < 8; ++i) rA[i] = *(const u32x4*)(EV4 + (size_t)(mb[8 * i + kl] & 0xffffu) * 128);
    int cur = 0;
#pragma unroll 1
    for (int t = t0; t < T; t += ts) {
        const int tn = (t + ts < T) ? t + ts : t;
        const unsigned gn0 = WI[(size_t)tn * 128 + L], gn1 = WI[(size_t)tn * 128 + 64 + L];
        float* o = c.out + (size_t)t * 1024 + col; const float* g2 = mod + (t >> 11) * 6144 + 5120 + col;
        f32x4 xo = *(const f32x4*)o; const f32x4 gt = *(const f32x4*)g2;
#pragma unroll
        for (int i = 0; i < 8; ++i) rB[i] = *(const u32x4*)(EV4 + (size_t)(mb[cur * 128 + 64 + 8 * i + kl] & 0xffffu) * 128);
        f32x2 ac2[16];
#pragma unroll
        for (int j = 0; j < 16; ++j) ac2[j] = (f32x2){0.f, 0.f};
#pragma unroll
        for (int i = 0; i < 8; ++i) { const float w = bfhi(mb[cur * 128 + 8 * i + kl]); const f32x2 w2 = {w, w}; f32x2 f[16]; dec32_fp4(rA[i], f);
#pragma unroll
            for (int j = 0; j < 16; ++j) ac2[j] = ac2[j] + f[j] * w2; }
        mb[(cur ^ 1) * 128 + L] = gn0; mb[(cur ^ 1) * 128 + 64 + L] = gn1;
#pragma unroll
        for (int i = 0; i < 8; ++i) rA[i] = *(const u32x4*)(EV4 + (size_t)(mb[(cur ^ 1) * 128 + 8 * i + kl] & 0xffffu) * 128);
#pragma unroll
        for (int i = 0; i < 8; ++i) { const float w = bfhi(mb[cur * 128 + 64 + 8 * i + kl]); const f32x2 w2 = {w, w}; f32x2 f[16]; dec32_fp4(rB[i], f);
#pragma unroll
            for (int j = 0; j < 16; ++j) ac2[j] = ac2[j] + f[j] * w2; }
        float acc[32];
#pragma unroll
        for (int j = 0; j < 16; ++j) { acc[2 * j] = ac2[j].x; acc[2 * j + 1] = ac2[j].y; }
        float n16[16], n8[8], n4[4];
#pragma unroll
        for (int i = 0; i < 16; ++i) { const float send = b5 ? acc[i] : acc[i + 16], keep = b5 ? acc[i + 16] : acc[i]; n16[i] = keep + __shfl_xor(send, 32); }
#pragma unroll
        for (int i = 0; i < 8; ++i) { const float send = b4 ? n16[i] : n16[i + 8], keep = b4 ? n16[i + 8] : n16[i]; n8[i] = keep + __shfl_xor(send, 16); }
#pragma unroll
        for (int i = 0; i < 4; ++i) { const float send = b3 ? n8[i] : n8[i + 4], keep = b3 ? n8[i + 4] : n8[i]; n4[i] = keep + __shfl_xor(send, 8); }
        xo.x += gt.x * n4[0]; xo.y += gt.y * n4[1]; xo.z += gt.z * n4[2]; xo.w += gt.w * n4[3];
        if (DRY) asm volatile("" :: "v"(xo.x), "v"(xo.y), "v"(xo.z), "v"(xo.w)); else *(f32x4*)o = xo;
        cur ^= 1;
    }
}

struct ENone {};
struct FInProj { static constexpr int NB = 4; bf16_t *pa, *lx, *lg, *mg; typedef ENone Tile; typedef ENone Pre;
    __device__ __forceinline__ Tile tile(int, int, int) const { return Tile{}; }
    __device__ __forceinline__ Pre pre(int, int, int) const { return Pre{}; }
    __device__ __forceinline__ void apply(int row, int pn, int cc, const float (&v0)[8], const float (&v1)[8], const Pre&, const Tile&) const {
        bf16_t* d;
        if (pn < 2) d = pa + (size_t)row * 512 + pn * 256 + cc; else if (pn < 6) d = lx + (size_t)row * 1024 + (pn - 2) * 256 + cc;
        else if (pn < 10) d = lg + (size_t)row * 1024 + (pn - 6) * 256 + cc; else d = mg + (size_t)row * 2048 + (pn - 10) * 256 + cc;
        *(u32x4*)d = pack8(v0); *(u32x4*)(d + 128) = pack8(v1); } };
struct FRowScale { static constexpr int NB = 4; bf16_t* dst; int ldc; const float* rstd; int which; typedef ENone Tile; struct Pre { float r; };
    __device__ __forceinline__ Tile tile(int, int, int) const { return Tile{}; }
    __device__ __forceinline__ Pre pre(int row, int, int) const { return Pre{rstd[2 * row + which]}; }
    __device__ __forceinline__ void apply(int row, int pn, int cc, const float (&v0)[8], const float (&v1)[8], const Pre& p, const Tile&) const {
        float a[8], b[8];
#pragma unroll
        for (int j = 0; j < 8; ++j) { a[j] = v0[j] * p.r; b[j] = v1[j] * p.r; }
        *(u32x4*)(dst + (size_t)row * ldc + pn * 256 + cc) = pack8(a); *(u32x4*)(dst + (size_t)row * ldc + pn * 256 + 128 + cc) = pack8(b); } };
__device__ __forceinline__ void phase_peer_fin(const Ctx& c0) {
    Ctx c = c0; c.lane = lane_id_v(); c.tid = c.wave * 64 + c.lane;
    const int* IDX = WSP(int, WS_IDX); const float* GW = WSP(float, WS_GW); const float* PD = WSP(float, WS_PD);
    const float* SU = WSP(float, WS_SU); const float* SV = WSP(float, WS_SV); const float* SH = WSP(float, WS_SH);
    unsigned char* W8 = c.ws + WS_W8; float* SWT = WSP(float, WS_SWT);
    const int L = c.lane, gw = c.vcu * 8 + c.wave, NGW = c.G * 8;
    const int pi = (L & 3) * 32 + (L >> 2) * 2;
#pragma unroll 1
    for (int t = gw; t < T; t += 2 * NGW) {
        f32x2 d[2], g[2]; int e0[2], e1[2]; float sh[2];
#pragma unroll
        for (int u = 0; u < 2; ++u) { const int tt = (t + u * NGW < T) ? t + u * NGW : t; f32x2 s = (f32x2){0.f, 0.f};
#pragma unroll
            for (int p = 0; p < 8; ++p) s = s + *(const f32x2*)(PD + (size_t)p * T * 128 + (size_t)tt * 128 + pi);
            d[u] = s; const i32x2 ee = *(const i32x2*)(IDX + (size_t)tt * 128 + 2 * L); e0[u] = ee.x; e1[u] = ee.y; g[u] = *(const f32x2*)(GW + (size_t)tt * 128 + 2 * L); sh[u] = SH[tt]; }
        float su0[2], su1[2], sv0[2], sv1[2];
#pragma unroll
        for (int u = 0; u < 2; ++u) { su0[u] = SU[e0[u]]; su1[u] = SU[e1[u]]; sv0[u] = SV[e0[u]]; sv1[u] = SV[e1[u]]; }
#pragma unroll
        for (int u = 0; u < 2; ++u) { const int tt = t + u * NGW; if (tt < T) {
            const float w0 = g[u].x * gelu_tanh(d[u].x * su0[u] * sh[u]) * sv0[u], w1 = g[u].y * gelu_tanh(d[u].y * su1[u] * sh[u]) * sv1[u];
            float m = fmaxf(fabsf(w0), fabsf(w1));
#pragma unroll
            for (int o = 1; o < 64; o <<= 1) m = fmaxf(m, __shfl_xor(m, o));
            const float sc = m > 0.f ? m * (1.f / 224.f) : 1.f, inv = 1.f / sc;
            const int pk = __builtin_amdgcn_cvt_pk_fp8_f32(w0 * inv, w1 * inv, 0, false);
            *(unsigned short*)(W8 + (size_t)tt * 128 + 2 * L) = (unsigned short)(pk & 0xffff);
            if (L == 0) SWT[tt] = sc; } }
    }
}

template <bool DRY> __device__ __forceinline__ void phase_peer_v(const Ctx& c0) {
    Ctx c = c0; c.lane = lane_id_v(); c.tid = c.wave * 64 + c.lane;
    const float* mod = WSP(float, WS_MOD); const float* SWT = WSP(float, WS_SWT);
    const int L = c.lane, pp = blockIdx.x & 3, hh = (blockIdx.x >> 2) & 1, rank = blockIdx.x >> 3, nrank = c.G >> 3;
    LAS unsigned char* meta = c.lds + 131584 + c.wave * 3072;
    LAS int* mb = (LAS int*)meta;
    LAS unsigned char* wq = meta + 1024;
    LAS unsigned char* stg = meta + 2048;
    LAS unsigned char* tile = c.lds + c.wave * 16384;
    const int n = L & 15, g4 = L >> 4, lr = L >> 3, lc = L & 7;
    const unsigned char* EVe = c.ws + WS_EV + (size_t)pp * NE * 128 + ((lc ^ (lr >> 1)) << 4);
    const unsigned char* EVo = c.ws + WS_EV + (size_t)pp * NE * 128 + ((lc ^ (4 + (lr >> 1))) << 4);
    const int* IDXl = WSP(int, WS_IDX) + L;
    const unsigned char* W8l = c.ws + WS_W8 + 4 * L;
    const int t0 = 2 * (rank * 8 + c.wave) + hh, ts = 2 * nrank * 8;
    if (t0 >= T) return;
    const int nk = (T - t0 + ts - 1) / ts;
    int sc1 = 0x7f7f7f7f; asm volatile("" : "+v"(sc1));
    const bool swapn = WSP(unsigned, WS_C8SP)[1024] != 0u;
    const int rb = (32 * g4 + n) * 128, xs = (n >> 1) & 7;
    const int hoff = g4 * 16;
#define PEER_V_IDS(par, tk) do { __builtin_amdgcn_global_load_lds((const unsigned*)(IDXl + (size_t)(tk) * 128), (LAS unsigned*)(mb + (par) * 128), 4, 0, 0); \
        __builtin_amdgcn_global_load_lds((const unsigned*)(IDXl + (size_t)(tk) * 128 + 64), (LAS unsigned*)(mb + (par) * 128 + 64), 4, 0, 0); } while (0)
#define PEER_V_W8(par, tk) __builtin_amdgcn_global_load_lds((const unsigned*)(W8l + (size_t)(tk) * 128), (LAS unsigned*)(wq + (par) * 256), 4, 0, 0)
#define PEER_V_GATHER(par) do { unsigned id_[16]; _Pragma("unroll") for (int G = 0; G < 16; ++G) id_[G] = (unsigned)mb[(par) * 128 + 8 * G + lr]; \
        _Pragma("unroll") for (int G = 0; G < 16; ++G) __builtin_amdgcn_global_load_lds((const unsigned*)(((G & 1) ? EVo : EVe) + (id_[G] << 7)), (LAS unsigned*)(tile + G * 1024), 16, 0, 0); } while (0)
    PEER_V_IDS(0, t0); PEER_V_IDS(1, (nk > 1) ? t0 + ts : t0); PEER_V_W8(0, t0);
    asm volatile("s_waitcnt vmcnt(0)" ::: "memory");
    PEER_V_GATHER(0);
    const float* o0 = c.out + (size_t)t0 * 1024 + pp * 256 + 4 * L;
    f32x4 xo = *(const f32x4*)o0; f32x4 gt = *(const f32x4*)(mod + (t0 >> 11) * 6144 + 5120 + pp * 256 + 4 * L); float swt = SWT[t0];
#pragma unroll 1
    for (int k = 0; k < nk; ++k) {
        const int p = k & 1, tk = t0 + k * ts, tn1 = t0 + ((k + 1 < nk) ? k + 1 : nk - 1) * ts, tn2 = t0 + ((k + 2 < nk) ? k + 2 : nk - 1) * ts;
        asm volatile("s_waitcnt vmcnt(0)" ::: "memory");
        i32x2 fa[16][2];
        { int rbo = rb, xo_ = xs; asm volatile("" : "+v"(rbo), "+v"(xo_));
#pragma unroll
          for (int cc = 0; cc < 8; ++cc) { const int ad = rbo + ((cc ^ xo_) << 4);
#pragma unroll
              for (int h2 = 0; h2 < 2; ++h2) { const int m = 2 * cc + h2;
                  fa[m][0] = __builtin_amdgcn_ds_read_tr4_b64_v2i32((LAS i32x2*)(tile + ad + h2 * 8));
                  fa[m][1] = __builtin_amdgcn_ds_read_tr4_b64_v2i32((LAS i32x2*)(tile + ad + h2 * 8 + 2048)); } } }
        i32x8 hb;
        { int ho = hoff; asm volatile("" : "+v"(ho)); const u32x4 h0 = *(const LAS u32x4*)(wq + p * 256 + ho), h1 = *(const LAS u32x4*)(wq + p * 256 + ho + 64);
          const bool z = n != 0;
          hb = (i32x8){z ? 0 : (int)h0.x, z ? 0 : (int)h0.y, z ? 0 : (int)h0.z, z ? 0 : (int)h0.w, z ? 0 : (int)h1.x, z ? 0 : (int)h1.y, z ? 0 : (int)h1.z, z ? 0 : (int)h1.w}; }
        asm volatile("s_waitcnt lgkmcnt(0)" ::: "memory");
        float* o = c.out + (size_t)tk * 1024 + pp * 256 + 4 * L;
        PEER_V_IDS(p, tn2); PEER_V_W8(p ^ 1, tn1);
        PEER_V_GATHER(p ^ 1);
        const f32x4 xn = *(const f32x4*)(c.out + (size_t)tn1 * 1024 + pp * 256 + 4 * L), gn = *(const f32x4*)(mod + (tn1 >> 11) * 6144 + 5120 + pp * 256 + 4 * L); const float swn = SWT[tn1];
        f32x4 acc[16];
#pragma unroll
        for (int m = 0; m < 16; ++m) { const i32x8 a = (i32x8){fa[m][0].x, fa[m][0].y, fa[m][1].x, fa[m][1].y, 0, 0, 0, 0};
            acc[m] = __builtin_amdgcn_mfma_scale_f32_16x16x128_f8f6f4(a, hb, (f32x4){0.f, 0.f, 0.f, 0.f}, 4, 0, 0, sc1, 0, sc1); }
        if (n == 0) {
#pragma unroll
            for (int m = 0; m < 16; ++m) { f32x4 v = acc[m]; if (swapn) v = (f32x4){v.y, v.x, v.w, v.z}; *(LAS f32x4*)(stg + (16 * m + 4 * g4) * 4) = v; } }
        const f32x4 r = *(const LAS f32x4*)(stg + 16 * L);
        xo.x += gt.x * swt * r.x; xo.y += gt.y * swt * r.y; xo.z += gt.z * swt * r.z; xo.w += gt.w * swt * r.w;
        if (DRY) asm volatile("" :: "v"(xo.x), "v"(xo.y), "v"(xo.z), "v"(xo.w)); else *(f32x4*)o = xo;
        xo = xn; gt = gn; swt = swn;
    }
    asm volatile("s_waitcnt vmcnt(0)" ::: "memory");
#undef PEER_V_IDS
#undef PEER_V_W8
#undef PEER_V_GATHER
}

constexpr int GT_OFF = 132096;
struct FGates { static constexpr int NB = 2; const bf16_t* xc; bf16_t *LA, *Bv; LAS const float* gt;
    typedef ENone Tile; struct Pre { u32x4 x; };
    __device__ __forceinline__ Tile tile(int, int, int) const { return Tile{}; }
    __device__ __forceinline__ Pre pre(int row, int pn, int cc) const { return Pre{*(const u32x4*)(xc + (size_t)row * 1024 + pn * 128 + cc)}; }
    __device__ __forceinline__ void apply(int row, int pn, int cc, const float (&v0)[8], const float (&v1)[8], const Pre& p, const Tile&) const {
        const int ch = pn * 128 + cc; float x[8], la[8], bv[8]; unpack8(p.x, x);
        const f32x4 br0 = *(LAS const f32x4*)(gt + ch), br1 = *(LAS const f32x4*)(gt + ch + 4), bi0 = *(LAS const f32x4*)(gt + 1024 + ch), bi1 = *(LAS const f32x4*)(gt + 1024 + ch + 4),
                    c80 = *(LAS const f32x4*)(gt + 2048 + ch), c81 = *(LAS const f32x4*)(gt + 2048 + ch + 4);
        const float br[8] = {br0.x, br0.y, br0.z, br0.w, br1.x, br1.y, br1.z, br1.w}, bi[8] = {bi0.x, bi0.y, bi0.z, bi0.w, bi1.x, bi1.y, bi1.z, bi1.w}, c8[8] = {c80.x, c80.y, c80.z, c80.w, c81.x, c81.y, c81.z, c81.w};
#pragma unroll
        for (int j = 0; j < 8; ++j) {
            const float r = __builtin_amdgcn_rcpf(1.f + __expf(-(v0[j] + br[j]))), ig = __builtin_amdgcn_rcpf(1.f + __expf(-(v1[j] + bi[j])));
            const float loga = r * c8[j];
            const float z = 2.f * loga;
            const float ser = -z * (1.f + z * (0.5f + z * (0.16666667f + z * (0.041666668f + z * (0.008333334f + z * 0.0013888889f)))));
            const float om = (z > -0.25f) ? ser : (1.f - __expf(z));
            la[j] = loga * 1.4426950408889634f;
            bv[j] = sqrtf(om) * (ig * x[j]);
        }
        *(u32x4*)(LA + (size_t)row * 1024 + ch) = pack8(la); *(u32x4*)(Bv + (size_t)row * 1024 + ch) = pack8(bv); } };
struct FY1 { static constexpr int NB = 4; const bf16_t* mg; bf16_t* y; int goff; bool accum; typedef ENone Tile; struct Pre { u32x4 g0, g1, y0, y1; };
    __device__ __forceinline__ Tile tile(int, int, int) const { return Tile{}; }
    __device__ __forceinline__ Pre pre(int row, int pn, int cc) const { Pre p; const int col = pn * 256 + cc;
        p.g0 = *(const u32x4*)(mg + (size_t)row * 2048 + goff + col); p.g1 = *(const u32x4*)(mg + (size_t)row * 2048 + goff + col + 128);
        if (accum) { p.y0 = *(const u32x4*)(y + (size_t)row * 1024 + col); p.y1 = *(const u32x4*)(y + (size_t)row * 1024 + col + 128); } else { p.y0 = (u32x4){0u, 0u, 0u, 0u}; p.y1 = p.y0; }
        return p; }
    __device__ __forceinline__ void one(bf16_t* dst, const u32x4 g, const u32x4 yo, const float (&v)[8]) const {
        float gt[8], o[8]; unpack8(g, gt); unpack8(yo, o);
#pragma unroll
        for (int j = 0; j < 8; ++j) o[j] = o[j] + sigmoidf_(gt[j]) * v[j];
        *(u32x4*)dst = pack8(o); }
    __device__ __forceinline__ void apply(int row, int pn, int cc, const float (&v0)[8], const float (&v1)[8], const Pre& p, const Tile&) const {
        bf16_t* d = y + (size_t)row * 1024 + pn * 256 + cc; one(d, p.g0, p.y0, v0); one(d + 128, p.g1, p.y1, v1); } };
struct FX1 { static constexpr int NB = 4; const float* x; float* out; const float* mod; struct Tile { f32x4 a[4]; }; struct Pre { f32x4 x[4]; };
    __device__ __forceinline__ Tile tile(int pn, int cc, int pm) const { Tile t; const float* g1 = mod + ((pm * 256) >> 11) * 6144 + 2048 + pn * 256 + cc;
        t.a[0] = *(const f32x4*)g1; t.a[1] = *(const f32x4*)(g1 + 4); t.a[2] = *(const f32x4*)(g1 + 128); t.a[3] = *(const f32x4*)(g1 + 132); return t; }
    __device__ __forceinline__ Pre pre(int row, int pn, int cc) const { Pre p; const float* xr = x + (size_t)row * 1024 + pn * 256 + cc;
        p.x[0] = *(const f32x4*)xr; p.x[1] = *(const f32x4*)(xr + 4); p.x[2] = *(const f32x4*)(xr + 128); p.x[3] = *(const f32x4*)(xr + 132); return p; }
    __device__ __forceinline__ void apply(int row, int pn, int cc, const float (&v0)[8], const float (&v1)[8], const Pre& p, const Tile& t) const {
        float* o = out + (size_t)row * 1024 + pn * 256 + cc;
        f32x4 r0, r1, r2, r3;
        r0.x = p.x[0].x + t.a[0].x * v0[0]; r0.y = p.x[0].y + t.a[0].y * v0[1]; r0.z = p.x[0].z + t.a[0].z * v0[2]; r0.w = p.x[0].w + t.a[0].w * v0[3];
        r1.x = p.x[1].x + t.a[1].x * v0[4]; r1.y = p.x[1].y + t.a[1].y * v0[5]; r1.z = p.x[1].z + t.a[1].z * v0[6]; r1.w = p.x[1].w + t.a[1].w * v0[7];
        r2.x = p.x[2].x + t.a[2].x * v1[0]; r2.y = p.x[2].y + t.a[2].y * v1[1]; r2.z = p.x[2].z + t.a[2].z * v1[2]; r2.w = p.x[2].w + t.a[2].w * v1[3];
        r3.x = p.x[3].x + t.a[3].x * v1[4]; r3.y = p.x[3].y + t.a[3].y * v1[5]; r3.z = p.x[3].z + t.a[3].z * v1[6]; r3.w = p.x[3].w + t.a[3].w * v1[7];
        *(f32x4*)o = r0; *(f32x4*)(o + 4) = r1; *(f32x4*)(o + 128) = r2; *(f32x4*)(o + 132) = r3; } };
struct FStore { static constexpr int NB = 4; bf16_t* dst; int ldc; typedef ENone Tile; typedef ENone Pre;
    __device__ __forceinline__ Tile tile(int, int, int) const { return Tile{}; }
    __device__ __forceinline__ Pre pre(int, int, int) const { return Pre{}; }
    __device__ __forceinline__ void apply(int row, int pn, int cc, const float (&v0)[8], const float (&v1)[8], const Pre&, const Tile&) const {
        *(u32x4*)(dst + (size_t)row * ldc + pn * 256 + cc) = pack8(v0); *(u32x4*)(dst + (size_t)row * ldc + pn * 256 + 128 + cc) = pack8(v1); } };

template <int M, int N, int K, int LDA, int ACS, class F> __device__ __forceinline__ void run_gemm(const Ctx& c, const bf16_t* A, const bf16_t* Bt, const F& f) {
    pg8::Gemm g{A, Bt}; pg8::StaticOrder<M, N> So; So.init(c.G, (int)blockIdx.x);
    pg8::EpiF<F> E{f};
    pg8::gemm_phase<K, LDA, ACS, pg8::EpiF<F>, pg8::StaticOrder<M, N>>((PG8_LAS unsigned char*)c.lds, g, So, E, c.wave * 64 + lane_id_v());
}

__global__ void __launch_bounds__(512, 2) mk_fwd(Args args) {
    extern __shared__ __attribute__((aligned(16))) unsigned char lds_raw[];
    Ctx c;
    c.lds = (LAS unsigned char*)lds_raw;
    c.wave = __builtin_amdgcn_readfirstlane(threadIdx.x >> 6); c.lane = lane_id_v(); c.tid = c.wave * 64 + c.lane;
    c.G = gridDim.x; { const int bx = blockIdx.x; c.vcu = (c.G % 8 == 0) ? (bx % 8) * (c.G / 8) + bx / 8 : bx; }
    c.in = args.in; c.out = args.out; c.ws = args.ws;
    volatile LAS unsigned* MISC = (volatile LAS unsigned*)(c.lds + MISC_OFF);
    if (c.tid < 32) MISC[c.tid] = 0u;
    __syncthreads();
    XcdBarrier bar; bar.bar = (unsigned*)(c.ws + WS_CTL) + 4096; bar.x = 0; bar.st = nullptr;
    if (args.ph_hi - args.ph_lo > 1) bar = xcd_barrier_post((unsigned*)(c.ws + WS_CTL) + 4096, MISC + 8);

    const int lo = args.ph_lo, hi = args.ph_hi;
#ifndef ONLYP
#define ONLYP -1
#endif
#define IN(k) (lo <= (k) && (k) < hi && (ONLYP < 0 || ONLYP == (k)))
#define SEAM(k) do { if ((k) + 1 < hi) xcd_barrier(bar, c.wave); } while (0)
#ifndef REPEAT_MASK
#define REPEAT_MASK 0
#endif
#define PHASE(k, ...) if (IN(k)) { c.lane = lane_id_v(); c.tid = c.wave * 64 + c.lane; { __VA_ARGS__ } if ((REPEAT_MASK >> (k)) & 1) { xcd_barrier(bar, c.wave); { __VA_ARGS__ } } SEAM(k); }
    PHASE(0, phase_prep(c);)
    PHASE(1, phase_modnorm<false>(c, c.in[I_X], c.in[I_N1G], 0, 1024, WSP(bf16_t, WS_R0));)
    PHASE(2, FInProj f{WSP(bf16_t, WS_R1), WSP(bf16_t, WS_R2), WSP(bf16_t, WS_R3), (bf16_t*)c.out};
             run_gemm<T, 4608, 1024, 1024, 0>(c, WSP(bf16_t, WS_R0), WSP(bf16_t, WS_WIN), f);)
    PHASE(3, phase_conv(c);)
    PHASE(4, { LAS float* gtl = (LAS float*)(c.lds + GT_OFF);
               for (int e = c.tid; e < 1024; e += 512) { gtl[e] = c.in[I_BRG][e]; gtl[1024 + e] = c.in[I_BIG][e]; gtl[2048 + e] = WSP(float, WS_C8SP)[e]; }
               __syncthreads();
               FGates fg{WSP(bf16_t, WS_R4), WSP(bf16_t, WS_R0), WSP(bf16_t, WS_R6), gtl};
               run_gemm<T, 2048, 128, 1024, 128>(c, WSP(bf16_t, WS_R4), WSP(bf16_t, WS_WG), fg); }
             { FRowScale fq{WSP(bf16_t, WS_R5), 768, WSP(float, WS_RSTD), 0};
               run_gemm<T, 768, 256, 512, 0>(c, WSP(bf16_t, WS_R1), WSP(bf16_t, WS_WUQ), fq); })
    PHASE(5, { FRowScale fkv{WSP(bf16_t, WS_R2), 1024, WSP(float, WS_RSTD), 1};
               run_gemm<T, 1024, 128, 512, 0>(c, WSP(bf16_t, WS_R1) + 256, WSP(bf16_t, WS_WUKV), fkv); }
             phase_scan(c);)
    PHASE(6, phase_qkv_layout(c);)
    PHASE(7, phase_attn(c);)
    PHASE(8, { FY1 f1{(const bf16_t*)c.out, WSP(bf16_t, WS_R2), 0, false};
               run_gemm<T, 1024, 512, 512, 0>(c, WSP(bf16_t, WS_R0 + 32 * MiB), WSP(bf16_t, WS_WOA), f1); }
             { FY1 f2{(const bf16_t*)c.out, WSP(bf16_t, WS_R2), 1024, true};
               run_gemm<T, 1024, 1024, 1024, 0>(c, WSP(bf16_t, WS_R6), WSP(bf16_t, WS_WOL), f2); })
    PHASE(9, FX1 f{c.in[I_X], c.out, WSP(float, WS_MOD)};
             run_gemm<T, 1024, 1024, 1024, 0>(c, WSP(bf16_t, WS_R2), WSP(bf16_t, WS_WOUT), f);)
    PHASE(10, phase_modnorm<true>(c, c.out, c.in[I_N2G], 3072, 4096, WSP(bf16_t, WS_R0));)
    PHASE(11, FStore f{WSP(bf16_t, WS_SC), 2048};
              run_gemm<T, 2048, 1024, 1024, 0>(c, WSP(bf16_t, WS_R0), WSP(bf16_t, WS_WQ), f);)
    PHASE(13, phase_topk(c);)
#ifdef PROBE_UVAR
    if (IN(14)) { c.lane = lane_id_v(); c.tid = c.wave * 64 + c.lane; phase_peer_u<PROBE_UVAR>(c); xcd_barrier(bar, c.wave); }
#endif
    PHASE(14, phase_peer_u<0>(c);)
    PHASE(15, phase_peer_fin(c);)
#ifdef PROBE_VDRY
    if (IN(16)) { c.lane = lane_id_v(); c.tid = c.wave * 64 + c.lane; phase_peer_v<true>(c); xcd_barrier(bar, c.wave); }
#endif
    PHASE(16, phase_peer_v<false>(c);)
#undef PHASE
#undef IN
#undef SEAM
}

extern "C" void kernel_launch(void* const* d_in, const int* in_sizes, int n_in, void* d_out, int out_size, void* d_ws, size_t ws_size, hipStream_t stream) {
    static int grid = 0;
    if (grid == 0) {
        if (n_in != 28 || out_size != T * D || ws_size < WS_END) { fprintf(stderr, "kernel_launch: unexpected shapes (n_in %d out %d ws %zu)\n", n_in, out_size, ws_size); grid = -1; return; }
        int dev = 0, cus = 0, per_cu = 0;
        if (hipGetDevice(&dev) != hipSuccess || hipDeviceGetAttribute(&cus, hipDeviceAttributeMultiprocessorCount, dev) != hipSuccess) { grid = -1; return; }
        if (hipFuncSetAttribute((const void*)mk_fwd, hipFuncAttributeMaxDynamicSharedMemorySize, LDS_BYTES) != hipSuccess) { fprintf(stderr, "kernel_launch: hipFuncSetAttribute failed\n"); grid = -1; return; }
        if (hipOccupancyMaxActiveBlocksPerMultiprocessor(&per_cu, (const void*)mk_fwd, 512, LDS_BYTES) != hipSuccess || per_cu < 1) { fprintf(stderr, "kernel_launch: occupancy query says %d blocks per CU\n", per_cu); grid = -1; (void)hipGetLastError(); return; }
        grid = cus - (cus % 8);
        if (grid < 8) { fprintf(stderr, "kernel_launch: needs at least 8 CUs\n"); grid = -1; return; }
    }
    if (grid < 0) return;
    (void)hipMemsetAsync((char*)d_ws + WS_CTL, 0, CTL_ZERO_BYTES, stream);
    Args a{};
    for (int i = 0; i < 28; ++i) a.in[i] = (const float*)d_in[i];
    a.out = (float*)d_out; a.ws = (unsigned char*)d_ws;
#if MK_N_LAUNCHES == 1
    a.ph_lo = 0; a.ph_hi = N_PHASES;
    hipLaunchKernelGGL(mk_fwd, dim3(grid), dim3(512), LDS_BYTES, stream, a);
#else
    for (int ph = 0; ph < N_PHASES; ++ph) { a.ph_lo = ph; a.ph_hi = ph + 1; hipLaunchKernelGGL(mk_fwd, dim3(grid), dim3(512), LDS_BYTES, stream, a); }
#endif
}
```

```cpp
#include <hip/hip_runtime.h>
#include <cstdio>
#include <cstdint>

#define LAS __attribute__((address_space(3)))
#define GAS __attribute__((address_space(1)))
typedef unsigned short bf16_t;
typedef short bf16x8 __attribute__((ext_vector_type(8)));
typedef float f32x4 __attribute__((ext_vector_type(4)));
typedef float f32x2 __attribute__((ext_vector_type(2)));
typedef unsigned u32x4 __attribute__((ext_vector_type(4)));
typedef unsigned u32x2 __attribute__((ext_vector_type(2)));
typedef int i32x2 __attribute__((ext_vector_type(2)));

#ifndef MK_N_LAUNCHES
#define MK_N_LAUNCHES 1
#endif

constexpr int T = 32768, D = 1024, NB_ = 16, S = 2048, H = 8;
constexpr int QKH = 96, VH = 64;
constexpr int NE = 16384;
constexpr float EPS = 1e-6f;

constexpr size_t MiB = 1u << 20;
constexpr size_t WS_CTL = 0, CTL_ZERO_BYTES = 65536;
constexpr size_t WS_MOD = 1 * MiB;
constexpr size_t WS_RSTD = 1 * MiB + 512 * 1024;
constexpr size_t WS_C8SP = 1 * MiB + 448 * 1024;
constexpr size_t WS_WIN = 2 * MiB;
constexpr size_t WS_WUQ = 11 * MiB;
constexpr size_t WS_WUKV = 11 * MiB + 512 * 1024;
constexpr size_t WS_WOA = 12 * MiB;
constexpr size_t WS_WOL = 13 * MiB;
constexpr size_t WS_WOUT = 15 * MiB;
constexpr size_t WS_WQ = 17 * MiB;
constexpr size_t WS_WG = 21 * MiB;
constexpr size_t WS_SK = 22 * MiB;
constexpr size_t WS_EU = 24 * MiB;
constexpr size_t WS_EV = 40 * MiB;
constexpr size_t WS_SU = 1 * MiB + 768 * 1024;
constexpr size_t WS_SV = 1 * MiB + 832 * 1024;
constexpr size_t WS_WGT = 440 * MiB;
constexpr size_t WS_CS = 56 * MiB;
constexpr size_t WS_H2Q = 456 * MiB;
constexpr size_t WS_SH = 1 * MiB + 896 * 1024;
constexpr size_t WS_PD = 280 * MiB;
constexpr size_t WS_R0 = 88 * MiB;
constexpr size_t WS_R1 = 152 * MiB;
constexpr size_t WS_R2 = 184 * MiB;
constexpr size_t WS_R3 = 248 * MiB;
constexpr size_t WS_R4 = 312 * MiB;
constexpr size_t WS_R5 = 376 * MiB;
constexpr size_t WS_R6 = 424 * MiB;
constexpr size_t WS_QP = 152 * MiB;
constexpr size_t WS_SC = 280 * MiB;
constexpr size_t WS_IDX = 408 * MiB;
constexpr size_t WS_GW = 424 * MiB;
constexpr size_t WS_W8 = 440 * MiB;
constexpr size_t WS_END = 488 * MiB;

constexpr int LDS_BYTES = 160256;
constexpr int MISC_OFF = 131072 + 320;

__device__ __forceinline__ unsigned f2bf(float f) { unsigned u = __builtin_bit_cast(unsigned, f); return (u + 0x7fffu + ((u >> 16) & 1u)) >> 16; }
typedef __bf16 bf16x2_t __attribute__((ext_vector_type(2)));
__device__ __forceinline__ unsigned pk2(float lo, float hi) { f32x2 v = {lo, hi}; return __builtin_bit_cast(unsigned, __builtin_convertvector(v, bf16x2_t)); }
__device__ __forceinline__ float bf2f(unsigned h) { return __builtin_bit_cast(float, h << 16); }
__device__ __forceinline__ float bflo(unsigned w) { return __builtin_bit_cast(float, w << 16); }
__device__ __forceinline__ float bfhi(unsigned w) { return __builtin_bit_cast(float, w & 0xffff0000u); }
__device__ __forceinline__ float sigmoidf_(float x) { return 1.f / (1.f + __expf(-x)); }
__device__ __forceinline__ float gelu_tanh(float x) {
    const float u = 0.7978845608028654f * (x + 0.044715f * x * x * x);
    const float e = __expf(2.f * u);
    const float th = 1.f - 2.f / (e + 1.f);
    return 0.5f * x * (1.f + th);
}
__device__ __forceinline__ int lane_id_v() { int l; asm volatile("v_mbcnt_lo_u32_b32 %0, -1, 0\n\tv_mbcnt_hi_u32_b32 %0, -1, %0" : "=v"(l)); return l; }
__device__ __forceinline__ float wave_sum(float v) {
#pragma unroll
    for (int o = 1; o < 64; o <<= 1) v += __shfl_xor(v, o);
    return v;
}
__device__ __forceinline__ void unpack8(const u32x4 w, float (&v)[8]) {
    v[0] = bflo(w.x); v[1] = bfhi(w.x); v[2] = bflo(w.y); v[3] = bfhi(w.y); v[4] = bflo(w.z); v[5] = bfhi(w.z); v[6] = bflo(w.w); v[7] = bfhi(w.w);
}
__device__ __forceinline__ u32x4 pack8(const float (&v)[8]) {
    u32x4 w; w.x = pk2(v[0], v[1]); w.y = pk2(v[2], v[3]); w.z = pk2(v[4], v[5]); w.w = pk2(v[6], v[7]); return w;
}

namespace pg8 {
#define PG8_LAS __attribute__((address_space(3)))
constexpr int BM = 256, BK = 64, HALF = 128, HTB = HALF * BK * 2, STAGE_BYTES = 8 * HTB, NXCD = 8, WGM = 8;
__host__ __device__ __forceinline__ int lds_byte(int r, int c) { const int st = (r >> 4) * 2 + (c >> 5), rr = r & 15, cc = c & 31, ob = rr * 64 + cc * 2; return st * 1024 + (ob ^ (((ob >> 9) & 1) << 5)); }
__host__ __device__ __forceinline__ void stage_rc(int b, int& R, int& C) { const int st = b / 1024, sb = b % 1024, swz = sb ^ (((sb >> 9) & 1) << 5); R = (st >> 1) * 16 + swz / 64; C = (st & 1) * 32 + (swz % 64) / 2; }
__host__ __device__ __forceinline__ int perm32(int rho) { const int n = rho >> 4, i = rho & 15; return 8 * (i >> 2) + 4 * n + (i & 3); }

struct Unit { int pm, pn; };
struct Gemm { const bf16_t* A; const bf16_t* Bt; };

template <int M_, int N_> struct StaticOrder {
    static constexpr int nM = M_ / BM, nN = N_ / BM, nwg = nM * nN;
    int G, c;
    __host__ __device__ void init(int G_, int c_) { G = G_; c = c_; }
    __host__ __device__ bool next(int i, Unit& u) const {
        const long L = (long)i * G + c; if (L >= nwg) return false;
        int wgid = (int)L; { const int q = nwg / NXCD, r = nwg % NXCD, xcd = wgid % NXCD, off = wgid / NXCD; wgid = (xcd < r ? xcd * (q + 1) : r * (q + 1) + (xcd - r) * q) + off; }
        const int nig = WGM * nN, gid = wgid / nig, fm = gid * WGM, gsz = (nM - fm) < WGM ? (nM - fm) : WGM;
        u.pm = fm + ((wgid % nig) % gsz); u.pn = (wgid % nig) / gsz; return true;
    }
};

template <class F> struct EpiF {
    static constexpr bool PERM = true;
    F f;
    __device__ __forceinline__ void operator()(const f32x4 (&acc)[2][2][4][2], const Unit& u, int wr, int wc, int fr, int fq) const {
        { int l_; asm volatile("v_mbcnt_lo_u32_b32 %0, -1, 0\n\tv_mbcnt_hi_u32_b32 %0, -1, %0" : "=v"(l_)); fr = l_ & 15; fq = l_ >> 4; }
        const int c = wc * 32 + 8 * fq;
        const typename F::Tile tl = f.tile(u.pn, c, u.pm);
#pragma unroll
        for (int ai = 0; ai < 2; ++ai)
#pragma unroll
            for (int mb = 0; mb < 4; mb += F::NB) {
                typename F::Pre pre[F::NB];
#pragma unroll
                for (int m = 0; m < F::NB; ++m) pre[m] = f.pre(u.pm * BM + ai * HALF + wr * 64 + (mb + m) * 16 + fr, u.pn, c);
#pragma unroll
                for (int m = 0; m < F::NB; ++m) {
                    const int row = u.pm * BM + ai * HALF + wr * 64 + (mb + m) * 16 + fr;
                    float v0[8], v1[8];
#pragma unroll
                    for (int j = 0; j < 4; ++j) { v0[j] = acc[ai][0][mb + m][0][j]; v0[4 + j] = acc[ai][0][mb + m][1][j]; v1[j] = acc[ai][1][mb + m][0][j]; v1[4 + j] = acc[ai][1][mb + m][1][j]; }
                    f.apply(row, u.pn, c, v0, v1, pre[m], tl);
                }
            }
    }
};

template <int K, int LDA, int ACS, class Epi, class Sched>
__device__ __forceinline__ void gemm_phase(PG8_LAS unsigned char* lds, const Gemm g, const Sched& S, const Epi& E, const int tid) {
    const int wid = __builtin_amdgcn_readfirstlane(tid >> 6), lane = tid & 63, wr = wid >> 2, wc = wid & 3, fr = lane & 15, fq = lane >> 4;
    constexpr int nt = K / BK;
    unsigned voffA[2], voffB[2];
#pragma unroll
    for (int i = 0; i < 2; ++i) { int R, C; stage_rc(tid * 16 + i * 8192, R, C); const int Rb = Epi::PERM ? ((R & ~31) + perm32(R & 31)) : R;
        voffA[i] = (unsigned)(R * LDA + C) * 2u; voffB[i] = (unsigned)(Rb * K + C) * 2u; }
    constexpr size_t kstep = (size_t)(BK * 2);
    constexpr size_t hstepA = (size_t)HALF * LDA * 2, hstepB = (size_t)HALF * K * 2;
    constexpr size_t tstepA = 2 * hstepA, tstepB = 2 * hstepB;
    constexpr size_t acsb = (size_t)ACS * 2;
    const unsigned ldsw = (unsigned)wid * 1024u;
    const int aoff = lds_byte(wr * 64 + fr, fq * 8), boff = lds_byte(wc * 32 + fr, fq * 8);
#define PG8_SA(b, h) (((b) * 2 + (h)) * HTB)
#define PG8_SB(b, h) ((4 + (b) * 2 + (h)) * HTB)
#define PG8_STAGE(bufoff, gbase, voff) do { _Pragma("unroll") for (int _i = 0; _i < 2; ++_i) \
        __builtin_amdgcn_global_load_lds((const unsigned*)((const char*)(gbase) + (voff)[_i]), (PG8_LAS unsigned*)(lds + (bufoff) + ldsw + _i * 8192), 16, 0, 0); } while (0)
#define PG8_LDA(dst, b, h) do { _Pragma("unroll") for (int m = 0; m < 4; ++m) _Pragma("unroll") for (int k = 0; k < 2; ++k) dst[m][k] = *(const PG8_LAS bf16x8*)(lds + PG8_SA(b, h) + aoff + m * 2048 + k * 1024); } while (0)
#define PG8_LDB(dst, b, h) do { _Pragma("unroll") for (int n = 0; n < 2; ++n) _Pragma("unroll") for (int k = 0; k < 2; ++k) dst[n][k] = *(const PG8_LAS bf16x8*)(lds + PG8_SB(b, h) + boff + n * 2048 + k * 1024); } while (0)
#define PG8_MMA(ai, bj, At, Bt) do { __builtin_amdgcn_s_setprio(1); _Pragma("unroll") for (int m = 0; m < 4; ++m) _Pragma("unroll") for (int n = 0; n < 2; ++n) _Pragma("unroll") for (int k = 0; k < 2; ++k) \
        acc[ai][bj][m][n] = __builtin_amdgcn_mfma_f32_16x16x32_bf16(Bt[n][k], At[m][k], acc[ai][bj][m][n], 0, 0, 0); __builtin_amdgcn_s_setprio(0); } while (0)
#define PG8_WAIT_V(n) asm volatile("s_waitcnt vmcnt(" #n ")" ::: "memory")
#define PG8_WAIT_L(n) asm volatile("s_waitcnt lgkmcnt(" #n ")" ::: "memory")
#define PG8_BAR __builtin_amdgcn_s_barrier()
#define PG8_SCHED __builtin_amdgcn_sched_barrier(0)
    Unit cur, nxt; int ui = 0;
    if (!S.next(0, cur)) return;
    f32x4 acc[2][2][4][2];
#pragma unroll
    for (int a = 0; a < 2; ++a)
#pragma unroll
        for (int b = 0; b < 2; ++b)
#pragma unroll
            for (int m = 0; m < 4; ++m)
#pragma unroll
                for (int n = 0; n < 2; ++n) acc[a][b][m][n] = (f32x4){0.f, 0.f, 0.f, 0.f};
    bf16x8 At[4][2], B0[2][2], B1[2][2];
    const char* cA = (const char*)g.A + (size_t)cur.pm * tstepA + (size_t)cur.pn * acsb; const char* cB = (const char*)g.Bt + (size_t)cur.pn * tstepB;
    PG8_STAGE(PG8_SB(0, 0), cB, voffB); PG8_STAGE(PG8_SB(0, 1), cB + hstepB, voffB); PG8_STAGE(PG8_SA(0, 0), cA, voffA); PG8_STAGE(PG8_SA(0, 1), cA + hstepA, voffA);
    if (wr == 1) PG8_BAR;
    PG8_WAIT_V(2); PG8_BAR;
    PG8_STAGE(PG8_SB(1, 0), cB + kstep, voffB); PG8_STAGE(PG8_SA(1, 0), cA + kstep, voffA); PG8_STAGE(PG8_SB(1, 1), cB + hstepB + kstep, voffB);
    PG8_WAIT_V(6); PG8_BAR;
    for (;;) {
        const bool has_next = S.next(ui + 1, nxt);
        const char* nA = has_next ? (const char*)g.A + (size_t)nxt.pm * tstepA + (size_t)nxt.pn * acsb : cA; const char* nB = has_next ? (const char*)g.Bt + (size_t)nxt.pn * tstepB : cB;
#pragma unroll 1
        for (int t = 0; t < nt; t += 2) {
            const bool last = (t == nt - 2);
            const char* a1 = cA + (size_t)(t + 1) * kstep;
            const char* a2 = last ? nA : cA + (size_t)(t + 2) * kstep; const char* b2 = last ? nB : cB + (size_t)(t + 2) * kstep;
            const char* a3 = a2 + kstep; const char* b3 = b2 + kstep;
            PG8_LDB(B0, 0, 0); PG8_LDB(B1, 0, 1); PG8_SCHED; PG8_LDA(At, 0, 0); PG8_STAGE(PG8_SA(1, 1), a1 + hstepA, voffA);
            PG8_WAIT_V(8); PG8_WAIT_L(0); PG8_BAR; PG8_MMA(0, 0, At, B0); PG8_MMA(0, 1, At, B1); PG8_BAR; PG8_SCHED;
            PG8_LDA(At, 0, 1); PG8_STAGE(PG8_SB(0, 0), b2, voffB); PG8_STAGE(PG8_SB(0, 1), b2 + hstepB, voffB); PG8_STAGE(PG8_SA(0, 0), a2, voffA);
            PG8_WAIT_V(8); PG8_WAIT_L(0); PG8_BAR; PG8_MMA(1, 0, At, B0); PG8_MMA(1, 1, At, B1); PG8_BAR; PG8_SCHED;
            PG8_LDB(B0, 1, 0); PG8_LDB(B1, 1, 1); PG8_SCHED; PG8_LDA(At, 1, 0); PG8_STAGE(PG8_SA(0, 1), a2 + hstepA, voffA);
            PG8_WAIT_V(8); PG8_WAIT_L(0); PG8_BAR; PG8_MMA(0, 0, At, B0); PG8_MMA(0, 1, At, B1); PG8_BAR; PG8_SCHED;
            PG8_LDA(At, 1, 1); PG8_STAGE(PG8_SB(1, 0), b3, voffB); PG8_STAGE(PG8_SB(1, 1), b3 + hstepB, voffB); PG8_STAGE(PG8_SA(1, 0), a3, voffA);
            PG8_WAIT_V(8); PG8_WAIT_L(0); PG8_BAR; PG8_MMA(1, 0, At, B0); PG8_MMA(1, 1, At, B1); PG8_BAR; PG8_SCHED;
        }
        if (wr == 0) PG8_BAR;
        E(acc, cur, wr, wc, fr, fq);
        if (!has_next) break;
#pragma unroll
        for (int a = 0; a < 2; ++a)
#pragma unroll
            for (int b = 0; b < 2; ++b)
#pragma unroll
                for (int m = 0; m < 4; ++m)
#pragma unroll
                    for (int n = 0; n < 2; ++n) acc[a][b][m][n] = (f32x4){0.f, 0.f, 0.f, 0.f};
        cur = nxt; cA = nA; cB = nB; ++ui;
        if (wr == 1) PG8_BAR;
    }
    PG8_WAIT_V(0);
    PG8_BAR;
#undef PG8_SA
#undef PG8_SB
#undef PG8_STAGE
#undef PG8_LDA
#undef PG8_LDB
#undef PG8_MMA
#undef PG8_WAIT_V
#undef PG8_WAIT_L
#undef PG8_BAR
#undef PG8_SCHED
}
}

#define XB_TMO      128
#define XB_XCNT(j)  (256  + 64 * (j))
#define XB_XSUB(j)  (1280 + 64 * (j))
#define XB_XGEN(j)  (2304 + 64 * (j))
#define XB_TOP      3328
#define XB_TOPGEN   3392
#define XCD_BAR_WORDS 3456
#define XB_SPIN_CAP (1u << 18)
__device__ __forceinline__ unsigned xb_ld(unsigned* p)              { return __hip_atomic_load(p, __ATOMIC_RELAXED, __HIP_MEMORY_SCOPE_AGENT); }
__device__ __forceinline__ unsigned xb_add(unsigned* p, unsigned v) { return __hip_atomic_fetch_add(p, v, __ATOMIC_RELAXED, __HIP_MEMORY_SCOPE_AGENT); }
__device__ __forceinline__ unsigned xb_xcc_id() { return (unsigned)__builtin_amdgcn_s_getreg((3 << 11) | 20) & 0xFu; }
#define XB_SPIN(cond, bar) do { unsigned _sp = 0; while (cond) { __builtin_amdgcn_s_sleep(1); \
    if ((++_sp & 255u) == 0u) { if (xb_ld(&(bar)[XB_TMO])) break; if (_sp > XB_SPIN_CAP) { atomicAdd(&(bar)[XB_TMO], 1u); break; } } } } while (0)
struct XcdBarrier { unsigned* bar; unsigned x; volatile LAS unsigned* st; };
__device__ __forceinline__ XcdBarrier xcd_barrier_post(unsigned* bar, volatile LAS unsigned* st) {
    XcdBarrier b; b.bar = bar; b.x = xb_xcc_id(); b.st = st;
    if (threadIdx.x == 0) (void)xb_add(&bar[XB_XCNT(b.x)], 1u);
    return b;
}
__device__ __forceinline__ void xcd_barrier_complete(unsigned* bar, unsigned x, unsigned& nloc, unsigned& nx) {
    const unsigned G = gridDim.x * gridDim.y * gridDim.z;
    unsigned sum, cnt, mine, sp = 0u;
    for (;;) {
        sum = 0u; cnt = 0u; mine = 0u;
#pragma unroll
        for (unsigned j = 0; j < 16; ++j) { const unsigned c = xb_ld(&bar[XB_XCNT(j)]); sum += c; cnt += (c > 0u) ? 1u : 0u; mine = (j == x) ? c : mine; }
        if (sum == G) break;
        __builtin_amdgcn_s_sleep(1);
        if ((++sp & 255u) == 0u) { if (xb_ld(&bar[XB_TMO])) break; if (sp > XB_SPIN_CAP) { atomicAdd(&bar[XB_TMO], 1u); break; } }
    }
    nloc = mine > 0u ? mine : 1u; nx = cnt > 0u ? cnt : 1u;
}
__device__ __forceinline__ void xcd_barrier(const XcdBarrier& b, int wave) {
    asm volatile("s_waitcnt vmcnt(0)" ::: "memory");
    __syncthreads();
    if (wave == 0 && lane_id_v() == 0) {
        unsigned* bar = b.bar;
        __builtin_amdgcn_s_waitcnt(0);
        unsigned nloc = b.st[0], nx = b.st[1];
        if (nloc == 0u) { xcd_barrier_complete(bar, b.x, nloc, nx); b.st[0] = nloc; b.st[1] = nx; }
        const unsigned old = xb_add(&bar[XB_XSUB(b.x)], 1u);
        const unsigned gen = old / nloc;
        if (old + 1u == (gen + 1u) * nloc) {
            __builtin_amdgcn_fence(__ATOMIC_RELEASE, "agent");
            asm volatile("s_waitcnt vmcnt(0)" ::: "memory");
            const unsigned og = xb_add(&bar[XB_TOP], 1u);
            const unsigned tg = og / nx;
            if (og + 1u == (tg + 1u) * nx) xb_add(&bar[XB_TOPGEN], 1u);
            else XB_SPIN(xb_ld(&bar[XB_TOPGEN]) == tg, bar);
            __builtin_amdgcn_fence(__ATOMIC_ACQUIRE, "agent");
            xb_add(&bar[XB_XGEN(b.x)], 1u);
            asm volatile("s_waitcnt vmcnt(0)" ::: "memory");
        } else {
            XB_SPIN(xb_ld(&bar[XB_XGEN(b.x)]) == gen, bar);
            __builtin_amdgcn_fence(__ATOMIC_ACQUIRE, "agent");
            asm volatile("s_waitcnt vmcnt(0)" ::: "memory");
        }
    }
    __syncthreads();
}

struct Args { const float* in[28]; float* out; unsigned char* ws; int ph_lo, ph_hi; };
enum { I_X = 0, I_C, I_POS, I_WADA, I_BADA, I_N1G, I_WIN, I_QAG, I_WUQ, I_KVAG, I_WUKV, I_QNG, I_KNG, I_WOA, I_CONVW, I_CONVB, I_WRG, I_BRG, I_WIG, I_BIG, I_LAM, I_WOL, I_WOUT, I_N2G, I_WQ, I_SUBK, I_EU, I_EV };
constexpr int N_PHASES = 17;

struct Ctx {
    LAS unsigned char* lds;
    int tid, lane, wave, vcu, G;
    const float* const* in; float* out; unsigned char* ws;
};
#define WSP(type, off) ((type*)(c.ws + (off)))

template <class F>
__device__ __forceinline__ void tr_tile(const Ctx& c, bf16_t* dst, int K, int n0, int k0, F f) {
    LAS float* scr = (LAS float*)c.lds;
#pragma unroll
    for (int i = 0; i < 8; ++i) { const int kk = i * 8 + (c.tid >> 6), nn = c.tid & 63; scr[kk * 65 + nn] = f(k0 + kk, n0 + nn); }
    __syncthreads();
    { const int kc = c.tid & 7, nn = c.tid >> 3;
      LAS const float* s = scr + (8 * kc) * 65 + nn;
      u32x4 o; o.x = pk2(s[0], s[65]); o.y = pk2(s[2 * 65], s[3 * 65]); o.z = pk2(s[4 * 65], s[5 * 65]); o.w = pk2(s[6 * 65], s[7 * 65]);
      *(u32x4*)(dst + (size_t)(n0 + nn) * K + k0 + 8 * kc) = o; }
    __syncthreads();
}

template <class F>
__device__ __forceinline__ void tr_tile_wave(LAS float* scr, int L, bf16_t* dst, int K, int n0, int k0, F f) {
#pragma unroll 16
    for (int kk = 0; kk < 64; ++kk) scr[kk * 65 + L] = f(k0 + kk, n0 + L);
    asm volatile("s_waitcnt lgkmcnt(0)" ::: "memory");
    const int kc = L & 7;
#pragma unroll
    for (int j = 0; j < 8; ++j) { const int nn = (L >> 3) + 8 * j; LAS const float* s = scr + (8 * kc) * 65 + nn;
        u32x4 o; o.x = pk2(s[0], s[65]); o.y = pk2(s[2 * 65], s[3 * 65]); o.z = pk2(s[4 * 65], s[5 * 65]); o.w = pk2(s[6 * 65], s[7 * 65]);
        *(u32x4*)(dst + (size_t)(n0 + nn) * K + k0 + 8 * kc) = o; }
    asm volatile("s_waitcnt lgkmcnt(0)" ::: "memory");
}
__device__ __forceinline__ void phase_prep(const Ctx& c0) {
    Ctx c = c0; c.lane = lane_id_v(); c.tid = c.wave * 64 + c.lane;
    const float* w_in = c.in[I_WIN]; const float* w_uq = c.in[I_WUQ]; const float* qag = c.in[I_QAG]; const float* w_ukv = c.in[I_WUKV]; const float* kvag = c.in[I_KVAG];
    const float* w_oa = c.in[I_WOA]; const float* w_ol = c.in[I_WOL]; const float* w_out = c.in[I_WOUT]; const float* w_q = c.in[I_WQ];
    const float* w_rg = c.in[I_WRG]; const float* w_ig = c.in[I_WIG];
    constexpr int T_WIN = 72 * 16, T_WUQ = 12 * 4, T_WUKV = 16 * 2, T_WOA = 16 * 8, T_WOL = 16 * 16, T_WOUT = 16 * 16, T_WQ = 32 * 16, T_WG = 8 * 4 * 2;
    constexpr int T_WAVE = T_WIN + T_WUQ + T_WUKV + T_WOA + T_WOL + T_WOUT + T_WG;
    { LAS float* scr = (LAS float*)(c.lds + (c.wave < 7 ? c.wave * 16640 : 131584)); const int L = c.lane;
      static_assert(7 * 16640 <= 131072 && 131584 + 16640 <= LDS_BYTES && 131584 >= MISC_OFF + 128, "prep LDS tiles");
      for (int it = c.vcu * 8 + c.wave; it < T_WAVE; it += c.G * 8) {
        int r = it;
        if (r < T_WIN) { const int nb = r / 16, kb = r % 16;
            tr_tile_wave(scr, L, WSP(bf16_t, WS_WIN), 1024, nb * 64, kb * 64, [=](int k, int n) -> float { return n < 416 ? w_in[(size_t)k * 4512 + n] : (n < 512 ? 0.f : w_in[(size_t)k * 4512 + n - 96]); }); continue; }
        r -= T_WIN;
        if (r < T_WUQ) { const int nb = r / 4, kb = r % 4;
            tr_tile_wave(scr, L, WSP(bf16_t, WS_WUQ), 256, nb * 64, kb * 64, [=](int k, int n) -> float { return w_uq[(size_t)k * 768 + n] * qag[k]; }); continue; }
        r -= T_WUQ;
        if (r < T_WUKV) { const int nb = r / 2, kb = r % 2;
            tr_tile_wave(scr, L, WSP(bf16_t, WS_WUKV), 128, nb * 64, kb * 64, [=](int k, int n) -> float { return w_ukv[(size_t)k * 1024 + n] * kvag[k]; }); continue; }
        r -= T_WUKV;
        if (r < T_WOA) { const int nb = r / 8, kb = r % 8;
            tr_tile_wave(scr, L, WSP(bf16_t, WS_WOA), 512, nb * 64, kb * 64, [=](int k, int n) -> float { return w_oa[(size_t)k * 1024 + n]; }); continue; }
        r -= T_WOA;
        if (r < T_WOL) { const int nb = r / 16, kb = r % 16;
            tr_tile_wave(scr, L, WSP(bf16_t, WS_WOL), 1024, nb * 64, kb * 64, [=](int k, int n) -> float { return w_ol[(size_t)k * 1024 + n]; }); continue; }
        r -= T_WOL;
        if (r < T_WOUT) { const int nb = r / 16, kb = r % 16;
            tr_tile_wave(scr, L, WSP(bf16_t, WS_WOUT), 1024, nb * 64, kb * 64, [=](int k, int n) -> float { return w_out[(size_t)k * 1024 + n]; }); continue; }
        r -= T_WOUT;
        { const int blk = r / 8, q = r % 8, nb = q / 2, kb = q % 2;
            tr_tile_wave(scr, L, WSP(bf16_t, WS_WG) + (size_t)blk * 256 * 128, 128, nb * 64, kb * 64,
                    [=](int k, int n) -> float { return n < 128 ? w_rg[((size_t)blk * 128 + k) * 128 + n] : w_ig[((size_t)blk * 128 + k) * 128 + n - 128]; }); }
      } }
    __syncthreads();
    for (int r = c.vcu; r < T_WQ; r += c.G) {
        const int nb = r / 16, kb = r % 16;
        const int slot = nb >> 1, n0 = (nb & 1) * 64, k0 = kb * 64;
        LAS float* wq_s = (LAS float*)(c.lds + 32768);
        LAS float* sk_s = (LAS float*)(c.lds + 32768 + 64 * 129 * 4);
        const float* skp = c.in[I_SUBK] + ((size_t)slot * 128 + n0) * 128;
        for (int e = c.tid; e < 64 * 128; e += 512) { const int rr = e >> 7, cc = e & 127; wq_s[rr * 129 + cc] = w_q[(size_t)(k0 + rr) * 2048 + slot * 128 + cc]; sk_s[rr * 129 + cc] = skp[(size_t)rr * 128 + cc]; }
        __syncthreads();
        tr_tile(c, WSP(bf16_t, WS_WQ), 1024, nb * 64, k0, [=](int k, int n) -> float { const LAS float* a = wq_s + (k - k0) * 129; const LAS float* b = sk_s + (n - nb * 64) * 129; float s = 0.f;
#pragma unroll 16
            for (int d = 0; d < 128; ++d) s += a[d] * b[d];
            return s; });
    }
    { const float* lam = c.in[I_LAM]; float* t8 = WSP(float, WS_C8SP);
      if (c.vcu == 0) for (int e = c.tid; e < 1024; e += 512) t8[e] = -8.f * log1pf(__expf(-lam[e])); }
    if (c.vcu == 0 && c.tid == 0) {
        const unsigned probe = __builtin_amdgcn_cvt_scalef32_pk_fp4_f32(0u, 1.0f, 0.0f, 1.0f, 0) & 0xffu;
        WSP(unsigned, WS_C8SP)[1024] = (probe == 0x02u) ? 0u : 1u; }
    { const int gw = c.vcu * 8 + c.wave, NGW = c.G * 8, L = c.lane;
      f32x4 vn[4];
      if (gw < 2 * NE) { const f32x4* s4 = (const f32x4*)((gw >= NE ? c.in[I_EV] : c.in[I_EU]) + (size_t)(gw >= NE ? gw - NE : gw) * 1024 + 16 * L);
#pragma unroll
          for (int j = 0; j < 4; ++j) vn[j] = s4[j]; }
#pragma unroll 1
      for (int r = gw; r < 2 * NE; r += NGW) {
          const int isv = r >= NE, e = isv ? r - NE : r;
          f32x4 v[4]; float am = 0.f;
#pragma unroll
          for (int j = 0; j < 4; ++j) { v[j] = vn[j]; am = fmaxf(am, fmaxf(fmaxf(fabsf(v[j].x), fabsf(v[j].y)), fmaxf(fabsf(v[j].z), fabsf(v[j].w)))); }
          { const int rn = (r + NGW < 2 * NE) ? r + NGW : r; const f32x4* s4 = (const f32x4*)((rn >= NE ? c.in[I_EV] : c.in[I_EU]) + (size_t)(rn >= NE ? rn - NE : rn) * 1024 + 16 * L);
#pragma unroll
            for (int j = 0; j < 4; ++j) vn[j] = s4[j]; }
#pragma unroll
          for (int o = 1; o < 64; o <<= 1) am = fmaxf(am, __shfl_xor(am, o));
          const float s = am > 0.f ? am * (1.f / 6.f) : 1.f, inv = 1.f / s;
          unsigned w0 = 0u, w1 = 0u;
          w0 = __builtin_amdgcn_cvt_scalef32_pk_fp4_f32(w0, v[0].x * inv, v[0].y * inv, 1.0f, 0); w0 = __builtin_amdgcn_cvt_scalef32_pk_fp4_f32(w0, v[0].z * inv, v[0].w * inv, 1.0f, 1);
          w0 = __builtin_amdgcn_cvt_scalef32_pk_fp4_f32(w0, v[1].x * inv, v[1].y * inv, 1.0f, 2); w0 = __builtin_amdgcn_cvt_scalef32_pk_fp4_f32(w0, v[1].z * inv, v[1].w * inv, 1.0f, 3);
          w1 = __builtin_amdgcn_cvt_scalef32_pk_fp4_f32(w1, v[2].x * inv, v[2].y * inv, 1.0f, 0); w1 = __builtin_amdgcn_cvt_scalef32_pk_fp4_f32(w1, v[2].z * inv, v[2].w * inv, 1.0f, 1);
          w1 = __builtin_amdgcn_cvt_scalef32_pk_fp4_f32(w1, v[3].x * inv, v[3].y * inv, 1.0f, 2); w1 = __builtin_amdgcn_cvt_scalef32_pk_fp4_f32(w1, v[3].z * inv, v[3].w * inv, 1.0f, 3);
          u32x2 q; q.x = w0; q.y = w1;
          *(u32x2*)(c.ws + (isv ? WS_EV : WS_EU) + ((size_t)(L >> 4) * NE + e) * 128 + (L & 15) * 8) = q;
          if (L == 0) WSP(float, isv ? WS_SV : WS_SU)[e] = s;
      } }
    { const float* cin = c.in[I_C]; const float* w_ada = c.in[I_WADA]; const float* b_ada = c.in[I_BADA]; float* mod = WSP(float, WS_MOD);
      LAS float* cs = (LAS float*)c.lds;
      LAS float* red = (LAS float*)(c.lds + 65536);
      bool have = false;
      for (int it = c.vcu; it < 192; it += c.G) {
          if (!have) { for (int e = c.tid; e < 16 * 1024; e += 512) { const float v = cin[e]; cs[e] = v / (1.f + __expf(-v)); } have = true; }
          __syncthreads();
          const int cl = c.tid & 31, ks = c.tid >> 5, j = it * 32 + cl;
          float acc[16];
#pragma unroll
          for (int b = 0; b < 16; ++b) acc[b] = 0.f;
          for (int kk = 0; kk < 64; ++kk) { const int k = ks * 64 + kk; const float w = w_ada[(size_t)k * 6144 + j];
#pragma unroll
              for (int b = 0; b < 16; ++b) acc[b] += cs[b * 1024 + k] * w; }
#pragma unroll
          for (int b = 0; b < 16; ++b) red[(ks * 16 + b) * 32 + cl] = acc[b];
          __syncthreads();
          { const int b = c.tid >> 5; float s = b_ada[j];
#pragma unroll
            for (int k2 = 0; k2 < 16; ++k2) s += red[(k2 * 16 + b) * 32 + cl];
            mod[b * 6144 + j] = s; }
          __syncthreads();
      } }
}

template <bool Q8>
__device__ __forceinline__ void phase_modnorm(const Ctx& c0, const float* x, const float* g, int shift_off, int scale_off, bf16_t* dst) {
    Ctx c = c0; c.lane = lane_id_v(); c.tid = c.wave * 64 + c.lane;
    const float* mod = WSP(float, WS_MOD);
    const int gw = c.vcu * 8 + c.wave, NGW = c.G * 8;
    if (gw >= T) return;
    f32x4 vn[4];
    { const f32x4* xr = (const f32x4*)(x + (size_t)gw * D) + c.lane;
#pragma unroll
      for (int j = 0; j < 4; ++j) vn[j] = xr[64 * j]; }
#pragma unroll 1
    for (int m = gw; m < T; m += NGW) {
        const int b = m >> 11;
        f32x4 v[4]; float s = 0.f;
#pragma unroll
        for (int j = 0; j < 4; ++j) { v[j] = vn[j]; s += (v[j].x * v[j].x + v[j].y * v[j].y) + (v[j].z * v[j].z + v[j].w * v[j].w); }
        { const int mn = (m + NGW < T) ? m + NGW : m; const f32x4* xr = (const f32x4*)(x + (size_t)mn * D) + c.lane;
#pragma unroll
          for (int j = 0; j < 4; ++j) vn[j] = xr[64 * j]; }
        const float rstd = rsqrtf(wave_sum(s) * (1.f / D) + EPS);
        u32x2* o8 = (u32x2*)(dst + (size_t)m * D) + c.lane;
        float am = 0.f;
#pragma unroll
        for (int j = 0; j < 4; ++j) {
            const int col = 4 * c.lane + 256 * j;
            const f32x4 gg = *(const f32x4*)(g + col), sc = *(const f32x4*)(mod + b * 6144 + scale_off + col), sh = *(const f32x4*)(mod + b * 6144 + shift_off + col);
            const float r0 = v[j].x * rstd * gg.x * (1.f + sc.x) + sh.x, r1 = v[j].y * rstd * gg.y * (1.f + sc.y) + sh.y;
            const float r2 = v[j].z * rstd * gg.z * (1.f + sc.z) + sh.z, r3 = v[j].w * rstd * gg.w * (1.f + sc.w) + sh.w;
            u32x2 w; w.x = pk2(r0, r1); w.y = pk2(r2, r3); o8[64 * j] = w;
            if (Q8) { v[j].x = r0; v[j].y = r1; v[j].z = r2; v[j].w = r3; am = fmaxf(am, fmaxf(fmaxf(fabsf(r0), fabsf(r1)), fmaxf(fabsf(r2), fabsf(r3)))); }
        }
        if (Q8) {
#pragma unroll
            for (int o = 1; o < 64; o <<= 1) am = fmaxf(am, __shfl_xor(am, o));
            const float sq = am > 0.f ? am * (1.f / 256.f) : 1.f, inv = 1.f / sq;
            unsigned* q8 = (unsigned*)(c.ws + WS_H2Q + (size_t)m * D) + c.lane;
#pragma unroll
            for (int j = 0; j < 4; ++j) { int w = __builtin_amdgcn_cvt_pk_fp8_f32(v[j].x * inv, v[j].y * inv, 0, false); w = __builtin_amdgcn_cvt_pk_fp8_f32(v[j].z * inv, v[j].w * inv, w, true); q8[64 * j] = (unsigned)w; }
            if (c.lane == 0) WSP(float, WS_SH)[m] = sq;
        }
    }
}

__device__ __forceinline__ void phase_conv(const Ctx& c0) {
    Ctx c = c0; c.lane = lane_id_v(); c.tid = c.wave * 64 + c.lane;
    const bf16_t* pa = WSP(bf16_t, WS_R1); const bf16_t* lx = WSP(bf16_t, WS_R2); bf16_t* xc = WSP(bf16_t, WS_R4); float* rstd = WSP(float, WS_RSTD);
    const float* cw = c.in[I_CONVW]; const float* cb = c.in[I_CONVB];
    const int gt = c.vcu * 512 + c.tid, NT = c.G * 512;
    { const int gw = c.vcu * 8 + c.wave, NGW = c.G * 8, L = c.lane;
      for (int t = gw; t < T; t += NGW) {
          float ss = 0.f;
          if (L < 48) { float v[8]; unpack8(*(const u32x4*)(pa + (size_t)t * 512 + 8 * L), v);
#pragma unroll
              for (int j = 0; j < 8; ++j) ss += v[j] * v[j]; }
          const float sq = wave_sum(L < 32 ? ss : 0.f), skv = wave_sum(L >= 32 ? ss : 0.f);
          if (L == 0) { rstd[2 * t] = rsqrtf(sq * (1.f / 256.f) + EPS); rstd[2 * t + 1] = rsqrtf(skv * (1.f / 128.f) + EPS); }
      } }
    { const int* pos = (const int*)c.in[I_POS]; float* CS = WSP(float, WS_CS);
      for (int e = gt; e < T * 16; e += NT) {
          const int t = e >> 4, jj = e & 15;
          const float invf = exp2f(-(float)jj * (13.287712379549449f / 16.f));
          const float ang = (float)pos[t] * invf; const float n = rintf(ang * 0.15915494309189535f);
          const float red = (float)((double)ang - (double)n * 6.283185307179586);
          CS[(size_t)t * 32 + jj] = __cosf(red); CS[(size_t)t * 32 + 16 + jj] = __sinf(red);
      } }
    {
        const int ch = (gt & 127) * 8;
        f32x4 wv[4][2]; f32x4 bv[2];
#pragma unroll
        for (int j = 0; j < 4; ++j) { wv[j][0] = *(const f32x4*)(cw + j * 1024 + ch); wv[j][1] = *(const f32x4*)(cw + j * 1024 + ch + 4); }
        bv[0] = *(const f32x4*)(cb + ch); bv[1] = *(const f32x4*)(cb + ch + 4);
        const int tstep = NT >> 7;
        for (int tq = gt >> 7; tq < T; tq += 4 * tstep) {
            u32x4 raw[4][4];
#pragma unroll
            for (int u = 0; u < 4; ++u) { const int t = tq + u * tstep; const int s = t & 2047;
#pragma unroll
                for (int j = 0; j < 4; ++j) { raw[u][j] = (u32x4){0u, 0u, 0u, 0u}; if (t < T && s - 3 + j >= 0) raw[u][j] = *(const u32x4*)(lx + (size_t)(t - 3 + j) * 1024 + ch); } }
#pragma unroll
            for (int u = 0; u < 4; ++u) { const int t = tq + u * tstep;
                float acc[8] = {bv[0].x, bv[0].y, bv[0].z, bv[0].w, bv[1].x, bv[1].y, bv[1].z, bv[1].w};
#pragma unroll
                for (int j = 0; j < 4; ++j) { float v[8]; unpack8(raw[u][j], v);
                    acc[0] += wv[j][0].x * v[0]; acc[1] += wv[j][0].y * v[1]; acc[2] += wv[j][0].z * v[2]; acc[3] += wv[j][0].w * v[3];
                    acc[4] += wv[j][1].x * v[4]; acc[5] += wv[j][1].y * v[5]; acc[6] += wv[j][1].z * v[6]; acc[7] += wv[j][1].w * v[7]; }
                if (t < T) *(u32x4*)(xc + (size_t)t * 1024 + ch) = pack8(acc); }
        }
    }
}

__device__ __forceinline__ void phase_scan(const Ctx& c0) {
    Ctx c = c0; c.lane = lane_id_v(); c.tid = c.wave * 64 + c.lane;
    const bf16_t* LA = WSP(bf16_t, WS_R0); bf16_t* Bv = WSP(bf16_t, WS_R6); const bf16_t* gate = WSP(bf16_t, WS_R3);
    LAS float* Ps = (LAS float*)c.lds; LAS float* Hs = Ps + 512;
    for (int it = c.vcu; it < 256; it += c.G) {
        const int b = it >> 4, cg = it & 15, seg = c.tid >> 6, ch = cg * 64 + (c.tid & 63);
        const size_t base = ((size_t)b * 2048 + seg * 256) * 1024 + ch;
        float P = 1.f, Hl = 0.f;
#pragma unroll 1
        for (int i0 = 0; i0 < 256; i0 += 16) {
            unsigned la[16], bv[16];
#pragma unroll
            for (int i = 0; i < 16; ++i) { la[i] = LA[base + (size_t)(i0 + i) * 1024]; bv[i] = Bv[base + (size_t)(i0 + i) * 1024]; }
#pragma unroll
            for (int i = 0; i < 16; ++i) { const float a = __builtin_amdgcn_exp2f(bf2f(la[i])); Hl = a * Hl + bf2f(bv[i]); P *= a; }
        }
        Ps[c.tid] = P; Hs[c.tid] = Hl;
        __syncthreads();
        float h = 0.f;
        for (int s2 = 0; s2 < seg; ++s2) h = Ps[s2 * 64 + (c.tid & 63)] * h + Hs[s2 * 64 + (c.tid & 63)];
#pragma unroll 1
        for (int i0 = 0; i0 < 256; i0 += 16) {
            unsigned la[16], bv[16], gv[16]; unsigned ov[16];
#pragma unroll
            for (int i = 0; i < 16; ++i) { la[i] = LA[base + (size_t)(i0 + i) * 1024]; bv[i] = Bv[base + (size_t)(i0 + i) * 1024]; gv[i] = gate[base + (size_t)(i0 + i) * 1024]; }
#pragma unroll
            for (int i = 0; i < 16; ++i) { const float a = __builtin_amdgcn_exp2f(bf2f(la[i])); h = a * h + bf2f(bv[i]); ov[i] = f2bf(h * gelu_tanh(bf2f(gv[i]))); }
#pragma unroll
            for (int i = 0; i < 16; ++i) Bv[base + (size_t)(i0 + i) * 1024] = (bf16_t)ov[i];
        }
        __syncthreads();
    }
}

struct QkvRaw { u32x4 k[2]; f32x4 cs[4]; };
__device__ __forceinline__ void qkv_load(QkvRaw& r, const bf16_t* kvraw, const bf16_t* pa, const float* CS, int t, int ch, int hq) {
    const bool act = ch < 12;
#pragma unroll
    for (int pass = 0; pass < 2; ++pass) { const int h = pass * 4 + hq;
        r.k[pass] = (u32x4){0u, 0u, 0u, 0u};
        if (ch < 8) r.k[pass] = *(const u32x4*)(kvraw + (size_t)t * 1024 + h * 128 + 8 * ch);
        else if (act) r.k[pass] = *(const u32x4*)(pa + (size_t)t * 512 + 384 + 8 * (ch - 8)); }
    const float* cp = CS + (size_t)t * 32 + 8 * (ch & 1);
    r.cs[0] = *(const f32x4*)cp; r.cs[1] = *(const f32x4*)(cp + 4); r.cs[2] = *(const f32x4*)(cp + 16); r.cs[3] = *(const f32x4*)(cp + 20);
}
__device__ __forceinline__ void phase_qkv_layout(const Ctx& c0) {
    Ctx c = c0; c.lane = lane_id_v(); c.tid = c.wave * 64 + c.lane;
    const bf16_t* kvraw = WSP(bf16_t, WS_R2); const bf16_t* pa = WSP(bf16_t, WS_R1);
    bf16_t* Kh = WSP(bf16_t, WS_R3);
    const float* kng = c.in[I_KNG]; const float* CS = WSP(float, WS_CS);
    const int gw = c.vcu * 8 + c.wave, NGW = c.G * 8, L = c.lane;
    const int ch = L & 15, hq = L >> 4;
    const bool act = ch < 12, isr = ch >= 8, hi2 = ch >= 10;
    float gk[8];
#pragma unroll
    for (int j = 0; j < 8; ++j) gk[j] = act ? kng[8 * ch + j] : 0.f;
    if (gw >= T) return;
    QkvRaw cur, nxt;
    qkv_load(cur, kvraw, pa, CS, gw, ch, hq);
#pragma unroll 1
    for (int t = gw; t < T; t += NGW) {
        qkv_load(nxt, kvraw, pa, CS, (t + NGW < T) ? t + NGW : t, ch, hq);
        const int b = t >> 11, s = t & 2047;
        const float cs[8] = {cur.cs[0].x, cur.cs[0].y, cur.cs[0].z, cur.cs[0].w, cur.cs[1].x, cur.cs[1].y, cur.cs[1].z, cur.cs[1].w};
        const float sn[8] = {cur.cs[2].x, cur.cs[2].y, cur.cs[2].z, cur.cs[2].w, cur.cs[3].x, cur.cs[3].y, cur.cs[3].z, cur.cs[3].w};
#pragma unroll
        for (int pass = 0; pass < 2; ++pass) {
            const int h = pass * 4 + hq;
            const size_t orow = ((size_t)(b * H + h) * S + s);
            float v[8]; unpack8(cur.k[pass], v);
            float ss = 0.f;
#pragma unroll
            for (int j = 0; j < 8; ++j) ss += v[j] * v[j];
#pragma unroll
            for (int o = 1; o < 16; o <<= 1) ss += __shfl_xor(ss, o);
            const float r = rsqrtf(ss * (1.f / 96.f) + EPS);
            float x[8], o8[8];
#pragma unroll
            for (int j = 0; j < 8; ++j) x[j] = v[j] * r * gk[j];
#pragma unroll
            for (int j = 0; j < 8; ++j) { const float px = __shfl_xor(x[j], 2);
                o8[j] = !isr ? x[j] : (hi2 ? px * sn[j] + x[j] * cs[j] : x[j] * cs[j] - px * sn[j]); }
            if (act) *(u32x4*)(Kh + orow * 96 + 8 * ch) = pack8(o8);
        }
        cur = nxt;
    }
}

constexpr int KROW = 208, VROW = 160;
constexpr int KBUF = 128 * KROW, VBUF = 128 * VROW;
typedef short v4i16_t __attribute__((ext_vector_type(4)));
__device__ __forceinline__ void attn_chunk2(LAS unsigned char* kb, LAS unsigned char* vb, const bf16x8 (&qf)[2][3], f32x4 (&o)[2][4], float (&mrun)[2], float (&lrun)[2], int fr, int g) {
    f32x4 sacc[2][4];
#pragma unroll
    for (int kt = 0; kt < 4; ++kt) { sacc[0][kt] = (f32x4){0.f, 0.f, 0.f, 0.f}; sacc[1][kt] = (f32x4){0.f, 0.f, 0.f, 0.f};
#pragma unroll
        for (int ks = 0; ks < 3; ++ks) { const bf16x8 kf = *(const LAS bf16x8*)(kb + (16 * kt + fr) * KROW + (ks * 32 + g * 8) * 2);
            sacc[0][kt] = __builtin_amdgcn_mfma_f32_16x16x32_bf16(kf, qf[0][ks], sacc[0][kt], 0, 0, 0);
            sacc[1][kt] = __builtin_amdgcn_mfma_f32_16x16x32_bf16(kf, qf[1][ks], sacc[1][kt], 0, 0, 0); } }
    bf16x8 pb[2][2];
#pragma unroll
    for (int t = 0; t < 2; ++t) {
        float mx = sacc[t][0][0];
#pragma unroll
        for (int kt = 0; kt < 4; ++kt)
#pragma unroll
            for (int r = 0; r < 4; ++r) mx = fmaxf(mx, sacc[t][kt][r]);
        mx = fmaxf(mx, __shfl_xor(mx, 16)); mx = fmaxf(mx, __shfl_xor(mx, 32));
        const float mnew = fmaxf(mrun[t], mx), alpha = __builtin_amdgcn_exp2f(mrun[t] - mnew); mrun[t] = mnew;
        float ps = 0.f;
#pragma unroll
        for (int kt = 0; kt < 4; ++kt)
#pragma unroll
            for (int r = 0; r < 4; ++r) { const float p = __builtin_amdgcn_exp2f(sacc[t][kt][r] - mnew); sacc[t][kt][r] = p; ps += p; }
        lrun[t] = lrun[t] * alpha + ps;
#pragma unroll
        for (int dt = 0; dt < 4; ++dt) o[t][dt] = o[t][dt] * alpha;
#pragma unroll
        for (int s2 = 0; s2 < 2; ++s2) { u32x4 pw; pw.x = pk2(sacc[t][2 * s2][0], sacc[t][2 * s2][1]); pw.y = pk2(sacc[t][2 * s2][2], sacc[t][2 * s2][3]); pw.z = pk2(sacc[t][2 * s2 + 1][0], sacc[t][2 * s2 + 1][1]); pw.w = pk2(sacc[t][2 * s2 + 1][2], sacc[t][2 * s2 + 1][3]);
            pb[t][s2] = __builtin_bit_cast(bf16x8, pw); }
    }
#pragma unroll
    for (int s2 = 0; s2 < 2; ++s2)
#pragma unroll
        for (int dt = 0; dt < 4; ++dt) {
            LAS unsigned char* va = vb + (32 * s2 + 4 * g + (fr >> 2)) * VROW + (16 * dt + 4 * (fr & 3)) * 2;
            const v4i16_t t0 = __builtin_amdgcn_ds_read_tr16_b64_v4i16((LAS v4i16_t*)va), t1 = __builtin_amdgcn_ds_read_tr16_b64_v4i16((LAS v4i16_t*)(va + 16 * VROW));
            const bf16x8 vf = (bf16x8){t0[0], t0[1], t0[2], t0[3], t1[0], t1[1], t1[2], t1[3]};
            o[0][dt] = __builtin_amdgcn_mfma_f32_16x16x32_bf16(vf, pb[0][s2], o[0][dt], 0, 0, 0);
            o[1][dt] = __builtin_amdgcn_mfma_f32_16x16x32_bf16(vf, pb[1][s2], o[1][dt], 0, 0, 0); }
}
__device__ __forceinline__ void attn_unit(const Ctx& c, int b, int h, int qb) {
    const bf16_t* qraw = WSP(bf16_t, WS_R5); const bf16_t* Kh = WSP(bf16_t, WS_R3); const bf16_t* kvraw = WSP(bf16_t, WS_R2); bf16_t* AO = WSP(bf16_t, WS_R0 + 32 * MiB);
    const float* qng = c.in[I_QNG]; const float* CS = WSP(float, WS_CS);
    const int fr = c.lane & 15, g = c.lane >> 4, wid = c.wave;
    const size_t hb = (size_t)(b * H + h) * S;
    const int q0 = qb * 256 + wid * 32;
    const int nsup = 2 * qb + 2;
    const int nch = 4 * qb + (wid >> 1) + 1;
    bf16x8 qf[2][3];
    { const float qscale = 0.10206207261596577f * 1.4426950408889634f;
#pragma unroll
      for (int t = 0; t < 2; ++t) {
          const size_t tok = (size_t)b * S + q0 + 16 * t + fr;
          float v[3][8]; float ss = 0.f;
#pragma unroll
          for (int ks = 0; ks < 3; ++ks) { unpack8(*(const u32x4*)(qraw + tok * 768 + h * 96 + ks * 32 + g * 8), v[ks]);
#pragma unroll
              for (int j = 0; j < 8; ++j) ss += v[ks][j] * v[ks][j]; }
          ss += __shfl_xor(ss, 16); ss += __shfl_xor(ss, 32);
          const float r = rsqrtf(ss * (1.f / 96.f) + EPS) * qscale;
#pragma unroll
          for (int ks = 0; ks < 3; ++ks)
#pragma unroll
              for (int j = 0; j < 8; ++j) v[ks][j] *= r * qng[ks * 32 + g * 8 + j];
          { const float* cp = CS + tok * 32 + 8 * (g & 1);
            const f32x4 c0v = *(const f32x4*)cp, c1v = *(const f32x4*)(cp + 4), s0v = *(const f32x4*)(cp + 16), s1v = *(const f32x4*)(cp + 20);
            const float cs[8] = {c0v.x, c0v.y, c0v.z, c0v.w, c1v.x, c1v.y, c1v.z, c1v.w}, sn[8] = {s0v.x, s0v.y, s0v.z, s0v.w, s1v.x, s1v.y, s1v.z, s1v.w};
#pragma unroll
            for (int j = 0; j < 8; ++j) { const float px = __shfl_xor(v[2][j], 32); v[2][j] = (g >= 2) ? px * sn[j] + v[2][j] * cs[j] : v[2][j] * cs[j] - px * sn[j]; } }
#pragma unroll
          for (int ks = 0; ks < 3; ++ks) qf[t][ks] = __builtin_bit_cast(bf16x8, pack8(v[ks]));
      } }
    f32x4 o[2][4];
#pragma unroll
    for (int t = 0; t < 2; ++t)
#pragma unroll
        for (int dt = 0; dt < 4; ++dt) o[t][dt] = (f32x4){0.f, 0.f, 0.f, 0.f};
    float mrun[2] = {-1e30f, -1e30f}, lrun[2] = {0.f, 0.f};
    u32x4 kr[3], vr[2];
    const u32x4* Ksrc = (const u32x4*)(Kh + hb * 96);
    const bf16_t* Vsrc = kvraw + ((size_t)b * S) * 1024 + h * 128 + 64;
#pragma unroll
    for (int i = 0; i < 3; ++i) kr[i] = Ksrc[c.tid + 512 * i];
#pragma unroll
    for (int i = 0; i < 2; ++i) { const int vc = c.tid + 512 * i; vr[i] = *(const u32x4*)(Vsrc + (size_t)(vc >> 3) * 1024 + (vc & 7) * 8); }
    for (int j = 0; j < nsup; ++j) {
        LAS unsigned char* kb = c.lds + (j & 1) * (KBUF + VBUF); LAS unsigned char* vb = kb + KBUF;
#pragma unroll
        for (int i = 0; i < 3; ++i) { const int kc = c.tid + 512 * i; *(LAS u32x4*)(kb + (kc / 12) * KROW + (kc % 12) * 16) = kr[i]; }
#pragma unroll
        for (int i = 0; i < 2; ++i) { const int vc = c.tid + 512 * i; *(LAS u32x4*)(vb + (vc >> 3) * VROW + (vc & 7) * 16) = vr[i]; }
        __syncthreads();
        if (j + 1 < nsup) {
#pragma unroll
            for (int i = 0; i < 3; ++i) kr[i] = Ksrc[(j + 1) * 1536 + c.tid + 512 * i];
#pragma unroll
            for (int i = 0; i < 2; ++i) { const int vc = c.tid + 512 * i; vr[i] = *(const u32x4*)(Vsrc + (size_t)((j + 1) * 128 + (vc >> 3)) * 1024 + (vc & 7) * 8); }
        }
        if (2 * j < nch) attn_chunk2(kb, vb, qf, o, mrun, lrun, fr, g);
        if (2 * j + 1 < nch) attn_chunk2(kb + 64 * KROW, vb + 64 * VROW, qf, o, mrun, lrun, fr, g);
    }
#pragma unroll
    for (int t = 0; t < 2; ++t) {
        float lt = lrun[t] + __shfl_xor(lrun[t], 16); lt += __shfl_xor(lt, 32);
        const float inv = 1.f / lt;
        bf16_t* orow = AO + ((size_t)b * S + q0 + 16 * t + fr) * 512 + h * 64;
#pragma unroll
        for (int dt = 0; dt < 4; ++dt) { u32x2 w; w.x = pk2(o[t][dt][0] * inv, o[t][dt][1] * inv); w.y = pk2(o[t][dt][2] * inv, o[t][dt][3] * inv); *(u32x2*)(orow + 16 * dt + 4 * g) = w; }
    }
    __syncthreads();
}
__device__ __forceinline__ void phase_attn(const Ctx& c0) {
    Ctx c = c0; c.lane = lane_id_v(); c.tid = c.wave * 64 + c.lane;
    for (int v = c.vcu; v < 256; v += c.G) {
        const int bh = v >> 1, odd = v & 1;
        for (int i = 0; i < 4; ++i) {
            const int setA[4] = {7, 4, 3, 0}, setB[4] = {6, 5, 2, 1};
            int qb = 0;
#pragma unroll
            for (int k = 0; k < 4; ++k) if (k == i) qb = odd ? setB[k] : setA[k];
            attn_unit(c, bh >> 3, bh & 7, qb);
        }
    }
}

__device__ __forceinline__ float wave_max(float v) {
#pragma unroll
    for (int o = 1; o < 64; o <<= 1) v = fmaxf(v, __shfl_xor(v, o));
    return v;
}
__device__ __forceinline__ int wave_min_i(int v) {
#pragma unroll
    for (int o = 1; o < 64; o <<= 1) v = min(v, __shfl_xor(v, o));
    return v;
}
__device__ __forceinline__ int prefix_cnt(unsigned long long m) { return (int)__builtin_amdgcn_mbcnt_hi((unsigned)(m >> 32), __builtin_amdgcn_mbcnt_lo((unsigned)m, 0u)); }
template <int NV, int NBITS> __device__ __forceinline__ void select16(const unsigned (&key)[NV], int (&slot)[NV]) {
    unsigned tau = 0u;
    for (int bit = NBITS - 1; bit >= 0; --bit) {
        const unsigned trial = tau | (1u << bit); int cnt = 0;
#pragma unroll
        for (int j = 0; j < NV; ++j) cnt += __popcll(__ballot(key[j] >= trial));
        if (cnt >= 16) { tau = trial; if (cnt == 16) break; }
    }
    int base = 0;
#pragma unroll
    for (int j = 0; j < NV; ++j) { const unsigned long long m = __ballot(key[j] > tau); slot[j] = (key[j] > tau) ? base + prefix_cnt(m) : -1; base += __popcll(m); }
#pragma unroll
    for (int j = 0; j < NV; ++j) { const unsigned long long m = __ballot(key[j] == tau); if (key[j] == tau) { const int s = base + prefix_cnt(m); slot[j] = s < 16 ? s : -1; } base += __popcll(m); }
}
template <int N> __device__ __forceinline__ void bitonic_stage_desc(unsigned (&x)[N], int k, int j) {
#pragma unroll
    for (int i = 0; i < N; ++i) { const int l = i ^ j; if (l > i) { const bool asc = ((i & k) != 0);
        const unsigned a = x[i], b = x[l]; const unsigned hi = a > b ? a : b, lo = a > b ? b : a; x[i] = asc ? lo : hi; x[l] = asc ? hi : lo; } }
}
__device__ __forceinline__ void sort16_desc(unsigned (&x)[16]) {
#pragma unroll
    for (int k = 2; k <= 16; k <<= 1)
#pragma unroll
        for (int j = k >> 1; j > 0; j >>= 1) bitonic_stage_desc<16>(x, k, j);
}
__device__ __forceinline__ void merge16_desc(unsigned (&run)[16], const unsigned (&ch)[16]) {
#pragma unroll
    for (int i = 0; i < 16; ++i) run[i] = run[i] > ch[15 - i] ? run[i] : ch[15 - i];
#pragma unroll
    for (int j = 8; j > 0; j >>= 1) bitonic_stage_desc<16>(run, 16, j);
}
__device__ __forceinline__ unsigned mono_hi(unsigned w) { return w ^ ((unsigned)((int)w >> 31) | 0x80000000u); }
__device__ __forceinline__ float demono_hi(unsigned k) { const unsigned kk = k & 0xffff0000u; return __builtin_bit_cast(float, (kk ^ ((unsigned)(~(int)kk >> 31) | 0x80000000u)) & 0xffff0000u); }
__device__ __forceinline__ void top16_list(LAS const unsigned char* row, int sw, unsigned (&run)[16]) {
#pragma unroll
    for (int ck = 0; ck < 8; ++ck) {
        const u32x4 w0 = *(LAS const u32x4*)(row + (((2 * ck) ^ sw) << 4)), w1 = *(LAS const u32x4*)(row + (((2 * ck + 1) ^ sw) << 4));
        const unsigned w[8] = {w0.x, w0.y, w0.z, w0.w, w1.x, w1.y, w1.z, w1.w};
        unsigned ch[16];
#pragma unroll
        for (int i = 0; i < 8; ++i) { ch[2 * i] = (mono_hi(w[i] << 16) & 0xffff0000u) | (unsigned)(ck * 16 + 2 * i); ch[2 * i + 1] = (mono_hi(w[i]) & 0xffff0000u) | (unsigned)(ck * 16 + 2 * i + 1); }
        sort16_desc(ch);
        if (ck == 0) {
#pragma unroll
            for (int i = 0; i < 16; ++i) run[i] = ch[i];
        } else merge16_desc(run, ch);
    }
}
__device__ __forceinline__ void topk_fetch(const bf16_t* src, u32x4 (&r)[16], int L) {
#pragma unroll
    for (int i = 0; i < 16; ++i) r[i] = *(const u32x4*)(src + (size_t)(4 * i + (L >> 4)) * 256 + (L & 15) * 8);
}
__device__ __forceinline__ void topk_stage(LAS unsigned char* tile, const u32x4 (&r)[16], int L) {
#pragma unroll
    for (int i = 0; i < 16; ++i) { const int row = 4 * i + (L >> 4); *(LAS u32x4*)(tile + row * 256 + ((((L & 15) ^ (row & 15))) << 4)) = r[i]; }
}
__device__ __forceinline__ void phase_topk(const Ctx& c0) {
    Ctx c = c0; c.lane = lane_id_v(); c.tid = c.wave * 64 + c.lane;
    const bf16_t* sc = WSP(bf16_t, WS_SC); int* IDX = WSP(int, WS_IDX); float* GW = WSP(float, WS_GW);
    const int L = c.lane, gw0 = (c.vcu * 8 + c.wave) * 64, NL = c.G * 512;
    LAS unsigned char* tile = c.lds + c.wave * 16384;
    LAS const unsigned char* myrow = tile + L * 256; const int sw = L & 15;
    for (int eb = gw0; eb < T * H; eb += NL) {
        const int e = eb + L;
        unsigned ka[16], kb[16];
        u32x4 ra[16], rb[16];
        topk_fetch(sc + (size_t)eb * 256, ra, L);
        topk_fetch(sc + (size_t)eb * 256 + 128, rb, L);
        topk_stage(tile, ra, L);
        top16_list(myrow, sw, ka);
        topk_stage(tile, rb, L);
        top16_list(myrow, sw, kb);
        float sa[16], sb[16]; unsigned ia[16], ib[16];
#pragma unroll
        for (int i = 0; i < 16; ++i) { sa[i] = demono_hi(ka[i]); sb[i] = demono_hi(kb[i]); ia[i] = (ka[i] & 0x7fu) << 7; ib[i] = kb[i] & 0x7fu; }
        const float mx = sa[0] + sb[0];
        unsigned run[16], ch[16]; int n = 0, nc = 0;
#pragma unroll
        for (int a = 0; a < 16; ++a)
#pragma unroll
            for (int b = 0; b < 16; ++b) if ((a + 1) * (b + 1) <= 16) {
                const int k = 65535 + (int)((sa[a] + sb[b] - mx) * 1024.f);
                ch[n] = ((unsigned)(k < 0 ? 0 : k) << 16) | ia[a] | ib[b];
                if (++n == 16) { sort16_desc(ch); if (nc == 0) {
#pragma unroll
                        for (int i = 0; i < 16; ++i) run[i] = ch[i]; } else merge16_desc(run, ch);
                    n = 0; ++nc; }
            }
#pragma unroll
        for (int i = 2; i < 16; ++i) ch[i] = 0u;
        sort16_desc(ch); merge16_desc(run, ch);
        float ex[16]; float sum = 0.f;
#pragma unroll
        for (int i = 0; i < 16; ++i) { ex[i] = __expf((float)((int)(run[i] >> 16) - 65535) * (1.f / 1024.f)); sum += ex[i]; }
        const float inv = 1.f / sum;
        u32x4* oi = (u32x4*)(IDX + (size_t)e * 16); f32x4* og = (f32x4*)(GW + (size_t)e * 16);
#pragma unroll
        for (int q = 0; q < 4; ++q) { u32x4 vi; vi.x = run[4 * q] & 0x3fffu; vi.y = run[4 * q + 1] & 0x3fffu; vi.z = run[4 * q + 2] & 0x3fffu; vi.w = run[4 * q + 3] & 0x3fffu; oi[q] = vi;
            f32x4 vg; vg.x = ex[4 * q] * inv; vg.y = ex[4 * q + 1] * inv; vg.z = ex[4 * q + 2] * inv; vg.w = ex[4 * q + 3] * inv; og[q] = vg; }
    }
}

__device__ __forceinline__ void dec32_fp4(const u32x4 r, f32x2 (&f)[16]) {
    const unsigned w[4] = {r.x, r.y, r.z, r.w};
#pragma unroll
    for (int i = 0; i < 4; ++i) { f[4 * i] = __builtin_amdgcn_cvt_scalef32_pk_f32_fp4(w[i], 1.0f, 0); f[4 * i + 1] = __builtin_amdgcn_cvt_scalef32_pk_f32_fp4(w[i], 1.0f, 1);
        f[4 * i + 2] = __builtin_amdgcn_cvt_scalef32_pk_f32_fp4(w[i], 1.0f, 2); f[4 * i + 3] = __builtin_amdgcn_cvt_scalef32_pk_f32_fp4(w[i], 1.0f, 3); }
}
__device__ __forceinline__ float dot32_fp4(const f32x2 (&hv)[16], const u32x4 r) {
    f32x2 f[16]; dec32_fp4(r, f); f32x2 s = hv[0] * f[0];
#pragma unroll
    for (int j = 1; j < 16; ++j) s = s + hv[j] * f[j];
    return s.x + s.y;
}
typedef int i32x8 __attribute__((ext_vector_type(8)));
template <int UV> __device__ __forceinline__ void phase_peer_u(const Ctx& c0) {
    Ctx c = c0; c.lane = lane_id_v(); c.tid = c.wave * 64 + c.lane;
    const int L = c.lane, pp = blockIdx.x & 3, hh = (blockIdx.x >> 2) & 1, rank = blockIdx.x >> 3, nrank = c.G >> 3;
    LAS unsigned char* meta = c.lds + 131584 + c.wave * 2048;
    LAS int* mb = (LAS int*)meta;
    LAS unsigned char* hq = meta + 1536;
    LAS unsigned char* tile = c.lds + c.wave * 16384;
    const int n = L & 15, g4 = L >> 4, lr = L >> 3, lc = L & 7;
    const unsigned char* EUs = c.ws + WS_EU + (size_t)pp * NE * 128 + ((lc ^ (lr >> 1)) << 4);
    const int* IDXl = WSP(int, WS_IDX) + L;
    const unsigned char* H8l = c.ws + WS_H2Q + pp * 256 + 4 * L;
    float* PD = WSP(float, WS_PD) + (size_t)pp * T * 128 + 32 * g4 + 4 * (n >> 1);
    const int t0 = 2 * (rank * 8 + c.wave) + hh, ts = 2 * nrank * 8;
    if (t0 >= T) return;
    const int nk = (T - t0 + ts - 1) / ts;
    int sc1 = 0x7f7f7f7f; asm volatile("" : "+v"(sc1));
    const bool swapb = WSP(unsigned, WS_C8SP)[1024] != 0u;
    const int roff = (n >> 1) * 128 + (((4 * (n & 1) + g4) ^ (n >> 2)) << 4);
    const int hoff = (n & 1) * 128 + g4 * 16;
    const int i0 = n & 1, myP = n >> 1;
#define PEER_U_DMA(m3, q) do { unsigned id_[4]; _Pragma("unroll") for (int Gq = 0; Gq < 4; ++Gq) id_[Gq] = (unsigned)mb[(m3) * 128 + 8 * (4 * (q) + Gq) + lr]; \
        _Pragma("unroll") for (int Gq = 0; Gq < 4; ++Gq) __builtin_amdgcn_global_load_lds((const unsigned*)(EUs + (id_[Gq] << 7)), (LAS unsigned*)(tile + (q) * 4096 + Gq * 1024), 16, 0, 0); } while (0)
#define PEER_U_IDS(m3, tk) do { __builtin_amdgcn_global_load_lds((const unsigned*)(IDXl + (size_t)(tk) * 128), (LAS unsigned*)(mb + (m3) * 128), 4, 0, 0); \
        __builtin_amdgcn_global_load_lds((const unsigned*)(IDXl + (size_t)(tk) * 128 + 64), (LAS unsigned*)(mb + (m3) * 128 + 64), 4, 0, 0); } while (0)
#define PEER_U_HQ(par, tk) __builtin_amdgcn_global_load_lds((const unsigned*)(H8l + (size_t)(tk) * 1024), (LAS unsigned*)(hq + (par) * 256), 4, 0, 0)
#define PEER_U_HB(dst, par) do { int ho = hoff; asm volatile("" : "+v"(ho)); const u32x4 h0 = *(const LAS u32x4*)(hq + (par) * 256 + ho), h1 = *(const LAS u32x4*)(hq + (par) * 256 + ho + 64); \
        unsigned hw[8] = {h0.x, h0.y, h0.z, h0.w, h1.x, h1.y, h1.z, h1.w}; \
        if (swapb) { _Pragma("unroll") for (int q_ = 0; q_ < 8; ++q_) hw[q_] = ((hw[q_] & 0x00ff00ffu) << 8) | ((hw[q_] >> 8) & 0x00ff00ffu); } \
        dst = (i32x8){(int)hw[0], (int)hw[1], (int)hw[2], (int)hw[3], (int)hw[4], (int)hw[5], (int)hw[6], (int)hw[7]}; } while (0)
#define PEER_U_STEP(q, dm3, dq, WAITN) do { \
        PEER_U_DMA(dm3, dq); \
        asm volatile("s_waitcnt vmcnt(" #WAITN ")" ::: "memory"); \
        int ro = roff; asm volatile("" : "+v"(ro)); \
        f32x4 a4[4]; \
        _Pragma("unroll") for (int Gq = 0; Gq < 4; ++Gq) { const u32x4 av = *(const LAS u32x4*)(tile + (q) * 4096 + Gq * 1024 + ro); \
            const i32x8 a = (i32x8){(int)av.x, (int)av.y, (int)av.z, (int)av.w, 0, 0, 0, 0}; \
            a4[Gq] = __builtin_amdgcn_mfma_scale_f32_16x16x128_f8f6f4(a, hb, (f32x4){0.f, 0.f, 0.f, 0.f}, 4, 0, 0, sc1, 0, sc1); } \
        _Pragma("unroll") for (int P = 0; P < 2; ++P) { const f32x4 x0 = a4[2 * P], x1 = a4[2 * P + 1]; \
            const f32x4 cand = (f32x4){i0 ? x0[1] : x0[0], i0 ? x0[3] : x0[2], i0 ? x1[1] : x1[0], i0 ? x1[3] : x1[2]}; \
            if (myP == 2 * (q) + P) o = cand; } \
        asm volatile("s_waitcnt lgkmcnt(0)" ::: "memory"); } while (0)
    PEER_U_IDS(0, t0); PEER_U_IDS(1, (nk > 1) ? t0 + ts : t0); PEER_U_HQ(0, t0);
    asm volatile("s_waitcnt vmcnt(0)" ::: "memory");
    PEER_U_DMA(0, 0); PEER_U_DMA(0, 1); PEER_U_DMA(0, 2);
    i32x8 hb; PEER_U_HB(hb, 0);
    int m0 = 0;
#pragma unroll 1
    for (int k = 0; k < nk; ++k) {
        const int p = k & 1, tk = t0 + k * ts, tn1 = t0 + ((k + 1 < nk) ? k + 1 : nk - 1) * ts, tn2 = t0 + ((k + 2 < nk) ? k + 2 : nk - 1) * ts;
        const int m1 = (m0 == 2) ? 0 : m0 + 1, m2 = (m1 == 2) ? 0 : m1 + 1;
        PEER_U_IDS(m2, tn2); PEER_U_HQ(p ^ 1, tn1);
        f32x4 o = (f32x4){0.f, 0.f, 0.f, 0.f};
        PEER_U_STEP(0, m0, 3, 15);
        PEER_U_STEP(1, m1, 0, 15);
        PEER_U_STEP(2, m1, 1, 15);
        PEER_U_STEP(3, m1, 2, 12);
        { f32x4 o2;
#pragma unroll
          for (int j = 0; j < 4; ++j) { const float ov = o[j]; o2[j] = ov + __builtin_bit_cast(float, __builtin_amdgcn_update_dpp(0, __builtin_bit_cast(int, ov), 0xB1, 0xf, 0xf, false)); }
          if (!(n & 1)) *(f32x4*)(PD + (size_t)tk * 128) = o2; }
        PEER_U_HB(hb, p ^ 1);
        m0 = m1;
    }
    asm volatile("s_waitcnt vmcnt(0)" ::: "memory");
#undef PEER_U_DMA
#undef PEER_U_IDS
#undef PEER_U_HQ
#undef PEER_U_HB
#undef PEER_U_STEP
}
__device__ __forceinline__ void phase_peer_fin_old(const Ctx& c0) {
    Ctx c = c0; c.lane = lane_id_v(); c.tid = c.wave * 64 + c.lane;
    const int* IDX = WSP(int, WS_IDX); const float* GW = WSP(float, WS_GW); const float* PD = WSP(float, WS_PD); unsigned* WGT = WSP(unsigned, WS_WGT);
    const float* SU = WSP(float, WS_SU); const float* SV = WSP(float, WS_SV); const float* SH = WSP(float, WS_SH);
    const int NTH = c.G * 512;
    for (int i0 = c.vcu * 512 + c.tid; i0 < T * 128; i0 += 4 * NTH) {
        float d[4]; int e[4]; float g[4];
#pragma unroll
        for (int u = 0; u < 4; ++u) { const int i = (i0 + u * NTH < T * 128) ? i0 + u * NTH : i0; float s = 0.f;
            const int k = i & 127, pi = (i & ~127) + ((k >> 1) & 3) * 32 + (k >> 3) * 2 + (k & 1);
#pragma unroll
            for (int p = 0; p < 8; ++p) s += PD[(size_t)p * T * 128 + pi];
            d[u] = s; e[u] = IDX[i]; g[u] = GW[i]; }
        float su[4], sv[4], sh[4];
#pragma unroll
        for (int u = 0; u < 4; ++u) { const int i = (i0 + u * NTH < T * 128) ? i0 + u * NTH : i0; su[u] = SU[e[u]]; sv[u] = SV[e[u]]; sh[u] = SH[i >> 7]; }
#pragma unroll
        for (int u = 0; u < 4; ++u) { const int i = i0 + u * NTH; if (i < T * 128) WGT[i] = (f2bf(g[u] * gelu_tanh(d[u] * su[u] * sh[u]) * sv[u]) << 16) | (unsigned)e[u]; }
    }
}
template <bool DRY> __device__ __forceinline__ void phase_peer_v_old(const Ctx& c0) {
    Ctx c = c0; c.lane = lane_id_v(); c.tid = c.wave * 64 + c.lane;
    const unsigned* WI = WSP(unsigned, WS_WGT); const float* mod = WSP(float, WS_MOD);
    const int L = c.lane, pp = blockIdx.x & 3, hh = (blockIdx.x >> 2) & 1, rank = blockIdx.x >> 3, nrank = c.G >> 3;
    const bool b5 = L & 32, b4 = L & 16, b3 = L & 8;
    LAS unsigned* mb = (LAS unsigned*)(c.lds + c.wave * 1024);
    const int kl = L >> 3;
    const unsigned char* EV4 = c.ws + WS_EV + (size_t)pp * NE * 128 + (L & 7) * 16;
    const int col = pp * 256 + (L & 7) * 32 + (b5 ? 16 : 0) + (b4 ? 8 : 0) + (b3 ? 4 : 0);
    const int t0 = 2 * (rank * 8 + c.wave) + hh, ts = 2 * nrank * 8;
    if (t0 >= T) return;
    { const unsigned g0 = WI[(size_t)t0 * 128 + L], g1 = WI[(size_t)t0 * 128 + 64 + L]; mb[L] = g0; mb[64 + L] = g1; }
    u32x4 rA[8], rB[8];
#pragma unroll
    for (int i = 0; i < 8; ++i) rA[i] = *(const u32x4*)(EV4 + (size_t)(mb[8 * i + kl] & 0xffffu) * 128);
    int cur = 0;
#pragma unroll 1
    for (int t = t0; t < T; t += ts) {
        const int tn = (t + ts < T) ? t + ts : t;
        const unsigned gn0 = WI[(size_t)tn * 128 + L], gn1 = WI[(size_t)tn * 128 + 64 + L];
        float* o = c.out + (size_t)t * 1024 + col; const float* g2 = mod + (t >> 11) * 6144 + 5120 + col;
        f32x4 xo = *(const f32x4*)o; const f32x4 gt = *(const f32x4*)g2;
#pragma unroll
        for (int i = 0; i < 8; ++i) rB[i] = *(const u32x4*)(EV4 + (size_t)(mb[cur * 128 + 64 + 8 * i + kl] & 0xffffu) * 128);
        f32x2 ac2[16];
#pragma unroll
        for (int j = 0; j < 16; ++j) ac2[j] = (f32x2){0.f, 0.f};
#pragma unroll
        for (int i = 0; i < 8; ++i) { const float w = bfhi(mb[cur * 128 + 8 * i + kl]); const f32x2 w2 = {w, w}; f32x2 f[16]; dec32_fp4(rA[i], f);
#pragma unroll
            for (int j = 0; j < 16; ++j) ac2[j] = ac2[j] + f[j] * w2; }
        mb[(cur ^ 1) * 128 + L] = gn0; mb[(cur ^ 1) * 128 + 64 + L] = gn1;
#pragma unroll
        for (int i = 0; i < 8; ++i) rA[i] = *(const u32x4*)(EV4 + (size_t)(mb[(cur ^ 1) * 128 + 8 * i + kl] & 0xffffu) * 128);
#pragma unroll
        for (int i = 0; i < 8; ++i) { const float w = bfhi(mb[cur * 128 + 64 + 8 * i + kl]); const f32x2 w2 = {w, w}; f32x2 f[16]; dec32_fp4(rB[i], f);
#pragma unroll
            for (int j = 0; j < 16; ++j) ac2[j] = ac2[j] + f[j] * w2; }
        float acc[32];
#pragma unroll
        for (int j = 0; j < 16; ++j) { acc[2 * j] = ac2[j].x; acc[2 * j + 1] = ac2[j].y; }
        float n16[16], n8[8], n4[4];
#pragma unroll
        for (int i = 0; i < 16; ++i) { const float send = b5 ? acc[i] : acc[i + 16], keep = b5 ? acc[i + 16] : acc[i]; n16[i] = keep + __shfl_xor(send, 32); }
#pragma unroll
        for (int i = 0; i < 8; ++i) { const float send = b4 ? n16[i] : n16[i + 8], keep = b4 ? n16[i + 8] : n16[i]; n8[i] = keep + __shfl_xor(send, 16); }
#pragma unroll
        for (int i = 0; i < 4; ++i) { const float send = b3 ? n8[i] : n8[i + 4], keep = b3 ? n8[i + 4] : n8[i]; n4[i] = keep + __shfl_xor(send, 8); }
        xo.x += gt.x * n4[0]; xo.y += gt.y * n4[1]; xo.z += gt.z * n4[2]; xo.w += gt.w * n4[3];
        if (DRY) asm volatile("" :: "v"(xo.x), "v"(xo.y), "v"(xo.z), "v"(xo.w)); else *(f32x4*)o = xo;
        cur ^= 1;
    }
}

struct ENone {};
struct FInProj { static constexpr int NB = 4; bf16_t *pa, *lx, *lg, *mg; typedef ENone Tile; typedef ENone Pre;
    __device__ __forceinline__ Tile tile(int, int, int) const { return Tile{}; }
    __device__ __forceinline__ Pre pre(int, int, int) const { return Pre{}; }
    __device__ __forceinline__ void apply(int row, int pn, int cc, const float (&v0)[8], const float (&v1)[8], const Pre&, const Tile&) const {
        bf16_t* d;
        if (pn < 2) d = pa + (size_t)row * 512 + pn * 256 + cc; else if (pn < 6) d = lx + (size_t)row * 1024 + (pn - 2) * 256 + cc;
        else if (pn < 10) d = lg + (size_t)row * 1024 + (pn - 6) * 256 + cc; else d = mg + (size_t)row * 2048 + (pn - 10) * 256 + cc;
        *(u32x4*)d = pack8(v0); *(u32x4*)(d + 128) = pack8(v1); } };
struct FRowScale { static constexpr int NB = 4; bf16_t* dst; int ldc; const float* rstd; int which; typedef ENone Tile; struct Pre { float r; };
    __device__ __forceinline__ Tile tile(int, int, int) const { return Tile{}; }
    __device__ __forceinline__ Pre pre(int row, int, int) const { return Pre{rstd[2 * row + which]}; }
    __device__ __forceinline__ void apply(int row, int pn, int cc, const float (&v0)[8], const float (&v1)[8], const Pre& p, const Tile&) const {
        float a[8], b[8];
#pragma unroll
        for (int j = 0; j < 8; ++j) { a[j] = v0[j] * p.r; b[j] = v1[j] * p.r; }
        *(u32x4*)(dst + (size_t)row * ldc + pn * 256 + cc) = pack8(a); *(u32x4*)(dst + (size_t)row * ldc + pn * 256 + 128 + cc) = pack8(b); } };
__device__ __forceinline__ void phase_peer_fin(const Ctx& c0) {
    Ctx c = c0; c.lane = lane_id_v(); c.tid = c.wave * 64 + c.lane;
    const int* IDX = WSP(int, WS_IDX); const float* GW = WSP(float, WS_GW); const float* PD = WSP(float, WS_PD);
    const float* SU = WSP(float, WS_SU); const float* SV = WSP(float, WS_SV); const float* SH = WSP(float, WS_SH);
    unsigned char* W8 = c.ws + WS_W8;
    const int L = c.lane, gw = c.vcu * 8 + c.wave, NGW = c.G * 8;
    const int pi = (L & 3) * 32 + (L >> 2) * 2;
    constexpr int NT = 4;
#pragma unroll 1
    for (int t = gw; t < T; t += NT * NGW) {
        f32x2 d[NT], g[NT]; int e0[NT], e1[NT]; float sh[NT];
#pragma unroll
        for (int u = 0; u < NT; ++u) { const int tt = (t + u * NGW < T) ? t + u * NGW : t; f32x2 s = (f32x2){0.f, 0.f};
#pragma unroll
            for (int p = 0; p < 4; ++p) s = s + *(const f32x2*)(PD + (size_t)p * T * 128 + (size_t)tt * 128 + pi);
            d[u] = s; const i32x2 ee = *(const i32x2*)(IDX + (size_t)tt * 128 + 2 * L); e0[u] = ee.x; e1[u] = ee.y; g[u] = *(const f32x2*)(GW + (size_t)tt * 128 + 2 * L); sh[u] = SH[tt]; }
        float su0[NT], su1[NT], sv0[NT], sv1[NT];
#pragma unroll
        for (int u = 0; u < NT; ++u) { su0[u] = SU[e0[u]]; su1[u] = SU[e1[u]]; sv0[u] = SV[e0[u]]; sv1[u] = SV[e1[u]]; }
#pragma unroll
        for (int u = 0; u < NT; ++u) { const int tt = t + u * NGW; if (tt < T) {
            const float w0 = g[u].x * gelu_tanh(d[u].x * su0[u] * sh[u]) * sv0[u], w1 = g[u].y * gelu_tanh(d[u].y * su1[u] * sh[u]) * sv1[u];
            float m = fmaxf(fabsf(w0), fabsf(w1));
#pragma unroll
            for (int o = 1; o < 64; o <<= 1) m = fmaxf(m, __shfl_xor(m, o));
            const float sc = m > 0.f ? m * (1.f / 224.f) : 1.f, inv = 1.f / sc;
            const int pk = __builtin_amdgcn_cvt_pk_fp8_f32(w0 * inv, w1 * inv, 0, false);
            *(unsigned short*)(W8 + (size_t)tt * 256 + 2 * L) = (unsigned short)(pk & 0xffff);
            if (L == 0) *(float*)(W8 + (size_t)tt * 256 + 128) = sc; } }
    }
}

template <int DRY> __device__ __forceinline__ void phase_peer_v(const Ctx& c0) {
    Ctx c = c0; c.lane = lane_id_v(); c.tid = c.wave * 64 + c.lane;
    const int L = c.lane, pp = blockIdx.x & 3, hh = (blockIdx.x >> 2) & 1, rank = blockIdx.x >> 3, nrank = c.G >> 3;
    LAS unsigned char* meta = c.lds + 131584 + c.wave * 3584;
    LAS int* mb = (LAS int*)meta;
    LAS unsigned char* wq = meta + 1024;
    LAS unsigned char* buf = meta + 1536;
    LAS unsigned char* gbuf = meta + 2560;
    LAS unsigned char* tile = c.lds + c.wave * 16384;
    const int n = L & 15, g4 = L >> 4, lr = L >> 3, lc = L & 7;
    const unsigned char* EVe = c.ws + WS_EV + (size_t)pp * NE * 128 + ((lc ^ (lr >> 1)) << 4);
    const unsigned char* EVo = c.ws + WS_EV + (size_t)pp * NE * 128 + ((lc ^ (4 + (lr >> 1))) << 4);
    const int* IDXl = WSP(int, WS_IDX) + L;
    const unsigned char* W8l = c.ws + WS_W8 + 4 * L;
    const float* X1l = c.out + pp * 256 + 4 * L;
    const float* G2l = WSP(float, WS_MOD) + 5120 + pp * 256 + 4 * L;
    const int t0 = 2 * (rank * 8 + c.wave) + hh, ts = 2 * nrank * 8;
    if (t0 >= T) return;
    const int nk = (T - t0 + ts - 1) / ts;
    int sc1 = 0x7f7f7f7f; asm volatile("" : "+v"(sc1));
    const bool swapn = WSP(unsigned, WS_C8SP)[1024] != 0u;
    const int ab = n * 128 + (g4 & 1) * 8, ay = ((g4 >> 1) ^ ((n >> 1) & 7)) << 4;
    const int wo = 16 * (g4 & 1);
    const bool z0 = n == (g4 >> 1), z1 = n == 2 + (g4 >> 1);
#define PEER_V_IDS(par, tk) do { __builtin_amdgcn_global_load_lds((const unsigned*)(IDXl + (size_t)(tk) * 128), (LAS unsigned*)(mb + (par) * 128), 4, 0, 0); \
        __builtin_amdgcn_global_load_lds((const unsigned*)(IDXl + (size_t)(tk) * 128 + 64), (LAS unsigned*)(mb + (par) * 128 + 64), 4, 0, 0); } while (0)
#define PEER_V_W8(par, tk) __builtin_amdgcn_global_load_lds((const unsigned*)(W8l + (size_t)(tk) * 256), (LAS unsigned*)(wq + (par) * 256), 4, 0, 0)
#define PEER_V_XG(tk) do { if (DRY == 3) break; __builtin_amdgcn_global_load_lds((const unsigned*)(X1l + (size_t)(tk) * 1024), (LAS unsigned*)buf, 16, 0, 0); \
        __builtin_amdgcn_global_load_lds((const unsigned*)(G2l + ((tk) >> 11) * 6144), (LAS unsigned*)gbuf, 16, 0, 0); } while (0)
#define PEER_V_DMA(par, q) do { unsigned id_[4]; _Pragma("unroll") for (int Gq = 0; Gq < 4; ++Gq) id_[Gq] = (unsigned)mb[(par) * 128 + 8 * (4 * (q) + Gq) + lr]; \
        _Pragma("unroll") for (int Gq = 0; Gq < 4; ++Gq) __builtin_amdgcn_global_load_lds((const unsigned*)(((Gq & 1) ? EVo : EVe) + (id_[Gq] << 7)), (LAS unsigned*)(tile + (q) * 4096 + Gq * 1024), 16, 0, 0); } while (0)
#define PEER_V_STEP(q, dpar, dq, WAITN) do { \
        PEER_V_DMA(dpar, dq); \
        asm volatile("s_waitcnt vmcnt(" #WAITN ")" ::: "memory"); \
        int ab_ = ab, ay_ = ay, wo_ = wo; asm volatile("" : "+v"(ab_), "+v"(ay_), "+v"(wo_)); \
        const u32x4 wv = *(const LAS u32x4*)(wq + p * 256 + 32 * (q) + wo_); \
        const i32x8 hb = (i32x8){z0 ? (int)wv.x : 0, z0 ? (int)wv.y : 0, z0 ? (int)wv.z : 0, z0 ? (int)wv.w : 0, z1 ? (int)wv.x : 0, z1 ? (int)wv.y : 0, z1 ? (int)wv.z : 0, z1 ? (int)wv.w : 0}; \
          \
        const unsigned tb_ = (unsigned)(__SIZE_TYPE__)(tile + (q) * 4096) + (unsigned)ab_; \
        const unsigned a0_ = tb_ + (unsigned)(0 ^ ay_), a1_ = tb_ + (unsigned)(32 ^ ay_), a2_ = tb_ + (unsigned)(64 ^ ay_), a3_ = tb_ + (unsigned)(96 ^ ay_); \
        i32x2 f00, f01, f10, f11, f20, f21, f30, f31; \
        asm volatile("ds_read_b64_tr_b4 %0, %8\n\tds_read_b64_tr_b4 %1, %8 offset:2048\n\tds_read_b64_tr_b4 %2, %9\n\tds_read_b64_tr_b4 %3, %9 offset:2048\n\t" \
                     "ds_read_b64_tr_b4 %4, %10\n\tds_read_b64_tr_b4 %5, %10 offset:2048\n\tds_read_b64_tr_b4 %6, %11\n\tds_read_b64_tr_b4 %7, %11 offset:2048\n\ts_waitcnt lgkmcnt(0)" \
                     : "=&v"(f00), "=&v"(f01), "=&v"(f10), "=&v"(f11), "=&v"(f20), "=&v"(f21), "=&v"(f30), "=&v"(f31) : "v"(a0_), "v"(a1_), "v"(a2_), "v"(a3_) : "memory"); \
        acc[0] = __builtin_amdgcn_mfma_scale_f32_16x16x128_f8f6f4((i32x8){f00.x, f00.y, f01.x, f01.y, 0, 0, 0, 0}, hb, acc[0], 4, 0, 0, sc1, 0, sc1); \
        acc[1] = __builtin_amdgcn_mfma_scale_f32_16x16x128_f8f6f4((i32x8){f10.x, f10.y, f11.x, f11.y, 0, 0, 0, 0}, hb, acc[1], 4, 0, 0, sc1, 0, sc1); \
        acc[2] = __builtin_amdgcn_mfma_scale_f32_16x16x128_f8f6f4((i32x8){f20.x, f20.y, f21.x, f21.y, 0, 0, 0, 0}, hb, acc[2], 4, 0, 0, sc1, 0, sc1); \
        acc[3] = __builtin_amdgcn_mfma_scale_f32_16x16x128_f8f6f4((i32x8){f30.x, f30.y, f31.x, f31.y, 0, 0, 0, 0}, hb, acc[3], 4, 0, 0, sc1, 0, sc1); \
        asm volatile("s_waitcnt lgkmcnt(0)" ::: "memory"); } while (0)
    PEER_V_IDS(0, t0); PEER_V_IDS(1, (nk > 1) ? t0 + ts : t0); PEER_V_W8(0, t0);
    asm volatile("s_waitcnt vmcnt(0)" ::: "memory");
    PEER_V_DMA(0, 0); PEER_V_DMA(0, 1); PEER_V_DMA(0, 2); PEER_V_XG(t0);
#pragma unroll 1
    for (int k = 0; k < nk; ++k) {
        const int p = k & 1, tk = t0 + k * ts, tn1 = t0 + ((k + 1 < nk) ? k + 1 : nk - 1) * ts, tn2 = t0 + ((k + 2 < nk) ? k + 2 : nk - 1) * ts;
        f32x4 acc[4];
#pragma unroll
        for (int M = 0; M < 4; ++M) acc[M] = (f32x4){0.f, 0.f, 0.f, 0.f};
        PEER_V_STEP(0, p, 3, 14);
        PEER_V_IDS(p, tn2); PEER_V_W8(p ^ 1, tn1);
        PEER_V_STEP(1, p ^ 1, 0, 17);
        PEER_V_STEP(2, p ^ 1, 1, 17);
        PEER_V_STEP(3, p ^ 1, 2, 15);
        const f32x4 xo = *(const LAS f32x4*)(buf + 16 * L), gt = *(const LAS f32x4*)(gbuf + 16 * L); const float swt = *(const LAS float*)(wq + p * 256 + 128);
        asm volatile("s_waitcnt lgkmcnt(0)" ::: "memory");
        if (n < 4) {
#pragma unroll
            for (int M = 0; M < 4; ++M) { f32x4 v = acc[M]; if (swapn) v = (f32x4){v.y, v.x, v.w, v.z}; *(LAS f32x4*)(buf + (64 * M + 16 * n + 4 * g4) * 4) = v; } }
        const f32x4 r = *(const LAS f32x4*)(buf + 16 * L);
        f32x4 res; res.x = xo.x + gt.x * swt * r.x; res.y = xo.y + gt.y * swt * r.y; res.z = xo.z + gt.z * swt * r.z; res.w = xo.w + gt.w * swt * r.w;
        if (DRY) asm volatile("" :: "v"(res.x), "v"(res.y), "v"(res.z), "v"(res.w)); else *(f32x4*)(c.out + (size_t)tk * 1024 + pp * 256 + 4 * L) = res;
        asm volatile("s_waitcnt lgkmcnt(0)" ::: "memory");
        PEER_V_XG(tn1);
    }
    asm volatile("s_waitcnt vmcnt(0)" ::: "memory");
#undef PEER_V_IDS
#undef PEER_V_W8
#undef PEER_V_XG
#undef PEER_V_DMA
#undef PEER_V_STEP
}


constexpr int GT_OFF = 132096;
struct FGates { static constexpr int NB = 2; const bf16_t* xc; bf16_t *LA, *Bv; LAS const float* gt;
    typedef ENone Tile; struct Pre { u32x4 x; };
    __device__ __forceinline__ Tile tile(int, int, int) const { return Tile{}; }
    __device__ __forceinline__ Pre pre(int row, int pn, int cc) const { return Pre{*(const u32x4*)(xc + (size_t)row * 1024 + pn * 128 + cc)}; }
    __device__ __forceinline__ void apply(int row, int pn, int cc, const float (&v0)[8], const float (&v1)[8], const Pre& p, const Tile&) const {
        const int ch = pn * 128 + cc; float x[8], la[8], bv[8]; unpack8(p.x, x);
        const f32x4 br0 = *(LAS const f32x4*)(gt + ch), br1 = *(LAS const f32x4*)(gt + ch + 4), bi0 = *(LAS const f32x4*)(gt + 1024 + ch), bi1 = *(LAS const f32x4*)(gt + 1024 + ch + 4),
                    c80 = *(LAS const f32x4*)(gt + 2048 + ch), c81 = *(LAS const f32x4*)(gt + 2048 + ch + 4);
        const float br[8] = {br0.x, br0.y, br0.z, br0.w, br1.x, br1.y, br1.z, br1.w}, bi[8] = {bi0.x, bi0.y, bi0.z, bi0.w, bi1.x, bi1.y, bi1.z, bi1.w}, c8[8] = {c80.x, c80.y, c80.z, c80.w, c81.x, c81.y, c81.z, c81.w};
#pragma unroll
        for (int j = 0; j < 8; ++j) {
            const float r = __builtin_amdgcn_rcpf(1.f + __expf(-(v0[j] + br[j]))), ig = __builtin_amdgcn_rcpf(1.f + __expf(-(v1[j] + bi[j])));
            const float loga = r * c8[j];
            const float z = 2.f * loga;
            const float ser = -z * (1.f + z * (0.5f + z * (0.16666667f + z * (0.041666668f + z * (0.008333334f + z * 0.0013888889f)))));
            const float om = (z > -0.25f) ? ser : (1.f - __expf(z));
            la[j] = loga * 1.4426950408889634f;
            bv[j] = sqrtf(om) * (ig * x[j]);
        }
        *(u32x4*)(LA + (size_t)row * 1024 + ch) = pack8(la); *(u32x4*)(Bv + (size_t)row * 1024 + ch) = pack8(bv); } };
struct FY1 { static constexpr int NB = 4; const bf16_t* mg; bf16_t* y; int goff; bool accum; typedef ENone Tile; struct Pre { u32x4 g0, g1, y0, y1; };
    __device__ __forceinline__ Tile tile(int, int, int) const { return Tile{}; }
    __device__ __forceinline__ Pre pre(int row, int pn, int cc) const { Pre p; const int col = pn * 256 + cc;
        p.g0 = *(const u32x4*)(mg + (size_t)row * 2048 + goff + col); p.g1 = *(const u32x4*)(mg + (size_t)row * 2048 + goff + col + 128);
        if (accum) { p.y0 = *(const u32x4*)(y + (size_t)row * 1024 + col); p.y1 = *(const u32x4*)(y + (size_t)row * 1024 + col + 128); } else { p.y0 = (u32x4){0u, 0u, 0u, 0u}; p.y1 = p.y0; }
        return p; }
    __device__ __forceinline__ void one(bf16_t* dst, const u32x4 g, const u32x4 yo, const float (&v)[8]) const {
        float gt[8], o[8]; unpack8(g, gt); unpack8(yo, o);
#pragma unroll
        for (int j = 0; j < 8; ++j) o[j] = o[j] + sigmoidf_(gt[j]) * v[j];
        *(u32x4*)dst = pack8(o); }
    __device__ __forceinline__ void apply(int row, int pn, int cc, const float (&v0)[8], const float (&v1)[8], const Pre& p, const Tile&) const {
        bf16_t* d = y + (size_t)row * 1024 + pn * 256 + cc; one(d, p.g0, p.y0, v0); one(d + 128, p.g1, p.y1, v1); } };
struct FX1 { static constexpr int NB = 4; const float* x; float* out; const float* mod; struct Tile { f32x4 a[4]; }; struct Pre { f32x4 x[4]; };
    __device__ __forceinline__ Tile tile(int pn, int cc, int pm) const { Tile t; const float* g1 = mod + ((pm * 256) >> 11) * 6144 + 2048 + pn * 256 + cc;
        t.a[0] = *(const f32x4*)g1; t.a[1] = *(const f32x4*)(g1 + 4); t.a[2] = *(const f32x4*)(g1 + 128); t.a[3] = *(const f32x4*)(g1 + 132); return t; }
    __device__ __forceinline__ Pre pre(int row, int pn, int cc) const { Pre p; const float* xr = x + (size_t)row * 1024 + pn * 256 + cc;
        p.x[0] = *(const f32x4*)xr; p.x[1] = *(const f32x4*)(xr + 4); p.x[2] = *(const f32x4*)(xr + 128); p.x[3] = *(const f32x4*)(xr + 132); return p; }
    __device__ __forceinline__ void apply(int row, int pn, int cc, const float (&v0)[8], const float (&v1)[8], const Pre& p, const Tile& t) const {
        float* o = out + (size_t)row * 1024 + pn * 256 + cc;
        f32x4 r0, r1, r2, r3;
        r0.x = p.x[0].x + t.a[0].x * v0[0]; r0.y = p.x[0].y + t.a[0].y * v0[1]; r0.z = p.x[0].z + t.a[0].z * v0[2]; r0.w = p.x[0].w + t.a[0].w * v0[3];
        r1.x = p.x[1].x + t.a[1].x * v0[4]; r1.y = p.x[1].y + t.a[1].y * v0[5]; r1.z = p.x[1].z + t.a[1].z * v0[6]; r1.w = p.x[1].w + t.a[1].w * v0[7];
        r2.x = p.x[2].x + t.a[2].x * v1[0]; r2.y = p.x[2].y + t.a[2].y * v1[1]; r2.z = p.x[2].z + t.a[2].z * v1[2]; r2.w = p.x[2].w + t.a[2].w * v1[3];
        r3.x = p.x[3].x + t.a[3].x * v1[4]; r3.y = p.x[3].y + t.a[3].y * v1[5]; r3.z = p.x[3].z + t.a[3].z * v1[6]; r3.w = p.x[3].w + t.a[3].w * v1[7];
        *(f32x4*)o = r0; *(f32x4*)(o + 4) = r1; *(f32x4*)(o + 128) = r2; *(f32x4*)(o + 132) = r3; } };
struct FStore { static constexpr int NB = 4; bf16_t* dst; int ldc; typedef ENone Tile; typedef ENone Pre;
    __device__ __forceinline__ Tile tile(int, int, int) const { return Tile{}; }
    __device__ __forceinline__ Pre pre(int, int, int) const { return Pre{}; }
    __device__ __forceinline__ void apply(int row, int pn, int cc, const float (&v0)[8], const float (&v1)[8], const Pre&, const Tile&) const {
        *(u32x4*)(dst + (size_t)row * ldc + pn * 256 + cc) = pack8(v0); *(u32x4*)(dst + (size_t)row * ldc + pn * 256 + 128 + cc) = pack8(v1); } };

template <int M, int N, int K, int LDA, int ACS, class F> __device__ __forceinline__ void run_gemm(const Ctx& c, const bf16_t* A, const bf16_t* Bt, const F& f) {
    pg8::Gemm g{A, Bt}; pg8::StaticOrder<M, N> So; So.init(c.G, (int)blockIdx.x);
    pg8::EpiF<F> E{f};
    pg8::gemm_phase<K, LDA, ACS, pg8::EpiF<F>, pg8::StaticOrder<M, N>>((PG8_LAS unsigned char*)c.lds, g, So, E, c.wave * 64 + lane_id_v());
}

__global__ void __launch_bounds__(512, 2) mk_fwd(Args args) {
    extern __shared__ __attribute__((aligned(16))) unsigned char lds_raw[];
    Ctx c;
    c.lds = (LAS unsigned char*)lds_raw;
    c.wave = __builtin_amdgcn_readfirstlane(threadIdx.x >> 6); c.lane = lane_id_v(); c.tid = c.wave * 64 + c.lane;
    c.G = gridDim.x; { const int bx = blockIdx.x; c.vcu = (c.G % 8 == 0) ? (bx % 8) * (c.G / 8) + bx / 8 : bx; }
    c.in = args.in; c.out = args.out; c.ws = args.ws;
    volatile LAS unsigned* MISC = (volatile LAS unsigned*)(c.lds + MISC_OFF);
    if (c.tid < 32) MISC[c.tid] = 0u;
    __syncthreads();
    XcdBarrier bar; bar.bar = (unsigned*)(c.ws + WS_CTL) + 4096; bar.x = 0; bar.st = nullptr;
    if (args.ph_hi - args.ph_lo > 1) bar = xcd_barrier_post((unsigned*)(c.ws + WS_CTL) + 4096, MISC + 8);

    const int lo = args.ph_lo, hi = args.ph_hi;
#ifndef ONLYP
#define ONLYP -1
#endif
#define IN(k) (lo <= (k) && (k) < hi && (ONLYP < 0 || ONLYP == (k)))
#define SEAM(k) do { if ((k) + 1 < hi) xcd_barrier(bar, c.wave); } while (0)
#ifndef REPEAT_MASK
#define REPEAT_MASK 0
#endif
#define PHASE(k, ...) if (IN(k)) { c.lane = lane_id_v(); c.tid = c.wave * 64 + c.lane; { __VA_ARGS__ } if ((REPEAT_MASK >> (k)) & 1) { xcd_barrier(bar, c.wave); { __VA_ARGS__ } } SEAM(k); }
    PHASE(0, phase_prep(c);)
    PHASE(1, phase_modnorm<false>(c, c.in[I_X], c.in[I_N1G], 0, 1024, WSP(bf16_t, WS_R0));)
    PHASE(2, FInProj f{WSP(bf16_t, WS_R1), WSP(bf16_t, WS_R2), WSP(bf16_t, WS_R3), (bf16_t*)c.out};
             run_gemm<T, 4608, 1024, 1024, 0>(c, WSP(bf16_t, WS_R0), WSP(bf16_t, WS_WIN), f);)
    PHASE(3, phase_conv(c);)
    PHASE(4, { LAS float* gtl = (LAS float*)(c.lds + GT_OFF);
               for (int e = c.tid; e < 1024; e += 512) { gtl[e] = c.in[I_BRG][e]; gtl[1024 + e] = c.in[I_BIG][e]; gtl[2048 + e] = WSP(float, WS_C8SP)[e]; }
               __syncthreads();
               FGates fg{WSP(bf16_t, WS_R4), WSP(bf16_t, WS_R0), WSP(bf16_t, WS_R6), gtl};
               run_gemm<T, 2048, 128, 1024, 128>(c, WSP(bf16_t, WS_R4), WSP(bf16_t, WS_WG), fg); }
             { FRowScale fq{WSP(bf16_t, WS_R5), 768, WSP(float, WS_RSTD), 0};
               run_gemm<T, 768, 256, 512, 0>(c, WSP(bf16_t, WS_R1), WSP(bf16_t, WS_WUQ), fq); })
    PHASE(5, { FRowScale fkv{WSP(bf16_t, WS_R2), 1024, WSP(float, WS_RSTD), 1};
               run_gemm<T, 1024, 128, 512, 0>(c, WSP(bf16_t, WS_R1) + 256, WSP(bf16_t, WS_WUKV), fkv); }
             phase_scan(c);)
    PHASE(6, phase_qkv_layout(c);)
    PHASE(7, phase_attn(c);)
    PHASE(8, { FY1 f1{(const bf16_t*)c.out, WSP(bf16_t, WS_R2), 0, false};
               run_gemm<T, 1024, 512, 512, 0>(c, WSP(bf16_t, WS_R0 + 32 * MiB), WSP(bf16_t, WS_WOA), f1); }
             { FY1 f2{(const bf16_t*)c.out, WSP(bf16_t, WS_R2), 1024, true};
               run_gemm<T, 1024, 1024, 1024, 0>(c, WSP(bf16_t, WS_R6), WSP(bf16_t, WS_WOL), f2); })
    PHASE(9, FX1 f{c.in[I_X], c.out, WSP(float, WS_MOD)};
             run_gemm<T, 1024, 1024, 1024, 0>(c, WSP(bf16_t, WS_R2), WSP(bf16_t, WS_WOUT), f);)
    PHASE(10, phase_modnorm<true>(c, c.out, c.in[I_N2G], 3072, 4096, WSP(bf16_t, WS_R0));)
    PHASE(11, FStore f{WSP(bf16_t, WS_SC), 2048};
              run_gemm<T, 2048, 1024, 1024, 0>(c, WSP(bf16_t, WS_R0), WSP(bf16_t, WS_WQ), f);)
    PHASE(13, phase_topk(c);)
#ifdef PROBE_UVAR
    if (IN(14)) { c.lane = lane_id_v(); c.tid = c.wave * 64 + c.lane; phase_peer_u<PROBE_UVAR>(c); xcd_barrier(bar, c.wave); }
#endif
    PHASE(14, phase_peer_u<0>(c);)
    PHASE(15, phase_peer_fin(c);)
#ifdef PROBE_VDRY
    if (IN(16)) { for (int rep = 0; rep < PROBE_VDRY; ++rep) { c.lane = lane_id_v(); c.tid = c.wave * 64 + c.lane; phase_peer_v<PROBE_VVAR>(c); xcd_barrier(bar, c.wave); } }
#endif
    PHASE(16, phase_peer_v<0>(c);)
#undef PHASE
#undef IN
#undef SEAM
}

extern "C" void kernel_launch(void* const* d_in, const int* in_sizes, int n_in, void* d_out, int out_size, void* d_ws, size_t ws_size, hipStream_t stream) {
    static int grid = 0;
    if (grid == 0) {
        if (n_in != 28 || out_size != T * D || ws_size < WS_END) { fprintf(stderr, "kernel_launch: unexpected shapes (n_in %d out %d ws %zu)\n", n_in, out_size, ws_size); grid = -1; return; }
        int dev = 0, cus = 0, per_cu = 0;
        if (hipGetDevice(&dev) != hipSuccess || hipDeviceGetAttribute(&cus, hipDeviceAttributeMultiprocessorCount, dev) != hipSuccess) { grid = -1; return; }
        if (hipFuncSetAttribute((const void*)mk_fwd, hipFuncAttributeMaxDynamicSharedMemorySize, LDS_BYTES) != hipSuccess) { fprintf(stderr, "kernel_launch: hipFuncSetAttribute failed\n"); grid = -1; return; }
        if (hipOccupancyMaxActiveBlocksPerMultiprocessor(&per_cu, (const void*)mk_fwd, 512, LDS_BYTES) != hipSuccess || per_cu < 1) { fprintf(stderr, "kernel_launch: occupancy query says %d blocks per CU\n", per_cu); grid = -1; (void)hipGetLastError(); return; }
        grid = cus - (cus % 8);
        if (grid < 8) { fprintf(stderr, "kernel_launch: needs at least 8 CUs\n"); grid = -1; return; }
    }
    if (grid < 0) return;
    (void)hipMemsetAsync((char*)d_ws + WS_CTL, 0, CTL_ZERO_BYTES, stream);
    Args a{};
    for (int i = 0; i < 28; ++i) a.in[i] = (const float*)d_in[i];
    a.out = (float*)d_out; a.ws = (unsigned char*)d_ws;
#if MK_N_LAUNCHES == 1
    a.ph_lo = 0; a.ph_hi = N_PHASES;
    hipLaunchKernelGGL(mk_fwd, dim3(grid), dim3(512), LDS_BYTES, stream, a);
#else
    for (int ph = 0; ph < N_PHASES; ++ph) { a.ph_lo = ph; a.ph_hi = ph + 1; hipLaunchKernelGGL(mk_fwd, dim3(grid), dim3(512), LDS_BYTES, stream, a); }
#endif
}
```

```cpp
#include <hip/hip_runtime.h>
#include <type_traits>
#include <cstdio>
#include <cstdint>

#define LAS __attribute__((address_space(3)))
#define GAS __attribute__((address_space(1)))
typedef unsigned short bf16_t;
typedef short bf16x8 __attribute__((ext_vector_type(8)));
typedef float f32x4 __attribute__((ext_vector_type(4)));
typedef float f32x2 __attribute__((ext_vector_type(2)));
typedef unsigned u32x4 __attribute__((ext_vector_type(4)));
typedef unsigned u32x2 __attribute__((ext_vector_type(2)));
typedef int i32x2 __attribute__((ext_vector_type(2)));

#ifndef MK_N_LAUNCHES
#define MK_N_LAUNCHES 1
#endif

constexpr int T = 32768, D = 1024, NB_ = 16, S = 2048, H = 8;
constexpr int QKH = 96, VH = 64;
constexpr int NE = 16384;
constexpr float EPS = 1e-6f;

constexpr size_t MiB = 1u << 20;
constexpr size_t WS_CTL = 0, CTL_ZERO_BYTES = 65536;
constexpr size_t WS_MOD = 1 * MiB;
constexpr size_t WS_RSTD = 1 * MiB + 512 * 1024;
constexpr size_t WS_C8SP = 1 * MiB + 448 * 1024;
constexpr size_t WS_WIN = 2 * MiB;
constexpr size_t WS_WUQ = 11 * MiB;
constexpr size_t WS_WUKV = 11 * MiB + 512 * 1024;
constexpr size_t WS_WOA = 12 * MiB;
constexpr size_t WS_WOL = 13 * MiB;
constexpr size_t WS_WOUT = 15 * MiB;
constexpr size_t WS_WQ = 17 * MiB;
constexpr size_t WS_WG = 21 * MiB;
constexpr size_t WS_SK = 22 * MiB;
constexpr size_t WS_EU = 24 * MiB;
constexpr size_t WS_EV = 40 * MiB;
constexpr size_t WS_SU = 1 * MiB + 768 * 1024;
constexpr size_t WS_SV = 1 * MiB + 832 * 1024;
constexpr size_t WS_WGT = 440 * MiB;
constexpr size_t WS_CS = 56 * MiB;
constexpr size_t WS_H2Q = 456 * MiB;
constexpr size_t WS_SH = 1 * MiB + 896 * 1024;
constexpr size_t WS_PD = 184 * MiB;
constexpr size_t WS_R0 = 88 * MiB;
constexpr size_t WS_R1 = 152 * MiB;
constexpr size_t WS_R2 = 184 * MiB;
constexpr size_t WS_R3 = 248 * MiB;
constexpr size_t WS_R4 = 312 * MiB;
constexpr size_t WS_R5 = 376 * MiB;
constexpr size_t WS_R6 = 424 * MiB;
constexpr size_t WS_QP = 152 * MiB;
constexpr size_t WS_SC = 184 * MiB;
constexpr size_t WS_X1B = 312 * MiB;
constexpr size_t WS_IDX = 408 * MiB;
constexpr size_t WS_GW = 424 * MiB;
constexpr size_t WS_W8 = 440 * MiB;
constexpr size_t WS_END = 488 * MiB;

constexpr int LDS_BYTES = 160256;
constexpr int MISC_OFF = 131072 + 320;

__device__ __forceinline__ unsigned f2bf(float f) { unsigned u = __builtin_bit_cast(unsigned, f); return (u + 0x7fffu + ((u >> 16) & 1u)) >> 16; }
typedef __bf16 bf16x2_t __attribute__((ext_vector_type(2)));
__device__ __forceinline__ unsigned pk2(float lo, float hi) { f32x2 v = {lo, hi}; return __builtin_bit_cast(unsigned, __builtin_convertvector(v, bf16x2_t)); }
__device__ __forceinline__ float bf2f(unsigned h) { return __builtin_bit_cast(float, h << 16); }
__device__ __forceinline__ float bflo(unsigned w) { return __builtin_bit_cast(float, w << 16); }
__device__ __forceinline__ float bfhi(unsigned w) { return __builtin_bit_cast(float, w & 0xffff0000u); }
__device__ __forceinline__ float sigmoidf_(float x) { return 1.f / (1.f + __expf(-x)); }
__device__ __forceinline__ float gelu_tanh(float x) {
    const float u = 0.7978845608028654f * (x + 0.044715f * x * x * x);
    const float e = __expf(2.f * u);
    const float th = 1.f - 2.f / (e + 1.f);
    return 0.5f * x * (1.f + th);
}
__device__ __forceinline__ int lane_id_v() { int l; asm volatile("v_mbcnt_lo_u32_b32 %0, -1, 0\n\tv_mbcnt_hi_u32_b32 %0, -1, %0" : "=v"(l)); return l; }
__device__ __forceinline__ float wave_sum(float v) {
#pragma unroll
    for (int o = 1; o < 64; o <<= 1) v += __shfl_xor(v, o);
    return v;
}
__device__ __forceinline__ void unpack8(const u32x4 w, float (&v)[8]) {
    v[0] = bflo(w.x); v[1] = bfhi(w.x); v[2] = bflo(w.y); v[3] = bfhi(w.y); v[4] = bflo(w.z); v[5] = bfhi(w.z); v[6] = bflo(w.w); v[7] = bfhi(w.w);
}
__device__ __forceinline__ u32x4 pack8(const float (&v)[8]) {
    u32x4 w; w.x = pk2(v[0], v[1]); w.y = pk2(v[2], v[3]); w.z = pk2(v[4], v[5]); w.w = pk2(v[6], v[7]); return w;
}

namespace pg8 {
#define PG8_LAS __attribute__((address_space(3)))
constexpr int BM = 256, BK = 64, HALF = 128, HTB = HALF * BK * 2, STAGE_BYTES = 8 * HTB, NXCD = 8, WGM = 8;
__host__ __device__ __forceinline__ int lds_byte(int r, int c) { const int st = (r >> 4) * 2 + (c >> 5), rr = r & 15, cc = c & 31, ob = rr * 64 + cc * 2; return st * 1024 + (ob ^ (((ob >> 9) & 1) << 5)); }
__host__ __device__ __forceinline__ void stage_rc(int b, int& R, int& C) { const int st = b / 1024, sb = b % 1024, swz = sb ^ (((sb >> 9) & 1) << 5); R = (st >> 1) * 16 + swz / 64; C = (st & 1) * 32 + (swz % 64) / 2; }
__host__ __device__ __forceinline__ int perm32(int rho) { const int n = rho >> 4, i = rho & 15; return 8 * (i >> 2) + 4 * n + (i & 3); }

struct Unit { int pm, pn; };
struct Gemm { const bf16_t* A; const bf16_t* Bt; };

template <int M_, int N_> struct StaticOrder {
    static constexpr int nM = M_ / BM, nN = N_ / BM, nwg = nM * nN;
    int G, c;
    __host__ __device__ void init(int G_, int c_) { G = G_; c = c_; }
    __host__ __device__ bool next(int i, Unit& u) const {
        const long L = (long)i * G + c; if (L >= nwg) return false;
        int wgid = (int)L; { const int q = nwg / NXCD, r = nwg % NXCD, xcd = wgid % NXCD, off = wgid / NXCD; wgid = (xcd < r ? xcd * (q + 1) : r * (q + 1) + (xcd - r) * q) + off; }
        const int nig = WGM * nN, gid = wgid / nig, fm = gid * WGM, gsz = (nM - fm) < WGM ? (nM - fm) : WGM;
        u.pm = fm + ((wgid % nig) % gsz); u.pn = (wgid % nig) / gsz; return true;
    }
};

template <class F> struct EpiF {
    static constexpr bool PERM = true;
    F f;
    __device__ __forceinline__ void operator()(const f32x4 (&acc)[2][2][4][2], const Unit& u, int wr, int wc, int fr, int fq) const {
        { int l_; asm volatile("v_mbcnt_lo_u32_b32 %0, -1, 0\n\tv_mbcnt_hi_u32_b32 %0, -1, %0" : "=v"(l_)); fr = l_ & 15; fq = l_ >> 4; }
        const int c = wc * 32 + 8 * fq;
        const typename F::Tile tl = f.tile(u.pn, c, u.pm);
#pragma unroll
        for (int ai = 0; ai < 2; ++ai)
#pragma unroll
            for (int mb = 0; mb < 4; mb += F::NB) {
                typename F::Pre pre[F::NB];
#pragma unroll
                for (int m = 0; m < F::NB; ++m) pre[m] = f.pre(u.pm * BM + ai * HALF + wr * 64 + (mb + m) * 16 + fr, u.pn, c);
#pragma unroll
                for (int m = 0; m < F::NB; ++m) {
                    const int row = u.pm * BM + ai * HALF + wr * 64 + (mb + m) * 16 + fr;
                    float v0[8], v1[8];
#pragma unroll
                    for (int j = 0; j < 4; ++j) { v0[j] = acc[ai][0][mb + m][0][j]; v0[4 + j] = acc[ai][0][mb + m][1][j]; v1[j] = acc[ai][1][mb + m][0][j]; v1[4 + j] = acc[ai][1][mb + m][1][j]; }
                    f.apply(row, u.pn, c, v0, v1, pre[m], tl);
                }
            }
    }
};

template <int K, int LDA, int ACS, class Epi, class Sched>
__device__ __forceinline__ void gemm_phase(PG8_LAS unsigned char* lds, const Gemm g, const Sched& S, const Epi& E, const int tid) {
    const int wid = __builtin_amdgcn_readfirstlane(tid >> 6), lane = tid & 63, wr = wid >> 2, wc = wid & 3, fr = lane & 15, fq = lane >> 4;
    constexpr int nt = K / BK;
    unsigned voffA[2], voffB[2];
#pragma unroll
    for (int i = 0; i < 2; ++i) { int R, C; stage_rc(tid * 16 + i * 8192, R, C); const int Rb = Epi::PERM ? ((R & ~31) + perm32(R & 31)) : R;
        voffA[i] = (unsigned)(R * LDA + C) * 2u; voffB[i] = (unsigned)(Rb * K + C) * 2u; }
    constexpr size_t kstep = (size_t)(BK * 2);
    constexpr size_t hstepA = (size_t)HALF * LDA * 2, hstepB = (size_t)HALF * K * 2;
    constexpr size_t tstepA = 2 * hstepA, tstepB = 2 * hstepB;
    constexpr size_t acsb = (size_t)ACS * 2;
    const unsigned ldsw = (unsigned)wid * 1024u;
    const int aoff = lds_byte(wr * 64 + fr, fq * 8), boff = lds_byte(wc * 32 + fr, fq * 8);
#define PG8_SA(b, h) (((b) * 2 + (h)) * HTB)
#define PG8_SB(b, h) ((4 + (b) * 2 + (h)) * HTB)
#define PG8_STAGE(bufoff, gbase, voff) do { _Pragma("unroll") for (int _i = 0; _i < 2; ++_i) \
        __builtin_amdgcn_global_load_lds((const unsigned*)((const char*)(gbase) + (voff)[_i]), (PG8_LAS unsigned*)(lds + (bufoff) + ldsw + _i * 8192), 16, 0, 0); } while (0)
#define PG8_LDA(dst, b, h) do { _Pragma("unroll") for (int m = 0; m < 4; ++m) _Pragma("unroll") for (int k = 0; k < 2; ++k) dst[m][k] = *(const PG8_LAS bf16x8*)(lds + PG8_SA(b, h) + aoff + m * 2048 + k * 1024); } while (0)
#define PG8_LDB(dst, b, h) do { _Pragma("unroll") for (int n = 0; n < 2; ++n) _Pragma("unroll") for (int k = 0; k < 2; ++k) dst[n][k] = *(const PG8_LAS bf16x8*)(lds + PG8_SB(b, h) + boff + n * 2048 + k * 1024); } while (0)
#define PG8_MMA(ai, bj, At, Bt) do { __builtin_amdgcn_s_setprio(1); _Pragma("unroll") for (int m = 0; m < 4; ++m) _Pragma("unroll") for (int n = 0; n < 2; ++n) _Pragma("unroll") for (int k = 0; k < 2; ++k) \
        acc[ai][bj][m][n] = __builtin_amdgcn_mfma_f32_16x16x32_bf16(Bt[n][k], At[m][k], acc[ai][bj][m][n], 0, 0, 0); __builtin_amdgcn_s_setprio(0); } while (0)
#define PG8_WAIT_V(n) asm volatile("s_waitcnt vmcnt(" #n ")" ::: "memory")
#define PG8_WAIT_L(n) asm volatile("s_waitcnt lgkmcnt(" #n ")" ::: "memory")
#define PG8_BAR __builtin_amdgcn_s_barrier()
#define PG8_SCHED __builtin_amdgcn_sched_barrier(0)
    Unit cur, nxt; int ui = 0;
    if (!S.next(0, cur)) return;
    f32x4 acc[2][2][4][2];
#pragma unroll
    for (int a = 0; a < 2; ++a)
#pragma unroll
        for (int b = 0; b < 2; ++b)
#pragma unroll
            for (int m = 0; m < 4; ++m)
#pragma unroll
                for (int n = 0; n < 2; ++n) acc[a][b][m][n] = (f32x4){0.f, 0.f, 0.f, 0.f};
    bf16x8 At[4][2], B0[2][2], B1[2][2];
    const char* cA = (const char*)g.A + (size_t)cur.pm * tstepA + (size_t)cur.pn * acsb; const char* cB = (const char*)g.Bt + (size_t)cur.pn * tstepB;
    PG8_STAGE(PG8_SB(0, 0), cB, voffB); PG8_STAGE(PG8_SB(0, 1), cB + hstepB, voffB); PG8_STAGE(PG8_SA(0, 0), cA, voffA); PG8_STAGE(PG8_SA(0, 1), cA + hstepA, voffA);
    if (wr == 1) PG8_BAR;
    PG8_WAIT_V(2); PG8_BAR;
    PG8_STAGE(PG8_SB(1, 0), cB + kstep, voffB); PG8_STAGE(PG8_SA(1, 0), cA + kstep, voffA); PG8_STAGE(PG8_SB(1, 1), cB + hstepB + kstep, voffB);
    PG8_WAIT_V(6); PG8_BAR;
    for (;;) {
        const bool has_next = S.next(ui + 1, nxt);
        const char* nA = has_next ? (const char*)g.A + (size_t)nxt.pm * tstepA + (size_t)nxt.pn * acsb : cA; const char* nB = has_next ? (const char*)g.Bt + (size_t)nxt.pn * tstepB : cB;
#pragma unroll 1
        for (int t = 0; t < nt; t += 2) {
            const bool last = (t == nt - 2);
            const char* a1 = cA + (size_t)(t + 1) * kstep;
            const char* a2 = last ? nA : cA + (size_t)(t + 2) * kstep; const char* b2 = last ? nB : cB + (size_t)(t + 2) * kstep;
            const char* a3 = a2 + kstep; const char* b3 = b2 + kstep;
            PG8_LDB(B0, 0, 0); PG8_LDB(B1, 0, 1); PG8_SCHED; PG8_LDA(At, 0, 0); PG8_STAGE(PG8_SA(1, 1), a1 + hstepA, voffA);
            PG8_WAIT_V(8); PG8_WAIT_L(0); PG8_BAR; PG8_MMA(0, 0, At, B0); PG8_MMA(0, 1, At, B1); PG8_BAR; PG8_SCHED;
            PG8_LDA(At, 0, 1); PG8_STAGE(PG8_SB(0, 0), b2, voffB); PG8_STAGE(PG8_SB(0, 1), b2 + hstepB, voffB); PG8_STAGE(PG8_SA(0, 0), a2, voffA);
            PG8_WAIT_V(8); PG8_WAIT_L(0); PG8_BAR; PG8_MMA(1, 0, At, B0); PG8_MMA(1, 1, At, B1); PG8_BAR; PG8_SCHED;
            PG8_LDB(B0, 1, 0); PG8_LDB(B1, 1, 1); PG8_SCHED; PG8_LDA(At, 1, 0); PG8_STAGE(PG8_SA(0, 1), a2 + hstepA, voffA);
            PG8_WAIT_V(8); PG8_WAIT_L(0); PG8_BAR; PG8_MMA(0, 0, At, B0); PG8_MMA(0, 1, At, B1); PG8_BAR; PG8_SCHED;
            PG8_LDA(At, 1, 1); PG8_STAGE(PG8_SB(1, 0), b3, voffB); PG8_STAGE(PG8_SB(1, 1), b3 + hstepB, voffB); PG8_STAGE(PG8_SA(1, 0), a3, voffA);
            PG8_WAIT_V(8); PG8_WAIT_L(0); PG8_BAR; PG8_MMA(1, 0, At, B0); PG8_MMA(1, 1, At, B1); PG8_BAR; PG8_SCHED;
        }
        if (wr == 0) PG8_BAR;
        E(acc, cur, wr, wc, fr, fq);
        if (!has_next) break;
#pragma unroll
        for (int a = 0; a < 2; ++a)
#pragma unroll
            for (int b = 0; b < 2; ++b)
#pragma unroll
                for (int m = 0; m < 4; ++m)
#pragma unroll
                    for (int n = 0; n < 2; ++n) acc[a][b][m][n] = (f32x4){0.f, 0.f, 0.f, 0.f};
        cur = nxt; cA = nA; cB = nB; ++ui;
        if (wr == 1) PG8_BAR;
    }
    PG8_WAIT_V(0);
    PG8_BAR;
#undef PG8_SA
#undef PG8_SB
#undef PG8_STAGE
#undef PG8_LDA
#undef PG8_LDB
#undef PG8_MMA
#undef PG8_WAIT_V
#undef PG8_WAIT_L
#undef PG8_BAR
#undef PG8_SCHED
}
}

#define XB_TMO      128
#define XB_XCNT(j)  (256  + 64 * (j))
#define XB_XSUB(j)  (1280 + 64 * (j))
#define XB_XGEN(j)  (2304 + 64 * (j))
#define XB_TOP      3328
#define XB_TOPGEN   3392
#define XCD_BAR_WORDS 3456
#define XB_SPIN_CAP (1u << 18)
__device__ __forceinline__ unsigned xb_ld(unsigned* p)              { return __hip_atomic_load(p, __ATOMIC_RELAXED, __HIP_MEMORY_SCOPE_AGENT); }
__device__ __forceinline__ unsigned xb_add(unsigned* p, unsigned v) { return __hip_atomic_fetch_add(p, v, __ATOMIC_RELAXED, __HIP_MEMORY_SCOPE_AGENT); }
__device__ __forceinline__ unsigned xb_xcc_id() { return (unsigned)__builtin_amdgcn_s_getreg((3 << 11) | 20) & 0xFu; }
#define XB_SPIN(cond, bar) do { unsigned _sp = 0; while (cond) { __builtin_amdgcn_s_sleep(1); \
    if ((++_sp & 255u) == 0u) { if (xb_ld(&(bar)[XB_TMO])) break; if (_sp > XB_SPIN_CAP) { atomicAdd(&(bar)[XB_TMO], 1u); break; } } } } while (0)
struct XcdBarrier { unsigned* bar; unsigned x; volatile LAS unsigned* st; };
__device__ __forceinline__ XcdBarrier xcd_barrier_post(unsigned* bar, volatile LAS unsigned* st) {
    XcdBarrier b; b.bar = bar; b.x = xb_xcc_id(); b.st = st;
    if (threadIdx.x == 0) (void)xb_add(&bar[XB_XCNT(b.x)], 1u);
    return b;
}
__device__ __forceinline__ void xcd_barrier_complete(unsigned* bar, unsigned x, unsigned& nloc, unsigned& nx) {
    const unsigned G = gridDim.x * gridDim.y * gridDim.z;
    unsigned sum, cnt, mine, sp = 0u;
    for (;;) {
        sum = 0u; cnt = 0u; mine = 0u;
#pragma unroll
        for (unsigned j = 0; j < 16; ++j) { const unsigned c = xb_ld(&bar[XB_XCNT(j)]); sum += c; cnt += (c > 0u) ? 1u : 0u; mine = (j == x) ? c : mine; }
        if (sum == G) break;
        __builtin_amdgcn_s_sleep(1);
        if ((++sp & 255u) == 0u) { if (xb_ld(&bar[XB_TMO])) break; if (sp > XB_SPIN_CAP) { atomicAdd(&bar[XB_TMO], 1u); break; } }
    }
    nloc = mine > 0u ? mine : 1u; nx = cnt > 0u ? cnt : 1u;
}
__device__ __forceinline__ void xcd_barrier(const XcdBarrier& b, int wave) {
    asm volatile("s_waitcnt vmcnt(0)" ::: "memory");
    __syncthreads();
    if (wave == 0 && lane_id_v() == 0) {
        unsigned* bar = b.bar;
        __builtin_amdgcn_s_waitcnt(0);
        unsigned nloc = b.st[0], nx = b.st[1];
        if (nloc == 0u) { xcd_barrier_complete(bar, b.x, nloc, nx); b.st[0] = nloc; b.st[1] = nx; }
        const unsigned old = xb_add(&bar[XB_XSUB(b.x)], 1u);
        const unsigned gen = old / nloc;
        if (old + 1u == (gen + 1u) * nloc) {
            __builtin_amdgcn_fence(__ATOMIC_RELEASE, "agent");
            asm volatile("s_waitcnt vmcnt(0)" ::: "memory");
            const unsigned og = xb_add(&bar[XB_TOP], 1u);
            const unsigned tg = og / nx;
            if (og + 1u == (tg + 1u) * nx) xb_add(&bar[XB_TOPGEN], 1u);
            else XB_SPIN(xb_ld(&bar[XB_TOPGEN]) == tg, bar);
            __builtin_amdgcn_fence(__ATOMIC_ACQUIRE, "agent");
            xb_add(&bar[XB_XGEN(b.x)], 1u);
            asm volatile("s_waitcnt vmcnt(0)" ::: "memory");
        } else {
            XB_SPIN(xb_ld(&bar[XB_XGEN(b.x)]) == gen, bar);
            __builtin_amdgcn_fence(__ATOMIC_ACQUIRE, "agent");
            asm volatile("s_waitcnt vmcnt(0)" ::: "memory");
        }
    }
    __syncthreads();
}

struct Args { const float* in[28]; float* out; unsigned char* ws; int ph_lo, ph_hi; };
enum { I_X = 0, I_C, I_POS, I_WADA, I_BADA, I_N1G, I_WIN, I_QAG, I_WUQ, I_KVAG, I_WUKV, I_QNG, I_KNG, I_WOA, I_CONVW, I_CONVB, I_WRG, I_BRG, I_WIG, I_BIG, I_LAM, I_WOL, I_WOUT, I_N2G, I_WQ, I_SUBK, I_EU, I_EV };
constexpr int N_PHASES = 17;

struct Ctx {
    LAS unsigned char* lds;
    int tid, lane, wave, vcu, G;
    const float* const* in; float* out; unsigned char* ws;
};
#define WSP(type, off) ((type*)(c.ws + (off)))

template <class F>
__device__ __forceinline__ void tr_tile(const Ctx& c, bf16_t* dst, int K, int n0, int k0, F f) {
    LAS float* scr = (LAS float*)c.lds;
#pragma unroll
    for (int i = 0; i < 8; ++i) { const int kk = i * 8 + (c.tid >> 6), nn = c.tid & 63; scr[kk * 65 + nn] = f(k0 + kk, n0 + nn); }
    __syncthreads();
    { const int kc = c.tid & 7, nn = c.tid >> 3;
      LAS const float* s = scr + (8 * kc) * 65 + nn;
      u32x4 o; o.x = pk2(s[0], s[65]); o.y = pk2(s[2 * 65], s[3 * 65]); o.z = pk2(s[4 * 65], s[5 * 65]); o.w = pk2(s[6 * 65], s[7 * 65]);
      *(u32x4*)(dst + (size_t)(n0 + nn) * K + k0 + 8 * kc) = o; }
    __syncthreads();
}

template <class F>
__device__ __forceinline__ void tr_tile_wave(LAS float* scr, int L, bf16_t* dst, int K, int n0, int k0, F f) {
#pragma unroll 16
    for (int kk = 0; kk < 64; ++kk) scr[kk * 65 + L] = f(k0 + kk, n0 + L);
    asm volatile("s_waitcnt lgkmcnt(0)" ::: "memory");
    const int kc = L & 7;
#pragma unroll
    for (int j = 0; j < 8; ++j) { const int nn = (L >> 3) + 8 * j; LAS const float* s = scr + (8 * kc) * 65 + nn;
        u32x4 o; o.x = pk2(s[0], s[65]); o.y = pk2(s[2 * 65], s[3 * 65]); o.z = pk2(s[4 * 65], s[5 * 65]); o.w = pk2(s[6 * 65], s[7 * 65]);
        *(u32x4*)(dst + (size_t)(n0 + nn) * K + k0 + 8 * kc) = o; }
    asm volatile("s_waitcnt lgkmcnt(0)" ::: "memory");
}
template <int PARTS> __device__ __forceinline__ void phase_prep(const Ctx& c0) {
    Ctx c = c0; c.lane = lane_id_v(); c.tid = c.wave * 64 + c.lane;
    const float* w_in = c.in[I_WIN]; const float* w_uq = c.in[I_WUQ]; const float* qag = c.in[I_QAG]; const float* w_ukv = c.in[I_WUKV]; const float* kvag = c.in[I_KVAG];
    const float* w_oa = c.in[I_WOA]; const float* w_ol = c.in[I_WOL]; const float* w_out = c.in[I_WOUT]; const float* w_q = c.in[I_WQ];
    const float* w_rg = c.in[I_WRG]; const float* w_ig = c.in[I_WIG];
    constexpr int T_WIN = 72 * 16, T_WUQ = 12 * 4, T_WUKV = 16 * 2, T_WOA = 16 * 8, T_WOL = 16 * 16, T_WOUT = 16 * 16, T_WQ = 32 * 16, T_WG = 8 * 4 * 2;
    constexpr int T_WAVE = T_WIN + T_WUQ + T_WUKV + T_WOA + T_WOL + T_WOUT + T_WG;
    if (PARTS & 1) { LAS float* scr = (LAS float*)(c.lds + (c.wave < 7 ? c.wave * 16640 : 131584)); const int L = c.lane;
      static_assert(7 * 16640 <= 131072 && 131584 + 16640 <= LDS_BYTES && 131584 >= MISC_OFF + 128, "prep LDS tiles");
      for (int it = c.vcu * 8 + c.wave; it < T_WAVE; it += c.G * 8) {
        int r = it;
        if (r < T_WIN) { const int nb = r / 16, kb = r % 16;
            tr_tile_wave(scr, L, WSP(bf16_t, WS_WIN), 1024, nb * 64, kb * 64, [=](int k, int n) -> float { return n < 416 ? w_in[(size_t)k * 4512 + n] : (n < 512 ? 0.f : w_in[(size_t)k * 4512 + n - 96]); }); continue; }
        r -= T_WIN;
        if (r < T_WUQ) { const int nb = r / 4, kb = r % 4;
            tr_tile_wave(scr, L, WSP(bf16_t, WS_WUQ), 256, nb * 64, kb * 64, [=](int k, int n) -> float { return w_uq[(size_t)k * 768 + n] * qag[k]; }); continue; }
        r -= T_WUQ;
        if (r < T_WUKV) { const int nb = r / 2, kb = r % 2;
            tr_tile_wave(scr, L, WSP(bf16_t, WS_WUKV), 128, nb * 64, kb * 64, [=](int k, int n) -> float { return w_ukv[(size_t)k * 1024 + n] * kvag[k]; }); continue; }
        r -= T_WUKV;
        if (r < T_WOA) { const int nb = r / 8, kb = r % 8;
            tr_tile_wave(scr, L, WSP(bf16_t, WS_WOA), 512, nb * 64, kb * 64, [=](int k, int n) -> float { return w_oa[(size_t)k * 1024 + n]; }); continue; }
        r -= T_WOA;
        if (r < T_WOL) { const int nb = r / 16, kb = r % 16;
            tr_tile_wave(scr, L, WSP(bf16_t, WS_WOL), 1024, nb * 64, kb * 64, [=](int k, int n) -> float { return w_ol[(size_t)k * 1024 + n]; }); continue; }
        r -= T_WOL;
        if (r < T_WOUT) { const int nb = r / 16, kb = r % 16;
            tr_tile_wave(scr, L, WSP(bf16_t, WS_WOUT), 1024, nb * 64, kb * 64, [=](int k, int n) -> float { return w_out[(size_t)k * 1024 + n]; }); continue; }
        r -= T_WOUT;
        { const int blk = r / 8, q = r % 8, nb = q / 2, kb = q % 2;
            tr_tile_wave(scr, L, WSP(bf16_t, WS_WG) + (size_t)blk * 256 * 128, 128, nb * 64, kb * 64,
                    [=](int k, int n) -> float { return n < 128 ? w_rg[((size_t)blk * 128 + k) * 128 + n] : w_ig[((size_t)blk * 128 + k) * 128 + n - 128]; }); }
      } }
    __syncthreads();
    if (PARTS & 2) { const int L = c.lane, i = L & 15, kg = L >> 4;
      for (int it = c.vcu * 8 + c.wave; it < 128 * 16; it += c.G * 8) {
        const int nb = it >> 4, slot = nb >> 3, n0 = nb * 16, k0 = (it & 15) * 64;
        const float* sk = c.in[I_SUBK] + (size_t)(n0 + i) * 128 + 8 * kg;
        const float* wq = w_q + (size_t)(k0 + i) * 2048 + slot * 128 + 8 * kg;
        f32x4 acc[4];
#pragma unroll
        for (int kb = 0; kb < 4; ++kb) acc[kb] = (f32x4){0.f, 0.f, 0.f, 0.f};
#pragma unroll 2
        for (int ds = 0; ds < 4; ++ds) {
            f32x4 bl[2], al[4][2];
            bl[0] = *(const f32x4*)(sk + 32 * ds); bl[1] = *(const f32x4*)(sk + 32 * ds + 4);
#pragma unroll
            for (int kb = 0; kb < 4; ++kb) { al[kb][0] = *(const f32x4*)(wq + (size_t)(16 * kb) * 2048 + 32 * ds); al[kb][1] = *(const f32x4*)(wq + (size_t)(16 * kb) * 2048 + 32 * ds + 4); }
            u32x4 bw; bw.x = pk2(bl[0].x, bl[0].y); bw.y = pk2(bl[0].z, bl[0].w); bw.z = pk2(bl[1].x, bl[1].y); bw.w = pk2(bl[1].z, bl[1].w);
            const bf16x8 bf = __builtin_bit_cast(bf16x8, bw);
#pragma unroll
            for (int kb = 0; kb < 4; ++kb) { u32x4 aw; aw.x = pk2(al[kb][0].x, al[kb][0].y); aw.y = pk2(al[kb][0].z, al[kb][0].w); aw.z = pk2(al[kb][1].x, al[kb][1].y); aw.w = pk2(al[kb][1].z, al[kb][1].w);
                acc[kb] = __builtin_amdgcn_mfma_f32_16x16x32_bf16(__builtin_bit_cast(bf16x8, aw), bf, acc[kb], 0, 0, 0); }
        }
        bf16_t* dst = WSP(bf16_t, WS_WQ) + (size_t)(n0 + i) * 1024 + k0 + 4 * kg;
#pragma unroll
        for (int kb = 0; kb < 4; ++kb) { u32x2 w; w.x = pk2(acc[kb][0], acc[kb][1]); w.y = pk2(acc[kb][2], acc[kb][3]); *(u32x2*)(dst + 16 * kb) = w; }
      } }
    { const float* lam = c.in[I_LAM]; float* t8 = WSP(float, WS_C8SP);
      if (c.vcu == 0) for (int e = c.tid; e < 1024; e += 512) t8[e] = -8.f * log1pf(__expf(-lam[e])); }
    if (c.vcu == 0 && c.tid == 0) {
        const unsigned probe = __builtin_amdgcn_cvt_scalef32_pk_fp4_f32(0u, 1.0f, 0.0f, 1.0f, 0) & 0xffu;
        WSP(unsigned, WS_C8SP)[1024] = (probe == 0x02u) ? 0u : 1u; }
    if (PARTS & 4) { const int gw = c.vcu * 8 + c.wave, NGW = c.G * 8, L = c.lane;
      f32x4 vn[4], vm[4];
#define PREP_ROW(dst, rr) do { const int r_ = (rr) < 2 * NE ? (rr) : gw; const f32x4* s4 = (const f32x4*)((r_ >= NE ? c.in[I_EV] : c.in[I_EU]) + (size_t)(r_ >= NE ? r_ - NE : r_) * 1024 + 16 * L); \
          _Pragma("unroll") for (int j = 0; j < 4; ++j) dst[j] = s4[j]; } while (0)
      if (gw < 2 * NE) { PREP_ROW(vn, gw); PREP_ROW(vm, gw + NGW); }
#pragma unroll 1
      for (int r = gw; r < 2 * NE; r += NGW) {
          const int isv = r >= NE, e = isv ? r - NE : r;
          f32x4 v[4]; float am = 0.f;
#pragma unroll
          for (int j = 0; j < 4; ++j) { v[j] = vn[j]; vn[j] = vm[j]; am = fmaxf(am, fmaxf(fmaxf(fabsf(v[j].x), fabsf(v[j].y)), fmaxf(fabsf(v[j].z), fabsf(v[j].w)))); }
          PREP_ROW(vm, r + 2 * NGW);
#pragma unroll
          for (int o = 1; o < 64; o <<= 1) am = fmaxf(am, __shfl_xor(am, o));
          const float s = am > 0.f ? am * (1.f / 6.f) : 1.f, inv = 1.f / s;
          unsigned w0 = 0u, w1 = 0u;
          w0 = __builtin_amdgcn_cvt_scalef32_pk_fp4_f32(w0, v[0].x * inv, v[0].y * inv, 1.0f, 0); w0 = __builtin_amdgcn_cvt_scalef32_pk_fp4_f32(w0, v[0].z * inv, v[0].w * inv, 1.0f, 1);
          w0 = __builtin_amdgcn_cvt_scalef32_pk_fp4_f32(w0, v[1].x * inv, v[1].y * inv, 1.0f, 2); w0 = __builtin_amdgcn_cvt_scalef32_pk_fp4_f32(w0, v[1].z * inv, v[1].w * inv, 1.0f, 3);
          w1 = __builtin_amdgcn_cvt_scalef32_pk_fp4_f32(w1, v[2].x * inv, v[2].y * inv, 1.0f, 0); w1 = __builtin_amdgcn_cvt_scalef32_pk_fp4_f32(w1, v[2].z * inv, v[2].w * inv, 1.0f, 1);
          w1 = __builtin_amdgcn_cvt_scalef32_pk_fp4_f32(w1, v[3].x * inv, v[3].y * inv, 1.0f, 2); w1 = __builtin_amdgcn_cvt_scalef32_pk_fp4_f32(w1, v[3].z * inv, v[3].w * inv, 1.0f, 3);
          u32x2 q; q.x = w0; q.y = w1;
          *(u32x2*)(c.ws + (isv ? WS_EV : WS_EU) + ((size_t)(L >> 4) * NE + e) * 128 + (L & 15) * 8) = q;
          if (L == 0) WSP(float, isv ? WS_SV : WS_SU)[e] = s;
      }
#undef PREP_ROW
    }
    if (PARTS & 8) { const float* cin = c.in[I_C]; const float* w_ada = c.in[I_WADA]; const float* b_ada = c.in[I_BADA]; float* mod = WSP(float, WS_MOD);
      LAS float* cs = (LAS float*)c.lds;
      LAS float* red = (LAS float*)(c.lds + 65536);
      bool have = false;
      for (int it = c.vcu; it < 192; it += c.G) {
          if (!have) { for (int e = c.tid; e < 16 * 1024; e += 512) { const float v = cin[e]; cs[e] = v / (1.f + __expf(-v)); } have = true; }
          __syncthreads();
          const int cl = c.tid & 31, ks = c.tid >> 5, j = it * 32 + cl;
          float acc[16];
#pragma unroll
          for (int b = 0; b < 16; ++b) acc[b] = 0.f;
#pragma unroll 1
          for (int k0 = 0; k0 < 64; k0 += 16) { float w[16];
#pragma unroll
              for (int kk = 0; kk < 16; ++kk) w[kk] = w_ada[(size_t)(ks * 64 + k0 + kk) * 6144 + j];
#pragma unroll
              for (int kk = 0; kk < 16; ++kk) { const int k = ks * 64 + k0 + kk;
#pragma unroll
                  for (int b = 0; b < 16; ++b) acc[b] += cs[b * 1024 + k] * w[kk]; } }
#pragma unroll
          for (int b = 0; b < 16; ++b) red[(ks * 16 + b) * 32 + cl] = acc[b];
          __syncthreads();
          { const int b = c.tid >> 5; float s = b_ada[j];
#pragma unroll
            for (int k2 = 0; k2 < 16; ++k2) s += red[(k2 * 16 + b) * 32 + cl];
            mod[b * 6144 + j] = s; }
          __syncthreads();
      } }
}

__device__ __forceinline__ f32x4 raw4(const f32x4 v) { return v; }
__device__ __forceinline__ f32x4 raw4(const u32x2 v) { return (f32x4){bflo(v.x), bfhi(v.x), bflo(v.y), bfhi(v.y)}; }
template <bool Q8>
__device__ __forceinline__ void phase_modnorm(const Ctx& c0, const void* xsrc, const float* g, int shift_off, int scale_off, bf16_t* dst) {
    Ctx c = c0; c.lane = lane_id_v(); c.tid = c.wave * 64 + c.lane;
    const float* mod = WSP(float, WS_MOD);
    const int gw = c.vcu * 8 + c.wave, NGW = c.G * 8;
    if (gw >= T) return;
    typedef typename std::conditional<Q8, u32x2, f32x4>::type Raw;
    const Raw* x = (const Raw*)xsrc;
    Raw vn[4];
    { const Raw* xr = x + (size_t)gw * (D / 4) + c.lane;
#pragma unroll
      for (int j = 0; j < 4; ++j) vn[j] = xr[64 * j]; }
#pragma unroll 1
    for (int m = gw; m < T; m += NGW) {
        const int b = m >> 11;
        f32x4 v[4]; float s = 0.f;
#pragma unroll
        for (int j = 0; j < 4; ++j) { v[j] = raw4(vn[j]); s += (v[j].x * v[j].x + v[j].y * v[j].y) + (v[j].z * v[j].z + v[j].w * v[j].w); }
        { const int mn = (m + NGW < T) ? m + NGW : m; const Raw* xr = x + (size_t)mn * (D / 4) + c.lane;
#pragma unroll
          for (int j = 0; j < 4; ++j) vn[j] = xr[64 * j]; }
        const float rstd = rsqrtf(wave_sum(s) * (1.f / D) + EPS);
        u32x2* o8 = (u32x2*)(dst + (size_t)m * D) + c.lane;
        float am = 0.f;
#pragma unroll
        for (int j = 0; j < 4; ++j) {
            const int col = 4 * c.lane + 256 * j;
            const f32x4 gg = *(const f32x4*)(g + col), sc = *(const f32x4*)(mod + b * 6144 + scale_off + col), sh = *(const f32x4*)(mod + b * 6144 + shift_off + col);
            const float r0 = v[j].x * rstd * gg.x * (1.f + sc.x) + sh.x, r1 = v[j].y * rstd * gg.y * (1.f + sc.y) + sh.y;
            const float r2 = v[j].z * rstd * gg.z * (1.f + sc.z) + sh.z, r3 = v[j].w * rstd * gg.w * (1.f + sc.w) + sh.w;
            u32x2 w; w.x = pk2(r0, r1); w.y = pk2(r2, r3); o8[64 * j] = w;
            if (Q8) { v[j].x = r0; v[j].y = r1; v[j].z = r2; v[j].w = r3; am = fmaxf(am, fmaxf(fmaxf(fabsf(r0), fabsf(r1)), fmaxf(fabsf(r2), fabsf(r3)))); }
        }
        if (Q8) {
#pragma unroll
            for (int o = 1; o < 64; o <<= 1) am = fmaxf(am, __shfl_xor(am, o));
            const float sq = am > 0.f ? am * (1.f / 256.f) : 1.f, inv = 1.f / sq;
            unsigned* q8 = (unsigned*)(c.ws + WS_H2Q + (size_t)m * D) + c.lane;
#pragma unroll
            for (int j = 0; j < 4; ++j) { int w = __builtin_amdgcn_cvt_pk_fp8_f32(v[j].x * inv, v[j].y * inv, 0, false); w = __builtin_amdgcn_cvt_pk_fp8_f32(v[j].z * inv, v[j].w * inv, w, true); q8[64 * j] = (unsigned)w; }
            if (c.lane == 0) WSP(float, WS_SH)[m] = sq;
        }
    }
}

__device__ __forceinline__ void phase_conv(const Ctx& c0) {
    Ctx c = c0; c.lane = lane_id_v(); c.tid = c.wave * 64 + c.lane;
    const bf16_t* pa = WSP(bf16_t, WS_R1); const bf16_t* lx = WSP(bf16_t, WS_R2); bf16_t* xc = WSP(bf16_t, WS_R4); float* rstd = WSP(float, WS_RSTD);
    const float* cw = c.in[I_CONVW]; const float* cb = c.in[I_CONVB];
    const int gt = c.vcu * 512 + c.tid, NT = c.G * 512;
    { const int gw = c.vcu * 8 + c.wave, NGW = c.G * 8, L = c.lane;
      for (int t = gw; t < T; t += NGW) {
          float ss = 0.f;
          if (L < 48) { float v[8]; unpack8(*(const u32x4*)(pa + (size_t)t * 512 + 8 * L), v);
#pragma unroll
              for (int j = 0; j < 8; ++j) ss += v[j] * v[j]; }
          const float sq = wave_sum(L < 32 ? ss : 0.f), skv = wave_sum(L >= 32 ? ss : 0.f);
          if (L == 0) { rstd[2 * t] = rsqrtf(sq * (1.f / 256.f) + EPS); rstd[2 * t + 1] = rsqrtf(skv * (1.f / 128.f) + EPS); }
      } }
    { const int* pos = (const int*)c.in[I_POS]; float* CS = WSP(float, WS_CS);
      for (int e = gt; e < T * 16; e += NT) {
          const int t = e >> 4, jj = e & 15;
          const float invf = exp2f(-(float)jj * (13.287712379549449f / 16.f));
          const float ang = (float)pos[t] * invf; const float n = rintf(ang * 0.15915494309189535f);
          const float red = (float)((double)ang - (double)n * 6.283185307179586);
          CS[(size_t)t * 32 + jj] = __cosf(red); CS[(size_t)t * 32 + 16 + jj] = __sinf(red);
      } }
    {
        const int ch = (gt & 127) * 8;
        f32x4 wv[4][2]; f32x4 bv[2];
#pragma unroll
        for (int j = 0; j < 4; ++j) { wv[j][0] = *(const f32x4*)(cw + j * 1024 + ch); wv[j][1] = *(const f32x4*)(cw + j * 1024 + ch + 4); }
        bv[0] = *(const f32x4*)(cb + ch); bv[1] = *(const f32x4*)(cb + ch + 4);
        const int tstep = NT >> 7;
        for (int tq = gt >> 7; tq < T; tq += 4 * tstep) {
            u32x4 raw[4][4];
#pragma unroll
            for (int u = 0; u < 4; ++u) { const int t = tq + u * tstep; const int s = t & 2047;
#pragma unroll
                for (int j = 0; j < 4; ++j) { raw[u][j] = (u32x4){0u, 0u, 0u, 0u}; if (t < T && s - 3 + j >= 0) raw[u][j] = *(const u32x4*)(lx + (size_t)(t - 3 + j) * 1024 + ch); } }
#pragma unroll
            for (int u = 0; u < 4; ++u) { const int t = tq + u * tstep;
                float acc[8] = {bv[0].x, bv[0].y, bv[0].z, bv[0].w, bv[1].x, bv[1].y, bv[1].z, bv[1].w};
#pragma unroll
                for (int j = 0; j < 4; ++j) { float v[8]; unpack8(raw[u][j], v);
                    acc[0] += wv[j][0].x * v[0]; acc[1] += wv[j][0].y * v[1]; acc[2] += wv[j][0].z * v[2]; acc[3] += wv[j][0].w * v[3];
                    acc[4] += wv[j][1].x * v[4]; acc[5] += wv[j][1].y * v[5]; acc[6] += wv[j][1].z * v[6]; acc[7] += wv[j][1].w * v[7]; }
                if (t < T) *(u32x4*)(xc + (size_t)t * 1024 + ch) = pack8(acc); }
        }
    }
}

__device__ __forceinline__ void phase_scan(const Ctx& c0) {
    Ctx c = c0; c.lane = lane_id_v(); c.tid = c.wave * 64 + c.lane;
    const bf16_t* LA = WSP(bf16_t, WS_R0); bf16_t* Bv = WSP(bf16_t, WS_R6); const bf16_t* gate = WSP(bf16_t, WS_R3);
    LAS float* Ps = (LAS float*)c.lds; LAS float* Hs = Ps + 512;
    for (int it = c.vcu; it < 256; it += c.G) {
        const int b = it >> 4, cg = it & 15, seg = c.tid >> 6, ch = cg * 64 + (c.tid & 63);
        const size_t base = ((size_t)b * 2048 + seg * 256) * 1024 + ch;
        float P = 1.f, Hl = 0.f;
#pragma unroll 1
        for (int i0 = 0; i0 < 256; i0 += 16) {
            unsigned la[16], bv[16];
#pragma unroll
            for (int i = 0; i < 16; ++i) { la[i] = LA[base + (size_t)(i0 + i) * 1024]; bv[i] = Bv[base + (size_t)(i0 + i) * 1024]; }
#pragma unroll
            for (int i = 0; i < 16; ++i) { const float a = __builtin_amdgcn_exp2f(bf2f(la[i])); Hl = a * Hl + bf2f(bv[i]); P *= a; }
        }
        Ps[c.tid] = P; Hs[c.tid] = Hl;
        __syncthreads();
        float h = 0.f;
        for (int s2 = 0; s2 < seg; ++s2) h = Ps[s2 * 64 + (c.tid & 63)] * h + Hs[s2 * 64 + (c.tid & 63)];
#pragma unroll 1
        for (int i0 = 0; i0 < 256; i0 += 16) {
            unsigned la[16], bv[16], gv[16]; unsigned ov[16];
#pragma unroll
            for (int i = 0; i < 16; ++i) { la[i] = LA[base + (size_t)(i0 + i) * 1024]; bv[i] = Bv[base + (size_t)(i0 + i) * 1024]; gv[i] = gate[base + (size_t)(i0 + i) * 1024]; }
#pragma unroll
            for (int i = 0; i < 16; ++i) { const float a = __builtin_amdgcn_exp2f(bf2f(la[i])); h = a * h + bf2f(bv[i]); ov[i] = f2bf(h * gelu_tanh(bf2f(gv[i]))); }
#pragma unroll
            for (int i = 0; i < 16; ++i) Bv[base + (size_t)(i0 + i) * 1024] = (bf16_t)ov[i];
        }
        __syncthreads();
    }
}

struct QkvRaw { u32x4 k[2]; f32x4 cs[4]; };
__device__ __forceinline__ void qkv_load(QkvRaw& r, const bf16_t* kvraw, const bf16_t* pa, const float* CS, int t, int ch, int hq) {
    const bool act = ch < 12;
#pragma unroll
    for (int pass = 0; pass < 2; ++pass) { const int h = pass * 4 + hq;
        r.k[pass] = (u32x4){0u, 0u, 0u, 0u};
        if (ch < 8) r.k[pass] = *(const u32x4*)(kvraw + (size_t)t * 1024 + h * 128 + 8 * ch);
        else if (act) r.k[pass] = *(const u32x4*)(pa + (size_t)t * 512 + 384 + 8 * (ch - 8)); }
    const float* cp = CS + (size_t)t * 32 + 8 * (ch & 1);
    r.cs[0] = *(const f32x4*)cp; r.cs[1] = *(const f32x4*)(cp + 4); r.cs[2] = *(const f32x4*)(cp + 16); r.cs[3] = *(const f32x4*)(cp + 20);
}
__device__ __forceinline__ void phase_qkv_layout(const Ctx& c0) {
    Ctx c = c0; c.lane = lane_id_v(); c.tid = c.wave * 64 + c.lane;
    const bf16_t* kvraw = WSP(bf16_t, WS_R2); const bf16_t* pa = WSP(bf16_t, WS_R1);
    bf16_t* Kh = WSP(bf16_t, WS_R3);
    const float* kng = c.in[I_KNG]; const float* CS = WSP(float, WS_CS);
    const int gw = c.vcu * 8 + c.wave, NGW = c.G * 8, L = c.lane;
    const int ch = L & 15, hq = L >> 4;
    const bool act = ch < 12, isr = ch >= 8, hi2 = ch >= 10;
    float gk[8];
#pragma unroll
    for (int j = 0; j < 8; ++j) gk[j] = act ? kng[8 * ch + j] : 0.f;
    if (gw >= T) return;
    QkvRaw cur, nxt;
    qkv_load(cur, kvraw, pa, CS, gw, ch, hq);
#pragma unroll 1
    for (int t = gw; t < T; t += NGW) {
        qkv_load(nxt, kvraw, pa, CS, (t + NGW < T) ? t + NGW : t, ch, hq);
        const int b = t >> 11, s = t & 2047;
        const float cs[8] = {cur.cs[0].x, cur.cs[0].y, cur.cs[0].z, cur.cs[0].w, cur.cs[1].x, cur.cs[1].y, cur.cs[1].z, cur.cs[1].w};
        const float sn[8] = {cur.cs[2].x, cur.cs[2].y, cur.cs[2].z, cur.cs[2].w, cur.cs[3].x, cur.cs[3].y, cur.cs[3].z, cur.cs[3].w};
#pragma unroll
        for (int pass = 0; pass < 2; ++pass) {
            const int h = pass * 4 + hq;
            const size_t orow = ((size_t)(b * H + h) * S + s);
            float v[8]; unpack8(cur.k[pass], v);
            float ss = 0.f;
#pragma unroll
            for (int j = 0; j < 8; ++j) ss += v[j] * v[j];
#pragma unroll
            for (int o = 1; o < 16; o <<= 1) ss += __shfl_xor(ss, o);
            const float r = rsqrtf(ss * (1.f / 96.f) + EPS);
            float x[8], o8[8];
#pragma unroll
            for (int j = 0; j < 8; ++j) x[j] = v[j] * r * gk[j];
#pragma unroll
            for (int j = 0; j < 8; ++j) { const float px = __shfl_xor(x[j], 2);
                o8[j] = !isr ? x[j] : (hi2 ? px * sn[j] + x[j] * cs[j] : x[j] * cs[j] - px * sn[j]); }
            if (act) *(u32x4*)(Kh + orow * 96 + 8 * ch) = pack8(o8);
        }
        cur = nxt;
    }
}

constexpr int KROW = 208, VROW = 160;
constexpr int KBUF = 128 * KROW, VBUF = 128 * VROW;
typedef short v4i16_t __attribute__((ext_vector_type(4)));
__device__ __forceinline__ void attn_chunk2(LAS unsigned char* kb, LAS unsigned char* vb, const bf16x8 (&qf)[2][3], f32x4 (&o)[2][4], float (&mrun)[2], float (&lrun)[2], int fr, int g) {
    f32x4 sacc[2][4];
#pragma unroll
    for (int kt = 0; kt < 4; ++kt) { sacc[0][kt] = (f32x4){0.f, 0.f, 0.f, 0.f}; sacc[1][kt] = (f32x4){0.f, 0.f, 0.f, 0.f};
#pragma unroll
        for (int ks = 0; ks < 3; ++ks) { const bf16x8 kf = *(const LAS bf16x8*)(kb + (16 * kt + fr) * KROW + (ks * 32 + g * 8) * 2);
            sacc[0][kt] = __builtin_amdgcn_mfma_f32_16x16x32_bf16(kf, qf[0][ks], sacc[0][kt], 0, 0, 0);
            sacc[1][kt] = __builtin_amdgcn_mfma_f32_16x16x32_bf16(kf, qf[1][ks], sacc[1][kt], 0, 0, 0); } }
    bf16x8 pb[2][2];
#pragma unroll
    for (int t = 0; t < 2; ++t) {
        float mx = sacc[t][0][0];
#pragma unroll
        for (int kt = 0; kt < 4; ++kt)
#pragma unroll
            for (int r = 0; r < 4; ++r) mx = fmaxf(mx, sacc[t][kt][r]);
        mx = fmaxf(mx, __shfl_xor(mx, 16)); mx = fmaxf(mx, __shfl_xor(mx, 32));
        const float mnew = fmaxf(mrun[t], mx), alpha = __builtin_amdgcn_exp2f(mrun[t] - mnew); mrun[t] = mnew;
        float ps = 0.f;
#pragma unroll
        for (int kt = 0; kt < 4; ++kt)
#pragma unroll
            for (int r = 0; r < 4; ++r) { const float p = __builtin_amdgcn_exp2f(sacc[t][kt][r] - mnew); sacc[t][kt][r] = p; ps += p; }
        lrun[t] = lrun[t] * alpha + ps;
#pragma unroll
        for (int dt = 0; dt < 4; ++dt) o[t][dt] = o[t][dt] * alpha;
#pragma unroll
        for (int s2 = 0; s2 < 2; ++s2) { u32x4 pw; pw.x = pk2(sacc[t][2 * s2][0], sacc[t][2 * s2][1]); pw.y = pk2(sacc[t][2 * s2][2], sacc[t][2 * s2][3]); pw.z = pk2(sacc[t][2 * s2 + 1][0], sacc[t][2 * s2 + 1][1]); pw.w = pk2(sacc[t][2 * s2 + 1][2], sacc[t][2 * s2 + 1][3]);
            pb[t][s2] = __builtin_bit_cast(bf16x8, pw); }
    }
#pragma unroll
    for (int s2 = 0; s2 < 2; ++s2)
#pragma unroll
        for (int dt = 0; dt < 4; ++dt) {
            LAS unsigned char* va = vb + (32 * s2 + 4 * g + (fr >> 2)) * VROW + (16 * dt + 4 * (fr & 3)) * 2;
            const v4i16_t t0 = __builtin_amdgcn_ds_read_tr16_b64_v4i16((LAS v4i16_t*)va), t1 = __builtin_amdgcn_ds_read_tr16_b64_v4i16((LAS v4i16_t*)(va + 16 * VROW));
            const bf16x8 vf = (bf16x8){t0[0], t0[1], t0[2], t0[3], t1[0], t1[1], t1[2], t1[3]};
            o[0][dt] = __builtin_amdgcn_mfma_f32_16x16x32_bf16(vf, pb[0][s2], o[0][dt], 0, 0, 0);
            o[1][dt] = __builtin_amdgcn_mfma_f32_16x16x32_bf16(vf, pb[1][s2], o[1][dt], 0, 0, 0); }
}
__device__ __forceinline__ void attn_unit(const Ctx& c, int b, int h, int qb) {
    const bf16_t* qraw = WSP(bf16_t, WS_R5); const bf16_t* Kh = WSP(bf16_t, WS_R3); const bf16_t* kvraw = WSP(bf16_t, WS_R2); bf16_t* AO = WSP(bf16_t, WS_R0 + 32 * MiB);
    const float* qng = c.in[I_QNG]; const float* CS = WSP(float, WS_CS);
    const int fr = c.lane & 15, g = c.lane >> 4, wid = c.wave;
    const size_t hb = (size_t)(b * H + h) * S;
    const int q0 = qb * 256 + wid * 32;
    const int nsup = 2 * qb + 2;
    const int nch = 4 * qb + (wid >> 1) + 1;
    bf16x8 qf[2][3];
    { const float qscale = 0.10206207261596577f * 1.4426950408889634f;
#pragma unroll
      for (int t = 0; t < 2; ++t) {
          const size_t tok = (size_t)b * S + q0 + 16 * t + fr;
          float v[3][8]; float ss = 0.f;
#pragma unroll
          for (int ks = 0; ks < 3; ++ks) { unpack8(*(const u32x4*)(qraw + tok * 768 + h * 96 + ks * 32 + g * 8), v[ks]);
#pragma unroll
              for (int j = 0; j < 8; ++j) ss += v[ks][j] * v[ks][j]; }
          ss += __shfl_xor(ss, 16); ss += __shfl_xor(ss, 32);
          const float r = rsqrtf(ss * (1.f / 96.f) + EPS) * qscale;
#pragma unroll
          for (int ks = 0; ks < 3; ++ks)
#pragma unroll
              for (int j = 0; j < 8; ++j) v[ks][j] *= r * qng[ks * 32 + g * 8 + j];
          { const float* cp = CS + tok * 32 + 8 * (g & 1);
            const f32x4 c0v = *(const f32x4*)cp, c1v = *(const f32x4*)(cp + 4), s0v = *(const f32x4*)(cp + 16), s1v = *(const f32x4*)(cp + 20);
            const float cs[8] = {c0v.x, c0v.y, c0v.z, c0v.w, c1v.x, c1v.y, c1v.z, c1v.w}, sn[8] = {s0v.x, s0v.y, s0v.z, s0v.w, s1v.x, s1v.y, s1v.z, s1v.w};
#pragma unroll
            for (int j = 0; j < 8; ++j) { const float px = __shfl_xor(v[2][j], 32); v[2][j] = (g >= 2) ? px * sn[j] + v[2][j] * cs[j] : v[2][j] * cs[j] - px * sn[j]; } }
#pragma unroll
          for (int ks = 0; ks < 3; ++ks) qf[t][ks] = __builtin_bit_cast(bf16x8, pack8(v[ks]));
      } }
    f32x4 o[2][4];
#pragma unroll
    for (int t = 0; t < 2; ++t)
#pragma unroll
        for (int dt = 0; dt < 4; ++dt) o[t][dt] = (f32x4){0.f, 0.f, 0.f, 0.f};
    float mrun[2] = {-1e30f, -1e30f}, lrun[2] = {0.f, 0.f};
    u32x4 kr[3], vr[2];
    const u32x4* Ksrc = (const u32x4*)(Kh + hb * 96);
    const bf16_t* Vsrc = kvraw + ((size_t)b * S) * 1024 + h * 128 + 64;
#pragma unroll
    for (int i = 0; i < 3; ++i) kr[i] = Ksrc[c.tid + 512 * i];
#pragma unroll
    for (int i = 0; i < 2; ++i) { const int vc = c.tid + 512 * i; vr[i] = *(const u32x4*)(Vsrc + (size_t)(vc >> 3) * 1024 + (vc & 7) * 8); }
    for (int j = 0; j < nsup; ++j) {
        LAS unsigned char* kb = c.lds + (j & 1) * (KBUF + VBUF); LAS unsigned char* vb = kb + KBUF;
#pragma unroll
        for (int i = 0; i < 3; ++i) { const int kc = c.tid + 512 * i; *(LAS u32x4*)(kb + (kc / 12) * KROW + (kc % 12) * 16) = kr[i]; }
#pragma unroll
        for (int i = 0; i < 2; ++i) { const int vc = c.tid + 512 * i; *(LAS u32x4*)(vb + (vc >> 3) * VROW + (vc & 7) * 16) = vr[i]; }
        __syncthreads();
        if (j + 1 < nsup) {
#pragma unroll
            for (int i = 0; i < 3; ++i) kr[i] = Ksrc[(j + 1) * 1536 + c.tid + 512 * i];
#pragma unroll
            for (int i = 0; i < 2; ++i) { const int vc = c.tid + 512 * i; vr[i] = *(const u32x4*)(Vsrc + (size_t)((j + 1) * 128 + (vc >> 3)) * 1024 + (vc & 7) * 8); }
        }
        if (2 * j < nch) attn_chunk2(kb, vb, qf, o, mrun, lrun, fr, g);
        if (2 * j + 1 < nch) attn_chunk2(kb + 64 * KROW, vb + 64 * VROW, qf, o, mrun, lrun, fr, g);
    }
#pragma unroll
    for (int t = 0; t < 2; ++t) {
        float lt = lrun[t] + __shfl_xor(lrun[t], 16); lt += __shfl_xor(lt, 32);
        const float inv = 1.f / lt;
        bf16_t* orow = AO + ((size_t)b * S + q0 + 16 * t + fr) * 512 + h * 64;
#pragma unroll
        for (int dt = 0; dt < 4; ++dt) { u32x2 w; w.x = pk2(o[t][dt][0] * inv, o[t][dt][1] * inv); w.y = pk2(o[t][dt][2] * inv, o[t][dt][3] * inv); *(u32x2*)(orow + 16 * dt + 4 * g) = w; }
    }
    __syncthreads();
}
__device__ __forceinline__ void phase_attn(const Ctx& c0) {
    Ctx c = c0; c.lane = lane_id_v(); c.tid = c.wave * 64 + c.lane;
    for (int v = c.vcu; v < 256; v += c.G) {
        const int bh = v >> 1, odd = v & 1;
        for (int i = 0; i < 4; ++i) {
            const int setA[4] = {7, 4, 3, 0}, setB[4] = {6, 5, 2, 1};
            int qb = 0;
#pragma unroll
            for (int k = 0; k < 4; ++k) if (k == i) qb = odd ? setB[k] : setA[k];
            attn_unit(c, bh >> 3, bh & 7, qb);
        }
    }
}

__device__ __forceinline__ float wave_max(float v) {
#pragma unroll
    for (int o = 1; o < 64; o <<= 1) v = fmaxf(v, __shfl_xor(v, o));
    return v;
}
__device__ __forceinline__ int wave_min_i(int v) {
#pragma unroll
    for (int o = 1; o < 64; o <<= 1) v = min(v, __shfl_xor(v, o));
    return v;
}
__device__ __forceinline__ int prefix_cnt(unsigned long long m) { return (int)__builtin_amdgcn_mbcnt_hi((unsigned)(m >> 32), __builtin_amdgcn_mbcnt_lo((unsigned)m, 0u)); }
template <int NV, int NBITS> __device__ __forceinline__ void select16(const unsigned (&key)[NV], int (&slot)[NV]) {
    unsigned tau = 0u;
    for (int bit = NBITS - 1; bit >= 0; --bit) {
        const unsigned trial = tau | (1u << bit); int cnt = 0;
#pragma unroll
        for (int j = 0; j < NV; ++j) cnt += __popcll(__ballot(key[j] >= trial));
        if (cnt >= 16) { tau = trial; if (cnt == 16) break; }
    }
    int base = 0;
#pragma unroll
    for (int j = 0; j < NV; ++j) { const unsigned long long m = __ballot(key[j] > tau); slot[j] = (key[j] > tau) ? base + prefix_cnt(m) : -1; base += __popcll(m); }
#pragma unroll
    for (int j = 0; j < NV; ++j) { const unsigned long long m = __ballot(key[j] == tau); if (key[j] == tau) { const int s = base + prefix_cnt(m); slot[j] = s < 16 ? s : -1; } base += __popcll(m); }
}
template <int N> __device__ __forceinline__ void bitonic_stage_desc(unsigned (&x)[N], int k, int j) {
#pragma unroll
    for (int i = 0; i < N; ++i) { const int l = i ^ j; if (l > i) { const bool asc = ((i & k) != 0);
        const unsigned a = x[i], b = x[l]; const unsigned hi = a > b ? a : b, lo = a > b ? b : a; x[i] = asc ? lo : hi; x[l] = asc ? hi : lo; } }
}
__device__ __forceinline__ void sort16_desc(unsigned (&x)[16]) {
#pragma unroll
    for (int k = 2; k <= 16; k <<= 1)
#pragma unroll
        for (int j = k >> 1; j > 0; j >>= 1) bitonic_stage_desc<16>(x, k, j);
}
__device__ __forceinline__ void merge16_desc(unsigned (&run)[16], const unsigned (&ch)[16]) {
#pragma unroll
    for (int i = 0; i < 16; ++i) run[i] = run[i] > ch[15 - i] ? run[i] : ch[15 - i];
#pragma unroll
    for (int j = 8; j > 0; j >>= 1) bitonic_stage_desc<16>(run, 16, j);
}
__device__ __forceinline__ unsigned mono_hi(unsigned w) { return w ^ ((unsigned)((int)w >> 31) | 0x80000000u); }
__device__ __forceinline__ float demono_hi(unsigned k) { const unsigned kk = k & 0xffff0000u; return __builtin_bit_cast(float, (kk ^ ((unsigned)(~(int)kk >> 31) | 0x80000000u)) & 0xffff0000u); }
__device__ __forceinline__ void top16_list(LAS const unsigned char* row, int sw, unsigned (&run)[16]) {
#pragma unroll
    for (int ck = 0; ck < 8; ++ck) {
        const u32x4 w0 = *(LAS const u32x4*)(row + (((2 * ck) ^ sw) << 4)), w1 = *(LAS const u32x4*)(row + (((2 * ck + 1) ^ sw) << 4));
        const unsigned w[8] = {w0.x, w0.y, w0.z, w0.w, w1.x, w1.y, w1.z, w1.w};
        unsigned ch[16];
#pragma unroll
        for (int i = 0; i < 8; ++i) { ch[2 * i] = (mono_hi(w[i] << 16) & 0xffff0000u) | (unsigned)(ck * 16 + 2 * i); ch[2 * i + 1] = (mono_hi(w[i]) & 0xffff0000u) | (unsigned)(ck * 16 + 2 * i + 1); }
        sort16_desc(ch);
        if (ck == 0) {
#pragma unroll
            for (int i = 0; i < 16; ++i) run[i] = ch[i];
        } else merge16_desc(run, ch);
    }
}
__device__ __forceinline__ void topk_fetch(const bf16_t* src, u32x4 (&r)[16], int L) {
#pragma unroll
    for (int i = 0; i < 16; ++i) r[i] = *(const u32x4*)(src + (size_t)(4 * i + (L >> 4)) * 256 + (L & 15) * 8);
}
__device__ __forceinline__ void topk_stage(LAS unsigned char* tile, const u32x4 (&r)[16], int L) {
#pragma unroll
    for (int i = 0; i < 16; ++i) { const int row = 4 * i + (L >> 4); *(LAS u32x4*)(tile + row * 256 + ((((L & 15) ^ (row & 15))) << 4)) = r[i]; }
}
__device__ __forceinline__ void phase_topk(const Ctx& c0) {
    Ctx c = c0; c.lane = lane_id_v(); c.tid = c.wave * 64 + c.lane;
    const bf16_t* sc = WSP(bf16_t, WS_SC); int* IDX = WSP(int, WS_IDX); float* GW = WSP(float, WS_GW);
    const int L = c.lane, gw0 = (c.vcu * 8 + c.wave) * 64, NL = c.G * 512;
    LAS unsigned char* tile = c.lds + c.wave * 16384;
    LAS const unsigned char* myrow = tile + L * 256; const int sw = L & 15;
    for (int eb = gw0; eb < T * H; eb += NL) {
        const int e = eb + L;
        unsigned ka[16], kb[16];
        u32x4 ra[16], rb[16];
        topk_fetch(sc + (size_t)eb * 256, ra, L);
        topk_fetch(sc + (size_t)eb * 256 + 128, rb, L);
        topk_stage(tile, ra, L);
        top16_list(myrow, sw, ka);
        topk_stage(tile, rb, L);
        top16_list(myrow, sw, kb);
        float sa[16], sb[16]; unsigned ia[16], ib[16];
#pragma unroll
        for (int i = 0; i < 16; ++i) { sa[i] = demono_hi(ka[i]); sb[i] = demono_hi(kb[i]); ia[i] = (ka[i] & 0x7fu) << 7; ib[i] = kb[i] & 0x7fu; }
        const float mx = sa[0] + sb[0];
        unsigned run[16], ch[16]; int n = 0, nc = 0;
#pragma unroll
        for (int a = 0; a < 16; ++a)
#pragma unroll
            for (int b = 0; b < 16; ++b) if ((a + 1) * (b + 1) <= 16) {
                const int k = 65535 + (int)((sa[a] + sb[b] - mx) * 1024.f);
                ch[n] = ((unsigned)(k < 0 ? 0 : k) << 16) | ia[a] | ib[b];
                if (++n == 16) { sort16_desc(ch); if (nc == 0) {
#pragma unroll
                        for (int i = 0; i < 16; ++i) run[i] = ch[i]; } else merge16_desc(run, ch);
                    n = 0; ++nc; }
            }
#pragma unroll
        for (int i = 2; i < 16; ++i) ch[i] = 0u;
        sort16_desc(ch); merge16_desc(run, ch);
        float ex[16]; float sum = 0.f;
#pragma unroll
        for (int i = 0; i < 16; ++i) { ex[i] = __expf((float)((int)(run[i] >> 16) - 65535) * (1.f / 1024.f)); sum += ex[i]; }
        const float inv = 1.f / sum;
        u32x4* oi = (u32x4*)(IDX + (size_t)e * 16); f32x4* og = (f32x4*)(GW + (size_t)e * 16);
#pragma unroll
        for (int q = 0; q < 4; ++q) { u32x4 vi; vi.x = run[4 * q] & 0x3fffu; vi.y = run[4 * q + 1] & 0x3fffu; vi.z = run[4 * q + 2] & 0x3fffu; vi.w = run[4 * q + 3] & 0x3fffu; oi[q] = vi;
            f32x4 vg; vg.x = ex[4 * q] * inv; vg.y = ex[4 * q + 1] * inv; vg.z = ex[4 * q + 2] * inv; vg.w = ex[4 * q + 3] * inv; og[q] = vg; }
    }
}

__device__ __forceinline__ void dec32_fp4(const u32x4 r, f32x2 (&f)[16]) {
    const unsigned w[4] = {r.x, r.y, r.z, r.w};
#pragma unroll
    for (int i = 0; i < 4; ++i) { f[4 * i] = __builtin_amdgcn_cvt_scalef32_pk_f32_fp4(w[i], 1.0f, 0); f[4 * i + 1] = __builtin_amdgcn_cvt_scalef32_pk_f32_fp4(w[i], 1.0f, 1);
        f[4 * i + 2] = __builtin_amdgcn_cvt_scalef32_pk_f32_fp4(w[i], 1.0f, 2); f[4 * i + 3] = __builtin_amdgcn_cvt_scalef32_pk_f32_fp4(w[i], 1.0f, 3); }
}
__device__ __forceinline__ float dot32_fp4(const f32x2 (&hv)[16], const u32x4 r) {
    f32x2 f[16]; dec32_fp4(r, f); f32x2 s = hv[0] * f[0];
#pragma unroll
    for (int j = 1; j < 16; ++j) s = s + hv[j] * f[j];
    return s.x + s.y;
}
typedef int i32x8 __attribute__((ext_vector_type(8)));
template <int UV> __device__ __forceinline__ void phase_peer_u(const Ctx& c0) {
    Ctx c = c0; c.lane = lane_id_v(); c.tid = c.wave * 64 + c.lane;
    const int L = c.lane, pp = blockIdx.x & 3, hh = (blockIdx.x >> 2) & 1, rank = blockIdx.x >> 3, nrank = c.G >> 3;
    LAS unsigned char* meta = c.lds + 131584 + c.wave * 2048;
    LAS int* mb = (LAS int*)meta;
    LAS unsigned char* hq = meta + 1536;
    LAS unsigned char* tile = c.lds + c.wave * 16384;
    const int n = L & 15, g4 = L >> 4, lr = L >> 3, lc = L & 7;
    const unsigned char* EUs = c.ws + WS_EU + (size_t)pp * NE * 128 + ((lc ^ (lr >> 1)) << 4);
    const int* IDXl = WSP(int, WS_IDX) + L;
    const unsigned char* H8l = c.ws + WS_H2Q + pp * 256 + 4 * L;
    float* PD = WSP(float, WS_PD) + (size_t)pp * T * 128 + 32 * g4 + 4 * (n >> 1);
    const int t0 = 2 * (rank * 8 + c.wave) + hh, ts = 2 * nrank * 8;
    if (t0 >= T) return;
    const int nk = (T - t0 + ts - 1) / ts;
    int sc1 = 0x7f7f7f7f; asm volatile("" : "+v"(sc1));
    const bool swapb = WSP(unsigned, WS_C8SP)[1024] != 0u;
    const int roff = (n >> 1) * 128 + (((4 * (n & 1) + g4) ^ (n >> 2)) << 4);
    const int hoff = (n & 1) * 128 + g4 * 16;
    const int i0 = n & 1, myP = n >> 1;
#define PEER_U_DMA(m3, q) do { unsigned id_[4]; _Pragma("unroll") for (int Gq = 0; Gq < 4; ++Gq) id_[Gq] = (unsigned)mb[(m3) * 128 + 8 * (4 * (q) + Gq) + lr]; \
        _Pragma("unroll") for (int Gq = 0; Gq < 4; ++Gq) __builtin_amdgcn_global_load_lds((const unsigned*)(EUs + (id_[Gq] << 7)), (LAS unsigned*)(tile + (q) * 4096 + Gq * 1024), 16, 0, 0); } while (0)
#define PEER_U_IDS(m3, tk) do { __builtin_amdgcn_global_load_lds((const unsigned*)(IDXl + (size_t)(tk) * 128), (LAS unsigned*)(mb + (m3) * 128), 4, 0, 0); \
        __builtin_amdgcn_global_load_lds((const unsigned*)(IDXl + (size_t)(tk) * 128 + 64), (LAS unsigned*)(mb + (m3) * 128 + 64), 4, 0, 0); } while (0)
#define PEER_U_HQ(par, tk) __builtin_amdgcn_global_load_lds((const unsigned*)(H8l + (size_t)(tk) * 1024), (LAS unsigned*)(hq + (par) * 256), 4, 0, 0)
#define PEER_U_HB(dst, par) do { int ho = hoff; asm volatile("" : "+v"(ho)); const u32x4 h0 = *(const LAS u32x4*)(hq + (par) * 256 + ho), h1 = *(const LAS u32x4*)(hq + (par) * 256 + ho + 64); \
        unsigned hw[8] = {h0.x, h0.y, h0.z, h0.w, h1.x, h1.y, h1.z, h1.w}; \
        if (swapb) { _Pragma("unroll") for (int q_ = 0; q_ < 8; ++q_) hw[q_] = ((hw[q_] & 0x00ff00ffu) << 8) | ((hw[q_] >> 8) & 0x00ff00ffu); } \
        dst = (i32x8){(int)hw[0], (int)hw[1], (int)hw[2], (int)hw[3], (int)hw[4], (int)hw[5], (int)hw[6], (int)hw[7]}; } while (0)
#define PEER_U_STEP(q, dm3, dq, WAITN) do { \
        PEER_U_DMA(dm3, dq); \
        asm volatile("s_waitcnt vmcnt(" #WAITN ")" ::: "memory"); \
        int ro = roff; asm volatile("" : "+v"(ro)); \
        f32x4 a4[4]; \
        _Pragma("unroll") for (int Gq = 0; Gq < 4; ++Gq) { const u32x4 av = *(const LAS u32x4*)(tile + (q) * 4096 + Gq * 1024 + ro); \
            const i32x8 a = (i32x8){(int)av.x, (int)av.y, (int)av.z, (int)av.w, 0, 0, 0, 0}; \
            a4[Gq] = __builtin_amdgcn_mfma_scale_f32_16x16x128_f8f6f4(a, hb, (f32x4){0.f, 0.f, 0.f, 0.f}, 4, 0, 0, sc1, 0, sc1); } \
        _Pragma("unroll") for (int P = 0; P < 2; ++P) { const f32x4 x0 = a4[2 * P], x1 = a4[2 * P + 1]; \
            const f32x4 cand = (f32x4){i0 ? x0[1] : x0[0], i0 ? x0[3] : x0[2], i0 ? x1[1] : x1[0], i0 ? x1[3] : x1[2]}; \
            if (myP == 2 * (q) + P) o = cand; } \
        asm volatile("s_waitcnt lgkmcnt(0)" ::: "memory"); } while (0)
    PEER_U_IDS(0, t0); PEER_U_IDS(1, (nk > 1) ? t0 + ts : t0); PEER_U_HQ(0, t0);
    asm volatile("s_waitcnt vmcnt(0)" ::: "memory");
    PEER_U_DMA(0, 0); PEER_U_DMA(0, 1); PEER_U_DMA(0, 2);
    i32x8 hb; PEER_U_HB(hb, 0);
    int m0 = 0;
#pragma unroll 1
    for (int k = 0; k < nk; ++k) {
        const int p = k & 1, tk = t0 + k * ts, tn1 = t0 + ((k + 1 < nk) ? k + 1 : nk - 1) * ts, tn2 = t0 + ((k + 2 < nk) ? k + 2 : nk - 1) * ts;
        const int m1 = (m0 == 2) ? 0 : m0 + 1, m2 = (m1 == 2) ? 0 : m1 + 1;
        PEER_U_IDS(m2, tn2); PEER_U_HQ(p ^ 1, tn1);
        f32x4 o = (f32x4){0.f, 0.f, 0.f, 0.f};
        PEER_U_STEP(0, m0, 3, 15);
        PEER_U_STEP(1, m1, 0, 15);
        PEER_U_STEP(2, m1, 1, 15);
        PEER_U_STEP(3, m1, 2, 12);
        { f32x4 o2;
#pragma unroll
          for (int j = 0; j < 4; ++j) { const float ov = o[j]; o2[j] = ov + __builtin_bit_cast(float, __builtin_amdgcn_update_dpp(0, __builtin_bit_cast(int, ov), 0xB1, 0xf, 0xf, false)); }
          if (!(n & 1)) *(f32x4*)(PD + (size_t)tk * 128) = o2; }
        PEER_U_HB(hb, p ^ 1);
        m0 = m1;
    }
    asm volatile("s_waitcnt vmcnt(0)" ::: "memory");
#undef PEER_U_DMA
#undef PEER_U_IDS
#undef PEER_U_HQ
#undef PEER_U_HB
#undef PEER_U_STEP
}
__device__ __forceinline__ void phase_peer_fin_old(const Ctx& c0) {
    Ctx c = c0; c.lane = lane_id_v(); c.tid = c.wave * 64 + c.lane;
    const int* IDX = WSP(int, WS_IDX); const float* GW = WSP(float, WS_GW); const float* PD = WSP(float, WS_PD); unsigned* WGT = WSP(unsigned, WS_WGT);
    const float* SU = WSP(float, WS_SU); const float* SV = WSP(float, WS_SV); const float* SH = WSP(float, WS_SH);
    const int NTH = c.G * 512;
    for (int i0 = c.vcu * 512 + c.tid; i0 < T * 128; i0 += 4 * NTH) {
        float d[4]; int e[4]; float g[4];
#pragma unroll
        for (int u = 0; u < 4; ++u) { const int i = (i0 + u * NTH < T * 128) ? i0 + u * NTH : i0; float s = 0.f;
            const int k = i & 127, pi = (i & ~127) + ((k >> 1) & 3) * 32 + (k >> 3) * 2 + (k & 1);
#pragma unroll
            for (int p = 0; p < 8; ++p) s += PD[(size_t)p * T * 128 + pi];
            d[u] = s; e[u] = IDX[i]; g[u] = GW[i]; }
        float su[4], sv[4], sh[4];
#pragma unroll
        for (int u = 0; u < 4; ++u) { const int i = (i0 + u * NTH < T * 128) ? i0 + u * NTH : i0; su[u] = SU[e[u]]; sv[u] = SV[e[u]]; sh[u] = SH[i >> 7]; }
#pragma unroll
        for (int u = 0; u < 4; ++u) { const int i = i0 + u * NTH; if (i < T * 128) WGT[i] = (f2bf(g[u] * gelu_tanh(d[u] * su[u] * sh[u]) * sv[u]) << 16) | (unsigned)e[u]; }
    }
}
template <bool DRY> __device__ __forceinline__ void phase_peer_v_old(const Ctx& c0) {
    Ctx c = c0; c.lane = lane_id_v(); c.tid = c.wave * 64 + c.lane;
    const unsigned* WI = WSP(unsigned, WS_WGT); const float* mod = WSP(float, WS_MOD);
    const int L = c.lane, pp = blockIdx.x & 3, hh = (blockIdx.x >> 2) & 1, rank = blockIdx.x >> 3, nrank = c.G >> 3;
    const bool b5 = L & 32, b4 = L & 16, b3 = L & 8;
    LAS unsigned* mb = (LAS unsigned*)(c.lds + c.wave * 1024);
    const int kl = L >> 3;
    const unsigned char* EV4 = c.ws + WS_EV + (size_t)pp * NE * 128 + (L & 7) * 16;
    const int col = pp * 256 + (L & 7) * 32 + (b5 ? 16 : 0) + (b4 ? 8 : 0) + (b3 ? 4 : 0);
    const int t0 = 2 * (rank * 8 + c.wave) + hh, ts = 2 * nrank * 8;
    if (t0 >= T) return;
    { const unsigned g0 = WI[(size_t)t0 * 128 + L], g1 = WI[(size_t)t0 * 128 + 64 + L]; mb[L] = g0; mb[64 + L] = g1; }
    u32x4 rA[8], rB[8];
#pragma unroll
    for (int i = 0; i < 8; ++i) rA[i] = *(const u32x4*)(EV4 + (size_t)(mb[8 * i + kl] & 0xffffu) * 128);
    int cur = 0;
#pragma unroll 1
    for (int t = t0; t < T; t += ts) {
        const int tn = (t + ts < T) ? t + ts : t;
        const unsigned gn0 = WI[(size_t)tn * 128 + L], gn1 = WI[(size_t)tn * 128 + 64 + L];
        float* o = c.out + (size_t)t * 1024 + col; const float* g2 = mod + (t >> 11) * 6144 + 5120 + col;
        f32x4 xo = *(const f32x4*)o; const f32x4 gt = *(const f32x4*)g2;
#pragma unroll
        for (int i = 0; i < 8; ++i) rB[i] = *(const u32x4*)(EV4 + (size_t)(mb[cur * 128 + 64 + 8 * i + kl] & 0xffffu) * 128);
        f32x2 ac2[16];
#pragma unroll
        for (int j = 0; j < 16; ++j) ac2[j] = (f32x2){0.f, 0.f};
#pragma unroll
        for (int i = 0; i < 8; ++i) { const float w = bfhi(mb[cur * 128 + 8 * i + kl]); const f32x2 w2 = {w, w}; f32x2 f[16]; dec32_fp4(rA[i], f);
#pragma unroll
            for (int j = 0; j < 16; ++j) ac2[j] = ac2[j] + f[j] * w2; }
        mb[(cur ^ 1) * 128 + L] = gn0; mb[(cur ^ 1) * 128 + 64 + L] = gn1;
#pragma unroll
        for (int i = 0; i < 8; ++i) rA[i] = *(const u32x4*)(EV4 + (size_t)(mb[(cur ^ 1) * 128 + 8 * i + kl] & 0xffffu) * 128);
#pragma unroll
        for (int i = 0; i < 8; ++i) { const float w = bfhi(mb[cur * 128 + 64 + 8 * i + kl]); const f32x2 w2 = {w, w}; f32x2 f[16]; dec32_fp4(rB[i], f);
#pragma unroll
            for (int j = 0; j < 16; ++j) ac2[j] = ac2[j] + f[j] * w2; }
        float acc[32];
#pragma unroll
        for (int j = 0; j < 16; ++j) { acc[2 * j] = ac2[j].x; acc[2 * j + 1] = ac2[j].y; }
        float n16[16], n8[8], n4[4];
#pragma unroll
        for (int i = 0; i < 16; ++i) { const float send = b5 ? acc[i] : acc[i + 16], keep = b5 ? acc[i + 16] : acc[i]; n16[i] = keep + __shfl_xor(send, 32); }
#pragma unroll
        for (int i = 0; i < 8; ++i) { const float send = b4 ? n16[i] : n16[i + 8], keep = b4 ? n16[i + 8] : n16[i]; n8[i] = keep + __shfl_xor(send, 16); }
#pragma unroll
        for (int i = 0; i < 4; ++i) { const float send = b3 ? n8[i] : n8[i + 4], keep = b3 ? n8[i + 4] : n8[i]; n4[i] = keep + __shfl_xor(send, 8); }
        xo.x += gt.x * n4[0]; xo.y += gt.y * n4[1]; xo.z += gt.z * n4[2]; xo.w += gt.w * n4[3];
        if (DRY) asm volatile("" :: "v"(xo.x), "v"(xo.y), "v"(xo.z), "v"(xo.w)); else *(f32x4*)o = xo;
        cur ^= 1;
    }
}

struct ENone {};
struct FInProj { static constexpr int NB = 4; bf16_t *pa, *lx, *lg, *mg; typedef ENone Tile; typedef ENone Pre;
    __device__ __forceinline__ Tile tile(int, int, int) const { return Tile{}; }
    __device__ __forceinline__ Pre pre(int, int, int) const { return Pre{}; }
    __device__ __forceinline__ void apply(int row, int pn, int cc, const float (&v0)[8], const float (&v1)[8], const Pre&, const Tile&) const {
        bf16_t* d;
        if (pn < 2) d = pa + (size_t)row * 512 + pn * 256 + cc; else if (pn < 6) d = lx + (size_t)row * 1024 + (pn - 2) * 256 + cc;
        else if (pn < 10) d = lg + (size_t)row * 1024 + (pn - 6) * 256 + cc; else d = mg + (size_t)row * 2048 + (pn - 10) * 256 + cc;
        *(u32x4*)d = pack8(v0); *(u32x4*)(d + 128) = pack8(v1); } };
struct FRowScale { static constexpr int NB = 4; bf16_t* dst; int ldc; const float* rstd; int which; typedef ENone Tile; struct Pre { float r; };
    __device__ __forceinline__ Tile tile(int, int, int) const { return Tile{}; }
    __device__ __forceinline__ Pre pre(int row, int, int) const { return Pre{rstd[2 * row + which]}; }
    __device__ __forceinline__ void apply(int row, int pn, int cc, const float (&v0)[8], const float (&v1)[8], const Pre& p, const Tile&) const {
        float a[8], b[8];
#pragma unroll
        for (int j = 0; j < 8; ++j) { a[j] = v0[j] * p.r; b[j] = v1[j] * p.r; }
        *(u32x4*)(dst + (size_t)row * ldc + pn * 256 + cc) = pack8(a); *(u32x4*)(dst + (size_t)row * ldc + pn * 256 + 128 + cc) = pack8(b); } };
__device__ __forceinline__ void phase_peer_fin(const Ctx& c0) {
    Ctx c = c0; c.lane = lane_id_v(); c.tid = c.wave * 64 + c.lane;
    const int* IDX = WSP(int, WS_IDX); const float* GW = WSP(float, WS_GW); const float* PD = WSP(float, WS_PD);
    const float* SU = WSP(float, WS_SU); const float* SV = WSP(float, WS_SV); const float* SH = WSP(float, WS_SH);
    unsigned char* W8 = c.ws + WS_W8;
    const int L = c.lane, gw = c.vcu * 8 + c.wave, NGW = c.G * 8;
    const int pi = 2 * L, k0 = 8 * (L & 15) + 2 * (L >> 4);
    constexpr int NT = 4;
#pragma unroll 1
    for (int t = gw; t < T; t += NT * NGW) {
        f32x2 d[NT], g[NT]; int e0[NT], e1[NT]; float sh[NT];
#pragma unroll
        for (int u = 0; u < NT; ++u) { const int tt = (t + u * NGW < T) ? t + u * NGW : t; f32x2 s = (f32x2){0.f, 0.f};
#pragma unroll
            for (int p = 0; p < 4; ++p) s = s + *(const f32x2*)(PD + (size_t)p * T * 128 + (size_t)tt * 128 + pi);
            d[u] = s; const i32x2 ee = *(const i32x2*)(IDX + (size_t)tt * 128 + k0); e0[u] = ee.x; e1[u] = ee.y; g[u] = *(const f32x2*)(GW + (size_t)tt * 128 + k0); sh[u] = SH[tt]; }
        float su0[NT], su1[NT], sv0[NT], sv1[NT];
#pragma unroll
        for (int u = 0; u < NT; ++u) { su0[u] = SU[e0[u]]; su1[u] = SU[e1[u]]; sv0[u] = SV[e0[u]]; sv1[u] = SV[e1[u]]; }
#pragma unroll
        for (int u = 0; u < NT; ++u) { const int tt = t + u * NGW; if (tt < T) {
            const float w0 = g[u].x * gelu_tanh(d[u].x * su0[u] * sh[u]) * sv0[u], w1 = g[u].y * gelu_tanh(d[u].y * su1[u] * sh[u]) * sv1[u];
            float m = fmaxf(fabsf(w0), fabsf(w1));
#pragma unroll
            for (int o = 1; o < 64; o <<= 1) m = fmaxf(m, __shfl_xor(m, o));
            const float sc = m > 0.f ? m * (1.f / 224.f) : 1.f, inv = 1.f / sc;
            const int pk = __builtin_amdgcn_cvt_pk_fp8_f32(w0 * inv, w1 * inv, 0, false);
            *(unsigned short*)(W8 + (size_t)tt * 256 + k0) = (unsigned short)(pk & 0xffff);
            if (L == 0) *(float*)(W8 + (size_t)tt * 256 + 128) = sc; } }
    }
}

template <int DRY> __device__ __forceinline__ void phase_peer_v(const Ctx& c0) {
    Ctx c = c0; c.lane = lane_id_v(); c.tid = c.wave * 64 + c.lane;
    const int L = c.lane, pp = blockIdx.x & 3, hh = (blockIdx.x >> 2) & 1, rank = blockIdx.x >> 3, nrank = c.G >> 3;
    LAS unsigned char* meta = c.lds + 131584 + c.wave * 3584;
    LAS int* mb = (LAS int*)meta;
    LAS unsigned char* wq = meta + 1024;
    LAS unsigned char* buf = meta + 1536;
    LAS unsigned char* gbuf = meta + 2560;
    LAS unsigned char* tile = c.lds + c.wave * 16384;
    const int n = L & 15, g4 = L >> 4, lr = L >> 3, lc = L & 7;
    const unsigned char* EVe = c.ws + WS_EV + (size_t)pp * NE * 128 + ((lc ^ (lr >> 1)) << 4);
    const unsigned char* EVo = c.ws + WS_EV + (size_t)pp * NE * 128 + ((lc ^ (4 + (lr >> 1))) << 4);
    const int* IDXl = WSP(int, WS_IDX) + L;
    const unsigned char* W8l = c.ws + WS_W8 + 4 * L;
    const unsigned char* X1l = c.ws + WS_X1B + pp * 512 + 4 * L;
    const float* G2l = WSP(float, WS_MOD) + 5120 + pp * 256 + 4 * L;
    const int t0 = 2 * (rank * 8 + c.wave) + hh, ts = 2 * nrank * 8;
    if (t0 >= T) return;
    const int nk = (T - t0 + ts - 1) / ts;
    int sc1 = 0x7f7f7f7f; asm volatile("" : "+v"(sc1));
    const bool swapn = WSP(unsigned, WS_C8SP)[1024] != 0u;
    const int ab = n * 128, ay = (g4 ^ ((n >> 1) & 7)) << 4;
    const bool z0 = n == g4, z1 = n == 4 + g4;
#define PEER_V_IDS(par, tk) do { __builtin_amdgcn_global_load_lds((const unsigned*)(IDXl + (size_t)(tk) * 128), (LAS unsigned*)(mb + (par) * 128), 4, 0, 0); \
        __builtin_amdgcn_global_load_lds((const unsigned*)(IDXl + (size_t)(tk) * 128 + 64), (LAS unsigned*)(mb + (par) * 128 + 64), 4, 0, 0); } while (0)
#define PEER_V_W8(par, tk) __builtin_amdgcn_global_load_lds((const unsigned*)(W8l + (size_t)(tk) * 256), (LAS unsigned*)(wq + (par) * 256), 4, 0, 0)
#define PEER_V_XG(tk) do { if (DRY == 3) break; __builtin_amdgcn_global_load_lds((const unsigned*)(X1l + (size_t)(tk) * 2048), (LAS unsigned*)buf, 4, 0, 0); \
        __builtin_amdgcn_global_load_lds((const unsigned*)(X1l + (size_t)(tk) * 2048 + 256), (LAS unsigned*)(buf + 256), 4, 0, 0); \
        __builtin_amdgcn_global_load_lds((const unsigned*)(G2l + ((tk) >> 11) * 6144), (LAS unsigned*)gbuf, 16, 0, 0); } while (0)
#define PEER_V_DMA(par, e) do { const unsigned id0_ = (unsigned)mb[(par) * 128 + 16 * (e) + lr], id1_ = (unsigned)mb[(par) * 128 + 16 * (e) + 8 + lr]; \
        __builtin_amdgcn_global_load_lds((const unsigned*)(EVe + (id0_ << 7)), (LAS unsigned*)(tile + (e) * 2048), 16, 0, 0); \
        __builtin_amdgcn_global_load_lds((const unsigned*)(EVo + (id1_ << 7)), (LAS unsigned*)(tile + (e) * 2048 + 1024), 16, 0, 0); } while (0)
#define PEER_V_STEP(e, dpar, de, WAITN) do { \
        PEER_V_DMA(dpar, de); \
        asm volatile("s_waitcnt vmcnt(" #WAITN ")" ::: "memory"); \
        int ab_ = ab, ay_ = ay; asm volatile("" : "+v"(ab_), "+v"(ay_)); \
        const u32x4 wv = *(const LAS u32x4*)(wq + p * 256 + 16 * (e)); \
        const i32x8 hb = (i32x8){z0 ? (int)wv.x : 0, z0 ? (int)wv.y : 0, z0 ? (int)wv.z : 0, z0 ? (int)wv.w : 0, z1 ? (int)wv.x : 0, z1 ? (int)wv.y : 0, z1 ? (int)wv.z : 0, z1 ? (int)wv.w : 0}; \
          \
        const unsigned tb_ = (unsigned)(__SIZE_TYPE__)(tile + (e) * 2048) + (unsigned)ab_; \
        const unsigned a0_ = tb_ + (unsigned)(0 ^ ay_), a1_ = tb_ + (unsigned)(64 ^ ay_); \
        i32x2 f00, f01, f10, f11; \
        asm volatile("ds_read_b64_tr_b4 %0, %4\n\tds_read_b64_tr_b4 %1, %4 offset:8\n\tds_read_b64_tr_b4 %2, %5\n\tds_read_b64_tr_b4 %3, %5 offset:8\n\ts_waitcnt lgkmcnt(0)" \
                     : "=&v"(f00), "=&v"(f01), "=&v"(f10), "=&v"(f11) : "v"(a0_), "v"(a1_) : "memory"); \
        acc[0] = __builtin_amdgcn_mfma_scale_f32_16x16x128_f8f6f4((i32x8){f00.x, f00.y, f01.x, f01.y, 0, 0, 0, 0}, hb, acc[0], 4, 0, 0, sc1, 0, sc1); \
        acc[1] = __builtin_amdgcn_mfma_scale_f32_16x16x128_f8f6f4((i32x8){f10.x, f10.y, f11.x, f11.y, 0, 0, 0, 0}, hb, acc[1], 4, 0, 0, sc1, 0, sc1); \
        } while (0)
    PEER_V_IDS(0, t0); PEER_V_IDS(1, (nk > 1) ? t0 + ts : t0); PEER_V_W8(0, t0);
    asm volatile("s_waitcnt vmcnt(0)" ::: "memory");
    PEER_V_DMA(0, 0); PEER_V_DMA(0, 1); PEER_V_DMA(0, 2); PEER_V_DMA(0, 3); PEER_V_DMA(0, 4); PEER_V_DMA(0, 5); PEER_V_DMA(0, 6); PEER_V_XG(t0);
#pragma unroll 1
    for (int k = 0; k < nk; ++k) {
        const int p = k & 1, tk = t0 + k * ts, tn1 = t0 + ((k + 1 < nk) ? k + 1 : nk - 1) * ts, tn2 = t0 + ((k + 2 < nk) ? k + 2 : nk - 1) * ts;
        f32x4 acc[2];
        acc[0] = (f32x4){0.f, 0.f, 0.f, 0.f}; acc[1] = (f32x4){0.f, 0.f, 0.f, 0.f};
        PEER_V_STEP(0, p, 7, 17);
        PEER_V_IDS(p, tn2); PEER_V_W8(p ^ 1, tn1);
        PEER_V_STEP(1, p ^ 1, 0, 20);
        PEER_V_STEP(2, p ^ 1, 1, 20);
        PEER_V_STEP(3, p ^ 1, 2, 20);
        PEER_V_STEP(4, p ^ 1, 3, 20);
        PEER_V_STEP(5, p ^ 1, 4, 20);
        PEER_V_STEP(6, p ^ 1, 5, 20);
        PEER_V_STEP(7, p ^ 1, 6, 17);
        const u32x2 xb = *(const LAS u32x2*)(buf + 8 * L); const f32x4 xo = (f32x4){bflo(xb.x), bfhi(xb.x), bflo(xb.y), bfhi(xb.y)}, gt = *(const LAS f32x4*)(gbuf + 16 * L); const float swt = *(const LAS float*)(wq + p * 256 + 128);
        asm volatile("s_waitcnt lgkmcnt(0)" ::: "memory");
        if (n < 8) {
#pragma unroll
            for (int M = 0; M < 2; ++M) { f32x4 v = acc[M]; if (swapn) v = (f32x4){v.y, v.x, v.w, v.z}; *(LAS f32x4*)(buf + (128 * M + 16 * n + 4 * g4) * 4) = v; } }
        const f32x4 r = *(const LAS f32x4*)(buf + 16 * L);
        f32x4 res; res.x = xo.x + gt.x * swt * r.x; res.y = xo.y + gt.y * swt * r.y; res.z = xo.z + gt.z * swt * r.z; res.w = xo.w + gt.w * swt * r.w;
        if (DRY) asm volatile("" :: "v"(res.x), "v"(res.y), "v"(res.z), "v"(res.w)); else *(f32x4*)(c.out + (size_t)tk * 1024 + pp * 256 + 4 * L) = res;
        asm volatile("s_waitcnt lgkmcnt(0)" ::: "memory");
        PEER_V_XG(tn1);
    }
    asm volatile("s_waitcnt vmcnt(0)" ::: "memory");
#undef PEER_V_IDS
#undef PEER_V_W8
#undef PEER_V_XG
#undef PEER_V_DMA
#undef PEER_V_STEP
}


constexpr int GT_OFF = 132096;
struct FGates { static constexpr int NB = 2; const bf16_t* xc; bf16_t *LA, *Bv; LAS const float* gt;
    typedef ENone Tile; struct Pre { u32x4 x; };
    __device__ __forceinline__ Tile tile(int, int, int) const { return Tile{}; }
    __device__ __forceinline__ Pre pre(int row, int pn, int cc) const { return Pre{*(const u32x4*)(xc + (size_t)row * 1024 + pn * 128 + cc)}; }
    __device__ __forceinline__ void apply(int row, int pn, int cc, const float (&v0)[8], const float (&v1)[8], const Pre& p, const Tile&) const {
        const int ch = pn * 128 + cc; float x[8], la[8], bv[8]; unpack8(p.x, x);
        const f32x4 br0 = *(LAS const f32x4*)(gt + ch), br1 = *(LAS const f32x4*)(gt + ch + 4), bi0 = *(LAS const f32x4*)(gt + 1024 + ch), bi1 = *(LAS const f32x4*)(gt + 1024 + ch + 4),
                    c80 = *(LAS const f32x4*)(gt + 2048 + ch), c81 = *(LAS const f32x4*)(gt + 2048 + ch + 4);
        const float br[8] = {br0.x, br0.y, br0.z, br0.w, br1.x, br1.y, br1.z, br1.w}, bi[8] = {bi0.x, bi0.y, bi0.z, bi0.w, bi1.x, bi1.y, bi1.z, bi1.w}, c8[8] = {c80.x, c80.y, c80.z, c80.w, c81.x, c81.y, c81.z, c81.w};
#pragma unroll
        for (int j = 0; j < 8; ++j) {
            const float r = __builtin_amdgcn_rcpf(1.f + __expf(-(v0[j] + br[j]))), ig = __builtin_amdgcn_rcpf(1.f + __expf(-(v1[j] + bi[j])));
            const float loga = r * c8[j];
            const float z = 2.f * loga;
            const float ser = -z * (1.f + z * (0.5f + z * (0.16666667f + z * (0.041666668f + z * (0.008333334f + z * 0.0013888889f)))));
            const float om = (z > -0.25f) ? ser : (1.f - __expf(z));
            la[j] = loga * 1.4426950408889634f;
            bv[j] = sqrtf(om) * (ig * x[j]);
        }
        *(u32x4*)(LA + (size_t)row * 1024 + ch) = pack8(la); *(u32x4*)(Bv + (size_t)row * 1024 + ch) = pack8(bv); } };
struct FY1 { static constexpr int NB = 4; const bf16_t* mg; bf16_t* y; int goff; bool accum; typedef ENone Tile; struct Pre { u32x4 g0, g1, y0, y1; };
    __device__ __forceinline__ Tile tile(int, int, int) const { return Tile{}; }
    __device__ __forceinline__ Pre pre(int row, int pn, int cc) const { Pre p; const int col = pn * 256 + cc;
        p.g0 = *(const u32x4*)(mg + (size_t)row * 2048 + goff + col); p.g1 = *(const u32x4*)(mg + (size_t)row * 2048 + goff + col + 128);
        if (accum) { p.y0 = *(const u32x4*)(y + (size_t)row * 1024 + col); p.y1 = *(const u32x4*)(y + (size_t)row * 1024 + col + 128); } else { p.y0 = (u32x4){0u, 0u, 0u, 0u}; p.y1 = p.y0; }
        return p; }
    __device__ __forceinline__ void one(bf16_t* dst, const u32x4 g, const u32x4 yo, const float (&v)[8]) const {
        float gt[8], o[8]; unpack8(g, gt); unpack8(yo, o);
#pragma unroll
        for (int j = 0; j < 8; ++j) o[j] = o[j] + sigmoidf_(gt[j]) * v[j];
        *(u32x4*)dst = pack8(o); }
    __device__ __forceinline__ void apply(int row, int pn, int cc, const float (&v0)[8], const float (&v1)[8], const Pre& p, const Tile&) const {
        bf16_t* d = y + (size_t)row * 1024 + pn * 256 + cc; one(d, p.g0, p.y0, v0); one(d + 128, p.g1, p.y1, v1); } };
struct FX1 { static constexpr int NB = 4; const float* x; bf16_t* out; const float* mod; struct Tile { f32x4 a[4]; }; struct Pre { f32x4 x[4]; };
    __device__ __forceinline__ Tile tile(int pn, int cc, int pm) const { Tile t; const float* g1 = mod + ((pm * 256) >> 11) * 6144 + 2048 + pn * 256 + cc;
        t.a[0] = *(const f32x4*)g1; t.a[1] = *(const f32x4*)(g1 + 4); t.a[2] = *(const f32x4*)(g1 + 128); t.a[3] = *(const f32x4*)(g1 + 132); return t; }
    __device__ __forceinline__ Pre pre(int row, int pn, int cc) const { Pre p; const float* xr = x + (size_t)row * 1024 + pn * 256 + cc;
        p.x[0] = *(const f32x4*)xr; p.x[1] = *(const f32x4*)(xr + 4); p.x[2] = *(const f32x4*)(xr + 128); p.x[3] = *(const f32x4*)(xr + 132); return p; }
    __device__ __forceinline__ void apply(int row, int pn, int cc, const float (&v0)[8], const float (&v1)[8], const Pre& p, const Tile& t) const {
        bf16_t* o = out + (size_t)row * 1024 + pn * 256 + cc;
        f32x4 r0, r1, r2, r3;
        r0.x = p.x[0].x + t.a[0].x * v0[0]; r0.y = p.x[0].y + t.a[0].y * v0[1]; r0.z = p.x[0].z + t.a[0].z * v0[2]; r0.w = p.x[0].w + t.a[0].w * v0[3];
        r1.x = p.x[1].x + t.a[1].x * v0[4]; r1.y = p.x[1].y + t.a[1].y * v0[5]; r1.z = p.x[1].z + t.a[1].z * v0[6]; r1.w = p.x[1].w + t.a[1].w * v0[7];
        r2.x = p.x[2].x + t.a[2].x * v1[0]; r2.y = p.x[2].y + t.a[2].y * v1[1]; r2.z = p.x[2].z + t.a[2].z * v1[2]; r2.w = p.x[2].w + t.a[2].w * v1[3];
        r3.x = p.x[3].x + t.a[3].x * v1[4]; r3.y = p.x[3].y + t.a[3].y * v1[5]; r3.z = p.x[3].z + t.a[3].z * v1[6]; r3.w = p.x[3].w + t.a[3].w * v1[7];
        u32x4 w0, w1; w0.x = pk2(r0.x, r0.y); w0.y = pk2(r0.z, r0.w); w0.z = pk2(r1.x, r1.y); w0.w = pk2(r1.z, r1.w); w1.x = pk2(r2.x, r2.y); w1.y = pk2(r2.z, r2.w); w1.z = pk2(r3.x, r3.y); w1.w = pk2(r3.z, r3.w);
        *(u32x4*)o = w0; *(u32x4*)(o + 128) = w1; } };
struct FStore { static constexpr int NB = 4; bf16_t* dst; int ldc; typedef ENone Tile; typedef ENone Pre;
    __device__ __forceinline__ Tile tile(int, int, int) const { return Tile{}; }
    __device__ __forceinline__ Pre pre(int, int, int) const { return Pre{}; }
    __device__ __forceinline__ void apply(int row, int pn, int cc, const float (&v0)[8], const float (&v1)[8], const Pre&, const Tile&) const {
        *(u32x4*)(dst + (size_t)row * ldc + pn * 256 + cc) = pack8(v0); *(u32x4*)(dst + (size_t)row * ldc + pn * 256 + 128 + cc) = pack8(v1); } };

template <int M, int N, int K, int LDA, int ACS, class F> __device__ __forceinline__ void run_gemm(const Ctx& c, const bf16_t* A, const bf16_t* Bt, const F& f) {
    pg8::Gemm g{A, Bt}; pg8::StaticOrder<M, N> So; So.init(c.G, (int)blockIdx.x);
    pg8::EpiF<F> E{f};
    pg8::gemm_phase<K, LDA, ACS, pg8::EpiF<F>, pg8::StaticOrder<M, N>>((PG8_LAS unsigned char*)c.lds, g, So, E, c.wave * 64 + lane_id_v());
}

__global__ void __launch_bounds__(512, 2) mk_fwd(Args args) {
    extern __shared__ __attribute__((aligned(16))) unsigned char lds_raw[];
    Ctx c;
    c.lds = (LAS unsigned char*)lds_raw;
    c.wave = __builtin_amdgcn_readfirstlane(threadIdx.x >> 6); c.lane = lane_id_v(); c.tid = c.wave * 64 + c.lane;
    c.G = gridDim.x; { const int bx = blockIdx.x; c.vcu = (c.G % 8 == 0) ? (bx % 8) * (c.G / 8) + bx / 8 : bx; }
    c.in = args.in; c.out = args.out; c.ws = args.ws;
    volatile LAS unsigned* MISC = (volatile LAS unsigned*)(c.lds + MISC_OFF);
    if (c.tid < 32) MISC[c.tid] = 0u;
    __syncthreads();
    XcdBarrier bar; bar.bar = (unsigned*)(c.ws + WS_CTL) + 4096; bar.x = 0; bar.st = nullptr;
    if (args.ph_hi - args.ph_lo > 1) bar = xcd_barrier_post((unsigned*)(c.ws + WS_CTL) + 4096, MISC + 8);

    const int lo = args.ph_lo, hi = args.ph_hi;
#ifndef ONLYP
#define ONLYP -1
#endif
#define IN(k) (lo <= (k) && (k) < hi && (ONLYP < 0 || ONLYP == (k)))
#define SEAM(k) do { if ((k) + 1 < hi) xcd_barrier(bar, c.wave); } while (0)
#ifndef REPEAT_MASK
#define REPEAT_MASK 0
#endif
#ifdef PROBE_TIME
#define PROBE_TS(k) do { if (blockIdx.x == 0 && c.wave == 0 && lane_id_v() == 0) WSP(unsigned long long, WS_C8SP + 16384)[k] = wall_clock64(); } while (0)
#else
#define PROBE_TS(k) do { } while (0)
#endif
#define PHASE(k, ...) if (IN(k)) { c.lane = lane_id_v(); c.tid = c.wave * 64 + c.lane; { __VA_ARGS__ } if ((REPEAT_MASK >> (k)) & 1) { xcd_barrier(bar, c.wave); { __VA_ARGS__ } } SEAM(k); PROBE_TS((k) + 1); }
    PROBE_TS(0);
#ifdef PROBE_PREP
    if (IN(0)) { c.lane = lane_id_v(); c.tid = c.wave * 64 + c.lane; phase_prep<PROBE_PREP>(c); xcd_barrier(bar, c.wave); }
#endif
    PHASE(0, phase_prep<15>(c);)
    PHASE(1, phase_modnorm<false>(c, c.in[I_X], c.in[I_N1G], 0, 1024, WSP(bf16_t, WS_R0));)
    PHASE(2, FInProj f{WSP(bf16_t, WS_R1), WSP(bf16_t, WS_R2), WSP(bf16_t, WS_R3), (bf16_t*)c.out};
             run_gemm<T, 4608, 1024, 1024, 0>(c, WSP(bf16_t, WS_R0), WSP(bf16_t, WS_WIN), f);)
    PHASE(3, phase_conv(c);)
    PHASE(4, { LAS float* gtl = (LAS float*)(c.lds + GT_OFF);
               for (int e = c.tid; e < 1024; e += 512) { gtl[e] = c.in[I_BRG][e]; gtl[1024 + e] = c.in[I_BIG][e]; gtl[2048 + e] = WSP(float, WS_C8SP)[e]; }
               __syncthreads();
               FGates fg{WSP(bf16_t, WS_R4), WSP(bf16_t, WS_R0), WSP(bf16_t, WS_R6), gtl};
               run_gemm<T, 2048, 128, 1024, 128>(c, WSP(bf16_t, WS_R4), WSP(bf16_t, WS_WG), fg); }
             { FRowScale fq{WSP(bf16_t, WS_R5), 768, WSP(float, WS_RSTD), 0};
               run_gemm<T, 768, 256, 512, 0>(c, WSP(bf16_t, WS_R1), WSP(bf16_t, WS_WUQ), fq); })
    PHASE(5, { FRowScale fkv{WSP(bf16_t, WS_R2), 1024, WSP(float, WS_RSTD), 1};
               run_gemm<T, 1024, 128, 512, 0>(c, WSP(bf16_t, WS_R1) + 256, WSP(bf16_t, WS_WUKV), fkv); }
             phase_scan(c);)
    PHASE(6, phase_qkv_layout(c);)
    PHASE(7, phase_attn(c);)
    PHASE(8, { FY1 f1{(const bf16_t*)c.out, WSP(bf16_t, WS_R2), 0, false};
               run_gemm<T, 1024, 512, 512, 0>(c, WSP(bf16_t, WS_R0 + 32 * MiB), WSP(bf16_t, WS_WOA), f1); }
             { FY1 f2{(const bf16_t*)c.out, WSP(bf16_t, WS_R2), 1024, true};
               run_gemm<T, 1024, 1024, 1024, 0>(c, WSP(bf16_t, WS_R6), WSP(bf16_t, WS_WOL), f2); })
    PHASE(9, FX1 f{c.in[I_X], WSP(bf16_t, WS_X1B), WSP(float, WS_MOD)};
             run_gemm<T, 1024, 1024, 1024, 0>(c, WSP(bf16_t, WS_R2), WSP(bf16_t, WS_WOUT), f);)
    PHASE(10, phase_modnorm<true>(c, WSP(bf16_t, WS_X1B), c.in[I_N2G], 3072, 4096, WSP(bf16_t, WS_R0));)
    PHASE(11, FStore f{WSP(bf16_t, WS_SC), 2048};
              run_gemm<T, 2048, 1024, 1024, 0>(c, WSP(bf16_t, WS_R0), WSP(bf16_t, WS_WQ), f);)
    PHASE(13, phase_topk(c);)
#ifdef PROBE_UVAR
    if (IN(14)) { c.lane = lane_id_v(); c.tid = c.wave * 64 + c.lane; phase_peer_u<PROBE_UVAR>(c); xcd_barrier(bar, c.wave); }
#endif
    PHASE(14, phase_peer_u<0>(c);)
    PHASE(15, phase_peer_fin(c);)
#ifdef PROBE_VDRY
    if (IN(16)) { for (int rep = 0; rep < PROBE_VDRY; ++rep) { c.lane = lane_id_v(); c.tid = c.wave * 64 + c.lane; phase_peer_v<PROBE_VVAR>(c); xcd_barrier(bar, c.wave); } }
#endif
    PHASE(16, phase_peer_v<0>(c);)
#ifdef PROBE_TIME
    if (blockIdx.x == 0) { __syncthreads(); if (c.wave == 0 && lane_id_v() == 0) { __threadfence(); const unsigned long long* ts = WSP(unsigned long long, WS_C8SP + 16384); c.out[0] = (float)(ts[PROBE_TIME_HI] - ts[PROBE_TIME]) * 0.01f; } }
#endif
#undef PHASE
#undef IN
#undef SEAM
}

extern "C" void kernel_launch(void* const* d_in, const int* in_sizes, int n_in, void* d_out, int out_size, void* d_ws, size_t ws_size, hipStream_t stream) {
    static int grid = 0;
    if (grid == 0) {
        if (n_in != 28 || out_size != T * D || ws_size < WS_END) { fprintf(stderr, "kernel_launch: unexpected shapes (n_in %d out %d ws %zu)\n", n_in, out_size, ws_size); grid = -1; return; }
        int dev = 0, cus = 0, per_cu = 0;
        if (hipGetDevice(&dev) != hipSuccess || hipDeviceGetAttribute(&cus, hipDeviceAttributeMultiprocessorCount, dev) != hipSuccess) { grid = -1; return; }
        if (hipFuncSetAttribute((const void*)mk_fwd, hipFuncAttributeMaxDynamicSharedMemorySize, LDS_BYTES) != hipSuccess) { fprintf(stderr, "kernel_launch: hipFuncSetAttribute failed\n"); grid = -1; return; }
        if (hipOccupancyMaxActiveBlocksPerMultiprocessor(&per_cu, (const void*)mk_fwd, 512, LDS_BYTES) != hipSuccess || per_cu < 1) { fprintf(stderr, "kernel_launch: occupancy query says %d blocks per CU\n", per_cu); grid = -1; (void)hipGetLastError(); return; }
        grid = cus - (cus % 8);
        if (grid < 8) { fprintf(stderr, "kernel_launch: needs at least 8 CUs\n"); grid = -1; return; }
    }
    if (grid < 0) return;
    (void)hipMemsetAsync((char*)d_ws + WS_CTL, 0, CTL_ZERO_BYTES, stream);
    Args a{};
    for (int i = 0; i < 28; ++i) a.in[i] = (const float*)d_in[i];
    a.out = (float*)d_out; a.ws = (unsigned char*)d_ws;
#if MK_N_LAUNCHES == 1
    a.ph_lo = 0; a.ph_hi = N_PHASES;
    hipLaunchKernelGGL(mk_fwd, dim3(grid), dim3(512), LDS_BYTES, stream, a);
#else
    for (int ph = 0; ph < N_PHASES; ++ph) { a.ph_lo = ph; a.ph_hi = ph + 1; hipLaunchKernelGGL(mk_fwd, dim3(grid), dim3(512), LDS_BYTES, stream, a); }
#endif
}
```

```cpp
#include <hip/hip_runtime.h>
#include <type_traits>
#include <cstdio>
#include <cstdint>

#define LAS __attribute__((address_space(3)))
#define GAS __attribute__((address_space(1)))
typedef unsigned short bf16_t;
typedef short bf16x8 __attribute__((ext_vector_type(8)));
typedef float f32x4 __attribute__((ext_vector_type(4)));
typedef float f32x2 __attribute__((ext_vector_type(2)));
typedef unsigned u32x4 __attribute__((ext_vector_type(4)));
typedef unsigned u32x2 __attribute__((ext_vector_type(2)));
typedef int i32x2 __attribute__((ext_vector_type(2)));

#ifndef MK_N_LAUNCHES
#define MK_N_LAUNCHES 1
#endif

constexpr int T = 32768, D = 1024, NB_ = 16, S = 2048, H = 8;
constexpr int QKH = 96, VH = 64;
constexpr int NE = 16384;
constexpr float EPS = 1e-6f;

constexpr size_t MiB = 1u << 20;
constexpr size_t WS_CTL = 0, CTL_ZERO_BYTES = 65536;
constexpr size_t WS_MOD = 1 * MiB;
constexpr size_t WS_RSTD = 1 * MiB + 512 * 1024;
constexpr size_t WS_C8SP = 1 * MiB + 448 * 1024;
constexpr size_t WS_WIN = 2 * MiB;
constexpr size_t WS_WUQ = 11 * MiB;
constexpr size_t WS_WUKV = 11 * MiB + 512 * 1024;
constexpr size_t WS_WOA = 12 * MiB;
constexpr size_t WS_WOL = 13 * MiB;
constexpr size_t WS_WOUT = 15 * MiB;
constexpr size_t WS_WQ = 17 * MiB;
constexpr size_t WS_WG = 21 * MiB;
constexpr size_t WS_SK = 22 * MiB;
constexpr size_t WS_EU = 24 * MiB;
constexpr size_t WS_EV = 40 * MiB;
constexpr size_t WS_SU = 1 * MiB + 768 * 1024;
constexpr size_t WS_SV = 1 * MiB + 832 * 1024;
constexpr size_t WS_WGT = 440 * MiB;
constexpr size_t WS_CS = 56 * MiB;
constexpr size_t WS_H2Q = 456 * MiB;
constexpr size_t WS_SH = 1 * MiB + 896 * 1024;
constexpr size_t WS_PD = 184 * MiB;
constexpr size_t WS_R0 = 88 * MiB;
constexpr size_t WS_R1 = 152 * MiB;
constexpr size_t WS_R2 = 184 * MiB;
constexpr size_t WS_R3 = 248 * MiB;
constexpr size_t WS_R4 = 312 * MiB;
constexpr size_t WS_R5 = 376 * MiB;
constexpr size_t WS_R6 = 424 * MiB;
constexpr size_t WS_QP = 152 * MiB;
constexpr size_t WS_SC = 184 * MiB;
constexpr size_t WS_X1B = 312 * MiB;
constexpr size_t WS_IDX = 408 * MiB;
constexpr size_t WS_GW = 424 * MiB;
constexpr size_t WS_W8 = 440 * MiB;
constexpr size_t WS_END = 488 * MiB;

constexpr int LDS_BYTES = 160256;
constexpr int MISC_OFF = 131072 + 320;

__device__ __forceinline__ unsigned f2bf(float f) { unsigned u = __builtin_bit_cast(unsigned, f); return (u + 0x7fffu + ((u >> 16) & 1u)) >> 16; }
typedef __bf16 bf16x2_t __attribute__((ext_vector_type(2)));
__device__ __forceinline__ unsigned pk2(float lo, float hi) { f32x2 v = {lo, hi}; return __builtin_bit_cast(unsigned, __builtin_convertvector(v, bf16x2_t)); }
__device__ __forceinline__ float bf2f(unsigned h) { return __builtin_bit_cast(float, h << 16); }
__device__ __forceinline__ float bflo(unsigned w) { return __builtin_bit_cast(float, w << 16); }
__device__ __forceinline__ float bfhi(unsigned w) { return __builtin_bit_cast(float, w & 0xffff0000u); }
__device__ __forceinline__ float sigmoidf_(float x) { return 1.f / (1.f + __expf(-x)); }
__device__ __forceinline__ float gelu_tanh(float x) {
    const float u = 0.7978845608028654f * (x + 0.044715f * x * x * x);
    const float e = __expf(2.f * u);
    const float th = 1.f - 2.f / (e + 1.f);
    return 0.5f * x * (1.f + th);
}
__device__ __forceinline__ int lane_id_v() { int l; asm volatile("v_mbcnt_lo_u32_b32 %0, -1, 0\n\tv_mbcnt_hi_u32_b32 %0, -1, %0" : "=v"(l)); return l; }
__device__ __forceinline__ float wave_sum(float v) {
#pragma unroll
    for (int o = 1; o < 64; o <<= 1) v += __shfl_xor(v, o);
    return v;
}
__device__ __forceinline__ void unpack8(const u32x4 w, float (&v)[8]) {
    v[0] = bflo(w.x); v[1] = bfhi(w.x); v[2] = bflo(w.y); v[3] = bfhi(w.y); v[4] = bflo(w.z); v[5] = bfhi(w.z); v[6] = bflo(w.w); v[7] = bfhi(w.w);
}
__device__ __forceinline__ u32x4 pack8(const float (&v)[8]) {
    u32x4 w; w.x = pk2(v[0], v[1]); w.y = pk2(v[2], v[3]); w.z = pk2(v[4], v[5]); w.w = pk2(v[6], v[7]); return w;
}

namespace pg8 {
#define PG8_LAS __attribute__((address_space(3)))
constexpr int BM = 256, BK = 64, HALF = 128, HTB = HALF * BK * 2, STAGE_BYTES = 8 * HTB, NXCD = 8, WGM = 8;
__host__ __device__ __forceinline__ int lds_byte(int r, int c) { const int st = (r >> 4) * 2 + (c >> 5), rr = r & 15, cc = c & 31, ob = rr * 64 + cc * 2; return st * 1024 + (ob ^ (((ob >> 9) & 1) << 5)); }
__host__ __device__ __forceinline__ void stage_rc(int b, int& R, int& C) { const int st = b / 1024, sb = b % 1024, swz = sb ^ (((sb >> 9) & 1) << 5); R = (st >> 1) * 16 + swz / 64; C = (st & 1) * 32 + (swz % 64) / 2; }
__host__ __device__ __forceinline__ int perm32(int rho) { const int n = rho >> 4, i = rho & 15; return 8 * (i >> 2) + 4 * n + (i & 3); }

struct Unit { int pm, pn; };
struct Gemm { const bf16_t* A; const bf16_t* Bt; };

template <int M_, int N_> struct StaticOrder {
    static constexpr int nM = M_ / BM, nN = N_ / BM, nwg = nM * nN;
    int G, c;
    __host__ __device__ void init(int G_, int c_) { G = G_; c = c_; }
    __host__ __device__ bool next(int i, Unit& u) const {
        const long L = (long)i * G + c; if (L >= nwg) return false;
        int wgid = (int)L; { const int q = nwg / NXCD, r = nwg % NXCD, xcd = wgid % NXCD, off = wgid / NXCD; wgid = (xcd < r ? xcd * (q + 1) : r * (q + 1) + (xcd - r) * q) + off; }
        const int nig = WGM * nN, gid = wgid / nig, fm = gid * WGM, gsz = (nM - fm) < WGM ? (nM - fm) : WGM;
        u.pm = fm + ((wgid % nig) % gsz); u.pn = (wgid % nig) / gsz; return true;
    }
};

template <class F> struct EpiF {
    static constexpr bool PERM = true;
    F f;
    __device__ __forceinline__ void operator()(const f32x4 (&acc)[2][2][4][2], const Unit& u, int wr, int wc, int fr, int fq) const {
        { int l_; asm volatile("v_mbcnt_lo_u32_b32 %0, -1, 0\n\tv_mbcnt_hi_u32_b32 %0, -1, %0" : "=v"(l_)); fr = l_ & 15; fq = l_ >> 4; }
        const int c = wc * 32 + 8 * fq;
        const typename F::Tile tl = f.tile(u.pn, c, u.pm);
#pragma unroll
        for (int ai = 0; ai < 2; ++ai)
#pragma unroll
            for (int mb = 0; mb < 4; mb += F::NB) {
                typename F::Pre pre[F::NB];
#pragma unroll
                for (int m = 0; m < F::NB; ++m) pre[m] = f.pre(u.pm * BM + ai * HALF + wr * 64 + (mb + m) * 16 + fr, u.pn, c);
#pragma unroll
                for (int m = 0; m < F::NB; ++m) {
                    const int row = u.pm * BM + ai * HALF + wr * 64 + (mb + m) * 16 + fr;
                    float v0[8], v1[8];
#pragma unroll
                    for (int j = 0; j < 4; ++j) { v0[j] = acc[ai][0][mb + m][0][j]; v0[4 + j] = acc[ai][0][mb + m][1][j]; v1[j] = acc[ai][1][mb + m][0][j]; v1[4 + j] = acc[ai][1][mb + m][1][j]; }
                    f.apply(row, u.pn, c, v0, v1, pre[m], tl);
                }
            }
    }
};

struct NoFill { __device__ __forceinline__ void operator()(int) const {} };
template <int K, int LDA, int ACS, class Epi, class Sched, class Fill = NoFill>
__device__ __forceinline__ void gemm_phase(PG8_LAS unsigned char* lds, const Gemm g, const Sched& S, const Epi& E, const int tid, const Fill& fill = Fill{}) {
    const int wid = __builtin_amdgcn_readfirstlane(tid >> 6), lane = tid & 63, wr = wid >> 2, wc = wid & 3, fr = lane & 15, fq = lane >> 4;
    constexpr int nt = K / BK;
    unsigned voffA[2], voffB[2];
#pragma unroll
    for (int i = 0; i < 2; ++i) { int R, C; stage_rc(tid * 16 + i * 8192, R, C); const int Rb = Epi::PERM ? ((R & ~31) + perm32(R & 31)) : R;
        voffA[i] = (unsigned)(R * LDA + C) * 2u; voffB[i] = (unsigned)(Rb * K + C) * 2u; }
    constexpr size_t kstep = (size_t)(BK * 2);
    constexpr size_t hstepA = (size_t)HALF * LDA * 2, hstepB = (size_t)HALF * K * 2;
    constexpr size_t tstepA = 2 * hstepA, tstepB = 2 * hstepB;
    constexpr size_t acsb = (size_t)ACS * 2;
    const unsigned ldsw = (unsigned)wid * 1024u;
    const int aoff = lds_byte(wr * 64 + fr, fq * 8), boff = lds_byte(wc * 32 + fr, fq * 8);
#define PG8_SA(b, h) (((b) * 2 + (h)) * HTB)
#define PG8_SB(b, h) ((4 + (b) * 2 + (h)) * HTB)
#define PG8_STAGE(bufoff, gbase, voff) do { _Pragma("unroll") for (int _i = 0; _i < 2; ++_i) \
        __builtin_amdgcn_global_load_lds((const unsigned*)((const char*)(gbase) + (voff)[_i]), (PG8_LAS unsigned*)(lds + (bufoff) + ldsw + _i * 8192), 16, 0, 0); } while (0)
#define PG8_LDA(dst, b, h) do { _Pragma("unroll") for (int m = 0; m < 4; ++m) _Pragma("unroll") for (int k = 0; k < 2; ++k) dst[m][k] = *(const PG8_LAS bf16x8*)(lds + PG8_SA(b, h) + aoff + m * 2048 + k * 1024); } while (0)
#define PG8_LDB(dst, b, h) do { _Pragma("unroll") for (int n = 0; n < 2; ++n) _Pragma("unroll") for (int k = 0; k < 2; ++k) dst[n][k] = *(const PG8_LAS bf16x8*)(lds + PG8_SB(b, h) + boff + n * 2048 + k * 1024); } while (0)
#define PG8_MMA(ai, bj, At, Bt) do { __builtin_amdgcn_s_setprio(1); _Pragma("unroll") for (int m = 0; m < 4; ++m) _Pragma("unroll") for (int n = 0; n < 2; ++n) _Pragma("unroll") for (int k = 0; k < 2; ++k) \
        acc[ai][bj][m][n] = __builtin_amdgcn_mfma_f32_16x16x32_bf16(Bt[n][k], At[m][k], acc[ai][bj][m][n], 0, 0, 0); __builtin_amdgcn_s_setprio(0); } while (0)
#define PG8_WAIT_V(n) asm volatile("s_waitcnt vmcnt(" #n ")" ::: "memory")
#define PG8_WAIT_L(n) asm volatile("s_waitcnt lgkmcnt(" #n ")" ::: "memory")
#define PG8_BAR __builtin_amdgcn_s_barrier()
#define PG8_SCHED __builtin_amdgcn_sched_barrier(0)
    Unit cur, nxt; int ui = 0;
    if (!S.next(0, cur)) return;
    f32x4 acc[2][2][4][2];
#pragma unroll
    for (int a = 0; a < 2; ++a)
#pragma unroll
        for (int b = 0; b < 2; ++b)
#pragma unroll
            for (int m = 0; m < 4; ++m)
#pragma unroll
                for (int n = 0; n < 2; ++n) acc[a][b][m][n] = (f32x4){0.f, 0.f, 0.f, 0.f};
    bf16x8 At[4][2], B0[2][2], B1[2][2];
    const char* cA = (const char*)g.A + (size_t)cur.pm * tstepA + (size_t)cur.pn * acsb; const char* cB = (const char*)g.Bt + (size_t)cur.pn * tstepB;
    PG8_STAGE(PG8_SB(0, 0), cB, voffB); PG8_STAGE(PG8_SB(0, 1), cB + hstepB, voffB); PG8_STAGE(PG8_SA(0, 0), cA, voffA); PG8_STAGE(PG8_SA(0, 1), cA + hstepA, voffA);
    if (wr == 1) PG8_BAR;
    PG8_WAIT_V(2); PG8_BAR;
    PG8_STAGE(PG8_SB(1, 0), cB + kstep, voffB); PG8_STAGE(PG8_SA(1, 0), cA + kstep, voffA); PG8_STAGE(PG8_SB(1, 1), cB + hstepB + kstep, voffB);
    PG8_WAIT_V(6); PG8_BAR;
    for (;;) {
        const bool has_next = S.next(ui + 1, nxt);
        const char* nA = has_next ? (const char*)g.A + (size_t)nxt.pm * tstepA + (size_t)nxt.pn * acsb : cA; const char* nB = has_next ? (const char*)g.Bt + (size_t)nxt.pn * tstepB : cB;
#pragma unroll 1
        for (int t = 0; t < nt; t += 2) {
            const bool last = (t == nt - 2);
            const char* a1 = cA + (size_t)(t + 1) * kstep;
            const char* a2 = last ? nA : cA + (size_t)(t + 2) * kstep; const char* b2 = last ? nB : cB + (size_t)(t + 2) * kstep;
            const char* a3 = a2 + kstep; const char* b3 = b2 + kstep;
            PG8_LDB(B0, 0, 0); PG8_LDB(B1, 0, 1); PG8_SCHED; PG8_LDA(At, 0, 0); PG8_STAGE(PG8_SA(1, 1), a1 + hstepA, voffA);
            PG8_WAIT_V(8); PG8_WAIT_L(0); PG8_BAR; PG8_MMA(0, 0, At, B0); PG8_MMA(0, 1, At, B1); PG8_BAR; PG8_SCHED;
            PG8_LDA(At, 0, 1); PG8_STAGE(PG8_SB(0, 0), b2, voffB); PG8_STAGE(PG8_SB(0, 1), b2 + hstepB, voffB); PG8_STAGE(PG8_SA(0, 0), a2, voffA);
            PG8_WAIT_V(8); PG8_WAIT_L(0); PG8_BAR; PG8_MMA(1, 0, At, B0); PG8_MMA(1, 1, At, B1); PG8_BAR; PG8_SCHED;
            PG8_LDB(B0, 1, 0); PG8_LDB(B1, 1, 1); PG8_SCHED; PG8_LDA(At, 1, 0); PG8_STAGE(PG8_SA(0, 1), a2 + hstepA, voffA);
            PG8_WAIT_V(8); PG8_WAIT_L(0); PG8_BAR; PG8_MMA(0, 0, At, B0); PG8_MMA(0, 1, At, B1); PG8_BAR; PG8_SCHED;
            PG8_LDA(At, 1, 1); PG8_STAGE(PG8_SB(1, 0), b3, voffB); PG8_STAGE(PG8_SB(1, 1), b3 + hstepB, voffB); PG8_STAGE(PG8_SA(1, 0), a3, voffA);
            PG8_WAIT_V(8); PG8_WAIT_L(0); PG8_BAR; PG8_MMA(1, 0, At, B0); PG8_MMA(1, 1, At, B1); PG8_BAR; PG8_SCHED;
        }
        if (wr == 0) PG8_BAR;
        E(acc, cur, wr, wc, fr, fq);
        fill(ui);
        if (!has_next) break;
#pragma unroll
        for (int a = 0; a < 2; ++a)
#pragma unroll
            for (int b = 0; b < 2; ++b)
#pragma unroll
                for (int m = 0; m < 4; ++m)
#pragma unroll
                    for (int n = 0; n < 2; ++n) acc[a][b][m][n] = (f32x4){0.f, 0.f, 0.f, 0.f};
        cur = nxt; cA = nA; cB = nB; ++ui;
        if (wr == 1) PG8_BAR;
    }
    PG8_WAIT_V(0);
    PG8_BAR;
#undef PG8_SA
#undef PG8_SB
#undef PG8_STAGE
#undef PG8_LDA
#undef PG8_LDB
#undef PG8_MMA
#undef PG8_WAIT_V
#undef PG8_WAIT_L
#undef PG8_BAR
#undef PG8_SCHED
}
}

#define XB_TMO      128
#define XB_XCNT(j)  (256  + 64 * (j))
#define XB_XSUB(j)  (1280 + 64 * (j))
#define XB_XGEN(j)  (2304 + 64 * (j))
#define XB_TOP      3328
#define XB_TOPGEN   3392
#define XCD_BAR_WORDS 3456
#define XB_SPIN_CAP (1u << 18)
__device__ __forceinline__ unsigned xb_ld(unsigned* p)              { return __hip_atomic_load(p, __ATOMIC_RELAXED, __HIP_MEMORY_SCOPE_AGENT); }
__device__ __forceinline__ unsigned xb_add(unsigned* p, unsigned v) { return __hip_atomic_fetch_add(p, v, __ATOMIC_RELAXED, __HIP_MEMORY_SCOPE_AGENT); }
__device__ __forceinline__ unsigned xb_xcc_id() { return (unsigned)__builtin_amdgcn_s_getreg((3 << 11) | 20) & 0xFu; }
#define XB_SPIN(cond, bar) do { unsigned _sp = 0; while (cond) { __builtin_amdgcn_s_sleep(1); \
    if ((++_sp & 255u) == 0u) { if (xb_ld(&(bar)[XB_TMO])) break; if (_sp > XB_SPIN_CAP) { atomicAdd(&(bar)[XB_TMO], 1u); break; } } } } while (0)
struct XcdBarrier { unsigned* bar; unsigned x; volatile LAS unsigned* st; };
__device__ __forceinline__ XcdBarrier xcd_barrier_post(unsigned* bar, volatile LAS unsigned* st) {
    XcdBarrier b; b.bar = bar; b.x = xb_xcc_id(); b.st = st;
    if (threadIdx.x == 0) (void)xb_add(&bar[XB_XCNT(b.x)], 1u);
    return b;
}
__device__ __forceinline__ void xcd_barrier_complete(unsigned* bar, unsigned x, unsigned& nloc, unsigned& nx) {
    const unsigned G = gridDim.x * gridDim.y * gridDim.z;
    unsigned sum, cnt, mine, sp = 0u;
    for (;;) {
        sum = 0u; cnt = 0u; mine = 0u;
#pragma unroll
        for (unsigned j = 0; j < 16; ++j) { const unsigned c = xb_ld(&bar[XB_XCNT(j)]); sum += c; cnt += (c > 0u) ? 1u : 0u; mine = (j == x) ? c : mine; }
        if (sum == G) break;
        __builtin_amdgcn_s_sleep(1);
        if ((++sp & 255u) == 0u) { if (xb_ld(&bar[XB_TMO])) break; if (sp > XB_SPIN_CAP) { atomicAdd(&bar[XB_TMO], 1u); break; } }
    }
    nloc = mine > 0u ? mine : 1u; nx = cnt > 0u ? cnt : 1u;
}
__device__ __forceinline__ void xcd_barrier(const XcdBarrier& b, int wave) {
    asm volatile("s_waitcnt vmcnt(0)" ::: "memory");
    __syncthreads();
    if (wave == 0 && lane_id_v() == 0) {
        unsigned* bar = b.bar;
        __builtin_amdgcn_s_waitcnt(0);
        unsigned nloc = b.st[0], nx = b.st[1];
        if (nloc == 0u) { xcd_barrier_complete(bar, b.x, nloc, nx); b.st[0] = nloc; b.st[1] = nx; }
        const unsigned old = xb_add(&bar[XB_XSUB(b.x)], 1u);
        const unsigned gen = old / nloc;
        if (old + 1u == (gen + 1u) * nloc) {
            __builtin_amdgcn_fence(__ATOMIC_RELEASE, "agent");
            asm volatile("s_waitcnt vmcnt(0)" ::: "memory");
            const unsigned og = xb_add(&bar[XB_TOP], 1u);
            const unsigned tg = og / nx;
            if (og + 1u == (tg + 1u) * nx) xb_add(&bar[XB_TOPGEN], 1u);
            else XB_SPIN(xb_ld(&bar[XB_TOPGEN]) == tg, bar);
            __builtin_amdgcn_fence(__ATOMIC_ACQUIRE, "agent");
            xb_add(&bar[XB_XGEN(b.x)], 1u);
            asm volatile("s_waitcnt vmcnt(0)" ::: "memory");
        } else {
            XB_SPIN(xb_ld(&bar[XB_XGEN(b.x)]) == gen, bar);
            __builtin_amdgcn_fence(__ATOMIC_ACQUIRE, "agent");
            asm volatile("s_waitcnt vmcnt(0)" ::: "memory");
        }
    }
    __syncthreads();
}

struct Args { const float* in[28]; float* out; unsigned char* ws; int ph_lo, ph_hi; };
enum { I_X = 0, I_C, I_POS, I_WADA, I_BADA, I_N1G, I_WIN, I_QAG, I_WUQ, I_KVAG, I_WUKV, I_QNG, I_KNG, I_WOA, I_CONVW, I_CONVB, I_WRG, I_BRG, I_WIG, I_BIG, I_LAM, I_WOL, I_WOUT, I_N2G, I_WQ, I_SUBK, I_EU, I_EV };
constexpr int N_PHASES = 17;

struct Ctx {
    LAS unsigned char* lds;
    int tid, lane, wave, vcu, G;
    const float* const* in; float* out; unsigned char* ws;
};
#define WSP(type, off) ((type*)(c.ws + (off)))

template <class F>
__device__ __forceinline__ void tr_tile(const Ctx& c, bf16_t* dst, int K, int n0, int k0, F f) {
    LAS float* scr = (LAS float*)c.lds;
#pragma unroll
    for (int i = 0; i < 8; ++i) { const int kk = i * 8 + (c.tid >> 6), nn = c.tid & 63; scr[kk * 65 + nn] = f(k0 + kk, n0 + nn); }
    __syncthreads();
    { const int kc = c.tid & 7, nn = c.tid >> 3;
      LAS const float* s = scr + (8 * kc) * 65 + nn;
      u32x4 o; o.x = pk2(s[0], s[65]); o.y = pk2(s[2 * 65], s[3 * 65]); o.z = pk2(s[4 * 65], s[5 * 65]); o.w = pk2(s[6 * 65], s[7 * 65]);
      *(u32x4*)(dst + (size_t)(n0 + nn) * K + k0 + 8 * kc) = o; }
    __syncthreads();
}

template <class F>
__device__ __forceinline__ void tr_tile_wave(LAS float* scr, int L, bf16_t* dst, int K, int n0, int k0, F f) {
#pragma unroll 16
    for (int kk = 0; kk < 64; ++kk) scr[kk * 65 + L] = f(k0 + kk, n0 + L);
    asm volatile("s_waitcnt lgkmcnt(0)" ::: "memory");
    const int kc = L & 7;
#pragma unroll
    for (int j = 0; j < 8; ++j) { const int nn = (L >> 3) + 8 * j; LAS const float* s = scr + (8 * kc) * 65 + nn;
        u32x4 o; o.x = pk2(s[0], s[65]); o.y = pk2(s[2 * 65], s[3 * 65]); o.z = pk2(s[4 * 65], s[5 * 65]); o.w = pk2(s[6 * 65], s[7 * 65]);
        *(u32x4*)(dst + (size_t)(n0 + nn) * K + k0 + 8 * kc) = o; }
    asm volatile("s_waitcnt lgkmcnt(0)" ::: "memory");
}
__device__ __forceinline__ void prep_tables(const Ctx& c) {
    const int gw = c.vcu * 8 + c.wave, NGW = c.G * 8, L = lane_id_v();
    constexpr int NBR = 8;
#pragma unroll 1
    for (int r0 = gw; r0 < 2 * NE; r0 += NBR * NGW) {
        f32x4 v[NBR][4];
#pragma unroll
        for (int u = 0; u < NBR; ++u) { const int r_ = (r0 + u * NGW < 2 * NE) ? r0 + u * NGW : r0;
            const f32x4* s4 = (const f32x4*)((r_ >= NE ? c.in[I_EV] : c.in[I_EU]) + (size_t)(r_ >= NE ? r_ - NE : r_) * 1024) + L;
#pragma unroll
            for (int j = 0; j < 4; ++j) v[u][j] = s4[64 * j]; }
#pragma unroll
        for (int u = 0; u < NBR; ++u) { const int r = r0 + u * NGW; if (r < 2 * NE) {
            const int isv = r >= NE, e = isv ? r - NE : r;
            float am = 0.f;
#pragma unroll
            for (int j = 0; j < 4; ++j) am = fmaxf(am, fmaxf(fmaxf(fabsf(v[u][j].x), fabsf(v[u][j].y)), fmaxf(fabsf(v[u][j].z), fabsf(v[u][j].w))));
#pragma unroll
            for (int o = 1; o < 64; o <<= 1) am = fmaxf(am, __shfl_xor(am, o));
            const float s = am > 0.f ? am * (1.f / 6.f) : 1.f, inv = 1.f / s;
            unsigned char* dst = c.ws + (isv ? WS_EV : WS_EU) + (size_t)e * 128 + 2 * L;
#pragma unroll
            for (int j = 0; j < 4; ++j) { unsigned w = 0u;
                w = __builtin_amdgcn_cvt_scalef32_pk_fp4_f32(w, v[u][j].x * inv, v[u][j].y * inv, 1.0f, 0); w = __builtin_amdgcn_cvt_scalef32_pk_fp4_f32(w, v[u][j].z * inv, v[u][j].w * inv, 1.0f, 1);
                *(unsigned short*)(dst + (size_t)j * NE * 128) = (unsigned short)(w & 0xffffu); }
            if (L == 0) WSP(float, isv ? WS_SV : WS_SU)[e] = s; } }
    }
}

template <int PARTS> __device__ __forceinline__ void phase_prep(const Ctx& c0) {
    Ctx c = c0; c.lane = lane_id_v(); c.tid = c.wave * 64 + c.lane;
    const float* w_in = c.in[I_WIN]; const float* w_uq = c.in[I_WUQ]; const float* qag = c.in[I_QAG]; const float* w_ukv = c.in[I_WUKV]; const float* kvag = c.in[I_KVAG];
    const float* w_oa = c.in[I_WOA]; const float* w_ol = c.in[I_WOL]; const float* w_out = c.in[I_WOUT]; const float* w_q = c.in[I_WQ];
    const float* w_rg = c.in[I_WRG]; const float* w_ig = c.in[I_WIG];
    constexpr int T_WIN = 72 * 16, T_WUQ = 12 * 4, T_WUKV = 16 * 2, T_WOA = 16 * 8, T_WOL = 16 * 16, T_WOUT = 16 * 16, T_WQ = 32 * 16, T_WG = 8 * 4 * 2;
    constexpr int T_WAVE = T_WIN + T_WUQ + T_WUKV + T_WOA + T_WOL + T_WOUT + T_WG;
    if (PARTS & 1) { LAS float* scr = (LAS float*)(c.lds + (c.wave < 7 ? c.wave * 16640 : 131584)); const int L = c.lane;
      static_assert(7 * 16640 <= 131072 && 131584 + 16640 <= LDS_BYTES && 131584 >= MISC_OFF + 128, "prep LDS tiles");
      for (int it = c.vcu * 8 + c.wave; it < T_WAVE; it += c.G * 8) {
        int r = it;
        if (r < T_WIN) { const int nb = r / 16, kb = r % 16;
            tr_tile_wave(scr, L, WSP(bf16_t, WS_WIN), 1024, nb * 64, kb * 64, [=](int k, int n) -> float { return n < 416 ? w_in[(size_t)k * 4512 + n] : (n < 512 ? 0.f : w_in[(size_t)k * 4512 + n - 96]); }); continue; }
        r -= T_WIN;
        if (r < T_WUQ) { const int nb = r / 4, kb = r % 4;
            tr_tile_wave(scr, L, WSP(bf16_t, WS_WUQ), 256, nb * 64, kb * 64, [=](int k, int n) -> float { return w_uq[(size_t)k * 768 + n] * qag[k]; }); continue; }
        r -= T_WUQ;
        if (r < T_WUKV) { const int nb = r / 2, kb = r % 2;
            tr_tile_wave(scr, L, WSP(bf16_t, WS_WUKV), 128, nb * 64, kb * 64, [=](int k, int n) -> float { return w_ukv[(size_t)k * 1024 + n] * kvag[k]; }); continue; }
        r -= T_WUKV;
        if (r < T_WOA) { const int nb = r / 8, kb = r % 8;
            tr_tile_wave(scr, L, WSP(bf16_t, WS_WOA), 512, nb * 64, kb * 64, [=](int k, int n) -> float { return w_oa[(size_t)k * 1024 + n]; }); continue; }
        r -= T_WOA;
        if (r < T_WOL) { const int nb = r / 16, kb = r % 16;
            tr_tile_wave(scr, L, WSP(bf16_t, WS_WOL), 1024, nb * 64, kb * 64, [=](int k, int n) -> float { return w_ol[(size_t)k * 1024 + n]; }); continue; }
        r -= T_WOL;
        if (r < T_WOUT) { const int nb = r / 16, kb = r % 16;
            tr_tile_wave(scr, L, WSP(bf16_t, WS_WOUT), 1024, nb * 64, kb * 64, [=](int k, int n) -> float { return w_out[(size_t)k * 1024 + n]; }); continue; }
        r -= T_WOUT;
        { const int blk = r / 8, q = r % 8, nb = q / 2, kb = q % 2;
            tr_tile_wave(scr, L, WSP(bf16_t, WS_WG) + (size_t)blk * 256 * 128, 128, nb * 64, kb * 64,
                    [=](int k, int n) -> float { return n < 128 ? w_rg[((size_t)blk * 128 + k) * 128 + n] : w_ig[((size_t)blk * 128 + k) * 128 + n - 128]; }); }
      } }
    __syncthreads();
    if (PARTS & 2) { const int L = c.lane, i = L & 15, kg = L >> 4;
      for (int it = c.vcu * 8 + c.wave; it < 128 * 16; it += c.G * 8) {
        const int nb = it >> 4, slot = nb >> 3, n0 = nb * 16, k0 = (it & 15) * 64;
        const float* sk = c.in[I_SUBK] + (size_t)(n0 + i) * 128 + 8 * kg;
        const float* wq = w_q + (size_t)(k0 + i) * 2048 + slot * 128 + 8 * kg;
        f32x4 acc[4];
#pragma unroll
        for (int kb = 0; kb < 4; ++kb) acc[kb] = (f32x4){0.f, 0.f, 0.f, 0.f};
#pragma unroll 2
        for (int ds = 0; ds < 4; ++ds) {
            f32x4 bl[2], al[4][2];
            bl[0] = *(const f32x4*)(sk + 32 * ds); bl[1] = *(const f32x4*)(sk + 32 * ds + 4);
#pragma unroll
            for (int kb = 0; kb < 4; ++kb) { al[kb][0] = *(const f32x4*)(wq + (size_t)(16 * kb) * 2048 + 32 * ds); al[kb][1] = *(const f32x4*)(wq + (size_t)(16 * kb) * 2048 + 32 * ds + 4); }
            u32x4 bw; bw.x = pk2(bl[0].x, bl[0].y); bw.y = pk2(bl[0].z, bl[0].w); bw.z = pk2(bl[1].x, bl[1].y); bw.w = pk2(bl[1].z, bl[1].w);
            const bf16x8 bf = __builtin_bit_cast(bf16x8, bw);
#pragma unroll
            for (int kb = 0; kb < 4; ++kb) { u32x4 aw; aw.x = pk2(al[kb][0].x, al[kb][0].y); aw.y = pk2(al[kb][0].z, al[kb][0].w); aw.z = pk2(al[kb][1].x, al[kb][1].y); aw.w = pk2(al[kb][1].z, al[kb][1].w);
                acc[kb] = __builtin_amdgcn_mfma_f32_16x16x32_bf16(__builtin_bit_cast(bf16x8, aw), bf, acc[kb], 0, 0, 0); }
        }
        bf16_t* dst = WSP(bf16_t, WS_WQ) + (size_t)(n0 + i) * 1024 + k0 + 4 * kg;
#pragma unroll
        for (int kb = 0; kb < 4; ++kb) { u32x2 w; w.x = pk2(acc[kb][0], acc[kb][1]); w.y = pk2(acc[kb][2], acc[kb][3]); *(u32x2*)(dst + 16 * kb) = w; }
      } }
    { const float* lam = c.in[I_LAM]; float* t8 = WSP(float, WS_C8SP);
      if (c.vcu == 0) for (int e = c.tid; e < 1024; e += 512) t8[e] = -8.f * log1pf(__expf(-lam[e])); }
    if (c.vcu == 0 && c.tid == 0) {
        const unsigned probe = __builtin_amdgcn_cvt_scalef32_pk_fp4_f32(0u, 1.0f, 0.0f, 1.0f, 0) & 0xffu;
        WSP(unsigned, WS_C8SP)[1024] = (probe == 0x02u) ? 0u : 1u; }
    if (PARTS & 4) prep_tables(c);
    if (PARTS & 8) { const float* cin = c.in[I_C]; const float* w_ada = c.in[I_WADA]; const float* b_ada = c.in[I_BADA]; float* mod = WSP(float, WS_MOD);
      LAS float* cs = (LAS float*)c.lds;
      LAS float* red = (LAS float*)(c.lds + 65536);
      bool have = false;
      for (int it = c.vcu; it < 192; it += c.G) {
          if (!have) { for (int e = c.tid; e < 16 * 1024; e += 512) { const float v = cin[e]; cs[e] = v / (1.f + __expf(-v)); } have = true; }
          __syncthreads();
          const int cl = c.tid & 31, ks = c.tid >> 5, j = it * 32 + cl;
          float acc[16];
#pragma unroll
          for (int b = 0; b < 16; ++b) acc[b] = 0.f;
#pragma unroll 1
          for (int k0 = 0; k0 < 64; k0 += 16) { float w[16];
#pragma unroll
              for (int kk = 0; kk < 16; ++kk) w[kk] = w_ada[(size_t)(ks * 64 + k0 + kk) * 6144 + j];
#pragma unroll
              for (int kk = 0; kk < 16; ++kk) { const int k = ks * 64 + k0 + kk;
#pragma unroll
                  for (int b = 0; b < 16; ++b) acc[b] += cs[b * 1024 + k] * w[kk]; } }
#pragma unroll
          for (int b = 0; b < 16; ++b) red[(ks * 16 + b) * 32 + cl] = acc[b];
          __syncthreads();
          { const int b = c.tid >> 5; float s = b_ada[j];
#pragma unroll
            for (int k2 = 0; k2 < 16; ++k2) s += red[(k2 * 16 + b) * 32 + cl];
            mod[b * 6144 + j] = s; }
          __syncthreads();
      } }
}

__device__ __forceinline__ f32x4 raw4(const f32x4 v) { return v; }
__device__ __forceinline__ f32x4 raw4(const u32x2 v) { return (f32x4){bflo(v.x), bfhi(v.x), bflo(v.y), bfhi(v.y)}; }
template <bool Q8>
__device__ __forceinline__ void phase_modnorm(const Ctx& c0, const void* xsrc, const float* g, int shift_off, int scale_off, bf16_t* dst) {
    Ctx c = c0; c.lane = lane_id_v(); c.tid = c.wave * 64 + c.lane;
    const float* mod = WSP(float, WS_MOD);
    const int gw = c.vcu * 8 + c.wave, NGW = c.G * 8;
    if (gw >= T) return;
    typedef typename std::conditional<Q8, u32x2, f32x4>::type Raw;
    const Raw* x = (const Raw*)xsrc;
    Raw vn[4];
    { const Raw* xr = x + (size_t)gw * (D / 4) + c.lane;
#pragma unroll
      for (int j = 0; j < 4; ++j) vn[j] = xr[64 * j]; }
#pragma unroll 1
    for (int m = gw; m < T; m += NGW) {
        const int b = m >> 11;
        f32x4 v[4]; float s = 0.f;
#pragma unroll
        for (int j = 0; j < 4; ++j) { v[j] = raw4(vn[j]); s += (v[j].x * v[j].x + v[j].y * v[j].y) + (v[j].z * v[j].z + v[j].w * v[j].w); }
        { const int mn = (m + NGW < T) ? m + NGW : m; const Raw* xr = x + (size_t)mn * (D / 4) + c.lane;
#pragma unroll
          for (int j = 0; j < 4; ++j) vn[j] = xr[64 * j]; }
        const float rstd = rsqrtf(wave_sum(s) * (1.f / D) + EPS);
        u32x2* o8 = (u32x2*)(dst + (size_t)m * D) + c.lane;
        float am = 0.f;
#pragma unroll
        for (int j = 0; j < 4; ++j) {
            const int col = 4 * c.lane + 256 * j;
            const f32x4 gg = *(const f32x4*)(g + col), sc = *(const f32x4*)(mod + b * 6144 + scale_off + col), sh = *(const f32x4*)(mod + b * 6144 + shift_off + col);
            const float r0 = v[j].x * rstd * gg.x * (1.f + sc.x) + sh.x, r1 = v[j].y * rstd * gg.y * (1.f + sc.y) + sh.y;
            const float r2 = v[j].z * rstd * gg.z * (1.f + sc.z) + sh.z, r3 = v[j].w * rstd * gg.w * (1.f + sc.w) + sh.w;
            u32x2 w; w.x = pk2(r0, r1); w.y = pk2(r2, r3); o8[64 * j] = w;
            if (Q8) { v[j].x = r0; v[j].y = r1; v[j].z = r2; v[j].w = r3; am = fmaxf(am, fmaxf(fmaxf(fabsf(r0), fabsf(r1)), fmaxf(fabsf(r2), fabsf(r3)))); }
        }
        if (Q8) {
#pragma unroll
            for (int o = 1; o < 64; o <<= 1) am = fmaxf(am, __shfl_xor(am, o));
            const float sq = am > 0.f ? am * (1.f / 256.f) : 1.f, inv = 1.f / sq;
            unsigned* q8 = (unsigned*)(c.ws + WS_H2Q + (size_t)m * D) + c.lane;
#pragma unroll
            for (int j = 0; j < 4; ++j) { int w = __builtin_amdgcn_cvt_pk_fp8_f32(v[j].x * inv, v[j].y * inv, 0, false); w = __builtin_amdgcn_cvt_pk_fp8_f32(v[j].z * inv, v[j].w * inv, w, true); q8[64 * j] = (unsigned)w; }
            if (c.lane == 0) WSP(float, WS_SH)[m] = sq;
        }
    }
}

__device__ __forceinline__ void phase_conv(const Ctx& c0) {
    Ctx c = c0; c.lane = lane_id_v(); c.tid = c.wave * 64 + c.lane;
    const bf16_t* pa = WSP(bf16_t, WS_R1); const bf16_t* lx = WSP(bf16_t, WS_R2); bf16_t* xc = WSP(bf16_t, WS_R4); float* rstd = WSP(float, WS_RSTD);
    const float* cw = c.in[I_CONVW]; const float* cb = c.in[I_CONVB];
    const int gt = c.vcu * 512 + c.tid, NT = c.G * 512;
    { const int gw = c.vcu * 8 + c.wave, NGW = c.G * 8, L = c.lane;
      for (int t = gw; t < T; t += NGW) {
          float ss = 0.f;
          if (L < 48) { float v[8]; unpack8(*(const u32x4*)(pa + (size_t)t * 512 + 8 * L), v);
#pragma unroll
              for (int j = 0; j < 8; ++j) ss += v[j] * v[j]; }
          const float sq = wave_sum(L < 32 ? ss : 0.f), skv = wave_sum(L >= 32 ? ss : 0.f);
          if (L == 0) { rstd[2 * t] = rsqrtf(sq * (1.f / 256.f) + EPS); rstd[2 * t + 1] = rsqrtf(skv * (1.f / 128.f) + EPS); }
      } }
    { const int* pos = (const int*)c.in[I_POS]; float* CS = WSP(float, WS_CS);
      for (int e = gt; e < T * 16; e += NT) {
          const int t = e >> 4, jj = e & 15;
          const float invf = exp2f(-(float)jj * (13.287712379549449f / 16.f));
          const float ang = (float)pos[t] * invf; const float n = rintf(ang * 0.15915494309189535f);
          const float red = (float)((double)ang - (double)n * 6.283185307179586);
          CS[(size_t)t * 32 + jj] = __cosf(red); CS[(size_t)t * 32 + 16 + jj] = __sinf(red);
      } }
    {
        const int ch = (gt & 127) * 8;
        f32x4 wv[4][2]; f32x4 bv[2];
#pragma unroll
        for (int j = 0; j < 4; ++j) { wv[j][0] = *(const f32x4*)(cw + j * 1024 + ch); wv[j][1] = *(const f32x4*)(cw + j * 1024 + ch + 4); }
        bv[0] = *(const f32x4*)(cb + ch); bv[1] = *(const f32x4*)(cb + ch + 4);
        const int tstep = NT >> 7;
        for (int tq = gt >> 7; tq < T; tq += 4 * tstep) {
            u32x4 raw[4][4];
#pragma unroll
            for (int u = 0; u < 4; ++u) { const int t = tq + u * tstep; const int s = t & 2047;
#pragma unroll
                for (int j = 0; j < 4; ++j) { raw[u][j] = (u32x4){0u, 0u, 0u, 0u}; if (t < T && s - 3 + j >= 0) raw[u][j] = *(const u32x4*)(lx + (size_t)(t - 3 + j) * 1024 + ch); } }
#pragma unroll
            for (int u = 0; u < 4; ++u) { const int t = tq + u * tstep;
                float acc[8] = {bv[0].x, bv[0].y, bv[0].z, bv[0].w, bv[1].x, bv[1].y, bv[1].z, bv[1].w};
#pragma unroll
                for (int j = 0; j < 4; ++j) { float v[8]; unpack8(raw[u][j], v);
                    acc[0] += wv[j][0].x * v[0]; acc[1] += wv[j][0].y * v[1]; acc[2] += wv[j][0].z * v[2]; acc[3] += wv[j][0].w * v[3];
                    acc[4] += wv[j][1].x * v[4]; acc[5] += wv[j][1].y * v[5]; acc[6] += wv[j][1].z * v[6]; acc[7] += wv[j][1].w * v[7]; }
                if (t < T) *(u32x4*)(xc + (size_t)t * 1024 + ch) = pack8(acc); }
        }
    }
}

__device__ __forceinline__ void phase_scan(const Ctx& c0) {
    Ctx c = c0; c.lane = lane_id_v(); c.tid = c.wave * 64 + c.lane;
    const bf16_t* LA = WSP(bf16_t, WS_R0); bf16_t* Bv = WSP(bf16_t, WS_R6); const bf16_t* gate = WSP(bf16_t, WS_R3);
    LAS float* Ps = (LAS float*)c.lds; LAS float* Hs = Ps + 512;
    for (int it = c.vcu; it < 256; it += c.G) {
        const int b = it >> 4, cg = it & 15, seg = c.tid >> 6, ch = cg * 64 + (c.tid & 63);
        const size_t base = ((size_t)b * 2048 + seg * 256) * 1024 + ch;
        float P = 1.f, Hl = 0.f;
#pragma unroll 1
        for (int i0 = 0; i0 < 256; i0 += 16) {
            unsigned la[16], bv[16];
#pragma unroll
            for (int i = 0; i < 16; ++i) { la[i] = LA[base + (size_t)(i0 + i) * 1024]; bv[i] = Bv[base + (size_t)(i0 + i) * 1024]; }
#pragma unroll
            for (int i = 0; i < 16; ++i) { const float a = __builtin_amdgcn_exp2f(bf2f(la[i])); Hl = a * Hl + bf2f(bv[i]); P *= a; }
        }
        Ps[c.tid] = P; Hs[c.tid] = Hl;
        __syncthreads();
        float h = 0.f;
        for (int s2 = 0; s2 < seg; ++s2) h = Ps[s2 * 64 + (c.tid & 63)] * h + Hs[s2 * 64 + (c.tid & 63)];
#pragma unroll 1
        for (int i0 = 0; i0 < 256; i0 += 16) {
            unsigned la[16], bv[16], gv[16]; unsigned ov[16];
#pragma unroll
            for (int i = 0; i < 16; ++i) { la[i] = LA[base + (size_t)(i0 + i) * 1024]; bv[i] = Bv[base + (size_t)(i0 + i) * 1024]; gv[i] = gate[base + (size_t)(i0 + i) * 1024]; }
#pragma unroll
            for (int i = 0; i < 16; ++i) { const float a = __builtin_amdgcn_exp2f(bf2f(la[i])); h = a * h + bf2f(bv[i]); ov[i] = f2bf(h * gelu_tanh(bf2f(gv[i]))); }
#pragma unroll
            for (int i = 0; i < 16; ++i) Bv[base + (size_t)(i0 + i) * 1024] = (bf16_t)ov[i];
        }
        __syncthreads();
    }
}

struct QkvRaw { u32x4 k[2]; f32x4 cs[4]; };
__device__ __forceinline__ void qkv_load(QkvRaw& r, const bf16_t* kvraw, const bf16_t* pa, const float* CS, int t, int ch, int hq) {
    const bool act = ch < 12;
#pragma unroll
    for (int pass = 0; pass < 2; ++pass) { const int h = pass * 4 + hq;
        r.k[pass] = (u32x4){0u, 0u, 0u, 0u};
        if (ch < 8) r.k[pass] = *(const u32x4*)(kvraw + (size_t)t * 1024 + h * 128 + 8 * ch);
        else if (act) r.k[pass] = *(const u32x4*)(pa + (size_t)t * 512 + 384 + 8 * (ch - 8)); }
    const float* cp = CS + (size_t)t * 32 + 8 * (ch & 1);
    r.cs[0] = *(const f32x4*)cp; r.cs[1] = *(const f32x4*)(cp + 4); r.cs[2] = *(const f32x4*)(cp + 16); r.cs[3] = *(const f32x4*)(cp + 20);
}
__device__ __forceinline__ void phase_qkv_layout(const Ctx& c0) {
    Ctx c = c0; c.lane = lane_id_v(); c.tid = c.wave * 64 + c.lane;
    const bf16_t* kvraw = WSP(bf16_t, WS_R2); const bf16_t* pa = WSP(bf16_t, WS_R1);
    bf16_t* Kh = WSP(bf16_t, WS_R3);
    const float* kng = c.in[I_KNG]; const float* CS = WSP(float, WS_CS);
    const int gw = c.vcu * 8 + c.wave, NGW = c.G * 8, L = c.lane;
    const int ch = L & 15, hq = L >> 4;
    const bool act = ch < 12, isr = ch >= 8, hi2 = ch >= 10;
    float gk[8];
#pragma unroll
    for (int j = 0; j < 8; ++j) gk[j] = act ? kng[8 * ch + j] : 0.f;
    if (gw >= T) return;
    QkvRaw cur, nxt;
    qkv_load(cur, kvraw, pa, CS, gw, ch, hq);
#pragma unroll 1
    for (int t = gw; t < T; t += NGW) {
        qkv_load(nxt, kvraw, pa, CS, (t + NGW < T) ? t + NGW : t, ch, hq);
        const int b = t >> 11, s = t & 2047;
        const float cs[8] = {cur.cs[0].x, cur.cs[0].y, cur.cs[0].z, cur.cs[0].w, cur.cs[1].x, cur.cs[1].y, cur.cs[1].z, cur.cs[1].w};
        const float sn[8] = {cur.cs[2].x, cur.cs[2].y, cur.cs[2].z, cur.cs[2].w, cur.cs[3].x, cur.cs[3].y, cur.cs[3].z, cur.cs[3].w};
#pragma unroll
        for (int pass = 0; pass < 2; ++pass) {
            const int h = pass * 4 + hq;
            const size_t orow = ((size_t)(b * H + h) * S + s);
            float v[8]; unpack8(cur.k[pass], v);
            float ss = 0.f;
#pragma unroll
            for (int j = 0; j < 8; ++j) ss += v[j] * v[j];
#pragma unroll
            for (int o = 1; o < 16; o <<= 1) ss += __shfl_xor(ss, o);
            const float r = rsqrtf(ss * (1.f / 96.f) + EPS);
            float x[8], o8[8];
#pragma unroll
            for (int j = 0; j < 8; ++j) x[j] = v[j] * r * gk[j];
#pragma unroll
            for (int j = 0; j < 8; ++j) { const float px = __shfl_xor(x[j], 2);
                o8[j] = !isr ? x[j] : (hi2 ? px * sn[j] + x[j] * cs[j] : x[j] * cs[j] - px * sn[j]); }
            if (act) *(u32x4*)(Kh + orow * 96 + 8 * ch) = pack8(o8);
        }
        cur = nxt;
    }
}

constexpr int KROW = 208, VROW = 160;
constexpr int KBUF = 128 * KROW, VBUF = 128 * VROW;
typedef short v4i16_t __attribute__((ext_vector_type(4)));
__device__ __forceinline__ void attn_chunk2(LAS unsigned char* kb, LAS unsigned char* vb, const bf16x8 (&qf)[2][3], f32x4 (&o)[2][4], float (&mrun)[2], float (&lrun)[2], int fr, int g) {
    f32x4 sacc[2][4];
#pragma unroll
    for (int kt = 0; kt < 4; ++kt) { sacc[0][kt] = (f32x4){0.f, 0.f, 0.f, 0.f}; sacc[1][kt] = (f32x4){0.f, 0.f, 0.f, 0.f};
#pragma unroll
        for (int ks = 0; ks < 3; ++ks) { const bf16x8 kf = *(const LAS bf16x8*)(kb + (16 * kt + fr) * KROW + (ks * 32 + g * 8) * 2);
            sacc[0][kt] = __builtin_amdgcn_mfma_f32_16x16x32_bf16(kf, qf[0][ks], sacc[0][kt], 0, 0, 0);
            sacc[1][kt] = __builtin_amdgcn_mfma_f32_16x16x32_bf16(kf, qf[1][ks], sacc[1][kt], 0, 0, 0); } }
    bf16x8 pb[2][2];
#pragma unroll
    for (int t = 0; t < 2; ++t) {
        float mx = sacc[t][0][0];
#pragma unroll
        for (int kt = 0; kt < 4; ++kt)
#pragma unroll
            for (int r = 0; r < 4; ++r) mx = fmaxf(mx, sacc[t][kt][r]);
        mx = fmaxf(mx, __shfl_xor(mx, 16)); mx = fmaxf(mx, __shfl_xor(mx, 32));
        const float mnew = fmaxf(mrun[t], mx), alpha = __builtin_amdgcn_exp2f(mrun[t] - mnew); mrun[t] = mnew;
        float ps = 0.f;
#pragma unroll
        for (int kt = 0; kt < 4; ++kt)
#pragma unroll
            for (int r = 0; r < 4; ++r) { const float p = __builtin_amdgcn_exp2f(sacc[t][kt][r] - mnew); sacc[t][kt][r] = p; ps += p; }
        lrun[t] = lrun[t] * alpha + ps;
#pragma unroll
        for (int dt = 0; dt < 4; ++dt) o[t][dt] = o[t][dt] * alpha;
#pragma unroll
        for (int s2 = 0; s2 < 2; ++s2) { u32x4 pw; pw.x = pk2(sacc[t][2 * s2][0], sacc[t][2 * s2][1]); pw.y = pk2(sacc[t][2 * s2][2], sacc[t][2 * s2][3]); pw.z = pk2(sacc[t][2 * s2 + 1][0], sacc[t][2 * s2 + 1][1]); pw.w = pk2(sacc[t][2 * s2 + 1][2], sacc[t][2 * s2 + 1][3]);
            pb[t][s2] = __builtin_bit_cast(bf16x8, pw); }
    }
#pragma unroll
    for (int s2 = 0; s2 < 2; ++s2)
#pragma unroll
        for (int dt = 0; dt < 4; ++dt) {
            LAS unsigned char* va = vb + (32 * s2 + 4 * g + (fr >> 2)) * VROW + (16 * dt + 4 * (fr & 3)) * 2;
            const v4i16_t t0 = __builtin_amdgcn_ds_read_tr16_b64_v4i16((LAS v4i16_t*)va), t1 = __builtin_amdgcn_ds_read_tr16_b64_v4i16((LAS v4i16_t*)(va + 16 * VROW));
            const bf16x8 vf = (bf16x8){t0[0], t0[1], t0[2], t0[3], t1[0], t1[1], t1[2], t1[3]};
            o[0][dt] = __builtin_amdgcn_mfma_f32_16x16x32_bf16(vf, pb[0][s2], o[0][dt], 0, 0, 0);
            o[1][dt] = __builtin_amdgcn_mfma_f32_16x16x32_bf16(vf, pb[1][s2], o[1][dt], 0, 0, 0); }
}
__device__ __forceinline__ void attn_unit(const Ctx& c, int b, int h, int qb) {
    const bf16_t* qraw = WSP(bf16_t, WS_R5); const bf16_t* Kh = WSP(bf16_t, WS_R3); const bf16_t* kvraw = WSP(bf16_t, WS_R2); bf16_t* AO = WSP(bf16_t, WS_R0 + 32 * MiB);
    const float* qng = c.in[I_QNG]; const float* CS = WSP(float, WS_CS);
    const int fr = c.lane & 15, g = c.lane >> 4, wid = c.wave;
    const size_t hb = (size_t)(b * H + h) * S;
    const int q0 = qb * 256 + wid * 32;
    const int nsup = 2 * qb + 2;
    const int nch = 4 * qb + (wid >> 1) + 1;
    bf16x8 qf[2][3];
    { const float qscale = 0.10206207261596577f * 1.4426950408889634f;
#pragma unroll
      for (int t = 0; t < 2; ++t) {
          const size_t tok = (size_t)b * S + q0 + 16 * t + fr;
          float v[3][8]; float ss = 0.f;
#pragma unroll
          for (int ks = 0; ks < 3; ++ks) { unpack8(*(const u32x4*)(qraw + tok * 768 + h * 96 + ks * 32 + g * 8), v[ks]);
#pragma unroll
              for (int j = 0; j < 8; ++j) ss += v[ks][j] * v[ks][j]; }
          ss += __shfl_xor(ss, 16); ss += __shfl_xor(ss, 32);
          const float r = rsqrtf(ss * (1.f / 96.f) + EPS) * qscale;
#pragma unroll
          for (int ks = 0; ks < 3; ++ks)
#pragma unroll
              for (int j = 0; j < 8; ++j) v[ks][j] *= r * qng[ks * 32 + g * 8 + j];
          { const float* cp = CS + tok * 32 + 8 * (g & 1);
            const f32x4 c0v = *(const f32x4*)cp, c1v = *(const f32x4*)(cp + 4), s0v = *(const f32x4*)(cp + 16), s1v = *(const f32x4*)(cp + 20);
            const float cs[8] = {c0v.x, c0v.y, c0v.z, c0v.w, c1v.x, c1v.y, c1v.z, c1v.w}, sn[8] = {s0v.x, s0v.y, s0v.z, s0v.w, s1v.x, s1v.y, s1v.z, s1v.w};
#pragma unroll
            for (int j = 0; j < 8; ++j) { const float px = __shfl_xor(v[2][j], 32); v[2][j] = (g >= 2) ? px * sn[j] + v[2][j] * cs[j] : v[2][j] * cs[j] - px * sn[j]; } }
#pragma unroll
          for (int ks = 0; ks < 3; ++ks) qf[t][ks] = __builtin_bit_cast(bf16x8, pack8(v[ks]));
      } }
    f32x4 o[2][4];
#pragma unroll
    for (int t = 0; t < 2; ++t)
#pragma unroll
        for (int dt = 0; dt < 4; ++dt) o[t][dt] = (f32x4){0.f, 0.f, 0.f, 0.f};
    float mrun[2] = {-1e30f, -1e30f}, lrun[2] = {0.f, 0.f};
    u32x4 kr[3], vr[2];
    const u32x4* Ksrc = (const u32x4*)(Kh + hb * 96);
    const bf16_t* Vsrc = kvraw + ((size_t)b * S) * 1024 + h * 128 + 64;
#pragma unroll
    for (int i = 0; i < 3; ++i) kr[i] = Ksrc[c.tid + 512 * i];
#pragma unroll
    for (int i = 0; i < 2; ++i) { const int vc = c.tid + 512 * i; vr[i] = *(const u32x4*)(Vsrc + (size_t)(vc >> 3) * 1024 + (vc & 7) * 8); }
    for (int j = 0; j < nsup; ++j) {
        LAS unsigned char* kb = c.lds + (j & 1) * (KBUF + VBUF); LAS unsigned char* vb = kb + KBUF;
#pragma unroll
        for (int i = 0; i < 3; ++i) { const int kc = c.tid + 512 * i; *(LAS u32x4*)(kb + (kc / 12) * KROW + (kc % 12) * 16) = kr[i]; }
#pragma unroll
        for (int i = 0; i < 2; ++i) { const int vc = c.tid + 512 * i; *(LAS u32x4*)(vb + (vc >> 3) * VROW + (vc & 7) * 16) = vr[i]; }
        __syncthreads();
        if (j + 1 < nsup) {
#pragma unroll
            for (int i = 0; i < 3; ++i) kr[i] = Ksrc[(j + 1) * 1536 + c.tid + 512 * i];
#pragma unroll
            for (int i = 0; i < 2; ++i) { const int vc = c.tid + 512 * i; vr[i] = *(const u32x4*)(Vsrc + (size_t)((j + 1) * 128 + (vc >> 3)) * 1024 + (vc & 7) * 8); }
        }
        if (2 * j < nch) attn_chunk2(kb, vb, qf, o, mrun, lrun, fr, g);
        if (2 * j + 1 < nch) attn_chunk2(kb + 64 * KROW, vb + 64 * VROW, qf, o, mrun, lrun, fr, g);
    }
#pragma unroll
    for (int t = 0; t < 2; ++t) {
        float lt = lrun[t] + __shfl_xor(lrun[t], 16); lt += __shfl_xor(lt, 32);
        const float inv = 1.f / lt;
        bf16_t* orow = AO + ((size_t)b * S + q0 + 16 * t + fr) * 512 + h * 64;
#pragma unroll
        for (int dt = 0; dt < 4; ++dt) { u32x2 w; w.x = pk2(o[t][dt][0] * inv, o[t][dt][1] * inv); w.y = pk2(o[t][dt][2] * inv, o[t][dt][3] * inv); *(u32x2*)(orow + 16 * dt + 4 * g) = w; }
    }
    __syncthreads();
}
__device__ __forceinline__ void phase_attn(const Ctx& c0) {
    Ctx c = c0; c.lane = lane_id_v(); c.tid = c.wave * 64 + c.lane;
    for (int v = c.vcu; v < 256; v += c.G) {
        const int bh = v >> 1, odd = v & 1;
        for (int i = 0; i < 4; ++i) {
            const int setA[4] = {7, 4, 3, 0}, setB[4] = {6, 5, 2, 1};
            int qb = 0;
#pragma unroll
            for (int k = 0; k < 4; ++k) if (k == i) qb = odd ? setB[k] : setA[k];
            attn_unit(c, bh >> 3, bh & 7, qb);
        }
    }
}

__device__ __forceinline__ float wave_max(float v) {
#pragma unroll
    for (int o = 1; o < 64; o <<= 1) v = fmaxf(v, __shfl_xor(v, o));
    return v;
}
__device__ __forceinline__ int wave_min_i(int v) {
#pragma unroll
    for (int o = 1; o < 64; o <<= 1) v = min(v, __shfl_xor(v, o));
    return v;
}
__device__ __forceinline__ int prefix_cnt(unsigned long long m) { return (int)__builtin_amdgcn_mbcnt_hi((unsigned)(m >> 32), __builtin_amdgcn_mbcnt_lo((unsigned)m, 0u)); }
template <int NV, int NBITS> __device__ __forceinline__ void select16(const unsigned (&key)[NV], int (&slot)[NV]) {
    unsigned tau = 0u;
    for (int bit = NBITS - 1; bit >= 0; --bit) {
        const unsigned trial = tau | (1u << bit); int cnt = 0;
#pragma unroll
        for (int j = 0; j < NV; ++j) cnt += __popcll(__ballot(key[j] >= trial));
        if (cnt >= 16) { tau = trial; if (cnt == 16) break; }
    }
    int base = 0;
#pragma unroll
    for (int j = 0; j < NV; ++j) { const unsigned long long m = __ballot(key[j] > tau); slot[j] = (key[j] > tau) ? base + prefix_cnt(m) : -1; base += __popcll(m); }
#pragma unroll
    for (int j = 0; j < NV; ++j) { const unsigned long long m = __ballot(key[j] == tau); if (key[j] == tau) { const int s = base + prefix_cnt(m); slot[j] = s < 16 ? s : -1; } base += __popcll(m); }
}
template <int N> __device__ __forceinline__ void bitonic_stage_desc(unsigned (&x)[N], int k, int j) {
#pragma unroll
    for (int i = 0; i < N; ++i) { const int l = i ^ j; if (l > i) { const bool asc = ((i & k) != 0);
        const unsigned a = x[i], b = x[l]; const unsigned hi = a > b ? a : b, lo = a > b ? b : a; x[i] = asc ? lo : hi; x[l] = asc ? hi : lo; } }
}
__device__ __forceinline__ void sort16_desc(unsigned (&x)[16]) {
#pragma unroll
    for (int k = 2; k <= 16; k <<= 1)
#pragma unroll
        for (int j = k >> 1; j > 0; j >>= 1) bitonic_stage_desc<16>(x, k, j);
}
__device__ __forceinline__ void merge16_desc(unsigned (&run)[16], const unsigned (&ch)[16]) {
#pragma unroll
    for (int i = 0; i < 16; ++i) run[i] = run[i] > ch[15 - i] ? run[i] : ch[15 - i];
#pragma unroll
    for (int j = 8; j > 0; j >>= 1) bitonic_stage_desc<16>(run, 16, j);
}
__device__ __forceinline__ unsigned mono_hi(unsigned w) { return w ^ ((unsigned)((int)w >> 31) | 0x80000000u); }
__device__ __forceinline__ float demono_hi(unsigned k) { const unsigned kk = k & 0xffff0000u; return __builtin_bit_cast(float, (kk ^ ((unsigned)(~(int)kk >> 31) | 0x80000000u)) & 0xffff0000u); }
__device__ __forceinline__ void top16_list(LAS const unsigned char* row, int sw, unsigned (&run)[16]) {
#pragma unroll
    for (int ck = 0; ck < 8; ++ck) {
        const u32x4 w0 = *(LAS const u32x4*)(row + (((2 * ck) ^ sw) << 4)), w1 = *(LAS const u32x4*)(row + (((2 * ck + 1) ^ sw) << 4));
        const unsigned w[8] = {w0.x, w0.y, w0.z, w0.w, w1.x, w1.y, w1.z, w1.w};
        unsigned ch[16];
#pragma unroll
        for (int i = 0; i < 8; ++i) { ch[2 * i] = (mono_hi(w[i] << 16) & 0xffff0000u) | (unsigned)(ck * 16 + 2 * i); ch[2 * i + 1] = (mono_hi(w[i]) & 0xffff0000u) | (unsigned)(ck * 16 + 2 * i + 1); }
        sort16_desc(ch);
        if (ck == 0) {
#pragma unroll
            for (int i = 0; i < 16; ++i) run[i] = ch[i];
        } else merge16_desc(run, ch);
    }
}
__device__ __forceinline__ void topk_fetch(const bf16_t* src, u32x4 (&r)[16], int L) {
#pragma unroll
    for (int i = 0; i < 16; ++i) r[i] = *(const u32x4*)(src + (size_t)(4 * i + (L >> 4)) * 256 + (L & 15) * 8);
}
__device__ __forceinline__ void topk_stage(LAS unsigned char* tile, const u32x4 (&r)[16], int L) {
#pragma unroll
    for (int i = 0; i < 16; ++i) { const int row = 4 * i + (L >> 4); *(LAS u32x4*)(tile + row * 256 + ((((L & 15) ^ (row & 15))) << 4)) = r[i]; }
}
__device__ __forceinline__ void phase_topk(const Ctx& c0) {
    Ctx c = c0; c.lane = lane_id_v(); c.tid = c.wave * 64 + c.lane;
    const bf16_t* sc = WSP(bf16_t, WS_SC); int* IDX = WSP(int, WS_IDX); float* GW = WSP(float, WS_GW);
    const int L = c.lane, gw0 = (c.vcu * 8 + c.wave) * 64, NL = c.G * 512;
    LAS unsigned char* tile = c.lds + c.wave * 16384;
    LAS const unsigned char* myrow = tile + L * 256; const int sw = L & 15;
    for (int eb = gw0; eb < T * H; eb += NL) {
        const int e = eb + L;
        unsigned ka[16], kb[16];
        u32x4 ra[16], rb[16];
        topk_fetch(sc + (size_t)eb * 256, ra, L);
        topk_fetch(sc + (size_t)eb * 256 + 128, rb, L);
        topk_stage(tile, ra, L);
        top16_list(myrow, sw, ka);
        topk_stage(tile, rb, L);
        top16_list(myrow, sw, kb);
        float sa[16], sb[16]; unsigned ia[16], ib[16];
#pragma unroll
        for (int i = 0; i < 16; ++i) { sa[i] = demono_hi(ka[i]); sb[i] = demono_hi(kb[i]); ia[i] = (ka[i] & 0x7fu) << 7; ib[i] = kb[i] & 0x7fu; }
        const float mx = sa[0] + sb[0];
        unsigned run[16], ch[16]; int n = 0, nc = 0;
#pragma unroll
        for (int a = 0; a < 16; ++a)
#pragma unroll
            for (int b = 0; b < 16; ++b) if ((a + 1) * (b + 1) <= 16) {
                const int k = 65535 + (int)((sa[a] + sb[b] - mx) * 1024.f);
                ch[n] = ((unsigned)(k < 0 ? 0 : k) << 16) | ia[a] | ib[b];
                if (++n == 16) { sort16_desc(ch); if (nc == 0) {
#pragma unroll
                        for (int i = 0; i < 16; ++i) run[i] = ch[i]; } else merge16_desc(run, ch);
                    n = 0; ++nc; }
            }
#pragma unroll
        for (int i = 2; i < 16; ++i) ch[i] = 0u;
        sort16_desc(ch); merge16_desc(run, ch);
        float ex[16]; float sum = 0.f;
#pragma unroll
        for (int i = 0; i < 16; ++i) { ex[i] = __expf((float)((int)(run[i] >> 16) - 65535) * (1.f / 1024.f)); sum += ex[i]; }
        const float inv = 1.f / sum;
        u32x4* oi = (u32x4*)(IDX + (size_t)e * 16); f32x4* og = (f32x4*)(GW + (size_t)e * 16);
#pragma unroll
        for (int q = 0; q < 4; ++q) { u32x4 vi; vi.x = run[4 * q] & 0x3fffu; vi.y = run[4 * q + 1] & 0x3fffu; vi.z = run[4 * q + 2] & 0x3fffu; vi.w = run[4 * q + 3] & 0x3fffu; oi[q] = vi;
            f32x4 vg; vg.x = ex[4 * q] * inv; vg.y = ex[4 * q + 1] * inv; vg.z = ex[4 * q + 2] * inv; vg.w = ex[4 * q + 3] * inv; og[q] = vg; }
    }
}

__device__ __forceinline__ void dec32_fp4(const u32x4 r, f32x2 (&f)[16]) {
    const unsigned w[4] = {r.x, r.y, r.z, r.w};
#pragma unroll
    for (int i = 0; i < 4; ++i) { f[4 * i] = __builtin_amdgcn_cvt_scalef32_pk_f32_fp4(w[i], 1.0f, 0); f[4 * i + 1] = __builtin_amdgcn_cvt_scalef32_pk_f32_fp4(w[i], 1.0f, 1);
        f[4 * i + 2] = __builtin_amdgcn_cvt_scalef32_pk_f32_fp4(w[i], 1.0f, 2); f[4 * i + 3] = __builtin_amdgcn_cvt_scalef32_pk_f32_fp4(w[i], 1.0f, 3); }
}
__device__ __forceinline__ float dot32_fp4(const f32x2 (&hv)[16], const u32x4 r) {
    f32x2 f[16]; dec32_fp4(r, f); f32x2 s = hv[0] * f[0];
#pragma unroll
    for (int j = 1; j < 16; ++j) s = s + hv[j] * f[j];
    return s.x + s.y;
}
typedef int i32x8 __attribute__((ext_vector_type(8)));
template <int UV> __device__ __forceinline__ void phase_peer_u(const Ctx& c0) {
    Ctx c = c0; c.lane = lane_id_v(); c.tid = c.wave * 64 + c.lane;
    const int L = c.lane, pp = blockIdx.x & 3, hh = (blockIdx.x >> 2) & 1, rank = blockIdx.x >> 3, nrank = c.G >> 3;
    LAS unsigned char* meta = c.lds + 131584 + c.wave * 2048;
    LAS int* mb = (LAS int*)meta;
    LAS unsigned char* hq = meta + 1536;
    LAS unsigned char* tile = c.lds + c.wave * 16384;
    const int n = L & 15, g4 = L >> 4, lr = L >> 3, lc = L & 7;
    const unsigned char* EUs = c.ws + WS_EU + (size_t)pp * NE * 128 + ((lc ^ (lr >> 1)) << 4);
    const int* IDXl = WSP(int, WS_IDX) + L;
    const unsigned char* H8l = c.ws + WS_H2Q + pp * 256 + 4 * L;
    float* PD = WSP(float, WS_PD) + (size_t)pp * T * 128 + 32 * g4 + 4 * (n >> 1);
    const int t0 = 2 * (rank * 8 + c.wave) + hh, ts = 2 * nrank * 8;
    if (t0 >= T) return;
    const int nk = (T - t0 + ts - 1) / ts;
    int sc1 = 0x7f7f7f7f; asm volatile("" : "+v"(sc1));
    const bool swapb = WSP(unsigned, WS_C8SP)[1024] != 0u;
    const int roff = (n >> 1) * 128 + (((4 * (n & 1) + g4) ^ (n >> 2)) << 4);
    const int hoff = (n & 1) * 128 + g4 * 16;
    const int i0 = n & 1, myP = n >> 1;
#define PEER_U_DMA(m3, q) do { unsigned id_[4]; _Pragma("unroll") for (int Gq = 0; Gq < 4; ++Gq) id_[Gq] = (unsigned)mb[(m3) * 128 + 8 * (4 * (q) + Gq) + lr]; \
        _Pragma("unroll") for (int Gq = 0; Gq < 4; ++Gq) __builtin_amdgcn_global_load_lds((const unsigned*)(EUs + (id_[Gq] << 7)), (LAS unsigned*)(tile + (q) * 4096 + Gq * 1024), 16, 0, 0); } while (0)
#define PEER_U_IDS(m3, tk) do { __builtin_amdgcn_global_load_lds((const unsigned*)(IDXl + (size_t)(tk) * 128), (LAS unsigned*)(mb + (m3) * 128), 4, 0, 0); \
        __builtin_amdgcn_global_load_lds((const unsigned*)(IDXl + (size_t)(tk) * 128 + 64), (LAS unsigned*)(mb + (m3) * 128 + 64), 4, 0, 0); } while (0)
#define PEER_U_HQ(par, tk) __builtin_amdgcn_global_load_lds((const unsigned*)(H8l + (size_t)(tk) * 1024), (LAS unsigned*)(hq + (par) * 256), 4, 0, 0)
#define PEER_U_HB(dst, par) do { int ho = hoff; asm volatile("" : "+v"(ho)); const u32x4 h0 = *(const LAS u32x4*)(hq + (par) * 256 + ho), h1 = *(const LAS u32x4*)(hq + (par) * 256 + ho + 64); \
        unsigned hw[8] = {h0.x, h0.y, h0.z, h0.w, h1.x, h1.y, h1.z, h1.w}; \
        if (swapb) { _Pragma("unroll") for (int q_ = 0; q_ < 8; ++q_) hw[q_] = ((hw[q_] & 0x00ff00ffu) << 8) | ((hw[q_] >> 8) & 0x00ff00ffu); } \
        dst = (i32x8){(int)hw[0], (int)hw[1], (int)hw[2], (int)hw[3], (int)hw[4], (int)hw[5], (int)hw[6], (int)hw[7]}; } while (0)
#define PEER_U_STEP(q, dm3, dq, WAITN) do { \
        PEER_U_DMA(dm3, dq); \
        asm volatile("s_waitcnt vmcnt(" #WAITN ")" ::: "memory"); \
        int ro = roff; asm volatile("" : "+v"(ro)); \
        f32x4 a4[4]; \
        _Pragma("unroll") for (int Gq = 0; Gq < 4; ++Gq) { const u32x4 av = *(const LAS u32x4*)(tile + (q) * 4096 + Gq * 1024 + ro); \
            const i32x8 a = (i32x8){(int)av.x, (int)av.y, (int)av.z, (int)av.w, 0, 0, 0, 0}; \
            a4[Gq] = __builtin_amdgcn_mfma_scale_f32_16x16x128_f8f6f4(a, hb, (f32x4){0.f, 0.f, 0.f, 0.f}, 4, 0, 0, sc1, 0, sc1); } \
        _Pragma("unroll") for (int P = 0; P < 2; ++P) { const f32x4 x0 = a4[2 * P], x1 = a4[2 * P + 1]; \
            const f32x4 cand = (f32x4){i0 ? x0[1] : x0[0], i0 ? x0[3] : x0[2], i0 ? x1[1] : x1[0], i0 ? x1[3] : x1[2]}; \
            if (myP == 2 * (q) + P) o = cand; } \
        asm volatile("s_waitcnt lgkmcnt(0)" ::: "memory"); } while (0)
    PEER_U_IDS(0, t0); PEER_U_IDS(1, (nk > 1) ? t0 + ts : t0); PEER_U_HQ(0, t0);
    asm volatile("s_waitcnt vmcnt(0)" ::: "memory");
    PEER_U_DMA(0, 0); PEER_U_DMA(0, 1); PEER_U_DMA(0, 2);
    i32x8 hb; PEER_U_HB(hb, 0);
    int m0 = 0;
#pragma unroll 1
    for (int k = 0; k < nk; ++k) {
        const int p = k & 1, tk = t0 + k * ts, tn1 = t0 + ((k + 1 < nk) ? k + 1 : nk - 1) * ts, tn2 = t0 + ((k + 2 < nk) ? k + 2 : nk - 1) * ts;
        const int m1 = (m0 == 2) ? 0 : m0 + 1, m2 = (m1 == 2) ? 0 : m1 + 1;
        PEER_U_IDS(m2, tn2); PEER_U_HQ(p ^ 1, tn1);
        f32x4 o = (f32x4){0.f, 0.f, 0.f, 0.f};
        PEER_U_STEP(0, m0, 3, 15);
        PEER_U_STEP(1, m1, 0, 15);
        PEER_U_STEP(2, m1, 1, 15);
        PEER_U_STEP(3, m1, 2, 12);
        { f32x4 o2;
#pragma unroll
          for (int j = 0; j < 4; ++j) { const float ov = o[j]; o2[j] = ov + __builtin_bit_cast(float, __builtin_amdgcn_update_dpp(0, __builtin_bit_cast(int, ov), 0xB1, 0xf, 0xf, false)); }
          if (!(n & 1)) *(f32x4*)(PD + (size_t)tk * 128) = o2; }
        PEER_U_HB(hb, p ^ 1);
        m0 = m1;
    }
    asm volatile("s_waitcnt vmcnt(0)" ::: "memory");
#undef PEER_U_DMA
#undef PEER_U_IDS
#undef PEER_U_HQ
#undef PEER_U_HB
#undef PEER_U_STEP
}
__device__ __forceinline__ void phase_peer_fin_old(const Ctx& c0) {
    Ctx c = c0; c.lane = lane_id_v(); c.tid = c.wave * 64 + c.lane;
    const int* IDX = WSP(int, WS_IDX); const float* GW = WSP(float, WS_GW); const float* PD = WSP(float, WS_PD); unsigned* WGT = WSP(unsigned, WS_WGT);
    const float* SU = WSP(float, WS_SU); const float* SV = WSP(float, WS_SV); const float* SH = WSP(float, WS_SH);
    const int NTH = c.G * 512;
    for (int i0 = c.vcu * 512 + c.tid; i0 < T * 128; i0 += 4 * NTH) {
        float d[4]; int e[4]; float g[4];
#pragma unroll
        for (int u = 0; u < 4; ++u) { const int i = (i0 + u * NTH < T * 128) ? i0 + u * NTH : i0; float s = 0.f;
            const int k = i & 127, pi = (i & ~127) + ((k >> 1) & 3) * 32 + (k >> 3) * 2 + (k & 1);
#pragma unroll
            for (int p = 0; p < 8; ++p) s += PD[(size_t)p * T * 128 + pi];
            d[u] = s; e[u] = IDX[i]; g[u] = GW[i]; }
        float su[4], sv[4], sh[4];
#pragma unroll
        for (int u = 0; u < 4; ++u) { const int i = (i0 + u * NTH < T * 128) ? i0 + u * NTH : i0; su[u] = SU[e[u]]; sv[u] = SV[e[u]]; sh[u] = SH[i >> 7]; }
#pragma unroll
        for (int u = 0; u < 4; ++u) { const int i = i0 + u * NTH; if (i < T * 128) WGT[i] = (f2bf(g[u] * gelu_tanh(d[u] * su[u] * sh[u]) * sv[u]) << 16) | (unsigned)e[u]; }
    }
}
template <bool DRY> __device__ __forceinline__ void phase_peer_v_old(const Ctx& c0) {
    Ctx c = c0; c.lane = lane_id_v(); c.tid = c.wave * 64 + c.lane;
    const unsigned* WI = WSP(unsigned, WS_WGT); const float* mod = WSP(float, WS_MOD);
    const int L = c.lane, pp = blockIdx.x & 3, hh = (blockIdx.x >> 2) & 1, rank = blockIdx.x >> 3, nrank = c.G >> 3;
    const bool b5 = L & 32, b4 = L & 16, b3 = L & 8;
    LAS unsigned* mb = (LAS unsigned*)(c.lds + c.wave * 1024);
    const int kl = L >> 3;
    const unsigned char* EV4 = c.ws + WS_EV + (size_t)pp * NE * 128 + (L & 7) * 16;
    const int col = pp * 256 + (L & 7) * 32 + (b5 ? 16 : 0) + (b4 ? 8 : 0) + (b3 ? 4 : 0);
    const int t0 = 2 * (rank * 8 + c.wave) + hh, ts = 2 * nrank * 8;
    if (t0 >= T) return;
    { const unsigned g0 = WI[(size_t)t0 * 128 + L], g1 = WI[(size_t)t0 * 128 + 64 + L]; mb[L] = g0; mb[64 + L] = g1; }
    u32x4 rA[8], rB[8];
#pragma unroll
    for (int i = 0; i < 8; ++i) rA[i] = *(const u32x4*)(EV4 + (size_t)(mb[8 * i + kl] & 0xffffu) * 128);
    int cur = 0;
#pragma unroll 1
    for (int t = t0; t < T; t += ts) {
        const int tn = (t + ts < T) ? t + ts : t;
        const unsigned gn0 = WI[(size_t)tn * 128 + L], gn1 = WI[(size_t)tn * 128 + 64 + L];
        float* o = c.out + (size_t)t * 1024 + col; const float* g2 = mod + (t >> 11) * 6144 + 5120 + col;
        f32x4 xo = *(const f32x4*)o; const f32x4 gt = *(const f32x4*)g2;
#pragma unroll
        for (int i = 0; i < 8; ++i) rB[i] = *(const u32x4*)(EV4 + (size_t)(mb[cur * 128 + 64 + 8 * i + kl] & 0xffffu) * 128);
        f32x2 ac2[16];
#pragma unroll
        for (int j = 0; j < 16; ++j) ac2[j] = (f32x2){0.f, 0.f};
#pragma unroll
        for (int i = 0; i < 8; ++i) { const float w = bfhi(mb[cur * 128 + 8 * i + kl]); const f32x2 w2 = {w, w}; f32x2 f[16]; dec32_fp4(rA[i], f);
#pragma unroll
            for (int j = 0; j < 16; ++j) ac2[j] = ac2[j] + f[j] * w2; }
        mb[(cur ^ 1) * 128 + L] = gn0; mb[(cur ^ 1) * 128 + 64 + L] = gn1;
#pragma unroll
        for (int i = 0; i < 8; ++i) rA[i] = *(const u32x4*)(EV4 + (size_t)(mb[(cur ^ 1) * 128 + 8 * i + kl] & 0xffffu) * 128);
#pragma unroll
        for (int i = 0; i < 8; ++i) { const float w = bfhi(mb[cur * 128 + 64 + 8 * i + kl]); const f32x2 w2 = {w, w}; f32x2 f[16]; dec32_fp4(rB[i], f);
#pragma unroll
            for (int j = 0; j < 16; ++j) ac2[j] = ac2[j] + f[j] * w2; }
        float acc[32];
#pragma unroll
        for (int j = 0; j < 16; ++j) { acc[2 * j] = ac2[j].x; acc[2 * j + 1] = ac2[j].y; }
        float n16[16], n8[8], n4[4];
#pragma unroll
        for (int i = 0; i < 16; ++i) { const float send = b5 ? acc[i] : acc[i + 16], keep = b5 ? acc[i + 16] : acc[i]; n16[i] = keep + __shfl_xor(send, 32); }
#pragma unroll
        for (int i = 0; i < 8; ++i) { const float send = b4 ? n16[i] : n16[i + 8], keep = b4 ? n16[i + 8] : n16[i]; n8[i] = keep + __shfl_xor(send, 16); }
#pragma unroll
        for (int i = 0; i < 4; ++i) { const float send = b3 ? n8[i] : n8[i + 4], keep = b3 ? n8[i + 4] : n8[i]; n4[i] = keep + __shfl_xor(send, 8); }
        xo.x += gt.x * n4[0]; xo.y += gt.y * n4[1]; xo.z += gt.z * n4[2]; xo.w += gt.w * n4[3];
        if (DRY) asm volatile("" :: "v"(xo.x), "v"(xo.y), "v"(xo.z), "v"(xo.w)); else *(f32x4*)o = xo;
        cur ^= 1;
    }
}

struct ENone {};
struct FInProj { static constexpr int NB = 4; bf16_t *pa, *lx, *lg, *mg; typedef ENone Tile; typedef ENone Pre;
    __device__ __forceinline__ Tile tile(int, int, int) const { return Tile{}; }
    __device__ __forceinline__ Pre pre(int, int, int) const { return Pre{}; }
    __device__ __forceinline__ void apply(int row, int pn, int cc, const float (&v0)[8], const float (&v1)[8], const Pre&, const Tile&) const {
        bf16_t* d;
        if (pn < 2) d = pa + (size_t)row * 512 + pn * 256 + cc; else if (pn < 6) d = lx + (size_t)row * 1024 + (pn - 2) * 256 + cc;
        else if (pn < 10) d = lg + (size_t)row * 1024 + (pn - 6) * 256 + cc; else d = mg + (size_t)row * 2048 + (pn - 10) * 256 + cc;
        *(u32x4*)d = pack8(v0); *(u32x4*)(d + 128) = pack8(v1); } };
struct FRowScale { static constexpr int NB = 4; bf16_t* dst; int ldc; const float* rstd; int which; typedef ENone Tile; struct Pre { float r; };
    __device__ __forceinline__ Tile tile(int, int, int) const { return Tile{}; }
    __device__ __forceinline__ Pre pre(int row, int, int) const { return Pre{rstd[2 * row + which]}; }
    __device__ __forceinline__ void apply(int row, int pn, int cc, const float (&v0)[8], const float (&v1)[8], const Pre& p, const Tile&) const {
        float a[8], b[8];
#pragma unroll
        for (int j = 0; j < 8; ++j) { a[j] = v0[j] * p.r; b[j] = v1[j] * p.r; }
        *(u32x4*)(dst + (size_t)row * ldc + pn * 256 + cc) = pack8(a); *(u32x4*)(dst + (size_t)row * ldc + pn * 256 + 128 + cc) = pack8(b); } };
__device__ __forceinline__ void phase_peer_fin(const Ctx& c0) {
    Ctx c = c0; c.lane = lane_id_v(); c.tid = c.wave * 64 + c.lane;
    const int* IDX = WSP(int, WS_IDX); const float* GW = WSP(float, WS_GW); const float* PD = WSP(float, WS_PD);
    const float* SU = WSP(float, WS_SU); const float* SV = WSP(float, WS_SV); const float* SH = WSP(float, WS_SH);
    unsigned char* W8 = c.ws + WS_W8;
    const int L = c.lane, gw = c.vcu * 8 + c.wave, NGW = c.G * 8;
    const int pi = 2 * L, k0 = 8 * (L & 15) + 2 * (L >> 4);
    constexpr int NT = 4;
#pragma unroll 1
    for (int t = gw; t < T; t += NT * NGW) {
        f32x2 d[NT], g[NT]; int e0[NT], e1[NT]; float sh[NT];
#pragma unroll
        for (int u = 0; u < NT; ++u) { const int tt = (t + u * NGW < T) ? t + u * NGW : t; f32x2 s = (f32x2){0.f, 0.f};
#pragma unroll
            for (int p = 0; p < 4; ++p) s = s + *(const f32x2*)(PD + (size_t)p * T * 128 + (size_t)tt * 128 + pi);
            d[u] = s; const i32x2 ee = *(const i32x2*)(IDX + (size_t)tt * 128 + k0); e0[u] = ee.x; e1[u] = ee.y; g[u] = *(const f32x2*)(GW + (size_t)tt * 128 + k0); sh[u] = SH[tt]; }
        float su0[NT], su1[NT], sv0[NT], sv1[NT];
#pragma unroll
        for (int u = 0; u < NT; ++u) { su0[u] = SU[e0[u]]; su1[u] = SU[e1[u]]; sv0[u] = SV[e0[u]]; sv1[u] = SV[e1[u]]; }
#pragma unroll
        for (int u = 0; u < NT; ++u) { const int tt = t + u * NGW; if (tt < T) {
            const float w0 = g[u].x * gelu_tanh(d[u].x * su0[u] * sh[u]) * sv0[u], w1 = g[u].y * gelu_tanh(d[u].y * su1[u] * sh[u]) * sv1[u];
            float m = fmaxf(fabsf(w0), fabsf(w1));
#pragma unroll
            for (int o = 1; o < 64; o <<= 1) m = fmaxf(m, __shfl_xor(m, o));
            const float sc = m > 0.f ? m * (1.f / 224.f) : 1.f, inv = 1.f / sc;
            const int pk = __builtin_amdgcn_cvt_pk_fp8_f32(w0 * inv, w1 * inv, 0, false);
            *(unsigned short*)(W8 + (size_t)tt * 256 + k0) = (unsigned short)(pk & 0xffff);
            if (L == 0) *(float*)(W8 + (size_t)tt * 256 + 128) = sc; } }
    }
}

template <int DRY> __device__ __forceinline__ void phase_peer_v(const Ctx& c0) {
    Ctx c = c0; c.lane = lane_id_v(); c.tid = c.wave * 64 + c.lane;
    const int L = c.lane, pp = blockIdx.x & 3, hh = (blockIdx.x >> 2) & 1, rank = blockIdx.x >> 3, nrank = c.G >> 3;
    LAS unsigned char* meta = c.lds + 131584 + c.wave * 3584;
    LAS int* mb = (LAS int*)meta;
    LAS unsigned char* wq = meta + 1024;
    LAS unsigned char* buf = meta + 1536;
    LAS unsigned char* gbuf = meta + 2560;
    LAS unsigned char* tile = c.lds + c.wave * 16384;
    const int n = L & 15, g4 = L >> 4, lr = L >> 3, lc = L & 7;
    const unsigned char* EVe = c.ws + WS_EV + (size_t)pp * NE * 128 + ((lc ^ (lr >> 1)) << 4);
    const unsigned char* EVo = c.ws + WS_EV + (size_t)pp * NE * 128 + ((lc ^ (4 + (lr >> 1))) << 4);
    const int* IDXl = WSP(int, WS_IDX) + L;
    const unsigned char* W8l = c.ws + WS_W8 + 4 * L;
    const unsigned char* X1l = c.ws + WS_X1B + pp * 512 + 4 * L;
    const float* G2l = WSP(float, WS_MOD) + 5120 + pp * 256 + 4 * L;
    const int t0 = 2 * (rank * 8 + c.wave) + hh, ts = 2 * nrank * 8;
    if (t0 >= T) return;
    const int nk = (T - t0 + ts - 1) / ts;
    int sc1 = 0x7f7f7f7f; asm volatile("" : "+v"(sc1));
    const bool swapn = WSP(unsigned, WS_C8SP)[1024] != 0u;
    const int ab = n * 128, ay = (g4 ^ ((n >> 1) & 7)) << 4;
    const bool z0 = n == g4, z1 = n == 4 + g4;
#define PEER_V_IDS(par, tk) do { __builtin_amdgcn_global_load_lds((const unsigned*)(IDXl + (size_t)(tk) * 128), (LAS unsigned*)(mb + (par) * 128), 4, 0, 0); \
        __builtin_amdgcn_global_load_lds((const unsigned*)(IDXl + (size_t)(tk) * 128 + 64), (LAS unsigned*)(mb + (par) * 128 + 64), 4, 0, 0); } while (0)
#define PEER_V_W8(par, tk) __builtin_amdgcn_global_load_lds((const unsigned*)(W8l + (size_t)(tk) * 256), (LAS unsigned*)(wq + (par) * 256), 4, 0, 0)
#define PEER_V_XG(tk) do { if (DRY == 3) break; __builtin_amdgcn_global_load_lds((const unsigned*)(X1l + (size_t)(tk) * 2048), (LAS unsigned*)buf, 4, 0, 0); \
        __builtin_amdgcn_global_load_lds((const unsigned*)(X1l + (size_t)(tk) * 2048 + 256), (LAS unsigned*)(buf + 256), 4, 0, 0); \
        __builtin_amdgcn_global_load_lds((const unsigned*)(G2l + ((tk) >> 11) * 6144), (LAS unsigned*)gbuf, 16, 0, 0); } while (0)
#define PEER_V_DMA(par, e) do { const unsigned id0_ = (unsigned)mb[(par) * 128 + 16 * (e) + lr], id1_ = (unsigned)mb[(par) * 128 + 16 * (e) + 8 + lr]; \
        __builtin_amdgcn_global_load_lds((const unsigned*)(EVe + (id0_ << 7)), (LAS unsigned*)(tile + (e) * 2048), 16, 0, 0); \
        __builtin_amdgcn_global_load_lds((const unsigned*)(EVo + (id1_ << 7)), (LAS unsigned*)(tile + (e) * 2048 + 1024), 16, 0, 0); } while (0)
#define PEER_V_STEP(e, dpar, de, WAITN) do { \
        PEER_V_DMA(dpar, de); \
        asm volatile("s_waitcnt vmcnt(" #WAITN ")" ::: "memory"); \
        int ab_ = ab, ay_ = ay; asm volatile("" : "+v"(ab_), "+v"(ay_)); \
        const u32x4 wv = *(const LAS u32x4*)(wq + p * 256 + 16 * (e)); \
        const i32x8 hb = (i32x8){z0 ? (int)wv.x : 0, z0 ? (int)wv.y : 0, z0 ? (int)wv.z : 0, z0 ? (int)wv.w : 0, z1 ? (int)wv.x : 0, z1 ? (int)wv.y : 0, z1 ? (int)wv.z : 0, z1 ? (int)wv.w : 0}; \
          \
        const unsigned tb_ = (unsigned)(__SIZE_TYPE__)(tile + (e) * 2048) + (unsigned)ab_; \
        const unsigned a0_ = tb_ + (unsigned)(0 ^ ay_), a1_ = tb_ + (unsigned)(64 ^ ay_); \
        i32x2 f00, f01, f10, f11; \
        asm volatile("ds_read_b64_tr_b4 %0, %4\n\tds_read_b64_tr_b4 %1, %4 offset:8\n\tds_read_b64_tr_b4 %2, %5\n\tds_read_b64_tr_b4 %3, %5 offset:8\n\ts_waitcnt lgkmcnt(0)" \
                     : "=&v"(f00), "=&v"(f01), "=&v"(f10), "=&v"(f11) : "v"(a0_), "v"(a1_) : "memory"); \
        acc[0] = __builtin_amdgcn_mfma_scale_f32_16x16x128_f8f6f4((i32x8){f00.x, f00.y, f01.x, f01.y, 0, 0, 0, 0}, hb, acc[0], 4, 0, 0, sc1, 0, sc1); \
        acc[1] = __builtin_amdgcn_mfma_scale_f32_16x16x128_f8f6f4((i32x8){f10.x, f10.y, f11.x, f11.y, 0, 0, 0, 0}, hb, acc[1], 4, 0, 0, sc1, 0, sc1); \
        } while (0)
    PEER_V_IDS(0, t0); PEER_V_IDS(1, (nk > 1) ? t0 + ts : t0); PEER_V_W8(0, t0);
    asm volatile("s_waitcnt vmcnt(0)" ::: "memory");
    PEER_V_DMA(0, 0); PEER_V_DMA(0, 1); PEER_V_DMA(0, 2); PEER_V_DMA(0, 3); PEER_V_DMA(0, 4); PEER_V_DMA(0, 5); PEER_V_DMA(0, 6); PEER_V_XG(t0);
#pragma unroll 1
    for (int k = 0; k < nk; ++k) {
        const int p = k & 1, tk = t0 + k * ts, tn1 = t0 + ((k + 1 < nk) ? k + 1 : nk - 1) * ts, tn2 = t0 + ((k + 2 < nk) ? k + 2 : nk - 1) * ts;
        f32x4 acc[2];
        acc[0] = (f32x4){0.f, 0.f, 0.f, 0.f}; acc[1] = (f32x4){0.f, 0.f, 0.f, 0.f};
        PEER_V_STEP(0, p, 7, 17);
        PEER_V_IDS(p, tn2); PEER_V_W8(p ^ 1, tn1);
        PEER_V_STEP(1, p ^ 1, 0, 20);
        PEER_V_STEP(2, p ^ 1, 1, 20);
        PEER_V_STEP(3, p ^ 1, 2, 20);
        PEER_V_STEP(4, p ^ 1, 3, 20);
        PEER_V_STEP(5, p ^ 1, 4, 20);
        PEER_V_STEP(6, p ^ 1, 5, 20);
        PEER_V_STEP(7, p ^ 1, 6, 17);
        const u32x2 xb = *(const LAS u32x2*)(buf + 8 * L); const f32x4 xo = (f32x4){bflo(xb.x), bfhi(xb.x), bflo(xb.y), bfhi(xb.y)}, gt = *(const LAS f32x4*)(gbuf + 16 * L); const float swt = *(const LAS float*)(wq + p * 256 + 128);
        asm volatile("s_waitcnt lgkmcnt(0)" ::: "memory");
        if (n < 8) {
#pragma unroll
            for (int M = 0; M < 2; ++M) { f32x4 v = acc[M]; if (swapn) v = (f32x4){v.y, v.x, v.w, v.z}; *(LAS f32x4*)(buf + (128 * M + 16 * n + 4 * g4) * 4) = v; } }
        const f32x4 r = *(const LAS f32x4*)(buf + 16 * L);
        f32x4 res; res.x = xo.x + gt.x * swt * r.x; res.y = xo.y + gt.y * swt * r.y; res.z = xo.z + gt.z * swt * r.z; res.w = xo.w + gt.w * swt * r.w;
        if (DRY) asm volatile("" :: "v"(res.x), "v"(res.y), "v"(res.z), "v"(res.w)); else *(f32x4*)(c.out + (size_t)tk * 1024 + pp * 256 + 4 * L) = res;
        asm volatile("s_waitcnt lgkmcnt(0)" ::: "memory");
        PEER_V_XG(tn1);
    }
    asm volatile("s_waitcnt vmcnt(0)" ::: "memory");
#undef PEER_V_IDS
#undef PEER_V_W8
#undef PEER_V_XG
#undef PEER_V_DMA
#undef PEER_V_STEP
}


constexpr int GT_OFF = 132096;
struct FGates { static constexpr int NB = 2; const bf16_t* xc; bf16_t *LA, *Bv; LAS const float* gt;
    typedef ENone Tile; struct Pre { u32x4 x; };
    __device__ __forceinline__ Tile tile(int, int, int) const { return Tile{}; }
    __device__ __forceinline__ Pre pre(int row, int pn, int cc) const { return Pre{*(const u32x4*)(xc + (size_t)row * 1024 + pn * 128 + cc)}; }
    __device__ __forceinline__ void apply(int row, int pn, int cc, const float (&v0)[8], const float (&v1)[8], const Pre& p, const Tile&) const {
        const int ch = pn * 128 + cc; float x[8], la[8], bv[8]; unpack8(p.x, x);
        const f32x4 br0 = *(LAS const f32x4*)(gt + ch), br1 = *(LAS const f32x4*)(gt + ch + 4), bi0 = *(LAS const f32x4*)(gt + 1024 + ch), bi1 = *(LAS const f32x4*)(gt + 1024 + ch + 4),
                    c80 = *(LAS const f32x4*)(gt + 2048 + ch), c81 = *(LAS const f32x4*)(gt + 2048 + ch + 4);
        const float br[8] = {br0.x, br0.y, br0.z, br0.w, br1.x, br1.y, br1.z, br1.w}, bi[8] = {bi0.x, bi0.y, bi0.z, bi0.w, bi1.x, bi1.y, bi1.z, bi1.w}, c8[8] = {c80.x, c80.y, c80.z, c80.w, c81.x, c81.y, c81.z, c81.w};
#pragma unroll
        for (int j = 0; j < 8; ++j) {
            const float r = __builtin_amdgcn_rcpf(1.f + __expf(-(v0[j] + br[j]))), ig = __builtin_amdgcn_rcpf(1.f + __expf(-(v1[j] + bi[j])));
            const float loga = r * c8[j];
            const float z = 2.f * loga;
            const float ser = -z * (1.f + z * (0.5f + z * (0.16666667f + z * (0.041666668f + z * (0.008333334f + z * 0.0013888889f)))));
            const float om = (z > -0.25f) ? ser : (1.f - __expf(z));
            la[j] = loga * 1.4426950408889634f;
            bv[j] = sqrtf(om) * (ig * x[j]);
        }
        *(u32x4*)(LA + (size_t)row * 1024 + ch) = pack8(la); *(u32x4*)(Bv + (size_t)row * 1024 + ch) = pack8(bv); } };
struct FY1 { static constexpr int NB = 4; const bf16_t* mg; bf16_t* y; int goff; bool accum; typedef ENone Tile; struct Pre { u32x4 g0, g1, y0, y1; };
    __device__ __forceinline__ Tile tile(int, int, int) const { return Tile{}; }
    __device__ __forceinline__ Pre pre(int row, int pn, int cc) const { Pre p; const int col = pn * 256 + cc;
        p.g0 = *(const u32x4*)(mg + (size_t)row * 2048 + goff + col); p.g1 = *(const u32x4*)(mg + (size_t)row * 2048 + goff + col + 128);
        if (accum) { p.y0 = *(const u32x4*)(y + (size_t)row * 1024 + col); p.y1 = *(const u32x4*)(y + (size_t)row * 1024 + col + 128); } else { p.y0 = (u32x4){0u, 0u, 0u, 0u}; p.y1 = p.y0; }
        return p; }
    __device__ __forceinline__ void one(bf16_t* dst, const u32x4 g, const u32x4 yo, const float (&v)[8]) const {
        float gt[8], o[8]; unpack8(g, gt); unpack8(yo, o);
#pragma unroll
        for (int j = 0; j < 8; ++j) o[j] = o[j] + sigmoidf_(gt[j]) * v[j];
        *(u32x4*)dst = pack8(o); }
    __device__ __forceinline__ void apply(int row, int pn, int cc, const float (&v0)[8], const float (&v1)[8], const Pre& p, const Tile&) const {
        bf16_t* d = y + (size_t)row * 1024 + pn * 256 + cc; one(d, p.g0, p.y0, v0); one(d + 128, p.g1, p.y1, v1); } };
struct FX1 { static constexpr int NB = 4; const float* x; bf16_t* out; const float* mod; struct Tile { f32x4 a[4]; }; struct Pre { f32x4 x[4]; };
    __device__ __forceinline__ Tile tile(int pn, int cc, int pm) const { Tile t; const float* g1 = mod + ((pm * 256) >> 11) * 6144 + 2048 + pn * 256 + cc;
        t.a[0] = *(const f32x4*)g1; t.a[1] = *(const f32x4*)(g1 + 4); t.a[2] = *(const f32x4*)(g1 + 128); t.a[3] = *(const f32x4*)(g1 + 132); return t; }
    __device__ __forceinline__ Pre pre(int row, int pn, int cc) const { Pre p; const float* xr = x + (size_t)row * 1024 + pn * 256 + cc;
        p.x[0] = *(const f32x4*)xr; p.x[1] = *(const f32x4*)(xr + 4); p.x[2] = *(const f32x4*)(xr + 128); p.x[3] = *(const f32x4*)(xr + 132); return p; }
    __device__ __forceinline__ void apply(int row, int pn, int cc, const float (&v0)[8], const float (&v1)[8], const Pre& p, const Tile& t) const {
        bf16_t* o = out + (size_t)row * 1024 + pn * 256 + cc;
        f32x4 r0, r1, r2, r3;
        r0.x = p.x[0].x + t.a[0].x * v0[0]; r0.y = p.x[0].y + t.a[0].y * v0[1]; r0.z = p.x[0].z + t.a[0].z * v0[2]; r0.w = p.x[0].w + t.a[0].w * v0[3];
        r1.x = p.x[1].x + t.a[1].x * v0[4]; r1.y = p.x[1].y + t.a[1].y * v0[5]; r1.z = p.x[1].z + t.a[1].z * v0[6]; r1.w = p.x[1].w + t.a[1].w * v0[7];
        r2.x = p.x[2].x + t.a[2].x * v1[0]; r2.y = p.x[2].y + t.a[2].y * v1[1]; r2.z = p.x[2].z + t.a[2].z * v1[2]; r2.w = p.x[2].w + t.a[2].w * v1[3];
        r3.x = p.x[3].x + t.a[3].x * v1[4]; r3.y = p.x[3].y + t.a[3].y * v1[5]; r3.z = p.x[3].z + t.a[3].z * v1[6]; r3.w = p.x[3].w + t.a[3].w * v1[7];
        u32x4 w0, w1; w0.x = pk2(r0.x, r0.y); w0.y = pk2(r0.z, r0.w); w0.z = pk2(r1.x, r1.y); w0.w = pk2(r1.z, r1.w); w1.x = pk2(r2.x, r2.y); w1.y = pk2(r2.z, r2.w); w1.z = pk2(r3.x, r3.y); w1.w = pk2(r3.z, r3.w);
        *(u32x4*)o = w0; *(u32x4*)(o + 128) = w1; } };
struct FStore { static constexpr int NB = 4; bf16_t* dst; int ldc; typedef ENone Tile; typedef ENone Pre;
    __device__ __forceinline__ Tile tile(int, int, int) const { return Tile{}; }
    __device__ __forceinline__ Pre pre(int, int, int) const { return Pre{}; }
    __device__ __forceinline__ void apply(int row, int pn, int cc, const float (&v0)[8], const float (&v1)[8], const Pre&, const Tile&) const {
        *(u32x4*)(dst + (size_t)row * ldc + pn * 256 + cc) = pack8(v0); *(u32x4*)(dst + (size_t)row * ldc + pn * 256 + 128 + cc) = pack8(v1); } };

struct TablesFill { const Ctx* c; int slot; __device__ __forceinline__ void operator()(int ui) const { if (ui == slot) prep_tables(*c); } };
template <int M, int N, int K, int LDA, int ACS, class F, class Fill> __device__ __forceinline__ void run_gemm_fill(const Ctx& c, const bf16_t* A, const bf16_t* Bt, const F& f, const Fill& fill) {
    pg8::Gemm g{A, Bt}; pg8::StaticOrder<M, N> So; So.init(c.G, (int)blockIdx.x);
    pg8::EpiF<F> E{f};
    pg8::gemm_phase<K, LDA, ACS, pg8::EpiF<F>, pg8::StaticOrder<M, N>, Fill>((PG8_LAS unsigned char*)c.lds, g, So, E, c.wave * 64 + lane_id_v(), fill);
}
template <int M, int N, int K, int LDA, int ACS, class F> __device__ __forceinline__ void run_gemm(const Ctx& c, const bf16_t* A, const bf16_t* Bt, const F& f) {
    pg8::Gemm g{A, Bt}; pg8::StaticOrder<M, N> So; So.init(c.G, (int)blockIdx.x);
    pg8::EpiF<F> E{f};
    pg8::gemm_phase<K, LDA, ACS, pg8::EpiF<F>, pg8::StaticOrder<M, N>>((PG8_LAS unsigned char*)c.lds, g, So, E, c.wave * 64 + lane_id_v());
}

__global__ void __launch_bounds__(512, 2) mk_fwd(Args args) {
    extern __shared__ __attribute__((aligned(16))) unsigned char lds_raw[];
    Ctx c;
    c.lds = (LAS unsigned char*)lds_raw;
    c.wave = __builtin_amdgcn_readfirstlane(threadIdx.x >> 6); c.lane = lane_id_v(); c.tid = c.wave * 64 + c.lane;
    c.G = gridDim.x; { const int bx = blockIdx.x; c.vcu = (c.G % 8 == 0) ? (bx % 8) * (c.G / 8) + bx / 8 : bx; }
    c.in = args.in; c.out = args.out; c.ws = args.ws;
    volatile LAS unsigned* MISC = (volatile LAS unsigned*)(c.lds + MISC_OFF);
    if (c.tid < 32) MISC[c.tid] = 0u;
    __syncthreads();
    XcdBarrier bar; bar.bar = (unsigned*)(c.ws + WS_CTL) + 4096; bar.x = 0; bar.st = nullptr;
    if (args.ph_hi - args.ph_lo > 1) bar = xcd_barrier_post((unsigned*)(c.ws + WS_CTL) + 4096, MISC + 8);

    const int lo = args.ph_lo, hi = args.ph_hi;
#ifndef ONLYP
#define ONLYP -1
#endif
#define IN(k) (lo <= (k) && (k) < hi && (ONLYP < 0 || ONLYP == (k)))
#define SEAM(k) do { if ((k) + 1 < hi) xcd_barrier(bar, c.wave); } while (0)
#ifndef REPEAT_MASK
#define REPEAT_MASK 0
#endif
#ifdef PROBE_TIME
#define PROBE_TS(k) do { if (blockIdx.x == 0 && c.wave == 0 && lane_id_v() == 0) WSP(unsigned long long, WS_C8SP + 16384)[k] = wall_clock64(); } while (0)
#else
#define PROBE_TS(k) do { } while (0)
#endif
#define PHASE(k, ...) if (IN(k)) { c.lane = lane_id_v(); c.tid = c.wave * 64 + c.lane; { __VA_ARGS__ } if ((REPEAT_MASK >> (k)) & 1) { xcd_barrier(bar, c.wave); { __VA_ARGS__ } } SEAM(k); PROBE_TS((k) + 1); }
    PROBE_TS(0);
#ifdef PROBE_PREP
    if (IN(0)) { c.lane = lane_id_v(); c.tid = c.wave * 64 + c.lane; phase_prep<PROBE_PREP>(c); xcd_barrier(bar, c.wave); }
#endif
    PHASE(0, phase_prep<11>(c);)
    PHASE(1, phase_modnorm<false>(c, c.in[I_X], c.in[I_N1G], 0, 1024, WSP(bf16_t, WS_R0));)
    PHASE(2, FInProj f{WSP(bf16_t, WS_R1), WSP(bf16_t, WS_R2), WSP(bf16_t, WS_R3), (bf16_t*)c.out};
             const int upb = (128 * 18) / c.G;
             TablesFill tf{&c, upb > 0 ? c.vcu % upb : 0};
             run_gemm_fill<T, 4608, 1024, 1024, 0>(c, WSP(bf16_t, WS_R0), WSP(bf16_t, WS_WIN), f, tf);)
    PHASE(3, phase_conv(c);)
    PHASE(4, { LAS float* gtl = (LAS float*)(c.lds + GT_OFF);
               for (int e = c.tid; e < 1024; e += 512) { gtl[e] = c.in[I_BRG][e]; gtl[1024 + e] = c.in[I_BIG][e]; gtl[2048 + e] = WSP(float, WS_C8SP)[e]; }
               __syncthreads();
               FGates fg{WSP(bf16_t, WS_R4), WSP(bf16_t, WS_R0), WSP(bf16_t, WS_R6), gtl};
               run_gemm<T, 2048, 128, 1024, 128>(c, WSP(bf16_t, WS_R4), WSP(bf16_t, WS_WG), fg); }
             { FRowScale fq{WSP(bf16_t, WS_R5), 768, WSP(float, WS_RSTD), 0};
               run_gemm<T, 768, 256, 512, 0>(c, WSP(bf16_t, WS_R1), WSP(bf16_t, WS_WUQ), fq); })
    PHASE(5, { FRowScale fkv{WSP(bf16_t, WS_R2), 1024, WSP(float, WS_RSTD), 1};
               run_gemm<T, 1024, 128, 512, 0>(c, WSP(bf16_t, WS_R1) + 256, WSP(bf16_t, WS_WUKV), fkv); }
             phase_scan(c);)
    PHASE(6, phase_qkv_layout(c);)
    PHASE(7, phase_attn(c);)
    PHASE(8, { FY1 f1{(const bf16_t*)c.out, WSP(bf16_t, WS_R2), 0, false};
               run_gemm<T, 1024, 512, 512, 0>(c, WSP(bf16_t, WS_R0 + 32 * MiB), WSP(bf16_t, WS_WOA), f1); }
             { FY1 f2{(const bf16_t*)c.out, WSP(bf16_t, WS_R2), 1024, true};
               run_gemm<T, 1024, 1024, 1024, 0>(c, WSP(bf16_t, WS_R6), WSP(bf16_t, WS_WOL), f2); })
    PHASE(9, FX1 f{c.in[I_X], WSP(bf16_t, WS_X1B), WSP(float, WS_MOD)};
             run_gemm<T, 1024, 1024, 1024, 0>(c, WSP(bf16_t, WS_R2), WSP(bf16_t, WS_WOUT), f);)
    PHASE(10, phase_modnorm<true>(c, WSP(bf16_t, WS_X1B), c.in[I_N2G], 3072, 4096, WSP(bf16_t, WS_R0));)
    PHASE(11, FStore f{WSP(bf16_t, WS_SC), 2048};
              run_gemm<T, 2048, 1024, 1024, 0>(c, WSP(bf16_t, WS_R0), WSP(bf16_t, WS_WQ), f);)
    PHASE(13, phase_topk(c);)
#ifdef PROBE_UVAR
    if (IN(14)) { c.lane = lane_id_v(); c.tid = c.wave * 64 + c.lane; phase_peer_u<PROBE_UVAR>(c); xcd_barrier(bar, c.wave); }
#endif
    PHASE(14, phase_peer_u<0>(c);)
    PHASE(15, phase_peer_fin(c);)
#ifdef PROBE_VDRY
    if (IN(16)) { for (int rep = 0; rep < PROBE_VDRY; ++rep) { c.lane = lane_id_v(); c.tid = c.wave * 64 + c.lane; phase_peer_v<PROBE_VVAR>(c); xcd_barrier(bar, c.wave); } }
#endif
    PHASE(16, phase_peer_v<0>(c);)
#ifdef PROBE_TIME
    if (blockIdx.x == 0) { __syncthreads(); if (c.wave == 0 && lane_id_v() == 0) { __threadfence(); const unsigned long long* ts = WSP(unsigned long long, WS_C8SP + 16384); c.out[0] = (float)(ts[PROBE_TIME_HI] - ts[PROBE_TIME]) * 0.01f; } }
#endif
#undef PHASE
#undef IN
#undef SEAM
}

extern "C" void kernel_launch(void* const* d_in, const int* in_sizes, int n_in, void* d_out, int out_size, void* d_ws, size_t ws_size, hipStream_t stream) {
    static int grid = 0;
    if (grid == 0) {
        if (n_in != 28 || out_size != T * D || ws_size < WS_END) { fprintf(stderr, "kernel_launch: unexpected shapes (n_in %d out %d ws %zu)\n", n_in, out_size, ws_size); grid = -1; return; }
        int dev = 0, cus = 0, per_cu = 0;
        if (hipGetDevice(&dev) != hipSuccess || hipDeviceGetAttribute(&cus, hipDeviceAttributeMultiprocessorCount, dev) != hipSuccess) { grid = -1; return; }
        if (hipFuncSetAttribute((const void*)mk_fwd, hipFuncAttributeMaxDynamicSharedMemorySize, LDS_BYTES) != hipSuccess) { fprintf(stderr, "kernel_launch: hipFuncSetAttribute failed\n"); grid = -1; return; }
        if (hipOccupancyMaxActiveBlocksPerMultiprocessor(&per_cu, (const void*)mk_fwd, 512, LDS_BYTES) != hipSuccess || per_cu < 1) { fprintf(stderr, "kernel_launch: occupancy query says %d blocks per CU\n", per_cu); grid = -1; (void)hipGetLastError(); return; }
        grid = cus - (cus % 8);
        if (grid < 8) { fprintf(stderr, "kernel_launch: needs at least 8 CUs\n"); grid = -1; return; }
    }
    if (grid < 0) return;
    (void)hipMemsetAsync((char*)d_ws + WS_CTL, 0, CTL_ZERO_BYTES, stream);
    Args a{};
    for (int i = 0; i < 28; ++i) a.in[i] = (const float*)d_in[i];
    a.out = (float*)d_out; a.ws = (unsigned char*)d_ws;
#if MK_N_LAUNCHES == 1
    a.ph_lo = 0; a.ph_hi = N_PHASES;
    hipLaunchKernelGGL(mk_fwd, dim3(grid), dim3(512), LDS_BYTES, stream, a);
#else
    for (int ph = 0; ph < N_PHASES; ++ph) { a.ph_lo = ph; a.ph_hi = ph + 1; hipLaunchKernelGGL(mk_fwd, dim3(grid), dim3(512), LDS_BYTES, stream, a); }
#endif
}
```
